# Optimizing an MI355X kernel written in HIP

```python
import math
import jax, jax.numpy as jnp
from jax import lax
import numpy as np

D_MODEL = 1024
BATCH = 16
SEQ = 2048
DEPTH = 1

HG_HEADS = 4
HG_KDIM = 128
HG_VDIM = 128
HG_F = HG_HEADS * HG_KDIM
HG_V = HG_HEADS * HG_VDIM
HG_CHUNK = 64
MLA_HEADS = 8
MLA_NOPE = 64
MLA_ROPE = 32
MLA_VDIM = 64
MLA_QK = MLA_NOPE + MLA_ROPE
MLA_Q_RANK = 256
MLA_KV_RANK = 128
ATTN_BLOCK = 128
ROPE_THETA = 10000.0
N_GROUPS = 8
EXPERTS_PER_GROUP = 8
N_EXPERTS = N_GROUPS * EXPERTS_PER_GROUP
TOP_K = 2
D_EXPERT = 256
MOE_BLOCK = 128
PLE_DIM = 256
EPS = 1e-6
IN_WIDTHS = (HG_F, HG_F, HG_F, HG_V, HG_V, MLA_Q_RANK, MLA_KV_RANK, MLA_ROPE, D_MODEL, D_MODEL)
D_IN = HG_F * 3 + HG_V * 2 + MLA_Q_RANK + MLA_KV_RANK + MLA_ROPE + 2 * D_MODEL

kernel_name = "hybrid_hgrn2_mla_hmoe_block"


def rmsnorm(x, g):
    xf = x.astype(jnp.float32)
    y = xf * lax.rsqrt(jnp.mean(xf * xf, axis=-1, keepdims=True) + EPS)
    return (y * g.astype(jnp.float32)).astype(x.dtype)


def rope(x, positions):
    half = MLA_ROPE // 2
    inv_freq = ROPE_THETA ** (-jnp.arange(half, dtype=jnp.float32) / half)
    ang = positions.astype(jnp.float32)[..., None] * inv_freq
    cos = jnp.cos(ang)[:, :, None, :]
    sin = jnp.sin(ang)[:, :, None, :]
    x1 = x[..., :half].astype(jnp.float32)
    x2 = x[..., half:].astype(jnp.float32)
    out = jnp.concatenate([x1 * cos - x2 * sin, x2 * cos + x1 * sin], axis=-1)
    return out.astype(x.dtype)


def gla_chunkwise(q, k, v, log_f):
    B, H, S, K = q.shape
    V = v.shape[-1]
    n = S // HG_CHUNK

    def to_chunks(a):
        return jnp.moveaxis(a.reshape(B, H, n, HG_CHUNK, a.shape[-1]), 2, 0)

    qc, kc, vc, gc = to_chunks(q), to_chunks(k), to_chunks(v), to_chunks(log_f)
    lower = jnp.tril(jnp.ones((HG_CHUNK, HG_CHUNK), dtype=bool))

    def step(state, inp):
        qb, kb, vb, gb = inp
        g = jnp.cumsum(gb, axis=2)
        o_inter = jnp.einsum('bhtk,bhkv->bhtv', qb * jnp.exp(g), state)
        diff = g[:, :, :, None, :] - g[:, :, None, :, :]
        decay = jnp.exp(jnp.where(lower[:, :, None], diff, -jnp.inf))
        scores = jnp.einsum('bhtk,bhsk,bhtsk->bhts', qb, kb, decay)
        o_intra = jnp.einsum('bhts,bhsv->bhtv', scores, vb)
        g_last = g[:, :, -1]
        k_dec = kb * jnp.exp(g_last[:, :, None, :] - g)
        new_state = jnp.exp(g_last)[..., None] * state + jnp.einsum('bhck,bhcv->bhkv', k_dec, vb)
        return new_state, o_inter + o_intra

    s0 = jnp.zeros((B, H, K, V), jnp.float32)
    _, o = lax.scan(step, s0, (qc, kc, vc, gc))
    return jnp.moveaxis(o, 0, 2).reshape(B, H, S, V)


def block_dense_attention(q, k, v):
    B, H, S, Dq = q.shape
    nb = S // ATTN_BLOCK
    qb = jnp.moveaxis(q.reshape(B, H, nb, ATTN_BLOCK, Dq), 2, 0)
    scale = MLA_QK ** -0.5

    def one_block(qblk):
        s = jnp.einsum('bhqd,bhkd->bhqk', qblk, k).astype(jnp.float32) * scale
        pr = jax.nn.softmax(s, axis=-1).astype(v.dtype)
        return jnp.einsum('bhqk,bhkd->bhqd', pr, v)

    o = lax.map(one_block, qb)
    return jnp.moveaxis(o, 0, 2).reshape(B, H, S, v.shape[-1])


def hierarchical_moe(h, w_rg, b_rg, w_re, b_re, w1, w3, w2):
    T, D = h.shape
    g_logits = (h @ w_rg).astype(jnp.float32) + b_rg.astype(jnp.float32)
    g_prob = jax.nn.softmax(g_logits, axis=-1)
    g_sel = jnp.argmax(g_prob, axis=-1).astype(jnp.int32)
    p_group = jnp.max(g_prob, axis=-1)
    e_logits = ((h @ w_re).astype(jnp.float32) + b_re.astype(jnp.float32)).reshape(T, N_GROUPS, EXPERTS_PER_GROUP)
    e_in_group = jnp.take_along_axis(e_logits, g_sel[:, None, None], axis=1)[:, 0]
    top_v, top_i = lax.top_k(e_in_group, TOP_K)
    w_local = jax.nn.softmax(top_v, axis=-1)
    expert = (g_sel[:, None] * EXPERTS_PER_GROUP + top_i.astype(jnp.int32)).reshape(-1)
    weight = (p_group[:, None] * w_local).reshape(-1)
    token = jnp.repeat(jnp.arange(T, dtype=jnp.int32), TOP_K)
    A = T * TOP_K

    counts = jnp.zeros((N_EXPERTS,), jnp.int32).at[expert].add(1)
    starts = jnp.cumsum(counts) - counts
    pcounts = (counts + MOE_BLOCK - 1) // MOE_BLOCK * MOE_BLOCK
    pends = jnp.cumsum(pcounts)
    pstarts = pends - pcounts
    order = jnp.argsort(expert)
    e_sorted = expert[order]
    rank = jnp.arange(A, dtype=jnp.int32) - starts[e_sorted]
    dest = pstarts[e_sorted] + rank
    n_blocks = (A + N_EXPERTS * (MOE_BLOCK - 1) + MOE_BLOCK - 1) // MOE_BLOCK
    P = n_blocks * MOE_BLOCK
    buf_tok = jnp.full((P,), T, jnp.int32).at[dest].set(token[order])
    buf_w = jnp.zeros((P,), h.dtype).at[dest].set(weight[order].astype(h.dtype))
    block_expert = jnp.minimum(
        jnp.searchsorted(pends, jnp.arange(n_blocks, dtype=jnp.int32) * MOE_BLOCK, side='right'),
        N_EXPERTS - 1)
    h_pad = jnp.concatenate([h, jnp.zeros((1, D), h.dtype)], axis=0)
    xb = h_pad[buf_tok].reshape(n_blocks, MOE_BLOCK, D)

    def expert_block(args):
        xblk, e = args
        return (jax.nn.silu(xblk @ w1[e]) * (xblk @ w3[e])) @ w2[e]

    yb = lax.map(expert_block, (xb, block_expert)).reshape(P, D)
    out = jax.ops.segment_sum(yb * buf_w[:, None], buf_tok, num_segments=T + 1)
    return out[:T]


def setup_inputs(seed: int = 0) -> dict:
    key = jax.random.key(seed)
    ks = jax.random.split(key, 32)
    f32 = jnp.float32

    def w(k, shape, fan_in):
        return jax.random.normal(k, shape, f32) * (fan_in ** -0.5)

    def gain(k, shape):
        return 1.0 + 0.1 * jax.random.normal(k, shape, f32)

    L = DEPTH
    offsets = jax.random.randint(ks[2], (BATCH, 1), 0, SEQ, dtype=jnp.int32)
    positions = jnp.arange(SEQ, dtype=jnp.int32)[None, :] + offsets
    return {
        "x": jax.random.normal(ks[0], (BATCH, SEQ, D_MODEL), f32),
        "p": jax.random.normal(ks[1], (DEPTH, BATCH, SEQ, PLE_DIM), f32),
        "positions": positions,
        "ln_mix": gain(ks[3], (L, D_MODEL)),
        "w_in": w(ks[4], (L, D_MODEL, D_IN), D_MODEL),
        "hg_lb": 0.5 * jax.random.normal(ks[5], (2, DEPTH + 1, HG_F), f32),
        "hg_onorm": gain(ks[6], (L, HG_VDIM)),
        "w_oA": w(ks[7], (L, HG_V, D_MODEL), HG_V),
        "mla_qa_norm": gain(ks[8], (L, MLA_Q_RANK)),
        "mla_kva_norm": gain(ks[9], (L, MLA_KV_RANK)),
        "w_uq": w(ks[10], (L, MLA_Q_RANK, MLA_HEADS * MLA_QK), MLA_Q_RANK),
        "w_ukv": w(ks[11], (L, MLA_KV_RANK, MLA_HEADS * (MLA_NOPE + MLA_VDIM)), MLA_KV_RANK),
        "q_norm": gain(ks[12], (L, MLA_QK)),
        "k_norm": gain(ks[13], (L, MLA_QK)),
        "w_oB": w(ks[14], (L, MLA_HEADS * MLA_VDIM, D_MODEL), MLA_HEADS * MLA_VDIM),
        "w_out": w(ks[15], (L, D_MODEL, D_MODEL), D_MODEL),
        "ln_moe": gain(ks[16], (L, D_MODEL)),
        "w_rg": w(ks[17], (L, D_MODEL, N_GROUPS), D_MODEL),
        "b_rg": 0.01 * jax.random.normal(ks[18], (L, N_GROUPS), f32),
        "w_re": w(ks[19], (L, D_MODEL, N_EXPERTS), D_MODEL),
        "b_re": 0.01 * jax.random.normal(ks[20], (L, N_EXPERTS), f32),
        "w1": w(ks[21], (L, N_EXPERTS, D_MODEL, D_EXPERT), D_MODEL),
        "w3": w(ks[22], (L, N_EXPERTS, D_MODEL, D_EXPERT), D_MODEL),
        "w2": w(ks[23], (L, N_EXPERTS, D_EXPERT, D_MODEL), D_EXPERT),
        "ln_ple": gain(ks[24], (L, D_MODEL)),
        "w_ple_gate": w(ks[25], (L, D_MODEL, D_MODEL), D_MODEL),
        "w_ple_proj": w(ks[26], (L, PLE_DIM, D_MODEL), PLE_DIM),
    }


def reference(x, p, positions, ln_mix, w_in, hg_lb, hg_onorm, w_oA,
              mla_qa_norm, mla_kva_norm, w_uq, w_ukv, q_norm, k_norm, w_oB,
              w_out, ln_moe, w_rg, b_rg, w_re, b_re, w1, w3, w2,
              ln_ple, w_ple_gate, w_ple_proj):
    B, S, D = x.shape
    f32 = jnp.float32
    split_points = [int(v) for v in np.cumsum(IN_WIDTHS)[:-1]]
    lb_all = jnp.cumsum(jax.nn.softmax(hg_lb.astype(f32), axis=1), axis=1)

    def heads(a, hd):
        return a.reshape(B, S, -1, hd).transpose(0, 2, 1, 3)

    for layer in range(DEPTH):
        h = rmsnorm(x, ln_mix[layer])
        z = h @ w_in[layer]
        q_a, f_fw, f_bw, i_a, og_a, c_q, c_kv, k_rope, gate_a, gate_b = jnp.split(z, split_points, axis=-1)

        qh = heads(jax.nn.silu(q_a.astype(f32)), HG_KDIM)
        vh = heads(i_a.astype(f32), HG_VDIM)

        def hgrn_direction(f_logit, lb, reverse):
            f = lb + (1.0 - lb) * jax.nn.sigmoid(f_logit.astype(f32))
            log_f = heads(jnp.log(f), HG_KDIM)
            kh = heads(1.0 - f, HG_KDIM)
            if reverse:
                o = gla_chunkwise(jnp.flip(qh, 2), jnp.flip(kh, 2), jnp.flip(vh, 2), jnp.flip(log_f, 2))
                return jnp.flip(o, 2)
            return gla_chunkwise(qh, kh, vh, log_f)

        o_hg = hgrn_direction(f_fw, lb_all[0, layer], False) + hgrn_direction(f_bw, lb_all[1, layer], True)
        o_hg = o_hg.transpose(0, 2, 1, 3)
        o_hg = rmsnorm(o_hg, hg_onorm[layer]) * jax.nn.silu(og_a.astype(f32).reshape(B, S, HG_HEADS, HG_VDIM))
        y_a = o_hg.reshape(B, S, HG_V).astype(x.dtype) @ w_oA[layer]

        cq = rmsnorm(c_q, mla_qa_norm[layer])
        qm = (cq @ w_uq[layer]).reshape(B, S, MLA_HEADS, MLA_QK)
        ckv = rmsnorm(c_kv, mla_kva_norm[layer])
        kv = (ckv @ w_ukv[layer]).reshape(B, S, MLA_HEADS, MLA_NOPE + MLA_VDIM)
        k_nope, vm = kv[..., :MLA_NOPE], kv[..., MLA_NOPE:]
        km = jnp.concatenate(
            [k_nope, jnp.broadcast_to(k_rope[:, :, None, :], (B, S, MLA_HEADS, MLA_ROPE))], axis=-1)
        qm = rmsnorm(qm, q_norm[layer])
        km = rmsnorm(km, k_norm[layer])
        qm = jnp.concatenate([qm[..., :MLA_NOPE], rope(qm[..., MLA_NOPE:], positions)], axis=-1)
        km = jnp.concatenate([km[..., :MLA_NOPE], rope(km[..., MLA_NOPE:], positions)], axis=-1)
        o_mla = block_dense_attention(qm.transpose(0, 2, 1, 3), km.transpose(0, 2, 1, 3), vm.transpose(0, 2, 1, 3))
        y_b = o_mla.transpose(0, 2, 1, 3).reshape(B, S, MLA_HEADS * MLA_VDIM) @ w_oB[layer]

        merged = jax.nn.sigmoid(gate_a) * y_a + jax.nn.sigmoid(gate_b) * y_b
        x = x + merged @ w_out[layer]

        hm = rmsnorm(x, ln_moe[layer]).reshape(B * S, D)
        x = x + hierarchical_moe(hm, w_rg[layer], b_rg[layer], w_re[layer], b_re[layer],
                                 w1[layer], w3[layer], w2[layer]).reshape(B, S, D)

        ple_gate = jax.nn.sigmoid(rmsnorm(x, ln_ple[layer]) @ w_ple_gate[layer])
        x = x + (p[layer] @ w_ple_proj[layer]) * ple_gate
    return x
```

```cpp
#include <hip/hip_runtime.h>
#include <cstdio>
#include <cstdint>

#define GAS __attribute__((address_space(1)))
#define LAS __attribute__((address_space(3)))
typedef unsigned short bf16;
typedef unsigned v4u __attribute__((ext_vector_type(4)));
typedef unsigned v2u __attribute__((ext_vector_type(2)));
typedef float f32x4 __attribute__((ext_vector_type(4)));
typedef float f32x2 __attribute__((ext_vector_type(2)));
typedef short bf16x8 __attribute__((ext_vector_type(8)));
typedef GAS unsigned gu32;
#define RLX_AGENT __ATOMIC_RELAXED, __HIP_MEMORY_SCOPE_AGENT
#define LDS_WAIT() asm volatile("s_waitcnt lgkmcnt(0)" ::: "memory")
#define VM_WAIT() asm volatile("s_waitcnt vmcnt(0)" ::: "memory")

constexpr int NB = 16, SEQ = 2048, T = NB * SEQ, D = 1024;
constexpr int HGH = 4, HGK = 128, HGV = 128, HGF = 512, CHUNK = 64, NCHUNK = T / CHUNK;
constexpr int MH = 8, NOPE = 64, ROPE = 32, QK = 96, VD = 64, QR = 256, KVR = 128;
constexpr int NG = 8, EPG = 8, NE = 64, DE = 256, PLE = 256;
constexpr int DIN = 5024, NIN = 5120;
constexpr float EPS = 1e-6f;
constexpr int NWAVES = 8, NTHR = 512;

__device__ __forceinline__ unsigned f2bf(float f) { unsigned u = __builtin_bit_cast(unsigned, f); return (u + 0x7fffu + ((u >> 16) & 1u)) >> 16; }
__device__ __forceinline__ unsigned pk2(float lo, float hi) { return f2bf(lo) | (f2bf(hi) << 16); }
__device__ __forceinline__ float bf2f(unsigned b) { return __builtin_bit_cast(float, b << 16); }
__device__ __forceinline__ float bflo(unsigned w) { return __builtin_bit_cast(float, w << 16); }
__device__ __forceinline__ float bfhi(unsigned w) { return __builtin_bit_cast(float, w & 0xffff0000u); }
__device__ __forceinline__ float sigm(float x) { return 1.0f / (1.0f + __expf(-x)); }
__device__ __forceinline__ float silu_(float x) { return x / (1.0f + __expf(-x)); }
__device__ __forceinline__ float wave_sum(float v) {
#pragma unroll
    for (int o = 1; o < 64; o <<= 1) v += __shfl_xor(v, o);
    return v;
}
__host__ __device__ __forceinline__ int perm8(int p) { const int r = p & 31, n = r >> 4, fq = (r >> 2) & 3, j = r & 3; return (p & ~31) + 8 * fq + 4 * n + j; }
__host__ __device__ __forceinline__ int iperm8(int l) { const int r = l & 31, fq = r >> 3, n = (r >> 2) & 1, j = r & 3; return (l & ~31) + 16 * n + 4 * fq + j; }

constexpr size_t MiB = 1u << 20;
constexpr size_t WS_CTL = 0, CTL_ZERO_BYTES = 1 * MiB;
constexpr size_t WS_LB = 1 * MiB;
constexpr size_t WS_WR = 1 * MiB + 65536;
constexpr size_t WS_BR = 1 * MiB + 65536 + 72 * 1024 * 4;
constexpr size_t WS_CQSS = 2 * MiB;
constexpr size_t WS_CKVSS = 2 * MiB + 512 * 1024;
constexpr size_t WS_ROPE = 4 * MiB;
constexpr size_t WS_EREF = 8 * MiB, WS_ELAST = 10 * MiB;
constexpr size_t WS_EIDX = 12 * MiB;
constexpr size_t WS_EW = 12 * MiB + 512 * 1024;
constexpr size_t WS_KR = 13 * MiB;
constexpr size_t WS_LIST = 4 * MiB;
constexpr size_t WS_WIN = 17 * MiB, WS_WOAB = 27 * MiB, WS_WUQ = 29 * MiB, WS_WUKV = 29 * MiB + 512 * 1024, WS_WOUT = 30 * MiB, WS_WPG = 32 * MiB, WS_WPP = 34 * MiB;
constexpr size_t WS_ACT = 36 * MiB;
constexpr size_t WS_VA = 100 * MiB, WS_OG = 132 * MiB, WS_CQ = 164 * MiB, WS_CKVR = 180 * MiB, WS_GA = 196 * MiB, WS_GB = 260 * MiB;
constexpr size_t WS_QM = 324 * MiB, WS_KH = 372 * MiB, WS_VH = 420 * MiB, WS_PB = 452 * MiB, WS_END = 468 * MiB;
constexpr size_t WS_W13 = 196 * MiB, WS_W2T = 260 * MiB;
constexpr size_t WS_H1 = 324 * MiB;
constexpr size_t WS_Y0 = 100 * MiB, WS_Y1 = 372 * MiB;
constexpr size_t WS_PROJ = 292 * MiB;
constexpr size_t DO_QF = 0, DO_KF = 32 * MiB, DO_QB = 64 * MiB, DO_KB = 96 * MiB, DO_OA = 0, DO_OM = 32 * MiB;
constexpr int CW_TMO = 0, CW_CODE = 1, CW_BAR = 4096, CW_CNT = 8192  ;
constexpr int MAXROWT = 320;
constexpr int RING_BYTES = 131072, LDSCTL_OFF = RING_BYTES, MISC_OFF = LDSCTL_OFF + 320, TAB_OFF = RING_BYTES + 1024, LDS_BYTES = 147456;
#define N_LAUNCHES 11
#define NAIVE_MOE 0
#define GEMM_PHASE(EPI, SCHED, g, S, E) gemm_ref<EPI, SCHED>(g, S, E)
#define HGRN_PHASE(F) hgrn_naive(F)
#define ATTN_PHASE(F) attn_naive(F)
#define ROUTE_PHASE(F) route_naive(F)
#define XB_TMO      128
#define XB_XCNT(j)  (256  + 64 * (j))
#define XB_XSUB(j)  (1280 + 64 * (j))
#define XB_XGEN(j)  (2304 + 64 * (j))
#define XB_TOP      3328
#define XB_TOPGEN   3392
#define XCD_BAR_WORDS 3456
#define XB_SPIN_CAP (1u << 18)

__device__ __forceinline__ unsigned xb_ld(unsigned* p)              { return __hip_atomic_load(p, __ATOMIC_RELAXED, __HIP_MEMORY_SCOPE_AGENT); }
__device__ __forceinline__ unsigned xb_add(unsigned* p, unsigned v) { return __hip_atomic_fetch_add(p, v, __ATOMIC_RELAXED, __HIP_MEMORY_SCOPE_AGENT); }
__device__ __forceinline__ unsigned xb_xcc_id() { return (unsigned)__builtin_amdgcn_s_getreg((3 << 11) | 20) & 0xFu; }
#define XB_SPIN(cond, bar) do { unsigned _sp = 0; while (cond) { __builtin_amdgcn_s_sleep(1); \
    if ((++_sp & 255u) == 0u) { if (xb_ld(&(bar)[XB_TMO])) break; if (_sp > XB_SPIN_CAP) { atomicAdd(&(bar)[XB_TMO], 1u); break; } } } } while (0)

struct XcdBarrier {
    unsigned* bar; unsigned x;
    volatile LAS unsigned* st;
};

__device__ __forceinline__ XcdBarrier xcd_barrier_post(unsigned* bar, volatile LAS unsigned* st) {
    XcdBarrier b; b.bar = bar; b.x = xb_xcc_id(); b.st = st;
    if (threadIdx.x == 0) (void)xb_add(&bar[XB_XCNT(b.x)], 1u);
    return b;
}
__device__ __forceinline__ void xcd_barrier_complete(unsigned* bar, unsigned x, unsigned& nloc, unsigned& nx) {
    const unsigned G = gridDim.x * gridDim.y * gridDim.z;
    unsigned sum, cnt, mine, sp = 0u;
    for (;;) {
        sum = 0u; cnt = 0u; mine = 0u;
#pragma unroll
        for (unsigned j = 0; j < 16; ++j) { const unsigned c = xb_ld(&bar[XB_XCNT(j)]); sum += c; cnt += (c > 0u) ? 1u : 0u; mine = (j == x) ? c : mine; }
        if (sum == G) break;
        __builtin_amdgcn_s_sleep(1);
        if ((++sp & 255u) == 0u) { if (xb_ld(&bar[XB_TMO])) break; if (sp > XB_SPIN_CAP) { atomicAdd(&bar[XB_TMO], 1u); break; } }
    }
    nloc = mine > 0u ? mine : 1u; nx = cnt > 0u ? cnt : 1u;
}

__device__ __forceinline__ void xcd_barrier(const XcdBarrier& b) {
    asm volatile("s_waitcnt vmcnt(0)" ::: "memory");
    __syncthreads();
    if (threadIdx.x == 0) {
        unsigned* bar = b.bar;
        __builtin_amdgcn_s_waitcnt(0);
        unsigned nloc = b.st[0], nx = b.st[1];
        if (nloc == 0u) { xcd_barrier_complete(bar, b.x, nloc, nx); b.st[0] = nloc; b.st[1] = nx; }
        const unsigned old = xb_add(&bar[XB_XSUB(b.x)], 1u);
        const unsigned gen = old / nloc;
        if (old + 1u == (gen + 1u) * nloc) {
            __builtin_amdgcn_fence(__ATOMIC_RELEASE, "agent");
            asm volatile("s_waitcnt vmcnt(0)" ::: "memory");
            const unsigned og = xb_add(&bar[XB_TOP], 1u);
            const unsigned tg = og / nx;
            if (og + 1u == (tg + 1u) * nx) xb_add(&bar[XB_TOPGEN], 1u);
            else XB_SPIN(xb_ld(&bar[XB_TOPGEN]) == tg, bar);
            __builtin_amdgcn_fence(__ATOMIC_ACQUIRE, "agent");
            xb_add(&bar[XB_XGEN(b.x)], 1u);
            asm volatile("s_waitcnt vmcnt(0)" ::: "memory");
        } else {
            XB_SPIN(xb_ld(&bar[XB_XGEN(b.x)]) == gen, bar);
            __builtin_amdgcn_fence(__ATOMIC_ACQUIRE, "agent");
            asm volatile("s_waitcnt vmcnt(0)" ::: "memory");
        }
    }
    __syncthreads();
}
struct Unit { int pm, pn, lbase, nvalid; };
struct Gemm { const bf16* A; const bf16* Bt; int K; const int* list; };
typedef __bf16 bf16x2_t __attribute__((ext_vector_type(2)));
__device__ __forceinline__ float dot2bf(unsigned a, unsigned b, float c) { return __builtin_amdgcn_fdot2_f32_bf16(__builtin_bit_cast(bf16x2_t, a), __builtin_bit_cast(bf16x2_t, b), c, false); }

constexpr int NXCD = 8, WGM = 8;
struct StaticOrder {
    int nM, nN, nwg, G, c;
    __device__ void init(int M, int N, int G_, int c_) { nM = M / 256; nN = N / 256; nwg = nM * nN; G = G_; c = c_; }
    __device__ __forceinline__ bool next(int i, Unit& u) const {
        const long L = (long)i * G + c; if (L >= nwg) return false;
        int wgid = (int)L; { const int q = nwg / NXCD, r = nwg % NXCD, xcd = wgid % NXCD, off = wgid / NXCD; wgid = (xcd < r ? xcd * (q + 1) : r * (q + 1) + (xcd - r) * q) + off; }
        const int nig = WGM * nN, gid = wgid / nig, fm = gid * WGM, gsz = (nM - fm) < WGM ? (nM - fm) : WGM;
        u.pm = fm + ((wgid % nig) % gsz); u.pn = (wgid % nig) / gsz; u.lbase = 0; u.nvalid = 256; return true;
    }
};
struct PairOrder {
    StaticOrder so;
    __device__ void init(int G_, int c_) { so.init(T, D, G_, c_); }
    __device__ __forceinline__ bool next(int i, Unit& u) const { if (!so.next(i >> 1, u)) return false; if (i & 1) { u.pm += T / 256; u.pn += D / 256; } return true; }
};
struct MoeOrder {
    const LAS int* tab; int npn, G, c;
    __device__ __forceinline__ bool next(int i, Unit& u) const {
        const int L = i * G + c; const int nt = tab[0]; if (L >= nt * npn) return false;
        const int rt = L / npn, pl = L - rt * npn; const int e = tab[16 + 4 * rt];
        u.pm = rt; u.pn = e * npn + pl; u.lbase = tab[16 + 4 * rt + 1]; u.nvalid = tab[16 + 4 * rt + 2]; return true;
    }
};

template <class Epi, class Sched>
__device__ __forceinline__ void gemm_ref(const Gemm g, const Sched& S, const Epi& E) {
    const int tid = threadIdx.x, wid = tid >> 6, lane = tid & 63, wr = wid >> 2, wc = wid & 3, fr = lane & 15, fq = lane >> 4;
    const int K = g.K; Unit u;
    for (int i = 0; S.next(i, u); ++i) {
        f32x4 acc[2][2][4][2];
#pragma unroll
        for (int a = 0; a < 2; ++a)
#pragma unroll
            for (int b = 0; b < 2; ++b)
#pragma unroll
                for (int m = 0; m < 4; ++m)
#pragma unroll
                    for (int n = 0; n < 2; ++n) acc[a][b][m][n] = (f32x4){0.f, 0.f, 0.f, 0.f};
        unsigned ar[2][4];
#pragma unroll
        for (int ai = 0; ai < 2; ++ai)
#pragma unroll
            for (int m = 0; m < 4; ++m) { const int r = ai * 128 + wr * 64 + m * 16 + fr;
                if (g.list) { const int rr = r < u.nvalid ? r : u.nvalid - 1; ar[ai][m] = (unsigned)(g.list[u.lbase + rr] >> 1) * (unsigned)K; }
                else ar[ai][m] = (unsigned)(u.pm * 256 + r) * (unsigned)K; }
        const unsigned bb = (unsigned)(u.pn * 256 + wc * 32 + 4 * fq) * (unsigned)K;
#pragma unroll 1
        for (int k0 = 0; k0 < K; k0 += 8) {
#pragma unroll
            for (int bj = 0; bj < 2; ++bj)
#pragma unroll
                for (int n = 0; n < 2; ++n) {
                    v4u bw[4];
#pragma unroll
                    for (int j = 0; j < 4; ++j) bw[j] = *(const v4u*)(g.Bt + (bb + (unsigned)(bj * 128 + n * 16 + j) * (unsigned)K + (unsigned)k0));
#pragma unroll
                    for (int ai = 0; ai < 2; ++ai)
#pragma unroll
                        for (int m = 0; m < 4; ++m) { const v4u aw = *(const v4u*)(g.A + (ar[ai][m] + (unsigned)k0));
#pragma unroll
                            for (int j = 0; j < 4; ++j) { float c = acc[ai][bj][m][n][j];
                                c = dot2bf(aw.x, bw[j].x, c); c = dot2bf(aw.y, bw[j].y, c); c = dot2bf(aw.z, bw[j].z, c); c = dot2bf(aw.w, bw[j].w, c);
                                acc[ai][bj][m][n][j] = c; }
                            asm volatile("" ::: "memory"); }
                }
        }
        E(acc, u, wr, wc, fr, fq);
    }
}
__device__ __forceinline__ void st8(bf16* p, f32x4 a, f32x4 b) { v4u w; w.x = pk2(a[0], a[1]); w.y = pk2(a[2], a[3]); w.z = pk2(b[0], b[1]); w.w = pk2(b[2], b[3]); *(v4u*)p = w; }
__device__ __forceinline__ void st4(bf16* p, f32x4 a) { v2u w; w.x = pk2(a[0], a[1]); w.y = pk2(a[2], a[3]); *(v2u*)p = w; }
__device__ __forceinline__ f32x4 up4(unsigned lo, unsigned hi) { return (f32x4){bflo(lo), bfhi(lo), bflo(hi), bfhi(hi)}; }
__device__ __forceinline__ float dot4(f32x4 a) { return (a[0] * a[0] + a[1] * a[1]) + (a[2] * a[2] + a[3] * a[3]); }
__device__ __forceinline__ float scan16(float v, int fr) {
    float t;
    t = __shfl_up(v, 1, 16); if (fr >= 1) v += t;
    t = __shfl_up(v, 2, 16); if (fr >= 2) v += t;
    t = __shfl_up(v, 4, 16); if (fr >= 4) v += t;
    t = __shfl_up(v, 8, 16); if (fr >= 8) v += t;
    return v;
}

struct EpiIn {
    unsigned char *wsb, *dob;
#define EI_W(type, off) ((type*)(wsb + (off)))
#define EI_D(type, off) ((type*)(dob + (off)))
    __device__ __forceinline__ void hgrn(const f32x4 (&acc)[2][2][4][2], const Unit& u, int wr, int wc, int fr, int fq) const {
        const int hh = u.pn >> 1, cb = u.pn & 1;
        const int gch0 = hh * 128 + cb * 64 + wc * 16 + fq * 4;
        bf16* const QF = EI_D(bf16, DO_QF); bf16* const KF = EI_D(bf16, DO_KF); bf16* const QB = EI_D(bf16, DO_QB); bf16* const KB = EI_D(bf16, DO_KB); bf16* const VA = EI_W(bf16, WS_VA);
        float* const EREF = EI_W(float, WS_EREF); float* const ELAST = EI_W(float, WS_ELAST); const float* const LB = EI_W(float, WS_LB);
        const f32x4 lbf = *(const f32x4*)(LB + gch0), lbb = *(const f32x4*)(LB + 512 + gch0);
#pragma unroll
        for (int ai = 0; ai < 2; ++ai) {
            const int cidx = u.pm * 4 + ai * 2 + wr;
            const size_t off0 = (size_t)(u.pm * 256 + ai * 128 + wr * 64 + fr) * 512 + gch0;
#pragma unroll
            for (int m = 0; m < 4; ++m) st4(VA + off0 + (size_t)m * 16 * 512, acc[ai][1][m][1]);
#pragma unroll
            for (int jp = 0; jp < 2; ++jp) {
                f32x2 qo[4], ko[4];
#pragma unroll
                for (int jj = 0; jj < 2; ++jj) { const int j = 2 * jp + jj;
                    float lf[4], kk[4];
#pragma unroll
                    for (int m = 0; m < 4; ++m) { const float z = fminf(fmaxf(acc[ai][0][m][1][j], -30.f), 30.f), e = __expf(-z), s = 1.0f / (1.0f + e); kk[m] = (1.0f - lbf[j]) * e * s; lf[m] = __logf(lbf[j] + (1.0f - lbf[j]) * s); }
                    float G[4], carry = 0.f;
#pragma unroll
                    for (int m = 0; m < 4; ++m) { G[m] = scan16(lf[m], fr) + carry; carry = __shfl(G[m], 15, 16); }
                    const float Gref = __shfl(G[1], 15, 16);
#pragma unroll
                    for (int m = 0; m < 4; ++m) { qo[m][jj] = silu_(acc[ai][0][m][0][j]) * __expf(G[m] - Gref); ko[m][jj] = kk[m] * __expf(fminf(Gref - G[m], 80.f)); }
                    if (fr == 0) { EREF[(size_t)cidx * 512 + gch0 + j] = __expf(Gref); ELAST[(size_t)cidx * 512 + gch0 + j] = __expf(carry - Gref); }
                }
#pragma unroll
                for (int m = 0; m < 4; ++m) { *(unsigned*)(QF + off0 + (size_t)m * 16 * 512 + 2 * jp) = pk2(qo[m][0], qo[m][1]); *(unsigned*)(KF + off0 + (size_t)m * 16 * 512 + 2 * jp) = pk2(ko[m][0], ko[m][1]); }
                asm volatile("" ::: "memory");
#pragma unroll
                for (int jj = 0; jj < 2; ++jj) { const int j = 2 * jp + jj;
                    float lw[4], kk[4];
#pragma unroll
                    for (int m = 0; m < 4; ++m) { const float z = fminf(fmaxf(acc[ai][1][m][0][j], -30.f), 30.f), e = __expf(-z), s = 1.0f / (1.0f + e); kk[m] = (1.0f - lbb[j]) * e * s; lw[m] = __logf(lbb[j] + (1.0f - lbb[j]) * s); }
                    float P[4], carry = 0.f;
#pragma unroll
                    for (int m = 0; m < 4; ++m) { P[m] = scan16(lw[m], fr) + carry; carry = __shfl(P[m], 15, 16); }
                    float Gb[4];
#pragma unroll
                    for (int m = 0; m < 4; ++m) Gb[m] = carry - (P[m] - lw[m]);
                    const float Gbref = __shfl(Gb[2], 0, 16);
#pragma unroll
                    for (int m = 0; m < 4; ++m) { qo[m][jj] = silu_(acc[ai][0][m][0][j]) * __expf(Gb[m] - Gbref); ko[m][jj] = kk[m] * __expf(fminf(Gbref - Gb[m], 80.f)); }
                    if (fr == 0) { EREF[(size_t)(NCHUNK + cidx) * 512 + gch0 + j] = __expf(Gbref); ELAST[(size_t)(NCHUNK + cidx) * 512 + gch0 + j] = __expf(carry - Gbref); }
                }
#pragma unroll
                for (int m = 0; m < 4; ++m) { *(unsigned*)(QB + off0 + (size_t)m * 16 * 512 + 2 * jp) = pk2(qo[m][0], qo[m][1]); *(unsigned*)(KB + off0 + (size_t)m * 16 * 512 + 2 * jp) = pk2(ko[m][0], ko[m][1]); }
                asm volatile("" ::: "memory");
            }
        }
    }
    __device__ __forceinline__ void operator()(const f32x4 (&acc)[2][2][4][2], const Unit& u, int wr, int wc, int fr, int fq) const {
        const int pn = u.pn, row0 = u.pm * 256 + wr * 64 + fr;
        if (pn < 8) { hgrn(acc, u, wr, wc, fr, fq); return; }
        bf16* const OG = EI_W(bf16, WS_OG); bf16* const CQ = EI_W(bf16, WS_CQ); bf16* const CKVR = EI_W(bf16, WS_CKVR); bf16* const GA = EI_W(bf16, WS_GA); bf16* const GB = EI_W(bf16, WS_GB);
        float* const CQSS = EI_W(float, WS_CQSS); float* const CKVSS = EI_W(float, WS_CKVSS); float* const KR = EI_W(float, WS_KR);
        if (pn == 10) {
#pragma unroll
            for (int ai = 0; ai < 2; ++ai)
#pragma unroll
                for (int m = 0; m < 4; ++m) { const int row = row0 + ai * 128 + m * 16; float ss = 0.f;
#pragma unroll
                    for (int bj = 0; bj < 2; ++bj) { const f32x4 a = acc[ai][bj][m][0], b = acc[ai][bj][m][1]; ss += dot4(a) + dot4(b); st8(CQ + (size_t)row * 256 + bj * 128 + wc * 32 + 8 * fq, a, b); }
                    ss += __shfl_xor(ss, 16); ss += __shfl_xor(ss, 32); if (fq == 0) CQSS[(size_t)row * 4 + wc] = ss; }
            return;
        }
        if (pn == 11) {
#pragma unroll
            for (int ai = 0; ai < 2; ++ai)
#pragma unroll
                for (int m = 0; m < 4; ++m) { const int row = row0 + ai * 128 + m * 16;
                    const f32x4 a0 = acc[ai][0][m][0], b0 = acc[ai][0][m][1], a1 = acc[ai][1][m][0], b1 = acc[ai][1][m][1];
                    float ss = dot4(a0) + dot4(b0); ss += __shfl_xor(ss, 16); ss += __shfl_xor(ss, 32); if (fq == 0) CKVSS[(size_t)row * 4 + wc] = ss;
                    st8(CKVR + (size_t)row * 256 + wc * 32 + 8 * fq, a0, b0); st8(CKVR + (size_t)row * 256 + 128 + wc * 32 + 8 * fq, a1, b1);
                    if (wc == 0) { *(f32x4*)(KR + (size_t)row * 32 + 8 * fq) = a1; *(f32x4*)(KR + (size_t)row * 32 + 8 * fq + 4) = b1; } }
            return;
        }
        const bool sil = pn < 10; const int ld = sil ? 512 : 1024, cb = (sil ? pn - 8 : (pn - 12) & 3) * 256;
        const size_t dsto = sil ? (size_t)0 : (pn < 16 ? (size_t)((unsigned char*)GA - (unsigned char*)OG) : (size_t)((unsigned char*)GB - (unsigned char*)OG));
        bf16* dst = (bf16*)((unsigned char*)OG + dsto);
#pragma unroll
        for (int ai = 0; ai < 2; ++ai)
#pragma unroll
            for (int m = 0; m < 4; ++m)
#pragma unroll
                for (int bj = 0; bj < 2; ++bj) { f32x4 a = acc[ai][bj][m][0], b = acc[ai][bj][m][1];
#pragma unroll
                    for (int j = 0; j < 4; ++j) { a[j] = sil ? silu_(a[j]) : sigm(a[j]); b[j] = sil ? silu_(b[j]) : sigm(b[j]); }
                    st8(dst + (size_t)(row0 + ai * 128 + m * 16) * ld + cb + bj * 128 + wc * 32 + 8 * fq, a, b); }
    }
};

struct EpiQ {
    bf16* QM; const float* CQSS;
    __device__ __forceinline__ void operator()(const f32x4 (&acc)[2][2][4][2], const Unit& u, int wr, int wc, int fr, int fq) const {
#pragma unroll
        for (int ai = 0; ai < 2; ++ai)
#pragma unroll
            for (int m = 0; m < 4; ++m) { const int row = u.pm * 256 + ai * 128 + wr * 64 + m * 16 + fr;
                const f32x4 s4 = *(const f32x4*)(CQSS + (size_t)row * 4); const float rs = rsqrtf(((s4[0] + s4[1]) + (s4[2] + s4[3])) * (1.0f / 256.0f) + EPS);
#pragma unroll
                for (int bj = 0; bj < 2; ++bj) st8(QM + (size_t)row * 768 + u.pn * 256 + bj * 128 + wc * 32 + 8 * fq, acc[ai][bj][m][0] * rs, acc[ai][bj][m][1] * rs);
                asm volatile("" ::: "memory"); }
    }
};
struct EpiKV {
    bf16 *KH, *VH; const float *CKVSS, *KR, *ROPE_, *KN;
    __device__ __forceinline__ void operator()(const f32x4 (&acc)[2][2][4][2], const Unit& u, int wr, int wc, int fr, int fq) const {
        const int pn = u.pn, head = (pn & 1) * 4 + wc;
#pragma unroll
        for (int ai = 0; ai < 2; ++ai)
#pragma unroll
            for (int m = 0; m < 4; ++m) { const int row = u.pm * 256 + ai * 128 + wr * 64 + m * 16 + fr;
                const f32x4 s4 = *(const f32x4*)(CKVSS + (size_t)row * 4); const float rs = rsqrtf(((s4[0] + s4[1]) + (s4[2] + s4[3])) * (1.0f / 128.0f) + EPS);
                if (pn >= 2) {
#pragma unroll
                    for (int bj = 0; bj < 2; ++bj) st8(VH + ((size_t)row * 8 + head) * 64 + bj * 32 + 8 * fq, acc[ai][bj][m][0] * rs, acc[ai][bj][m][1] * rs);
                } else {
                    f32x4 v[2][2]; float ss = 0.f;
#pragma unroll
                    for (int bj = 0; bj < 2; ++bj)
#pragma unroll
                        for (int n = 0; n < 2; ++n) { v[bj][n] = acc[ai][bj][m][n] * rs; ss += dot4(v[bj][n]); }
                    const f32x4 x1 = *(const f32x4*)(KR + (size_t)row * 32 + 4 * fq), x2 = *(const f32x4*)(KR + (size_t)row * 32 + 16 + 4 * fq);
                    ss += dot4(x1) + dot4(x2);
                    ss += __shfl_xor(ss, 16); ss += __shfl_xor(ss, 32);
                    const float rk = rsqrtf(ss * (1.0f / 96.0f) + EPS);
                    bf16* kp = KH + ((size_t)row * 8 + head) * 96;
#pragma unroll
                    for (int bj = 0; bj < 2; ++bj) { const f32x4 g0 = *(const f32x4*)(KN + bj * 32 + 8 * fq), g1 = *(const f32x4*)(KN + bj * 32 + 8 * fq + 4);
                        st8(kp + bj * 32 + 8 * fq, v[bj][0] * rk * g0, v[bj][1] * rk * g1); }
                    const f32x4 c = *(const f32x4*)(ROPE_ + (size_t)row * 32 + 4 * fq), s = *(const f32x4*)(ROPE_ + (size_t)row * 32 + 16 + 4 * fq);
                    const f32x4 gA = *(const f32x4*)(KN + 64 + 4 * fq), gB = *(const f32x4*)(KN + 80 + 4 * fq);
                    const f32x4 y1 = x1 * rk * gA, y2 = x2 * rk * gB;
                    st4(kp + 64 + 4 * fq, y1 * c - y2 * s); st4(kp + 80 + 4 * fq, y2 * c + y1 * s);
                }
                asm volatile("" ::: "memory"); }
    }
};
struct EpiMerge {
    bf16* MG; const bf16 *GA, *GB;
    __device__ __forceinline__ void operator()(const f32x4 (&acc)[2][2][4][2], const Unit& u, int wr, int wc, int fr, int fq) const {
        const bool which = u.pm >= T / 256; const int pm = u.pm - (which ? T / 256 : 0), pn = u.pn - (which ? D / 256 : 0); const bf16* Gt = (const bf16*)((const unsigned char*)GA + (which ? (size_t)((const unsigned char*)GB - (const unsigned char*)GA) : (size_t)0));
#pragma unroll
        for (int ai = 0; ai < 2; ++ai)
#pragma unroll
            for (int m = 0; m < 4; ++m)
#pragma unroll
                for (int bj = 0; bj < 2; ++bj) { const size_t off = (size_t)(pm * 256 + ai * 128 + wr * 64 + m * 16 + fr) * 1024 + pn * 256 + bj * 128 + wc * 32 + 8 * fq;
                    const v4u g = *(const v4u*)(Gt + off); f32x4 a = acc[ai][bj][m][0] * up4(g.x, g.y), b = acc[ai][bj][m][1] * up4(g.z, g.w);
                    if (which) { const v4u o = *(const v4u*)(MG + off); a += up4(o.x, o.y); b += up4(o.z, o.w); }
                    st8(MG + off, a, b); if (bj == 1) asm volatile("" ::: "memory"); }
    }
};
struct EpiX2 {
    const float* X; float* O;
    __device__ __forceinline__ void operator()(const f32x4 (&acc)[2][2][4][2], const Unit& u, int wr, int wc, int fr, int fq) const {
#pragma unroll
        for (int ai = 0; ai < 2; ++ai)
#pragma unroll
            for (int m = 0; m < 4; ++m)
#pragma unroll
                for (int bj = 0; bj < 2; ++bj)
#pragma unroll
                    for (int n = 0; n < 2; ++n) { const size_t off = (size_t)(u.pm * 256 + ai * 128 + wr * 64 + m * 16 + fr) * 1024 + u.pn * 256 + bj * 128 + wc * 32 + n * 16 + 4 * fq;
                        *(f32x4*)(O + off) = *(const f32x4*)(X + off) + acc[ai][bj][m][n]; if (n == 1 && bj == 1) asm volatile("" ::: "memory"); }
    }
};
struct EpiUp {
    bf16* H1;
    __device__ __forceinline__ void operator()(const f32x4 (&acc)[2][2][4][2], const Unit& u, int wr, int wc, int fr, int fq) const {
        const int pl = u.pn & 1;
#pragma unroll
        for (int ai = 0; ai < 2; ++ai)
#pragma unroll
            for (int m = 0; m < 4; ++m) { f32x4 a = acc[ai][0][m][0], b = acc[ai][0][m][1];
#pragma unroll
                for (int j = 0; j < 4; ++j) { a[j] = silu_(a[j]) * acc[ai][1][m][0][j]; b[j] = silu_(b[j]) * acc[ai][1][m][1][j]; }
                st8(H1 + (size_t)(u.pm * 256 + ai * 128 + wr * 64 + m * 16 + fr) * 256 + pl * 128 + wc * 32 + 8 * fq, a, b); }
    }
};
struct EpiDown {
    bf16 *Y0, *Y1; const int* LIST; const float* EW;
    __device__ __forceinline__ void operator()(const f32x4 (&acc)[2][2][4][2], const Unit& u, int wr, int wc, int fr, int fq) const {
        const int pl = u.pn & 3;
#pragma unroll
        for (int ai = 0; ai < 2; ++ai)
#pragma unroll
            for (int m = 0; m < 4; ++m) { const int r = ai * 128 + wr * 64 + m * 16 + fr;
                if (r < u.nvalid) { const int ent = LIST[u.lbase + r]; const float w = EW[ent]; const size_t so = (ent & 1) ? (size_t)((unsigned char*)Y1 - (unsigned char*)Y0) : (size_t)0;
                    bf16* dst = (bf16*)((unsigned char*)Y0 + so) + (size_t)(ent >> 1) * 1024 + pl * 256 + wc * 32 + 8 * fq;
#pragma unroll
                    for (int bj = 0; bj < 2; ++bj) st8(dst + bj * 128, acc[ai][bj][m][0] * w, acc[ai][bj][m][1] * w); }
                asm volatile("" ::: "memory"); }
    }
};
struct EpiProj {
    bf16* PR;
    __device__ __forceinline__ void operator()(const f32x4 (&acc)[2][2][4][2], const Unit& u, int wr, int wc, int fr, int fq) const {
#pragma unroll
        for (int ai = 0; ai < 2; ++ai)
#pragma unroll
            for (int m = 0; m < 4; ++m)
#pragma unroll
                for (int bj = 0; bj < 2; ++bj) st8(PR + (size_t)(u.pm * 256 + ai * 128 + wr * 64 + m * 16 + fr) * 1024 + u.pn * 256 + bj * 128 + wc * 32 + 8 * fq, acc[ai][bj][m][0], acc[ai][bj][m][1]);
    }
};
struct EpiFinal {
    float* O; const bf16* PR;
    __device__ __forceinline__ void operator()(const f32x4 (&acc)[2][2][4][2], const Unit& u, int wr, int wc, int fr, int fq) const {
#pragma unroll
        for (int ai = 0; ai < 2; ++ai)
#pragma unroll
            for (int m = 0; m < 4; ++m)
#pragma unroll
                for (int bj = 0; bj < 2; ++bj)
#pragma unroll
                    for (int n = 0; n < 2; ++n) { const size_t off = (size_t)(u.pm * 256 + ai * 128 + wr * 64 + m * 16 + fr) * 1024 + u.pn * 256 + bj * 128 + wc * 32 + n * 16 + 4 * fq;
                        const v2u pr = *(const v2u*)(PR + off); f32x4 g = acc[ai][bj][m][n];
#pragma unroll
                        for (int j = 0; j < 4; ++j) g[j] = sigm(g[j]);
                        *(f32x4*)(O + off) = *(const f32x4*)(O + off) + up4(pr.x, pr.y) * g; if (n == 1 && bj == 1) asm volatile("" ::: "memory"); }
    }
};
struct Frame {
    LAS unsigned char* lds; unsigned char* gl;
    volatile LAS unsigned* MISC; gu32* ctl;
    int tid, lane, wave, vcu, G;
    const float* in[27]; float* out; unsigned char* ws;
};
#define WSP(type, off) ((type*)(F.ws + (off)))
#define DOP(type, off) ((type*)((unsigned char*)F.out + (off)))
enum { I_X = 0, I_P, I_POS, I_LNMIX, I_WIN, I_HGLB, I_HGON, I_WOA, I_QAN, I_KVAN, I_WUQ, I_WUKV, I_QN, I_KN, I_WOB, I_WOUT, I_LNMOE, I_WRG, I_BRG, I_WRE, I_BRE, I_W1, I_W3, I_W2, I_LNPLE, I_WPG, I_WPP };

enum { M_WIN = 0, M_WOAB, M_WUQ, M_WUKV, M_WOUT, M_WPG, M_WPP, M_W13, M_W2T };
template <int MAT> struct MatInfo;
template <> struct MatInfo<M_WIN>  { static constexpr int K = 1024, NP = NIN; };
template <> struct MatInfo<M_WOAB> { static constexpr int K = 512,  NP = 2048; };
template <> struct MatInfo<M_WUQ>  { static constexpr int K = 256,  NP = 768; };
template <> struct MatInfo<M_WUKV> { static constexpr int K = 256,  NP = 1024; };
template <> struct MatInfo<M_WOUT> { static constexpr int K = 1024, NP = 1024; };
template <> struct MatInfo<M_WPG>  { static constexpr int K = 1024, NP = 1024; };
template <> struct MatInfo<M_WPP>  { static constexpr int K = 256,  NP = 1024; };
template <> struct MatInfo<M_W13>  { static constexpr int K = 1024, NP = NE * 512; };
template <> struct MatInfo<M_W2T>  { static constexpr int K = 256,  NP = NE * 1024; };
template <int MAT> __device__ __forceinline__ void conv_item(const Frame& F, int item, int lane) {
    constexpr int K = MatInfo<MAT>::K; constexpr int KB = K / 64;
    const int kb = item % KB, p = (item / KB) * 64 + lane;
    const float* src = nullptr; size_t ld = 0; const float* gain = nullptr; int kvalid = K; bf16* dst = nullptr;
    if constexpr (MAT == M_WIN) {
        const int pn = p >> 8; int col;
        if (pn < 8) { const int q = p & 255, bj = q >> 7, wc = (q >> 5) & 3, n = (q >> 4) & 1, fq = (q >> 2) & 3, j = q & 3; const int kind = 2 * bj + n;
            col = kind * 512 + (pn >> 1) * 128 + (pn & 1) * 64 + wc * 16 + fq * 4 + j; }
        else if (pn < 10) col = 2048 + perm8(p - 2048);
        else if (pn == 10) col = 2560 + perm8(p - 2560);
        else if (pn == 11) { const int l = perm8(p - 2816); col = l < 128 ? 2816 + l : (l < 160 ? 2944 + (l - 128) : -1); }
        else if (pn < 16) col = 2976 + perm8(p - 3072);
        else col = 4000 + perm8(p - 4096);
        if (col >= 0) src = F.in[I_WIN] + col; ld = DIN; gain = F.in[I_LNMIX]; dst = WSP(bf16, WS_WIN);
    } else if constexpr (MAT == M_WOAB) { { const float* sa = F.in[I_WOA]; const float* sb = F.in[I_WOB]; src = (const float*)((const unsigned char*)sa + ((p >> 10) ? (size_t)((const unsigned char*)sb - (const unsigned char*)sa) : (size_t)0)) + perm8(p & 1023); } ld = 1024; dst = WSP(bf16, WS_WOAB); }
    else if constexpr (MAT == M_WUQ) { src = F.in[I_WUQ] + perm8(p); ld = 768; gain = F.in[I_QAN]; dst = WSP(bf16, WS_WUQ); }
    else if constexpr (MAT == M_WUKV) { const int pn = p >> 8, q = p & 255, bj = q >> 7, wc = (q >> 5) & 3, n = (q >> 4) & 1, fq = (q >> 2) & 3, j = q & 3;
        const int head = (pn & 1) * 4 + wc, d = 32 * bj + 8 * fq + 4 * n + j; src = F.in[I_WUKV] + head * 128 + (pn >= 2 ? 64 : 0) + d; ld = 1024; gain = F.in[I_KVAN]; kvalid = 128; dst = WSP(bf16, WS_WUKV); }
    else if constexpr (MAT == M_WOUT) { src = F.in[I_WOUT] + p; ld = 1024; dst = WSP(bf16, WS_WOUT); }
    else if constexpr (MAT == M_WPG) { src = F.in[I_WPG] + p; ld = 1024; gain = F.in[I_LNPLE]; dst = WSP(bf16, WS_WPG); }
    else if constexpr (MAT == M_WPP) { src = F.in[I_WPP] + perm8(p); ld = 1024; dst = WSP(bf16, WS_WPP); }
    else if constexpr (MAT == M_W13) { const int e = p >> 9, q = p & 511, pl = q >> 8, bj = (q >> 7) & 1, r = q & 127;
        { const float* sa = F.in[I_W1]; const float* sb = F.in[I_W3]; src = (const float*)((const unsigned char*)sa + (bj ? (size_t)((const unsigned char*)sb - (const unsigned char*)sa) : (size_t)0)) + (size_t)e * 1024 * 256 + pl * 128 + perm8(r); } ld = 256; gain = F.in[I_LNMOE]; dst = WSP(bf16, WS_W13); }
    else { const int e = p >> 10, q = p & 1023; src = F.in[I_W2] + (size_t)e * 256 * 1024 + perm8(q); ld = 1024; dst = WSP(bf16, WS_W2T); }
#pragma unroll
    for (int k8 = 0; k8 < 8; ++k8) { const int k = kb * 64 + k8 * 8; float v[8];
#pragma unroll
        for (int i = 0; i < 8; ++i) v[i] = (src && (k + i) < kvalid) ? src[(size_t)(k + i) * ld] * (gain ? gain[k + i] : 1.0f) : 0.0f;
        v4u o; o.x = pk2(v[0], v[1]); o.y = pk2(v[2], v[3]); o.z = pk2(v[4], v[5]); o.w = pk2(v[6], v[7]);
        *(v4u*)(dst + (size_t)p * K + k) = o; }
}
template <int MAT> __device__ __forceinline__ void conv_mat(const Frame& F) {
    constexpr int NITEMS = (MatInfo<MAT>::NP / 64) * (MatInfo<MAT>::K / 64);
    const int gw = F.vcu * NWAVES + F.wave, NGW = F.G * NWAVES;
    for (int it = gw; it < NITEMS; it += NGW) conv_item<MAT>(F, it, F.lane);
}

__device__ __forceinline__ void p0_prologue(const Frame& F) {
    conv_mat<M_WIN>(F); conv_mat<M_WOAB>(F); conv_mat<M_WUQ>(F); conv_mat<M_WUKV>(F); conv_mat<M_WOUT>(F); conv_mat<M_WPG>(F); conv_mat<M_WPP>(F);
    const int gt = F.vcu * NTHR + F.tid, NGT = F.G * NTHR;
    for (int i = gt; i < 72 * 1024; i += NGT) { const int o = i >> 10, k = i & 1023; WSP(float, WS_WR)[i] = F.in[I_LNMOE][k] * (o < 8 ? F.in[I_WRG][k * 8 + o] : F.in[I_WRE][k * 64 + (o - 8)]); }
    for (int i = gt; i < 72; i += NGT) WSP(float, WS_BR)[i] = i < 8 ? F.in[I_BRG][i] : F.in[I_BRE][i - 8];
    for (int i = gt; i < 1024; i += NGT) { const int d = i >> 9, f = i & 511; const float a0 = F.in[I_HGLB][d * 1024 + f], a1 = F.in[I_HGLB][d * 1024 + 512 + f]; WSP(float, WS_LB)[i] = 1.0f / (1.0f + expf(a1 - a0)); }
    for (int i = gt; i < T * 16; i += NGT) { const int t = i >> 4, f = i & 15; const float pos = (float)((const int*)F.in[I_POS])[t]; const float inv = powf(10000.0f, -(float)f / 16.0f);
        const float ang = pos * inv; WSP(float, WS_ROPE)[t * 32 + f] = cosf(ang); WSP(float, WS_ROPE)[t * 32 + 16 + f] = sinf(ang); }
    const int gw = F.vcu * NWAVES + F.wave, NGW = F.G * NWAVES;
    for (int m = gw; m < T; m += NGW) {
        const float* xr = F.in[I_X] + (size_t)m * D + F.lane * 8; f32x4 v[4]; float ss = 0.f;
#pragma unroll
        for (int j = 0; j < 2; ++j) { v[2 * j] = *(const f32x4*)(xr + 512 * j); v[2 * j + 1] = *(const f32x4*)(xr + 512 * j + 4); ss += dot4(v[2 * j]) + dot4(v[2 * j + 1]); }
        const float rs = rsqrtf(wave_sum(ss) * (1.0f / D) + EPS);
#pragma unroll
        for (int j = 0; j < 2; ++j) st8(WSP(bf16, WS_ACT) + (size_t)m * D + F.lane * 8 + 512 * j, v[2 * j] * rs, v[2 * j + 1] * rs);
        if (F.lane < 32) { const float* pr = F.in[I_P] + (size_t)m * PLE + F.lane * 8; st8(WSP(bf16, WS_PB) + (size_t)m * PLE + F.lane * 8, *(const f32x4*)pr, *(const f32x4*)(pr + 4)); }
    }
}

__device__ __forceinline__ void oa_pass(const Frame& F) {
    const int gw = F.vcu * NWAVES + F.wave, NGW = F.G * NWAVES;
    const bf16* OFp = WSP(bf16, WS_ACT); const bf16* OBp = OFp + (size_t)T * 512; const bf16* OGp = WSP(bf16, WS_OG); bf16* OA = DOP(bf16, DO_OA);
    const int c0 = F.lane * 8; const f32x4 g0 = *(const f32x4*)(F.in[I_HGON] + (c0 & 127)), g1 = *(const f32x4*)(F.in[I_HGON] + (c0 & 127) + 4);
    for (int m = gw; m < T; m += NGW) {
        const size_t off = (size_t)m * 512 + c0;
        const v4u a = *(const v4u*)(OFp + off), b = *(const v4u*)(OBp + off), g = *(const v4u*)(OGp + off);
        f32x4 s0 = up4(a.x, a.y) + up4(b.x, b.y), s1 = up4(a.z, a.w) + up4(b.z, b.w);
        float ss = dot4(s0) + dot4(s1); ss += __shfl_xor(ss, 1); ss += __shfl_xor(ss, 2); ss += __shfl_xor(ss, 4); ss += __shfl_xor(ss, 8);
        const float rs = rsqrtf(ss * (1.0f / 128.0f) + EPS);
        st8(OA + off, s0 * rs * g0 * up4(g.x, g.y), s1 * rs * g1 * up4(g.z, g.w));
    }
}
__device__ __forceinline__ void x3_pass(const Frame& F) {
    const int gw = F.vcu * NWAVES + F.wave, NGW = F.G * NWAVES;
    const bf16* Y0 = WSP(bf16, WS_Y0); const bf16* Y1 = WSP(bf16, WS_Y1); bf16* HP = WSP(bf16, WS_ACT);
    for (int m = gw; m < T; m += NGW) {
        float* xr = F.out + (size_t)m * D + F.lane * 8; f32x4 v[4]; float ss = 0.f;
#pragma unroll
        for (int j = 0; j < 2; ++j) { const size_t o = (size_t)m * D + F.lane * 8 + 512 * j; const v4u a = *(const v4u*)(Y0 + o), b = *(const v4u*)(Y1 + o);
            v[2 * j] = *(const f32x4*)(xr + 512 * j) + up4(a.x, a.y) + up4(b.x, b.y); v[2 * j + 1] = *(const f32x4*)(xr + 512 * j + 4) + up4(a.z, a.w) + up4(b.z, b.w);
            *(f32x4*)(xr + 512 * j) = v[2 * j]; *(f32x4*)(xr + 512 * j + 4) = v[2 * j + 1]; ss += dot4(v[2 * j]) + dot4(v[2 * j + 1]); }
        const float rs = rsqrtf(wave_sum(ss) * (1.0f / D) + EPS);
#pragma unroll
        for (int j = 0; j < 2; ++j) st8(HP + (size_t)m * D + F.lane * 8 + 512 * j, v[2 * j] * rs, v[2 * j + 1] * rs);
    }
}
__device__ __forceinline__ void moe_build_table(const Frame& F) {
    LAS int* tab = (LAS int*)(F.lds + TAB_OFF);
    if (F.tid == 0) { int rt = 0;
        for (int e = 0; e < NE; ++e) { const int cnt = (int)__hip_atomic_load(F.ctl + CW_CNT + 64 * e, RLX_AGENT); const int nt = (cnt + 255) >> 8;
            for (int lt = 0; lt < nt; ++lt) { tab[16 + 4 * rt] = e; tab[16 + 4 * rt + 1] = e * T + 256 * lt; const int rem = cnt - 256 * lt; tab[16 + 4 * rt + 2] = rem < 256 ? rem : 256; ++rt; } }
        tab[0] = rt; }
    __syncthreads();
}
__device__ __forceinline__ void hgrn_naive(const Frame& F) {
    float* Qs = (float*)F.gl; float* Ks = Qs + 64 * 128; float* Vs = Ks + 64 * 128; float* Ps = Vs + 64 * 64; float* Os = Ps + 64 * 64;
    const int v = F.tid & 63, kq = F.tid >> 6;
    for (int item = blockIdx.x; item < NB * HGH * 2 * 2; item += F.G) {
        const int vh = item & 1, dir = (item >> 1) & 1, hh = (item >> 2) & 3, b = item >> 4;
        const bf16* Qd = DOP(bf16, dir ? DO_QB : DO_QF); const bf16* Kd = DOP(bf16, dir ? DO_KB : DO_KF); const bf16* Va = WSP(bf16, WS_VA);
        bf16* Od = WSP(bf16, WS_ACT) + (dir ? (size_t)T * 512 : 0);
        const float* ER = WSP(float, WS_EREF) + (size_t)dir * NCHUNK * 512; const float* EL = WSP(float, WS_ELAST) + (size_t)dir * NCHUNK * 512;
        float M[16];
#pragma unroll
        for (int i = 0; i < 16; ++i) M[i] = 0.f;
        for (int cc = 0; cc < 32; ++cc) {
            const int c = dir ? 31 - cc : cc, gc = b * 32 + c, t0 = gc * 64;
            __syncthreads();
            for (int idx = F.tid; idx < 64 * 128; idx += NTHR) { const int t = idx >> 7, ch = idx & 127; const size_t o = (size_t)(t0 + t) * 512 + hh * 128 + ch; Qs[idx] = bf2f(Qd[o]); Ks[idx] = bf2f(Kd[o]); }
            for (int idx = F.tid; idx < 64 * 64; idx += NTHR) { const int t = idx >> 6, vv = idx & 63; Vs[idx] = bf2f(Va[(size_t)(t0 + t) * 512 + hh * 128 + vh * 64 + vv]); Os[idx] = 0.f; }
            __syncthreads();
            for (int idx = F.tid; idx < 64 * 64; idx += NTHR) { const int t = idx >> 6, s = idx & 63; const bool ok = dir ? (s >= t) : (s <= t); float a = 0.f;
                if (ok) for (int ch = 0; ch < 128; ++ch) a += Qs[t * 128 + ch] * Ks[s * 128 + ch];
                Ps[idx] = a; }
            __syncthreads();
            for (int t = 0; t < 64; ++t) { float a = 0.f;
#pragma unroll
                for (int i = 0; i < 16; ++i) a += Qs[t * 128 + kq * 16 + i] * M[i];
#pragma unroll
                for (int s = 0; s < 8; ++s) a += Ps[t * 64 + kq * 8 + s] * Vs[(kq * 8 + s) * 64 + v];
                atomicAdd(&Os[t * 64 + v], a); }
            __syncthreads();
            for (int idx = F.tid; idx < 64 * 64; idx += NTHR) { const int t = idx >> 6, vv = idx & 63; Od[(size_t)(t0 + t) * 512 + hh * 128 + vh * 64 + vv] = (bf16)f2bf(Os[idx]); }
            const int cn = dir ? c - 1 : c + 1; const bool has = cc < 31;
#pragma unroll
            for (int i = 0; i < 16; ++i) { float u = 0.f; const int ch = kq * 16 + i;
                for (int t = 0; t < 64; ++t) u += Ks[t * 128 + ch] * Vs[t * 64 + v];
                const float d = has ? EL[(size_t)gc * 512 + hh * 128 + ch] * ER[(size_t)(b * 32 + cn) * 512 + hh * 128 + ch] : 0.f;
                M[i] = (M[i] + u) * d; }
        }
    }
    __syncthreads();
}
__device__ __forceinline__ void attn_naive(const Frame& F) {
    const bf16* QM = WSP(bf16, WS_QM); const bf16* KH = WSP(bf16, WS_KH); const bf16* VH = WSP(bf16, WS_VH); bf16* OM = DOP(bf16, DO_OM);
    const float* RT = WSP(float, WS_ROPE); const float* QN = F.in[I_QN];
    for (int item = blockIdx.x; item < NB * MH * 4; item += F.G) {
        const int qb = item & 3, h = (item >> 2) & 7, b = item >> 5; const int t = b * SEQ + qb * 512 + F.tid;
        float q[96]; float ss = 0.f;
#pragma unroll
        for (int c = 0; c < 12; ++c) { const v4u w = *(const v4u*)(QM + (size_t)t * 768 + h * 96 + c * 8);
            q[c * 8 + 0] = bflo(w.x); q[c * 8 + 1] = bfhi(w.x); q[c * 8 + 2] = bflo(w.y); q[c * 8 + 3] = bfhi(w.y); q[c * 8 + 4] = bflo(w.z); q[c * 8 + 5] = bfhi(w.z); q[c * 8 + 6] = bflo(w.w); q[c * 8 + 7] = bfhi(w.w); }
#pragma unroll
        for (int d = 0; d < 96; ++d) ss += q[d] * q[d];
        const float rs = rsqrtf(ss * (1.0f / 96.0f) + EPS) ;
#pragma unroll
        for (int d = 0; d < 96; ++d) q[d] = q[d] * rs * QN[d];
#pragma unroll
        for (int i = 0; i < 16; ++i) { const float c = RT[(size_t)t * 32 + i], s = RT[(size_t)t * 32 + 16 + i]; const float x1 = q[64 + i], x2 = q[80 + i]; q[64 + i] = x1 * c - x2 * s; q[80 + i] = x2 * c + x1 * s; }
        const float sc = 0.10206207261596577f;
        unsigned qp[48];
#pragma unroll
        for (int d = 0; d < 48; ++d) qp[d] = pk2(q[2 * d] * sc, q[2 * d + 1] * sc);
        float o[64]; float mx = -1e30f, l = 0.f;
#pragma unroll
        for (int d = 0; d < 64; ++d) o[d] = 0.f;
        for (int s = 0; s < SEQ; ++s) {
            const bf16* kp = KH + ((size_t)(b * SEQ + s) * 8 + h) * 96; float a = 0.f;
#pragma unroll
            for (int c = 0; c < 12; ++c) { const v4u w = *(const v4u*)(kp + c * 8);
                a = dot2bf(qp[c * 4 + 0], w.x, a); a = dot2bf(qp[c * 4 + 1], w.y, a); a = dot2bf(qp[c * 4 + 2], w.z, a); a = dot2bf(qp[c * 4 + 3], w.w, a);
                if (c & 1) asm volatile("" ::: "memory"); }
            const float mn = fmaxf(mx, a), al = __expf(mx - mn), p = __expf(a - mn); mx = mn; l = l * al + p;
            const bf16* vp = VH + ((size_t)(b * SEQ + s) * 8 + h) * 64;
#pragma unroll
            for (int c = 0; c < 8; ++c) { const v4u w = *(const v4u*)(vp + c * 8);
                o[c * 8 + 0] = o[c * 8 + 0] * al + p * bflo(w.x); o[c * 8 + 1] = o[c * 8 + 1] * al + p * bfhi(w.x); o[c * 8 + 2] = o[c * 8 + 2] * al + p * bflo(w.y); o[c * 8 + 3] = o[c * 8 + 3] * al + p * bfhi(w.y);
                o[c * 8 + 4] = o[c * 8 + 4] * al + p * bflo(w.z); o[c * 8 + 5] = o[c * 8 + 5] * al + p * bfhi(w.z); o[c * 8 + 6] = o[c * 8 + 6] * al + p * bflo(w.w); o[c * 8 + 7] = o[c * 8 + 7] * al + p * bfhi(w.w); if (c & 1) asm volatile("" ::: "memory"); }
        }
        const float il = 1.0f / l;
#pragma unroll
        for (int c = 0; c < 8; ++c) st8(OM + (size_t)t * 512 + h * 64 + c * 8, (f32x4){o[c * 8] * il, o[c * 8 + 1] * il, o[c * 8 + 2] * il, o[c * 8 + 3] * il}, (f32x4){o[c * 8 + 4] * il, o[c * 8 + 5] * il, o[c * 8 + 6] * il, o[c * 8 + 7] * il});
    }
}
__device__ __forceinline__ void route_naive(const Frame& F) {
    const int gw = F.vcu * NWAVES + F.wave, NGW = F.G * NWAVES; const float* WR = WSP(float, WS_WR); const float* BR = WSP(float, WS_BR);
    bf16* HM = WSP(bf16, WS_ACT); int* EIDX = WSP(int, WS_EIDX); float* EW = WSP(float, WS_EW); int* LIST = WSP(int, WS_LIST);
    for (int m = gw; m < T; m += NGW) {
        const float* xr = F.out + (size_t)m * D + F.lane * 8; f32x4 v[4]; float ss = 0.f;
#pragma unroll
        for (int j = 0; j < 2; ++j) { v[2 * j] = *(const f32x4*)(xr + 512 * j); v[2 * j + 1] = *(const f32x4*)(xr + 512 * j + 4); ss += dot4(v[2 * j]) + dot4(v[2 * j + 1]); }
        const float rs = rsqrtf(wave_sum(ss) * (1.0f / D) + EPS);
#pragma unroll
        for (int j = 0; j < 4; ++j) v[j] = v[j] * rs;
#pragma unroll
        for (int j = 0; j < 2; ++j) st8(HM + (size_t)m * D + F.lane * 8 + 512 * j, v[2 * j], v[2 * j + 1]);
        float gl = -1e30f, el = -1e30f;
        for (int o = 0; o < 72; ++o) { const float* wr_ = WR + (size_t)o * 1024 + F.lane * 8; float a = 0.f;
#pragma unroll
            for (int j = 0; j < 2; ++j) { const f32x4 w0 = *(const f32x4*)(wr_ + 512 * j), w1 = *(const f32x4*)(wr_ + 512 * j + 4);
                a += (v[2 * j][0] * w0[0] + v[2 * j][1] * w0[1]) + (v[2 * j][2] * w0[2] + v[2 * j][3] * w0[3]) + (v[2 * j + 1][0] * w1[0] + v[2 * j + 1][1] * w1[1]) + (v[2 * j + 1][2] * w1[2] + v[2 * j + 1][3] * w1[3]); }
            a = wave_sum(a) + BR[o];
            if (o < 8) { if (F.lane == o) gl = a; } else { if (F.lane == o - 8) el = a; } }
        float gm = gl; gm = fmaxf(gm, __shfl_xor(gm, 1)); gm = fmaxf(gm, __shfl_xor(gm, 2)); gm = fmaxf(gm, __shfl_xor(gm, 4)); gm = __shfl(gm, 0);
        const int gsel = __ffsll((unsigned long long)__ballot(F.lane < 8 && gl == gm)) - 1;
        float ge = F.lane < 8 ? __expf(gl - gm) : 0.f; ge += __shfl_xor(ge, 1); ge += __shfl_xor(ge, 2); ge += __shfl_xor(ge, 4); const float pg = 1.0f / __shfl(ge, 0);
        float c1 = (F.lane >> 3) == gsel ? el : -3e38f; float m1 = c1;
#pragma unroll
        for (int o = 1; o < 64; o <<= 1) m1 = fmaxf(m1, __shfl_xor(m1, o));
        const int i1 = __ffsll((unsigned long long)__ballot(c1 == m1)) - 1;
        float c2 = F.lane == i1 ? -3e38f : c1; float m2 = c2;
#pragma unroll
        for (int o = 1; o < 64; o <<= 1) m2 = fmaxf(m2, __shfl_xor(m2, o));
        const int i2 = __ffsll((unsigned long long)__ballot(c2 == m2)) - 1;
        const float e2 = __expf(m2 - m1), w0 = pg / (1.0f + e2), w1 = pg * e2 / (1.0f + e2);
        if (F.lane < 2) { const int e = F.lane ? i2 : i1; EIDX[m * 2 + F.lane] = e; EW[m * 2 + F.lane] = F.lane ? w1 : w0;
            const unsigned pos = __hip_atomic_fetch_add(F.ctl + CW_CNT + 64 * e, 1u, RLX_AGENT); LIST[(size_t)e * T + pos] = m * 2 + F.lane; }
    }
}
__device__ __forceinline__ void moe_naive(const Frame& F) {
    float* hs = (float*)F.gl; float* s1 = hs + 1024; float* h1 = s1 + 512;
    const bf16* HM = WSP(bf16, WS_ACT); const bf16* W13 = WSP(bf16, WS_W13); const bf16* W2T = WSP(bf16, WS_W2T); const int* EIDX = WSP(int, WS_EIDX); const float* EW = WSP(float, WS_EW);
    for (int a = blockIdx.x; a < T * 2; a += F.G) {
        const int t = a >> 1, slot = a & 1, e = EIDX[a]; const float w = EW[a];
        __syncthreads();
        hs[F.tid] = bf2f(HM[(size_t)t * 1024 + F.tid]); hs[F.tid + 512] = bf2f(HM[(size_t)t * 1024 + 512 + F.tid]);
        __syncthreads();
        { const int c = F.tid & 255, half = F.tid >> 8; const int p = 256 * (c >> 7) + 128 * half + iperm8(c & 127);
          const bf16* wr_ = W13 + ((size_t)e * 512 + p) * 1024; float acc = 0.f;
          for (int k = 0; k < 1024; k += 8) { const v4u wv = *(const v4u*)(wr_ + k);
              acc += hs[k] * bflo(wv.x) + hs[k + 1] * bfhi(wv.x) + hs[k + 2] * bflo(wv.y) + hs[k + 3] * bfhi(wv.y) + hs[k + 4] * bflo(wv.z) + hs[k + 5] * bfhi(wv.z) + hs[k + 6] * bflo(wv.w) + hs[k + 7] * bfhi(wv.w); }
          s1[F.tid] = acc; }
        __syncthreads();
        if (F.tid < 256) h1[F.tid] = bf2f(f2bf(silu_(s1[F.tid]) * s1[256 + F.tid]));
        __syncthreads();
        for (int pp = F.tid; pp < 1024; pp += NTHR) { const bf16* wr_ = W2T + ((size_t)e * 1024 + pp) * 256; float acc = 0.f;
            for (int k = 0; k < 256; k += 8) { const v4u wv = *(const v4u*)(wr_ + k);
                acc += h1[k] * bflo(wv.x) + h1[k + 1] * bfhi(wv.x) + h1[k + 2] * bflo(wv.y) + h1[k + 3] * bfhi(wv.y) + h1[k + 4] * bflo(wv.z) + h1[k + 5] * bfhi(wv.z) + h1[k + 6] * bflo(wv.w) + h1[k + 7] * bfhi(wv.w); }
            WSP(bf16, slot ? WS_Y1 : WS_Y0)[(size_t)t * 1024 + perm8(pp)] = (bf16)f2bf(acc * w); }
    }
    __syncthreads();
}
struct Args { const float* in[27]; float* out; unsigned char* ws; int ph_lo, ph_hi, use_bar, pad; };
constexpr int NPHASE = 11;
__device__ __forceinline__ void frame_init(Frame& F, const Args& args, unsigned char* lds) {
    F.lds = (LAS unsigned char*)lds; F.gl = lds;
    F.MISC = (volatile LAS unsigned*)(F.lds + MISC_OFF);
    F.tid = threadIdx.x; F.lane = F.tid & 63; F.wave = __builtin_amdgcn_readfirstlane(F.tid >> 6);
    F.G = gridDim.x; { const int bx = blockIdx.x; F.vcu = (F.G % 8 == 0) ? (bx % 8) * (F.G / 8) + bx / 8 : bx; }
    F.ws = args.ws; F.out = args.out; F.ctl = (gu32*)(args.ws + WS_CTL);
#pragma unroll
    for (int i = 0; i < 27; ++i) F.in[i] = args.in[i];
    for (int u = F.tid; u < 1024 / 4; u += NTHR) ((LAS unsigned*)(F.lds + LDSCTL_OFF))[u] = 0u;
    __syncthreads();
}
template <int PH> __device__ __forceinline__ void run_phase(const Frame& F) {
    if constexpr (PH == 0) { p0_prologue(F); }
    if constexpr (PH == 1) {
        Gemm g{WSP(bf16, WS_ACT), WSP(bf16, WS_WIN), 1024, nullptr}; StaticOrder S; S.init(T, NIN, F.G, (int)blockIdx.x);
        EpiIn E{F.ws, (unsigned char*)F.out};
        GEMM_PHASE(EpiIn, StaticOrder, g, S, E);
    }
    if constexpr (PH == 2) {
        { Gemm g{WSP(bf16, WS_CQ), WSP(bf16, WS_WUQ), 256, nullptr}; StaticOrder S; S.init(T, 768, F.G, (int)blockIdx.x); EpiQ E{WSP(bf16, WS_QM), WSP(float, WS_CQSS)}; GEMM_PHASE(EpiQ, StaticOrder, g, S, E); }
        { Gemm g{WSP(bf16, WS_CKVR), WSP(bf16, WS_WUKV), 256, nullptr}; StaticOrder S; S.init(T, 1024, F.G, (int)blockIdx.x);
          EpiKV E{WSP(bf16, WS_KH), WSP(bf16, WS_VH), WSP(float, WS_CKVSS), WSP(float, WS_KR), WSP(float, WS_ROPE), F.in[I_KN]}; GEMM_PHASE(EpiKV, StaticOrder, g, S, E); }
        HGRN_PHASE(F);
    }
    if constexpr (PH == 3) { oa_pass(F); ATTN_PHASE(F); }
    if constexpr (PH == 4) {
        Gemm g{DOP(bf16, DO_OA), WSP(bf16, WS_WOAB), 512, nullptr}; PairOrder S; S.init(F.G, (int)blockIdx.x); EpiMerge E{WSP(bf16, WS_ACT), WSP(bf16, WS_GA), WSP(bf16, WS_GB)};
        GEMM_PHASE(EpiMerge, PairOrder, g, S, E);
    }
    if constexpr (PH == 5) {
        Gemm g{WSP(bf16, WS_ACT), WSP(bf16, WS_WOUT), 1024, nullptr}; StaticOrder S; S.init(T, D, F.G, (int)blockIdx.x); EpiX2 E{F.in[I_X], F.out};
        GEMM_PHASE(EpiX2, StaticOrder, g, S, E);
    }
    if constexpr (PH == 6) { ROUTE_PHASE(F); conv_mat<M_W13>(F); conv_mat<M_W2T>(F); }
#if NAIVE_MOE
    if constexpr (PH == 7) { moe_naive(F); }

#else
    if constexpr (PH == 7) {
        moe_build_table(F);
        Gemm g{WSP(bf16, WS_ACT), WSP(bf16, WS_W13), 1024, WSP(int, WS_LIST)}; MoeOrder S{(const LAS int*)(F.lds + TAB_OFF), 2, F.G, (int)blockIdx.x}; EpiUp E{WSP(bf16, WS_H1)};
        GEMM_PHASE(EpiUp, MoeOrder, g, S, E);
    }
    if constexpr (PH == 8) {
        moe_build_table(F);
        Gemm g{WSP(bf16, WS_H1), WSP(bf16, WS_W2T), 256, nullptr}; MoeOrder S{(const LAS int*)(F.lds + TAB_OFF), 4, F.G, (int)blockIdx.x}; EpiDown E{WSP(bf16, WS_Y0), WSP(bf16, WS_Y1), WSP(int, WS_LIST), WSP(float, WS_EW)};
        GEMM_PHASE(EpiDown, MoeOrder, g, S, E);
    }
#endif
    if constexpr (PH == 9) {
        Gemm g{WSP(bf16, WS_PB), WSP(bf16, WS_WPP), 256, nullptr}; StaticOrder S; S.init(T, D, F.G, (int)blockIdx.x); EpiProj E{WSP(bf16, WS_PROJ)};
        GEMM_PHASE(EpiProj, StaticOrder, g, S, E);
        x3_pass(F);
    }
    if constexpr (PH == 10) {
        Gemm g{WSP(bf16, WS_ACT), WSP(bf16, WS_WPG), 1024, nullptr}; StaticOrder S; S.init(T, D, F.G, (int)blockIdx.x); EpiFinal E{F.out, WSP(bf16, WS_PROJ)};
        GEMM_PHASE(EpiFinal, StaticOrder, g, S, E);
    }
}

template <int PH> __global__ void __launch_bounds__(NTHR, 2) phase_kernel(Args args) {
    extern __shared__ __attribute__((aligned(16))) unsigned char lds[];
    Frame F; frame_init(F, args, lds);
    run_phase<PH>(F);
}
#if N_LAUNCHES == 1
__global__ void __launch_bounds__(NTHR, 2) mega(Args args) {
    extern __shared__ __attribute__((aligned(16))) unsigned char lds[];
    Frame F; frame_init(F, args, lds);
    XcdBarrier bar = xcd_barrier_post((unsigned*)(F.ctl + CW_BAR), F.MISC + 8);
    run_phase<0>(F); xcd_barrier(bar);
    run_phase<1>(F); xcd_barrier(bar);
    run_phase<2>(F); xcd_barrier(bar);
    run_phase<3>(F); xcd_barrier(bar);
    run_phase<4>(F); xcd_barrier(bar);
    run_phase<5>(F); xcd_barrier(bar);
    run_phase<6>(F); xcd_barrier(bar);
    run_phase<7>(F); xcd_barrier(bar);
    run_phase<8>(F); xcd_barrier(bar);
    run_phase<9>(F); xcd_barrier(bar);
    run_phase<10>(F);
}
#endif
extern "C" void kernel_launch(void* const* d_in, const int* in_sizes, int n_in, void* d_out, int out_size, void* d_ws, size_t ws_size, hipStream_t stream) {
    static int grid = 0;
    if (grid == 0) {
        if (n_in != 27 || in_sizes[0] != T * D || out_size != T * D || ws_size < WS_END) { fprintf(stderr, "kernel_launch: unexpected shapes (n_in %d, in0 %d, out %d, ws %zu)\n", n_in, n_in > 0 ? in_sizes[0] : -1, out_size, ws_size); grid = -1; return; }
        int dev = 0, cus = 0;
        if (hipGetDevice(&dev) != hipSuccess || hipDeviceGetAttribute(&cus, hipDeviceAttributeMultiprocessorCount, dev) != hipSuccess) { grid = -1; return; }
#if N_LAUNCHES == 1
        if (hipFuncSetAttribute((const void*)mega, hipFuncAttributeMaxDynamicSharedMemorySize, LDS_BYTES) != hipSuccess) { fprintf(stderr, "kernel_launch: hipFuncSetAttribute failed\n"); grid = -1; return; }
#else
#define SETATTR(k) if (hipFuncSetAttribute((const void*)phase_kernel<k>, hipFuncAttributeMaxDynamicSharedMemorySize, LDS_BYTES) != hipSuccess) { fprintf(stderr, "kernel_launch: hipFuncSetAttribute failed\n"); grid = -1; return; }
        SETATTR(0) SETATTR(1) SETATTR(2) SETATTR(3) SETATTR(4) SETATTR(5) SETATTR(6) SETATTR(7) SETATTR(8) SETATTR(9) SETATTR(10)
#endif
        grid = cus;
    }
    if (grid < 0) return;
    (void)hipMemsetAsync((char*)d_ws + WS_CTL, 0, CTL_ZERO_BYTES, stream);
    Args a{};
    for (int i = 0; i < 27; ++i) a.in[i] = (const float*)d_in[i];
    a.out = (float*)d_out; a.ws = (unsigned char*)d_ws;
#if N_LAUNCHES == 1
    a.ph_lo = 0; a.ph_hi = NPHASE; a.use_bar = 1;
    hipLaunchKernelGGL(mega, dim3(grid), dim3(NTHR), LDS_BYTES, stream, a);
#else
#define LAUNCH_PH(k) hipLaunchKernelGGL(phase_kernel<k>, dim3(grid), dim3(NTHR), LDS_BYTES, stream, a)
#ifndef LAST_PHASE
#define LAST_PHASE 10
#endif
    LAUNCH_PH(0); LAUNCH_PH(1); LAUNCH_PH(2); LAUNCH_PH(3); LAUNCH_PH(4); LAUNCH_PH(5);
    if (LAST_PHASE >= 6) { LAUNCH_PH(6); } if (LAST_PHASE >= 7) { LAUNCH_PH(7); } if (LAST_PHASE >= 8) { LAUNCH_PH(8); } if (LAST_PHASE >= 9) { LAUNCH_PH(9); } if (LAST_PHASE >= 10) { LAUNCH_PH(10); }
#endif
    const hipError_t le = hipPeekAtLastError();
    if (le != hipSuccess) fprintf(stderr, "kernel_launch: launch failed: %s\n", hipGetErrorName(le));
}
```

```cpp
#include <hip/hip_runtime.h>
#include <cstdio>
#include <cstdint>

#define GAS __attribute__((address_space(1)))
#define LAS __attribute__((address_space(3)))
typedef unsigned short bf16;
typedef unsigned v4u __attribute__((ext_vector_type(4)));
typedef unsigned v2u __attribute__((ext_vector_type(2)));
typedef float f32x4 __attribute__((ext_vector_type(4)));
typedef float f32x2 __attribute__((ext_vector_type(2)));
typedef short bf16x8 __attribute__((ext_vector_type(8)));
typedef GAS unsigned gu32;
#define RLX_AGENT __ATOMIC_RELAXED, __HIP_MEMORY_SCOPE_AGENT
#define LDS_WAIT() asm volatile("s_waitcnt lgkmcnt(0)" ::: "memory")
#define VM_WAIT() asm volatile("s_waitcnt vmcnt(0)" ::: "memory")

constexpr int NB = 16, SEQ = 2048, T = NB * SEQ, D = 1024;
constexpr int HGH = 4, HGK = 128, HGV = 128, HGF = 512, CHUNK = 64, NCHUNK = T / CHUNK;
constexpr int MH = 8, NOPE = 64, ROPE = 32, QK = 96, VD = 64, QR = 256, KVR = 128;
constexpr int NG = 8, EPG = 8, NE = 64, DE = 256, PLE = 256;
constexpr int DIN = 5024, NIN = 5120;
constexpr float EPS = 1e-6f;
constexpr int NWAVES = 8, NTHR = 512;

__device__ __forceinline__ unsigned f2bf(float f) { unsigned u = __builtin_bit_cast(unsigned, f); return (u + 0x7fffu + ((u >> 16) & 1u)) >> 16; }
__device__ __forceinline__ unsigned pk2(float lo, float hi) { return f2bf(lo) | (f2bf(hi) << 16); }
__device__ __forceinline__ float bf2f(unsigned b) { return __builtin_bit_cast(float, b << 16); }
__device__ __forceinline__ float bflo(unsigned w) { return __builtin_bit_cast(float, w << 16); }
__device__ __forceinline__ float bfhi(unsigned w) { return __builtin_bit_cast(float, w & 0xffff0000u); }
__device__ __forceinline__ float sigm(float x) { return 1.0f / (1.0f + __expf(-x)); }
__device__ __forceinline__ float silu_(float x) { return x / (1.0f + __expf(-x)); }
__device__ __forceinline__ float wave_sum(float v) {
#pragma unroll
    for (int o = 1; o < 64; o <<= 1) v += __shfl_xor(v, o);
    return v;
}
__host__ __device__ __forceinline__ int perm8(int p) { const int r = p & 31, n = r >> 4, fq = (r >> 2) & 3, j = r & 3; return (p & ~31) + 8 * fq + 4 * n + j; }
__host__ __device__ __forceinline__ int iperm8(int l) { const int r = l & 31, fq = r >> 3, n = (r >> 2) & 1, j = r & 3; return (l & ~31) + 16 * n + 4 * fq + j; }

constexpr size_t MiB = 1u << 20;
constexpr size_t WS_CTL = 0, CTL_ZERO_BYTES = 1 * MiB;
constexpr size_t WS_LB = 1 * MiB;
constexpr size_t WS_WR = 1 * MiB + 65536;
constexpr size_t WS_BR = 1 * MiB + 65536 + 72 * 1024 * 4;
constexpr size_t WS_CQSS = 2 * MiB;
constexpr size_t WS_CKVSS = 2 * MiB + 512 * 1024;
constexpr size_t WS_ROPE = 4 * MiB;
constexpr size_t WS_EREF = 8 * MiB, WS_ELAST = 10 * MiB;
constexpr size_t WS_EIDX = 12 * MiB;
constexpr size_t WS_EW = 12 * MiB + 512 * 1024;
constexpr size_t WS_KR = 13 * MiB;
constexpr size_t WS_LIST = 4 * MiB;
constexpr size_t WS_WIN = 17 * MiB, WS_WOAB = 27 * MiB, WS_WUQ = 29 * MiB, WS_WUKV = 29 * MiB + 512 * 1024, WS_WOUT = 30 * MiB, WS_WPG = 32 * MiB, WS_WPP = 34 * MiB;
constexpr size_t WS_ACT = 36 * MiB;
constexpr size_t WS_VA = 100 * MiB, WS_OG = 132 * MiB, WS_CQ = 164 * MiB, WS_CKVR = 180 * MiB, WS_GA = 196 * MiB, WS_GB = 260 * MiB;
constexpr size_t WS_QM = 324 * MiB, WS_KH = 372 * MiB, WS_VH = 420 * MiB, WS_PB = 452 * MiB, WS_END = 468 * MiB;
constexpr size_t WS_W13 = 196 * MiB, WS_W2T = 260 * MiB;
constexpr size_t WS_H1 = 324 * MiB;
constexpr size_t WS_Y0 = 100 * MiB, WS_Y1 = 372 * MiB;
constexpr size_t WS_PROJ = 292 * MiB;
constexpr size_t DO_QF = 0, DO_KF = 32 * MiB, DO_QB = 64 * MiB, DO_KB = 96 * MiB, DO_OA = 0, DO_OM = 32 * MiB;
constexpr int CW_TMO = 0, CW_CODE = 1, CW_BAR = 4096, CW_CNT = 8192  ;
constexpr int MAXROWT = 320;
constexpr int RING_BYTES = 131072, LDSCTL_OFF = RING_BYTES, MISC_OFF = LDSCTL_OFF + 320, TAB_OFF = RING_BYTES + 1024, LDS_BYTES = 147456;
#define N_LAUNCHES 1
#define NAIVE_MOE 0
#define GEMM_PHASE(EPI, SCHED, g, S, E) gemm_fast<EPI, SCHED, false>(F.lds, g, S, E)
#define GEMM_PHASE_GATHER(EPI, SCHED, g, S, E) gemm_fast<EPI, SCHED, true>(F.lds, g, S, E)
#define HGRN_PHASE(F) hgrn_naive(F)
#define ATTN_PHASE(F) attn_naive(F)
#define ROUTE_PHASE(F) route_naive(F)
#define XB_TMO      128
#define XB_XCNT(j)  (256  + 64 * (j))
#define XB_XSUB(j)  (1280 + 64 * (j))
#define XB_XGEN(j)  (2304 + 64 * (j))
#define XB_TOP      3328
#define XB_TOPGEN   3392
#define XCD_BAR_WORDS 3456
#define XB_SPIN_CAP (1u << 18)

__device__ __forceinline__ unsigned xb_ld(unsigned* p)              { return __hip_atomic_load(p, __ATOMIC_RELAXED, __HIP_MEMORY_SCOPE_AGENT); }
__device__ __forceinline__ unsigned xb_add(unsigned* p, unsigned v) { return __hip_atomic_fetch_add(p, v, __ATOMIC_RELAXED, __HIP_MEMORY_SCOPE_AGENT); }
__device__ __forceinline__ unsigned xb_xcc_id() { return (unsigned)__builtin_amdgcn_s_getreg((3 << 11) | 20) & 0xFu; }
#define XB_SPIN(cond, bar) do { unsigned _sp = 0; while (cond) { __builtin_amdgcn_s_sleep(1); \
    if ((++_sp & 255u) == 0u) { if (xb_ld(&(bar)[XB_TMO])) break; if (_sp > XB_SPIN_CAP) { atomicAdd(&(bar)[XB_TMO], 1u); break; } } } } while (0)

struct XcdBarrier {
    unsigned* bar; unsigned x;
    volatile LAS unsigned* st;
};

__device__ __forceinline__ XcdBarrier xcd_barrier_post(unsigned* bar, volatile LAS unsigned* st) {
    XcdBarrier b; b.bar = bar; b.x = xb_xcc_id(); b.st = st;
    if (threadIdx.x == 0) (void)xb_add(&bar[XB_XCNT(b.x)], 1u);
    return b;
}
__device__ __forceinline__ void xcd_barrier_complete(unsigned* bar, unsigned x, unsigned& nloc, unsigned& nx) {
    const unsigned G = gridDim.x * gridDim.y * gridDim.z;
    unsigned sum, cnt, mine, sp = 0u;
    for (;;) {
        sum = 0u; cnt = 0u; mine = 0u;
#pragma unroll
        for (unsigned j = 0; j < 16; ++j) { const unsigned c = xb_ld(&bar[XB_XCNT(j)]); sum += c; cnt += (c > 0u) ? 1u : 0u; mine = (j == x) ? c : mine; }
        if (sum == G) break;
        __builtin_amdgcn_s_sleep(1);
        if ((++sp & 255u) == 0u) { if (xb_ld(&bar[XB_TMO])) break; if (sp > XB_SPIN_CAP) { atomicAdd(&bar[XB_TMO], 1u); break; } }
    }
    nloc = mine > 0u ? mine : 1u; nx = cnt > 0u ? cnt : 1u;
}

__device__ __forceinline__ void xcd_barrier(const XcdBarrier& b) {
    asm volatile("s_waitcnt vmcnt(0)" ::: "memory");
    __syncthreads();
    if (threadIdx.x == 0) {
        unsigned* bar = b.bar;
        __builtin_amdgcn_s_waitcnt(0);
        unsigned nloc = b.st[0], nx = b.st[1];
        if (nloc == 0u) { xcd_barrier_complete(bar, b.x, nloc, nx); b.st[0] = nloc; b.st[1] = nx; }
        const unsigned old = xb_add(&bar[XB_XSUB(b.x)], 1u);
        const unsigned gen = old / nloc;
        if (old + 1u == (gen + 1u) * nloc) {
            __builtin_amdgcn_fence(__ATOMIC_RELEASE, "agent");
            asm volatile("s_waitcnt vmcnt(0)" ::: "memory");
            const unsigned og = xb_add(&bar[XB_TOP], 1u);
            const unsigned tg = og / nx;
            if (og + 1u == (tg + 1u) * nx) xb_add(&bar[XB_TOPGEN], 1u);
            else XB_SPIN(xb_ld(&bar[XB_TOPGEN]) == tg, bar);
            __builtin_amdgcn_fence(__ATOMIC_ACQUIRE, "agent");
            xb_add(&bar[XB_XGEN(b.x)], 1u);
            asm volatile("s_waitcnt vmcnt(0)" ::: "memory");
        } else {
            XB_SPIN(xb_ld(&bar[XB_XGEN(b.x)]) == gen, bar);
            __builtin_amdgcn_fence(__ATOMIC_ACQUIRE, "agent");
            asm volatile("s_waitcnt vmcnt(0)" ::: "memory");
        }
    }
    __syncthreads();
}
struct Unit { int pm, pn, lbase, nvalid; };
struct Gemm { const bf16* A; const bf16* Bt; int K; const int* list; };
typedef __bf16 bf16x2_t __attribute__((ext_vector_type(2)));
__device__ __forceinline__ float dot2bf(unsigned a, unsigned b, float c) { return __builtin_amdgcn_fdot2_f32_bf16(__builtin_bit_cast(bf16x2_t, a), __builtin_bit_cast(bf16x2_t, b), c, false); }

constexpr int NXCD = 8, WGM = 8;
struct StaticOrder {
    int nM, nN, nwg, G, c;
    __device__ void init(int M, int N, int G_, int c_) { nM = M / 256; nN = N / 256; nwg = nM * nN; G = G_; c = c_; }
    __device__ __forceinline__ bool next(int i, Unit& u) const {
        const long L = (long)i * G + c; if (L >= nwg) return false;
        int wgid = (int)L; { const int q = nwg / NXCD, r = nwg % NXCD, xcd = wgid % NXCD, off = wgid / NXCD; wgid = (xcd < r ? xcd * (q + 1) : r * (q + 1) + (xcd - r) * q) + off; }
        const int nig = WGM * nN, gid = wgid / nig, fm = gid * WGM, gsz = (nM - fm) < WGM ? (nM - fm) : WGM;
        u.pm = fm + ((wgid % nig) % gsz); u.pn = (wgid % nig) / gsz; u.lbase = 0; u.nvalid = 256; return true;
    }
};
struct PairOrder {
    StaticOrder so;
    __device__ void init(int G_, int c_) { so.init(T, D, G_, c_); }
    __device__ __forceinline__ bool next(int i, Unit& u) const { if (!so.next(i >> 1, u)) return false; if (i & 1) { u.pm += T / 256; u.pn += D / 256; } return true; }
};
struct MoeOrder {
    const LAS int* tab; int npn, G, c;
    __device__ __forceinline__ bool next(int i, Unit& u) const {
        const int L = i * G + c; const int nt = tab[0]; if (L >= nt * npn) return false;
        const int rt = L / npn, pl = L - rt * npn; const int e = tab[16 + 4 * rt];
        u.pm = rt; u.pn = e * npn + pl; u.lbase = tab[16 + 4 * rt + 1]; u.nvalid = tab[16 + 4 * rt + 2]; return true;
    }
};

template <class Epi, class Sched>
__device__ __forceinline__ void gemm_ref(const Gemm g, const Sched& S, const Epi& E) {
    const int tid = threadIdx.x, wid = tid >> 6, lane = tid & 63, wr = wid >> 2, wc = wid & 3, fr = lane & 15, fq = lane >> 4;
    const int K = g.K; Unit u;
    for (int i = 0; S.next(i, u); ++i) {
        f32x4 acc[2][2][4][2];
#pragma unroll
        for (int a = 0; a < 2; ++a)
#pragma unroll
            for (int b = 0; b < 2; ++b)
#pragma unroll
                for (int m = 0; m < 4; ++m)
#pragma unroll
                    for (int n = 0; n < 2; ++n) acc[a][b][m][n] = (f32x4){0.f, 0.f, 0.f, 0.f};
        unsigned ar[2][4];
#pragma unroll
        for (int ai = 0; ai < 2; ++ai)
#pragma unroll
            for (int m = 0; m < 4; ++m) { const int r = ai * 128 + wr * 64 + m * 16 + fr;
                if (g.list) { const int rr = r < u.nvalid ? r : u.nvalid - 1; ar[ai][m] = (unsigned)(g.list[u.lbase + rr] >> 1) * (unsigned)K; }
                else ar[ai][m] = (unsigned)(u.pm * 256 + r) * (unsigned)K; }
        const unsigned bb = (unsigned)(u.pn * 256 + wc * 32 + 4 * fq) * (unsigned)K;
#pragma unroll 1
        for (int k0 = 0; k0 < K; k0 += 8) {
#pragma unroll
            for (int bj = 0; bj < 2; ++bj)
#pragma unroll
                for (int n = 0; n < 2; ++n) {
                    v4u bw[4];
#pragma unroll
                    for (int j = 0; j < 4; ++j) bw[j] = *(const v4u*)(g.Bt + (bb + (unsigned)(bj * 128 + n * 16 + j) * (unsigned)K + (unsigned)k0));
#pragma unroll
                    for (int ai = 0; ai < 2; ++ai)
#pragma unroll
                        for (int m = 0; m < 4; ++m) { const v4u aw = *(const v4u*)(g.A + (ar[ai][m] + (unsigned)k0));
#pragma unroll
                            for (int j = 0; j < 4; ++j) { float c = acc[ai][bj][m][n][j];
                                c = dot2bf(aw.x, bw[j].x, c); c = dot2bf(aw.y, bw[j].y, c); c = dot2bf(aw.z, bw[j].z, c); c = dot2bf(aw.w, bw[j].w, c);
                                acc[ai][bj][m][n][j] = c; }
                            asm volatile("" ::: "memory"); }
                }
        }
        E(acc, u, wr, wc, fr, fq);
    }
}
constexpr int BM = 256, BK = 64, HALF = 128, HTB = HALF * BK * 2, STAGE_BYTES = 8 * HTB;
__host__ __device__ __forceinline__ int lds_byte(int r, int c) { const int st = (r >> 4) * 2 + (c >> 5), rr = r & 15, cc = c & 31, ob = rr * 64 + cc * 2; return st * 1024 + (ob ^ (((ob >> 9) & 1) << 5)); }
__host__ __device__ __forceinline__ void stage_rc(int b, int& R, int& C) { const int st = b / 1024, sb = b % 1024, swz = sb ^ (((sb >> 9) & 1) << 5); R = (st >> 1) * 16 + swz / 64; C = (st & 1) * 32 + (swz % 64) / 2; }
template <class Epi, class Sched, bool GATHER = false, bool ALIGN_EPI = true, bool SP2 = true>
__device__ __forceinline__ void gemm_fast(LAS unsigned char* lds, const Gemm g, const Sched& S, const Epi& E) {
    const int tid = threadIdx.x, wid = __builtin_amdgcn_readfirstlane(tid >> 6), lane = tid & 63, wr = wid >> 2, wc = wid & 3, fr = lane & 15, fq = lane >> 4;
    const int K = g.K, nt = K / BK;
    unsigned v0[2], v1[2], nv0[2], nv1[2], voffB[2]; int sR[2], sC[2];
#pragma unroll
    for (int i = 0; i < 2; ++i) { stage_rc(tid * 16 + i * 8192, sR[i], sC[i]); voffB[i] = (unsigned)(sR[i] * K + sC[i]) * 2u; }
#define PG8_AOFF(u, o0, o1) do { _Pragma("unroll") for (int _i = 0; _i < 2; ++_i) { \
        if constexpr (GATHER) { const int r0_ = sR[_i] < (u).nvalid ? sR[_i] : (u).nvalid - 1, r1_ = (128 + sR[_i]) < (u).nvalid ? 128 + sR[_i] : (u).nvalid - 1; \
            o0[_i] = ((unsigned)(g.list[(u).lbase + r0_] >> 1) * (unsigned)K + (unsigned)sC[_i]) * 2u; o1[_i] = ((unsigned)(g.list[(u).lbase + r1_] >> 1) * (unsigned)K + (unsigned)sC[_i]) * 2u; } \
        else { o0[_i] = (unsigned)(sR[_i] * K + sC[_i]) * 2u; o1[_i] = o0[_i] + (unsigned)(HALF * K * 2); } } } while (0)
    const size_t kstep = (size_t)(BK * 2);
    const size_t hstep = (size_t)HALF * K * 2;
    const size_t tstep = 2 * hstep;
    const unsigned ldsw = (unsigned)wid * 1024u;
    const int aoff = lds_byte(wr * 64 + fr, fq * 8), boff = lds_byte(wc * 32 + fr, fq * 8);
#define PG8_SA(b, h) (((b) * 2 + (h)) * HTB)
#define PG8_SB(b, h) ((4 + (b) * 2 + (h)) * HTB)
#define PG8_STAGE(bufoff, gbase, voff) do { _Pragma("unroll") for (int _i = 0; _i < 2; ++_i) \
        __builtin_amdgcn_global_load_lds((const unsigned*)((const char*)(gbase) + (voff)[_i]), (LAS unsigned*)(lds + (bufoff) + ldsw + _i * 8192), 16, 0, 0); } while (0)
#define PG8_LDA(dst, b, h) do { _Pragma("unroll") for (int m = 0; m < 4; ++m) _Pragma("unroll") for (int k = 0; k < 2; ++k) dst[m][k] = *(const LAS bf16x8*)(lds + PG8_SA(b, h) + aoff + m * 2048 + k * 1024); } while (0)
#define PG8_LDB(dst, b, h) do { _Pragma("unroll") for (int n = 0; n < 2; ++n) _Pragma("unroll") for (int k = 0; k < 2; ++k) dst[n][k] = *(const LAS bf16x8*)(lds + PG8_SB(b, h) + boff + n * 2048 + k * 1024); } while (0)
#define PG8_MMA(ai, bj, At, Bt) do { __builtin_amdgcn_s_setprio(1); _Pragma("unroll") for (int m = 0; m < 4; ++m) _Pragma("unroll") for (int n = 0; n < 2; ++n) _Pragma("unroll") for (int k = 0; k < 2; ++k) \
        acc[ai][bj][m][n] = __builtin_amdgcn_mfma_f32_16x16x32_bf16(Bt[n][k], At[m][k], acc[ai][bj][m][n], 0, 0, 0); __builtin_amdgcn_s_setprio(0); } while (0)
#define PG8_WAIT_V(n) asm volatile("s_waitcnt vmcnt(" #n ")" ::: "memory")
#define PG8_WAIT_L(n) asm volatile("s_waitcnt lgkmcnt(" #n ")" ::: "memory")
#define PG8_BAR __builtin_amdgcn_s_barrier()
#define PG8_SCHED __builtin_amdgcn_sched_barrier(0)
    Unit cur, nxt; int ui = 0;
    if (!S.next(0, cur)) return;
    f32x4 acc[2][2][4][2];
#pragma unroll
    for (int a = 0; a < 2; ++a)
#pragma unroll
        for (int b = 0; b < 2; ++b)
#pragma unroll
            for (int m = 0; m < 4; ++m)
#pragma unroll
                for (int n = 0; n < 2; ++n) acc[a][b][m][n] = (f32x4){0.f, 0.f, 0.f, 0.f};
    bf16x8 At[4][2], B0[2][2], B1[2][2];
    const char* cA = (const char*)g.A + (GATHER ? (size_t)0 : (size_t)cur.pm * tstep); const char* cB = (const char*)g.Bt + (size_t)cur.pn * tstep;
    PG8_AOFF(cur, v0, v1);
    if constexpr (SP2) {
        PG8_STAGE(PG8_SB(0, 0), cB, voffB); PG8_STAGE(PG8_SB(0, 1), cB + hstep, voffB); PG8_STAGE(PG8_SA(0, 0), cA, v0); PG8_STAGE(PG8_SA(0, 1), cA, v1);
        if (wr == 1) PG8_BAR;
        PG8_WAIT_V(2); PG8_BAR;
        PG8_STAGE(PG8_SB(1, 0), cB + kstep, voffB); PG8_STAGE(PG8_SA(1, 0), cA + kstep, v0); PG8_STAGE(PG8_SB(1, 1), cB + hstep + kstep, voffB);
        PG8_WAIT_V(6); PG8_BAR;
    } else {
        PG8_STAGE(PG8_SB(0, 0), cB, voffB); PG8_STAGE(PG8_SA(0, 0), cA, v0); PG8_STAGE(PG8_SB(0, 1), cB + hstep, voffB); PG8_STAGE(PG8_SA(0, 1), cA, v1);
        if (wr == 1) PG8_BAR;
        PG8_WAIT_V(4); PG8_BAR;
        PG8_STAGE(PG8_SB(1, 0), cB + kstep, voffB); PG8_STAGE(PG8_SA(1, 0), cA + kstep, v0); PG8_STAGE(PG8_SB(1, 1), cB + hstep + kstep, voffB);
        PG8_WAIT_V(6); PG8_BAR;
    }
    for (;;) {
        const bool has_next = S.next(ui + 1, nxt);
        const char* nA = (has_next && !GATHER) ? (const char*)g.A + (size_t)nxt.pm * tstep : cA; const char* nB = has_next ? (const char*)g.Bt + (size_t)nxt.pn * tstep : cB;
        if (has_next) { PG8_AOFF(nxt, nv0, nv1); } else { _Pragma("unroll") for (int _i = 0; _i < 2; ++_i) { nv0[_i] = v0[_i]; nv1[_i] = v1[_i]; } }
#pragma unroll 1
        for (int t = 0; t < nt; t += 2) {
            const bool last = (t == nt - 2);
            const char* a1 = cA + (size_t)(t + 1) * kstep;
            const char* a2 = last ? nA : cA + (size_t)(t + 2) * kstep; const char* b2 = last ? nB : cB + (size_t)(t + 2) * kstep;
            const char* a3 = a2 + kstep; const char* b3 = b2 + kstep;
            unsigned w0[2], w1[2];
#pragma unroll
            for (int _i = 0; _i < 2; ++_i) { w0[_i] = last ? nv0[_i] : v0[_i]; w1[_i] = last ? nv1[_i] : v1[_i]; }
            if constexpr (SP2) {
            PG8_LDB(B0, 0, 0); PG8_LDB(B1, 0, 1); PG8_SCHED; PG8_LDA(At, 0, 0); PG8_STAGE(PG8_SA(1, 1), a1, v1);
            PG8_WAIT_V(8); PG8_WAIT_L(0); PG8_BAR; PG8_MMA(0, 0, At, B0); PG8_MMA(0, 1, At, B1); PG8_BAR; PG8_SCHED;
            PG8_LDA(At, 0, 1); PG8_STAGE(PG8_SB(0, 0), b2, voffB); PG8_STAGE(PG8_SB(0, 1), b2 + hstep, voffB); PG8_STAGE(PG8_SA(0, 0), a2, w0);
            PG8_WAIT_V(8); PG8_WAIT_L(0); PG8_BAR; PG8_MMA(1, 0, At, B0); PG8_MMA(1, 1, At, B1); PG8_BAR; PG8_SCHED;
            PG8_LDB(B0, 1, 0); PG8_LDB(B1, 1, 1); PG8_SCHED; PG8_LDA(At, 1, 0); PG8_STAGE(PG8_SA(0, 1), a2, w1);
            PG8_WAIT_V(8); PG8_WAIT_L(0); PG8_BAR; PG8_MMA(0, 0, At, B0); PG8_MMA(0, 1, At, B1); PG8_BAR; PG8_SCHED;
            PG8_LDA(At, 1, 1); PG8_STAGE(PG8_SB(1, 0), b3, voffB); PG8_STAGE(PG8_SB(1, 1), b3 + hstep, voffB); PG8_STAGE(PG8_SA(1, 0), a3, w0);
            PG8_WAIT_V(8); PG8_WAIT_L(0); PG8_BAR; PG8_MMA(1, 0, At, B0); PG8_MMA(1, 1, At, B1); PG8_BAR; PG8_SCHED;
            } else {
            PG8_LDB(B0, 0, 0); PG8_SCHED; PG8_LDA(At, 0, 0); PG8_STAGE(PG8_SA(1, 1), a1, v1);
            PG8_WAIT_L(8); PG8_BAR; PG8_WAIT_L(0); PG8_MMA(0, 0, At, B0); PG8_BAR; PG8_SCHED;
            PG8_LDB(B1, 0, 1); PG8_STAGE(PG8_SB(0, 0), b2, voffB);
            PG8_BAR; PG8_WAIT_L(0); PG8_MMA(0, 1, At, B1); PG8_BAR;
            PG8_LDA(At, 0, 1); PG8_STAGE(PG8_SA(0, 0), a2, w0);
            PG8_BAR; PG8_WAIT_L(0); PG8_MMA(1, 0, At, B0); PG8_BAR; PG8_SCHED;
            PG8_STAGE(PG8_SB(0, 1), b2 + hstep, voffB);
            PG8_WAIT_V(6); PG8_BAR; PG8_MMA(1, 1, At, B1); PG8_BAR;
            PG8_LDB(B0, 1, 0); PG8_SCHED; PG8_LDA(At, 1, 0); PG8_STAGE(PG8_SA(0, 1), a2, w1);
            PG8_WAIT_L(8); PG8_BAR; PG8_WAIT_L(0); PG8_MMA(0, 0, At, B0); PG8_BAR; PG8_SCHED;
            PG8_LDB(B1, 1, 1); PG8_STAGE(PG8_SB(1, 0), b3, voffB);
            PG8_BAR; PG8_WAIT_L(0); PG8_MMA(0, 1, At, B1); PG8_BAR;
            PG8_LDA(At, 1, 1); PG8_STAGE(PG8_SA(1, 0), a3, w0);
            PG8_BAR; PG8_WAIT_L(0); PG8_MMA(1, 0, At, B0); PG8_BAR; PG8_SCHED;
            PG8_STAGE(PG8_SB(1, 1), b3 + hstep, voffB);
            PG8_WAIT_V(6); PG8_BAR; PG8_MMA(1, 1, At, B1); PG8_BAR;
            }
        }
        if constexpr (ALIGN_EPI) { if (wr == 0) PG8_BAR; }
        E(acc, cur, wr, wc, fr, fq);
        if (!has_next) break;
#pragma unroll
        for (int a = 0; a < 2; ++a)
#pragma unroll
            for (int b = 0; b < 2; ++b)
#pragma unroll
                for (int m = 0; m < 4; ++m)
#pragma unroll
                    for (int n = 0; n < 2; ++n) acc[a][b][m][n] = (f32x4){0.f, 0.f, 0.f, 0.f};
        cur = nxt; cA = nA; cB = nB; ++ui;
#pragma unroll
        for (int _i = 0; _i < 2; ++_i) { v0[_i] = nv0[_i]; v1[_i] = nv1[_i]; }
        if constexpr (ALIGN_EPI) { if (wr == 1) PG8_BAR; }
    }
    PG8_WAIT_V(0);
    if constexpr (!ALIGN_EPI) { if (wr == 0) PG8_BAR; }
    PG8_BAR;
#undef PG8_AOFF
#undef PG8_SA
#undef PG8_SB
#undef PG8_STAGE
#undef PG8_LDA
#undef PG8_LDB
#undef PG8_MMA
#undef PG8_WAIT_V
#undef PG8_WAIT_L
#undef PG8_BAR
#undef PG8_SCHED
}
__device__ __forceinline__ void st8(bf16* p, f32x4 a, f32x4 b) { v4u w; w.x = pk2(a[0], a[1]); w.y = pk2(a[2], a[3]); w.z = pk2(b[0], b[1]); w.w = pk2(b[2], b[3]); *(v4u*)p = w; }
__device__ __forceinline__ void st4(bf16* p, f32x4 a) { v2u w; w.x = pk2(a[0], a[1]); w.y = pk2(a[2], a[3]); *(v2u*)p = w; }
__device__ __forceinline__ f32x4 up4(unsigned lo, unsigned hi) { return (f32x4){bflo(lo), bfhi(lo), bflo(hi), bfhi(hi)}; }
__device__ __forceinline__ float dot4(f32x4 a) { return (a[0] * a[0] + a[1] * a[1]) + (a[2] * a[2] + a[3] * a[3]); }
__device__ __forceinline__ float scan16(float v, int fr) {
    float t;
    t = __shfl_up(v, 1, 16); if (fr >= 1) v += t;
    t = __shfl_up(v, 2, 16); if (fr >= 2) v += t;
    t = __shfl_up(v, 4, 16); if (fr >= 4) v += t;
    t = __shfl_up(v, 8, 16); if (fr >= 8) v += t;
    return v;
}

struct EpiIn {
    unsigned char *wsb, *dob;
#define EI_W(type, off) ((type*)(wsb + (off)))
#define EI_D(type, off) ((type*)(dob + (off)))
    __device__ __forceinline__ void hgrn(const f32x4 (&acc)[2][2][4][2], const Unit& u, int wr, int wc, int fr, int fq) const {
        const int hh = u.pn >> 1, cb = u.pn & 1;
        const int gch0 = hh * 128 + cb * 64 + wc * 16 + fq * 4;
        bf16* const QF = EI_D(bf16, DO_QF); bf16* const KF = EI_D(bf16, DO_KF); bf16* const QB = EI_D(bf16, DO_QB); bf16* const KB = EI_D(bf16, DO_KB); bf16* const VA = EI_W(bf16, WS_VA);
        float* const EREF = EI_W(float, WS_EREF); float* const ELAST = EI_W(float, WS_ELAST); const float* const LB = EI_W(float, WS_LB);
        const f32x4 lbf = *(const f32x4*)(LB + gch0), lbb = *(const f32x4*)(LB + 512 + gch0);
#pragma unroll
        for (int ai = 0; ai < 2; ++ai) {
            const int cidx = u.pm * 4 + ai * 2 + wr;
            const size_t off0 = (size_t)(u.pm * 256 + ai * 128 + wr * 64 + fr) * 512 + gch0;
#pragma unroll
            for (int m = 0; m < 4; ++m) st4(VA + off0 + (size_t)m * 16 * 512, acc[ai][1][m][1]);
#pragma unroll
            for (int jp = 0; jp < 2; ++jp) {
                f32x2 qo[4], ko[4];
#pragma unroll
                for (int jj = 0; jj < 2; ++jj) { const int j = 2 * jp + jj;
                    float lf[4], kk[4];
#pragma unroll
                    for (int m = 0; m < 4; ++m) { const float z = fminf(fmaxf(acc[ai][0][m][1][j], -30.f), 30.f), e = __expf(-z), s = 1.0f / (1.0f + e); kk[m] = (1.0f - lbf[j]) * e * s; lf[m] = __logf(lbf[j] + (1.0f - lbf[j]) * s); }
                    float G[4], carry = 0.f;
#pragma unroll
                    for (int m = 0; m < 4; ++m) { G[m] = scan16(lf[m], fr) + carry; carry = __shfl(G[m], 15, 16); }
                    const float Gref = __shfl(G[1], 15, 16);
#pragma unroll
                    for (int m = 0; m < 4; ++m) { qo[m][jj] = silu_(acc[ai][0][m][0][j]) * __expf(G[m] - Gref); ko[m][jj] = kk[m] * __expf(fminf(Gref - G[m], 80.f)); }
                    if (fr == 0) { EREF[(size_t)cidx * 512 + gch0 + j] = __expf(Gref); ELAST[(size_t)cidx * 512 + gch0 + j] = __expf(carry - Gref); }
                }
#pragma unroll
                for (int m = 0; m < 4; ++m) { *(unsigned*)(QF + off0 + (size_t)m * 16 * 512 + 2 * jp) = pk2(qo[m][0], qo[m][1]); *(unsigned*)(KF + off0 + (size_t)m * 16 * 512 + 2 * jp) = pk2(ko[m][0], ko[m][1]); }
                asm volatile("" ::: "memory");
#pragma unroll
                for (int jj = 0; jj < 2; ++jj) { const int j = 2 * jp + jj;
                    float lw[4], kk[4];
#pragma unroll
                    for (int m = 0; m < 4; ++m) { const float z = fminf(fmaxf(acc[ai][1][m][0][j], -30.f), 30.f), e = __expf(-z), s = 1.0f / (1.0f + e); kk[m] = (1.0f - lbb[j]) * e * s; lw[m] = __logf(lbb[j] + (1.0f - lbb[j]) * s); }
                    float P[4], carry = 0.f;
#pragma unroll
                    for (int m = 0; m < 4; ++m) { P[m] = scan16(lw[m], fr) + carry; carry = __shfl(P[m], 15, 16); }
                    float Gb[4];
#pragma unroll
                    for (int m = 0; m < 4; ++m) Gb[m] = carry - (P[m] - lw[m]);
                    const float Gbref = __shfl(Gb[2], 0, 16);
#pragma unroll
                    for (int m = 0; m < 4; ++m) { qo[m][jj] = silu_(acc[ai][0][m][0][j]) * __expf(Gb[m] - Gbref); ko[m][jj] = kk[m] * __expf(fminf(Gbref - Gb[m], 80.f)); }
                    if (fr == 0) { EREF[(size_t)(NCHUNK + cidx) * 512 + gch0 + j] = __expf(Gbref); ELAST[(size_t)(NCHUNK + cidx) * 512 + gch0 + j] = __expf(carry - Gbref); }
                }
#pragma unroll
                for (int m = 0; m < 4; ++m) { *(unsigned*)(QB + off0 + (size_t)m * 16 * 512 + 2 * jp) = pk2(qo[m][0], qo[m][1]); *(unsigned*)(KB + off0 + (size_t)m * 16 * 512 + 2 * jp) = pk2(ko[m][0], ko[m][1]); }
                asm volatile("" ::: "memory");
            }
        }
    }
    __device__ __forceinline__ void operator()(const f32x4 (&acc)[2][2][4][2], const Unit& u, int wr, int wc, int fr, int fq) const {
        const int pn = u.pn, row0 = u.pm * 256 + wr * 64 + fr;
        if (pn < 8) { hgrn(acc, u, wr, wc, fr, fq); return; }
        bf16* const OG = EI_W(bf16, WS_OG); bf16* const CQ = EI_W(bf16, WS_CQ); bf16* const CKVR = EI_W(bf16, WS_CKVR); bf16* const GA = EI_W(bf16, WS_GA); bf16* const GB = EI_W(bf16, WS_GB);
        float* const CQSS = EI_W(float, WS_CQSS); float* const CKVSS = EI_W(float, WS_CKVSS); float* const KR = EI_W(float, WS_KR);
        if (pn == 10) {
#pragma unroll
            for (int ai = 0; ai < 2; ++ai)
#pragma unroll
                for (int m = 0; m < 4; ++m) { const int row = row0 + ai * 128 + m * 16; float ss = 0.f;
#pragma unroll
                    for (int bj = 0; bj < 2; ++bj) { const f32x4 a = acc[ai][bj][m][0], b = acc[ai][bj][m][1]; ss += dot4(a) + dot4(b); st8(CQ + (size_t)row * 256 + bj * 128 + wc * 32 + 8 * fq, a, b); }
                    ss += __shfl_xor(ss, 16); ss += __shfl_xor(ss, 32); if (fq == 0) CQSS[(size_t)row * 4 + wc] = ss; }
            return;
        }
        if (pn == 11) {
#pragma unroll
            for (int ai = 0; ai < 2; ++ai)
#pragma unroll
                for (int m = 0; m < 4; ++m) { const int row = row0 + ai * 128 + m * 16;
                    const f32x4 a0 = acc[ai][0][m][0], b0 = acc[ai][0][m][1], a1 = acc[ai][1][m][0], b1 = acc[ai][1][m][1];
                    float ss = dot4(a0) + dot4(b0); ss += __shfl_xor(ss, 16); ss += __shfl_xor(ss, 32); if (fq == 0) CKVSS[(size_t)row * 4 + wc] = ss;
                    st8(CKVR + (size_t)row * 256 + wc * 32 + 8 * fq, a0, b0); st8(CKVR + (size_t)row * 256 + 128 + wc * 32 + 8 * fq, a1, b1);
                    if (wc == 0) { *(f32x4*)(KR + (size_t)row * 32 + 8 * fq) = a1; *(f32x4*)(KR + (size_t)row * 32 + 8 * fq + 4) = b1; } }
            return;
        }
        const bool sil = pn < 10; const int ld = sil ? 512 : 1024, cb = (sil ? pn - 8 : (pn - 12) & 3) * 256;
        const size_t dsto = sil ? (size_t)0 : (pn < 16 ? (size_t)((unsigned char*)GA - (unsigned char*)OG) : (size_t)((unsigned char*)GB - (unsigned char*)OG));
        bf16* dst = (bf16*)((unsigned char*)OG + dsto);
#pragma unroll
        for (int ai = 0; ai < 2; ++ai)
#pragma unroll
            for (int m = 0; m < 4; ++m)
#pragma unroll
                for (int bj = 0; bj < 2; ++bj) { f32x4 a = acc[ai][bj][m][0], b = acc[ai][bj][m][1];
#pragma unroll
                    for (int j = 0; j < 4; ++j) { a[j] = sil ? silu_(a[j]) : sigm(a[j]); b[j] = sil ? silu_(b[j]) : sigm(b[j]); }
                    st8(dst + (size_t)(row0 + ai * 128 + m * 16) * ld + cb + bj * 128 + wc * 32 + 8 * fq, a, b); }
    }
};

struct EpiQ {
    bf16* QM; const float* CQSS;
    __device__ __forceinline__ void operator()(const f32x4 (&acc)[2][2][4][2], const Unit& u, int wr, int wc, int fr, int fq) const {
#pragma unroll
        for (int ai = 0; ai < 2; ++ai)
#pragma unroll
            for (int m = 0; m < 4; ++m) { const int row = u.pm * 256 + ai * 128 + wr * 64 + m * 16 + fr;
                const f32x4 s4 = *(const f32x4*)(CQSS + (size_t)row * 4); const float rs = rsqrtf(((s4[0] + s4[1]) + (s4[2] + s4[3])) * (1.0f / 256.0f) + EPS);
#pragma unroll
                for (int bj = 0; bj < 2; ++bj) st8(QM + (size_t)row * 768 + u.pn * 256 + bj * 128 + wc * 32 + 8 * fq, acc[ai][bj][m][0] * rs, acc[ai][bj][m][1] * rs);
                asm volatile("" ::: "memory"); }
    }
};
struct EpiKV {
    bf16 *KH, *VH; const float *CKVSS, *KR, *ROPE_, *KN;
    __device__ __forceinline__ void operator()(const f32x4 (&acc)[2][2][4][2], const Unit& u, int wr, int wc, int fr, int fq) const {
        const int pn = u.pn, head = (pn & 1) * 4 + wc;
#pragma unroll
        for (int ai = 0; ai < 2; ++ai)
#pragma unroll
            for (int m = 0; m < 4; ++m) { const int row = u.pm * 256 + ai * 128 + wr * 64 + m * 16 + fr;
                const f32x4 s4 = *(const f32x4*)(CKVSS + (size_t)row * 4); const float rs = rsqrtf(((s4[0] + s4[1]) + (s4[2] + s4[3])) * (1.0f / 128.0f) + EPS);
                if (pn >= 2) {
#pragma unroll
                    for (int bj = 0; bj < 2; ++bj) st8(VH + ((size_t)row * 8 + head) * 64 + bj * 32 + 8 * fq, acc[ai][bj][m][0] * rs, acc[ai][bj][m][1] * rs);
                } else {
                    float ss = 0.f;
#pragma unroll
                    for (int bj = 0; bj < 2; ++bj)
#pragma unroll
                        for (int n = 0; n < 2; ++n) ss += dot4(acc[ai][bj][m][n]);
                    ss *= rs * rs;
                    const f32x4 x1 = *(const f32x4*)(KR + (size_t)row * 32 + 4 * fq), x2 = *(const f32x4*)(KR + (size_t)row * 32 + 16 + 4 * fq);
                    ss += dot4(x1) + dot4(x2);
                    ss += __shfl_xor(ss, 16); ss += __shfl_xor(ss, 32);
                    const float rk = rsqrtf(ss * (1.0f / 96.0f) + EPS), rr = rs * rk;
                    bf16* kp = KH + ((size_t)row * 8 + head) * 96;
#pragma unroll
                    for (int bj = 0; bj < 2; ++bj) { const f32x4 g0 = *(const f32x4*)(KN + bj * 32 + 8 * fq), g1 = *(const f32x4*)(KN + bj * 32 + 8 * fq + 4);
                        st8(kp + bj * 32 + 8 * fq, acc[ai][bj][m][0] * rr * g0, acc[ai][bj][m][1] * rr * g1); }
                    { const f32x4 c = *(const f32x4*)(ROPE_ + (size_t)row * 32 + 4 * fq), s = *(const f32x4*)(ROPE_ + (size_t)row * 32 + 16 + 4 * fq);
                      const f32x4 y1 = x1 * rk * *(const f32x4*)(KN + 64 + 4 * fq), y2 = x2 * rk * *(const f32x4*)(KN + 80 + 4 * fq);
                      st4(kp + 64 + 4 * fq, y1 * c - y2 * s); st4(kp + 80 + 4 * fq, y2 * c + y1 * s); }
                }
                asm volatile("" ::: "memory"); }
    }
};
struct EpiMerge {
    bf16* MG; const bf16 *GA, *GB;
    __device__ __forceinline__ void operator()(const f32x4 (&acc)[2][2][4][2], const Unit& u, int wr, int wc, int fr, int fq) const {
        const bool which = u.pm >= T / 256; const int pm = u.pm - (which ? T / 256 : 0), pn = u.pn - (which ? D / 256 : 0); const bf16* Gt = (const bf16*)((const unsigned char*)GA + (which ? (size_t)((const unsigned char*)GB - (const unsigned char*)GA) : (size_t)0));
#pragma unroll
        for (int ai = 0; ai < 2; ++ai)
#pragma unroll
            for (int m = 0; m < 4; ++m)
#pragma unroll
                for (int bj = 0; bj < 2; ++bj) { const size_t off = (size_t)(pm * 256 + ai * 128 + wr * 64 + m * 16 + fr) * 1024 + pn * 256 + bj * 128 + wc * 32 + 8 * fq;
                    const v4u g = *(const v4u*)(Gt + off); f32x4 a = acc[ai][bj][m][0] * up4(g.x, g.y), b = acc[ai][bj][m][1] * up4(g.z, g.w);
                    if (which) { const v4u o = *(const v4u*)(MG + off); a += up4(o.x, o.y); b += up4(o.z, o.w); }
                    st8(MG + off, a, b); if (bj == 1) asm volatile("" ::: "memory"); }
    }
};
struct EpiX2 {
    const float* X; float* O;
    __device__ __forceinline__ void operator()(const f32x4 (&acc)[2][2][4][2], const Unit& u, int wr, int wc, int fr, int fq) const {
#pragma unroll
        for (int ai = 0; ai < 2; ++ai)
#pragma unroll
            for (int m = 0; m < 4; ++m)
#pragma unroll
                for (int bj = 0; bj < 2; ++bj)
#pragma unroll
                    for (int n = 0; n < 2; ++n) { const size_t off = (size_t)(u.pm * 256 + ai * 128 + wr * 64 + m * 16 + fr) * 1024 + u.pn * 256 + bj * 128 + wc * 32 + n * 16 + 4 * fq;
                        *(f32x4*)(O + off) = *(const f32x4*)(X + off) + acc[ai][bj][m][n]; if (n == 1 && bj == 1) asm volatile("" ::: "memory"); }
    }
};
struct EpiUp {
    bf16* H1;
    __device__ __forceinline__ void operator()(const f32x4 (&acc)[2][2][4][2], const Unit& u, int wr, int wc, int fr, int fq) const {
        const int pl = u.pn & 1;
#pragma unroll
        for (int ai = 0; ai < 2; ++ai)
#pragma unroll
            for (int m = 0; m < 4; ++m) { f32x4 a = acc[ai][0][m][0], b = acc[ai][0][m][1];
#pragma unroll
                for (int j = 0; j < 4; ++j) { a[j] = silu_(a[j]) * acc[ai][1][m][0][j]; b[j] = silu_(b[j]) * acc[ai][1][m][1][j]; }
                st8(H1 + (size_t)(u.pm * 256 + ai * 128 + wr * 64 + m * 16 + fr) * 256 + pl * 128 + wc * 32 + 8 * fq, a, b); }
    }
};
struct EpiDown {
    bf16 *Y0, *Y1; const int* LIST; const float* EW;
    __device__ __forceinline__ void operator()(const f32x4 (&acc)[2][2][4][2], const Unit& u, int wr, int wc, int fr, int fq) const {
        const int pl = u.pn & 3;
#pragma unroll
        for (int ai = 0; ai < 2; ++ai)
#pragma unroll
            for (int m = 0; m < 4; ++m) { const int r = ai * 128 + wr * 64 + m * 16 + fr;
                if (r < u.nvalid) { const int ent = LIST[u.lbase + r]; const float w = EW[ent];
                    const unsigned eo = (unsigned)(ent >> 1) * 1024u + (unsigned)(pl * 256 + wc * 32 + 8 * fq) + ((ent & 1) ? (unsigned)(((unsigned char*)Y1 - (unsigned char*)Y0) / 2) : 0u);
#pragma unroll
                    for (int bj = 0; bj < 2; ++bj) st8(Y0 + eo + bj * 128, acc[ai][bj][m][0] * w, acc[ai][bj][m][1] * w); }
                asm volatile("" ::: "memory"); }
    }
};
struct EpiProj {
    bf16* PR;
    __device__ __forceinline__ void operator()(const f32x4 (&acc)[2][2][4][2], const Unit& u, int wr, int wc, int fr, int fq) const {
#pragma unroll
        for (int ai = 0; ai < 2; ++ai)
#pragma unroll
            for (int m = 0; m < 4; ++m)
#pragma unroll
                for (int bj = 0; bj < 2; ++bj) st8(PR + (size_t)(u.pm * 256 + ai * 128 + wr * 64 + m * 16 + fr) * 1024 + u.pn * 256 + bj * 128 + wc * 32 + 8 * fq, acc[ai][bj][m][0], acc[ai][bj][m][1]);
    }
};
struct EpiFinal {
    float* O; const bf16* PR;
    __device__ __forceinline__ void operator()(const f32x4 (&acc)[2][2][4][2], const Unit& u, int wr, int wc, int fr, int fq) const {
#pragma unroll
        for (int ai = 0; ai < 2; ++ai)
#pragma unroll
            for (int m = 0; m < 4; ++m)
#pragma unroll
                for (int bj = 0; bj < 2; ++bj)
#pragma unroll
                    for (int n = 0; n < 2; ++n) { const size_t off = (size_t)(u.pm * 256 + ai * 128 + wr * 64 + m * 16 + fr) * 1024 + u.pn * 256 + bj * 128 + wc * 32 + n * 16 + 4 * fq;
                        const v2u pr = *(const v2u*)(PR + off); f32x4 g = acc[ai][bj][m][n];
#pragma unroll
                        for (int j = 0; j < 4; ++j) g[j] = sigm(g[j]);
                        *(f32x4*)(O + off) = *(const f32x4*)(O + off) + up4(pr.x, pr.y) * g; if (n == 1 && bj == 1) asm volatile("" ::: "memory"); }
    }
};
struct Frame {
    LAS unsigned char* lds; unsigned char* gl;
    volatile LAS unsigned* MISC; gu32* ctl;
    int tid, lane, wave, vcu, G;
    const float* in[27]; float* out; unsigned char* ws;
};
#define WSP(type, off) ((type*)(F.ws + (off)))
#define DOP(type, off) ((type*)((unsigned char*)F.out + (off)))
enum { I_X = 0, I_P, I_POS, I_LNMIX, I_WIN, I_HGLB, I_HGON, I_WOA, I_QAN, I_KVAN, I_WUQ, I_WUKV, I_QN, I_KN, I_WOB, I_WOUT, I_LNMOE, I_WRG, I_BRG, I_WRE, I_BRE, I_W1, I_W3, I_W2, I_LNPLE, I_WPG, I_WPP };

enum { M_WIN = 0, M_WOAB, M_WUQ, M_WUKV, M_WOUT, M_WPG, M_WPP, M_W13, M_W2T };
template <int MAT> struct MatInfo;
template <> struct MatInfo<M_WIN>  { static constexpr int K = 1024, NP = NIN; };
template <> struct MatInfo<M_WOAB> { static constexpr int K = 512,  NP = 2048; };
template <> struct MatInfo<M_WUQ>  { static constexpr int K = 256,  NP = 768; };
template <> struct MatInfo<M_WUKV> { static constexpr int K = 256,  NP = 1024; };
template <> struct MatInfo<M_WOUT> { static constexpr int K = 1024, NP = 1024; };
template <> struct MatInfo<M_WPG>  { static constexpr int K = 1024, NP = 1024; };
template <> struct MatInfo<M_WPP>  { static constexpr int K = 256,  NP = 1024; };
template <> struct MatInfo<M_W13>  { static constexpr int K = 1024, NP = NE * 512; };
template <> struct MatInfo<M_W2T>  { static constexpr int K = 256,  NP = NE * 1024; };
template <int MAT> __device__ __forceinline__ void conv_item(const Frame& F, int item, int lane) {
    constexpr int K = MatInfo<MAT>::K; constexpr int KB = K / 64;
    const int kb = item % KB, p = (item / KB) * 64 + lane;
    const float* src = nullptr; size_t ld = 0; const float* gain = nullptr; int kvalid = K; bf16* dst = nullptr;
    if constexpr (MAT == M_WIN) {
        const int pn = p >> 8; int col;
        if (pn < 8) { const int q = p & 255, bj = q >> 7, wc = (q >> 5) & 3, n = (q >> 4) & 1, fq = (q >> 2) & 3, j = q & 3; const int kind = 2 * bj + n;
            col = kind * 512 + (pn >> 1) * 128 + (pn & 1) * 64 + wc * 16 + fq * 4 + j; }
        else if (pn < 10) col = 2048 + perm8(p - 2048);
        else if (pn == 10) col = 2560 + perm8(p - 2560);
        else if (pn == 11) { const int l = perm8(p - 2816); col = l < 128 ? 2816 + l : (l < 160 ? 2944 + (l - 128) : -1); }
        else if (pn < 16) col = 2976 + perm8(p - 3072);
        else col = 4000 + perm8(p - 4096);
        if (col >= 0) src = F.in[I_WIN] + col; ld = DIN; gain = F.in[I_LNMIX]; dst = WSP(bf16, WS_WIN);
    } else if constexpr (MAT == M_WOAB) { { const float* sa = F.in[I_WOA]; const float* sb = F.in[I_WOB]; src = (const float*)((const unsigned char*)sa + ((p >> 10) ? (size_t)((const unsigned char*)sb - (const unsigned char*)sa) : (size_t)0)) + perm8(p & 1023); } ld = 1024; dst = WSP(bf16, WS_WOAB); }
    else if constexpr (MAT == M_WUQ) { src = F.in[I_WUQ] + perm8(p); ld = 768; gain = F.in[I_QAN]; dst = WSP(bf16, WS_WUQ); }
    else if constexpr (MAT == M_WUKV) { const int pn = p >> 8, q = p & 255, bj = q >> 7, wc = (q >> 5) & 3, n = (q >> 4) & 1, fq = (q >> 2) & 3, j = q & 3;
        const int head = (pn & 1) * 4 + wc, d = 32 * bj + 8 * fq + 4 * n + j; src = F.in[I_WUKV] + head * 128 + (pn >= 2 ? 64 : 0) + d; ld = 1024; gain = F.in[I_KVAN]; kvalid = 128; dst = WSP(bf16, WS_WUKV); }
    else if constexpr (MAT == M_WOUT) { src = F.in[I_WOUT] + p; ld = 1024; dst = WSP(bf16, WS_WOUT); }
    else if constexpr (MAT == M_WPG) { src = F.in[I_WPG] + p; ld = 1024; gain = F.in[I_LNPLE]; dst = WSP(bf16, WS_WPG); }
    else if constexpr (MAT == M_WPP) { src = F.in[I_WPP] + perm8(p); ld = 1024; dst = WSP(bf16, WS_WPP); }
    else if constexpr (MAT == M_W13) { const int e = p >> 9, q = p & 511, pl = q >> 8, bj = (q >> 7) & 1, r = q & 127;
        { const float* sa = F.in[I_W1]; const float* sb = F.in[I_W3]; src = (const float*)((const unsigned char*)sa + (bj ? (size_t)((const unsigned char*)sb - (const unsigned char*)sa) : (size_t)0)) + (size_t)e * 1024 * 256 + pl * 128 + perm8(r); } ld = 256; gain = F.in[I_LNMOE]; dst = WSP(bf16, WS_W13); }
    else { const int e = p >> 10, q = p & 1023; src = F.in[I_W2] + (size_t)e * 256 * 1024 + perm8(q); ld = 1024; dst = WSP(bf16, WS_W2T); }
#pragma unroll
    for (int k8 = 0; k8 < 8; ++k8) { const int k = kb * 64 + k8 * 8; float v[8];
#pragma unroll
        for (int i = 0; i < 8; ++i) v[i] = (src && (k + i) < kvalid) ? src[(size_t)(k + i) * ld] * (gain ? gain[k + i] : 1.0f) : 0.0f;
        v4u o; o.x = pk2(v[0], v[1]); o.y = pk2(v[2], v[3]); o.z = pk2(v[4], v[5]); o.w = pk2(v[6], v[7]);
        *(v4u*)(dst + (size_t)p * K + k) = o; }
}
template <int MAT> __device__ __forceinline__ void conv_mat(const Frame& F) {
    constexpr int NITEMS = (MatInfo<MAT>::NP / 64) * (MatInfo<MAT>::K / 64);
    const int gw = F.vcu * NWAVES + F.wave, NGW = F.G * NWAVES;
    for (int it = gw; it < NITEMS; it += NGW) conv_item<MAT>(F, it, F.lane);
}

__device__ __forceinline__ void p0_prologue(const Frame& F) {
    conv_mat<M_WIN>(F); conv_mat<M_WOAB>(F); conv_mat<M_WUQ>(F); conv_mat<M_WUKV>(F); conv_mat<M_WOUT>(F); conv_mat<M_WPG>(F); conv_mat<M_WPP>(F);
    const int gt = F.vcu * NTHR + F.tid, NGT = F.G * NTHR;
    for (int i = gt; i < 72 * 1024; i += NGT) { const int o = i >> 10, k = i & 1023; WSP(float, WS_WR)[i] = F.in[I_LNMOE][k] * (o < 8 ? F.in[I_WRG][k * 8 + o] : F.in[I_WRE][k * 64 + (o - 8)]); }
    for (int i = gt; i < 72; i += NGT) WSP(float, WS_BR)[i] = i < 8 ? F.in[I_BRG][i] : F.in[I_BRE][i - 8];
    for (int i = gt; i < 1024; i += NGT) { const int d = i >> 9, f = i & 511; const float a0 = F.in[I_HGLB][d * 1024 + f], a1 = F.in[I_HGLB][d * 1024 + 512 + f]; WSP(float, WS_LB)[i] = 1.0f / (1.0f + expf(a1 - a0)); }
    for (int i = gt; i < T * 16; i += NGT) { const int t = i >> 4, f = i & 15; const float pos = (float)((const int*)F.in[I_POS])[t]; const float inv = powf(10000.0f, -(float)f / 16.0f);
        const float ang = pos * inv; WSP(float, WS_ROPE)[t * 32 + f] = cosf(ang); WSP(float, WS_ROPE)[t * 32 + 16 + f] = sinf(ang); }
    const int gw = F.vcu * NWAVES + F.wave, NGW = F.G * NWAVES;
    for (int m = gw; m < T; m += NGW) {
        const float* xr = F.in[I_X] + (size_t)m * D + F.lane * 8; f32x4 v[4]; float ss = 0.f;
#pragma unroll
        for (int j = 0; j < 2; ++j) { v[2 * j] = *(const f32x4*)(xr + 512 * j); v[2 * j + 1] = *(const f32x4*)(xr + 512 * j + 4); ss += dot4(v[2 * j]) + dot4(v[2 * j + 1]); }
        const float rs = rsqrtf(wave_sum(ss) * (1.0f / D) + EPS);
#pragma unroll
        for (int j = 0; j < 2; ++j) st8(WSP(bf16, WS_ACT) + (size_t)m * D + F.lane * 8 + 512 * j, v[2 * j] * rs, v[2 * j + 1] * rs);
        if (F.lane < 32) { const float* pr = F.in[I_P] + (size_t)m * PLE + F.lane * 8; st8(WSP(bf16, WS_PB) + (size_t)m * PLE + F.lane * 8, *(const f32x4*)pr, *(const f32x4*)(pr + 4)); }
    }
}

__device__ __forceinline__ void oa_pass(const Frame& F) {
    const int gw = F.vcu * NWAVES + F.wave, NGW = F.G * NWAVES;
    const bf16* OFp = WSP(bf16, WS_ACT); const bf16* OBp = OFp + (size_t)T * 512; const bf16* OGp = WSP(bf16, WS_OG); bf16* OA = DOP(bf16, DO_OA);
    const int c0 = F.lane * 8; const f32x4 g0 = *(const f32x4*)(F.in[I_HGON] + (c0 & 127)), g1 = *(const f32x4*)(F.in[I_HGON] + (c0 & 127) + 4);
    for (int m = gw; m < T; m += NGW) {
        const size_t off = (size_t)m * 512 + c0;
        const v4u a = *(const v4u*)(OFp + off), b = *(const v4u*)(OBp + off), g = *(const v4u*)(OGp + off);
        f32x4 s0 = up4(a.x, a.y) + up4(b.x, b.y), s1 = up4(a.z, a.w) + up4(b.z, b.w);
        float ss = dot4(s0) + dot4(s1); ss += __shfl_xor(ss, 1); ss += __shfl_xor(ss, 2); ss += __shfl_xor(ss, 4); ss += __shfl_xor(ss, 8);
        const float rs = rsqrtf(ss * (1.0f / 128.0f) + EPS);
        st8(OA + off, s0 * rs * g0 * up4(g.x, g.y), s1 * rs * g1 * up4(g.z, g.w));
    }
}
__device__ __forceinline__ void x3_pass(const Frame& F) {
    const int gw = F.vcu * NWAVES + F.wave, NGW = F.G * NWAVES;
    const bf16* Y0 = WSP(bf16, WS_Y0); const bf16* Y1 = WSP(bf16, WS_Y1); bf16* HP = WSP(bf16, WS_ACT);
    for (int m = gw; m < T; m += NGW) {
        float* xr = F.out + (size_t)m * D + F.lane * 8; f32x4 v[4]; float ss = 0.f;
#pragma unroll
        for (int j = 0; j < 2; ++j) { const size_t o = (size_t)m * D + F.lane * 8 + 512 * j; const v4u a = *(const v4u*)(Y0 + o), b = *(const v4u*)(Y1 + o);
            v[2 * j] = *(const f32x4*)(xr + 512 * j) + up4(a.x, a.y) + up4(b.x, b.y); v[2 * j + 1] = *(const f32x4*)(xr + 512 * j + 4) + up4(a.z, a.w) + up4(b.z, b.w);
            *(f32x4*)(xr + 512 * j) = v[2 * j]; *(f32x4*)(xr + 512 * j + 4) = v[2 * j + 1]; ss += dot4(v[2 * j]) + dot4(v[2 * j + 1]); }
        const float rs = rsqrtf(wave_sum(ss) * (1.0f / D) + EPS);
#pragma unroll
        for (int j = 0; j < 2; ++j) st8(HP + (size_t)m * D + F.lane * 8 + 512 * j, v[2 * j] * rs, v[2 * j + 1] * rs);
    }
}
__device__ __forceinline__ void moe_build_table(const Frame& F) {
    LAS int* tab = (LAS int*)(F.lds + TAB_OFF);
    if (F.tid == 0) { int rt = 0;
        for (int e = 0; e < NE; ++e) { const int cnt = (int)__hip_atomic_load(F.ctl + CW_CNT + 64 * e, RLX_AGENT); const int nt = (cnt + 255) >> 8;
            for (int lt = 0; lt < nt; ++lt) { tab[16 + 4 * rt] = e; tab[16 + 4 * rt + 1] = e * T + 256 * lt; const int rem = cnt - 256 * lt; tab[16 + 4 * rt + 2] = rem < 256 ? rem : 256; ++rt; } }
        tab[0] = rt; }
    __syncthreads();
}
__device__ __forceinline__ void hgrn_naive(const Frame& F) {
    float* Qs = (float*)F.gl; float* Ks = Qs + 64 * 128; float* Vs = Ks + 64 * 128; float* Ps = Vs + 64 * 64; float* Os = Ps + 64 * 64;
    const int v = F.tid & 63, kq = F.tid >> 6;
    for (int item = blockIdx.x; item < NB * HGH * 2 * 2; item += F.G) {
        const int vh = item & 1, dir = (item >> 1) & 1, hh = (item >> 2) & 3, b = item >> 4;
        const bf16* Qd = DOP(bf16, dir ? DO_QB : DO_QF); const bf16* Kd = DOP(bf16, dir ? DO_KB : DO_KF); const bf16* Va = WSP(bf16, WS_VA);
        bf16* Od = WSP(bf16, WS_ACT) + (dir ? (size_t)T * 512 : 0);
        const float* ER = WSP(float, WS_EREF) + (size_t)dir * NCHUNK * 512; const float* EL = WSP(float, WS_ELAST) + (size_t)dir * NCHUNK * 512;
        float M[16];
#pragma unroll
        for (int i = 0; i < 16; ++i) M[i] = 0.f;
        for (int cc = 0; cc < 32; ++cc) {
            const int c = dir ? 31 - cc : cc, gc = b * 32 + c, t0 = gc * 64;
            __syncthreads();
            for (int idx = F.tid; idx < 64 * 128; idx += NTHR) { const int t = idx >> 7, ch = idx & 127; const size_t o = (size_t)(t0 + t) * 512 + hh * 128 + ch; Qs[idx] = bf2f(Qd[o]); Ks[idx] = bf2f(Kd[o]); }
            for (int idx = F.tid; idx < 64 * 64; idx += NTHR) { const int t = idx >> 6, vv = idx & 63; Vs[idx] = bf2f(Va[(size_t)(t0 + t) * 512 + hh * 128 + vh * 64 + vv]); Os[idx] = 0.f; }
            __syncthreads();
            for (int idx = F.tid; idx < 64 * 64; idx += NTHR) { const int t = idx >> 6, s = idx & 63; const bool ok = dir ? (s >= t) : (s <= t); float a = 0.f;
                if (ok) for (int ch = 0; ch < 128; ++ch) a += Qs[t * 128 + ch] * Ks[s * 128 + ch];
                Ps[idx] = a; }
            __syncthreads();
            for (int t = 0; t < 64; ++t) { float a = 0.f;
#pragma unroll
                for (int i = 0; i < 16; ++i) a += Qs[t * 128 + kq * 16 + i] * M[i];
#pragma unroll
                for (int s = 0; s < 8; ++s) a += Ps[t * 64 + kq * 8 + s] * Vs[(kq * 8 + s) * 64 + v];
                atomicAdd(&Os[t * 64 + v], a); }
            __syncthreads();
            for (int idx = F.tid; idx < 64 * 64; idx += NTHR) { const int t = idx >> 6, vv = idx & 63; Od[(size_t)(t0 + t) * 512 + hh * 128 + vh * 64 + vv] = (bf16)f2bf(Os[idx]); }
            const int cn = dir ? c - 1 : c + 1; const bool has = cc < 31;
#pragma unroll
            for (int i = 0; i < 16; ++i) { float u = 0.f; const int ch = kq * 16 + i;
                for (int t = 0; t < 64; ++t) u += Ks[t * 128 + ch] * Vs[t * 64 + v];
                const float d = has ? EL[(size_t)gc * 512 + hh * 128 + ch] * ER[(size_t)(b * 32 + cn) * 512 + hh * 128 + ch] : 0.f;
                M[i] = (M[i] + u) * d; }
        }
    }
    __syncthreads();
}
__device__ __forceinline__ void attn_naive(const Frame& F) {
    const bf16* QM = WSP(bf16, WS_QM); const bf16* KH = WSP(bf16, WS_KH); const bf16* VH = WSP(bf16, WS_VH); bf16* OM = DOP(bf16, DO_OM);
    const float* RT = WSP(float, WS_ROPE); const float* QN = F.in[I_QN];
    for (int item = blockIdx.x; item < NB * MH * 4; item += F.G) {
        const int qb = item & 3, h = (item >> 2) & 7, b = item >> 5; const int t = b * SEQ + qb * 512 + F.tid;
        float q[96]; float ss = 0.f;
#pragma unroll
        for (int c = 0; c < 12; ++c) { const v4u w = *(const v4u*)(QM + (size_t)t * 768 + h * 96 + c * 8);
            q[c * 8 + 0] = bflo(w.x); q[c * 8 + 1] = bfhi(w.x); q[c * 8 + 2] = bflo(w.y); q[c * 8 + 3] = bfhi(w.y); q[c * 8 + 4] = bflo(w.z); q[c * 8 + 5] = bfhi(w.z); q[c * 8 + 6] = bflo(w.w); q[c * 8 + 7] = bfhi(w.w); }
#pragma unroll
        for (int d = 0; d < 96; ++d) ss += q[d] * q[d];
        const float rs = rsqrtf(ss * (1.0f / 96.0f) + EPS) ;
#pragma unroll
        for (int d = 0; d < 96; ++d) q[d] = q[d] * rs * QN[d];
#pragma unroll
        for (int i = 0; i < 16; ++i) { const float c = RT[(size_t)t * 32 + i], s = RT[(size_t)t * 32 + 16 + i]; const float x1 = q[64 + i], x2 = q[80 + i]; q[64 + i] = x1 * c - x2 * s; q[80 + i] = x2 * c + x1 * s; }
        const float sc = 0.10206207261596577f;
        unsigned qp[48];
#pragma unroll
        for (int d = 0; d < 48; ++d) qp[d] = pk2(q[2 * d] * sc, q[2 * d + 1] * sc);
        float o[64]; float mx = -1e30f, l = 0.f;
#pragma unroll
        for (int d = 0; d < 64; ++d) o[d] = 0.f;
        for (int s = 0; s < SEQ; ++s) {
            const bf16* kp = KH + ((size_t)(b * SEQ + s) * 8 + h) * 96; float a = 0.f;
#pragma unroll
            for (int c = 0; c < 12; ++c) { const v4u w = *(const v4u*)(kp + c * 8);
                a = dot2bf(qp[c * 4 + 0], w.x, a); a = dot2bf(qp[c * 4 + 1], w.y, a); a = dot2bf(qp[c * 4 + 2], w.z, a); a = dot2bf(qp[c * 4 + 3], w.w, a);
                if (c & 1) asm volatile("" ::: "memory"); }
            const float mn = fmaxf(mx, a), al = __expf(mx - mn), p = __expf(a - mn); mx = mn; l = l * al + p;
            const bf16* vp = VH + ((size_t)(b * SEQ + s) * 8 + h) * 64;
#pragma unroll
            for (int c = 0; c < 8; ++c) { const v4u w = *(const v4u*)(vp + c * 8);
                o[c * 8 + 0] = o[c * 8 + 0] * al + p * bflo(w.x); o[c * 8 + 1] = o[c * 8 + 1] * al + p * bfhi(w.x); o[c * 8 + 2] = o[c * 8 + 2] * al + p * bflo(w.y); o[c * 8 + 3] = o[c * 8 + 3] * al + p * bfhi(w.y);
                o[c * 8 + 4] = o[c * 8 + 4] * al + p * bflo(w.z); o[c * 8 + 5] = o[c * 8 + 5] * al + p * bfhi(w.z); o[c * 8 + 6] = o[c * 8 + 6] * al + p * bflo(w.w); o[c * 8 + 7] = o[c * 8 + 7] * al + p * bfhi(w.w); if (c & 1) asm volatile("" ::: "memory"); }
        }
        const float il = 1.0f / l;
#pragma unroll
        for (int c = 0; c < 8; ++c) st8(OM + (size_t)t * 512 + h * 64 + c * 8, (f32x4){o[c * 8] * il, o[c * 8 + 1] * il, o[c * 8 + 2] * il, o[c * 8 + 3] * il}, (f32x4){o[c * 8 + 4] * il, o[c * 8 + 5] * il, o[c * 8 + 6] * il, o[c * 8 + 7] * il});
    }
}
__device__ __forceinline__ void route_naive(const Frame& F) {
    const int gw = F.vcu * NWAVES + F.wave, NGW = F.G * NWAVES; const float* WR = WSP(float, WS_WR); const float* BR = WSP(float, WS_BR);
    bf16* HM = WSP(bf16, WS_ACT); int* EIDX = WSP(int, WS_EIDX); float* EW = WSP(float, WS_EW); int* LIST = WSP(int, WS_LIST);
    for (int m = gw; m < T; m += NGW) {
        const float* xr = F.out + (size_t)m * D + F.lane * 8; f32x4 v[4]; float ss = 0.f;
#pragma unroll
        for (int j = 0; j < 2; ++j) { v[2 * j] = *(const f32x4*)(xr + 512 * j); v[2 * j + 1] = *(const f32x4*)(xr + 512 * j + 4); ss += dot4(v[2 * j]) + dot4(v[2 * j + 1]); }
        const float rs = rsqrtf(wave_sum(ss) * (1.0f / D) + EPS);
#pragma unroll
        for (int j = 0; j < 4; ++j) v[j] = v[j] * rs;
#pragma unroll
        for (int j = 0; j < 2; ++j) st8(HM + (size_t)m * D + F.lane * 8 + 512 * j, v[2 * j], v[2 * j + 1]);
        float gl = -1e30f, el = -1e30f;
        for (int o = 0; o < 72; ++o) { const float* wr_ = WR + (size_t)o * 1024 + F.lane * 8; float a = 0.f;
#pragma unroll
            for (int j = 0; j < 2; ++j) { const f32x4 w0 = *(const f32x4*)(wr_ + 512 * j), w1 = *(const f32x4*)(wr_ + 512 * j + 4);
                a += (v[2 * j][0] * w0[0] + v[2 * j][1] * w0[1]) + (v[2 * j][2] * w0[2] + v[2 * j][3] * w0[3]) + (v[2 * j + 1][0] * w1[0] + v[2 * j + 1][1] * w1[1]) + (v[2 * j + 1][2] * w1[2] + v[2 * j + 1][3] * w1[3]); }
            a = wave_sum(a) + BR[o];
            if (o < 8) { if (F.lane == o) gl = a; } else { if (F.lane == o - 8) el = a; } }
        float gm = gl; gm = fmaxf(gm, __shfl_xor(gm, 1)); gm = fmaxf(gm, __shfl_xor(gm, 2)); gm = fmaxf(gm, __shfl_xor(gm, 4)); gm = __shfl(gm, 0);
        const int gsel = __ffsll((unsigned long long)__ballot(F.lane < 8 && gl == gm)) - 1;
        float ge = F.lane < 8 ? __expf(gl - gm) : 0.f; ge += __shfl_xor(ge, 1); ge += __shfl_xor(ge, 2); ge += __shfl_xor(ge, 4); const float pg = 1.0f / __shfl(ge, 0);
        float c1 = (F.lane >> 3) == gsel ? el : -3e38f; float m1 = c1;
#pragma unroll
        for (int o = 1; o < 64; o <<= 1) m1 = fmaxf(m1, __shfl_xor(m1, o));
        const int i1 = __ffsll((unsigned long long)__ballot(c1 == m1)) - 1;
        float c2 = F.lane == i1 ? -3e38f : c1; float m2 = c2;
#pragma unroll
        for (int o = 1; o < 64; o <<= 1) m2 = fmaxf(m2, __shfl_xor(m2, o));
        const int i2 = __ffsll((unsigned long long)__ballot(c2 == m2)) - 1;
        const float e2 = __expf(m2 - m1), w0 = pg / (1.0f + e2), w1 = pg * e2 / (1.0f + e2);
        if (F.lane < 2) { const int e = F.lane ? i2 : i1; EIDX[m * 2 + F.lane] = e; EW[m * 2 + F.lane] = F.lane ? w1 : w0;
            const unsigned pos = __hip_atomic_fetch_add(F.ctl + CW_CNT + 64 * e, 1u, RLX_AGENT); LIST[(size_t)e * T + pos] = m * 2 + F.lane; }
    }
}
__device__ __forceinline__ void moe_naive(const Frame& F) {
    float* hs = (float*)F.gl; float* s1 = hs + 1024; float* h1 = s1 + 512;
    const bf16* HM = WSP(bf16, WS_ACT); const bf16* W13 = WSP(bf16, WS_W13); const bf16* W2T = WSP(bf16, WS_W2T); const int* EIDX = WSP(int, WS_EIDX); const float* EW = WSP(float, WS_EW);
    for (int a = blockIdx.x; a < T * 2; a += F.G) {
        const int t = a >> 1, slot = a & 1, e = EIDX[a]; const float w = EW[a];
        __syncthreads();
        hs[F.tid] = bf2f(HM[(size_t)t * 1024 + F.tid]); hs[F.tid + 512] = bf2f(HM[(size_t)t * 1024 + 512 + F.tid]);
        __syncthreads();
        { const int c = F.tid & 255, half = F.tid >> 8; const int p = 256 * (c >> 7) + 128 * half + iperm8(c & 127);
          const bf16* wr_ = W13 + ((size_t)e * 512 + p) * 1024; float acc = 0.f;
          for (int k = 0; k < 1024; k += 8) { const v4u wv = *(const v4u*)(wr_ + k);
              acc += hs[k] * bflo(wv.x) + hs[k + 1] * bfhi(wv.x) + hs[k + 2] * bflo(wv.y) + hs[k + 3] * bfhi(wv.y) + hs[k + 4] * bflo(wv.z) + hs[k + 5] * bfhi(wv.z) + hs[k + 6] * bflo(wv.w) + hs[k + 7] * bfhi(wv.w); }
          s1[F.tid] = acc; }
        __syncthreads();
        if (F.tid < 256) h1[F.tid] = bf2f(f2bf(silu_(s1[F.tid]) * s1[256 + F.tid]));
        __syncthreads();
        for (int pp = F.tid; pp < 1024; pp += NTHR) { const bf16* wr_ = W2T + ((size_t)e * 1024 + pp) * 256; float acc = 0.f;
            for (int k = 0; k < 256; k += 8) { const v4u wv = *(const v4u*)(wr_ + k);
                acc += h1[k] * bflo(wv.x) + h1[k + 1] * bfhi(wv.x) + h1[k + 2] * bflo(wv.y) + h1[k + 3] * bfhi(wv.y) + h1[k + 4] * bflo(wv.z) + h1[k + 5] * bfhi(wv.z) + h1[k + 6] * bflo(wv.w) + h1[k + 7] * bfhi(wv.w); }
            WSP(bf16, slot ? WS_Y1 : WS_Y0)[(size_t)t * 1024 + perm8(pp)] = (bf16)f2bf(acc * w); }
    }
    __syncthreads();
}
struct Args { const float* in[27]; float* out; unsigned char* ws; int ph_lo, ph_hi, use_bar, pad; };
constexpr int NPHASE = 11;
__device__ __forceinline__ void frame_init(Frame& F, const Args& args, unsigned char* lds) {
    F.lds = (LAS unsigned char*)lds; F.gl = lds;
    F.MISC = (volatile LAS unsigned*)(F.lds + MISC_OFF);
    F.tid = threadIdx.x; F.lane = F.tid & 63; F.wave = __builtin_amdgcn_readfirstlane(F.tid >> 6);
    F.G = gridDim.x; { const int bx = blockIdx.x; F.vcu = (F.G % 8 == 0) ? (bx % 8) * (F.G / 8) + bx / 8 : bx; }
    F.ws = args.ws; F.out = args.out; F.ctl = (gu32*)(args.ws + WS_CTL);
#pragma unroll
    for (int i = 0; i < 27; ++i) F.in[i] = args.in[i];
    for (int u = F.tid; u < 1024 / 4; u += NTHR) ((LAS unsigned*)(F.lds + LDSCTL_OFF))[u] = 0u;
    __syncthreads();
}
template <int PH> __device__ __forceinline__ void run_phase(const Frame& F) {
    if constexpr (PH == 0) { p0_prologue(F); }
    if constexpr (PH == 1) {
        Gemm g{WSP(bf16, WS_ACT), WSP(bf16, WS_WIN), 1024, nullptr}; StaticOrder S; S.init(T, NIN, F.G, (int)blockIdx.x);
        EpiIn E{F.ws, (unsigned char*)F.out};
        GEMM_PHASE(EpiIn, StaticOrder, g, S, E);
    }
    if constexpr (PH == 2) {
        { Gemm g{WSP(bf16, WS_CQ), WSP(bf16, WS_WUQ), 256, nullptr}; StaticOrder S; S.init(T, 768, F.G, (int)blockIdx.x); EpiQ E{WSP(bf16, WS_QM), WSP(float, WS_CQSS)}; GEMM_PHASE(EpiQ, StaticOrder, g, S, E); }
        { Gemm g{WSP(bf16, WS_CKVR), WSP(bf16, WS_WUKV), 256, nullptr}; StaticOrder S; S.init(T, 1024, F.G, (int)blockIdx.x);
          EpiKV E{WSP(bf16, WS_KH), WSP(bf16, WS_VH), WSP(float, WS_CKVSS), WSP(float, WS_KR), WSP(float, WS_ROPE), F.in[I_KN]}; GEMM_PHASE(EpiKV, StaticOrder, g, S, E); }
        HGRN_PHASE(F);
    }
    if constexpr (PH == 3) { oa_pass(F); ATTN_PHASE(F); }
    if constexpr (PH == 4) {
        Gemm g{DOP(bf16, DO_OA), WSP(bf16, WS_WOAB), 512, nullptr}; PairOrder S; S.init(F.G, (int)blockIdx.x); EpiMerge E{WSP(bf16, WS_ACT), WSP(bf16, WS_GA), WSP(bf16, WS_GB)};
        GEMM_PHASE(EpiMerge, PairOrder, g, S, E);
    }
    if constexpr (PH == 5) {
        Gemm g{WSP(bf16, WS_ACT), WSP(bf16, WS_WOUT), 1024, nullptr}; StaticOrder S; S.init(T, D, F.G, (int)blockIdx.x); EpiX2 E{F.in[I_X], F.out};
        GEMM_PHASE(EpiX2, StaticOrder, g, S, E);
    }
    if constexpr (PH == 6) { ROUTE_PHASE(F); conv_mat<M_W13>(F); conv_mat<M_W2T>(F); }
#if NAIVE_MOE
    if constexpr (PH == 7) { moe_naive(F); }

#else
    if constexpr (PH == 7) {
        moe_build_table(F);
        Gemm g{WSP(bf16, WS_ACT), WSP(bf16, WS_W13), 1024, WSP(int, WS_LIST)}; MoeOrder S{(const LAS int*)(F.lds + TAB_OFF), 2, F.G, (int)blockIdx.x}; EpiUp E{WSP(bf16, WS_H1)};
        GEMM_PHASE_GATHER(EpiUp, MoeOrder, g, S, E);
    }
    if constexpr (PH == 8) {
        moe_build_table(F);
        Gemm g{WSP(bf16, WS_H1), WSP(bf16, WS_W2T), 256, nullptr}; MoeOrder S{(const LAS int*)(F.lds + TAB_OFF), 4, F.G, (int)blockIdx.x}; EpiDown E{WSP(bf16, WS_Y0), WSP(bf16, WS_Y1), WSP(int, WS_LIST), WSP(float, WS_EW)};
        GEMM_PHASE(EpiDown, MoeOrder, g, S, E);
    }
#endif
    if constexpr (PH == 9) {
        Gemm g{WSP(bf16, WS_PB), WSP(bf16, WS_WPP), 256, nullptr}; StaticOrder S; S.init(T, D, F.G, (int)blockIdx.x); EpiProj E{WSP(bf16, WS_PROJ)};
        GEMM_PHASE(EpiProj, StaticOrder, g, S, E);
        x3_pass(F);
    }
    if constexpr (PH == 10) {
        Gemm g{WSP(bf16, WS_ACT), WSP(bf16, WS_WPG), 1024, nullptr}; StaticOrder S; S.init(T, D, F.G, (int)blockIdx.x); EpiFinal E{F.out, WSP(bf16, WS_PROJ)};
        GEMM_PHASE(EpiFinal, StaticOrder, g, S, E);
    }
}

template <int PH> __global__ void __launch_bounds__(NTHR, 2) phase_kernel(Args args) {
    extern __shared__ __attribute__((aligned(16))) unsigned char lds[];
    Frame F; frame_init(F, args, lds);
    run_phase<PH>(F);
}
#if N_LAUNCHES == 1
__global__ void __launch_bounds__(NTHR, 2) mega(Args args) {
    extern __shared__ __attribute__((aligned(16))) unsigned char lds[];
    Frame F; frame_init(F, args, lds);
    XcdBarrier bar = xcd_barrier_post((unsigned*)(F.ctl + CW_BAR), F.MISC + 8);
    run_phase<0>(F); xcd_barrier(bar);
    run_phase<1>(F); xcd_barrier(bar);
    run_phase<2>(F); xcd_barrier(bar);
    run_phase<3>(F); xcd_barrier(bar);
    run_phase<4>(F); xcd_barrier(bar);
    run_phase<5>(F); xcd_barrier(bar);
    run_phase<6>(F); xcd_barrier(bar);
    run_phase<7>(F); xcd_barrier(bar);
    run_phase<8>(F); xcd_barrier(bar);
    run_phase<9>(F); xcd_barrier(bar);
    run_phase<10>(F);
}
#endif
extern "C" void kernel_launch(void* const* d_in, const int* in_sizes, int n_in, void* d_out, int out_size, void* d_ws, size_t ws_size, hipStream_t stream) {
    static int grid = 0;
    if (grid == 0) {
        if (n_in != 27 || in_sizes[0] != T * D || out_size != T * D || ws_size < WS_END) { fprintf(stderr, "kernel_launch: unexpected shapes (n_in %d, in0 %d, out %d, ws %zu)\n", n_in, n_in > 0 ? in_sizes[0] : -1, out_size, ws_size); grid = -1; return; }
        int dev = 0, cus = 0;
        if (hipGetDevice(&dev) != hipSuccess || hipDeviceGetAttribute(&cus, hipDeviceAttributeMultiprocessorCount, dev) != hipSuccess) { grid = -1; return; }
#if N_LAUNCHES == 1
        if (hipFuncSetAttribute((const void*)mega, hipFuncAttributeMaxDynamicSharedMemorySize, LDS_BYTES) != hipSuccess) { fprintf(stderr, "kernel_launch: hipFuncSetAttribute failed\n"); grid = -1; return; }
#else
#define SETATTR(k) if (hipFuncSetAttribute((const void*)phase_kernel<k>, hipFuncAttributeMaxDynamicSharedMemorySize, LDS_BYTES) != hipSuccess) { fprintf(stderr, "kernel_launch: hipFuncSetAttribute failed\n"); grid = -1; return; }
        SETATTR(0) SETATTR(1) SETATTR(2) SETATTR(3) SETATTR(4) SETATTR(5) SETATTR(6) SETATTR(7) SETATTR(8) SETATTR(9) SETATTR(10)
#endif
        grid = cus;
    }
    if (grid < 0) return;
    (void)hipMemsetAsync((char*)d_ws + WS_CTL, 0, CTL_ZERO_BYTES, stream);
    Args a{};
    for (int i = 0; i < 27; ++i) a.in[i] = (const float*)d_in[i];
    a.out = (float*)d_out; a.ws = (unsigned char*)d_ws;
#if N_LAUNCHES == 1
    a.ph_lo = 0; a.ph_hi = NPHASE; a.use_bar = 1;
    hipLaunchKernelGGL(mega, dim3(grid), dim3(NTHR), LDS_BYTES, stream, a);
#else
#define LAUNCH_PH(k) hipLaunchKernelGGL(phase_kernel<k>, dim3(grid), dim3(NTHR), LDS_BYTES, stream, a)
#ifndef LAST_PHASE
#define LAST_PHASE 10
#endif
    LAUNCH_PH(0); LAUNCH_PH(1); LAUNCH_PH(2); LAUNCH_PH(3); LAUNCH_PH(4); LAUNCH_PH(5);
    if (LAST_PHASE >= 6) { LAUNCH_PH(6); } if (LAST_PHASE >= 7) { LAUNCH_PH(7); } if (LAST_PHASE >= 8) { LAUNCH_PH(8); } if (LAST_PHASE >= 9) { LAUNCH_PH(9); } if (LAST_PHASE >= 10) { LAUNCH_PH(10); }
#endif
    const hipError_t le = hipPeekAtLastError();
    if (le != hipSuccess) fprintf(stderr, "kernel_launch: launch failed: %s\n", hipGetErrorName(le));
}
```

```cpp
#include <hip/hip_runtime.h>
#include <cstdio>
#include <cstdint>

#define GAS __attribute__((address_space(1)))
#define LAS __attribute__((address_space(3)))
typedef unsigned short bf16;
typedef unsigned v4u __attribute__((ext_vector_type(4)));
typedef unsigned v2u __attribute__((ext_vector_type(2)));
typedef float f32x4 __attribute__((ext_vector_type(4)));
typedef float f32x2 __attribute__((ext_vector_type(2)));
typedef short bf16x8 __attribute__((ext_vector_type(8)));
typedef GAS unsigned gu32;
#define RLX_AGENT __ATOMIC_RELAXED, __HIP_MEMORY_SCOPE_AGENT
#define LDS_WAIT() asm volatile("s_waitcnt lgkmcnt(0)" ::: "memory")
#define VM_WAIT() asm volatile("s_waitcnt vmcnt(0)" ::: "memory")

constexpr int NB = 16, SEQ = 2048, T = NB * SEQ, D = 1024;
constexpr int HGH = 4, HGK = 128, HGV = 128, HGF = 512, CHUNK = 64, NCHUNK = T / CHUNK;
constexpr int MH = 8, NOPE = 64, ROPE = 32, QK = 96, VD = 64, QR = 256, KVR = 128;
constexpr int NG = 8, EPG = 8, NE = 64, DE = 256, PLE = 256;
constexpr int DIN = 5024, NIN = 5120;
constexpr float EPS = 1e-6f;
constexpr int NWAVES = 8, NTHR = 512;

__device__ __forceinline__ unsigned f2bf(float f) { unsigned u = __builtin_bit_cast(unsigned, f); return (u + 0x7fffu + ((u >> 16) & 1u)) >> 16; }
__device__ __forceinline__ unsigned pk2(float lo, float hi) { return f2bf(lo) | (f2bf(hi) << 16); }
__device__ __forceinline__ float bf2f(unsigned b) { return __builtin_bit_cast(float, b << 16); }
__device__ __forceinline__ float bflo(unsigned w) { return __builtin_bit_cast(float, w << 16); }
__device__ __forceinline__ float bfhi(unsigned w) { return __builtin_bit_cast(float, w & 0xffff0000u); }
__device__ __forceinline__ float sigm(float x) { return 1.0f / (1.0f + __expf(-x)); }
__device__ __forceinline__ float silu_(float x) { return x / (1.0f + __expf(-x)); }
__device__ __forceinline__ float wave_sum(float v) {
#pragma unroll
    for (int o = 1; o < 64; o <<= 1) v += __shfl_xor(v, o);
    return v;
}
__host__ __device__ __forceinline__ int perm8(int p) { const int r = p & 31, n = r >> 4, fq = (r >> 2) & 3, j = r & 3; return (p & ~31) + 8 * fq + 4 * n + j; }
__host__ __device__ __forceinline__ int iperm8(int l) { const int r = l & 31, fq = r >> 3, n = (r >> 2) & 1, j = r & 3; return (l & ~31) + 16 * n + 4 * fq + j; }

constexpr size_t MiB = 1u << 20;
constexpr size_t WS_CTL = 0, CTL_ZERO_BYTES = 1 * MiB;
constexpr size_t WS_LB = 1 * MiB;
constexpr size_t WS_WR = 1 * MiB + 65536;
constexpr size_t WS_BR = 1 * MiB + 65536 + 72 * 1024 * 4;
constexpr size_t WS_CQSS = 2 * MiB;
constexpr size_t WS_CKVSS = 2 * MiB + 512 * 1024;
constexpr size_t WS_ROPE = 4 * MiB;
constexpr size_t WS_EREF = 8 * MiB, WS_ELAST = 10 * MiB;
constexpr size_t WS_EIDX = 12 * MiB;
constexpr size_t WS_EW = 12 * MiB + 512 * 1024;
constexpr size_t WS_KR = 13 * MiB;
constexpr size_t WS_LIST = 4 * MiB;
constexpr size_t WS_WIN = 17 * MiB, WS_WOAB = 27 * MiB, WS_WUQ = 29 * MiB, WS_WUKV = 29 * MiB + 512 * 1024, WS_WOUT = 30 * MiB, WS_WPG = 32 * MiB, WS_WPP = 34 * MiB;
constexpr size_t WS_ACT = 36 * MiB;
constexpr size_t WS_VA = 100 * MiB, WS_OG = 132 * MiB, WS_CQ = 164 * MiB, WS_CKVR = 180 * MiB, WS_GA = 196 * MiB, WS_GB = 260 * MiB;
constexpr size_t WS_QM = 324 * MiB, WS_KH = 372 * MiB, WS_VH = 420 * MiB, WS_PB = 452 * MiB, WS_END = 468 * MiB;
constexpr size_t WS_W13 = 196 * MiB, WS_W2T = 260 * MiB;
constexpr size_t WS_H1 = 324 * MiB;
constexpr size_t WS_Y0 = 100 * MiB, WS_Y1 = 372 * MiB;
constexpr size_t WS_PROJ = 292 * MiB;
constexpr size_t DO_QF = 0, DO_KF = 32 * MiB, DO_QB = 64 * MiB, DO_KB = 96 * MiB, DO_OA = 0, DO_OM = 32 * MiB;
constexpr int CW_TMO = 0, CW_CODE = 1, CW_BAR = 4096, CW_CNT = 8192  ;
constexpr int MAXROWT = 320;
constexpr int RING_BYTES = 131072, LDSCTL_OFF = RING_BYTES, MISC_OFF = LDSCTL_OFF + 320, TAB_OFF = RING_BYTES + 1024, LDS_BYTES = 147456;
#define N_LAUNCHES 1
#define NAIVE_MOE 0
#define GEMM_PHASE(EPI, SCHED, g, S, E) gemm_fast<EPI, SCHED, false>(F.lds, g, S, E)
#define GEMM_PHASE_GATHER(EPI, SCHED, g, S, E) gemm_fast<EPI, SCHED, true>(F.lds, g, S, E)
#define HGRN_PHASE(F) hgrn_fast(F)
#define ATTN_PHASE(F) attn_fast(F)
#define ROUTE_PHASE(F) route_naive(F)
#define XB_TMO      128
#define XB_XCNT(j)  (256  + 64 * (j))
#define XB_XSUB(j)  (1280 + 64 * (j))
#define XB_XGEN(j)  (2304 + 64 * (j))
#define XB_TOP      3328
#define XB_TOPGEN   3392
#define XCD_BAR_WORDS 3456
#define XB_SPIN_CAP (1u << 18)

__device__ __forceinline__ unsigned xb_ld(unsigned* p)              { return __hip_atomic_load(p, __ATOMIC_RELAXED, __HIP_MEMORY_SCOPE_AGENT); }
__device__ __forceinline__ unsigned xb_add(unsigned* p, unsigned v) { return __hip_atomic_fetch_add(p, v, __ATOMIC_RELAXED, __HIP_MEMORY_SCOPE_AGENT); }
__device__ __forceinline__ unsigned xb_xcc_id() { return (unsigned)__builtin_amdgcn_s_getreg((3 << 11) | 20) & 0xFu; }
#define XB_SPIN(cond, bar) do { unsigned _sp = 0; while (cond) { __builtin_amdgcn_s_sleep(1); \
    if ((++_sp & 255u) == 0u) { if (xb_ld(&(bar)[XB_TMO])) break; if (_sp > XB_SPIN_CAP) { atomicAdd(&(bar)[XB_TMO], 1u); break; } } } } while (0)

struct XcdBarrier {
    unsigned* bar; unsigned x;
    volatile LAS unsigned* st;
};

__device__ __forceinline__ XcdBarrier xcd_barrier_post(unsigned* bar, volatile LAS unsigned* st) {
    XcdBarrier b; b.bar = bar; b.x = xb_xcc_id(); b.st = st;
    if (threadIdx.x == 0) (void)xb_add(&bar[XB_XCNT(b.x)], 1u);
    return b;
}
__device__ __forceinline__ void xcd_barrier_complete(unsigned* bar, unsigned x, unsigned& nloc, unsigned& nx) {
    const unsigned G = gridDim.x * gridDim.y * gridDim.z;
    unsigned sum, cnt, mine, sp = 0u;
    for (;;) {
        sum = 0u; cnt = 0u; mine = 0u;
#pragma unroll
        for (unsigned j = 0; j < 16; ++j) { const unsigned c = xb_ld(&bar[XB_XCNT(j)]); sum += c; cnt += (c > 0u) ? 1u : 0u; mine = (j == x) ? c : mine; }
        if (sum == G) break;
        __builtin_amdgcn_s_sleep(1);
        if ((++sp & 255u) == 0u) { if (xb_ld(&bar[XB_TMO])) break; if (sp > XB_SPIN_CAP) { atomicAdd(&bar[XB_TMO], 1u); break; } }
    }
    nloc = mine > 0u ? mine : 1u; nx = cnt > 0u ? cnt : 1u;
}

__device__ __forceinline__ void xcd_barrier(const XcdBarrier& b) {
    asm volatile("s_waitcnt vmcnt(0)" ::: "memory");
    __syncthreads();
    if (threadIdx.x == 0) {
        unsigned* bar = b.bar;
        __builtin_amdgcn_s_waitcnt(0);
        unsigned nloc = b.st[0], nx = b.st[1];
        if (nloc == 0u) { xcd_barrier_complete(bar, b.x, nloc, nx); b.st[0] = nloc; b.st[1] = nx; }
        const unsigned old = xb_add(&bar[XB_XSUB(b.x)], 1u);
        const unsigned gen = old / nloc;
        if (old + 1u == (gen + 1u) * nloc) {
            __builtin_amdgcn_fence(__ATOMIC_RELEASE, "agent");
            asm volatile("s_waitcnt vmcnt(0)" ::: "memory");
            const unsigned og = xb_add(&bar[XB_TOP], 1u);
            const unsigned tg = og / nx;
            if (og + 1u == (tg + 1u) * nx) xb_add(&bar[XB_TOPGEN], 1u);
            else XB_SPIN(xb_ld(&bar[XB_TOPGEN]) == tg, bar);
            __builtin_amdgcn_fence(__ATOMIC_ACQUIRE, "agent");
            xb_add(&bar[XB_XGEN(b.x)], 1u);
            asm volatile("s_waitcnt vmcnt(0)" ::: "memory");
        } else {
            XB_SPIN(xb_ld(&bar[XB_XGEN(b.x)]) == gen, bar);
            __builtin_amdgcn_fence(__ATOMIC_ACQUIRE, "agent");
            asm volatile("s_waitcnt vmcnt(0)" ::: "memory");
        }
    }
    __syncthreads();
}
struct Unit { int pm, pn, lbase, nvalid; };
struct Gemm { const bf16* A; const bf16* Bt; int K; const int* list; };
typedef __bf16 bf16x2_t __attribute__((ext_vector_type(2)));
__device__ __forceinline__ float dot2bf(unsigned a, unsigned b, float c) { return __builtin_amdgcn_fdot2_f32_bf16(__builtin_bit_cast(bf16x2_t, a), __builtin_bit_cast(bf16x2_t, b), c, false); }

constexpr int NXCD = 8, WGM = 8;
struct StaticOrder {
    int nM, nN, nwg, G, c;
    __device__ void init(int M, int N, int G_, int c_) { nM = M / 256; nN = N / 256; nwg = nM * nN; G = G_; c = c_; }
    __device__ __forceinline__ bool next(int i, Unit& u) const {
        const long L = (long)i * G + c; if (L >= nwg) return false;
        int wgid = (int)L; { const int q = nwg / NXCD, r = nwg % NXCD, xcd = wgid % NXCD, off = wgid / NXCD; wgid = (xcd < r ? xcd * (q + 1) : r * (q + 1) + (xcd - r) * q) + off; }
        const int nig = WGM * nN, gid = wgid / nig, fm = gid * WGM, gsz = (nM - fm) < WGM ? (nM - fm) : WGM;
        u.pm = fm + ((wgid % nig) % gsz); u.pn = (wgid % nig) / gsz; u.lbase = 0; u.nvalid = 256; return true;
    }
};
struct PairOrder {
    StaticOrder so;
    __device__ void init(int G_, int c_) { so.init(T, D, G_, c_); }
    __device__ __forceinline__ bool next(int i, Unit& u) const { if (!so.next(i >> 1, u)) return false; if (i & 1) { u.pm += T / 256; u.pn += D / 256; } return true; }
};
struct MoeOrder {
    const LAS int* tab; int npn, G, c;
    __device__ __forceinline__ bool next(int i, Unit& u) const {
        const int L = i * G + c; const int nt = tab[0]; if (L >= nt * npn) return false;
        const int rt = L / npn, pl = L - rt * npn; const int e = tab[16 + 4 * rt];
        u.pm = rt; u.pn = e * npn + pl; u.lbase = tab[16 + 4 * rt + 1]; u.nvalid = tab[16 + 4 * rt + 2]; return true;
    }
};

template <class Epi, class Sched>
__device__ __forceinline__ void gemm_ref(const Gemm g, const Sched& S, const Epi& E) {
    const int tid = threadIdx.x, wid = tid >> 6, lane = tid & 63, wr = wid >> 2, wc = wid & 3, fr = lane & 15, fq = lane >> 4;
    const int K = g.K; Unit u;
    for (int i = 0; S.next(i, u); ++i) {
        f32x4 acc[2][2][4][2];
#pragma unroll
        for (int a = 0; a < 2; ++a)
#pragma unroll
            for (int b = 0; b < 2; ++b)
#pragma unroll
                for (int m = 0; m < 4; ++m)
#pragma unroll
                    for (int n = 0; n < 2; ++n) acc[a][b][m][n] = (f32x4){0.f, 0.f, 0.f, 0.f};
        unsigned ar[2][4];
#pragma unroll
        for (int ai = 0; ai < 2; ++ai)
#pragma unroll
            for (int m = 0; m < 4; ++m) { const int r = ai * 128 + wr * 64 + m * 16 + fr;
                if (g.list) { const int rr = r < u.nvalid ? r : u.nvalid - 1; ar[ai][m] = (unsigned)(g.list[u.lbase + rr] >> 1) * (unsigned)K; }
                else ar[ai][m] = (unsigned)(u.pm * 256 + r) * (unsigned)K; }
        const unsigned bb = (unsigned)(u.pn * 256 + wc * 32 + 4 * fq) * (unsigned)K;
#pragma unroll 1
        for (int k0 = 0; k0 < K; k0 += 8) {
#pragma unroll
            for (int bj = 0; bj < 2; ++bj)
#pragma unroll
                for (int n = 0; n < 2; ++n) {
                    v4u bw[4];
#pragma unroll
                    for (int j = 0; j < 4; ++j) bw[j] = *(const v4u*)(g.Bt + (bb + (unsigned)(bj * 128 + n * 16 + j) * (unsigned)K + (unsigned)k0));
#pragma unroll
                    for (int ai = 0; ai < 2; ++ai)
#pragma unroll
                        for (int m = 0; m < 4; ++m) { const v4u aw = *(const v4u*)(g.A + (ar[ai][m] + (unsigned)k0));
#pragma unroll
                            for (int j = 0; j < 4; ++j) { float c = acc[ai][bj][m][n][j];
                                c = dot2bf(aw.x, bw[j].x, c); c = dot2bf(aw.y, bw[j].y, c); c = dot2bf(aw.z, bw[j].z, c); c = dot2bf(aw.w, bw[j].w, c);
                                acc[ai][bj][m][n][j] = c; }
                            asm volatile("" ::: "memory"); }
                }
        }
        E(acc, u, wr, wc, fr, fq);
    }
}
constexpr int BM = 256, BK = 64, HALF = 128, HTB = HALF * BK * 2, STAGE_BYTES = 8 * HTB;
__host__ __device__ __forceinline__ int lds_byte(int r, int c) { const int st = (r >> 4) * 2 + (c >> 5), rr = r & 15, cc = c & 31, ob = rr * 64 + cc * 2; return st * 1024 + (ob ^ (((ob >> 9) & 1) << 5)); }
__host__ __device__ __forceinline__ void stage_rc(int b, int& R, int& C) { const int st = b / 1024, sb = b % 1024, swz = sb ^ (((sb >> 9) & 1) << 5); R = (st >> 1) * 16 + swz / 64; C = (st & 1) * 32 + (swz % 64) / 2; }
template <class Epi, class Sched, bool GATHER = false, bool ALIGN_EPI = true, bool SP2 = true>
__device__ __forceinline__ void gemm_fast(LAS unsigned char* lds, const Gemm g, const Sched& S, const Epi& E) {
    int tid_ = threadIdx.x; asm volatile("" : "+v"(tid_));
    const int tid = tid_, wid = __builtin_amdgcn_readfirstlane(tid >> 6), lane = tid & 63, wr = wid >> 2, wc = wid & 3, fr = lane & 15, fq = lane >> 4;
    const int K = g.K, nt = K / BK;
    unsigned v0[2], v1[2], nv0[2], nv1[2], voffB[2]; int sR[2], sC[2];
#pragma unroll
    for (int i = 0; i < 2; ++i) { stage_rc(tid * 16 + i * 8192, sR[i], sC[i]); voffB[i] = (unsigned)(sR[i] * K + sC[i]) * 2u; }
#define PG8_AOFF(u, o0, o1) do { _Pragma("unroll") for (int _i = 0; _i < 2; ++_i) { \
        if constexpr (GATHER) { const int r0_ = sR[_i] < (u).nvalid ? sR[_i] : (u).nvalid - 1, r1_ = (128 + sR[_i]) < (u).nvalid ? 128 + sR[_i] : (u).nvalid - 1; \
            o0[_i] = ((unsigned)(g.list[(u).lbase + r0_] >> 1) * (unsigned)K + (unsigned)sC[_i]) * 2u; o1[_i] = ((unsigned)(g.list[(u).lbase + r1_] >> 1) * (unsigned)K + (unsigned)sC[_i]) * 2u; } \
        else { o0[_i] = (unsigned)(sR[_i] * K + sC[_i]) * 2u; o1[_i] = o0[_i] + (unsigned)(HALF * K * 2); } } } while (0)
    const size_t kstep = (size_t)(BK * 2);
    const size_t hstep = (size_t)HALF * K * 2;
    const size_t tstep = 2 * hstep;
    const unsigned ldsw = (unsigned)wid * 1024u;
    const int aoff = lds_byte(wr * 64 + fr, fq * 8), boff = lds_byte(wc * 32 + fr, fq * 8);
#define PG8_SA(b, h) (((b) * 2 + (h)) * HTB)
#define PG8_SB(b, h) ((4 + (b) * 2 + (h)) * HTB)
#define PG8_STAGE(bufoff, gbase, voff) do { _Pragma("unroll") for (int _i = 0; _i < 2; ++_i) \
        __builtin_amdgcn_global_load_lds((const unsigned*)((const char*)(gbase) + (voff)[_i]), (LAS unsigned*)(lds + (bufoff) + ldsw + _i * 8192), 16, 0, 0); } while (0)
#define PG8_LDA(dst, b, h) do { _Pragma("unroll") for (int m = 0; m < 4; ++m) _Pragma("unroll") for (int k = 0; k < 2; ++k) dst[m][k] = *(const LAS bf16x8*)(lds + PG8_SA(b, h) + aoff + m * 2048 + k * 1024); } while (0)
#define PG8_LDB(dst, b, h) do { _Pragma("unroll") for (int n = 0; n < 2; ++n) _Pragma("unroll") for (int k = 0; k < 2; ++k) dst[n][k] = *(const LAS bf16x8*)(lds + PG8_SB(b, h) + boff + n * 2048 + k * 1024); } while (0)
#define PG8_MMA(ai, bj, At, Bt) do { __builtin_amdgcn_s_setprio(1); _Pragma("unroll") for (int m = 0; m < 4; ++m) _Pragma("unroll") for (int n = 0; n < 2; ++n) _Pragma("unroll") for (int k = 0; k < 2; ++k) \
        acc[ai][bj][m][n] = __builtin_amdgcn_mfma_f32_16x16x32_bf16(Bt[n][k], At[m][k], acc[ai][bj][m][n], 0, 0, 0); __builtin_amdgcn_s_setprio(0); } while (0)
#define PG8_WAIT_V(n) asm volatile("s_waitcnt vmcnt(" #n ")" ::: "memory")
#define PG8_WAIT_L(n) asm volatile("s_waitcnt lgkmcnt(" #n ")" ::: "memory")
#define PG8_BAR __builtin_amdgcn_s_barrier()
#define PG8_SCHED __builtin_amdgcn_sched_barrier(0)
    Unit cur, nxt; int ui = 0;
    if (!S.next(0, cur)) return;
    f32x4 acc[2][2][4][2];
#pragma unroll
    for (int a = 0; a < 2; ++a)
#pragma unroll
        for (int b = 0; b < 2; ++b)
#pragma unroll
            for (int m = 0; m < 4; ++m)
#pragma unroll
                for (int n = 0; n < 2; ++n) acc[a][b][m][n] = (f32x4){0.f, 0.f, 0.f, 0.f};
    bf16x8 At[4][2], B0[2][2], B1[2][2];
    const char* cA = (const char*)g.A + (GATHER ? (size_t)0 : (size_t)cur.pm * tstep); const char* cB = (const char*)g.Bt + (size_t)cur.pn * tstep;
    PG8_AOFF(cur, v0, v1);
    if constexpr (SP2) {
        PG8_STAGE(PG8_SB(0, 0), cB, voffB); PG8_STAGE(PG8_SB(0, 1), cB + hstep, voffB); PG8_STAGE(PG8_SA(0, 0), cA, v0); PG8_STAGE(PG8_SA(0, 1), cA, v1);
        if (wr == 1) PG8_BAR;
        PG8_WAIT_V(2); PG8_BAR;
        PG8_STAGE(PG8_SB(1, 0), cB + kstep, voffB); PG8_STAGE(PG8_SA(1, 0), cA + kstep, v0); PG8_STAGE(PG8_SB(1, 1), cB + hstep + kstep, voffB);
        PG8_WAIT_V(6); PG8_BAR;
    } else {
        PG8_STAGE(PG8_SB(0, 0), cB, voffB); PG8_STAGE(PG8_SA(0, 0), cA, v0); PG8_STAGE(PG8_SB(0, 1), cB + hstep, voffB); PG8_STAGE(PG8_SA(0, 1), cA, v1);
        if (wr == 1) PG8_BAR;
        PG8_WAIT_V(4); PG8_BAR;
        PG8_STAGE(PG8_SB(1, 0), cB + kstep, voffB); PG8_STAGE(PG8_SA(1, 0), cA + kstep, v0); PG8_STAGE(PG8_SB(1, 1), cB + hstep + kstep, voffB);
        PG8_WAIT_V(6); PG8_BAR;
    }
    for (;;) {
        const bool has_next = S.next(ui + 1, nxt);
        const char* nA = (has_next && !GATHER) ? (const char*)g.A + (size_t)nxt.pm * tstep : cA; const char* nB = has_next ? (const char*)g.Bt + (size_t)nxt.pn * tstep : cB;
        if (has_next) { PG8_AOFF(nxt, nv0, nv1); } else { _Pragma("unroll") for (int _i = 0; _i < 2; ++_i) { nv0[_i] = v0[_i]; nv1[_i] = v1[_i]; } }
#pragma unroll 1
        for (int t = 0; t < nt; t += 2) {
            const bool last = (t == nt - 2);
            const char* a1 = cA + (size_t)(t + 1) * kstep;
            const char* a2 = last ? nA : cA + (size_t)(t + 2) * kstep; const char* b2 = last ? nB : cB + (size_t)(t + 2) * kstep;
            const char* a3 = a2 + kstep; const char* b3 = b2 + kstep;
            unsigned w0[2], w1[2];
#pragma unroll
            for (int _i = 0; _i < 2; ++_i) { w0[_i] = last ? nv0[_i] : v0[_i]; w1[_i] = last ? nv1[_i] : v1[_i]; }
            if constexpr (SP2) {
            PG8_LDB(B0, 0, 0); PG8_LDB(B1, 0, 1); PG8_SCHED; PG8_LDA(At, 0, 0); PG8_STAGE(PG8_SA(1, 1), a1, v1);
            PG8_WAIT_V(8); PG8_WAIT_L(0); PG8_BAR; PG8_MMA(0, 0, At, B0); PG8_MMA(0, 1, At, B1); PG8_BAR; PG8_SCHED;
            PG8_LDA(At, 0, 1); PG8_STAGE(PG8_SB(0, 0), b2, voffB); PG8_STAGE(PG8_SB(0, 1), b2 + hstep, voffB); PG8_STAGE(PG8_SA(0, 0), a2, w0);
            PG8_WAIT_V(8); PG8_WAIT_L(0); PG8_BAR; PG8_MMA(1, 0, At, B0); PG8_MMA(1, 1, At, B1); PG8_BAR; PG8_SCHED;
            PG8_LDB(B0, 1, 0); PG8_LDB(B1, 1, 1); PG8_SCHED; PG8_LDA(At, 1, 0); PG8_STAGE(PG8_SA(0, 1), a2, w1);
            PG8_WAIT_V(8); PG8_WAIT_L(0); PG8_BAR; PG8_MMA(0, 0, At, B0); PG8_MMA(0, 1, At, B1); PG8_BAR; PG8_SCHED;
            PG8_LDA(At, 1, 1); PG8_STAGE(PG8_SB(1, 0), b3, voffB); PG8_STAGE(PG8_SB(1, 1), b3 + hstep, voffB); PG8_STAGE(PG8_SA(1, 0), a3, w0);
            PG8_WAIT_V(8); PG8_WAIT_L(0); PG8_BAR; PG8_MMA(1, 0, At, B0); PG8_MMA(1, 1, At, B1); PG8_BAR; PG8_SCHED;
            } else {
            PG8_LDB(B0, 0, 0); PG8_SCHED; PG8_LDA(At, 0, 0); PG8_STAGE(PG8_SA(1, 1), a1, v1);
            PG8_WAIT_L(8); PG8_BAR; PG8_WAIT_L(0); PG8_MMA(0, 0, At, B0); PG8_BAR; PG8_SCHED;
            PG8_LDB(B1, 0, 1); PG8_STAGE(PG8_SB(0, 0), b2, voffB);
            PG8_BAR; PG8_WAIT_L(0); PG8_MMA(0, 1, At, B1); PG8_BAR;
            PG8_LDA(At, 0, 1); PG8_STAGE(PG8_SA(0, 0), a2, w0);
            PG8_BAR; PG8_WAIT_L(0); PG8_MMA(1, 0, At, B0); PG8_BAR; PG8_SCHED;
            PG8_STAGE(PG8_SB(0, 1), b2 + hstep, voffB);
            PG8_WAIT_V(6); PG8_BAR; PG8_MMA(1, 1, At, B1); PG8_BAR;
            PG8_LDB(B0, 1, 0); PG8_SCHED; PG8_LDA(At, 1, 0); PG8_STAGE(PG8_SA(0, 1), a2, w1);
            PG8_WAIT_L(8); PG8_BAR; PG8_WAIT_L(0); PG8_MMA(0, 0, At, B0); PG8_BAR; PG8_SCHED;
            PG8_LDB(B1, 1, 1); PG8_STAGE(PG8_SB(1, 0), b3, voffB);
            PG8_BAR; PG8_WAIT_L(0); PG8_MMA(0, 1, At, B1); PG8_BAR;
            PG8_LDA(At, 1, 1); PG8_STAGE(PG8_SA(1, 0), a3, w0);
            PG8_BAR; PG8_WAIT_L(0); PG8_MMA(1, 0, At, B0); PG8_BAR; PG8_SCHED;
            PG8_STAGE(PG8_SB(1, 1), b3 + hstep, voffB);
            PG8_WAIT_V(6); PG8_BAR; PG8_MMA(1, 1, At, B1); PG8_BAR;
            }
        }
        if constexpr (ALIGN_EPI) { if (wr == 0) PG8_BAR; }
        E(acc, cur, wr, wc, fr, fq);
        if (!has_next) break;
#pragma unroll
        for (int a = 0; a < 2; ++a)
#pragma unroll
            for (int b = 0; b < 2; ++b)
#pragma unroll
                for (int m = 0; m < 4; ++m)
#pragma unroll
                    for (int n = 0; n < 2; ++n) acc[a][b][m][n] = (f32x4){0.f, 0.f, 0.f, 0.f};
        cur = nxt; cA = nA; cB = nB; ++ui;
#pragma unroll
        for (int _i = 0; _i < 2; ++_i) { v0[_i] = nv0[_i]; v1[_i] = nv1[_i]; }
        if constexpr (ALIGN_EPI) { if (wr == 1) PG8_BAR; }
    }
    PG8_WAIT_V(0);
    if constexpr (!ALIGN_EPI) { if (wr == 0) PG8_BAR; }
    PG8_BAR;
#undef PG8_AOFF
#undef PG8_SA
#undef PG8_SB
#undef PG8_STAGE
#undef PG8_LDA
#undef PG8_LDB
#undef PG8_MMA
#undef PG8_WAIT_V
#undef PG8_WAIT_L
#undef PG8_BAR
#undef PG8_SCHED
}
__device__ __forceinline__ void st8(bf16* p, f32x4 a, f32x4 b) { v4u w; w.x = pk2(a[0], a[1]); w.y = pk2(a[2], a[3]); w.z = pk2(b[0], b[1]); w.w = pk2(b[2], b[3]); *(v4u*)p = w; }
__device__ __forceinline__ void st4(bf16* p, f32x4 a) { v2u w; w.x = pk2(a[0], a[1]); w.y = pk2(a[2], a[3]); *(v2u*)p = w; }
__device__ __forceinline__ f32x4 up4(unsigned lo, unsigned hi) { return (f32x4){bflo(lo), bfhi(lo), bflo(hi), bfhi(hi)}; }
__device__ __forceinline__ float dot4(f32x4 a) { return (a[0] * a[0] + a[1] * a[1]) + (a[2] * a[2] + a[3] * a[3]); }
__device__ __forceinline__ float scan16(float v, int fr) {
    float t;
    t = __shfl_up(v, 1, 16); if (fr >= 1) v += t;
    t = __shfl_up(v, 2, 16); if (fr >= 2) v += t;
    t = __shfl_up(v, 4, 16); if (fr >= 4) v += t;
    t = __shfl_up(v, 8, 16); if (fr >= 8) v += t;
    return v;
}

struct EpiIn {
    unsigned char *wsb, *dob;
#define EI_W(type, off) ((type*)(wsb + (off)))
#define EI_D(type, off) ((type*)(dob + (off)))
    __device__ __forceinline__ void hgrn(const f32x4 (&acc)[2][2][4][2], const Unit& u, int wr, int wc, int fr, int fq) const {
        const int hh = u.pn >> 1, cb = u.pn & 1;
        const int gch0 = hh * 128 + cb * 64 + wc * 16 + fq * 4;
        bf16* const QF = EI_D(bf16, DO_QF); bf16* const KF = EI_D(bf16, DO_KF); bf16* const QB = EI_D(bf16, DO_QB); bf16* const KB = EI_D(bf16, DO_KB); bf16* const VA = EI_W(bf16, WS_VA);
        float* const EREF = EI_W(float, WS_EREF); float* const ELAST = EI_W(float, WS_ELAST); const float* const LB = EI_W(float, WS_LB);
        const f32x4 lbf = *(const f32x4*)(LB + gch0), lbb = *(const f32x4*)(LB + 512 + gch0);
#pragma unroll
        for (int ai = 0; ai < 2; ++ai) {
            const int cidx = u.pm * 4 + ai * 2 + wr;
            const size_t off0 = (size_t)(u.pm * 256 + ai * 128 + wr * 64 + fr) * 512 + gch0;
#pragma unroll
            for (int m = 0; m < 4; ++m) st4(VA + off0 + (size_t)m * 16 * 512, acc[ai][1][m][1]);
#pragma unroll
            for (int jp = 0; jp < 2; ++jp) {
                f32x2 qo[4], ko[4];
#pragma unroll
                for (int jj = 0; jj < 2; ++jj) { const int j = 2 * jp + jj;
                    float lf[4], kk[4];
#pragma unroll
                    for (int m = 0; m < 4; ++m) { const float z = fminf(fmaxf(acc[ai][0][m][1][j], -30.f), 30.f), e = __expf(-z), s = 1.0f / (1.0f + e); kk[m] = (1.0f - lbf[j]) * e * s; lf[m] = __logf(lbf[j] + (1.0f - lbf[j]) * s); }
                    float G[4], carry = 0.f;
#pragma unroll
                    for (int m = 0; m < 4; ++m) { G[m] = scan16(lf[m], fr) + carry; carry = __shfl(G[m], 15, 16); }
                    const float Gref = __shfl(G[1], 15, 16);
#pragma unroll
                    for (int m = 0; m < 4; ++m) { qo[m][jj] = silu_(acc[ai][0][m][0][j]) * __expf(G[m] - Gref); ko[m][jj] = kk[m] * __expf(fminf(Gref - G[m], 80.f)); }
                    if (fr == 0) { EREF[(size_t)cidx * 512 + gch0 + j] = __expf(Gref); ELAST[(size_t)cidx * 512 + gch0 + j] = __expf(carry - Gref); }
                }
#pragma unroll
                for (int m = 0; m < 4; ++m) { *(unsigned*)(QF + off0 + (size_t)m * 16 * 512 + 2 * jp) = pk2(qo[m][0], qo[m][1]); *(unsigned*)(KF + off0 + (size_t)m * 16 * 512 + 2 * jp) = pk2(ko[m][0], ko[m][1]); }
                asm volatile("" ::: "memory");
#pragma unroll
                for (int jj = 0; jj < 2; ++jj) { const int j = 2 * jp + jj;
                    float lw[4], kk[4];
#pragma unroll
                    for (int m = 0; m < 4; ++m) { const float z = fminf(fmaxf(acc[ai][1][m][0][j], -30.f), 30.f), e = __expf(-z), s = 1.0f / (1.0f + e); kk[m] = (1.0f - lbb[j]) * e * s; lw[m] = __logf(lbb[j] + (1.0f - lbb[j]) * s); }
                    float P[4], carry = 0.f;
#pragma unroll
                    for (int m = 0; m < 4; ++m) { P[m] = scan16(lw[m], fr) + carry; carry = __shfl(P[m], 15, 16); }
                    float Gb[4];
#pragma unroll
                    for (int m = 0; m < 4; ++m) Gb[m] = carry - (P[m] - lw[m]);
                    const float Gbref = __shfl(Gb[2], 0, 16);
#pragma unroll
                    for (int m = 0; m < 4; ++m) { qo[m][jj] = silu_(acc[ai][0][m][0][j]) * __expf(Gb[m] - Gbref); ko[m][jj] = kk[m] * __expf(fminf(Gbref - Gb[m], 80.f)); }
                    if (fr == 0) { EREF[(size_t)(NCHUNK + cidx) * 512 + gch0 + j] = __expf(Gbref); ELAST[(size_t)(NCHUNK + cidx) * 512 + gch0 + j] = __expf(carry - Gbref); }
                }
#pragma unroll
                for (int m = 0; m < 4; ++m) { *(unsigned*)(QB + off0 + (size_t)m * 16 * 512 + 2 * jp) = pk2(qo[m][0], qo[m][1]); *(unsigned*)(KB + off0 + (size_t)m * 16 * 512 + 2 * jp) = pk2(ko[m][0], ko[m][1]); }
                asm volatile("" ::: "memory");
            }
        }
    }
    __device__ __forceinline__ void operator()(const f32x4 (&acc)[2][2][4][2], const Unit& u, int wr, int wc, int fr, int fq) const {
        const int pn = u.pn, row0 = u.pm * 256 + wr * 64 + fr;
        if (pn < 8) { hgrn(acc, u, wr, wc, fr, fq); return; }
        bf16* const OG = EI_W(bf16, WS_OG); bf16* const CQ = EI_W(bf16, WS_CQ); bf16* const CKVR = EI_W(bf16, WS_CKVR); bf16* const GA = EI_W(bf16, WS_GA); bf16* const GB = EI_W(bf16, WS_GB);
        float* const CQSS = EI_W(float, WS_CQSS); float* const CKVSS = EI_W(float, WS_CKVSS); float* const KR = EI_W(float, WS_KR);
        if (pn == 10) {
#pragma unroll
            for (int ai = 0; ai < 2; ++ai)
#pragma unroll
                for (int m = 0; m < 4; ++m) { const int row = row0 + ai * 128 + m * 16; float ss = 0.f;
#pragma unroll
                    for (int bj = 0; bj < 2; ++bj) { const f32x4 a = acc[ai][bj][m][0], b = acc[ai][bj][m][1]; ss += dot4(a) + dot4(b); st8(CQ + (size_t)row * 256 + bj * 128 + wc * 32 + 8 * fq, a, b); }
                    ss += __shfl_xor(ss, 16); ss += __shfl_xor(ss, 32); if (fq == 0) CQSS[(size_t)row * 4 + wc] = ss; }
            return;
        }
        if (pn == 11) {
#pragma unroll
            for (int ai = 0; ai < 2; ++ai)
#pragma unroll
                for (int m = 0; m < 4; ++m) { const int row = row0 + ai * 128 + m * 16;
                    const f32x4 a0 = acc[ai][0][m][0], b0 = acc[ai][0][m][1], a1 = acc[ai][1][m][0], b1 = acc[ai][1][m][1];
                    float ss = dot4(a0) + dot4(b0); ss += __shfl_xor(ss, 16); ss += __shfl_xor(ss, 32); if (fq == 0) CKVSS[(size_t)row * 4 + wc] = ss;
                    st8(CKVR + (size_t)row * 256 + wc * 32 + 8 * fq, a0, b0); st8(CKVR + (size_t)row * 256 + 128 + wc * 32 + 8 * fq, a1, b1);
                    if (wc == 0) { *(f32x4*)(KR + (size_t)row * 32 + 8 * fq) = a1; *(f32x4*)(KR + (size_t)row * 32 + 8 * fq + 4) = b1; } }
            return;
        }
        const bool sil = pn < 10; const int ld = sil ? 512 : 1024, cb = (sil ? pn - 8 : (pn - 12) & 3) * 256;
        const size_t dsto = sil ? (size_t)0 : (pn < 16 ? (size_t)((unsigned char*)GA - (unsigned char*)OG) : (size_t)((unsigned char*)GB - (unsigned char*)OG));
        bf16* dst = (bf16*)((unsigned char*)OG + dsto);
#pragma unroll
        for (int ai = 0; ai < 2; ++ai)
#pragma unroll
            for (int m = 0; m < 4; ++m)
#pragma unroll
                for (int bj = 0; bj < 2; ++bj) { f32x4 a = acc[ai][bj][m][0], b = acc[ai][bj][m][1];
#pragma unroll
                    for (int j = 0; j < 4; ++j) { a[j] = sil ? silu_(a[j]) : sigm(a[j]); b[j] = sil ? silu_(b[j]) : sigm(b[j]); }
                    st8(dst + (size_t)(row0 + ai * 128 + m * 16) * ld + cb + bj * 128 + wc * 32 + 8 * fq, a, b); }
    }
};

struct EpiQ {
    bf16* QM; const float* CQSS;
    __device__ __forceinline__ void operator()(const f32x4 (&acc)[2][2][4][2], const Unit& u, int wr, int wc, int fr, int fq) const {
#pragma unroll
        for (int ai = 0; ai < 2; ++ai)
#pragma unroll
            for (int m = 0; m < 4; ++m) { const int row = u.pm * 256 + ai * 128 + wr * 64 + m * 16 + fr;
                const f32x4 s4 = *(const f32x4*)(CQSS + (size_t)row * 4); const float rs = rsqrtf(((s4[0] + s4[1]) + (s4[2] + s4[3])) * (1.0f / 256.0f) + EPS);
#pragma unroll
                for (int bj = 0; bj < 2; ++bj) st8(QM + (size_t)row * 768 + u.pn * 256 + bj * 128 + wc * 32 + 8 * fq, acc[ai][bj][m][0] * rs, acc[ai][bj][m][1] * rs);
                asm volatile("" ::: "memory"); }
    }
};
struct EpiKV {
    bf16 *KH, *VH; const float *CKVSS, *KR, *ROPE_, *KN;
    __device__ __forceinline__ void operator()(const f32x4 (&acc)[2][2][4][2], const Unit& u, int wr, int wc, int fr, int fq) const {
        const int pn = u.pn, head = (pn & 1) * 4 + wc;
#pragma unroll
        for (int ai = 0; ai < 2; ++ai)
#pragma unroll
            for (int m = 0; m < 4; ++m) { const int row = u.pm * 256 + ai * 128 + wr * 64 + m * 16 + fr;
                const f32x4 s4 = *(const f32x4*)(CKVSS + (size_t)row * 4); const float rs = rsqrtf(((s4[0] + s4[1]) + (s4[2] + s4[3])) * (1.0f / 128.0f) + EPS);
                if (pn >= 2) {
#pragma unroll
                    for (int bj = 0; bj < 2; ++bj) st8(VH + ((size_t)row * 8 + head) * 64 + bj * 32 + 8 * fq, acc[ai][bj][m][0] * rs, acc[ai][bj][m][1] * rs);
                } else {
                    float ss = 0.f;
#pragma unroll
                    for (int bj = 0; bj < 2; ++bj)
#pragma unroll
                        for (int n = 0; n < 2; ++n) ss += dot4(acc[ai][bj][m][n]);
                    ss *= rs * rs;
                    const f32x4 x1 = *(const f32x4*)(KR + (size_t)row * 32 + 4 * fq), x2 = *(const f32x4*)(KR + (size_t)row * 32 + 16 + 4 * fq);
                    ss += dot4(x1) + dot4(x2);
                    ss += __shfl_xor(ss, 16); ss += __shfl_xor(ss, 32);
                    const float rk = rsqrtf(ss * (1.0f / 96.0f) + EPS), rr = rs * rk;
                    bf16* kp = KH + ((size_t)row * 8 + head) * 96;
#pragma unroll
                    for (int bj = 0; bj < 2; ++bj) { const f32x4 g0 = *(const f32x4*)(KN + bj * 32 + 8 * fq), g1 = *(const f32x4*)(KN + bj * 32 + 8 * fq + 4);
                        st8(kp + bj * 32 + 8 * fq, acc[ai][bj][m][0] * rr * g0, acc[ai][bj][m][1] * rr * g1); }
                    { const f32x4 c = *(const f32x4*)(ROPE_ + (size_t)row * 32 + 4 * fq), s = *(const f32x4*)(ROPE_ + (size_t)row * 32 + 16 + 4 * fq);
                      const f32x4 y1 = x1 * rk * *(const f32x4*)(KN + 64 + 4 * fq), y2 = x2 * rk * *(const f32x4*)(KN + 80 + 4 * fq);
                      st4(kp + 64 + 4 * fq, y1 * c - y2 * s); st4(kp + 80 + 4 * fq, y2 * c + y1 * s); }
                }
                asm volatile("" ::: "memory"); }
    }
};
struct EpiMerge {
    bf16* MG; const bf16 *GA, *GB;
    __device__ __forceinline__ void operator()(const f32x4 (&acc)[2][2][4][2], const Unit& u, int wr, int wc, int fr, int fq) const {
        const bool which = u.pm >= T / 256; const int pm = u.pm - (which ? T / 256 : 0), pn = u.pn - (which ? D / 256 : 0); const bf16* Gt = (const bf16*)((const unsigned char*)GA + (which ? (size_t)((const unsigned char*)GB - (const unsigned char*)GA) : (size_t)0));
#pragma unroll
        for (int ai = 0; ai < 2; ++ai)
#pragma unroll
            for (int m = 0; m < 4; ++m)
#pragma unroll
                for (int bj = 0; bj < 2; ++bj) { const size_t off = (size_t)(pm * 256 + ai * 128 + wr * 64 + m * 16 + fr) * 1024 + pn * 256 + bj * 128 + wc * 32 + 8 * fq;
                    const v4u g = *(const v4u*)(Gt + off); f32x4 a = acc[ai][bj][m][0] * up4(g.x, g.y), b = acc[ai][bj][m][1] * up4(g.z, g.w);
                    if (which) { const v4u o = *(const v4u*)(MG + off); a += up4(o.x, o.y); b += up4(o.z, o.w); }
                    st8(MG + off, a, b); if (bj == 1) asm volatile("" ::: "memory"); }
    }
};
struct EpiX2 {
    const float* X; float* O;
    __device__ __forceinline__ void operator()(const f32x4 (&acc)[2][2][4][2], const Unit& u, int wr, int wc, int fr, int fq) const {
#pragma unroll
        for (int ai = 0; ai < 2; ++ai)
#pragma unroll
            for (int m = 0; m < 4; ++m)
#pragma unroll
                for (int bj = 0; bj < 2; ++bj)
#pragma unroll
                    for (int n = 0; n < 2; ++n) { const size_t off = (size_t)(u.pm * 256 + ai * 128 + wr * 64 + m * 16 + fr) * 1024 + u.pn * 256 + bj * 128 + wc * 32 + n * 16 + 4 * fq;
                        *(f32x4*)(O + off) = *(const f32x4*)(X + off) + acc[ai][bj][m][n]; if (n == 1 && bj == 1) asm volatile("" ::: "memory"); }
    }
};
struct EpiUp {
    bf16* H1;
    __device__ __forceinline__ void operator()(const f32x4 (&acc)[2][2][4][2], const Unit& u, int wr, int wc, int fr, int fq) const {
        const int pl = u.pn & 1;
#pragma unroll
        for (int ai = 0; ai < 2; ++ai)
#pragma unroll
            for (int m = 0; m < 4; ++m) { f32x4 a = acc[ai][0][m][0], b = acc[ai][0][m][1];
#pragma unroll
                for (int j = 0; j < 4; ++j) { a[j] = silu_(a[j]) * acc[ai][1][m][0][j]; b[j] = silu_(b[j]) * acc[ai][1][m][1][j]; }
                st8(H1 + (size_t)(u.pm * 256 + ai * 128 + wr * 64 + m * 16 + fr) * 256 + pl * 128 + wc * 32 + 8 * fq, a, b); }
    }
};
struct EpiDown {
    bf16 *Y0, *Y1; const int* LIST; const float* EW;
    __device__ __forceinline__ void operator()(const f32x4 (&acc)[2][2][4][2], const Unit& u, int wr, int wc, int fr, int fq) const {
        const int pl = u.pn & 3;
#pragma unroll
        for (int ai = 0; ai < 2; ++ai)
#pragma unroll
            for (int m = 0; m < 4; ++m) { const int r = ai * 128 + wr * 64 + m * 16 + fr;
                if (r < u.nvalid) { const int ent = LIST[u.lbase + r]; const float w = EW[ent];
                    const unsigned eo = (unsigned)(ent >> 1) * 1024u + (unsigned)(pl * 256 + wc * 32 + 8 * fq) + ((ent & 1) ? (unsigned)(((unsigned char*)Y1 - (unsigned char*)Y0) / 2) : 0u);
#pragma unroll
                    for (int bj = 0; bj < 2; ++bj) st8(Y0 + eo + bj * 128, acc[ai][bj][m][0] * w, acc[ai][bj][m][1] * w); }
                asm volatile("" ::: "memory"); }
    }
};
struct EpiProj {
    bf16* PR;
    __device__ __forceinline__ void operator()(const f32x4 (&acc)[2][2][4][2], const Unit& u, int wr, int wc, int fr, int fq) const {
#pragma unroll
        for (int ai = 0; ai < 2; ++ai)
#pragma unroll
            for (int m = 0; m < 4; ++m)
#pragma unroll
                for (int bj = 0; bj < 2; ++bj) st8(PR + (size_t)(u.pm * 256 + ai * 128 + wr * 64 + m * 16 + fr) * 1024 + u.pn * 256 + bj * 128 + wc * 32 + 8 * fq, acc[ai][bj][m][0], acc[ai][bj][m][1]);
    }
};
struct EpiFinal {
    float* O; const bf16* PR;
    __device__ __forceinline__ void operator()(const f32x4 (&acc)[2][2][4][2], const Unit& u, int wr, int wc, int fr, int fq) const {
#pragma unroll
        for (int ai = 0; ai < 2; ++ai)
#pragma unroll
            for (int m = 0; m < 4; ++m)
#pragma unroll
                for (int bj = 0; bj < 2; ++bj)
#pragma unroll
                    for (int n = 0; n < 2; ++n) { const size_t off = (size_t)(u.pm * 256 + ai * 128 + wr * 64 + m * 16 + fr) * 1024 + u.pn * 256 + bj * 128 + wc * 32 + n * 16 + 4 * fq;
                        const v2u pr = *(const v2u*)(PR + off); f32x4 g = acc[ai][bj][m][n];
#pragma unroll
                        for (int j = 0; j < 4; ++j) g[j] = sigm(g[j]);
                        *(f32x4*)(O + off) = *(const f32x4*)(O + off) + up4(pr.x, pr.y) * g; if (n == 1 && bj == 1) asm volatile("" ::: "memory"); }
    }
};
struct Frame {
    LAS unsigned char* lds; unsigned char* gl;
    volatile LAS unsigned* MISC; gu32* ctl;
    int tid, lane, wave, vcu, G;
    const float* in[27]; float* out; unsigned char* ws;
};
#define WSP(type, off) ((type*)(F.ws + (off)))
#define DOP(type, off) ((type*)((unsigned char*)F.out + (off)))
enum { I_X = 0, I_P, I_POS, I_LNMIX, I_WIN, I_HGLB, I_HGON, I_WOA, I_QAN, I_KVAN, I_WUQ, I_WUKV, I_QN, I_KN, I_WOB, I_WOUT, I_LNMOE, I_WRG, I_BRG, I_WRE, I_BRE, I_W1, I_W3, I_W2, I_LNPLE, I_WPG, I_WPP };

enum { M_WIN = 0, M_WOAB, M_WUQ, M_WUKV, M_WOUT, M_WPG, M_WPP, M_W13, M_W2T };
template <int MAT> struct MatInfo;
template <> struct MatInfo<M_WIN>  { static constexpr int K = 1024, NP = NIN; };
template <> struct MatInfo<M_WOAB> { static constexpr int K = 512,  NP = 2048; };
template <> struct MatInfo<M_WUQ>  { static constexpr int K = 256,  NP = 768; };
template <> struct MatInfo<M_WUKV> { static constexpr int K = 256,  NP = 1024; };
template <> struct MatInfo<M_WOUT> { static constexpr int K = 1024, NP = 1024; };
template <> struct MatInfo<M_WPG>  { static constexpr int K = 1024, NP = 1024; };
template <> struct MatInfo<M_WPP>  { static constexpr int K = 256,  NP = 1024; };
template <> struct MatInfo<M_W13>  { static constexpr int K = 1024, NP = NE * 512; };
template <> struct MatInfo<M_W2T>  { static constexpr int K = 256,  NP = NE * 1024; };
template <int MAT> __device__ __forceinline__ void conv_item(const Frame& F, int item, int lane) {
    constexpr int K = MatInfo<MAT>::K; constexpr int KB = K / 64;
    const int kb = item % KB, p = (item / KB) * 64 + lane;
    const float* src = nullptr; size_t ld = 0; const float* gain = nullptr; int kvalid = K; bf16* dst = nullptr;
    if constexpr (MAT == M_WIN) {
        const int pn = p >> 8; int col;
        if (pn < 8) { const int q = p & 255, bj = q >> 7, wc = (q >> 5) & 3, n = (q >> 4) & 1, fq = (q >> 2) & 3, j = q & 3; const int kind = 2 * bj + n;
            col = kind * 512 + (pn >> 1) * 128 + (pn & 1) * 64 + wc * 16 + fq * 4 + j; }
        else if (pn < 10) col = 2048 + perm8(p - 2048);
        else if (pn == 10) col = 2560 + perm8(p - 2560);
        else if (pn == 11) { const int l = perm8(p - 2816); col = l < 128 ? 2816 + l : (l < 160 ? 2944 + (l - 128) : -1); }
        else if (pn < 16) col = 2976 + perm8(p - 3072);
        else col = 4000 + perm8(p - 4096);
        if (col >= 0) src = F.in[I_WIN] + col; ld = DIN; gain = F.in[I_LNMIX]; dst = WSP(bf16, WS_WIN);
    } else if constexpr (MAT == M_WOAB) { { const float* sa = F.in[I_WOA]; const float* sb = F.in[I_WOB]; src = (const float*)((const unsigned char*)sa + ((p >> 10) ? (size_t)((const unsigned char*)sb - (const unsigned char*)sa) : (size_t)0)) + perm8(p & 1023); } ld = 1024; dst = WSP(bf16, WS_WOAB); }
    else if constexpr (MAT == M_WUQ) { src = F.in[I_WUQ] + perm8(p); ld = 768; gain = F.in[I_QAN]; dst = WSP(bf16, WS_WUQ); }
    else if constexpr (MAT == M_WUKV) { const int pn = p >> 8, q = p & 255, bj = q >> 7, wc = (q >> 5) & 3, n = (q >> 4) & 1, fq = (q >> 2) & 3, j = q & 3;
        const int head = (pn & 1) * 4 + wc, d = 32 * bj + 8 * fq + 4 * n + j; src = F.in[I_WUKV] + head * 128 + (pn >= 2 ? 64 : 0) + d; ld = 1024; gain = F.in[I_KVAN]; kvalid = 128; dst = WSP(bf16, WS_WUKV); }
    else if constexpr (MAT == M_WOUT) { src = F.in[I_WOUT] + p; ld = 1024; dst = WSP(bf16, WS_WOUT); }
    else if constexpr (MAT == M_WPG) { src = F.in[I_WPG] + p; ld = 1024; gain = F.in[I_LNPLE]; dst = WSP(bf16, WS_WPG); }
    else if constexpr (MAT == M_WPP) { src = F.in[I_WPP] + perm8(p); ld = 1024; dst = WSP(bf16, WS_WPP); }
    else if constexpr (MAT == M_W13) { const int e = p >> 9, q = p & 511, pl = q >> 8, bj = (q >> 7) & 1, r = q & 127;
        { const float* sa = F.in[I_W1]; const float* sb = F.in[I_W3]; src = (const float*)((const unsigned char*)sa + (bj ? (size_t)((const unsigned char*)sb - (const unsigned char*)sa) : (size_t)0)) + (size_t)e * 1024 * 256 + pl * 128 + perm8(r); } ld = 256; gain = F.in[I_LNMOE]; dst = WSP(bf16, WS_W13); }
    else { const int e = p >> 10, q = p & 1023; src = F.in[I_W2] + (size_t)e * 256 * 1024 + perm8(q); ld = 1024; dst = WSP(bf16, WS_W2T); }
#pragma unroll
    for (int k8 = 0; k8 < 8; ++k8) { const int k = kb * 64 + k8 * 8; float v[8];
#pragma unroll
        for (int i = 0; i < 8; ++i) v[i] = (src && (k + i) < kvalid) ? src[(size_t)(k + i) * ld] * (gain ? gain[k + i] : 1.0f) : 0.0f;
        v4u o; o.x = pk2(v[0], v[1]); o.y = pk2(v[2], v[3]); o.z = pk2(v[4], v[5]); o.w = pk2(v[6], v[7]);
        *(v4u*)(dst + (size_t)p * K + k) = o; }
}
template <int MAT> __device__ __forceinline__ void conv_mat(const Frame& F) {
    constexpr int NITEMS = (MatInfo<MAT>::NP / 64) * (MatInfo<MAT>::K / 64);
    const int gw = F.vcu * NWAVES + F.wave, NGW = F.G * NWAVES;
    for (int it = gw; it < NITEMS; it += NGW) conv_item<MAT>(F, it, F.lane);
}

__device__ __forceinline__ void p0_prologue(const Frame& F) {
    conv_mat<M_WIN>(F); conv_mat<M_WOAB>(F); conv_mat<M_WUQ>(F); conv_mat<M_WUKV>(F); conv_mat<M_WOUT>(F); conv_mat<M_WPG>(F); conv_mat<M_WPP>(F);
    const int gt = F.vcu * NTHR + F.tid, NGT = F.G * NTHR;
    for (int i = gt; i < 72 * 1024; i += NGT) { const int o = i >> 10, k = i & 1023; WSP(float, WS_WR)[i] = F.in[I_LNMOE][k] * (o < 8 ? F.in[I_WRG][k * 8 + o] : F.in[I_WRE][k * 64 + (o - 8)]); }
    for (int i = gt; i < 72; i += NGT) WSP(float, WS_BR)[i] = i < 8 ? F.in[I_BRG][i] : F.in[I_BRE][i - 8];
    for (int i = gt; i < 1024; i += NGT) { const int d = i >> 9, f = i & 511; const float a0 = F.in[I_HGLB][d * 1024 + f], a1 = F.in[I_HGLB][d * 1024 + 512 + f]; WSP(float, WS_LB)[i] = 1.0f / (1.0f + expf(a1 - a0)); }
    for (int i = gt; i < T * 16; i += NGT) { const int t = i >> 4, f = i & 15; const float pos = (float)((const int*)F.in[I_POS])[t]; const float inv = powf(10000.0f, -(float)f / 16.0f);
        const float ang = pos * inv; WSP(float, WS_ROPE)[t * 32 + f] = cosf(ang); WSP(float, WS_ROPE)[t * 32 + 16 + f] = sinf(ang); }
    const int gw = F.vcu * NWAVES + F.wave, NGW = F.G * NWAVES;
    for (int m = gw; m < T; m += NGW) {
        const float* xr = F.in[I_X] + (size_t)m * D + F.lane * 8; f32x4 v[4]; float ss = 0.f;
#pragma unroll
        for (int j = 0; j < 2; ++j) { v[2 * j] = *(const f32x4*)(xr + 512 * j); v[2 * j + 1] = *(const f32x4*)(xr + 512 * j + 4); ss += dot4(v[2 * j]) + dot4(v[2 * j + 1]); }
        const float rs = rsqrtf(wave_sum(ss) * (1.0f / D) + EPS);
#pragma unroll
        for (int j = 0; j < 2; ++j) st8(WSP(bf16, WS_ACT) + (size_t)m * D + F.lane * 8 + 512 * j, v[2 * j] * rs, v[2 * j + 1] * rs);
        if (F.lane < 32) { const float* pr = F.in[I_P] + (size_t)m * PLE + F.lane * 8; st8(WSP(bf16, WS_PB) + (size_t)m * PLE + F.lane * 8, *(const f32x4*)pr, *(const f32x4*)(pr + 4)); }
    }
}

__device__ __forceinline__ void oa_pass(const Frame& F) {
    const int gw = F.vcu * NWAVES + F.wave, NGW = F.G * NWAVES;
    const bf16* OFp = WSP(bf16, WS_ACT); const bf16* OBp = OFp + (size_t)T * 512; const bf16* OGp = WSP(bf16, WS_OG); bf16* OA = DOP(bf16, DO_OA);
    const int c0 = F.lane * 8; const f32x4 g0 = *(const f32x4*)(F.in[I_HGON] + (c0 & 127)), g1 = *(const f32x4*)(F.in[I_HGON] + (c0 & 127) + 4);
    for (int m = gw; m < T; m += NGW) {
        const size_t off = (size_t)m * 512 + c0;
        const v4u a = *(const v4u*)(OFp + off), b = *(const v4u*)(OBp + off), g = *(const v4u*)(OGp + off);
        f32x4 s0 = up4(a.x, a.y) + up4(b.x, b.y), s1 = up4(a.z, a.w) + up4(b.z, b.w);
        float ss = dot4(s0) + dot4(s1); ss += __shfl_xor(ss, 1); ss += __shfl_xor(ss, 2); ss += __shfl_xor(ss, 4); ss += __shfl_xor(ss, 8);
        const float rs = rsqrtf(ss * (1.0f / 128.0f) + EPS);
        st8(OA + off, s0 * rs * g0 * up4(g.x, g.y), s1 * rs * g1 * up4(g.z, g.w));
    }
}
__device__ __forceinline__ void x3_pass(const Frame& F) {
    const int gw = F.vcu * NWAVES + F.wave, NGW = F.G * NWAVES;
    const bf16* Y0 = WSP(bf16, WS_Y0); const bf16* Y1 = WSP(bf16, WS_Y1); bf16* HP = WSP(bf16, WS_ACT);
    for (int m = gw; m < T; m += NGW) {
        float* xr = F.out + (size_t)m * D + F.lane * 8; f32x4 v[4]; float ss = 0.f;
#pragma unroll
        for (int j = 0; j < 2; ++j) { const size_t o = (size_t)m * D + F.lane * 8 + 512 * j; const v4u a = *(const v4u*)(Y0 + o), b = *(const v4u*)(Y1 + o);
            v[2 * j] = *(const f32x4*)(xr + 512 * j) + up4(a.x, a.y) + up4(b.x, b.y); v[2 * j + 1] = *(const f32x4*)(xr + 512 * j + 4) + up4(a.z, a.w) + up4(b.z, b.w);
            *(f32x4*)(xr + 512 * j) = v[2 * j]; *(f32x4*)(xr + 512 * j + 4) = v[2 * j + 1]; ss += dot4(v[2 * j]) + dot4(v[2 * j + 1]); }
        const float rs = rsqrtf(wave_sum(ss) * (1.0f / D) + EPS);
#pragma unroll
        for (int j = 0; j < 2; ++j) st8(HP + (size_t)m * D + F.lane * 8 + 512 * j, v[2 * j] * rs, v[2 * j + 1] * rs);
    }
}
__device__ __forceinline__ void moe_build_table(const Frame& F) {
    LAS int* tab = (LAS int*)(F.lds + TAB_OFF);
    if (F.tid == 0) { int rt = 0;
        for (int e = 0; e < NE; ++e) { const int cnt = (int)__hip_atomic_load(F.ctl + CW_CNT + 64 * e, RLX_AGENT); const int nt = (cnt + 255) >> 8;
            for (int lt = 0; lt < nt; ++lt) { tab[16 + 4 * rt] = e; tab[16 + 4 * rt + 1] = e * T + 256 * lt; const int rem = cnt - 256 * lt; tab[16 + 4 * rt + 2] = rem < 256 ? rem : 256; ++rt; } }
        tab[0] = rt; }
    __syncthreads();
}
__device__ __forceinline__ void hgrn_naive(const Frame& F) {
    float* Qs = (float*)F.gl; float* Ks = Qs + 64 * 128; float* Vs = Ks + 64 * 128; float* Ps = Vs + 64 * 64; float* Os = Ps + 64 * 64;
    const int v = F.tid & 63, kq = F.tid >> 6;
    for (int item = blockIdx.x; item < NB * HGH * 2 * 2; item += F.G) {
        const int vh = item & 1, dir = (item >> 1) & 1, hh = (item >> 2) & 3, b = item >> 4;
        const bf16* Qd = DOP(bf16, dir ? DO_QB : DO_QF); const bf16* Kd = DOP(bf16, dir ? DO_KB : DO_KF); const bf16* Va = WSP(bf16, WS_VA);
        bf16* Od = WSP(bf16, WS_ACT) + (dir ? (size_t)T * 512 : 0);
        const float* ER = WSP(float, WS_EREF) + (size_t)dir * NCHUNK * 512; const float* EL = WSP(float, WS_ELAST) + (size_t)dir * NCHUNK * 512;
        float M[16];
#pragma unroll
        for (int i = 0; i < 16; ++i) M[i] = 0.f;
        for (int cc = 0; cc < 32; ++cc) {
            const int c = dir ? 31 - cc : cc, gc = b * 32 + c, t0 = gc * 64;
            __syncthreads();
            for (int idx = F.tid; idx < 64 * 128; idx += NTHR) { const int t = idx >> 7, ch = idx & 127; const size_t o = (size_t)(t0 + t) * 512 + hh * 128 + ch; Qs[idx] = bf2f(Qd[o]); Ks[idx] = bf2f(Kd[o]); }
            for (int idx = F.tid; idx < 64 * 64; idx += NTHR) { const int t = idx >> 6, vv = idx & 63; Vs[idx] = bf2f(Va[(size_t)(t0 + t) * 512 + hh * 128 + vh * 64 + vv]); Os[idx] = 0.f; }
            __syncthreads();
            for (int idx = F.tid; idx < 64 * 64; idx += NTHR) { const int t = idx >> 6, s = idx & 63; const bool ok = dir ? (s >= t) : (s <= t); float a = 0.f;
                if (ok) for (int ch = 0; ch < 128; ++ch) a += Qs[t * 128 + ch] * Ks[s * 128 + ch];
                Ps[idx] = a; }
            __syncthreads();
            for (int t = 0; t < 64; ++t) { float a = 0.f;
#pragma unroll
                for (int i = 0; i < 16; ++i) a += Qs[t * 128 + kq * 16 + i] * M[i];
#pragma unroll
                for (int s = 0; s < 8; ++s) a += Ps[t * 64 + kq * 8 + s] * Vs[(kq * 8 + s) * 64 + v];
                atomicAdd(&Os[t * 64 + v], a); }
            __syncthreads();
            for (int idx = F.tid; idx < 64 * 64; idx += NTHR) { const int t = idx >> 6, vv = idx & 63; Od[(size_t)(t0 + t) * 512 + hh * 128 + vh * 64 + vv] = (bf16)f2bf(Os[idx]); }
            const int cn = dir ? c - 1 : c + 1; const bool has = cc < 31;
#pragma unroll
            for (int i = 0; i < 16; ++i) { float u = 0.f; const int ch = kq * 16 + i;
                for (int t = 0; t < 64; ++t) u += Ks[t * 128 + ch] * Vs[t * 64 + v];
                const float d = has ? EL[(size_t)gc * 512 + hh * 128 + ch] * ER[(size_t)(b * 32 + cn) * 512 + hh * 128 + ch] : 0.f;
                M[i] = (M[i] + u) * d; }
        }
    }
    __syncthreads();
}
__device__ __forceinline__ void attn_naive(const Frame& F) {
    const bf16* QM = WSP(bf16, WS_QM); const bf16* KH = WSP(bf16, WS_KH); const bf16* VH = WSP(bf16, WS_VH); bf16* OM = DOP(bf16, DO_OM);
    const float* RT = WSP(float, WS_ROPE); const float* QN = F.in[I_QN];
    for (int item = blockIdx.x; item < NB * MH * 4; item += F.G) {
        const int qb = item & 3, h = (item >> 2) & 7, b = item >> 5; const int t = b * SEQ + qb * 512 + F.tid;
        float q[96]; float ss = 0.f;
#pragma unroll
        for (int c = 0; c < 12; ++c) { const v4u w = *(const v4u*)(QM + (size_t)t * 768 + h * 96 + c * 8);
            q[c * 8 + 0] = bflo(w.x); q[c * 8 + 1] = bfhi(w.x); q[c * 8 + 2] = bflo(w.y); q[c * 8 + 3] = bfhi(w.y); q[c * 8 + 4] = bflo(w.z); q[c * 8 + 5] = bfhi(w.z); q[c * 8 + 6] = bflo(w.w); q[c * 8 + 7] = bfhi(w.w); }
#pragma unroll
        for (int d = 0; d < 96; ++d) ss += q[d] * q[d];
        const float rs = rsqrtf(ss * (1.0f / 96.0f) + EPS) ;
#pragma unroll
        for (int d = 0; d < 96; ++d) q[d] = q[d] * rs * QN[d];
#pragma unroll
        for (int i = 0; i < 16; ++i) { const float c = RT[(size_t)t * 32 + i], s = RT[(size_t)t * 32 + 16 + i]; const float x1 = q[64 + i], x2 = q[80 + i]; q[64 + i] = x1 * c - x2 * s; q[80 + i] = x2 * c + x1 * s; }
        const float sc = 0.10206207261596577f;
        unsigned qp[48];
#pragma unroll
        for (int d = 0; d < 48; ++d) qp[d] = pk2(q[2 * d] * sc, q[2 * d + 1] * sc);
        float o[64]; float mx = -1e30f, l = 0.f;
#pragma unroll
        for (int d = 0; d < 64; ++d) o[d] = 0.f;
        for (int s = 0; s < SEQ; ++s) {
            const bf16* kp = KH + ((size_t)(b * SEQ + s) * 8 + h) * 96; float a = 0.f;
#pragma unroll
            for (int c = 0; c < 12; ++c) { const v4u w = *(const v4u*)(kp + c * 8);
                a = dot2bf(qp[c * 4 + 0], w.x, a); a = dot2bf(qp[c * 4 + 1], w.y, a); a = dot2bf(qp[c * 4 + 2], w.z, a); a = dot2bf(qp[c * 4 + 3], w.w, a);
                if (c & 1) asm volatile("" ::: "memory"); }
            const float mn = fmaxf(mx, a), al = __expf(mx - mn), p = __expf(a - mn); mx = mn; l = l * al + p;
            const bf16* vp = VH + ((size_t)(b * SEQ + s) * 8 + h) * 64;
#pragma unroll
            for (int c = 0; c < 8; ++c) { const v4u w = *(const v4u*)(vp + c * 8);
                o[c * 8 + 0] = o[c * 8 + 0] * al + p * bflo(w.x); o[c * 8 + 1] = o[c * 8 + 1] * al + p * bfhi(w.x); o[c * 8 + 2] = o[c * 8 + 2] * al + p * bflo(w.y); o[c * 8 + 3] = o[c * 8 + 3] * al + p * bfhi(w.y);
                o[c * 8 + 4] = o[c * 8 + 4] * al + p * bflo(w.z); o[c * 8 + 5] = o[c * 8 + 5] * al + p * bfhi(w.z); o[c * 8 + 6] = o[c * 8 + 6] * al + p * bflo(w.w); o[c * 8 + 7] = o[c * 8 + 7] * al + p * bfhi(w.w); if (c & 1) asm volatile("" ::: "memory"); }
        }
        const float il = 1.0f / l;
#pragma unroll
        for (int c = 0; c < 8; ++c) st8(OM + (size_t)t * 512 + h * 64 + c * 8, (f32x4){o[c * 8] * il, o[c * 8 + 1] * il, o[c * 8 + 2] * il, o[c * 8 + 3] * il}, (f32x4){o[c * 8 + 4] * il, o[c * 8 + 5] * il, o[c * 8 + 6] * il, o[c * 8 + 7] * il});
    }
}
__device__ __forceinline__ void route_naive(const Frame& F) {
    const int gw = F.vcu * NWAVES + F.wave, NGW = F.G * NWAVES; const float* WR = WSP(float, WS_WR); const float* BR = WSP(float, WS_BR);
    bf16* HM = WSP(bf16, WS_ACT); int* EIDX = WSP(int, WS_EIDX); float* EW = WSP(float, WS_EW); int* LIST = WSP(int, WS_LIST);
    for (int m = gw; m < T; m += NGW) {
        const float* xr = F.out + (size_t)m * D + F.lane * 8; f32x4 v[4]; float ss = 0.f;
#pragma unroll
        for (int j = 0; j < 2; ++j) { v[2 * j] = *(const f32x4*)(xr + 512 * j); v[2 * j + 1] = *(const f32x4*)(xr + 512 * j + 4); ss += dot4(v[2 * j]) + dot4(v[2 * j + 1]); }
        const float rs = rsqrtf(wave_sum(ss) * (1.0f / D) + EPS);
#pragma unroll
        for (int j = 0; j < 4; ++j) v[j] = v[j] * rs;
#pragma unroll
        for (int j = 0; j < 2; ++j) st8(HM + (size_t)m * D + F.lane * 8 + 512 * j, v[2 * j], v[2 * j + 1]);
        float gl = -1e30f, el = -1e30f;
        for (int o = 0; o < 72; ++o) { const float* wr_ = WR + (size_t)o * 1024 + F.lane * 8; float a = 0.f;
#pragma unroll
            for (int j = 0; j < 2; ++j) { const f32x4 w0 = *(const f32x4*)(wr_ + 512 * j), w1 = *(const f32x4*)(wr_ + 512 * j + 4);
                a += (v[2 * j][0] * w0[0] + v[2 * j][1] * w0[1]) + (v[2 * j][2] * w0[2] + v[2 * j][3] * w0[3]) + (v[2 * j + 1][0] * w1[0] + v[2 * j + 1][1] * w1[1]) + (v[2 * j + 1][2] * w1[2] + v[2 * j + 1][3] * w1[3]); }
            a = wave_sum(a) + BR[o];
            if (o < 8) { if (F.lane == o) gl = a; } else { if (F.lane == o - 8) el = a; } }
        float gm = gl; gm = fmaxf(gm, __shfl_xor(gm, 1)); gm = fmaxf(gm, __shfl_xor(gm, 2)); gm = fmaxf(gm, __shfl_xor(gm, 4)); gm = __shfl(gm, 0);
        const int gsel = __ffsll((unsigned long long)__ballot(F.lane < 8 && gl == gm)) - 1;
        float ge = F.lane < 8 ? __expf(gl - gm) : 0.f; ge += __shfl_xor(ge, 1); ge += __shfl_xor(ge, 2); ge += __shfl_xor(ge, 4); const float pg = 1.0f / __shfl(ge, 0);
        float c1 = (F.lane >> 3) == gsel ? el : -3e38f; float m1 = c1;
#pragma unroll
        for (int o = 1; o < 64; o <<= 1) m1 = fmaxf(m1, __shfl_xor(m1, o));
        const int i1 = __ffsll((unsigned long long)__ballot(c1 == m1)) - 1;
        float c2 = F.lane == i1 ? -3e38f : c1; float m2 = c2;
#pragma unroll
        for (int o = 1; o < 64; o <<= 1) m2 = fmaxf(m2, __shfl_xor(m2, o));
        const int i2 = __ffsll((unsigned long long)__ballot(c2 == m2)) - 1;
        const float e2 = __expf(m2 - m1), w0 = pg / (1.0f + e2), w1 = pg * e2 / (1.0f + e2);
        if (F.lane < 2) { const int e = F.lane ? i2 : i1; EIDX[m * 2 + F.lane] = e; EW[m * 2 + F.lane] = F.lane ? w1 : w0;
            const unsigned pos = __hip_atomic_fetch_add(F.ctl + CW_CNT + 64 * e, 1u, RLX_AGENT); LIST[(size_t)e * T + pos] = m * 2 + F.lane; }
    }
}
__device__ __forceinline__ void moe_naive(const Frame& F) {
    float* hs = (float*)F.gl; float* s1 = hs + 1024; float* h1 = s1 + 512;
    const bf16* HM = WSP(bf16, WS_ACT); const bf16* W13 = WSP(bf16, WS_W13); const bf16* W2T = WSP(bf16, WS_W2T); const int* EIDX = WSP(int, WS_EIDX); const float* EW = WSP(float, WS_EW);
    for (int a = blockIdx.x; a < T * 2; a += F.G) {
        const int t = a >> 1, slot = a & 1, e = EIDX[a]; const float w = EW[a];
        __syncthreads();
        hs[F.tid] = bf2f(HM[(size_t)t * 1024 + F.tid]); hs[F.tid + 512] = bf2f(HM[(size_t)t * 1024 + 512 + F.tid]);
        __syncthreads();
        { const int c = F.tid & 255, half = F.tid >> 8; const int p = 256 * (c >> 7) + 128 * half + iperm8(c & 127);
          const bf16* wr_ = W13 + ((size_t)e * 512 + p) * 1024; float acc = 0.f;
          for (int k = 0; k < 1024; k += 8) { const v4u wv = *(const v4u*)(wr_ + k);
              acc += hs[k] * bflo(wv.x) + hs[k + 1] * bfhi(wv.x) + hs[k + 2] * bflo(wv.y) + hs[k + 3] * bfhi(wv.y) + hs[k + 4] * bflo(wv.z) + hs[k + 5] * bfhi(wv.z) + hs[k + 6] * bflo(wv.w) + hs[k + 7] * bfhi(wv.w); }
          s1[F.tid] = acc; }
        __syncthreads();
        if (F.tid < 256) h1[F.tid] = bf2f(f2bf(silu_(s1[F.tid]) * s1[256 + F.tid]));
        __syncthreads();
        for (int pp = F.tid; pp < 1024; pp += NTHR) { const bf16* wr_ = W2T + ((size_t)e * 1024 + pp) * 256; float acc = 0.f;
            for (int k = 0; k < 256; k += 8) { const v4u wv = *(const v4u*)(wr_ + k);
                acc += h1[k] * bflo(wv.x) + h1[k + 1] * bfhi(wv.x) + h1[k + 2] * bflo(wv.y) + h1[k + 3] * bfhi(wv.y) + h1[k + 4] * bflo(wv.z) + h1[k + 5] * bfhi(wv.z) + h1[k + 6] * bflo(wv.w) + h1[k + 7] * bfhi(wv.w); }
            WSP(bf16, slot ? WS_Y1 : WS_Y0)[(size_t)t * 1024 + perm8(pp)] = (bf16)f2bf(acc * w); }
    }
    __syncthreads();
}
namespace att {
using f32x16 = __attribute__((ext_vector_type(16))) float;
using s16x4 = __attribute__((ext_vector_type(4))) short;
constexpr int QBLK = 32, KVBLK = 64;
constexpr float SCALE = 0.10206207261596577f;
constexpr float THR = 8.f;
constexpr int SHM_V = 16384, SHM_K = 16384, SHM_ATTN = 2 * SHM_V + 2 * SHM_K + NWAVES * 64 * 4;
#define KSWZ(row, colB) ((row) * 256 + ((colB) ^ (((row) & 7) << 4)))
#define SBAR() __builtin_amdgcn_sched_barrier(0)
__device__ __forceinline__ int crow(int r, int hi) { return (r & 3) + 8 * (r >> 2) + 4 * hi; }
__device__ __forceinline__ unsigned cvtpk(float lo, float hi) { unsigned r; asm volatile("v_cvt_pk_bf16_f32 %0, %1, %2" : "=v"(r) : "v"(lo), "v"(hi)); return r; }
__device__ __forceinline__ void partialSM(f32x16& p0, f32x16& p1, float& m_reg, float& mn, float& alpha) {
    constexpr float C = SCALE * 1.4426950408889634f;
    float pmax = p0[0];
#pragma unroll
    for (int r = 1; r < 16; ++r) pmax = fmaxf(pmax, p0[r]);
#pragma unroll
    for (int r = 0; r < 16; ++r) pmax = fmaxf(pmax, p1[r]);
    { auto rr = __builtin_amdgcn_permlane32_swap(__float_as_uint(pmax), __float_as_uint(pmax), false, false); pmax = fmaxf(__uint_as_float(rr[0]), __uint_as_float(rr[1])); }
    if (__builtin_expect(__all(pmax - m_reg <= THR / SCALE), 1)) { mn = m_reg; alpha = 1.f; }
    else { mn = fmaxf(m_reg, pmax); alpha = __builtin_amdgcn_exp2f((m_reg - mn) * C); m_reg = mn; }
    const float mnC = -mn * C;
#pragma unroll
    for (int r = 0; r < 16; ++r) p0[r] = fmaf(p0[r], C, mnC);
#pragma unroll
    for (int r = 0; r < 16; ++r) p1[r] = fmaf(p1[r], C, mnC);
#pragma unroll
    for (int r = 0; r < 16; ++r) p0[r] = __builtin_amdgcn_exp2f(p0[r]);
}
__device__ __forceinline__ void finishSM(f32x16& p0, f32x16& p1, float alpha, float& l_reg, bf16x8& pa0, bf16x8& pa1, bf16x8& pa2, bf16x8& pa3) {
#pragma unroll
    for (int r = 0; r < 16; ++r) p1[r] = __builtin_amdgcn_exp2f(p1[r]);
    float ps = 0;
#pragma unroll
    for (int r = 0; r < 16; ++r) ps += p0[r];
#pragma unroll
    for (int r = 0; r < 16; ++r) ps += p1[r];
    { auto rr = __builtin_amdgcn_permlane32_swap(__float_as_uint(ps), __float_as_uint(ps), false, false); ps = __uint_as_float(rr[0]) + __uint_as_float(rr[1]); }
    l_reg = l_reg * alpha + ps;
#define PK4(P, BASE, OUT) do { unsigned a0 = cvtpk(P[BASE + 0], P[BASE + 1]), a1 = cvtpk(P[BASE + 2], P[BASE + 3]);   \
    unsigned b0 = cvtpk(P[BASE + 4], P[BASE + 5]), b1 = cvtpk(P[BASE + 6], P[BASE + 7]);                              \
    auto r0 = __builtin_amdgcn_permlane32_swap(a0, b0, false, false); auto r1 = __builtin_amdgcn_permlane32_swap(a1, b1, false, false); \
    v4u w = {r0[0], r1[0], r0[1], r1[1]}; OUT = __builtin_bit_cast(bf16x8, w); } while (0)
    PK4(p0, 0, pa0); PK4(p0, 8, pa1); PK4(p1, 0, pa2); PK4(p1, 8, pa3);
#undef PK4
}
__device__ __forceinline__ void qkt(f32x16& p0, f32x16& p1, const char* Ks, const bf16x8* qr, int r32, int hi) {
    p0 = f32x16{}; p1 = f32x16{};
#pragma unroll
    for (int d0 = 0; d0 < 6; ++d0) { const int cb = (d0 * 16 + hi * 8) * 2;
        const bf16x8 b0 = *reinterpret_cast<const bf16x8*>(Ks + KSWZ(r32, cb));
        const bf16x8 b1 = *reinterpret_cast<const bf16x8*>(Ks + KSWZ(32 + r32, cb));
        p0 = __builtin_amdgcn_mfma_f32_32x32x16_bf16(b0, qr[d0], p0, 0, 0, 0);
        p1 = __builtin_amdgcn_mfma_f32_32x32x16_bf16(b1, qr[d0], p1, 0, 0, 0); }
}
__device__ __forceinline__ int v_st(int k, int c) { const int kk = (k & ~0xC) | ((k & 4) << 1) | ((k & 8) >> 1); return ((kk >> 3) * 4 + (c >> 5)) * 512 + ((kk & 7) * 32 + (c & 31)) * 2; }
__device__ __forceinline__ int v_rd_base(int lane) { return ((lane & 3) << 3) | (((lane >> 2) & 3) << 6) | (((lane >> 4) & 1) << 5) | (((lane >> 5) & 1) << 8); }
constexpr int v_rd_off(int d0, int ks, int half) { return d0 * 512 + ks * 4096 + half * 2048; }
template <int OFF> __device__ __forceinline__ s16x4 tr_read(int vb) { s16x4 r; asm volatile("ds_read_b64_tr_b16 %0, %1 offset:%2" : "=&v"(r) : "v"(vb), "i"(OFF) : "memory"); return r; }
template <int D0> __device__ __forceinline__ void pv_one(f32x16& od, int vb, bf16x8 pa0, bf16x8 pa1, bf16x8 pa2, bf16x8 pa3) {
    const s16x4 l0 = tr_read<v_rd_off(D0, 0, 0)>(vb), h0 = tr_read<v_rd_off(D0, 0, 1)>(vb), l1 = tr_read<v_rd_off(D0, 1, 0)>(vb), h1 = tr_read<v_rd_off(D0, 1, 1)>(vb);
    const s16x4 l2 = tr_read<v_rd_off(D0, 2, 0)>(vb), h2 = tr_read<v_rd_off(D0, 2, 1)>(vb), l3 = tr_read<v_rd_off(D0, 3, 0)>(vb), h3 = tr_read<v_rd_off(D0, 3, 1)>(vb);
    asm volatile("s_waitcnt lgkmcnt(0)" ::: "memory"); SBAR();
#define PK(L, H) (bf16x8){L[0], L[1], L[2], L[3], H[0], H[1], H[2], H[3]}
    od = __builtin_amdgcn_mfma_f32_32x32x16_bf16(pa0, PK(l0, h0), od, 0, 0, 0);
    od = __builtin_amdgcn_mfma_f32_32x32x16_bf16(pa1, PK(l1, h1), od, 0, 0, 0);
    od = __builtin_amdgcn_mfma_f32_32x32x16_bf16(pa2, PK(l2, h2), od, 0, 0, 0);
    od = __builtin_amdgcn_mfma_f32_32x32x16_bf16(pa3, PK(l3, h3), od, 0, 0, 0);
#undef PK
}
__device__ __forceinline__ void pv_d0(f32x16* o, int vb, bf16x8 pa0, bf16x8 pa1, bf16x8 pa2, bf16x8 pa3) { pv_one<0>(o[0], vb, pa0, pa1, pa2, pa3); pv_one<1>(o[1], vb, pa0, pa1, pa2, pa3); }

__device__ __forceinline__ void attn_unit(const bf16* __restrict__ QM, const bf16* __restrict__ KH, const bf16* __restrict__ VH, bf16* __restrict__ OM, const float* __restrict__ RT, const float* __restrict__ QN,
                                          int t0, int kb, int h, char* lds) {
    int tid_ = threadIdx.x; asm volatile("" : "+v"(tid_));
    const int tid = tid_, wid = __builtin_amdgcn_readfirstlane(tid >> 6), lane = tid & 63, r32 = lane & 31, hi = lane >> 5;
    char* V_lds = lds; char* K_lds = lds + 2 * SHM_V;
    float* wsf = (float*)(lds + 2 * SHM_V + 2 * SHM_K) + wid * 64; float* li_l = wsf; float* al_l = wsf + 32;
    float m_reg = -1e30f, l_reg = 0; f32x16 o[2] = {}; bf16x8 qr[6];
    {
        const int tq = t0 + wid * QBLK + r32; const bf16* qp = QM + (size_t)tq * 768 + h * 96 + hi * 8;
        float qf[6][8]; float ss = 0.f;
#pragma unroll
        for (int d0 = 0; d0 < 6; ++d0) { const v4u w = *(const v4u*)(qp + d0 * 16);
            qf[d0][0] = bflo(w.x); qf[d0][1] = bfhi(w.x); qf[d0][2] = bflo(w.y); qf[d0][3] = bfhi(w.y); qf[d0][4] = bflo(w.z); qf[d0][5] = bfhi(w.z); qf[d0][6] = bflo(w.w); qf[d0][7] = bfhi(w.w);
#pragma unroll
            for (int j = 0; j < 8; ++j) ss += qf[d0][j] * qf[d0][j]; }
        { auto rr = __builtin_amdgcn_permlane32_swap(__float_as_uint(ss), __float_as_uint(ss), false, false); ss = __uint_as_float(rr[0]) + __uint_as_float(rr[1]); }
        const float rs = rsqrtf(ss * (1.0f / 96.0f) + EPS);
#pragma unroll
        for (int d0 = 0; d0 < 6; ++d0) { const f32x4 g0 = *(const f32x4*)(QN + d0 * 16 + hi * 8), g1 = *(const f32x4*)(QN + d0 * 16 + hi * 8 + 4);
#pragma unroll
            for (int j = 0; j < 4; ++j) { qf[d0][j] *= rs * g0[j]; qf[d0][4 + j] *= rs * g1[j]; } }
        { const float* rt = RT + (size_t)tq * 32 + hi * 8; const f32x4 c0 = *(const f32x4*)rt, c1 = *(const f32x4*)(rt + 4), s0 = *(const f32x4*)(rt + 16), s1 = *(const f32x4*)(rt + 20);
#pragma unroll
          for (int j = 0; j < 8; ++j) { const float c = j < 4 ? c0[j & 3] : c1[j & 3], s = j < 4 ? s0[j & 3] : s1[j & 3]; const float x1 = qf[4][j], x2 = qf[5][j]; qf[4][j] = x1 * c - x2 * s; qf[5][j] = x2 * c + x1 * s; } }
#pragma unroll
        for (int d0 = 0; d0 < 6; ++d0) { v4u w = {cvtpk(qf[d0][0], qf[d0][1]), cvtpk(qf[d0][2], qf[d0][3]), cvtpk(qf[d0][4], qf[d0][5]), cvtpk(qf[d0][6], qf[d0][7])}; qr[d0] = __builtin_bit_cast(bf16x8, w); }
    }
    const int vrow = tid >> 3, vch = tid & 7, k0row = tid / 12, k0ch = tid - 12 * k0row, k1row = (tid + 512) / 12, k1ch = (tid + 512) - 12 * k1row; const bool two = wid < 4;
    const bf16* Kg = KH + ((size_t)kb * 8 + h) * 96; const bf16* Vg = VH + ((size_t)kb * 8 + h) * 64;
    const int vst0 = v_st(vrow, vch * 8), kst0 = KSWZ(k0row, k0ch * 16), kst1 = KSWZ(k1row, k1ch * 16);
    const int vb0 = (int)(uintptr_t)V_lds + v_rd_base(lane);
    struct { bf16x8 vs, ks0, ks1; } sr_[2];
#define SLOAD(i, kk) do { sr_[i].vs = *(const bf16x8*)(Vg + (size_t)((kk) + vrow) * 512 + vch * 8); sr_[i].ks0 = *(const bf16x8*)(Kg + (size_t)((kk) + k0row) * 768 + k0ch * 8); \
    if (two) sr_[i].ks1 = *(const bf16x8*)(Kg + (size_t)((kk) + k1row) * 768 + k1ch * 8); } while (0)
#define SWRITE(b, i) do { *(bf16x8*)(V_lds + (b) * SHM_V + vst0) = sr_[i].vs; *(bf16x8*)(K_lds + (b) * SHM_K + kst0) = sr_[i].ks0; if (two) *(bf16x8*)(K_lds + (b) * SHM_K + kst1) = sr_[i].ks1; } while (0)
#define SWAIT() do { if (two) asm volatile("s_waitcnt vmcnt(3)" ::: "memory"); else asm volatile("s_waitcnt vmcnt(2)" ::: "memory"); } while (0)
#define RESC(a) do { if (__any((a) < 1.f)) { if (hi == 0) al_l[r32] = (a); asm volatile("s_waitcnt lgkmcnt(0)" ::: "memory"); \
    _Pragma("unroll") for (int d = 0; d < 2; ++d) _Pragma("unroll") for (int r = 0; r < 16; ++r) o[d][r] *= al_l[crow(r, hi)]; } } while (0)
    f32x16 pA0, pA1, pB0, pB1; float mnA, mnB, alA, alB; bf16x8 pa0, pa1, pa2, pa3; constexpr int NT = SEQ / KVBLK;
    SLOAD(0, 0); asm volatile("s_waitcnt vmcnt(0)" ::: "memory"); SWRITE(0, 0); __syncthreads();
    qkt(pA0, pA1, K_lds, qr, r32, hi); partialSM(pA0, pA1, m_reg, mnA, alA);
    SLOAD(1, KVBLK); SLOAD(0, 2 * KVBLK);
    SWAIT(); SWRITE(1, 1); __syncthreads();
    for (int j = 1; j + 1 < NT; j += 2) {
        SBAR(); qkt(pB0, pB1, K_lds + SHM_K, qr, r32, hi);
        finishSM(pA0, pA1, alA, l_reg, pa0, pa1, pa2, pa3); SBAR();
        SLOAD(1, (j + 2) * KVBLK); SBAR();
        pv_d0(o, vb0, pa0, pa1, pa2, pa3); partialSM(pB0, pB1, m_reg, mnB, alB);
        __syncthreads(); SWAIT(); SWRITE(0, 0);
        RESC(alB); __syncthreads();
        SBAR(); qkt(pA0, pA1, K_lds, qr, r32, hi);
        finishSM(pB0, pB1, alB, l_reg, pa0, pa1, pa2, pa3); SBAR();
        if (j + 3 < NT) SLOAD(0, (j + 3) * KVBLK); SBAR();
        pv_d0(o, vb0 + SHM_V, pa0, pa1, pa2, pa3); partialSM(pA0, pA1, m_reg, mnA, alA);
        __syncthreads(); SWAIT(); SWRITE(1, 1);
        RESC(alA); __syncthreads();
    }
    SBAR(); qkt(pB0, pB1, K_lds + SHM_K, qr, r32, hi);
    finishSM(pA0, pA1, alA, l_reg, pa0, pa1, pa2, pa3); SBAR();
    pv_d0(o, vb0, pa0, pa1, pa2, pa3); partialSM(pB0, pB1, m_reg, mnB, alB);
    __syncthreads(); RESC(alB);
    finishSM(pB0, pB1, alB, l_reg, pa0, pa1, pa2, pa3); SBAR();
    pv_d0(o, vb0 + SHM_V, pa0, pa1, pa2, pa3);
    if (hi == 0) li_l[r32] = l_reg; asm volatile("s_waitcnt lgkmcnt(0)" ::: "memory");
    bf16* Ow = OM + (size_t)(t0 + wid * QBLK) * 512 + h * 64;
#pragma unroll
    for (int r = 0; r < 16; ++r) { const int orow = crow(r, hi); const float rl = __builtin_amdgcn_rcpf(li_l[orow]);
#pragma unroll
        for (int d0 = 0; d0 < 2; ++d0) Ow[(size_t)orow * 512 + d0 * 32 + r32] = (bf16)f2bf(o[d0][r] * rl); }
    asm volatile("s_waitcnt vmcnt(0)" ::: "memory");
    __syncthreads();
#undef SLOAD
#undef SWRITE
#undef SWAIT
#undef RESC
}
#undef KSWZ
#undef SBAR
}
__device__ __forceinline__ void attn_fast(const Frame& F) {
    const bf16* QM = WSP(bf16, WS_QM); const bf16* KH = WSP(bf16, WS_KH); const bf16* VH = WSP(bf16, WS_VH); bf16* OM = DOP(bf16, DO_OM);
    for (int item = F.vcu; item < NB * MH * 8; item += F.G) {
        const int qb = item & 7, h = (item >> 3) & 7, b = item >> 6;
        att::attn_unit(QM, KH, VH, OM, WSP(float, WS_ROPE), F.in[I_QN], b * SEQ + qb * 256, b * SEQ, h, (char*)F.gl);
    }
}
namespace hg {
typedef short v4i16_t __attribute__((ext_vector_type(4)));
constexpr int IN_BYTES = 40960, OFF_Q = 0, OFF_K = 16384, OFF_V = 32768, OFF_P = 2 * IN_BYTES, OFF_MT = OFF_P + 8192;
__device__ __forceinline__ unsigned off256(unsigned row, unsigned ch) { return 256u * row + 16u * (ch ^ (((row & 3) << 2) | ((row >> 2) & 3))); }
__device__ __forceinline__ unsigned off128(unsigned row, unsigned ch) { return 128u * row + 16u * (ch ^ (row & 7)); }
__device__ __forceinline__ bf16x8 ldrow(const LAS unsigned char* p) { return *(const LAS bf16x8*)p; }
__device__ __forceinline__ bf16x8 ldtr(const LAS unsigned char* p0, const LAS unsigned char* p1) {
    const v4i16_t a = __builtin_amdgcn_ds_read_tr16_b64_v4i16((LAS v4i16_t*)p0), b = __builtin_amdgcn_ds_read_tr16_b64_v4i16((LAS v4i16_t*)p1);
    return (bf16x8){a[0], a[1], a[2], a[3], b[0], b[1], b[2], b[3]};
}
}
__device__ __forceinline__ void hgrn_fast(const Frame& F) {
    using namespace hg;
    int tid_ = threadIdx.x; asm volatile("" : "+v"(tid_));
    const int tid = tid_, lane = tid & 63, w = __builtin_amdgcn_readfirstlane(tid >> 6), l15 = lane & 15, g = lane >> 4, q4 = (lane & 15) >> 2, p4 = lane & 3;
    const LAS unsigned char* L = F.lds;
    const unsigned qrow0 = tid >> 4, qch = tid & 15, qrow1 = qrow0 + 32, vrow = tid >> 3, vch = tid & 7;
    const unsigned sq0 = off256(qrow0, qch), sq1 = off256(qrow1, qch), sv = off128(vrow, vch);
    const int tb = w >> 1, sb0 = 2 * (w & 1);
    for (int item = blockIdx.x; item < NB * HGH * 2 * 2; item += F.G) {
        const int vh = item & 1, dir = (item >> 1) & 1, hh = (item >> 2) & 3, b = item >> 4;
        const bf16* Qd = DOP(bf16, dir ? DO_QB : DO_QF) + hh * 128 + qch * 8; const bf16* Kd = DOP(bf16, dir ? DO_KB : DO_KF) + hh * 128 + qch * 8;
        const bf16* Va = WSP(bf16, WS_VA) + hh * 128 + vh * 64 + vch * 8;
        bf16* Od = WSP(bf16, WS_ACT) + (dir ? (size_t)T * 512 : (size_t)0) + hh * 128 + vh * 64;
        const float* ER = WSP(float, WS_EREF) + (size_t)dir * NCHUNK * 512 + hh * 128 + 16 * w + 4 * g; const float* EL = WSP(float, WS_ELAST) + (size_t)dir * NCHUNK * 512 + hh * 128 + 16 * w + 4 * g;
        f32x4 M[4];
#pragma unroll
        for (int i = 0; i < 4; ++i) M[i] = (f32x4){0.f, 0.f, 0.f, 0.f};
        v4u rq0, rq1, rk0, rk1, rv;
#define HG_LOAD(gc_) do { const size_t t0_ = (size_t)(gc_) * 64; rq0 = *(const v4u*)(Qd + (t0_ + qrow0) * 512); rq1 = *(const v4u*)(Qd + (t0_ + qrow1) * 512); \
        rk0 = *(const v4u*)(Kd + (t0_ + qrow0) * 512); rk1 = *(const v4u*)(Kd + (t0_ + qrow1) * 512); rv = *(const v4u*)(Va + (t0_ + vrow) * 512); } while (0)
#define HG_WRITE(buf_) do { LAS unsigned char* B_ = (LAS unsigned char*)L + (buf_) * IN_BYTES; *(LAS v4u*)(B_ + OFF_Q + sq0) = rq0; *(LAS v4u*)(B_ + OFF_Q + sq1) = rq1; \
        *(LAS v4u*)(B_ + OFF_K + sq0) = rk0; *(LAS v4u*)(B_ + OFF_K + sq1) = rk1; *(LAS v4u*)(B_ + OFF_V + sv) = rv; } while (0)
        __syncthreads();
        { const int c0 = dir ? 31 : 0; HG_LOAD(b * 32 + c0); HG_WRITE(0); }
        __syncthreads();
        for (int cc = 0; cc < 32; ++cc) {
            const int c = dir ? 31 - cc : cc, gc = b * 32 + c, cn = dir ? c - 1 : c + 1, buf = cc & 1; const bool has = cc < 31;
            const LAS unsigned char* Bq = L + buf * IN_BYTES + OFF_Q; const LAS unsigned char* Bk = L + buf * IN_BYTES + OFF_K; const LAS unsigned char* Bv = L + buf * IN_BYTES + OFF_V;
            if (has) HG_LOAD(b * 32 + cn);
            f32x4 dv = (f32x4){0.f, 0.f, 0.f, 0.f};
            if (has) dv = *(const f32x4*)(EL + (size_t)gc * 512) * *(const f32x4*)(ER + (size_t)(b * 32 + cn) * 512);
            {
                f32x4 pa[2] = {(f32x4){0.f, 0.f, 0.f, 0.f}, (f32x4){0.f, 0.f, 0.f, 0.f}};
#pragma unroll
                for (int ks = 0; ks < 4; ++ks) { const bf16x8 qf = ldrow(Bq + off256(16 * tb + l15, 4 * ks + g));
#pragma unroll
                    for (int i = 0; i < 2; ++i) { const bf16x8 kf = ldrow(Bk + off256(16 * (sb0 + i) + l15, 4 * ks + g)); pa[i] = __builtin_amdgcn_mfma_f32_16x16x32_bf16(kf, qf, pa[i], 0, 0, 0); } }
                const int t = 16 * tb + l15;
#pragma unroll
                for (int i = 0; i < 2; ++i) { const int s0 = 16 * (sb0 + i) + 4 * g; f32x4 v = pa[i];
#pragma unroll
                    for (int r = 0; r < 4; ++r) { const bool ok = dir ? (s0 + r >= t) : (s0 + r <= t); v[r] = ok ? v[r] : 0.f; }
                    v2u pk; pk.x = pk2(v[0], v[1]); pk.y = pk2(v[2], v[3]);
                    *(LAS v2u*)((LAS unsigned char*)L + OFF_P + off128(t, 2 * (sb0 + i) + (g >> 1)) + (g & 1) * 8) = pk; }
#pragma unroll
                for (int vb = 0; vb < 4; ++vb) { v2u pk; pk.x = pk2(M[vb][0], M[vb][1]); pk.y = pk2(M[vb][2], M[vb][3]);
                    *(LAS v2u*)((LAS unsigned char*)L + OFF_MT + off256(16 * vb + l15, 2 * w + (g >> 1)) + (g & 1) * 8) = pk; }
            }
            __syncthreads();
            {
                f32x4 oa[2] = {(f32x4){0.f, 0.f, 0.f, 0.f}, (f32x4){0.f, 0.f, 0.f, 0.f}};
#pragma unroll
                for (int ks = 0; ks < 2; ++ks) { const bf16x8 pf = ldrow(L + OFF_P + off128(16 * tb + l15, 4 * ks + g));
#pragma unroll
                    for (int i = 0; i < 2; ++i) { const unsigned c = sb0 + i;
                        const bf16x8 vf = ldtr(Bv + off128(32 * ks + 8 * g + q4, 2 * c + (p4 >> 1)) + 8 * (p4 & 1), Bv + off128(32 * ks + 8 * g + 4 + q4, 2 * c + (p4 >> 1)) + 8 * (p4 & 1));
                        oa[i] = __builtin_amdgcn_mfma_f32_16x16x32_bf16(vf, pf, oa[i], 0, 0, 0); } }
#pragma unroll
                for (int ks = 0; ks < 4; ++ks) { const bf16x8 qf = ldrow(Bq + off256(16 * tb + l15, 4 * ks + g));
#pragma unroll
                    for (int i = 0; i < 2; ++i) { const bf16x8 mf = ldrow(L + OFF_MT + off256(16 * (sb0 + i) + l15, 4 * ks + g)); oa[i] = __builtin_amdgcn_mfma_f32_16x16x32_bf16(mf, qf, oa[i], 0, 0, 0); } }
                const size_t orow = ((size_t)gc * 64 + 16 * tb + l15) * 512;
#pragma unroll
                for (int i = 0; i < 2; ++i) st4(Od + orow + 16 * (sb0 + i) + 4 * g, oa[i]);
#pragma unroll
                for (int ks = 0; ks < 2; ++ks) {
                    const bf16x8 kf = ldtr(Bk + off256(32 * ks + 8 * g + q4, 2 * w + (p4 >> 1)) + 8 * (p4 & 1), Bk + off256(32 * ks + 8 * g + 4 + q4, 2 * w + (p4 >> 1)) + 8 * (p4 & 1));
#pragma unroll
                    for (int vb = 0; vb < 4; ++vb) {
                        const bf16x8 vf = ldtr(Bv + off128(32 * ks + 8 * g + q4, 2 * vb + (p4 >> 1)) + 8 * (p4 & 1), Bv + off128(32 * ks + 8 * g + 4 + q4, 2 * vb + (p4 >> 1)) + 8 * (p4 & 1));
                        M[vb] = __builtin_amdgcn_mfma_f32_16x16x32_bf16(kf, vf, M[vb], 0, 0, 0); } }
#pragma unroll
                for (int vb = 0; vb < 4; ++vb) M[vb] = M[vb] * dv;
            }
            if (has) HG_WRITE(buf ^ 1);
            __syncthreads();
        }
#undef HG_LOAD
#undef HG_WRITE
    }
}
struct Args { const float* in[27]; float* out; unsigned char* ws; int ph_lo, ph_hi, use_bar, pad; };
constexpr int NPHASE = 11;
__device__ __forceinline__ void frame_init(Frame& F, const Args& args, unsigned char* lds) {
    F.lds = (LAS unsigned char*)lds; F.gl = lds;
    F.MISC = (volatile LAS unsigned*)(F.lds + MISC_OFF);
    F.tid = threadIdx.x; F.lane = F.tid & 63; F.wave = __builtin_amdgcn_readfirstlane(F.tid >> 6);
    F.G = gridDim.x; { const int bx = blockIdx.x; F.vcu = (F.G % 8 == 0) ? (bx % 8) * (F.G / 8) + bx / 8 : bx; }
    F.ws = args.ws; F.out = args.out; F.ctl = (gu32*)(args.ws + WS_CTL);
#pragma unroll
    for (int i = 0; i < 27; ++i) F.in[i] = args.in[i];
    for (int u = F.tid; u < 1024 / 4; u += NTHR) ((LAS unsigned*)(F.lds + LDSCTL_OFF))[u] = 0u;
    __syncthreads();
}
template <int PH> __device__ __forceinline__ void run_phase(const Frame& F) {
    if constexpr (PH == 0) { p0_prologue(F); }
    if constexpr (PH == 1) {
        Gemm g{WSP(bf16, WS_ACT), WSP(bf16, WS_WIN), 1024, nullptr}; StaticOrder S; S.init(T, NIN, F.G, (int)blockIdx.x);
        EpiIn E{F.ws, (unsigned char*)F.out};
        GEMM_PHASE(EpiIn, StaticOrder, g, S, E);
    }
    if constexpr (PH == 2) {
        { Gemm g{WSP(bf16, WS_CQ), WSP(bf16, WS_WUQ), 256, nullptr}; StaticOrder S; S.init(T, 768, F.G, (int)blockIdx.x); EpiQ E{WSP(bf16, WS_QM), WSP(float, WS_CQSS)}; GEMM_PHASE(EpiQ, StaticOrder, g, S, E); }
        { Gemm g{WSP(bf16, WS_CKVR), WSP(bf16, WS_WUKV), 256, nullptr}; StaticOrder S; S.init(T, 1024, F.G, (int)blockIdx.x);
          EpiKV E{WSP(bf16, WS_KH), WSP(bf16, WS_VH), WSP(float, WS_CKVSS), WSP(float, WS_KR), WSP(float, WS_ROPE), F.in[I_KN]}; GEMM_PHASE(EpiKV, StaticOrder, g, S, E); }
        HGRN_PHASE(F);
    }
    if constexpr (PH == 3) { oa_pass(F); ATTN_PHASE(F); }
    if constexpr (PH == 4) {
        Gemm g{DOP(bf16, DO_OA), WSP(bf16, WS_WOAB), 512, nullptr}; PairOrder S; S.init(F.G, (int)blockIdx.x); EpiMerge E{WSP(bf16, WS_ACT), WSP(bf16, WS_GA), WSP(bf16, WS_GB)};
        GEMM_PHASE(EpiMerge, PairOrder, g, S, E);
    }
    if constexpr (PH == 5) {
        Gemm g{WSP(bf16, WS_ACT), WSP(bf16, WS_WOUT), 1024, nullptr}; StaticOrder S; S.init(T, D, F.G, (int)blockIdx.x); EpiX2 E{F.in[I_X], F.out};
        GEMM_PHASE(EpiX2, StaticOrder, g, S, E);
    }
    if constexpr (PH == 6) { ROUTE_PHASE(F); conv_mat<M_W13>(F); conv_mat<M_W2T>(F); }
#if NAIVE_MOE
    if constexpr (PH == 7) { moe_naive(F); }

#else
    if constexpr (PH == 7) {
        moe_build_table(F);
        Gemm g{WSP(bf16, WS_ACT), WSP(bf16, WS_W13), 1024, WSP(int, WS_LIST)}; MoeOrder S{(const LAS int*)(F.lds + TAB_OFF), 2, F.G, (int)blockIdx.x}; EpiUp E{WSP(bf16, WS_H1)};
        GEMM_PHASE_GATHER(EpiUp, MoeOrder, g, S, E);
    }
    if constexpr (PH == 8) {
        moe_build_table(F);
        Gemm g{WSP(bf16, WS_H1), WSP(bf16, WS_W2T), 256, nullptr}; MoeOrder S{(const LAS int*)(F.lds + TAB_OFF), 4, F.G, (int)blockIdx.x}; EpiDown E{WSP(bf16, WS_Y0), WSP(bf16, WS_Y1), WSP(int, WS_LIST), WSP(float, WS_EW)};
        GEMM_PHASE(EpiDown, MoeOrder, g, S, E);
    }
#endif
    if constexpr (PH == 9) {
        Gemm g{WSP(bf16, WS_PB), WSP(bf16, WS_WPP), 256, nullptr}; StaticOrder S; S.init(T, D, F.G, (int)blockIdx.x); EpiProj E{WSP(bf16, WS_PROJ)};
        GEMM_PHASE(EpiProj, StaticOrder, g, S, E);
        x3_pass(F);
    }
    if constexpr (PH == 10) {
        Gemm g{WSP(bf16, WS_ACT), WSP(bf16, WS_WPG), 1024, nullptr}; StaticOrder S; S.init(T, D, F.G, (int)blockIdx.x); EpiFinal E{F.out, WSP(bf16, WS_PROJ)};
        GEMM_PHASE(EpiFinal, StaticOrder, g, S, E);
    }
}

template <int PH> __global__ void __launch_bounds__(NTHR, 2) phase_kernel(Args args) {
    extern __shared__ __attribute__((aligned(16))) unsigned char lds[];
    Frame F; frame_init(F, args, lds);
    run_phase<PH>(F);
}
#if N_LAUNCHES == 1
__global__ void __launch_bounds__(NTHR, 2) mega(Args args) {
    extern __shared__ __attribute__((aligned(16))) unsigned char lds[];
    Frame F; frame_init(F, args, lds);
    XcdBarrier bar = xcd_barrier_post((unsigned*)(F.ctl + CW_BAR), F.MISC + 8);
#define PHASE(k) do { Frame Fk = F; int t_ = threadIdx.x; asm volatile("" : "+v"(t_)); Fk.tid = t_; Fk.lane = t_ & 63; Fk.wave = __builtin_amdgcn_readfirstlane(t_ >> 6); run_phase<k>(Fk); } while (0)
    PHASE(0); xcd_barrier(bar);
    PHASE(1); xcd_barrier(bar);
    PHASE(2); xcd_barrier(bar);
    PHASE(3); xcd_barrier(bar);
    PHASE(4); xcd_barrier(bar);
    PHASE(5); xcd_barrier(bar);
    PHASE(6); xcd_barrier(bar);
    PHASE(7); xcd_barrier(bar);
    PHASE(8); xcd_barrier(bar);
    PHASE(9); xcd_barrier(bar);
    PHASE(10);
#undef PHASE
}
#endif
extern "C" void kernel_launch(void* const* d_in, const int* in_sizes, int n_in, void* d_out, int out_size, void* d_ws, size_t ws_size, hipStream_t stream) {
    static int grid = 0;
    if (grid == 0) {
        if (n_in != 27 || in_sizes[0] != T * D || out_size != T * D || ws_size < WS_END) { fprintf(stderr, "kernel_launch: unexpected shapes (n_in %d, in0 %d, out %d, ws %zu)\n", n_in, n_in > 0 ? in_sizes[0] : -1, out_size, ws_size); grid = -1; return; }
        int dev = 0, cus = 0;
        if (hipGetDevice(&dev) != hipSuccess || hipDeviceGetAttribute(&cus, hipDeviceAttributeMultiprocessorCount, dev) != hipSuccess) { grid = -1; return; }
#if N_LAUNCHES == 1
        if (hipFuncSetAttribute((const void*)mega, hipFuncAttributeMaxDynamicSharedMemorySize, LDS_BYTES) != hipSuccess) { fprintf(stderr, "kernel_launch: hipFuncSetAttribute failed\n"); grid = -1; return; }
#else
#define SETATTR(k) if (hipFuncSetAttribute((const void*)phase_kernel<k>, hipFuncAttributeMaxDynamicSharedMemorySize, LDS_BYTES) != hipSuccess) { fprintf(stderr, "kernel_launch: hipFuncSetAttribute failed\n"); grid = -1; return; }
        SETATTR(0) SETATTR(1) SETATTR(2) SETATTR(3) SETATTR(4) SETATTR(5) SETATTR(6) SETATTR(7) SETATTR(8) SETATTR(9) SETATTR(10)
#endif
        grid = cus;
    }
    if (grid < 0) return;
    (void)hipMemsetAsync((char*)d_ws + WS_CTL, 0, CTL_ZERO_BYTES, stream);
    Args a{};
    for (int i = 0; i < 27; ++i) a.in[i] = (const float*)d_in[i];
    a.out = (float*)d_out; a.ws = (unsigned char*)d_ws;
#if N_LAUNCHES == 1
    a.ph_lo = 0; a.ph_hi = NPHASE; a.use_bar = 1;
    hipLaunchKernelGGL(mega, dim3(grid), dim3(NTHR), LDS_BYTES, stream, a);
#else
#define LAUNCH_PH(k) hipLaunchKernelGGL(phase_kernel<k>, dim3(grid), dim3(NTHR), LDS_BYTES, stream, a)
#ifndef LAST_PHASE
#define LAST_PHASE 10
#endif
    LAUNCH_PH(0); LAUNCH_PH(1); LAUNCH_PH(2); LAUNCH_PH(3); LAUNCH_PH(4); LAUNCH_PH(5);
    if (LAST_PHASE >= 6) { LAUNCH_PH(6); } if (LAST_PHASE >= 7) { LAUNCH_PH(7); } if (LAST_PHASE >= 8) { LAUNCH_PH(8); } if (LAST_PHASE >= 9) { LAUNCH_PH(9); } if (LAST_PHASE >= 10) { LAUNCH_PH(10); }
#endif
    const hipError_t le = hipPeekAtLastError();
    if (le != hipSuccess) fprintf(stderr, "kernel_launch: launch failed: %s\n", hipGetErrorName(le));
}
```

```cpp
#include <hip/hip_runtime.h>
#include <cstdio>
#include <cstdint>

#define GAS __attribute__((address_space(1)))
#define LAS __attribute__((address_space(3)))
typedef unsigned short bf16;
typedef unsigned v4u __attribute__((ext_vector_type(4)));
typedef unsigned v2u __attribute__((ext_vector_type(2)));
typedef float f32x4 __attribute__((ext_vector_type(4)));
typedef float f32x2 __attribute__((ext_vector_type(2)));
typedef short bf16x8 __attribute__((ext_vector_type(8)));
typedef GAS unsigned gu32;
#define RLX_AGENT __ATOMIC_RELAXED, __HIP_MEMORY_SCOPE_AGENT
#define LDS_WAIT() asm volatile("s_waitcnt lgkmcnt(0)" ::: "memory")
#define VM_WAIT() asm volatile("s_waitcnt vmcnt(0)" ::: "memory")

constexpr int NB = 16, SEQ = 2048, T = NB * SEQ, D = 1024;
constexpr int HGH = 4, HGK = 128, HGV = 128, HGF = 512, CHUNK = 64, NCHUNK = T / CHUNK;
constexpr int MH = 8, NOPE = 64, ROPE = 32, QK = 96, VD = 64, QR = 256, KVR = 128;
constexpr int NG = 8, EPG = 8, NE = 64, DE = 256, PLE = 256;
constexpr int DIN = 5024, NIN = 5120;
constexpr float EPS = 1e-6f;
constexpr int NWAVES = 8, NTHR = 512;

__device__ __forceinline__ unsigned f2bf(float f) { unsigned u = __builtin_bit_cast(unsigned, f); return (u + 0x7fffu + ((u >> 16) & 1u)) >> 16; }
__device__ __forceinline__ unsigned pk2(float lo, float hi) { return f2bf(lo) | (f2bf(hi) << 16); }
__device__ __forceinline__ float bf2f(unsigned b) { return __builtin_bit_cast(float, b << 16); }
__device__ __forceinline__ float bflo(unsigned w) { return __builtin_bit_cast(float, w << 16); }
__device__ __forceinline__ float bfhi(unsigned w) { return __builtin_bit_cast(float, w & 0xffff0000u); }
__device__ __forceinline__ float sigm(float x) { return 1.0f / (1.0f + __expf(-x)); }
__device__ __forceinline__ float silu_(float x) { return x / (1.0f + __expf(-x)); }
__device__ __forceinline__ float wave_sum(float v) {
#pragma unroll
    for (int o = 1; o < 64; o <<= 1) v += __shfl_xor(v, o);
    return v;
}
__host__ __device__ __forceinline__ int perm8(int p) { const int r = p & 31, n = r >> 4, fq = (r >> 2) & 3, j = r & 3; return (p & ~31) + 8 * fq + 4 * n + j; }
__host__ __device__ __forceinline__ int iperm8(int l) { const int r = l & 31, fq = r >> 3, n = (r >> 2) & 1, j = r & 3; return (l & ~31) + 16 * n + 4 * fq + j; }

constexpr size_t MiB = 1u << 20;
constexpr size_t WS_CTL = 0, CTL_ZERO_BYTES = 1 * MiB;
constexpr size_t WS_LB = 1 * MiB;
constexpr size_t WS_WRH = 1 * MiB + 65536, WS_WRL = WS_WRH + 80 * 1024 * 2;
constexpr size_t WS_BR = WS_WRL + 80 * 1024 * 2;
constexpr size_t WS_RS2 = 2 * MiB;
constexpr size_t WS_CQSS = 2 * MiB;
constexpr size_t WS_CKVSS = 2 * MiB + 512 * 1024;
constexpr size_t WS_ROPE = 4 * MiB;
constexpr size_t WS_EREF = 8 * MiB, WS_ELAST = 10 * MiB;
constexpr size_t WS_EIDX = 12 * MiB;
constexpr size_t WS_EW = 12 * MiB + 512 * 1024;
constexpr size_t WS_KR = 13 * MiB;
constexpr size_t WS_LIST = 4 * MiB;
constexpr size_t WS_WIN = 17 * MiB, WS_WOAB = 27 * MiB, WS_WUQ = 29 * MiB, WS_WUKV = 29 * MiB + 512 * 1024, WS_WOUT = 30 * MiB, WS_WPG = 32 * MiB, WS_WPP = 34 * MiB;
constexpr size_t WS_ACT = 36 * MiB;
constexpr size_t WS_VA = 100 * MiB, WS_OG = 132 * MiB, WS_CQ = 164 * MiB, WS_CKVR = 180 * MiB, WS_GA = 196 * MiB, WS_GB = 260 * MiB;
constexpr size_t WS_QM = 324 * MiB, WS_KH = 372 * MiB, WS_VH = 420 * MiB, WS_PB = 452 * MiB, WS_END = 468 * MiB;
constexpr size_t WS_W13 = 196 * MiB, WS_W2T = 260 * MiB;
constexpr size_t WS_H1 = 324 * MiB;
constexpr size_t WS_Y0 = 100 * MiB, WS_Y1 = 372 * MiB;
constexpr size_t WS_PROJ = 292 * MiB;
constexpr size_t DO_QF = 0, DO_KF = 32 * MiB, DO_QB = 64 * MiB, DO_KB = 96 * MiB, DO_OA = 0, DO_OM = 32 * MiB;
constexpr int CW_TMO = 0, CW_CODE = 1, CW_BAR = 4096, CW_CNT = 8192  ;
constexpr int MAXROWT = 320;
constexpr int RING_BYTES = 131072, LDSCTL_OFF = RING_BYTES, MISC_OFF = LDSCTL_OFF + 320, TAB_OFF = RING_BYTES + 1024, LDS_BYTES = 147456;
#define N_LAUNCHES 1
#define NAIVE_MOE 0
#define GEMM_PHASE(EPI, SCHED, g, S, E) gemm_fast<EPI, SCHED, false>(F.lds, g, S, E)
#define GEMM_PHASE_GATHER(EPI, SCHED, g, S, E) gemm_fast<EPI, SCHED, true>(F.lds, g, S, E)
#define HGRN_PHASE(F) hgrn_fast(F)
#define ATTN_PHASE(F) attn_fast(F)
#define ROUTE_PHASE(F) route_fast(F)
#define XB_TMO      128
#define XB_XCNT(j)  (256  + 64 * (j))
#define XB_XSUB(j)  (1280 + 64 * (j))
#define XB_XGEN(j)  (2304 + 64 * (j))
#define XB_TOP      3328
#define XB_TOPGEN   3392
#define XCD_BAR_WORDS 3456
#define XB_SPIN_CAP (1u << 18)

__device__ __forceinline__ unsigned xb_ld(unsigned* p)              { return __hip_atomic_load(p, __ATOMIC_RELAXED, __HIP_MEMORY_SCOPE_AGENT); }
__device__ __forceinline__ unsigned xb_add(unsigned* p, unsigned v) { return __hip_atomic_fetch_add(p, v, __ATOMIC_RELAXED, __HIP_MEMORY_SCOPE_AGENT); }
__device__ __forceinline__ unsigned xb_xcc_id() { return (unsigned)__builtin_amdgcn_s_getreg((3 << 11) | 20) & 0xFu; }
#define XB_SPIN(cond, bar) do { unsigned _sp = 0; while (cond) { __builtin_amdgcn_s_sleep(1); \
    if ((++_sp & 255u) == 0u) { if (xb_ld(&(bar)[XB_TMO])) break; if (_sp > XB_SPIN_CAP) { atomicAdd(&(bar)[XB_TMO], 1u); break; } } } } while (0)

struct XcdBarrier {
    unsigned* bar; unsigned x;
    volatile LAS unsigned* st;
};

__device__ __forceinline__ XcdBarrier xcd_barrier_post(unsigned* bar, volatile LAS unsigned* st) {
    XcdBarrier b; b.bar = bar; b.x = xb_xcc_id(); b.st = st;
    if (threadIdx.x == 0) (void)xb_add(&bar[XB_XCNT(b.x)], 1u);
    return b;
}
__device__ __forceinline__ void xcd_barrier_complete(unsigned* bar, unsigned x, unsigned& nloc, unsigned& nx) {
    const unsigned G = gridDim.x * gridDim.y * gridDim.z;
    unsigned sum, cnt, mine, sp = 0u;
    for (;;) {
        sum = 0u; cnt = 0u; mine = 0u;
#pragma unroll
        for (unsigned j = 0; j < 16; ++j) { const unsigned c = xb_ld(&bar[XB_XCNT(j)]); sum += c; cnt += (c > 0u) ? 1u : 0u; mine = (j == x) ? c : mine; }
        if (sum == G) break;
        __builtin_amdgcn_s_sleep(1);
        if ((++sp & 255u) == 0u) { if (xb_ld(&bar[XB_TMO])) break; if (sp > XB_SPIN_CAP) { atomicAdd(&bar[XB_TMO], 1u); break; } }
    }
    nloc = mine > 0u ? mine : 1u; nx = cnt > 0u ? cnt : 1u;
}

__device__ __forceinline__ void xcd_barrier(const XcdBarrier& b) {
    asm volatile("s_waitcnt vmcnt(0)" ::: "memory");
    __syncthreads();
    if (threadIdx.x == 0) {
        unsigned* bar = b.bar;
        __builtin_amdgcn_s_waitcnt(0);
        unsigned nloc = b.st[0], nx = b.st[1];
        if (nloc == 0u) { xcd_barrier_complete(bar, b.x, nloc, nx); b.st[0] = nloc; b.st[1] = nx; }
        const unsigned old = xb_add(&bar[XB_XSUB(b.x)], 1u);
        const unsigned gen = old / nloc;
        if (old + 1u == (gen + 1u) * nloc) {
            __builtin_amdgcn_fence(__ATOMIC_RELEASE, "agent");
            asm volatile("s_waitcnt vmcnt(0)" ::: "memory");
            const unsigned og = xb_add(&bar[XB_TOP], 1u);
            const unsigned tg = og / nx;
            if (og + 1u == (tg + 1u) * nx) xb_add(&bar[XB_TOPGEN], 1u);
            else XB_SPIN(xb_ld(&bar[XB_TOPGEN]) == tg, bar);
            __builtin_amdgcn_fence(__ATOMIC_ACQUIRE, "agent");
            xb_add(&bar[XB_XGEN(b.x)], 1u);
            asm volatile("s_waitcnt vmcnt(0)" ::: "memory");
        } else {
            XB_SPIN(xb_ld(&bar[XB_XGEN(b.x)]) == gen, bar);
            __builtin_amdgcn_fence(__ATOMIC_ACQUIRE, "agent");
            asm volatile("s_waitcnt vmcnt(0)" ::: "memory");
        }
    }
    __syncthreads();
}
struct Unit { int pm, pn, lbase, nvalid; };
struct Gemm { const bf16* A; const bf16* Bt; int K; const int* list; };
typedef __bf16 bf16x2_t __attribute__((ext_vector_type(2)));
__device__ __forceinline__ float dot2bf(unsigned a, unsigned b, float c) { return __builtin_amdgcn_fdot2_f32_bf16(__builtin_bit_cast(bf16x2_t, a), __builtin_bit_cast(bf16x2_t, b), c, false); }

constexpr int NXCD = 8, WGM = 8;
struct StaticOrder {
    int nM, nN, nwg, G, c;
    __device__ void init(int M, int N, int G_, int c_) { nM = M / 256; nN = N / 256; nwg = nM * nN; G = G_; c = c_; }
    __device__ __forceinline__ bool next(int i, Unit& u) const {
        const long L = (long)i * G + c; if (L >= nwg) return false;
        int wgid = (int)L; { const int q = nwg / NXCD, r = nwg % NXCD, xcd = wgid % NXCD, off = wgid / NXCD; wgid = (xcd < r ? xcd * (q + 1) : r * (q + 1) + (xcd - r) * q) + off; }
        const int nig = WGM * nN, gid = wgid / nig, fm = gid * WGM, gsz = (nM - fm) < WGM ? (nM - fm) : WGM;
        u.pm = fm + ((wgid % nig) % gsz); u.pn = (wgid % nig) / gsz; u.lbase = 0; u.nvalid = 256; return true;
    }
};
struct PairOrder {
    StaticOrder so;
    __device__ void init(int G_, int c_) { so.init(T, D, G_, c_); }
    __device__ __forceinline__ bool next(int i, Unit& u) const { if (!so.next(i >> 1, u)) return false; if (i & 1) { u.pm += T / 256; u.pn += D / 256; } return true; }
};
struct MoeOrder {
    const LAS int* tab; int npn, G, c;
    __device__ __forceinline__ bool next(int i, Unit& u) const {
        const int L = i * G + c; const int nt = tab[0]; if (L >= nt * npn) return false;
        const int rt = L / npn, pl = L - rt * npn; const int e = tab[16 + 4 * rt];
        u.pm = rt; u.pn = e * npn + pl; u.lbase = tab[16 + 4 * rt + 1]; u.nvalid = tab[16 + 4 * rt + 2]; return true;
    }
};

template <class Epi, class Sched>
__device__ __forceinline__ void gemm_ref(const Gemm g, const Sched& S, const Epi& E) {
    const int tid = threadIdx.x, wid = tid >> 6, lane = tid & 63, wr = wid >> 2, wc = wid & 3, fr = lane & 15, fq = lane >> 4;
    const int K = g.K; Unit u;
    for (int i = 0; S.next(i, u); ++i) {
        f32x4 acc[2][2][4][2];
#pragma unroll
        for (int a = 0; a < 2; ++a)
#pragma unroll
            for (int b = 0; b < 2; ++b)
#pragma unroll
                for (int m = 0; m < 4; ++m)
#pragma unroll
                    for (int n = 0; n < 2; ++n) acc[a][b][m][n] = (f32x4){0.f, 0.f, 0.f, 0.f};
        unsigned ar[2][4];
#pragma unroll
        for (int ai = 0; ai < 2; ++ai)
#pragma unroll
            for (int m = 0; m < 4; ++m) { const int r = ai * 128 + wr * 64 + m * 16 + fr;
                if (g.list) { const int rr = r < u.nvalid ? r : u.nvalid - 1; ar[ai][m] = (unsigned)(g.list[u.lbase + rr] >> 1) * (unsigned)K; }
                else ar[ai][m] = (unsigned)(u.pm * 256 + r) * (unsigned)K; }
        const unsigned bb = (unsigned)(u.pn * 256 + wc * 32 + 4 * fq) * (unsigned)K;
#pragma unroll 1
        for (int k0 = 0; k0 < K; k0 += 8) {
#pragma unroll
            for (int bj = 0; bj < 2; ++bj)
#pragma unroll
                for (int n = 0; n < 2; ++n) {
                    v4u bw[4];
#pragma unroll
                    for (int j = 0; j < 4; ++j) bw[j] = *(const v4u*)(g.Bt + (bb + (unsigned)(bj * 128 + n * 16 + j) * (unsigned)K + (unsigned)k0));
#pragma unroll
                    for (int ai = 0; ai < 2; ++ai)
#pragma unroll
                        for (int m = 0; m < 4; ++m) { const v4u aw = *(const v4u*)(g.A + (ar[ai][m] + (unsigned)k0));
#pragma unroll
                            for (int j = 0; j < 4; ++j) { float c = acc[ai][bj][m][n][j];
                                c = dot2bf(aw.x, bw[j].x, c); c = dot2bf(aw.y, bw[j].y, c); c = dot2bf(aw.z, bw[j].z, c); c = dot2bf(aw.w, bw[j].w, c);
                                acc[ai][bj][m][n][j] = c; }
                            asm volatile("" ::: "memory"); }
                }
        }
        E(acc, u, wr, wc, fr, fq);
    }
}
constexpr int BM = 256, BK = 64, HALF = 128, HTB = HALF * BK * 2, STAGE_BYTES = 8 * HTB;
__host__ __device__ __forceinline__ int lds_byte(int r, int c) { const int st = (r >> 4) * 2 + (c >> 5), rr = r & 15, cc = c & 31, ob = rr * 64 + cc * 2; return st * 1024 + (ob ^ (((ob >> 9) & 1) << 5)); }
__host__ __device__ __forceinline__ void stage_rc(int b, int& R, int& C) { const int st = b / 1024, sb = b % 1024, swz = sb ^ (((sb >> 9) & 1) << 5); R = (st >> 1) * 16 + swz / 64; C = (st & 1) * 32 + (swz % 64) / 2; }
template <class Epi, class Sched, bool GATHER = false, bool ALIGN_EPI = true, bool SP2 = true>
__device__ __forceinline__ void gemm_fast(LAS unsigned char* lds, const Gemm g, const Sched& S, const Epi& E) {
    int tid_ = threadIdx.x; asm volatile("" : "+v"(tid_));
    const int tid = tid_, wid = __builtin_amdgcn_readfirstlane(tid >> 6), lane = tid & 63, wr = wid >> 2, wc = wid & 3, fr = lane & 15, fq = lane >> 4;
    const int K = g.K, nt = K / BK;
    unsigned v0[2], v1[2], nv0[2], nv1[2], voffB[2]; int sR[2], sC[2];
#pragma unroll
    for (int i = 0; i < 2; ++i) { stage_rc(tid * 16 + i * 8192, sR[i], sC[i]); voffB[i] = (unsigned)(sR[i] * K + sC[i]) * 2u; }
#define PG8_AOFF(u, o0, o1) do { _Pragma("unroll") for (int _i = 0; _i < 2; ++_i) { \
        if constexpr (GATHER) { const int r0_ = sR[_i] < (u).nvalid ? sR[_i] : (u).nvalid - 1, r1_ = (128 + sR[_i]) < (u).nvalid ? 128 + sR[_i] : (u).nvalid - 1; \
            o0[_i] = ((unsigned)(g.list[(u).lbase + r0_] >> 1) * (unsigned)K + (unsigned)sC[_i]) * 2u; o1[_i] = ((unsigned)(g.list[(u).lbase + r1_] >> 1) * (unsigned)K + (unsigned)sC[_i]) * 2u; } \
        else { o0[_i] = (unsigned)(sR[_i] * K + sC[_i]) * 2u; o1[_i] = o0[_i] + (unsigned)(HALF * K * 2); } } } while (0)
    const size_t kstep = (size_t)(BK * 2);
    const size_t hstep = (size_t)HALF * K * 2;
    const size_t tstep = 2 * hstep;
    const unsigned ldsw = (unsigned)wid * 1024u;
    const int aoff = lds_byte(wr * 64 + fr, fq * 8), boff = lds_byte(wc * 32 + fr, fq * 8);
#define PG8_SA(b, h) (((b) * 2 + (h)) * HTB)
#define PG8_SB(b, h) ((4 + (b) * 2 + (h)) * HTB)
#define PG8_STAGE(bufoff, gbase, voff) do { _Pragma("unroll") for (int _i = 0; _i < 2; ++_i) \
        __builtin_amdgcn_global_load_lds((const unsigned*)((const char*)(gbase) + (voff)[_i]), (LAS unsigned*)(lds + (bufoff) + ldsw + _i * 8192), 16, 0, 0); } while (0)
#define PG8_LDA(dst, b, h) do { _Pragma("unroll") for (int m = 0; m < 4; ++m) _Pragma("unroll") for (int k = 0; k < 2; ++k) dst[m][k] = *(const LAS bf16x8*)(lds + PG8_SA(b, h) + aoff + m * 2048 + k * 1024); } while (0)
#define PG8_LDB(dst, b, h) do { _Pragma("unroll") for (int n = 0; n < 2; ++n) _Pragma("unroll") for (int k = 0; k < 2; ++k) dst[n][k] = *(const LAS bf16x8*)(lds + PG8_SB(b, h) + boff + n * 2048 + k * 1024); } while (0)
#define PG8_MMA(ai, bj, At, Bt) do { __builtin_amdgcn_s_setprio(1); _Pragma("unroll") for (int m = 0; m < 4; ++m) _Pragma("unroll") for (int n = 0; n < 2; ++n) _Pragma("unroll") for (int k = 0; k < 2; ++k) \
        acc[ai][bj][m][n] = __builtin_amdgcn_mfma_f32_16x16x32_bf16(Bt[n][k], At[m][k], acc[ai][bj][m][n], 0, 0, 0); __builtin_amdgcn_s_setprio(0); } while (0)
#define PG8_WAIT_V(n) asm volatile("s_waitcnt vmcnt(" #n ")" ::: "memory")
#define PG8_WAIT_L(n) asm volatile("s_waitcnt lgkmcnt(" #n ")" ::: "memory")
#define PG8_BAR __builtin_amdgcn_s_barrier()
#define PG8_SCHED __builtin_amdgcn_sched_barrier(0)
    Unit cur, nxt; int ui = 0;
    if (!S.next(0, cur)) return;
    f32x4 acc[2][2][4][2];
#pragma unroll
    for (int a = 0; a < 2; ++a)
#pragma unroll
        for (int b = 0; b < 2; ++b)
#pragma unroll
            for (int m = 0; m < 4; ++m)
#pragma unroll
                for (int n = 0; n < 2; ++n) acc[a][b][m][n] = (f32x4){0.f, 0.f, 0.f, 0.f};
    bf16x8 At[4][2], B0[2][2], B1[2][2];
    const char* cA = (const char*)g.A + (GATHER ? (size_t)0 : (size_t)cur.pm * tstep); const char* cB = (const char*)g.Bt + (size_t)cur.pn * tstep;
    PG8_AOFF(cur, v0, v1);
    if constexpr (SP2) {
        PG8_STAGE(PG8_SB(0, 0), cB, voffB); PG8_STAGE(PG8_SB(0, 1), cB + hstep, voffB); PG8_STAGE(PG8_SA(0, 0), cA, v0); PG8_STAGE(PG8_SA(0, 1), cA, v1);
        if (wr == 1) PG8_BAR;
        PG8_WAIT_V(2); PG8_BAR;
        PG8_STAGE(PG8_SB(1, 0), cB + kstep, voffB); PG8_STAGE(PG8_SA(1, 0), cA + kstep, v0); PG8_STAGE(PG8_SB(1, 1), cB + hstep + kstep, voffB);
        PG8_WAIT_V(6); PG8_BAR;
    } else {
        PG8_STAGE(PG8_SB(0, 0), cB, voffB); PG8_STAGE(PG8_SA(0, 0), cA, v0); PG8_STAGE(PG8_SB(0, 1), cB + hstep, voffB); PG8_STAGE(PG8_SA(0, 1), cA, v1);
        if (wr == 1) PG8_BAR;
        PG8_WAIT_V(4); PG8_BAR;
        PG8_STAGE(PG8_SB(1, 0), cB + kstep, voffB); PG8_STAGE(PG8_SA(1, 0), cA + kstep, v0); PG8_STAGE(PG8_SB(1, 1), cB + hstep + kstep, voffB);
        PG8_WAIT_V(6); PG8_BAR;
    }
    for (;;) {
        const bool has_next = S.next(ui + 1, nxt);
        const char* nA = (has_next && !GATHER) ? (const char*)g.A + (size_t)nxt.pm * tstep : cA; const char* nB = has_next ? (const char*)g.Bt + (size_t)nxt.pn * tstep : cB;
        if (has_next) { PG8_AOFF(nxt, nv0, nv1); } else { _Pragma("unroll") for (int _i = 0; _i < 2; ++_i) { nv0[_i] = v0[_i]; nv1[_i] = v1[_i]; } }
#pragma unroll 1
        for (int t = 0; t < nt; t += 2) {
            const bool last = (t == nt - 2);
            const char* a1 = cA + (size_t)(t + 1) * kstep;
            const char* a2 = last ? nA : cA + (size_t)(t + 2) * kstep; const char* b2 = last ? nB : cB + (size_t)(t + 2) * kstep;
            const char* a3 = a2 + kstep; const char* b3 = b2 + kstep;
            unsigned w0[2], w1[2];
#pragma unroll
            for (int _i = 0; _i < 2; ++_i) { w0[_i] = last ? nv0[_i] : v0[_i]; w1[_i] = last ? nv1[_i] : v1[_i]; }
            if constexpr (SP2) {
            PG8_LDB(B0, 0, 0); PG8_LDB(B1, 0, 1); PG8_SCHED; PG8_LDA(At, 0, 0); PG8_STAGE(PG8_SA(1, 1), a1, v1);
            PG8_WAIT_V(8); PG8_WAIT_L(0); PG8_BAR; PG8_MMA(0, 0, At, B0); PG8_MMA(0, 1, At, B1); PG8_BAR; PG8_SCHED;
            PG8_LDA(At, 0, 1); PG8_STAGE(PG8_SB(0, 0), b2, voffB); PG8_STAGE(PG8_SB(0, 1), b2 + hstep, voffB); PG8_STAGE(PG8_SA(0, 0), a2, w0);
            PG8_WAIT_V(8); PG8_WAIT_L(0); PG8_BAR; PG8_MMA(1, 0, At, B0); PG8_MMA(1, 1, At, B1); PG8_BAR; PG8_SCHED;
            PG8_LDB(B0, 1, 0); PG8_LDB(B1, 1, 1); PG8_SCHED; PG8_LDA(At, 1, 0); PG8_STAGE(PG8_SA(0, 1), a2, w1);
            PG8_WAIT_V(8); PG8_WAIT_L(0); PG8_BAR; PG8_MMA(0, 0, At, B0); PG8_MMA(0, 1, At, B1); PG8_BAR; PG8_SCHED;
            PG8_LDA(At, 1, 1); PG8_STAGE(PG8_SB(1, 0), b3, voffB); PG8_STAGE(PG8_SB(1, 1), b3 + hstep, voffB); PG8_STAGE(PG8_SA(1, 0), a3, w0);
            PG8_WAIT_V(8); PG8_WAIT_L(0); PG8_BAR; PG8_MMA(1, 0, At, B0); PG8_MMA(1, 1, At, B1); PG8_BAR; PG8_SCHED;
            } else {
            PG8_LDB(B0, 0, 0); PG8_SCHED; PG8_LDA(At, 0, 0); PG8_STAGE(PG8_SA(1, 1), a1, v1);
            PG8_WAIT_L(8); PG8_BAR; PG8_WAIT_L(0); PG8_MMA(0, 0, At, B0); PG8_BAR; PG8_SCHED;
            PG8_LDB(B1, 0, 1); PG8_STAGE(PG8_SB(0, 0), b2, voffB);
            PG8_BAR; PG8_WAIT_L(0); PG8_MMA(0, 1, At, B1); PG8_BAR;
            PG8_LDA(At, 0, 1); PG8_STAGE(PG8_SA(0, 0), a2, w0);
            PG8_BAR; PG8_WAIT_L(0); PG8_MMA(1, 0, At, B0); PG8_BAR; PG8_SCHED;
            PG8_STAGE(PG8_SB(0, 1), b2 + hstep, voffB);
            PG8_WAIT_V(6); PG8_BAR; PG8_MMA(1, 1, At, B1); PG8_BAR;
            PG8_LDB(B0, 1, 0); PG8_SCHED; PG8_LDA(At, 1, 0); PG8_STAGE(PG8_SA(0, 1), a2, w1);
            PG8_WAIT_L(8); PG8_BAR; PG8_WAIT_L(0); PG8_MMA(0, 0, At, B0); PG8_BAR; PG8_SCHED;
            PG8_LDB(B1, 1, 1); PG8_STAGE(PG8_SB(1, 0), b3, voffB);
            PG8_BAR; PG8_WAIT_L(0); PG8_MMA(0, 1, At, B1); PG8_BAR;
            PG8_LDA(At, 1, 1); PG8_STAGE(PG8_SA(1, 0), a3, w0);
            PG8_BAR; PG8_WAIT_L(0); PG8_MMA(1, 0, At, B0); PG8_BAR; PG8_SCHED;
            PG8_STAGE(PG8_SB(1, 1), b3 + hstep, voffB);
            PG8_WAIT_V(6); PG8_BAR; PG8_MMA(1, 1, At, B1); PG8_BAR;
            }
        }
        if constexpr (ALIGN_EPI) { if (wr == 0) PG8_BAR; }
        E(acc, cur, wr, wc, fr, fq);
        if (!has_next) break;
#pragma unroll
        for (int a = 0; a < 2; ++a)
#pragma unroll
            for (int b = 0; b < 2; ++b)
#pragma unroll
                for (int m = 0; m < 4; ++m)
#pragma unroll
                    for (int n = 0; n < 2; ++n) acc[a][b][m][n] = (f32x4){0.f, 0.f, 0.f, 0.f};
        cur = nxt; cA = nA; cB = nB; ++ui;
#pragma unroll
        for (int _i = 0; _i < 2; ++_i) { v0[_i] = nv0[_i]; v1[_i] = nv1[_i]; }
        if constexpr (ALIGN_EPI) { if (wr == 1) PG8_BAR; }
    }
    PG8_WAIT_V(0);
    if constexpr (!ALIGN_EPI) { if (wr == 0) PG8_BAR; }
    PG8_BAR;
#undef PG8_AOFF
#undef PG8_SA
#undef PG8_SB
#undef PG8_STAGE
#undef PG8_LDA
#undef PG8_LDB
#undef PG8_MMA
#undef PG8_WAIT_V
#undef PG8_WAIT_L
#undef PG8_BAR
#undef PG8_SCHED
}
__device__ __forceinline__ void st8(bf16* p, f32x4 a, f32x4 b) { v4u w; w.x = pk2(a[0], a[1]); w.y = pk2(a[2], a[3]); w.z = pk2(b[0], b[1]); w.w = pk2(b[2], b[3]); *(v4u*)p = w; }
__device__ __forceinline__ void st4(bf16* p, f32x4 a) { v2u w; w.x = pk2(a[0], a[1]); w.y = pk2(a[2], a[3]); *(v2u*)p = w; }
__device__ __forceinline__ f32x4 up4(unsigned lo, unsigned hi) { return (f32x4){bflo(lo), bfhi(lo), bflo(hi), bfhi(hi)}; }
__device__ __forceinline__ float dot4(f32x4 a) { return (a[0] * a[0] + a[1] * a[1]) + (a[2] * a[2] + a[3] * a[3]); }
__device__ __forceinline__ float scan16(float v, int fr) {
    float t;
    t = __shfl_up(v, 1, 16); if (fr >= 1) v += t;
    t = __shfl_up(v, 2, 16); if (fr >= 2) v += t;
    t = __shfl_up(v, 4, 16); if (fr >= 4) v += t;
    t = __shfl_up(v, 8, 16); if (fr >= 8) v += t;
    return v;
}

struct EpiIn {
    unsigned char *wsb, *dob;
#define EI_W(type, off) ((type*)(wsb + (off)))
#define EI_D(type, off) ((type*)(dob + (off)))
    __device__ __forceinline__ void hgrn(const f32x4 (&acc)[2][2][4][2], const Unit& u, int wr, int wc, int fr, int fq) const {
        const int hh = u.pn >> 1, cb = u.pn & 1;
        const int gch0 = hh * 128 + cb * 64 + wc * 16 + fq * 4;
        bf16* const QF = EI_D(bf16, DO_QF); bf16* const KF = EI_D(bf16, DO_KF); bf16* const QB = EI_D(bf16, DO_QB); bf16* const KB = EI_D(bf16, DO_KB); bf16* const VA = EI_W(bf16, WS_VA);
        float* const EREF = EI_W(float, WS_EREF); float* const ELAST = EI_W(float, WS_ELAST); const float* const LB = EI_W(float, WS_LB);
        const f32x4 lbf = *(const f32x4*)(LB + gch0), lbb = *(const f32x4*)(LB + 512 + gch0);
#pragma unroll
        for (int ai = 0; ai < 2; ++ai) {
            const int cidx = u.pm * 4 + ai * 2 + wr;
            const size_t off0 = (size_t)(u.pm * 256 + ai * 128 + wr * 64 + fr) * 512 + gch0;
#pragma unroll
            for (int m = 0; m < 4; ++m) st4(VA + off0 + (size_t)m * 16 * 512, acc[ai][1][m][1]);
#pragma unroll
            for (int jp = 0; jp < 2; ++jp) {
                f32x2 qo[4], ko[4];
#pragma unroll
                for (int jj = 0; jj < 2; ++jj) { const int j = 2 * jp + jj;
                    float lf[4], kk[4];
#pragma unroll
                    for (int m = 0; m < 4; ++m) { const float z = fminf(fmaxf(acc[ai][0][m][1][j], -30.f), 30.f), e = __expf(-z), s = 1.0f / (1.0f + e); kk[m] = (1.0f - lbf[j]) * e * s; lf[m] = __logf(lbf[j] + (1.0f - lbf[j]) * s); }
                    float G[4], carry = 0.f;
#pragma unroll
                    for (int m = 0; m < 4; ++m) { G[m] = scan16(lf[m], fr) + carry; carry = __shfl(G[m], 15, 16); }
                    const float Gref = __shfl(G[1], 15, 16);
#pragma unroll
                    for (int m = 0; m < 4; ++m) { qo[m][jj] = silu_(acc[ai][0][m][0][j]) * __expf(G[m] - Gref); ko[m][jj] = kk[m] * __expf(fminf(Gref - G[m], 80.f)); }
                    if (fr == 0) { EREF[(size_t)cidx * 512 + gch0 + j] = __expf(Gref); ELAST[(size_t)cidx * 512 + gch0 + j] = __expf(carry - Gref); }
                }
#pragma unroll
                for (int m = 0; m < 4; ++m) { *(unsigned*)(QF + off0 + (size_t)m * 16 * 512 + 2 * jp) = pk2(qo[m][0], qo[m][1]); *(unsigned*)(KF + off0 + (size_t)m * 16 * 512 + 2 * jp) = pk2(ko[m][0], ko[m][1]); }
                asm volatile("" ::: "memory");
#pragma unroll
                for (int jj = 0; jj < 2; ++jj) { const int j = 2 * jp + jj;
                    float lw[4], kk[4];
#pragma unroll
                    for (int m = 0; m < 4; ++m) { const float z = fminf(fmaxf(acc[ai][1][m][0][j], -30.f), 30.f), e = __expf(-z), s = 1.0f / (1.0f + e); kk[m] = (1.0f - lbb[j]) * e * s; lw[m] = __logf(lbb[j] + (1.0f - lbb[j]) * s); }
                    float P[4], carry = 0.f;
#pragma unroll
                    for (int m = 0; m < 4; ++m) { P[m] = scan16(lw[m], fr) + carry; carry = __shfl(P[m], 15, 16); }
                    float Gb[4];
#pragma unroll
                    for (int m = 0; m < 4; ++m) Gb[m] = carry - (P[m] - lw[m]);
                    const float Gbref = __shfl(Gb[2], 0, 16);
#pragma unroll
                    for (int m = 0; m < 4; ++m) { qo[m][jj] = silu_(acc[ai][0][m][0][j]) * __expf(Gb[m] - Gbref); ko[m][jj] = kk[m] * __expf(fminf(Gbref - Gb[m], 80.f)); }
                    if (fr == 0) { EREF[(size_t)(NCHUNK + cidx) * 512 + gch0 + j] = __expf(Gbref); ELAST[(size_t)(NCHUNK + cidx) * 512 + gch0 + j] = __expf(carry - Gbref); }
                }
#pragma unroll
                for (int m = 0; m < 4; ++m) { *(unsigned*)(QB + off0 + (size_t)m * 16 * 512 + 2 * jp) = pk2(qo[m][0], qo[m][1]); *(unsigned*)(KB + off0 + (size_t)m * 16 * 512 + 2 * jp) = pk2(ko[m][0], ko[m][1]); }
                asm volatile("" ::: "memory");
            }
        }
    }
    __device__ __forceinline__ void operator()(const f32x4 (&acc)[2][2][4][2], const Unit& u, int wr, int wc, int fr, int fq) const {
        const int pn = u.pn, row0 = u.pm * 256 + wr * 64 + fr;
        if (pn < 8) { hgrn(acc, u, wr, wc, fr, fq); return; }
        bf16* const OG = EI_W(bf16, WS_OG); bf16* const CQ = EI_W(bf16, WS_CQ); bf16* const CKVR = EI_W(bf16, WS_CKVR); bf16* const GA = EI_W(bf16, WS_GA); bf16* const GB = EI_W(bf16, WS_GB);
        float* const CQSS = EI_W(float, WS_CQSS); float* const CKVSS = EI_W(float, WS_CKVSS); float* const KR = EI_W(float, WS_KR);
        if (pn == 10) {
#pragma unroll
            for (int ai = 0; ai < 2; ++ai)
#pragma unroll
                for (int m = 0; m < 4; ++m) { const int row = row0 + ai * 128 + m * 16; float ss = 0.f;
#pragma unroll
                    for (int bj = 0; bj < 2; ++bj) { const f32x4 a = acc[ai][bj][m][0], b = acc[ai][bj][m][1]; ss += dot4(a) + dot4(b); st8(CQ + (size_t)row * 256 + bj * 128 + wc * 32 + 8 * fq, a, b); }
                    ss += __shfl_xor(ss, 16); ss += __shfl_xor(ss, 32); if (fq == 0) CQSS[(size_t)row * 4 + wc] = ss; }
            return;
        }
        if (pn == 11) {
#pragma unroll
            for (int ai = 0; ai < 2; ++ai)
#pragma unroll
                for (int m = 0; m < 4; ++m) { const int row = row0 + ai * 128 + m * 16;
                    const f32x4 a0 = acc[ai][0][m][0], b0 = acc[ai][0][m][1], a1 = acc[ai][1][m][0], b1 = acc[ai][1][m][1];
                    float ss = dot4(a0) + dot4(b0); ss += __shfl_xor(ss, 16); ss += __shfl_xor(ss, 32); if (fq == 0) CKVSS[(size_t)row * 4 + wc] = ss;
                    st8(CKVR + (size_t)row * 256 + wc * 32 + 8 * fq, a0, b0); st8(CKVR + (size_t)row * 256 + 128 + wc * 32 + 8 * fq, a1, b1);
                    if (wc == 0) { *(f32x4*)(KR + (size_t)row * 32 + 8 * fq) = a1; *(f32x4*)(KR + (size_t)row * 32 + 8 * fq + 4) = b1; } }
            return;
        }
        const bool sil = pn < 10; const int ld = sil ? 512 : 1024, cb = (sil ? pn - 8 : (pn - 12) & 3) * 256;
        const size_t dsto = sil ? (size_t)0 : (pn < 16 ? (size_t)((unsigned char*)GA - (unsigned char*)OG) : (size_t)((unsigned char*)GB - (unsigned char*)OG));
        bf16* dst = (bf16*)((unsigned char*)OG + dsto);
#pragma unroll
        for (int ai = 0; ai < 2; ++ai)
#pragma unroll
            for (int m = 0; m < 4; ++m)
#pragma unroll
                for (int bj = 0; bj < 2; ++bj) { f32x4 a = acc[ai][bj][m][0], b = acc[ai][bj][m][1];
#pragma unroll
                    for (int j = 0; j < 4; ++j) { a[j] = sil ? silu_(a[j]) : sigm(a[j]); b[j] = sil ? silu_(b[j]) : sigm(b[j]); }
                    st8(dst + (size_t)(row0 + ai * 128 + m * 16) * ld + cb + bj * 128 + wc * 32 + 8 * fq, a, b); }
    }
};

struct EpiQ {
    bf16* QM; const float* CQSS;
    __device__ __forceinline__ void operator()(const f32x4 (&acc)[2][2][4][2], const Unit& u, int wr, int wc, int fr, int fq) const {
#pragma unroll
        for (int ai = 0; ai < 2; ++ai)
#pragma unroll
            for (int m = 0; m < 4; ++m) { const int row = u.pm * 256 + ai * 128 + wr * 64 + m * 16 + fr;
                const f32x4 s4 = *(const f32x4*)(CQSS + (size_t)row * 4); const float rs = rsqrtf(((s4[0] + s4[1]) + (s4[2] + s4[3])) * (1.0f / 256.0f) + EPS);
#pragma unroll
                for (int bj = 0; bj < 2; ++bj) st8(QM + (size_t)row * 768 + u.pn * 256 + bj * 128 + wc * 32 + 8 * fq, acc[ai][bj][m][0] * rs, acc[ai][bj][m][1] * rs);
                asm volatile("" ::: "memory"); }
    }
};
struct EpiKV {
    bf16 *KH, *VH; const float *CKVSS, *KR, *ROPE_, *KN;
    __device__ __forceinline__ void operator()(const f32x4 (&acc)[2][2][4][2], const Unit& u, int wr, int wc, int fr, int fq) const {
        const int pn = u.pn, head = (pn & 1) * 4 + wc;
#pragma unroll
        for (int ai = 0; ai < 2; ++ai)
#pragma unroll
            for (int m = 0; m < 4; ++m) { const int row = u.pm * 256 + ai * 128 + wr * 64 + m * 16 + fr;
                const f32x4 s4 = *(const f32x4*)(CKVSS + (size_t)row * 4); const float rs = rsqrtf(((s4[0] + s4[1]) + (s4[2] + s4[3])) * (1.0f / 128.0f) + EPS);
                if (pn >= 2) {
#pragma unroll
                    for (int bj = 0; bj < 2; ++bj) st8(VH + ((size_t)row * 8 + head) * 64 + bj * 32 + 8 * fq, acc[ai][bj][m][0] * rs, acc[ai][bj][m][1] * rs);
                } else {
                    float ss = 0.f;
#pragma unroll
                    for (int bj = 0; bj < 2; ++bj)
#pragma unroll
                        for (int n = 0; n < 2; ++n) ss += dot4(acc[ai][bj][m][n]);
                    ss *= rs * rs;
                    const f32x4 x1 = *(const f32x4*)(KR + (size_t)row * 32 + 4 * fq), x2 = *(const f32x4*)(KR + (size_t)row * 32 + 16 + 4 * fq);
                    ss += dot4(x1) + dot4(x2);
                    ss += __shfl_xor(ss, 16); ss += __shfl_xor(ss, 32);
                    const float rk = rsqrtf(ss * (1.0f / 96.0f) + EPS), rr = rs * rk;
                    bf16* kp = KH + ((size_t)row * 8 + head) * 96;
#pragma unroll
                    for (int bj = 0; bj < 2; ++bj) { const f32x4 g0 = *(const f32x4*)(KN + bj * 32 + 8 * fq), g1 = *(const f32x4*)(KN + bj * 32 + 8 * fq + 4);
                        st8(kp + bj * 32 + 8 * fq, acc[ai][bj][m][0] * rr * g0, acc[ai][bj][m][1] * rr * g1); }
                    { const f32x4 c = *(const f32x4*)(ROPE_ + (size_t)row * 32 + 4 * fq), s = *(const f32x4*)(ROPE_ + (size_t)row * 32 + 16 + 4 * fq);
                      const f32x4 y1 = x1 * rk * *(const f32x4*)(KN + 64 + 4 * fq), y2 = x2 * rk * *(const f32x4*)(KN + 80 + 4 * fq);
                      st4(kp + 64 + 4 * fq, y1 * c - y2 * s); st4(kp + 80 + 4 * fq, y2 * c + y1 * s); }
                }
                asm volatile("" ::: "memory"); }
    }
};
struct EpiMerge {
    bf16* MG; const bf16 *GA, *GB;
    __device__ __forceinline__ void operator()(const f32x4 (&acc)[2][2][4][2], const Unit& u, int wr, int wc, int fr, int fq) const {
        const bool which = u.pm >= T / 256; const int pm = u.pm - (which ? T / 256 : 0), pn = u.pn - (which ? D / 256 : 0); const bf16* Gt = (const bf16*)((const unsigned char*)GA + (which ? (size_t)((const unsigned char*)GB - (const unsigned char*)GA) : (size_t)0));
#pragma unroll
        for (int ai = 0; ai < 2; ++ai)
#pragma unroll
            for (int m = 0; m < 4; ++m)
#pragma unroll
                for (int bj = 0; bj < 2; ++bj) { const size_t off = (size_t)(pm * 256 + ai * 128 + wr * 64 + m * 16 + fr) * 1024 + pn * 256 + bj * 128 + wc * 32 + 8 * fq;
                    const v4u g = *(const v4u*)(Gt + off); f32x4 a = acc[ai][bj][m][0] * up4(g.x, g.y), b = acc[ai][bj][m][1] * up4(g.z, g.w);
                    if (which) { const v4u o = *(const v4u*)(MG + off); a += up4(o.x, o.y); b += up4(o.z, o.w); }
                    st8(MG + off, a, b); if (bj == 1) asm volatile("" ::: "memory"); }
    }
};
struct EpiX2 {
    const float* X; float* O;
    __device__ __forceinline__ void operator()(const f32x4 (&acc)[2][2][4][2], const Unit& u, int wr, int wc, int fr, int fq) const {
#pragma unroll
        for (int ai = 0; ai < 2; ++ai)
#pragma unroll
            for (int m = 0; m < 4; ++m)
#pragma unroll
                for (int bj = 0; bj < 2; ++bj)
#pragma unroll
                    for (int n = 0; n < 2; ++n) { const size_t off = (size_t)(u.pm * 256 + ai * 128 + wr * 64 + m * 16 + fr) * 1024 + u.pn * 256 + bj * 128 + wc * 32 + n * 16 + 4 * fq;
                        *(f32x4*)(O + off) = *(const f32x4*)(X + off) + acc[ai][bj][m][n]; if (n == 1 && bj == 1) asm volatile("" ::: "memory"); }
    }
};
struct EpiUp {
    bf16* H1; const int* LIST; const float* RS2;
    __device__ __forceinline__ void operator()(const f32x4 (&acc)[2][2][4][2], const Unit& u, int wr, int wc, int fr, int fq) const {
        const int pl = u.pn & 1;
#pragma unroll
        for (int ai = 0; ai < 2; ++ai)
#pragma unroll
            for (int m = 0; m < 4; ++m) { const int r = ai * 128 + wr * 64 + m * 16 + fr; const int rr = r < u.nvalid ? r : u.nvalid - 1;
                const float rs = RS2[LIST[u.lbase + rr] >> 1];
                f32x4 a = acc[ai][0][m][0] * rs, b = acc[ai][0][m][1] * rs;
#pragma unroll
                for (int j = 0; j < 4; ++j) { a[j] = silu_(a[j]) * (acc[ai][1][m][0][j] * rs); b[j] = silu_(b[j]) * (acc[ai][1][m][1][j] * rs); }
                st8(H1 + (size_t)(u.pm * 256 + r) * 256 + pl * 128 + wc * 32 + 8 * fq, a, b);
                asm volatile("" ::: "memory"); }
    }
};
struct EpiDown {
    bf16 *Y0, *Y1; const int* LIST; const float* EW;
    __device__ __forceinline__ void operator()(const f32x4 (&acc)[2][2][4][2], const Unit& u, int wr, int wc, int fr, int fq) const {
        const int pl = u.pn & 3;
#pragma unroll
        for (int ai = 0; ai < 2; ++ai)
#pragma unroll
            for (int m = 0; m < 4; ++m) { const int r = ai * 128 + wr * 64 + m * 16 + fr;
                if (r < u.nvalid) { const int ent = LIST[u.lbase + r]; const float w = EW[ent];
                    const unsigned eo = (unsigned)(ent >> 1) * 1024u + (unsigned)(pl * 256 + wc * 32 + 8 * fq) + ((ent & 1) ? (unsigned)(((unsigned char*)Y1 - (unsigned char*)Y0) / 2) : 0u);
#pragma unroll
                    for (int bj = 0; bj < 2; ++bj) st8(Y0 + eo + bj * 128, acc[ai][bj][m][0] * w, acc[ai][bj][m][1] * w); }
                asm volatile("" ::: "memory"); }
    }
};
struct EpiProj {
    bf16* PR;
    __device__ __forceinline__ void operator()(const f32x4 (&acc)[2][2][4][2], const Unit& u, int wr, int wc, int fr, int fq) const {
#pragma unroll
        for (int ai = 0; ai < 2; ++ai)
#pragma unroll
            for (int m = 0; m < 4; ++m)
#pragma unroll
                for (int bj = 0; bj < 2; ++bj) st8(PR + (size_t)(u.pm * 256 + ai * 128 + wr * 64 + m * 16 + fr) * 1024 + u.pn * 256 + bj * 128 + wc * 32 + 8 * fq, acc[ai][bj][m][0], acc[ai][bj][m][1]);
    }
};
struct EpiFinal {
    float* O; const bf16* PR;
    __device__ __forceinline__ void operator()(const f32x4 (&acc)[2][2][4][2], const Unit& u, int wr, int wc, int fr, int fq) const {
#pragma unroll
        for (int ai = 0; ai < 2; ++ai)
#pragma unroll
            for (int m = 0; m < 4; ++m)
#pragma unroll
                for (int bj = 0; bj < 2; ++bj)
#pragma unroll
                    for (int n = 0; n < 2; ++n) { const size_t off = (size_t)(u.pm * 256 + ai * 128 + wr * 64 + m * 16 + fr) * 1024 + u.pn * 256 + bj * 128 + wc * 32 + n * 16 + 4 * fq;
                        const v2u pr = *(const v2u*)(PR + off); f32x4 g = acc[ai][bj][m][n];
#pragma unroll
                        for (int j = 0; j < 4; ++j) g[j] = sigm(g[j]);
                        *(f32x4*)(O + off) = *(const f32x4*)(O + off) + up4(pr.x, pr.y) * g; if (n == 1 && bj == 1) asm volatile("" ::: "memory"); }
    }
};
struct Frame {
    LAS unsigned char* lds; unsigned char* gl;
    volatile LAS unsigned* MISC; gu32* ctl;
    int tid, lane, wave, vcu, G;
    const float* in[27]; float* out; unsigned char* ws;
};
#define WSP(type, off) ((type*)(F.ws + (off)))
#define DOP(type, off) ((type*)((unsigned char*)F.out + (off)))
enum { I_X = 0, I_P, I_POS, I_LNMIX, I_WIN, I_HGLB, I_HGON, I_WOA, I_QAN, I_KVAN, I_WUQ, I_WUKV, I_QN, I_KN, I_WOB, I_WOUT, I_LNMOE, I_WRG, I_BRG, I_WRE, I_BRE, I_W1, I_W3, I_W2, I_LNPLE, I_WPG, I_WPP };

enum { M_WIN = 0, M_WOAB, M_WUQ, M_WUKV, M_WOUT, M_WPG, M_WPP, M_W13, M_W2T };
template <int MAT> struct MatInfo;
template <> struct MatInfo<M_WIN>  { static constexpr int K = 1024, NP = NIN; };
template <> struct MatInfo<M_WOAB> { static constexpr int K = 512,  NP = 2048; };
template <> struct MatInfo<M_WUQ>  { static constexpr int K = 256,  NP = 768; };
template <> struct MatInfo<M_WUKV> { static constexpr int K = 256,  NP = 1024; };
template <> struct MatInfo<M_WOUT> { static constexpr int K = 1024, NP = 1024; };
template <> struct MatInfo<M_WPG>  { static constexpr int K = 1024, NP = 1024; };
template <> struct MatInfo<M_WPP>  { static constexpr int K = 256,  NP = 1024; };
template <> struct MatInfo<M_W13>  { static constexpr int K = 1024, NP = NE * 512; };
template <> struct MatInfo<M_W2T>  { static constexpr int K = 256,  NP = NE * 1024; };
template <int MAT> __device__ __forceinline__ void conv_item(const Frame& F, int item, int lane, LAS float* scr) {
    constexpr int K = MatInfo<MAT>::K; constexpr int KB = K / 64;
    const int kb = item % KB, p0 = (item / KB) * 32, p = p0 + (lane & 31), k0 = kb * 64;
    const float* src = nullptr; size_t ld = 0; const float* gain = nullptr; int kvalid = K; bf16* dst = nullptr;
    if constexpr (MAT == M_WIN) {
        const int pn = p >> 8; int col;
        if (pn < 8) { const int q = p & 255, bj = q >> 7, wc = (q >> 5) & 3, n = (q >> 4) & 1, fq = (q >> 2) & 3, j = q & 3; const int kind = 2 * bj + n;
            col = kind * 512 + (pn >> 1) * 128 + (pn & 1) * 64 + wc * 16 + fq * 4 + j; }
        else if (pn < 10) col = 2048 + perm8(p - 2048);
        else if (pn == 10) col = 2560 + perm8(p - 2560);
        else if (pn == 11) { const int l = perm8(p - 2816); col = l < 128 ? 2816 + l : (l < 160 ? 2944 + (l - 128) : -1); }
        else if (pn < 16) col = 2976 + perm8(p - 3072);
        else col = 4000 + perm8(p - 4096);
        if (col >= 0) src = F.in[I_WIN] + col; ld = DIN; gain = F.in[I_LNMIX]; dst = WSP(bf16, WS_WIN);
    } else if constexpr (MAT == M_WOAB) { { const float* sa = F.in[I_WOA]; const float* sb = F.in[I_WOB]; src = (const float*)((const unsigned char*)sa + ((p >> 10) ? (size_t)((const unsigned char*)sb - (const unsigned char*)sa) : (size_t)0)) + perm8(p & 1023); } ld = 1024; dst = WSP(bf16, WS_WOAB); }
    else if constexpr (MAT == M_WUQ) { src = F.in[I_WUQ] + perm8(p); ld = 768; gain = F.in[I_QAN]; dst = WSP(bf16, WS_WUQ); }
    else if constexpr (MAT == M_WUKV) { const int pn = p >> 8, q = p & 255, bj = q >> 7, wc = (q >> 5) & 3, n = (q >> 4) & 1, fq = (q >> 2) & 3, j = q & 3;
        const int head = (pn & 1) * 4 + wc, d = 32 * bj + 8 * fq + 4 * n + j; src = F.in[I_WUKV] + head * 128 + (pn >= 2 ? 64 : 0) + d; ld = 1024; gain = F.in[I_KVAN]; kvalid = 128; dst = WSP(bf16, WS_WUKV); }
    else if constexpr (MAT == M_WOUT) { src = F.in[I_WOUT] + p; ld = 1024; dst = WSP(bf16, WS_WOUT); }
    else if constexpr (MAT == M_WPG) { src = F.in[I_WPG] + p; ld = 1024; gain = F.in[I_LNPLE]; dst = WSP(bf16, WS_WPG); }
    else if constexpr (MAT == M_WPP) { src = F.in[I_WPP] + perm8(p); ld = 1024; dst = WSP(bf16, WS_WPP); }
    else if constexpr (MAT == M_W13) { const int e = p >> 9, q = p & 511, pl = q >> 8, bj = (q >> 7) & 1, r = q & 127;
        { const float* sa = F.in[I_W1]; const float* sb = F.in[I_W3]; src = (const float*)((const unsigned char*)sa + (bj ? (size_t)((const unsigned char*)sb - (const unsigned char*)sa) : (size_t)0)) + (size_t)e * 1024 * 256 + pl * 128 + perm8(r); } ld = 256; gain = F.in[I_LNMOE]; dst = WSP(bf16, WS_W13); }
    else { const int e = p >> 10, q = p & 1023; src = F.in[I_W2] + (size_t)e * 256 * 1024 + perm8(q); ld = 1024; dst = WSP(bf16, WS_W2T); }
    float tv[32];
#pragma unroll
    for (int i = 0; i < 32; ++i) { const int k = k0 + 2 * i + (lane >> 5); tv[i] = (src && k < kvalid) ? src[(size_t)k * ld] : 0.0f; }
#pragma unroll
    for (int i = 0; i < 32; ++i) { const int kk = 2 * i + (lane >> 5); scr[kk * 33 + (lane & 31)] = gain ? tv[i] * gain[k0 + kk] : tv[i]; }
    LDS_WAIT(); asm volatile("" ::: "memory");
    const int c = lane & 7;
#pragma unroll
    for (int j = 0; j < 4; ++j) { const int n = (lane >> 3) + 8 * j; const LAS float* sp = scr + (8 * c) * 33 + n;
        v4u o; o.x = pk2(sp[0 * 33], sp[1 * 33]); o.y = pk2(sp[2 * 33], sp[3 * 33]); o.z = pk2(sp[4 * 33], sp[5 * 33]); o.w = pk2(sp[6 * 33], sp[7 * 33]);
        *(v4u*)(dst + (size_t)(p0 + n) * K + k0 + 8 * c) = o; }
    LDS_WAIT(); asm volatile("" ::: "memory");
}
template <int MAT> __device__ __forceinline__ void conv_mat(const Frame& F) {
    constexpr int NITEMS = (MatInfo<MAT>::NP / 32) * (MatInfo<MAT>::K / 64);
    const int gw = F.vcu * NWAVES + F.wave, NGW = F.G * NWAVES;
    LAS float* scr = (LAS float*)(F.lds + F.wave * 16384);
    for (int it = gw; it < NITEMS; it += NGW) conv_item<MAT>(F, it, F.lane, scr);
}

__device__ __forceinline__ void p0_prologue(const Frame& F) {
    conv_mat<M_WIN>(F); conv_mat<M_WOAB>(F); conv_mat<M_WUQ>(F); conv_mat<M_WUKV>(F); conv_mat<M_WOUT>(F); conv_mat<M_WPG>(F); conv_mat<M_WPP>(F);
    const int gt = F.vcu * NTHR + F.tid, NGT = F.G * NTHR;
    for (int i = gt; i < 80 * 1024; i += NGT) { const int o = i >> 10, k = i & 1023; const float wv = o >= 72 ? 0.f : F.in[I_LNMOE][k] * (o < 8 ? F.in[I_WRG][k * 8 + o] : F.in[I_WRE][k * 64 + (o - 8)]);
        const unsigned h = f2bf(wv); WSP(bf16, WS_WRH)[i] = (bf16)h; WSP(bf16, WS_WRL)[i] = (bf16)f2bf(wv - bf2f(h)); }
    for (int i = gt; i < 80; i += NGT) WSP(float, WS_BR)[i] = i < 8 ? F.in[I_BRG][i] : (i < 72 ? F.in[I_BRE][i - 8] : 0.f);
    for (int i = gt; i < 1024; i += NGT) { const int d = i >> 9, f = i & 511; const float a0 = F.in[I_HGLB][d * 1024 + f], a1 = F.in[I_HGLB][d * 1024 + 512 + f]; WSP(float, WS_LB)[i] = 1.0f / (1.0f + expf(a1 - a0)); }
    for (int i = gt; i < T * 16; i += NGT) { const int t = i >> 4, f = i & 15; const float pos = (float)((const int*)F.in[I_POS])[t]; const float inv = exp2f(-(float)f * (13.287712379549449f / 16.0f));
        const float ang = pos * inv;
        const float kq = rintf(ang * 0.15915494309189535f); float r = fmaf(-kq, 6.28318548202514648f, ang); r = fmaf(-kq, -1.7484555e-7f, r);
        WSP(float, WS_ROPE)[t * 32 + f] = __cosf(r); WSP(float, WS_ROPE)[t * 32 + 16 + f] = __sinf(r); }
    const int gw = F.vcu * NWAVES + F.wave, NGW = F.G * NWAVES;
    for (int m = gw; m < T; m += NGW) {
        const float* xr = F.in[I_X] + (size_t)m * D + F.lane * 8; f32x4 v[4]; float ss = 0.f;
#pragma unroll
        for (int j = 0; j < 2; ++j) { v[2 * j] = *(const f32x4*)(xr + 512 * j); v[2 * j + 1] = *(const f32x4*)(xr + 512 * j + 4); ss += dot4(v[2 * j]) + dot4(v[2 * j + 1]); }
        const float rs = rsqrtf(wave_sum(ss) * (1.0f / D) + EPS);
#pragma unroll
        for (int j = 0; j < 2; ++j) st8(WSP(bf16, WS_ACT) + (size_t)m * D + F.lane * 8 + 512 * j, v[2 * j] * rs, v[2 * j + 1] * rs);
        if (F.lane < 32) { const float* pr = F.in[I_P] + (size_t)m * PLE + F.lane * 8; st8(WSP(bf16, WS_PB) + (size_t)m * PLE + F.lane * 8, *(const f32x4*)pr, *(const f32x4*)(pr + 4)); }
    }
}

__device__ __forceinline__ void oa_pass(const Frame& F) {
    const int gw = F.vcu * NWAVES + F.wave, NGW = F.G * NWAVES;
    const bf16* OFp = WSP(bf16, WS_ACT); const bf16* OBp = OFp + (size_t)T * 512; const bf16* OGp = WSP(bf16, WS_OG); bf16* OA = DOP(bf16, DO_OA);
    const int c0 = F.lane * 8; const f32x4 g0 = *(const f32x4*)(F.in[I_HGON] + (c0 & 127)), g1 = *(const f32x4*)(F.in[I_HGON] + (c0 & 127) + 4);
    for (int m = gw; m < T; m += NGW) {
        const size_t off = (size_t)m * 512 + c0;
        const v4u a = *(const v4u*)(OFp + off), b = *(const v4u*)(OBp + off), g = *(const v4u*)(OGp + off);
        f32x4 s0 = up4(a.x, a.y) + up4(b.x, b.y), s1 = up4(a.z, a.w) + up4(b.z, b.w);
        float ss = dot4(s0) + dot4(s1); ss += __shfl_xor(ss, 1); ss += __shfl_xor(ss, 2); ss += __shfl_xor(ss, 4); ss += __shfl_xor(ss, 8);
        const float rs = rsqrtf(ss * (1.0f / 128.0f) + EPS);
        st8(OA + off, s0 * rs * g0 * up4(g.x, g.y), s1 * rs * g1 * up4(g.z, g.w));
    }
}
__device__ __forceinline__ void x3_pass(const Frame& F) {
    const int gw = F.vcu * NWAVES + F.wave, NGW = F.G * NWAVES;
    const bf16* Y0 = WSP(bf16, WS_Y0); const bf16* Y1 = WSP(bf16, WS_Y1); bf16* HP = WSP(bf16, WS_ACT);
    for (int m = gw; m < T; m += NGW) {
        float* xr = F.out + (size_t)m * D + F.lane * 8; f32x4 v[4]; float ss = 0.f;
#pragma unroll
        for (int j = 0; j < 2; ++j) { const size_t o = (size_t)m * D + F.lane * 8 + 512 * j; const v4u a = *(const v4u*)(Y0 + o), b = *(const v4u*)(Y1 + o);
            v[2 * j] = *(const f32x4*)(xr + 512 * j) + up4(a.x, a.y) + up4(b.x, b.y); v[2 * j + 1] = *(const f32x4*)(xr + 512 * j + 4) + up4(a.z, a.w) + up4(b.z, b.w);
            *(f32x4*)(xr + 512 * j) = v[2 * j]; *(f32x4*)(xr + 512 * j + 4) = v[2 * j + 1]; ss += dot4(v[2 * j]) + dot4(v[2 * j + 1]); }
        const float rs = rsqrtf(wave_sum(ss) * (1.0f / D) + EPS);
#pragma unroll
        for (int j = 0; j < 2; ++j) st8(HP + (size_t)m * D + F.lane * 8 + 512 * j, v[2 * j] * rs, v[2 * j + 1] * rs);
    }
}
__device__ __forceinline__ void moe_build_table(const Frame& F) {
    LAS int* tab = (LAS int*)(F.lds + TAB_OFF);
    if (F.tid == 0) { int rt = 0;
        for (int e = 0; e < NE; ++e) { const int cnt = (int)__hip_atomic_load(F.ctl + CW_CNT + 64 * e, RLX_AGENT); const int nt = (cnt + 255) >> 8;
            for (int lt = 0; lt < nt; ++lt) { tab[16 + 4 * rt] = e; tab[16 + 4 * rt + 1] = e * T + 256 * lt; const int rem = cnt - 256 * lt; tab[16 + 4 * rt + 2] = rem < 256 ? rem : 256; ++rt; } }
        tab[0] = rt; }
    __syncthreads();
}
__device__ __forceinline__ void hgrn_naive(const Frame& F) {
    float* Qs = (float*)F.gl; float* Ks = Qs + 64 * 128; float* Vs = Ks + 64 * 128; float* Ps = Vs + 64 * 64; float* Os = Ps + 64 * 64;
    const int v = F.tid & 63, kq = F.tid >> 6;
    for (int item = blockIdx.x; item < NB * HGH * 2 * 2; item += F.G) {
        const int vh = item & 1, dir = (item >> 1) & 1, hh = (item >> 2) & 3, b = item >> 4;
        const bf16* Qd = DOP(bf16, dir ? DO_QB : DO_QF); const bf16* Kd = DOP(bf16, dir ? DO_KB : DO_KF); const bf16* Va = WSP(bf16, WS_VA);
        bf16* Od = WSP(bf16, WS_ACT) + (dir ? (size_t)T * 512 : 0);
        const float* ER = WSP(float, WS_EREF) + (size_t)dir * NCHUNK * 512; const float* EL = WSP(float, WS_ELAST) + (size_t)dir * NCHUNK * 512;
        float M[16];
#pragma unroll
        for (int i = 0; i < 16; ++i) M[i] = 0.f;
        for (int cc = 0; cc < 32; ++cc) {
            const int c = dir ? 31 - cc : cc, gc = b * 32 + c, t0 = gc * 64;
            __syncthreads();
            for (int idx = F.tid; idx < 64 * 128; idx += NTHR) { const int t = idx >> 7, ch = idx & 127; const size_t o = (size_t)(t0 + t) * 512 + hh * 128 + ch; Qs[idx] = bf2f(Qd[o]); Ks[idx] = bf2f(Kd[o]); }
            for (int idx = F.tid; idx < 64 * 64; idx += NTHR) { const int t = idx >> 6, vv = idx & 63; Vs[idx] = bf2f(Va[(size_t)(t0 + t) * 512 + hh * 128 + vh * 64 + vv]); Os[idx] = 0.f; }
            __syncthreads();
            for (int idx = F.tid; idx < 64 * 64; idx += NTHR) { const int t = idx >> 6, s = idx & 63; const bool ok = dir ? (s >= t) : (s <= t); float a = 0.f;
                if (ok) for (int ch = 0; ch < 128; ++ch) a += Qs[t * 128 + ch] * Ks[s * 128 + ch];
                Ps[idx] = a; }
            __syncthreads();
            for (int t = 0; t < 64; ++t) { float a = 0.f;
#pragma unroll
                for (int i = 0; i < 16; ++i) a += Qs[t * 128 + kq * 16 + i] * M[i];
#pragma unroll
                for (int s = 0; s < 8; ++s) a += Ps[t * 64 + kq * 8 + s] * Vs[(kq * 8 + s) * 64 + v];
                atomicAdd(&Os[t * 64 + v], a); }
            __syncthreads();
            for (int idx = F.tid; idx < 64 * 64; idx += NTHR) { const int t = idx >> 6, vv = idx & 63; Od[(size_t)(t0 + t) * 512 + hh * 128 + vh * 64 + vv] = (bf16)f2bf(Os[idx]); }
            const int cn = dir ? c - 1 : c + 1; const bool has = cc < 31;
#pragma unroll
            for (int i = 0; i < 16; ++i) { float u = 0.f; const int ch = kq * 16 + i;
                for (int t = 0; t < 64; ++t) u += Ks[t * 128 + ch] * Vs[t * 64 + v];
                const float d = has ? EL[(size_t)gc * 512 + hh * 128 + ch] * ER[(size_t)(b * 32 + cn) * 512 + hh * 128 + ch] : 0.f;
                M[i] = (M[i] + u) * d; }
        }
    }
    __syncthreads();
}
__device__ __forceinline__ void attn_naive(const Frame& F) {
    const bf16* QM = WSP(bf16, WS_QM); const bf16* KH = WSP(bf16, WS_KH); const bf16* VH = WSP(bf16, WS_VH); bf16* OM = DOP(bf16, DO_OM);
    const float* RT = WSP(float, WS_ROPE); const float* QN = F.in[I_QN];
    for (int item = blockIdx.x; item < NB * MH * 4; item += F.G) {
        const int qb = item & 3, h = (item >> 2) & 7, b = item >> 5; const int t = b * SEQ + qb * 512 + F.tid;
        float q[96]; float ss = 0.f;
#pragma unroll
        for (int c = 0; c < 12; ++c) { const v4u w = *(const v4u*)(QM + (size_t)t * 768 + h * 96 + c * 8);
            q[c * 8 + 0] = bflo(w.x); q[c * 8 + 1] = bfhi(w.x); q[c * 8 + 2] = bflo(w.y); q[c * 8 + 3] = bfhi(w.y); q[c * 8 + 4] = bflo(w.z); q[c * 8 + 5] = bfhi(w.z); q[c * 8 + 6] = bflo(w.w); q[c * 8 + 7] = bfhi(w.w); }
#pragma unroll
        for (int d = 0; d < 96; ++d) ss += q[d] * q[d];
        const float rs = rsqrtf(ss * (1.0f / 96.0f) + EPS) ;
#pragma unroll
        for (int d = 0; d < 96; ++d) q[d] = q[d] * rs * QN[d];
#pragma unroll
        for (int i = 0; i < 16; ++i) { const float c = RT[(size_t)t * 32 + i], s = RT[(size_t)t * 32 + 16 + i]; const float x1 = q[64 + i], x2 = q[80 + i]; q[64 + i] = x1 * c - x2 * s; q[80 + i] = x2 * c + x1 * s; }
        const float sc = 0.10206207261596577f;
        unsigned qp[48];
#pragma unroll
        for (int d = 0; d < 48; ++d) qp[d] = pk2(q[2 * d] * sc, q[2 * d + 1] * sc);
        float o[64]; float mx = -1e30f, l = 0.f;
#pragma unroll
        for (int d = 0; d < 64; ++d) o[d] = 0.f;
        for (int s = 0; s < SEQ; ++s) {
            const bf16* kp = KH + ((size_t)(b * SEQ + s) * 8 + h) * 96; float a = 0.f;
#pragma unroll
            for (int c = 0; c < 12; ++c) { const v4u w = *(const v4u*)(kp + c * 8);
                a = dot2bf(qp[c * 4 + 0], w.x, a); a = dot2bf(qp[c * 4 + 1], w.y, a); a = dot2bf(qp[c * 4 + 2], w.z, a); a = dot2bf(qp[c * 4 + 3], w.w, a);
                if (c & 1) asm volatile("" ::: "memory"); }
            const float mn = fmaxf(mx, a), al = __expf(mx - mn), p = __expf(a - mn); mx = mn; l = l * al + p;
            const bf16* vp = VH + ((size_t)(b * SEQ + s) * 8 + h) * 64;
#pragma unroll
            for (int c = 0; c < 8; ++c) { const v4u w = *(const v4u*)(vp + c * 8);
                o[c * 8 + 0] = o[c * 8 + 0] * al + p * bflo(w.x); o[c * 8 + 1] = o[c * 8 + 1] * al + p * bfhi(w.x); o[c * 8 + 2] = o[c * 8 + 2] * al + p * bflo(w.y); o[c * 8 + 3] = o[c * 8 + 3] * al + p * bfhi(w.y);
                o[c * 8 + 4] = o[c * 8 + 4] * al + p * bflo(w.z); o[c * 8 + 5] = o[c * 8 + 5] * al + p * bfhi(w.z); o[c * 8 + 6] = o[c * 8 + 6] * al + p * bflo(w.w); o[c * 8 + 7] = o[c * 8 + 7] * al + p * bfhi(w.w); if (c & 1) asm volatile("" ::: "memory"); }
        }
        const float il = 1.0f / l;
#pragma unroll
        for (int c = 0; c < 8; ++c) st8(OM + (size_t)t * 512 + h * 64 + c * 8, (f32x4){o[c * 8] * il, o[c * 8 + 1] * il, o[c * 8 + 2] * il, o[c * 8 + 3] * il}, (f32x4){o[c * 8 + 4] * il, o[c * 8 + 5] * il, o[c * 8 + 6] * il, o[c * 8 + 7] * il});
    }
}
namespace att {
using f32x16 = __attribute__((ext_vector_type(16))) float;
using s16x4 = __attribute__((ext_vector_type(4))) short;
constexpr int QBLK = 32, KVBLK = 64;
constexpr float SCALE = 0.10206207261596577f;
constexpr float THR = 8.f;
constexpr int SHM_V = 16384, SHM_K = 16384, SHM_ATTN = 2 * SHM_V + 2 * SHM_K + NWAVES * 64 * 4;
#define KSWZ(row, colB) ((row) * 256 + ((colB) ^ (((row) & 7) << 4)))
#define SBAR() __builtin_amdgcn_sched_barrier(0)
__device__ __forceinline__ int crow(int r, int hi) { return (r & 3) + 8 * (r >> 2) + 4 * hi; }
__device__ __forceinline__ unsigned cvtpk(float lo, float hi) { unsigned r; asm volatile("v_cvt_pk_bf16_f32 %0, %1, %2" : "=v"(r) : "v"(lo), "v"(hi)); return r; }
__device__ __forceinline__ void partialSM(f32x16& p0, f32x16& p1, float& m_reg, float& mn, float& alpha) {
    constexpr float C = SCALE * 1.4426950408889634f;
    float pmax = p0[0];
#pragma unroll
    for (int r = 1; r < 16; ++r) pmax = fmaxf(pmax, p0[r]);
#pragma unroll
    for (int r = 0; r < 16; ++r) pmax = fmaxf(pmax, p1[r]);
    { auto rr = __builtin_amdgcn_permlane32_swap(__float_as_uint(pmax), __float_as_uint(pmax), false, false); pmax = fmaxf(__uint_as_float(rr[0]), __uint_as_float(rr[1])); }
    if (__builtin_expect(__all(pmax - m_reg <= THR / SCALE), 1)) { mn = m_reg; alpha = 1.f; }
    else { mn = fmaxf(m_reg, pmax); alpha = __builtin_amdgcn_exp2f((m_reg - mn) * C); m_reg = mn; }
    const float mnC = -mn * C;
#pragma unroll
    for (int r = 0; r < 16; ++r) p0[r] = fmaf(p0[r], C, mnC);
#pragma unroll
    for (int r = 0; r < 16; ++r) p1[r] = fmaf(p1[r], C, mnC);
#pragma unroll
    for (int r = 0; r < 16; ++r) p0[r] = __builtin_amdgcn_exp2f(p0[r]);
}
__device__ __forceinline__ void finishSM(f32x16& p0, f32x16& p1, float alpha, float& l_reg, bf16x8& pa0, bf16x8& pa1, bf16x8& pa2, bf16x8& pa3) {
#pragma unroll
    for (int r = 0; r < 16; ++r) p1[r] = __builtin_amdgcn_exp2f(p1[r]);
    float ps = 0;
#pragma unroll
    for (int r = 0; r < 16; ++r) ps += p0[r];
#pragma unroll
    for (int r = 0; r < 16; ++r) ps += p1[r];
    { auto rr = __builtin_amdgcn_permlane32_swap(__float_as_uint(ps), __float_as_uint(ps), false, false); ps = __uint_as_float(rr[0]) + __uint_as_float(rr[1]); }
    l_reg = l_reg * alpha + ps;
#define PK4(P, BASE, OUT) do { unsigned a0 = cvtpk(P[BASE + 0], P[BASE + 1]), a1 = cvtpk(P[BASE + 2], P[BASE + 3]);   \
    unsigned b0 = cvtpk(P[BASE + 4], P[BASE + 5]), b1 = cvtpk(P[BASE + 6], P[BASE + 7]);                              \
    auto r0 = __builtin_amdgcn_permlane32_swap(a0, b0, false, false); auto r1 = __builtin_amdgcn_permlane32_swap(a1, b1, false, false); \
    v4u w = {r0[0], r1[0], r0[1], r1[1]}; OUT = __builtin_bit_cast(bf16x8, w); } while (0)
    PK4(p0, 0, pa0); PK4(p0, 8, pa1); PK4(p1, 0, pa2); PK4(p1, 8, pa3);
#undef PK4
}
__device__ __forceinline__ void qkt(f32x16& p0, f32x16& p1, const char* Ks, const bf16x8* qr, int r32, int hi) {
    p0 = f32x16{}; p1 = f32x16{};
#pragma unroll
    for (int d0 = 0; d0 < 6; ++d0) { const int cb = (d0 * 16 + hi * 8) * 2;
        const bf16x8 b0 = *reinterpret_cast<const bf16x8*>(Ks + KSWZ(r32, cb));
        const bf16x8 b1 = *reinterpret_cast<const bf16x8*>(Ks + KSWZ(32 + r32, cb));
        p0 = __builtin_amdgcn_mfma_f32_32x32x16_bf16(b0, qr[d0], p0, 0, 0, 0);
        p1 = __builtin_amdgcn_mfma_f32_32x32x16_bf16(b1, qr[d0], p1, 0, 0, 0); }
}
__device__ __forceinline__ int v_st(int k, int c) { const int kk = (k & ~0xC) | ((k & 4) << 1) | ((k & 8) >> 1); return ((kk >> 3) * 4 + (c >> 5)) * 512 + ((kk & 7) * 32 + (c & 31)) * 2; }
__device__ __forceinline__ int v_rd_base(int lane) { return ((lane & 3) << 3) | (((lane >> 2) & 3) << 6) | (((lane >> 4) & 1) << 5) | (((lane >> 5) & 1) << 8); }
constexpr int v_rd_off(int d0, int ks, int half) { return d0 * 512 + ks * 4096 + half * 2048; }
template <int OFF> __device__ __forceinline__ s16x4 tr_read(int vb) { s16x4 r; asm volatile("ds_read_b64_tr_b16 %0, %1 offset:%2" : "=&v"(r) : "v"(vb), "i"(OFF) : "memory"); return r; }
template <int D0> __device__ __forceinline__ void pv_one(f32x16& od, int vb, bf16x8 pa0, bf16x8 pa1, bf16x8 pa2, bf16x8 pa3) {
    const s16x4 l0 = tr_read<v_rd_off(D0, 0, 0)>(vb), h0 = tr_read<v_rd_off(D0, 0, 1)>(vb), l1 = tr_read<v_rd_off(D0, 1, 0)>(vb), h1 = tr_read<v_rd_off(D0, 1, 1)>(vb);
    const s16x4 l2 = tr_read<v_rd_off(D0, 2, 0)>(vb), h2 = tr_read<v_rd_off(D0, 2, 1)>(vb), l3 = tr_read<v_rd_off(D0, 3, 0)>(vb), h3 = tr_read<v_rd_off(D0, 3, 1)>(vb);
    asm volatile("s_waitcnt lgkmcnt(0)" ::: "memory"); SBAR();
#define PK(L, H) (bf16x8){L[0], L[1], L[2], L[3], H[0], H[1], H[2], H[3]}
    od = __builtin_amdgcn_mfma_f32_32x32x16_bf16(pa0, PK(l0, h0), od, 0, 0, 0);
    od = __builtin_amdgcn_mfma_f32_32x32x16_bf16(pa1, PK(l1, h1), od, 0, 0, 0);
    od = __builtin_amdgcn_mfma_f32_32x32x16_bf16(pa2, PK(l2, h2), od, 0, 0, 0);
    od = __builtin_amdgcn_mfma_f32_32x32x16_bf16(pa3, PK(l3, h3), od, 0, 0, 0);
#undef PK
}
__device__ __forceinline__ void pv_d0(f32x16* o, int vb, bf16x8 pa0, bf16x8 pa1, bf16x8 pa2, bf16x8 pa3) { pv_one<0>(o[0], vb, pa0, pa1, pa2, pa3); pv_one<1>(o[1], vb, pa0, pa1, pa2, pa3); }

__device__ __forceinline__ void attn_unit(const bf16* __restrict__ QM, const bf16* __restrict__ KH, const bf16* __restrict__ VH, bf16* __restrict__ OM, const float* __restrict__ RT, const float* __restrict__ QN,
                                          int t0, int kb, int h, char* lds) {
    int tid_ = threadIdx.x; asm volatile("" : "+v"(tid_));
    const int tid = tid_, wid = __builtin_amdgcn_readfirstlane(tid >> 6), lane = tid & 63, r32 = lane & 31, hi = lane >> 5;
    char* V_lds = lds; char* K_lds = lds + 2 * SHM_V;
    float* wsf = (float*)(lds + 2 * SHM_V + 2 * SHM_K) + wid * 64; float* li_l = wsf; float* al_l = wsf + 32;
    float m_reg = -1e30f, l_reg = 0; f32x16 o[2] = {}; bf16x8 qr[6];
    {
        const int tq = t0 + wid * QBLK + r32; const bf16* qp = QM + (size_t)tq * 768 + h * 96 + hi * 8;
        float qf[6][8]; float ss = 0.f;
#pragma unroll
        for (int d0 = 0; d0 < 6; ++d0) { const v4u w = *(const v4u*)(qp + d0 * 16);
            qf[d0][0] = bflo(w.x); qf[d0][1] = bfhi(w.x); qf[d0][2] = bflo(w.y); qf[d0][3] = bfhi(w.y); qf[d0][4] = bflo(w.z); qf[d0][5] = bfhi(w.z); qf[d0][6] = bflo(w.w); qf[d0][7] = bfhi(w.w);
#pragma unroll
            for (int j = 0; j < 8; ++j) ss += qf[d0][j] * qf[d0][j]; }
        { auto rr = __builtin_amdgcn_permlane32_swap(__float_as_uint(ss), __float_as_uint(ss), false, false); ss = __uint_as_float(rr[0]) + __uint_as_float(rr[1]); }
        const float rs = rsqrtf(ss * (1.0f / 96.0f) + EPS);
#pragma unroll
        for (int d0 = 0; d0 < 6; ++d0) { const f32x4 g0 = *(const f32x4*)(QN + d0 * 16 + hi * 8), g1 = *(const f32x4*)(QN + d0 * 16 + hi * 8 + 4);
#pragma unroll
            for (int j = 0; j < 4; ++j) { qf[d0][j] *= rs * g0[j]; qf[d0][4 + j] *= rs * g1[j]; } }
        { const float* rt = RT + (size_t)tq * 32 + hi * 8; const f32x4 c0 = *(const f32x4*)rt, c1 = *(const f32x4*)(rt + 4), s0 = *(const f32x4*)(rt + 16), s1 = *(const f32x4*)(rt + 20);
#pragma unroll
          for (int j = 0; j < 8; ++j) { const float c = j < 4 ? c0[j & 3] : c1[j & 3], s = j < 4 ? s0[j & 3] : s1[j & 3]; const float x1 = qf[4][j], x2 = qf[5][j]; qf[4][j] = x1 * c - x2 * s; qf[5][j] = x2 * c + x1 * s; } }
#pragma unroll
        for (int d0 = 0; d0 < 6; ++d0) { v4u w = {cvtpk(qf[d0][0], qf[d0][1]), cvtpk(qf[d0][2], qf[d0][3]), cvtpk(qf[d0][4], qf[d0][5]), cvtpk(qf[d0][6], qf[d0][7])}; qr[d0] = __builtin_bit_cast(bf16x8, w); }
    }
    const int vrow = tid >> 3, vch = tid & 7, k0row = tid / 12, k0ch = tid - 12 * k0row, k1row = (tid + 512) / 12, k1ch = (tid + 512) - 12 * k1row; const bool two = wid < 4;
    const bf16* Kg = KH + ((size_t)kb * 8 + h) * 96; const bf16* Vg = VH + ((size_t)kb * 8 + h) * 64;
    const int vst0 = v_st(vrow, vch * 8), kst0 = KSWZ(k0row, k0ch * 16), kst1 = KSWZ(k1row, k1ch * 16);
    const int vb0 = (int)(uintptr_t)V_lds + v_rd_base(lane);
    struct { bf16x8 vs, ks0, ks1; } sr_[2];
#define SLOAD(i, kk) do { sr_[i].vs = *(const bf16x8*)(Vg + (size_t)((kk) + vrow) * 512 + vch * 8); sr_[i].ks0 = *(const bf16x8*)(Kg + (size_t)((kk) + k0row) * 768 + k0ch * 8); \
    if (two) sr_[i].ks1 = *(const bf16x8*)(Kg + (size_t)((kk) + k1row) * 768 + k1ch * 8); } while (0)
#define SWRITE(b, i) do { *(bf16x8*)(V_lds + (b) * SHM_V + vst0) = sr_[i].vs; *(bf16x8*)(K_lds + (b) * SHM_K + kst0) = sr_[i].ks0; if (two) *(bf16x8*)(K_lds + (b) * SHM_K + kst1) = sr_[i].ks1; } while (0)
#define SWAIT() do { if (two) asm volatile("s_waitcnt vmcnt(3)" ::: "memory"); else asm volatile("s_waitcnt vmcnt(2)" ::: "memory"); } while (0)
#define RESC(a) do { if (__any((a) < 1.f)) { if (hi == 0) al_l[r32] = (a); asm volatile("s_waitcnt lgkmcnt(0)" ::: "memory"); \
    _Pragma("unroll") for (int d = 0; d < 2; ++d) _Pragma("unroll") for (int r = 0; r < 16; ++r) o[d][r] *= al_l[crow(r, hi)]; } } while (0)
    f32x16 pA0, pA1, pB0, pB1; float mnA, mnB, alA, alB; bf16x8 pa0, pa1, pa2, pa3; constexpr int NT = SEQ / KVBLK;
    SLOAD(0, 0); asm volatile("s_waitcnt vmcnt(0)" ::: "memory"); SWRITE(0, 0); __syncthreads();
    qkt(pA0, pA1, K_lds, qr, r32, hi); partialSM(pA0, pA1, m_reg, mnA, alA);
    SLOAD(1, KVBLK); SLOAD(0, 2 * KVBLK);
    SWAIT(); SWRITE(1, 1); __syncthreads();
    for (int j = 1; j + 1 < NT; j += 2) {
        SBAR(); qkt(pB0, pB1, K_lds + SHM_K, qr, r32, hi);
        finishSM(pA0, pA1, alA, l_reg, pa0, pa1, pa2, pa3); SBAR();
        SLOAD(1, (j + 2) * KVBLK); SBAR();
        pv_d0(o, vb0, pa0, pa1, pa2, pa3); partialSM(pB0, pB1, m_reg, mnB, alB);
        __syncthreads(); SWAIT(); SWRITE(0, 0);
        RESC(alB); __syncthreads();
        SBAR(); qkt(pA0, pA1, K_lds, qr, r32, hi);
        finishSM(pB0, pB1, alB, l_reg, pa0, pa1, pa2, pa3); SBAR();
        if (j + 3 < NT) SLOAD(0, (j + 3) * KVBLK); SBAR();
        pv_d0(o, vb0 + SHM_V, pa0, pa1, pa2, pa3); partialSM(pA0, pA1, m_reg, mnA, alA);
        __syncthreads(); SWAIT(); SWRITE(1, 1);
        RESC(alA); __syncthreads();
    }
    SBAR(); qkt(pB0, pB1, K_lds + SHM_K, qr, r32, hi);
    finishSM(pA0, pA1, alA, l_reg, pa0, pa1, pa2, pa3); SBAR();
    pv_d0(o, vb0, pa0, pa1, pa2, pa3); partialSM(pB0, pB1, m_reg, mnB, alB);
    __syncthreads(); RESC(alB);
    finishSM(pB0, pB1, alB, l_reg, pa0, pa1, pa2, pa3); SBAR();
    pv_d0(o, vb0 + SHM_V, pa0, pa1, pa2, pa3);
    if (hi == 0) li_l[r32] = l_reg; asm volatile("s_waitcnt lgkmcnt(0)" ::: "memory");
    bf16* Ow = OM + (size_t)(t0 + wid * QBLK) * 512 + h * 64;
#pragma unroll
    for (int r = 0; r < 16; ++r) { const int orow = crow(r, hi); const float rl = __builtin_amdgcn_rcpf(li_l[orow]);
#pragma unroll
        for (int d0 = 0; d0 < 2; ++d0) Ow[(size_t)orow * 512 + d0 * 32 + r32] = (bf16)f2bf(o[d0][r] * rl); }
    asm volatile("s_waitcnt vmcnt(0)" ::: "memory");
    __syncthreads();
#undef SLOAD
#undef SWRITE
#undef SWAIT
#undef RESC
}
#undef KSWZ
#undef SBAR
}
__device__ __forceinline__ void attn_fast(const Frame& F) {
    const bf16* QM = WSP(bf16, WS_QM); const bf16* KH = WSP(bf16, WS_KH); const bf16* VH = WSP(bf16, WS_VH); bf16* OM = DOP(bf16, DO_OM);
    for (int item = F.vcu; item < NB * MH * 8; item += F.G) {
        const int qb = item & 7, h = (item >> 3) & 7, b = item >> 6;
        att::attn_unit(QM, KH, VH, OM, WSP(float, WS_ROPE), F.in[I_QN], b * SEQ + qb * 256, b * SEQ, h, (char*)F.gl);
    }
}
namespace hg {
typedef short v4i16_t __attribute__((ext_vector_type(4)));
constexpr int IN_BYTES = 40960, OFF_Q = 0, OFF_K = 16384, OFF_V = 32768, OFF_P = 2 * IN_BYTES, OFF_MT = OFF_P + 8192;
__device__ __forceinline__ unsigned off256(unsigned row, unsigned ch) { return 256u * row + 16u * (ch ^ (((row & 3) << 2) | ((row >> 2) & 3))); }
__device__ __forceinline__ unsigned off128(unsigned row, unsigned ch) { return 128u * row + 16u * (ch ^ (row & 7)); }
__device__ __forceinline__ bf16x8 ldrow(const LAS unsigned char* p) { return *(const LAS bf16x8*)p; }
__device__ __forceinline__ bf16x8 ldtr(const LAS unsigned char* p0, const LAS unsigned char* p1) {
    const v4i16_t a = __builtin_amdgcn_ds_read_tr16_b64_v4i16((LAS v4i16_t*)p0), b = __builtin_amdgcn_ds_read_tr16_b64_v4i16((LAS v4i16_t*)p1);
    return (bf16x8){a[0], a[1], a[2], a[3], b[0], b[1], b[2], b[3]};
}
}
__device__ __forceinline__ void hgrn_fast(const Frame& F) {
    using namespace hg;
    int tid_ = threadIdx.x; asm volatile("" : "+v"(tid_));
    const int tid = tid_, lane = tid & 63, w = __builtin_amdgcn_readfirstlane(tid >> 6), l15 = lane & 15, g = lane >> 4, q4 = (lane & 15) >> 2, p4 = lane & 3;
    const LAS unsigned char* L = F.lds;
    const unsigned qrow0 = tid >> 4, qch = tid & 15, qrow1 = qrow0 + 32, vrow = tid >> 3, vch = tid & 7;
    const unsigned sq0 = off256(qrow0, qch), sq1 = off256(qrow1, qch), sv = off128(vrow, vch);
    const int tb = w >> 1, sb0 = 2 * (w & 1);
    for (int item = blockIdx.x; item < NB * HGH * 2 * 2; item += F.G) {
        const int vh = item & 1, dir = (item >> 1) & 1, hh = (item >> 2) & 3, b = item >> 4;
        const bf16* Qd = DOP(bf16, dir ? DO_QB : DO_QF) + hh * 128 + qch * 8; const bf16* Kd = DOP(bf16, dir ? DO_KB : DO_KF) + hh * 128 + qch * 8;
        const bf16* Va = WSP(bf16, WS_VA) + hh * 128 + vh * 64 + vch * 8;
        bf16* Od = WSP(bf16, WS_ACT) + (dir ? (size_t)T * 512 : (size_t)0) + hh * 128 + vh * 64;
        const float* ER = WSP(float, WS_EREF) + (size_t)dir * NCHUNK * 512 + hh * 128 + 16 * w + 4 * g; const float* EL = WSP(float, WS_ELAST) + (size_t)dir * NCHUNK * 512 + hh * 128 + 16 * w + 4 * g;
        f32x4 M[4];
#pragma unroll
        for (int i = 0; i < 4; ++i) M[i] = (f32x4){0.f, 0.f, 0.f, 0.f};
        v4u rq0, rq1, rk0, rk1, rv;
#define HG_LOAD(gc_) do { const size_t t0_ = (size_t)(gc_) * 64; rq0 = *(const v4u*)(Qd + (t0_ + qrow0) * 512); rq1 = *(const v4u*)(Qd + (t0_ + qrow1) * 512); \
        rk0 = *(const v4u*)(Kd + (t0_ + qrow0) * 512); rk1 = *(const v4u*)(Kd + (t0_ + qrow1) * 512); rv = *(const v4u*)(Va + (t0_ + vrow) * 512); } while (0)
#define HG_WRITE(buf_) do { LAS unsigned char* B_ = (LAS unsigned char*)L + (buf_) * IN_BYTES; *(LAS v4u*)(B_ + OFF_Q + sq0) = rq0; *(LAS v4u*)(B_ + OFF_Q + sq1) = rq1; \
        *(LAS v4u*)(B_ + OFF_K + sq0) = rk0; *(LAS v4u*)(B_ + OFF_K + sq1) = rk1; *(LAS v4u*)(B_ + OFF_V + sv) = rv; } while (0)
        __syncthreads();
        { const int c0 = dir ? 31 : 0; HG_LOAD(b * 32 + c0); HG_WRITE(0); }
        __syncthreads();
        for (int cc = 0; cc < 32; ++cc) {
            const int c = dir ? 31 - cc : cc, gc = b * 32 + c, cn = dir ? c - 1 : c + 1, buf = cc & 1; const bool has = cc < 31;
            const LAS unsigned char* Bq = L + buf * IN_BYTES + OFF_Q; const LAS unsigned char* Bk = L + buf * IN_BYTES + OFF_K; const LAS unsigned char* Bv = L + buf * IN_BYTES + OFF_V;
            if (has) HG_LOAD(b * 32 + cn);
            f32x4 dv = (f32x4){0.f, 0.f, 0.f, 0.f};
            if (has) dv = *(const f32x4*)(EL + (size_t)gc * 512) * *(const f32x4*)(ER + (size_t)(b * 32 + cn) * 512);
            {
                f32x4 pa[2] = {(f32x4){0.f, 0.f, 0.f, 0.f}, (f32x4){0.f, 0.f, 0.f, 0.f}};
#pragma unroll
                for (int ks = 0; ks < 4; ++ks) { const bf16x8 qf = ldrow(Bq + off256(16 * tb + l15, 4 * ks + g));
#pragma unroll
                    for (int i = 0; i < 2; ++i) { const bf16x8 kf = ldrow(Bk + off256(16 * (sb0 + i) + l15, 4 * ks + g)); pa[i] = __builtin_amdgcn_mfma_f32_16x16x32_bf16(kf, qf, pa[i], 0, 0, 0); } }
                const int t = 16 * tb + l15;
#pragma unroll
                for (int i = 0; i < 2; ++i) { const int s0 = 16 * (sb0 + i) + 4 * g; f32x4 v = pa[i];
#pragma unroll
                    for (int r = 0; r < 4; ++r) { const bool ok = dir ? (s0 + r >= t) : (s0 + r <= t); v[r] = ok ? v[r] : 0.f; }
                    v2u pk; pk.x = pk2(v[0], v[1]); pk.y = pk2(v[2], v[3]);
                    *(LAS v2u*)((LAS unsigned char*)L + OFF_P + off128(t, 2 * (sb0 + i) + (g >> 1)) + (g & 1) * 8) = pk; }
#pragma unroll
                for (int vb = 0; vb < 4; ++vb) { v2u pk; pk.x = pk2(M[vb][0], M[vb][1]); pk.y = pk2(M[vb][2], M[vb][3]);
                    *(LAS v2u*)((LAS unsigned char*)L + OFF_MT + off256(16 * vb + l15, 2 * w + (g >> 1)) + (g & 1) * 8) = pk; }
            }
            __syncthreads();
            {
                f32x4 oa[2] = {(f32x4){0.f, 0.f, 0.f, 0.f}, (f32x4){0.f, 0.f, 0.f, 0.f}};
#pragma unroll
                for (int ks = 0; ks < 2; ++ks) { const bf16x8 pf = ldrow(L + OFF_P + off128(16 * tb + l15, 4 * ks + g));
#pragma unroll
                    for (int i = 0; i < 2; ++i) { const unsigned c = sb0 + i;
                        const bf16x8 vf = ldtr(Bv + off128(32 * ks + 8 * g + q4, 2 * c + (p4 >> 1)) + 8 * (p4 & 1), Bv + off128(32 * ks + 8 * g + 4 + q4, 2 * c + (p4 >> 1)) + 8 * (p4 & 1));
                        oa[i] = __builtin_amdgcn_mfma_f32_16x16x32_bf16(vf, pf, oa[i], 0, 0, 0); } }
#pragma unroll
                for (int ks = 0; ks < 4; ++ks) { const bf16x8 qf = ldrow(Bq + off256(16 * tb + l15, 4 * ks + g));
#pragma unroll
                    for (int i = 0; i < 2; ++i) { const bf16x8 mf = ldrow(L + OFF_MT + off256(16 * (sb0 + i) + l15, 4 * ks + g)); oa[i] = __builtin_amdgcn_mfma_f32_16x16x32_bf16(mf, qf, oa[i], 0, 0, 0); } }
                const size_t orow = ((size_t)gc * 64 + 16 * tb + l15) * 512;
#pragma unroll
                for (int i = 0; i < 2; ++i) st4(Od + orow + 16 * (sb0 + i) + 4 * g, oa[i]);
#pragma unroll
                for (int ks = 0; ks < 2; ++ks) {
                    const bf16x8 kf = ldtr(Bk + off256(32 * ks + 8 * g + q4, 2 * w + (p4 >> 1)) + 8 * (p4 & 1), Bk + off256(32 * ks + 8 * g + 4 + q4, 2 * w + (p4 >> 1)) + 8 * (p4 & 1));
#pragma unroll
                    for (int vb = 0; vb < 4; ++vb) {
                        const bf16x8 vf = ldtr(Bv + off128(32 * ks + 8 * g + q4, 2 * vb + (p4 >> 1)) + 8 * (p4 & 1), Bv + off128(32 * ks + 8 * g + 4 + q4, 2 * vb + (p4 >> 1)) + 8 * (p4 & 1));
                        M[vb] = __builtin_amdgcn_mfma_f32_16x16x32_bf16(kf, vf, M[vb], 0, 0, 0); } }
#pragma unroll
                for (int vb = 0; vb < 4; ++vb) M[vb] = M[vb] * dv;
            }
            if (has) HG_WRITE(buf ^ 1);
            __syncthreads();
        }
#undef HG_LOAD
#undef HG_WRITE
    }
}
__device__ __forceinline__ void route_fast(const Frame& F) {
    int tid_ = threadIdx.x; asm volatile("" : "+v"(tid_));
    const int tid = tid_, lane = tid & 63, w = __builtin_amdgcn_readfirstlane(tid >> 6), l15 = lane & 15, g = lane >> 4;
    LAS float* lg = (LAS float*)F.lds + w * 16 * 80;
    LAS int* cntL = (LAS int*)(F.lds + 40960); LAS int* baseL = cntL + 64;
    const bf16* WRH = WSP(bf16, WS_WRH); const bf16* WRL = WSP(bf16, WS_WRL); const float* BR = WSP(float, WS_BR);
    bf16* HM = WSP(bf16, WS_ACT); int* EIDX = WSP(int, WS_EIDX); float* EW = WSP(float, WS_EW); int* LIST = WSP(int, WS_LIST); float* RS2 = WSP(float, WS_RS2);
    for (int round = 0; round * F.G * 128 < T; ++round) {
        const int m0 = (round * F.G + F.vcu) * 128 + w * 16;
        if (tid < 64) cntL[tid] = 0;
        __syncthreads();
        f32x4 acc[5];
#pragma unroll
        for (int cb = 0; cb < 5; ++cb) acc[cb] = (f32x4){0.f, 0.f, 0.f, 0.f};
        float ss = 0.f;
        const float* xr = F.out + (size_t)(m0 + l15) * 1024 + 8 * g; bf16* hr = HM + (size_t)(m0 + l15) * 1024 + 8 * g;
        const bf16* wh = WRH + (size_t)l15 * 1024 + 8 * g; const bf16* wl = WRL + (size_t)l15 * 1024 + 8 * g;
#pragma unroll 2
        for (int ks = 0; ks < 32; ++ks) {
            const f32x4 a0 = *(const f32x4*)(xr + 32 * ks), a1 = *(const f32x4*)(xr + 32 * ks + 4);
            ss += dot4(a0) + dot4(a1);
            v4u hi; hi.x = pk2(a0[0], a0[1]); hi.y = pk2(a0[2], a0[3]); hi.z = pk2(a1[0], a1[1]); hi.w = pk2(a1[2], a1[3]);
            v4u lo; lo.x = pk2(a0[0] - bflo(hi.x), a0[1] - bfhi(hi.x)); lo.y = pk2(a0[2] - bflo(hi.y), a0[3] - bfhi(hi.y)); lo.z = pk2(a1[0] - bflo(hi.z), a1[1] - bfhi(hi.z)); lo.w = pk2(a1[2] - bflo(hi.w), a1[3] - bfhi(hi.w));
            *(v4u*)(hr + 32 * ks) = hi;
            const bf16x8 xh = __builtin_bit_cast(bf16x8, hi), xl = __builtin_bit_cast(bf16x8, lo);
#pragma unroll
            for (int cb = 0; cb < 5; ++cb) { const bf16x8 bh = *(const bf16x8*)(wh + (size_t)cb * 16 * 1024 + 32 * ks), bl = *(const bf16x8*)(wl + (size_t)cb * 16 * 1024 + 32 * ks);
                acc[cb] = __builtin_amdgcn_mfma_f32_16x16x32_bf16(xh, bh, acc[cb], 0, 0, 0);
                acc[cb] = __builtin_amdgcn_mfma_f32_16x16x32_bf16(xh, bl, acc[cb], 0, 0, 0);
                acc[cb] = __builtin_amdgcn_mfma_f32_16x16x32_bf16(xl, bh, acc[cb], 0, 0, 0); }
        }
        ss += __shfl_xor(ss, 16); ss += __shfl_xor(ss, 32);
        const float rs = rsqrtf(ss * (1.0f / D) + EPS);
        if (g == 0) RS2[m0 + l15] = rs;
        float rsr[4];
#pragma unroll
        for (int r = 0; r < 4; ++r) rsr[r] = __shfl(rs, 4 * g + r);
#pragma unroll
        for (int cb = 0; cb < 5; ++cb) { const float bias = BR[16 * cb + l15];
#pragma unroll
            for (int r = 0; r < 4; ++r) lg[(4 * g + r) * 80 + 16 * cb + l15] = acc[cb][r] * rsr[r] + bias; }
        LDS_WAIT(); asm volatile("" ::: "memory");
        int e0 = 0, e1 = 0, r0 = 0, r1 = 0; const int m = m0 + lane;
        if (lane < 16) {
            const LAS float* lt = lg + lane * 80;
            float gl[8];
#pragma unroll
            for (int i = 0; i < 8; ++i) gl[i] = lt[i];
            float gm = gl[0]; int gs = 0;
#pragma unroll
            for (int i = 1; i < 8; ++i) if (gl[i] > gm) { gm = gl[i]; gs = i; }
            float ge = 0.f;
#pragma unroll
            for (int i = 0; i < 8; ++i) ge += __expf(gl[i] - gm);
            const float pg = 1.0f / ge;
            float el[8];
#pragma unroll
            for (int i = 0; i < 8; ++i) el[i] = lt[8 + 8 * gs + i];
            float m1 = el[0]; int i1 = 0;
#pragma unroll
            for (int i = 1; i < 8; ++i) if (el[i] > m1) { m1 = el[i]; i1 = i; }
            float m2 = -3e38f; int i2 = 0;
#pragma unroll
            for (int i = 0; i < 8; ++i) if (i != i1 && el[i] > m2) { m2 = el[i]; i2 = i; }
            const float e2 = __expf(m2 - m1), w0 = pg / (1.0f + e2), w1 = pg * e2 / (1.0f + e2);
            e0 = 8 * gs + i1; e1 = 8 * gs + i2;
            EIDX[m * 2] = e0; EIDX[m * 2 + 1] = e1; EW[m * 2] = w0; EW[m * 2 + 1] = w1;
            r0 = __hip_atomic_fetch_add(cntL + e0, 1, __ATOMIC_RELAXED, __HIP_MEMORY_SCOPE_WORKGROUP);
            r1 = __hip_atomic_fetch_add(cntL + e1, 1, __ATOMIC_RELAXED, __HIP_MEMORY_SCOPE_WORKGROUP);
        }
        __syncthreads();
        if (tid < 64) { const int c = cntL[tid]; baseL[tid] = c ? (int)__hip_atomic_fetch_add(F.ctl + CW_CNT + 64 * tid, (unsigned)c, RLX_AGENT) : 0; }
        __syncthreads();
        if (lane < 16) { LIST[(size_t)e0 * T + baseL[e0] + r0] = m * 2; LIST[(size_t)e1 * T + baseL[e1] + r1] = m * 2 + 1; }
        __syncthreads();
    }
}
struct Args { const float* in[27]; float* out; unsigned char* ws; int ph_lo, ph_hi, use_bar, pad; };
constexpr int NPHASE = 11;
__device__ __forceinline__ void frame_init(Frame& F, const Args& args, unsigned char* lds) {
    F.lds = (LAS unsigned char*)lds; F.gl = lds;
    F.MISC = (volatile LAS unsigned*)(F.lds + MISC_OFF);
    F.tid = threadIdx.x; F.lane = F.tid & 63; F.wave = __builtin_amdgcn_readfirstlane(F.tid >> 6);
    F.G = gridDim.x; { const int bx = blockIdx.x; F.vcu = (F.G % 8 == 0) ? (bx % 8) * (F.G / 8) + bx / 8 : bx; }
    F.ws = args.ws; F.out = args.out; F.ctl = (gu32*)(args.ws + WS_CTL);
#pragma unroll
    for (int i = 0; i < 27; ++i) F.in[i] = args.in[i];
    for (int u = F.tid; u < 1024 / 4; u += NTHR) ((LAS unsigned*)(F.lds + LDSCTL_OFF))[u] = 0u;
    __syncthreads();
}
template <int PH> __device__ __forceinline__ void run_phase(const Frame& F) {
    if constexpr (PH == 0) { p0_prologue(F); }
    if constexpr (PH == 1) {
        Gemm g{WSP(bf16, WS_ACT), WSP(bf16, WS_WIN), 1024, nullptr}; StaticOrder S; S.init(T, NIN, F.G, (int)blockIdx.x);
        EpiIn E{F.ws, (unsigned char*)F.out};
        GEMM_PHASE(EpiIn, StaticOrder, g, S, E);
    }
    if constexpr (PH == 2) {
        { Gemm g{WSP(bf16, WS_CQ), WSP(bf16, WS_WUQ), 256, nullptr}; StaticOrder S; S.init(T, 768, F.G, (int)blockIdx.x); EpiQ E{WSP(bf16, WS_QM), WSP(float, WS_CQSS)}; GEMM_PHASE(EpiQ, StaticOrder, g, S, E); }
        { Gemm g{WSP(bf16, WS_CKVR), WSP(bf16, WS_WUKV), 256, nullptr}; StaticOrder S; S.init(T, 1024, F.G, (int)blockIdx.x);
          EpiKV E{WSP(bf16, WS_KH), WSP(bf16, WS_VH), WSP(float, WS_CKVSS), WSP(float, WS_KR), WSP(float, WS_ROPE), F.in[I_KN]}; GEMM_PHASE(EpiKV, StaticOrder, g, S, E); }
        HGRN_PHASE(F);
    }
    if constexpr (PH == 3) { oa_pass(F); ATTN_PHASE(F); }
    if constexpr (PH == 4) {
        Gemm g{DOP(bf16, DO_OA), WSP(bf16, WS_WOAB), 512, nullptr}; PairOrder S; S.init(F.G, (int)blockIdx.x); EpiMerge E{WSP(bf16, WS_ACT), WSP(bf16, WS_GA), WSP(bf16, WS_GB)};
        GEMM_PHASE(EpiMerge, PairOrder, g, S, E);
    }
    if constexpr (PH == 5) {
        Gemm g{WSP(bf16, WS_ACT), WSP(bf16, WS_WOUT), 1024, nullptr}; StaticOrder S; S.init(T, D, F.G, (int)blockIdx.x); EpiX2 E{F.in[I_X], F.out};
        GEMM_PHASE(EpiX2, StaticOrder, g, S, E);
    }
    if constexpr (PH == 6) { ROUTE_PHASE(F); __syncthreads(); conv_mat<M_W13>(F); conv_mat<M_W2T>(F); }
    if constexpr (PH == 7) {
        moe_build_table(F);
        Gemm g{WSP(bf16, WS_ACT), WSP(bf16, WS_W13), 1024, WSP(int, WS_LIST)}; MoeOrder S{(const LAS int*)(F.lds + TAB_OFF), 2, F.G, (int)blockIdx.x}; EpiUp E{WSP(bf16, WS_H1), WSP(int, WS_LIST), WSP(float, WS_RS2)};
        GEMM_PHASE_GATHER(EpiUp, MoeOrder, g, S, E);
    }
    if constexpr (PH == 8) {
        moe_build_table(F);
        Gemm g{WSP(bf16, WS_H1), WSP(bf16, WS_W2T), 256, nullptr}; MoeOrder S{(const LAS int*)(F.lds + TAB_OFF), 4, F.G, (int)blockIdx.x}; EpiDown E{WSP(bf16, WS_Y0), WSP(bf16, WS_Y1), WSP(int, WS_LIST), WSP(float, WS_EW)};
        GEMM_PHASE(EpiDown, MoeOrder, g, S, E);
    }
    if constexpr (PH == 9) {
        Gemm g{WSP(bf16, WS_PB), WSP(bf16, WS_WPP), 256, nullptr}; StaticOrder S; S.init(T, D, F.G, (int)blockIdx.x); EpiProj E{WSP(bf16, WS_PROJ)};
        GEMM_PHASE(EpiProj, StaticOrder, g, S, E);
        x3_pass(F);
    }
    if constexpr (PH == 10) {
        Gemm g{WSP(bf16, WS_ACT), WSP(bf16, WS_WPG), 1024, nullptr}; StaticOrder S; S.init(T, D, F.G, (int)blockIdx.x); EpiFinal E{F.out, WSP(bf16, WS_PROJ)};
        GEMM_PHASE(EpiFinal, StaticOrder, g, S, E);
    }
}

template <int PH> __global__ void __launch_bounds__(NTHR, 2) phase_kernel(Args args) {
    extern __shared__ __attribute__((aligned(16))) unsigned char lds[];
    Frame F; frame_init(F, args, lds);
    run_phase<PH>(F);
}
#if N_LAUNCHES == 1
__global__ void __launch_bounds__(NTHR, 2) mega(Args args) {
    extern __shared__ __attribute__((aligned(16))) unsigned char lds[];
    Frame F; frame_init(F, args, lds);
    XcdBarrier bar = xcd_barrier_post((unsigned*)(F.ctl + CW_BAR), F.MISC + 8);
#ifndef DOUBLE_MASK
#define DOUBLE_MASK 0
#endif
#define PHASE1(k) do { Frame Fk = F; int t_ = threadIdx.x; asm volatile("" : "+v"(t_)); Fk.tid = t_; Fk.lane = t_ & 63; Fk.wave = __builtin_amdgcn_readfirstlane(t_ >> 6); run_phase<k>(Fk); } while (0)
#define PHASE(k) do { PHASE1(k); if ((DOUBLE_MASK >> (k)) & 1) { xcd_barrier(bar); PHASE1(k); } } while (0)
    PHASE(0); xcd_barrier(bar);
    PHASE(1); xcd_barrier(bar);
    PHASE(2); xcd_barrier(bar);
    PHASE(3); xcd_barrier(bar);
    PHASE(4); xcd_barrier(bar);
    PHASE(5); xcd_barrier(bar);
    PHASE(6); xcd_barrier(bar);
    PHASE(7); xcd_barrier(bar);
    PHASE(8); xcd_barrier(bar);
    PHASE(9); xcd_barrier(bar);
    PHASE(10);
#undef PHASE
}
#endif
extern "C" void kernel_launch(void* const* d_in, const int* in_sizes, int n_in, void* d_out, int out_size, void* d_ws, size_t ws_size, hipStream_t stream) {
    static int grid = 0;
    if (grid == 0) {
        if (n_in != 27 || in_sizes[0] != T * D || out_size != T * D || ws_size < WS_END) { fprintf(stderr, "kernel_launch: unexpected shapes (n_in %d, in0 %d, out %d, ws %zu)\n", n_in, n_in > 0 ? in_sizes[0] : -1, out_size, ws_size); grid = -1; return; }
        int dev = 0, cus = 0;
        if (hipGetDevice(&dev) != hipSuccess || hipDeviceGetAttribute(&cus, hipDeviceAttributeMultiprocessorCount, dev) != hipSuccess) { grid = -1; return; }
#if N_LAUNCHES == 1
        if (hipFuncSetAttribute((const void*)mega, hipFuncAttributeMaxDynamicSharedMemorySize, LDS_BYTES) != hipSuccess) { fprintf(stderr, "kernel_launch: hipFuncSetAttribute failed\n"); grid = -1; return; }
#else
#define SETATTR(k) if (hipFuncSetAttribute((const void*)phase_kernel<k>, hipFuncAttributeMaxDynamicSharedMemorySize, LDS_BYTES) != hipSuccess) { fprintf(stderr, "kernel_launch: hipFuncSetAttribute failed\n"); grid = -1; return; }
        SETATTR(0) SETATTR(1) SETATTR(2) SETATTR(3) SETATTR(4) SETATTR(5) SETATTR(6) SETATTR(7) SETATTR(8) SETATTR(9) SETATTR(10)
#endif
        grid = cus;
    }
    if (grid < 0) return;
    (void)hipMemsetAsync((char*)d_ws + WS_CTL, 0, CTL_ZERO_BYTES, stream);
    Args a{};
    for (int i = 0; i < 27; ++i) a.in[i] = (const float*)d_in[i];
    a.out = (float*)d_out; a.ws = (unsigned char*)d_ws;
#if N_LAUNCHES == 1
    a.ph_lo = 0; a.ph_hi = NPHASE; a.use_bar = 1;
    hipLaunchKernelGGL(mega, dim3(grid), dim3(NTHR), LDS_BYTES, stream, a);
#else
#define LAUNCH_PH(k) hipLaunchKernelGGL(phase_kernel<k>, dim3(grid), dim3(NTHR), LDS_BYTES, stream, a)
#ifndef LAST_PHASE
#define LAST_PHASE 10
#endif
    LAUNCH_PH(0); LAUNCH_PH(1); LAUNCH_PH(2); LAUNCH_PH(3); LAUNCH_PH(4); LAUNCH_PH(5);
    if (LAST_PHASE >= 6) { LAUNCH_PH(6); } if (LAST_PHASE >= 7) { LAUNCH_PH(7); } if (LAST_PHASE >= 8) { LAUNCH_PH(8); } if (LAST_PHASE >= 9) { LAUNCH_PH(9); } if (LAST_PHASE >= 10) { LAUNCH_PH(10); }
#endif
    const hipError_t le = hipPeekAtLastError();
    if (le != hipSuccess) fprintf(stderr, "kernel_launch: launch failed: %s\n", hipGetErrorName(le));
}
```

```cpp
#include <hip/hip_runtime.h>
#include <cstdio>
#include <cstdint>

#define GAS __attribute__((address_space(1)))
#define LAS __attribute__((address_space(3)))
typedef unsigned short bf16;
typedef unsigned v4u __attribute__((ext_vector_type(4)));
typedef unsigned v2u __attribute__((ext_vector_type(2)));
typedef float f32x4 __attribute__((ext_vector_type(4)));
typedef float f32x2 __attribute__((ext_vector_type(2)));
typedef short bf16x8 __attribute__((ext_vector_type(8)));
typedef GAS unsigned gu32;
#define RLX_AGENT __ATOMIC_RELAXED, __HIP_MEMORY_SCOPE_AGENT
#define LDS_WAIT() asm volatile("s_waitcnt lgkmcnt(0)" ::: "memory")
#define VM_WAIT() asm volatile("s_waitcnt vmcnt(0)" ::: "memory")

constexpr int NB = 16, SEQ = 2048, T = NB * SEQ, D = 1024;
constexpr int HGH = 4, HGK = 128, HGV = 128, HGF = 512, CHUNK = 64, NCHUNK = T / CHUNK;
constexpr int MH = 8, NOPE = 64, ROPE = 32, QK = 96, VD = 64, QR = 256, KVR = 128;
constexpr int NG = 8, EPG = 8, NE = 64, DE = 256, PLE = 256;
constexpr int DIN = 5024, NIN = 5120;
constexpr float EPS = 1e-6f;
constexpr int NWAVES = 8, NTHR = 512;

__device__ __forceinline__ unsigned f2bf(float f) { unsigned u = __builtin_bit_cast(unsigned, f); return (u + 0x7fffu + ((u >> 16) & 1u)) >> 16; }
typedef __bf16 bf16pair_t __attribute__((ext_vector_type(2)));
__device__ __forceinline__ unsigned pk2(float lo, float hi) { const f32x2 v = {lo, hi}; return __builtin_bit_cast(unsigned, __builtin_convertvector(v, bf16pair_t)); }
__device__ __forceinline__ float bf2f(unsigned b) { return __builtin_bit_cast(float, b << 16); }
__device__ __forceinline__ float bflo(unsigned w) { return __builtin_bit_cast(float, w << 16); }
__device__ __forceinline__ float bfhi(unsigned w) { return __builtin_bit_cast(float, w & 0xffff0000u); }
__device__ __forceinline__ float sigm(float x) { return __builtin_amdgcn_rcpf(1.0f + __expf(-x)); }
__device__ __forceinline__ float silu_(float x) { return x * __builtin_amdgcn_rcpf(1.0f + __expf(-x)); }
__device__ __forceinline__ float wave_sum(float v) {
#pragma unroll
    for (int o = 1; o < 64; o <<= 1) v += __shfl_xor(v, o);
    return v;
}
__host__ __device__ __forceinline__ int perm8(int p) { const int r = p & 31, n = r >> 4, fq = (r >> 2) & 3, j = r & 3; return (p & ~31) + 8 * fq + 4 * n + j; }
__host__ __device__ __forceinline__ int iperm8(int l) { const int r = l & 31, fq = r >> 3, n = (r >> 2) & 1, j = r & 3; return (l & ~31) + 16 * n + 4 * fq + j; }

constexpr size_t MiB = 1u << 20;
constexpr size_t WS_CTL = 0, CTL_ZERO_BYTES = 1 * MiB;
constexpr size_t WS_LB = 1 * MiB;
constexpr size_t WS_WRH = 1 * MiB + 65536, WS_WRL = WS_WRH + 80 * 1024 * 2;
constexpr size_t WS_BR = WS_WRL + 80 * 1024 * 2;
constexpr size_t WS_RS2 = 2 * MiB;
constexpr size_t WS_CQSS = 2 * MiB;
constexpr size_t WS_CKVSS = 2 * MiB + 512 * 1024;
constexpr size_t WS_ROPE = 4 * MiB;
constexpr size_t WS_EREF = 8 * MiB, WS_ELAST = 10 * MiB;
constexpr size_t WS_EIDX = 12 * MiB;
constexpr size_t WS_EW = 12 * MiB + 512 * 1024;
constexpr size_t WS_KR = 13 * MiB;
constexpr size_t WS_LIST = 4 * MiB;
constexpr size_t WS_WIN = 17 * MiB, WS_WOAB = 27 * MiB, WS_WUQ = 29 * MiB, WS_WUKV = 29 * MiB + 512 * 1024, WS_WOUT = 30 * MiB, WS_WPG = 32 * MiB, WS_WPP = 34 * MiB;
constexpr size_t WS_ACT = 36 * MiB;
constexpr size_t WS_VA = 100 * MiB, WS_OG = 132 * MiB, WS_CQ = 164 * MiB, WS_CKVR = 180 * MiB, WS_GA = 196 * MiB, WS_GB = 260 * MiB;
constexpr size_t WS_QM = 324 * MiB, WS_KH = 372 * MiB, WS_VH = 420 * MiB, WS_PB = 452 * MiB, WS_END = 468 * MiB;
constexpr size_t WS_W13 = 196 * MiB, WS_W2T = 260 * MiB;
constexpr size_t WS_H1 = 324 * MiB;
constexpr size_t WS_Y0 = 100 * MiB, WS_Y1 = 372 * MiB;
constexpr size_t WS_PROJ = 292 * MiB;
constexpr size_t DO_QF = 0, DO_KF = 32 * MiB, DO_QB = 64 * MiB, DO_KB = 96 * MiB, DO_OA = 0, DO_OM = 32 * MiB;
constexpr int CW_TMO = 0, CW_CODE = 1, CW_BAR = 4096, CW_CNT = 8192  ;
constexpr int MAXROWT = 320;
constexpr int RING_BYTES = 131072, LDSCTL_OFF = RING_BYTES, MISC_OFF = LDSCTL_OFF + 320, TAB_OFF = RING_BYTES + 1024, LDS_BYTES = 147456;
#define N_LAUNCHES 1
#define NAIVE_MOE 0
#define GEMM_PHASE(EPI, SCHED, g, S, E) gemm_fast<EPI, SCHED, false>(F.lds, g, S, E)
#define GEMM_PHASE_GATHER(EPI, SCHED, g, S, E) gemm_fast<EPI, SCHED, true>(F.lds, g, S, E)
#define HGRN_PHASE(F) hgrn_fast(F)
#define ATTN_PHASE(F) attn_fast(F)
#define ROUTE_PHASE(F) route_fast(F)
#define XB_TMO      128
#define XB_XCNT(j)  (256  + 64 * (j))
#define XB_XSUB(j)  (1280 + 64 * (j))
#define XB_XGEN(j)  (2304 + 64 * (j))
#define XB_TOP      3328
#define XB_TOPGEN   3392
#define XCD_BAR_WORDS 3456
#define XB_SPIN_CAP (1u << 18)

__device__ __forceinline__ unsigned xb_ld(unsigned* p)              { return __hip_atomic_load(p, __ATOMIC_RELAXED, __HIP_MEMORY_SCOPE_AGENT); }
__device__ __forceinline__ unsigned xb_add(unsigned* p, unsigned v) { return __hip_atomic_fetch_add(p, v, __ATOMIC_RELAXED, __HIP_MEMORY_SCOPE_AGENT); }
__device__ __forceinline__ unsigned xb_xcc_id() { return (unsigned)__builtin_amdgcn_s_getreg((3 << 11) | 20) & 0xFu; }
#define XB_SPIN(cond, bar) do { unsigned _sp = 0; while (cond) { __builtin_amdgcn_s_sleep(1); \
    if ((++_sp & 255u) == 0u) { if (xb_ld(&(bar)[XB_TMO])) break; if (_sp > XB_SPIN_CAP) { atomicAdd(&(bar)[XB_TMO], 1u); break; } } } } while (0)

struct XcdBarrier {
    unsigned* bar; unsigned x;
    volatile LAS unsigned* st;
};

__device__ __forceinline__ XcdBarrier xcd_barrier_post(unsigned* bar, volatile LAS unsigned* st) {
    XcdBarrier b; b.bar = bar; b.x = xb_xcc_id(); b.st = st;
    if (threadIdx.x == 0) (void)xb_add(&bar[XB_XCNT(b.x)], 1u);
    return b;
}
__device__ __forceinline__ void xcd_barrier_complete(unsigned* bar, unsigned x, unsigned& nloc, unsigned& nx) {
    const unsigned G = gridDim.x * gridDim.y * gridDim.z;
    unsigned sum, cnt, mine, sp = 0u;
    for (;;) {
        sum = 0u; cnt = 0u; mine = 0u;
#pragma unroll
        for (unsigned j = 0; j < 16; ++j) { const unsigned c = xb_ld(&bar[XB_XCNT(j)]); sum += c; cnt += (c > 0u) ? 1u : 0u; mine = (j == x) ? c : mine; }
        if (sum == G) break;
        __builtin_amdgcn_s_sleep(1);
        if ((++sp & 255u) == 0u) { if (xb_ld(&bar[XB_TMO])) break; if (sp > XB_SPIN_CAP) { atomicAdd(&bar[XB_TMO], 1u); break; } }
    }
    nloc = mine > 0u ? mine : 1u; nx = cnt > 0u ? cnt : 1u;
}

__device__ __forceinline__ void xcd_barrier(const XcdBarrier& b) {
    asm volatile("s_waitcnt vmcnt(0)" ::: "memory");
    __syncthreads();
    if (threadIdx.x == 0) {
        unsigned* bar = b.bar;
        __builtin_amdgcn_s_waitcnt(0);
        unsigned nloc = b.st[0], nx = b.st[1];
        if (nloc == 0u) { xcd_barrier_complete(bar, b.x, nloc, nx); b.st[0] = nloc; b.st[1] = nx; }
        const unsigned old = xb_add(&bar[XB_XSUB(b.x)], 1u);
        const unsigned gen = old / nloc;
        if (old + 1u == (gen + 1u) * nloc) {
            __builtin_amdgcn_fence(__ATOMIC_RELEASE, "agent");
            asm volatile("s_waitcnt vmcnt(0)" ::: "memory");
            const unsigned og = xb_add(&bar[XB_TOP], 1u);
            const unsigned tg = og / nx;
            if (og + 1u == (tg + 1u) * nx) xb_add(&bar[XB_TOPGEN], 1u);
            else XB_SPIN(xb_ld(&bar[XB_TOPGEN]) == tg, bar);
            __builtin_amdgcn_fence(__ATOMIC_ACQUIRE, "agent");
            xb_add(&bar[XB_XGEN(b.x)], 1u);
            asm volatile("s_waitcnt vmcnt(0)" ::: "memory");
        } else {
            XB_SPIN(xb_ld(&bar[XB_XGEN(b.x)]) == gen, bar);
            __builtin_amdgcn_fence(__ATOMIC_ACQUIRE, "agent");
            asm volatile("s_waitcnt vmcnt(0)" ::: "memory");
        }
    }
    __syncthreads();
}
struct Unit { int pm, pn, lbase, nvalid; };
struct Gemm { const bf16* A; const bf16* Bt; int K; const int* list; };
typedef __bf16 bf16x2_t __attribute__((ext_vector_type(2)));
__device__ __forceinline__ float dot2bf(unsigned a, unsigned b, float c) { return __builtin_amdgcn_fdot2_f32_bf16(__builtin_bit_cast(bf16x2_t, a), __builtin_bit_cast(bf16x2_t, b), c, false); }

constexpr int NXCD = 8, WGM = 8;
struct StaticOrder {
    int nM, nN, nwg, G, c;
    __device__ void init(int M, int N, int G_, int c_) { nM = M / 256; nN = N / 256; nwg = nM * nN; G = G_; c = c_; }
    __device__ __forceinline__ bool next(int i, Unit& u) const {
        const long L = (long)i * G + c; if (L >= nwg) return false;
        int wgid = (int)L; { const int q = nwg / NXCD, r = nwg % NXCD, xcd = wgid % NXCD, off = wgid / NXCD; wgid = (xcd < r ? xcd * (q + 1) : r * (q + 1) + (xcd - r) * q) + off; }
        const int nig = WGM * nN, gid = wgid / nig, fm = gid * WGM, gsz = (nM - fm) < WGM ? (nM - fm) : WGM;
        u.pm = fm + ((wgid % nig) % gsz); u.pn = (wgid % nig) / gsz; u.lbase = 0; u.nvalid = 256; return true;
    }
};
struct PairOrder {
    StaticOrder so;
    __device__ void init(int G_, int c_) { so.init(T, D, G_, c_); }
    __device__ __forceinline__ bool next(int i, Unit& u) const { if (!so.next(i >> 1, u)) return false; if (i & 1) { u.pm += T / 256; u.pn += D / 256; } return true; }
};
struct MoeOrder {
    const LAS int* tab; int npn, G, c;
    __device__ __forceinline__ bool next(int i, Unit& u) const {
        const int L = i * G + c; const int nt = tab[0]; if (L >= nt * npn) return false;
        const int rt = L / npn, pl = L - rt * npn; const int e = tab[16 + 4 * rt];
        u.pm = rt; u.pn = e * npn + pl; u.lbase = tab[16 + 4 * rt + 1]; u.nvalid = tab[16 + 4 * rt + 2]; return true;
    }
};

template <class Epi, class Sched>
__device__ __forceinline__ void gemm_ref(const Gemm g, const Sched& S, const Epi& E) {
    const int tid = threadIdx.x, wid = tid >> 6, lane = tid & 63, wr = wid >> 2, wc = wid & 3, fr = lane & 15, fq = lane >> 4;
    const int K = g.K; Unit u;
    for (int i = 0; S.next(i, u); ++i) {
        f32x4 acc[2][2][4][2];
#pragma unroll
        for (int a = 0; a < 2; ++a)
#pragma unroll
            for (int b = 0; b < 2; ++b)
#pragma unroll
                for (int m = 0; m < 4; ++m)
#pragma unroll
                    for (int n = 0; n < 2; ++n) acc[a][b][m][n] = (f32x4){0.f, 0.f, 0.f, 0.f};
        unsigned ar[2][4];
#pragma unroll
        for (int ai = 0; ai < 2; ++ai)
#pragma unroll
            for (int m = 0; m < 4; ++m) { const int r = ai * 128 + wr * 64 + m * 16 + fr;
                if (g.list) { const int rr = r < u.nvalid ? r : u.nvalid - 1; ar[ai][m] = (unsigned)(g.list[u.lbase + rr] >> 1) * (unsigned)K; }
                else ar[ai][m] = (unsigned)(u.pm * 256 + r) * (unsigned)K; }
        const unsigned bb = (unsigned)(u.pn * 256 + wc * 32 + 4 * fq) * (unsigned)K;
#pragma unroll 1
        for (int k0 = 0; k0 < K; k0 += 8) {
#pragma unroll
            for (int bj = 0; bj < 2; ++bj)
#pragma unroll
                for (int n = 0; n < 2; ++n) {
                    v4u bw[4];
#pragma unroll
                    for (int j = 0; j < 4; ++j) bw[j] = *(const v4u*)(g.Bt + (bb + (unsigned)(bj * 128 + n * 16 + j) * (unsigned)K + (unsigned)k0));
#pragma unroll
                    for (int ai = 0; ai < 2; ++ai)
#pragma unroll
                        for (int m = 0; m < 4; ++m) { const v4u aw = *(const v4u*)(g.A + (ar[ai][m] + (unsigned)k0));
#pragma unroll
                            for (int j = 0; j < 4; ++j) { float c = acc[ai][bj][m][n][j];
                                c = dot2bf(aw.x, bw[j].x, c); c = dot2bf(aw.y, bw[j].y, c); c = dot2bf(aw.z, bw[j].z, c); c = dot2bf(aw.w, bw[j].w, c);
                                acc[ai][bj][m][n][j] = c; }
                            asm volatile("" ::: "memory"); }
                }
        }
        E(acc, u, wr, wc, fr, fq);
    }
}
constexpr int BM = 256, BK = 64, HALF = 128, HTB = HALF * BK * 2, STAGE_BYTES = 8 * HTB;
__host__ __device__ __forceinline__ int lds_byte(int r, int c) { const int st = (r >> 4) * 2 + (c >> 5), rr = r & 15, cc = c & 31, ob = rr * 64 + cc * 2; return st * 1024 + (ob ^ (((ob >> 9) & 1) << 5)); }
__host__ __device__ __forceinline__ void stage_rc(int b, int& R, int& C) { const int st = b / 1024, sb = b % 1024, swz = sb ^ (((sb >> 9) & 1) << 5); R = (st >> 1) * 16 + swz / 64; C = (st & 1) * 32 + (swz % 64) / 2; }
template <class Epi, class Sched, bool GATHER = false, bool ALIGN_EPI = true, bool SP2 = true>
__device__ __forceinline__ void gemm_fast(LAS unsigned char* lds, const Gemm g, const Sched& S, const Epi& E) {
    int tid_ = threadIdx.x; asm volatile("" : "+v"(tid_));
    const int tid = tid_, wid = __builtin_amdgcn_readfirstlane(tid >> 6), lane = tid & 63, wr = wid >> 2, wc = wid & 3, fr = lane & 15, fq = lane >> 4;
    const int K = g.K, nt = K / BK;
    unsigned v0[2], v1[2], nv0[2], nv1[2], voffB[2]; int sR[2], sC[2];
#pragma unroll
    for (int i = 0; i < 2; ++i) { stage_rc(tid * 16 + i * 8192, sR[i], sC[i]); voffB[i] = (unsigned)(sR[i] * K + sC[i]) * 2u; }
#define PG8_AOFF(u, o0, o1) do { _Pragma("unroll") for (int _i = 0; _i < 2; ++_i) { \
        if constexpr (GATHER) { const int r0_ = sR[_i] < (u).nvalid ? sR[_i] : (u).nvalid - 1, r1_ = (128 + sR[_i]) < (u).nvalid ? 128 + sR[_i] : (u).nvalid - 1; \
            o0[_i] = ((unsigned)(g.list[(u).lbase + r0_] >> 1) * (unsigned)K + (unsigned)sC[_i]) * 2u; o1[_i] = ((unsigned)(g.list[(u).lbase + r1_] >> 1) * (unsigned)K + (unsigned)sC[_i]) * 2u; } \
        else { o0[_i] = (unsigned)(sR[_i] * K + sC[_i]) * 2u; o1[_i] = o0[_i] + (unsigned)(HALF * K * 2); } } } while (0)
    const size_t kstep = (size_t)(BK * 2);
    const size_t hstep = (size_t)HALF * K * 2;
    const size_t tstep = 2 * hstep;
    const unsigned ldsw = (unsigned)wid * 1024u;
    const int aoff = lds_byte(wr * 64 + fr, fq * 8), boff = lds_byte(wc * 32 + fr, fq * 8);
#define PG8_SA(b, h) (((b) * 2 + (h)) * HTB)
#define PG8_SB(b, h) ((4 + (b) * 2 + (h)) * HTB)
#define PG8_STAGE(bufoff, gbase, voff) do { _Pragma("unroll") for (int _i = 0; _i < 2; ++_i) \
        __builtin_amdgcn_global_load_lds((const unsigned*)((const char*)(gbase) + (voff)[_i]), (LAS unsigned*)(lds + (bufoff) + ldsw + _i * 8192), 16, 0, 0); } while (0)
#define PG8_LDA(dst, b, h) do { _Pragma("unroll") for (int m = 0; m < 4; ++m) _Pragma("unroll") for (int k = 0; k < 2; ++k) dst[m][k] = *(const LAS bf16x8*)(lds + PG8_SA(b, h) + aoff + m * 2048 + k * 1024); } while (0)
#define PG8_LDB(dst, b, h) do { _Pragma("unroll") for (int n = 0; n < 2; ++n) _Pragma("unroll") for (int k = 0; k < 2; ++k) dst[n][k] = *(const LAS bf16x8*)(lds + PG8_SB(b, h) + boff + n * 2048 + k * 1024); } while (0)
#define PG8_MMA(ai, bj, At, Bt) do { __builtin_amdgcn_s_setprio(1); _Pragma("unroll") for (int m = 0; m < 4; ++m) _Pragma("unroll") for (int n = 0; n < 2; ++n) _Pragma("unroll") for (int k = 0; k < 2; ++k) \
        acc[ai][bj][m][n] = __builtin_amdgcn_mfma_f32_16x16x32_bf16(Bt[n][k], At[m][k], acc[ai][bj][m][n], 0, 0, 0); __builtin_amdgcn_s_setprio(0); } while (0)
#define PG8_WAIT_V(n) asm volatile("s_waitcnt vmcnt(" #n ")" ::: "memory")
#define PG8_WAIT_L(n) asm volatile("s_waitcnt lgkmcnt(" #n ")" ::: "memory")
#define PG8_BAR __builtin_amdgcn_s_barrier()
#define PG8_SCHED __builtin_amdgcn_sched_barrier(0)
    Unit cur, nxt; int ui = 0;
    if (!S.next(0, cur)) return;
    f32x4 acc[2][2][4][2];
#pragma unroll
    for (int a = 0; a < 2; ++a)
#pragma unroll
        for (int b = 0; b < 2; ++b)
#pragma unroll
            for (int m = 0; m < 4; ++m)
#pragma unroll
                for (int n = 0; n < 2; ++n) acc[a][b][m][n] = (f32x4){0.f, 0.f, 0.f, 0.f};
    bf16x8 At[4][2], B0[2][2], B1[2][2];
    const char* cA = (const char*)g.A + (GATHER ? (size_t)0 : (size_t)cur.pm * tstep); const char* cB = (const char*)g.Bt + (size_t)cur.pn * tstep;
    PG8_AOFF(cur, v0, v1);
    if constexpr (SP2) {
        PG8_STAGE(PG8_SB(0, 0), cB, voffB); PG8_STAGE(PG8_SB(0, 1), cB + hstep, voffB); PG8_STAGE(PG8_SA(0, 0), cA, v0); PG8_STAGE(PG8_SA(0, 1), cA, v1);
        if (wr == 1) PG8_BAR;
        PG8_WAIT_V(2); PG8_BAR;
        PG8_STAGE(PG8_SB(1, 0), cB + kstep, voffB); PG8_STAGE(PG8_SA(1, 0), cA + kstep, v0); PG8_STAGE(PG8_SB(1, 1), cB + hstep + kstep, voffB);
        PG8_WAIT_V(6); PG8_BAR;
    } else {
        PG8_STAGE(PG8_SB(0, 0), cB, voffB); PG8_STAGE(PG8_SA(0, 0), cA, v0); PG8_STAGE(PG8_SB(0, 1), cB + hstep, voffB); PG8_STAGE(PG8_SA(0, 1), cA, v1);
        if (wr == 1) PG8_BAR;
        PG8_WAIT_V(4); PG8_BAR;
        PG8_STAGE(PG8_SB(1, 0), cB + kstep, voffB); PG8_STAGE(PG8_SA(1, 0), cA + kstep, v0); PG8_STAGE(PG8_SB(1, 1), cB + hstep + kstep, voffB);
        PG8_WAIT_V(6); PG8_BAR;
    }
    for (;;) {
        const bool has_next = S.next(ui + 1, nxt);
        const char* nA = (has_next && !GATHER) ? (const char*)g.A + (size_t)nxt.pm * tstep : cA; const char* nB = has_next ? (const char*)g.Bt + (size_t)nxt.pn * tstep : cB;
        if (has_next) { PG8_AOFF(nxt, nv0, nv1); } else { _Pragma("unroll") for (int _i = 0; _i < 2; ++_i) { nv0[_i] = v0[_i]; nv1[_i] = v1[_i]; } }
#pragma unroll 1
        for (int t = 0; t < nt; t += 2) {
            const bool last = (t == nt - 2);
            const char* a1 = cA + (size_t)(t + 1) * kstep;
            const char* a2 = last ? nA : cA + (size_t)(t + 2) * kstep; const char* b2 = last ? nB : cB + (size_t)(t + 2) * kstep;
            const char* a3 = a2 + kstep; const char* b3 = b2 + kstep;
            unsigned w0[2], w1[2];
#pragma unroll
            for (int _i = 0; _i < 2; ++_i) { w0[_i] = last ? nv0[_i] : v0[_i]; w1[_i] = last ? nv1[_i] : v1[_i]; }
            if constexpr (SP2) {
            PG8_LDB(B0, 0, 0); PG8_LDB(B1, 0, 1); PG8_SCHED; PG8_LDA(At, 0, 0); PG8_STAGE(PG8_SA(1, 1), a1, v1);
            PG8_WAIT_V(8); PG8_WAIT_L(0); PG8_BAR; PG8_MMA(0, 0, At, B0); PG8_MMA(0, 1, At, B1); PG8_BAR; PG8_SCHED;
            PG8_LDA(At, 0, 1); PG8_STAGE(PG8_SB(0, 0), b2, voffB); PG8_STAGE(PG8_SB(0, 1), b2 + hstep, voffB); PG8_STAGE(PG8_SA(0, 0), a2, w0);
            PG8_WAIT_V(8); PG8_WAIT_L(0); PG8_BAR; PG8_MMA(1, 0, At, B0); PG8_MMA(1, 1, At, B1); PG8_BAR; PG8_SCHED;
            PG8_LDB(B0, 1, 0); PG8_LDB(B1, 1, 1); PG8_SCHED; PG8_LDA(At, 1, 0); PG8_STAGE(PG8_SA(0, 1), a2, w1);
            PG8_WAIT_V(8); PG8_WAIT_L(0); PG8_BAR; PG8_MMA(0, 0, At, B0); PG8_MMA(0, 1, At, B1); PG8_BAR; PG8_SCHED;
            PG8_LDA(At, 1, 1); PG8_STAGE(PG8_SB(1, 0), b3, voffB); PG8_STAGE(PG8_SB(1, 1), b3 + hstep, voffB); PG8_STAGE(PG8_SA(1, 0), a3, w0);
            PG8_WAIT_V(8); PG8_WAIT_L(0); PG8_BAR; PG8_MMA(1, 0, At, B0); PG8_MMA(1, 1, At, B1); PG8_BAR; PG8_SCHED;
            } else {
            PG8_LDB(B0, 0, 0); PG8_SCHED; PG8_LDA(At, 0, 0); PG8_STAGE(PG8_SA(1, 1), a1, v1);
            PG8_WAIT_L(8); PG8_BAR; PG8_WAIT_L(0); PG8_MMA(0, 0, At, B0); PG8_BAR; PG8_SCHED;
            PG8_LDB(B1, 0, 1); PG8_STAGE(PG8_SB(0, 0), b2, voffB);
            PG8_BAR; PG8_WAIT_L(0); PG8_MMA(0, 1, At, B1); PG8_BAR;
            PG8_LDA(At, 0, 1); PG8_STAGE(PG8_SA(0, 0), a2, w0);
            PG8_BAR; PG8_WAIT_L(0); PG8_MMA(1, 0, At, B0); PG8_BAR; PG8_SCHED;
            PG8_STAGE(PG8_SB(0, 1), b2 + hstep, voffB);
            PG8_WAIT_V(6); PG8_BAR; PG8_MMA(1, 1, At, B1); PG8_BAR;
            PG8_LDB(B0, 1, 0); PG8_SCHED; PG8_LDA(At, 1, 0); PG8_STAGE(PG8_SA(0, 1), a2, w1);
            PG8_WAIT_L(8); PG8_BAR; PG8_WAIT_L(0); PG8_MMA(0, 0, At, B0); PG8_BAR; PG8_SCHED;
            PG8_LDB(B1, 1, 1); PG8_STAGE(PG8_SB(1, 0), b3, voffB);
            PG8_BAR; PG8_WAIT_L(0); PG8_MMA(0, 1, At, B1); PG8_BAR;
            PG8_LDA(At, 1, 1); PG8_STAGE(PG8_SA(1, 0), a3, w0);
            PG8_BAR; PG8_WAIT_L(0); PG8_MMA(1, 0, At, B0); PG8_BAR; PG8_SCHED;
            PG8_STAGE(PG8_SB(1, 1), b3 + hstep, voffB);
            PG8_WAIT_V(6); PG8_BAR; PG8_MMA(1, 1, At, B1); PG8_BAR;
            }
        }
        if constexpr (ALIGN_EPI) { if (wr == 0) PG8_BAR; }
        E(acc, cur, wr, wc, fr, fq);
        if (!has_next) break;
#pragma unroll
        for (int a = 0; a < 2; ++a)
#pragma unroll
            for (int b = 0; b < 2; ++b)
#pragma unroll
                for (int m = 0; m < 4; ++m)
#pragma unroll
                    for (int n = 0; n < 2; ++n) acc[a][b][m][n] = (f32x4){0.f, 0.f, 0.f, 0.f};
        cur = nxt; cA = nA; cB = nB; ++ui;
#pragma unroll
        for (int _i = 0; _i < 2; ++_i) { v0[_i] = nv0[_i]; v1[_i] = nv1[_i]; }
        if constexpr (ALIGN_EPI) { if (wr == 1) PG8_BAR; }
    }
    PG8_WAIT_V(0);
    if constexpr (!ALIGN_EPI) { if (wr == 0) PG8_BAR; }
    PG8_BAR;
#undef PG8_AOFF
#undef PG8_SA
#undef PG8_SB
#undef PG8_STAGE
#undef PG8_LDA
#undef PG8_LDB
#undef PG8_MMA
#undef PG8_WAIT_V
#undef PG8_WAIT_L
#undef PG8_BAR
#undef PG8_SCHED
}
__device__ __forceinline__ void st8(bf16* p, f32x4 a, f32x4 b) { v4u w; w.x = pk2(a[0], a[1]); w.y = pk2(a[2], a[3]); w.z = pk2(b[0], b[1]); w.w = pk2(b[2], b[3]); *(v4u*)p = w; }
__device__ __forceinline__ void st4(bf16* p, f32x4 a) { v2u w; w.x = pk2(a[0], a[1]); w.y = pk2(a[2], a[3]); *(v2u*)p = w; }
__device__ __forceinline__ f32x4 up4(unsigned lo, unsigned hi) { return (f32x4){bflo(lo), bfhi(lo), bflo(hi), bfhi(hi)}; }
__device__ __forceinline__ float dot4(f32x4 a) { return (a[0] * a[0] + a[1] * a[1]) + (a[2] * a[2] + a[3] * a[3]); }
template <int CTRL> __device__ __forceinline__ float dppf(float v) { return __builtin_bit_cast(float, __builtin_amdgcn_update_dpp(0, __builtin_bit_cast(int, v), CTRL, 0xf, 0xf, true)); }
__device__ __forceinline__ float scan16(float v, int) { v += dppf<0x111>(v); v += dppf<0x112>(v); v += dppf<0x114>(v); v += dppf<0x118>(v); return v; }
__device__ __forceinline__ float bcast15(float v) { return dppf<0x15F>(v); }
__device__ __forceinline__ float bcast0(float v) { return dppf<0x150>(v); }

struct EpiIn {
    unsigned char *wsb, *dob;
#define EI_W(type, off) ((type*)(wsb + (off)))
#define EI_D(type, off) ((type*)(dob + (off)))
    __device__ __forceinline__ void hgrn(const f32x4 (&acc)[2][2][4][2], const Unit& u, int wr, int wc, int fr, int fq) const {
        const int hh = u.pn >> 1, cb = u.pn & 1;
        const int gch0 = hh * 128 + cb * 64 + wc * 16 + fq * 4;
        bf16* const QF = EI_D(bf16, DO_QF); bf16* const KF = EI_D(bf16, DO_KF); bf16* const QB = EI_D(bf16, DO_QB); bf16* const KB = EI_D(bf16, DO_KB); bf16* const VA = EI_W(bf16, WS_VA);
        float* const EREF = EI_W(float, WS_EREF); float* const ELAST = EI_W(float, WS_ELAST); const float* const LB = EI_W(float, WS_LB);
        const f32x4 lbf = *(const f32x4*)(LB + gch0), lbb = *(const f32x4*)(LB + 512 + gch0);
#pragma unroll
        for (int ai = 0; ai < 2; ++ai) {
            const int cidx = u.pm * 4 + ai * 2 + wr;
            const size_t off0 = (size_t)(u.pm * 256 + ai * 128 + wr * 64 + fr) * 512 + gch0;
#pragma unroll
            for (int m = 0; m < 4; ++m) st4(VA + off0 + (size_t)m * 16 * 512, acc[ai][1][m][1]);
#pragma unroll
            for (int jp = 0; jp < 2; ++jp) {
                f32x2 qo[4], ko[4];
#pragma unroll
                for (int jj = 0; jj < 2; ++jj) { const int j = 2 * jp + jj;
                    float lf[4], kk[4];
#pragma unroll
                    for (int m = 0; m < 4; ++m) { const float z = fminf(fmaxf(acc[ai][0][m][1][j], -30.f), 30.f), e = __expf(-z), s = __builtin_amdgcn_rcpf(1.0f + e); kk[m] = (1.0f - lbf[j]) * e * s; lf[m] = __logf(lbf[j] + (1.0f - lbf[j]) * s); }
                    float G[4], carry = 0.f;
#pragma unroll
                    for (int m = 0; m < 4; ++m) { G[m] = scan16(lf[m], fr) + carry; carry = bcast15(G[m]); }
                    const float Gref = bcast15(G[1]);
#pragma unroll
                    for (int m = 0; m < 4; ++m) { qo[m][jj] = silu_(acc[ai][0][m][0][j]) * __expf(G[m] - Gref); ko[m][jj] = kk[m] * __expf(fminf(Gref - G[m], 80.f)); }
                    if (fr == 0) { EREF[(size_t)cidx * 512 + gch0 + j] = __expf(Gref); ELAST[(size_t)cidx * 512 + gch0 + j] = __expf(carry - Gref); }
                }
#pragma unroll
                for (int m = 0; m < 4; ++m) { *(unsigned*)(QF + off0 + (size_t)m * 16 * 512 + 2 * jp) = pk2(qo[m][0], qo[m][1]); *(unsigned*)(KF + off0 + (size_t)m * 16 * 512 + 2 * jp) = pk2(ko[m][0], ko[m][1]); }
                asm volatile("" ::: "memory");
#pragma unroll
                for (int jj = 0; jj < 2; ++jj) { const int j = 2 * jp + jj;
                    float lw[4], kk[4];
#pragma unroll
                    for (int m = 0; m < 4; ++m) { const float z = fminf(fmaxf(acc[ai][1][m][0][j], -30.f), 30.f), e = __expf(-z), s = __builtin_amdgcn_rcpf(1.0f + e); kk[m] = (1.0f - lbb[j]) * e * s; lw[m] = __logf(lbb[j] + (1.0f - lbb[j]) * s); }
                    float P[4], carry = 0.f;
#pragma unroll
                    for (int m = 0; m < 4; ++m) { P[m] = scan16(lw[m], fr) + carry; carry = bcast15(P[m]); }
                    float Gb[4];
#pragma unroll
                    for (int m = 0; m < 4; ++m) Gb[m] = carry - (P[m] - lw[m]);
                    const float Gbref = bcast0(Gb[2]);
#pragma unroll
                    for (int m = 0; m < 4; ++m) { qo[m][jj] = silu_(acc[ai][0][m][0][j]) * __expf(Gb[m] - Gbref); ko[m][jj] = kk[m] * __expf(fminf(Gbref - Gb[m], 80.f)); }
                    if (fr == 0) { EREF[(size_t)(NCHUNK + cidx) * 512 + gch0 + j] = __expf(Gbref); ELAST[(size_t)(NCHUNK + cidx) * 512 + gch0 + j] = __expf(carry - Gbref); }
                }
#pragma unroll
                for (int m = 0; m < 4; ++m) { *(unsigned*)(QB + off0 + (size_t)m * 16 * 512 + 2 * jp) = pk2(qo[m][0], qo[m][1]); *(unsigned*)(KB + off0 + (size_t)m * 16 * 512 + 2 * jp) = pk2(ko[m][0], ko[m][1]); }
                asm volatile("" ::: "memory");
            }
        }
    }
    __device__ __forceinline__ void operator()(const f32x4 (&acc)[2][2][4][2], const Unit& u, int wr, int wc, int fr, int fq) const {
        const int pn = u.pn, row0 = u.pm * 256 + wr * 64 + fr;
        if (pn < 8) { hgrn(acc, u, wr, wc, fr, fq); return; }
        bf16* const OG = EI_W(bf16, WS_OG); bf16* const CQ = EI_W(bf16, WS_CQ); bf16* const CKVR = EI_W(bf16, WS_CKVR); bf16* const GA = EI_W(bf16, WS_GA); bf16* const GB = EI_W(bf16, WS_GB);
        float* const CQSS = EI_W(float, WS_CQSS); float* const CKVSS = EI_W(float, WS_CKVSS); float* const KR = EI_W(float, WS_KR);
        if (pn == 10) {
#pragma unroll
            for (int ai = 0; ai < 2; ++ai)
#pragma unroll
                for (int m = 0; m < 4; ++m) { const int row = row0 + ai * 128 + m * 16; float ss = 0.f;
#pragma unroll
                    for (int bj = 0; bj < 2; ++bj) { const f32x4 a = acc[ai][bj][m][0], b = acc[ai][bj][m][1]; ss += dot4(a) + dot4(b); st8(CQ + (size_t)row * 256 + bj * 128 + wc * 32 + 8 * fq, a, b); }
                    ss += __shfl_xor(ss, 16); ss += __shfl_xor(ss, 32); if (fq == 0) CQSS[(size_t)row * 4 + wc] = ss; }
            return;
        }
        if (pn == 11) {
#pragma unroll
            for (int ai = 0; ai < 2; ++ai)
#pragma unroll
                for (int m = 0; m < 4; ++m) { const int row = row0 + ai * 128 + m * 16;
                    const f32x4 a0 = acc[ai][0][m][0], b0 = acc[ai][0][m][1], a1 = acc[ai][1][m][0], b1 = acc[ai][1][m][1];
                    float ss = dot4(a0) + dot4(b0); ss += __shfl_xor(ss, 16); ss += __shfl_xor(ss, 32); if (fq == 0) CKVSS[(size_t)row * 4 + wc] = ss;
                    st8(CKVR + (size_t)row * 256 + wc * 32 + 8 * fq, a0, b0); st8(CKVR + (size_t)row * 256 + 128 + wc * 32 + 8 * fq, a1, b1);
                    if (wc == 0) { *(f32x4*)(KR + (size_t)row * 32 + 8 * fq) = a1; *(f32x4*)(KR + (size_t)row * 32 + 8 * fq + 4) = b1; } }
            return;
        }
        const bool sil = pn < 10; const int ld = sil ? 512 : 1024, cb = (sil ? pn - 8 : (pn - 12) & 3) * 256;
        const size_t dsto = sil ? (size_t)0 : (pn < 16 ? (size_t)((unsigned char*)GA - (unsigned char*)OG) : (size_t)((unsigned char*)GB - (unsigned char*)OG));
        bf16* dst = (bf16*)((unsigned char*)OG + dsto);
#pragma unroll
        for (int ai = 0; ai < 2; ++ai)
#pragma unroll
            for (int m = 0; m < 4; ++m)
#pragma unroll
                for (int bj = 0; bj < 2; ++bj) { f32x4 a = acc[ai][bj][m][0], b = acc[ai][bj][m][1];
#pragma unroll
                    for (int j = 0; j < 4; ++j) { a[j] = sil ? silu_(a[j]) : sigm(a[j]); b[j] = sil ? silu_(b[j]) : sigm(b[j]); }
                    st8(dst + (size_t)(row0 + ai * 128 + m * 16) * ld + cb + bj * 128 + wc * 32 + 8 * fq, a, b); }
    }
};

struct EpiQ {
    bf16* QM; const float* CQSS;
    __device__ __forceinline__ void operator()(const f32x4 (&acc)[2][2][4][2], const Unit& u, int wr, int wc, int fr, int fq) const {
#pragma unroll
        for (int ai = 0; ai < 2; ++ai)
#pragma unroll
            for (int m = 0; m < 4; ++m) { const int row = u.pm * 256 + ai * 128 + wr * 64 + m * 16 + fr;
                const f32x4 s4 = *(const f32x4*)(CQSS + (size_t)row * 4); const float rs = rsqrtf(((s4[0] + s4[1]) + (s4[2] + s4[3])) * (1.0f / 256.0f) + EPS);
#pragma unroll
                for (int bj = 0; bj < 2; ++bj) st8(QM + (size_t)row * 768 + u.pn * 256 + bj * 128 + wc * 32 + 8 * fq, acc[ai][bj][m][0] * rs, acc[ai][bj][m][1] * rs);
                if (m == 3) asm volatile("" ::: "memory"); }
    }
};
struct EpiKV {
    bf16 *KH, *VH; const float *CKVSS, *KR, *ROPE_, *KN;
    __device__ __forceinline__ void operator()(const f32x4 (&acc)[2][2][4][2], const Unit& u, int wr, int wc, int fr, int fq) const {
        const int pn = u.pn, head = (pn & 1) * 4 + wc;
#pragma unroll
        for (int ai = 0; ai < 2; ++ai)
#pragma unroll
            for (int m = 0; m < 4; ++m) { const int row = u.pm * 256 + ai * 128 + wr * 64 + m * 16 + fr;
                const f32x4 s4 = *(const f32x4*)(CKVSS + (size_t)row * 4); const float rs = rsqrtf(((s4[0] + s4[1]) + (s4[2] + s4[3])) * (1.0f / 128.0f) + EPS);
                if (pn >= 2) {
#pragma unroll
                    for (int bj = 0; bj < 2; ++bj) st8(VH + ((size_t)row * 8 + head) * 64 + bj * 32 + 8 * fq, acc[ai][bj][m][0] * rs, acc[ai][bj][m][1] * rs);
                } else {
                    float ss = 0.f;
#pragma unroll
                    for (int bj = 0; bj < 2; ++bj)
#pragma unroll
                        for (int n = 0; n < 2; ++n) ss += dot4(acc[ai][bj][m][n]);
                    ss *= rs * rs;
                    const f32x4 x1 = *(const f32x4*)(KR + (size_t)row * 32 + 4 * fq), x2 = *(const f32x4*)(KR + (size_t)row * 32 + 16 + 4 * fq);
                    ss += dot4(x1) + dot4(x2);
                    ss += __shfl_xor(ss, 16); ss += __shfl_xor(ss, 32);
                    const float rk = rsqrtf(ss * (1.0f / 96.0f) + EPS), rr = rs * rk;
                    bf16* kp = KH + ((size_t)row * 8 + head) * 96;
#pragma unroll
                    for (int bj = 0; bj < 2; ++bj) { const f32x4 g0 = *(const f32x4*)(KN + bj * 32 + 8 * fq), g1 = *(const f32x4*)(KN + bj * 32 + 8 * fq + 4);
                        st8(kp + bj * 32 + 8 * fq, acc[ai][bj][m][0] * rr * g0, acc[ai][bj][m][1] * rr * g1); }
                    { const f32x4 c = *(const f32x4*)(ROPE_ + (size_t)row * 32 + 4 * fq), s = *(const f32x4*)(ROPE_ + (size_t)row * 32 + 16 + 4 * fq);
                      const f32x4 y1 = x1 * rk * *(const f32x4*)(KN + 64 + 4 * fq), y2 = x2 * rk * *(const f32x4*)(KN + 80 + 4 * fq);
                      st4(kp + 64 + 4 * fq, y1 * c - y2 * s); st4(kp + 80 + 4 * fq, y2 * c + y1 * s); }
                }
                if (m == 3) asm volatile("" ::: "memory"); }
    }
};
struct EpiMerge {
    bf16* MG; const bf16 *GA, *GB;
    __device__ __forceinline__ void operator()(const f32x4 (&acc)[2][2][4][2], const Unit& u, int wr, int wc, int fr, int fq) const {
        const bool which = u.pm >= T / 256; const int pm = u.pm - (which ? T / 256 : 0), pn = u.pn - (which ? D / 256 : 0);
        const bf16* Gt = (const bf16*)((const unsigned char*)GA + (which ? (size_t)((const unsigned char*)GB - (const unsigned char*)GA) : (size_t)0));
#pragma unroll
        for (int ai = 0; ai < 2; ++ai)
#pragma unroll
            for (int mp = 0; mp < 2; ++mp) {
                v4u gv[2][2], ov[2][2];
#pragma unroll
                for (int mm = 0; mm < 2; ++mm)
#pragma unroll
                    for (int bj = 0; bj < 2; ++bj) { const size_t off = (size_t)(pm * 256 + ai * 128 + wr * 64 + (2 * mp + mm) * 16 + fr) * 1024 + pn * 256 + bj * 128 + wc * 32 + 8 * fq;
                        gv[mm][bj] = *(const v4u*)(Gt + off); ov[mm][bj] = which ? *(const v4u*)(MG + off) : (v4u){0u, 0u, 0u, 0u}; }
#pragma unroll
                for (int mm = 0; mm < 2; ++mm)
#pragma unroll
                    for (int bj = 0; bj < 2; ++bj) { const int m = 2 * mp + mm; const size_t off = (size_t)(pm * 256 + ai * 128 + wr * 64 + m * 16 + fr) * 1024 + pn * 256 + bj * 128 + wc * 32 + 8 * fq;
                        const v4u g = gv[mm][bj], o = ov[mm][bj];
                        const f32x4 a = acc[ai][bj][m][0] * up4(g.x, g.y) + up4(o.x, o.y), b = acc[ai][bj][m][1] * up4(g.z, g.w) + up4(o.z, o.w);
                        st8(MG + off, a, b); }
                asm volatile("" ::: "memory"); }
    }
};
struct EpiX2 {
    const float* X; float* O;
    __device__ __forceinline__ void operator()(const f32x4 (&acc)[2][2][4][2], const Unit& u, int wr, int wc, int fr, int fq) const {
#pragma unroll
        for (int ai = 0; ai < 2; ++ai)
#pragma unroll
            for (int mp = 0; mp < 2; ++mp) {
                f32x4 xv[2][2][2];
#pragma unroll
                for (int mm = 0; mm < 2; ++mm)
#pragma unroll
                    for (int bj = 0; bj < 2; ++bj)
#pragma unroll
                        for (int n = 0; n < 2; ++n) xv[mm][bj][n] = *(const f32x4*)(X + (size_t)(u.pm * 256 + ai * 128 + wr * 64 + (2 * mp + mm) * 16 + fr) * 1024 + u.pn * 256 + bj * 128 + wc * 32 + n * 16 + 4 * fq);
#pragma unroll
                for (int mm = 0; mm < 2; ++mm)
#pragma unroll
                    for (int bj = 0; bj < 2; ++bj)
#pragma unroll
                        for (int n = 0; n < 2; ++n) *(f32x4*)(O + (size_t)(u.pm * 256 + ai * 128 + wr * 64 + (2 * mp + mm) * 16 + fr) * 1024 + u.pn * 256 + bj * 128 + wc * 32 + n * 16 + 4 * fq) = xv[mm][bj][n] + acc[ai][bj][2 * mp + mm][n];
                asm volatile("" ::: "memory"); }
    }
};
struct EpiUp {
    bf16* H1; const int* LIST; const float* RS2;
    __device__ __forceinline__ void operator()(const f32x4 (&acc)[2][2][4][2], const Unit& u, int wr, int wc, int fr, int fq) const {
        const int pl = u.pn & 1; int tk[2][4]; float rsv[2][4];
#pragma unroll
        for (int ai = 0; ai < 2; ++ai)
#pragma unroll
            for (int m = 0; m < 4; ++m) { const int r = ai * 128 + wr * 64 + m * 16 + fr; tk[ai][m] = LIST[u.lbase + (r < u.nvalid ? r : u.nvalid - 1)] >> 1; }
#pragma unroll
        for (int ai = 0; ai < 2; ++ai)
#pragma unroll
            for (int m = 0; m < 4; ++m) rsv[ai][m] = RS2[tk[ai][m]];
#pragma unroll
        for (int ai = 0; ai < 2; ++ai)
#pragma unroll
            for (int m = 0; m < 4; ++m) { const int r = ai * 128 + wr * 64 + m * 16 + fr; const float rs = rsv[ai][m];
                f32x4 a = acc[ai][0][m][0] * rs, b = acc[ai][0][m][1] * rs;
#pragma unroll
                for (int j = 0; j < 4; ++j) { a[j] = silu_(a[j]) * (acc[ai][1][m][0][j] * rs); b[j] = silu_(b[j]) * (acc[ai][1][m][1][j] * rs); }
                st8(H1 + (size_t)(u.pm * 256 + r) * 256 + pl * 128 + wc * 32 + 8 * fq, a, b); }
    }
};
struct EpiDown {
    bf16 *Y0, *Y1; const int* LIST; const float* EW;
    __device__ __forceinline__ void operator()(const f32x4 (&acc)[2][2][4][2], const Unit& u, int wr, int wc, int fr, int fq) const {
        const int pl = u.pn & 3; int en[2][4]; float wv[2][4];
#pragma unroll
        for (int ai = 0; ai < 2; ++ai)
#pragma unroll
            for (int m = 0; m < 4; ++m) { const int r = ai * 128 + wr * 64 + m * 16 + fr; en[ai][m] = r < u.nvalid ? LIST[u.lbase + r] : -1; }
#pragma unroll
        for (int ai = 0; ai < 2; ++ai)
#pragma unroll
            for (int m = 0; m < 4; ++m) wv[ai][m] = en[ai][m] >= 0 ? EW[en[ai][m]] : 0.f;
#pragma unroll
        for (int ai = 0; ai < 2; ++ai)
#pragma unroll
            for (int m = 0; m < 4; ++m) { const int ent = en[ai][m]; const float w = wv[ai][m];
                if (ent >= 0) {
                    const unsigned eo = (unsigned)(ent >> 1) * 1024u + (unsigned)(pl * 256 + wc * 32 + 8 * fq) + ((ent & 1) ? (unsigned)(((unsigned char*)Y1 - (unsigned char*)Y0) / 2) : 0u);
#pragma unroll
                    for (int bj = 0; bj < 2; ++bj) st8(Y0 + eo + bj * 128, acc[ai][bj][m][0] * w, acc[ai][bj][m][1] * w); } }
    }
};
struct EpiProj {
    bf16* PR;
    __device__ __forceinline__ void operator()(const f32x4 (&acc)[2][2][4][2], const Unit& u, int wr, int wc, int fr, int fq) const {
#pragma unroll
        for (int ai = 0; ai < 2; ++ai)
#pragma unroll
            for (int m = 0; m < 4; ++m)
#pragma unroll
                for (int bj = 0; bj < 2; ++bj) st8(PR + (size_t)(u.pm * 256 + ai * 128 + wr * 64 + m * 16 + fr) * 1024 + u.pn * 256 + bj * 128 + wc * 32 + 8 * fq, acc[ai][bj][m][0], acc[ai][bj][m][1]);
    }
};
struct EpiFinal {
    float* O; const bf16* PR;
    __device__ __forceinline__ void operator()(const f32x4 (&acc)[2][2][4][2], const Unit& u, int wr, int wc, int fr, int fq) const {
#pragma unroll
        for (int ai = 0; ai < 2; ++ai)
#pragma unroll
            for (int mp = 0; mp < 2; ++mp) {
                f32x4 xv[2][2][2]; v2u pv[2][2][2];
#pragma unroll
                for (int mm = 0; mm < 2; ++mm)
#pragma unroll
                    for (int bj = 0; bj < 2; ++bj)
#pragma unroll
                        for (int n = 0; n < 2; ++n) { const size_t off = (size_t)(u.pm * 256 + ai * 128 + wr * 64 + (2 * mp + mm) * 16 + fr) * 1024 + u.pn * 256 + bj * 128 + wc * 32 + n * 16 + 4 * fq;
                            xv[mm][bj][n] = *(const f32x4*)(O + off); pv[mm][bj][n] = *(const v2u*)(PR + off); }
#pragma unroll
                for (int mm = 0; mm < 2; ++mm)
#pragma unroll
                    for (int bj = 0; bj < 2; ++bj)
#pragma unroll
                        for (int n = 0; n < 2; ++n) { const size_t off = (size_t)(u.pm * 256 + ai * 128 + wr * 64 + (2 * mp + mm) * 16 + fr) * 1024 + u.pn * 256 + bj * 128 + wc * 32 + n * 16 + 4 * fq;
                            f32x4 g = acc[ai][bj][2 * mp + mm][n];
#pragma unroll
                            for (int j = 0; j < 4; ++j) g[j] = sigm(g[j]);
                            *(f32x4*)(O + off) = xv[mm][bj][n] + up4(pv[mm][bj][n].x, pv[mm][bj][n].y) * g; }
                asm volatile("" ::: "memory"); }
    }
};
struct Frame {
    LAS unsigned char* lds; unsigned char* gl;
    volatile LAS unsigned* MISC; gu32* ctl;
    int tid, lane, wave, vcu, G;
    const float* in[27]; float* out; unsigned char* ws;
};
#define WSP(type, off) ((type*)(F.ws + (off)))
#define DOP(type, off) ((type*)((unsigned char*)F.out + (off)))
enum { I_X = 0, I_P, I_POS, I_LNMIX, I_WIN, I_HGLB, I_HGON, I_WOA, I_QAN, I_KVAN, I_WUQ, I_WUKV, I_QN, I_KN, I_WOB, I_WOUT, I_LNMOE, I_WRG, I_BRG, I_WRE, I_BRE, I_W1, I_W3, I_W2, I_LNPLE, I_WPG, I_WPP };

enum { M_WIN = 0, M_WOAB, M_WUQ, M_WUKV, M_WOUT, M_WPG, M_WPP, M_W13, M_W2T };
template <int MAT> struct MatInfo;
template <> struct MatInfo<M_WIN>  { static constexpr int K = 1024, NP = NIN; };
template <> struct MatInfo<M_WOAB> { static constexpr int K = 512,  NP = 2048; };
template <> struct MatInfo<M_WUQ>  { static constexpr int K = 256,  NP = 768; };
template <> struct MatInfo<M_WUKV> { static constexpr int K = 256,  NP = 1024; };
template <> struct MatInfo<M_WOUT> { static constexpr int K = 1024, NP = 1024; };
template <> struct MatInfo<M_WPG>  { static constexpr int K = 1024, NP = 1024; };
template <> struct MatInfo<M_WPP>  { static constexpr int K = 256,  NP = 1024; };
template <> struct MatInfo<M_W13>  { static constexpr int K = 1024, NP = NE * 512; };
template <> struct MatInfo<M_W2T>  { static constexpr int K = 256,  NP = NE * 1024; };
template <int MAT> __device__ __forceinline__ void conv_item(const Frame& F, int item, int lane, LAS float* scr) {
    constexpr int K = MatInfo<MAT>::K; constexpr int KB = K / 64;
    const int kb = item % KB, p0 = (item / KB) * 32, p = p0 + (lane & 31), k0 = kb * 64;
    const float* src = nullptr; size_t ld = 0; const float* gain = nullptr; int kvalid = K; bf16* dst = nullptr;
    if constexpr (MAT == M_WIN) {
        const int pn = p >> 8; int col;
        if (pn < 8) { const int q = p & 255, bj = q >> 7, wc = (q >> 5) & 3, n = (q >> 4) & 1, fq = (q >> 2) & 3, j = q & 3; const int kind = 2 * bj + n;
            col = kind * 512 + (pn >> 1) * 128 + (pn & 1) * 64 + wc * 16 + fq * 4 + j; }
        else if (pn < 10) col = 2048 + perm8(p - 2048);
        else if (pn == 10) col = 2560 + perm8(p - 2560);
        else if (pn == 11) { const int l = perm8(p - 2816); col = l < 128 ? 2816 + l : (l < 160 ? 2944 + (l - 128) : -1); }
        else if (pn < 16) col = 2976 + perm8(p - 3072);
        else col = 4000 + perm8(p - 4096);
        if (col >= 0) src = F.in[I_WIN] + col; ld = DIN; gain = F.in[I_LNMIX]; dst = WSP(bf16, WS_WIN);
    } else if constexpr (MAT == M_WOAB) { { const float* sa = F.in[I_WOA]; const float* sb = F.in[I_WOB]; src = (const float*)((const unsigned char*)sa + ((p >> 10) ? (size_t)((const unsigned char*)sb - (const unsigned char*)sa) : (size_t)0)) + perm8(p & 1023); } ld = 1024; dst = WSP(bf16, WS_WOAB); }
    else if constexpr (MAT == M_WUQ) { src = F.in[I_WUQ] + perm8(p); ld = 768; gain = F.in[I_QAN]; dst = WSP(bf16, WS_WUQ); }
    else if constexpr (MAT == M_WUKV) { const int pn = p >> 8, q = p & 255, bj = q >> 7, wc = (q >> 5) & 3, n = (q >> 4) & 1, fq = (q >> 2) & 3, j = q & 3;
        const int head = (pn & 1) * 4 + wc, d = 32 * bj + 8 * fq + 4 * n + j; src = F.in[I_WUKV] + head * 128 + (pn >= 2 ? 64 : 0) + d; ld = 1024; gain = F.in[I_KVAN]; kvalid = 128; dst = WSP(bf16, WS_WUKV); }
    else if constexpr (MAT == M_WOUT) { src = F.in[I_WOUT] + p; ld = 1024; dst = WSP(bf16, WS_WOUT); }
    else if constexpr (MAT == M_WPG) { src = F.in[I_WPG] + p; ld = 1024; gain = F.in[I_LNPLE]; dst = WSP(bf16, WS_WPG); }
    else if constexpr (MAT == M_WPP) { src = F.in[I_WPP] + perm8(p); ld = 1024; dst = WSP(bf16, WS_WPP); }
    else if constexpr (MAT == M_W13) { const int e = p >> 9, q = p & 511, pl = q >> 8, bj = (q >> 7) & 1, r = q & 127;
        { const float* sa = F.in[I_W1]; const float* sb = F.in[I_W3]; src = (const float*)((const unsigned char*)sa + (bj ? (size_t)((const unsigned char*)sb - (const unsigned char*)sa) : (size_t)0)) + (size_t)e * 1024 * 256 + pl * 128 + perm8(r); } ld = 256; gain = F.in[I_LNMOE]; dst = WSP(bf16, WS_W13); }
    else { const int e = p >> 10, q = p & 1023; src = F.in[I_W2] + (size_t)e * 256 * 1024 + perm8(q); ld = 1024; dst = WSP(bf16, WS_W2T); }
    float tv[32];
#pragma unroll
    for (int i = 0; i < 32; ++i) { const int k = k0 + 2 * i + (lane >> 5); tv[i] = (src && k < kvalid) ? src[(size_t)k * ld] : 0.0f; }
#pragma unroll
    for (int i = 0; i < 32; ++i) { const int kk = 2 * i + (lane >> 5); scr[kk * 33 + (lane & 31)] = gain ? tv[i] * gain[k0 + kk] : tv[i]; }
    LDS_WAIT(); asm volatile("" ::: "memory");
    const int c = lane & 7;
#pragma unroll
    for (int j = 0; j < 4; ++j) { const int n = (lane >> 3) + 8 * j; const LAS float* sp = scr + (8 * c) * 33 + n;
        v4u o; o.x = pk2(sp[0 * 33], sp[1 * 33]); o.y = pk2(sp[2 * 33], sp[3 * 33]); o.z = pk2(sp[4 * 33], sp[5 * 33]); o.w = pk2(sp[6 * 33], sp[7 * 33]);
        *(v4u*)(dst + (size_t)(p0 + n) * K + k0 + 8 * c) = o; }
    LDS_WAIT(); asm volatile("" ::: "memory");
}
template <int MAT> __device__ __forceinline__ void conv_mat(const Frame& F) {
    constexpr int NITEMS = (MatInfo<MAT>::NP / 32) * (MatInfo<MAT>::K / 64);
    const int gw = F.vcu * NWAVES + F.wave, NGW = F.G * NWAVES;
    LAS float* scr = (LAS float*)(F.lds + F.wave * 16384);
    for (int it = gw; it < NITEMS; it += NGW) conv_item<MAT>(F, it, F.lane, scr);
}

__device__ __forceinline__ void p0_prologue(const Frame& F) {
    conv_mat<M_WIN>(F); conv_mat<M_WOAB>(F); conv_mat<M_WUQ>(F); conv_mat<M_WUKV>(F); conv_mat<M_WOUT>(F); conv_mat<M_WPG>(F); conv_mat<M_WPP>(F);
    const int gt = F.vcu * NTHR + F.tid, NGT = F.G * NTHR;
    for (int i = gt; i < 80 * 1024; i += NGT) { const int o = i >> 10, k = i & 1023; const float wv = o >= 72 ? 0.f : F.in[I_LNMOE][k] * (o < 8 ? F.in[I_WRG][k * 8 + o] : F.in[I_WRE][k * 64 + (o - 8)]);
        const unsigned h = f2bf(wv); WSP(bf16, WS_WRH)[i] = (bf16)h; WSP(bf16, WS_WRL)[i] = (bf16)f2bf(wv - bf2f(h)); }
    for (int i = gt; i < 80; i += NGT) WSP(float, WS_BR)[i] = i < 8 ? F.in[I_BRG][i] : (i < 72 ? F.in[I_BRE][i - 8] : 0.f);
    for (int i = gt; i < 1024; i += NGT) { const int d = i >> 9, f = i & 511; const float a0 = F.in[I_HGLB][d * 1024 + f], a1 = F.in[I_HGLB][d * 1024 + 512 + f]; WSP(float, WS_LB)[i] = 1.0f / (1.0f + expf(a1 - a0)); }
    for (int i = gt; i < T * 16; i += NGT) { const int t = i >> 4, f = i & 15; const float pos = (float)((const int*)F.in[I_POS])[t]; const float inv = exp2f(-(float)f * (13.287712379549449f / 16.0f));
        const float ang = pos * inv;
        const float kq = rintf(ang * 0.15915494309189535f); float r = fmaf(-kq, 6.28318548202514648f, ang); r = fmaf(-kq, -1.7484555e-7f, r);
        WSP(float, WS_ROPE)[t * 32 + f] = __cosf(r); WSP(float, WS_ROPE)[t * 32 + 16 + f] = __sinf(r); }
    const int gw = F.vcu * NWAVES + F.wave, NGW = F.G * NWAVES;
    for (int m = gw; m < T; m += NGW) {
        const float* xr = F.in[I_X] + (size_t)m * D + F.lane * 8; f32x4 v[4]; float ss = 0.f;
#pragma unroll
        for (int j = 0; j < 2; ++j) { v[2 * j] = *(const f32x4*)(xr + 512 * j); v[2 * j + 1] = *(const f32x4*)(xr + 512 * j + 4); ss += dot4(v[2 * j]) + dot4(v[2 * j + 1]); }
        const float rs = rsqrtf(wave_sum(ss) * (1.0f / D) + EPS);
#pragma unroll
        for (int j = 0; j < 2; ++j) st8(WSP(bf16, WS_ACT) + (size_t)m * D + F.lane * 8 + 512 * j, v[2 * j] * rs, v[2 * j + 1] * rs);
        if (F.lane < 32) { const float* pr = F.in[I_P] + (size_t)m * PLE + F.lane * 8; st8(WSP(bf16, WS_PB) + (size_t)m * PLE + F.lane * 8, *(const f32x4*)pr, *(const f32x4*)(pr + 4)); }
    }
}

__device__ __forceinline__ void oa_pass(const Frame& F) {
    const int gw = F.vcu * NWAVES + F.wave, NGW = F.G * NWAVES;
    const bf16* OFp = WSP(bf16, WS_ACT); const bf16* OBp = OFp + (size_t)T * 512; const bf16* OGp = WSP(bf16, WS_OG); bf16* OA = DOP(bf16, DO_OA);
    const int c0 = F.lane * 8; const f32x4 g0 = *(const f32x4*)(F.in[I_HGON] + (c0 & 127)), g1 = *(const f32x4*)(F.in[I_HGON] + (c0 & 127) + 4);
    for (int m = gw; m < T; m += NGW) {
        const size_t off = (size_t)m * 512 + c0;
        const v4u a = *(const v4u*)(OFp + off), b = *(const v4u*)(OBp + off), g = *(const v4u*)(OGp + off);
        f32x4 s0 = up4(a.x, a.y) + up4(b.x, b.y), s1 = up4(a.z, a.w) + up4(b.z, b.w);
        float ss = dot4(s0) + dot4(s1); ss += __shfl_xor(ss, 1); ss += __shfl_xor(ss, 2); ss += __shfl_xor(ss, 4); ss += __shfl_xor(ss, 8);
        const float rs = rsqrtf(ss * (1.0f / 128.0f) + EPS);
        st8(OA + off, s0 * rs * g0 * up4(g.x, g.y), s1 * rs * g1 * up4(g.z, g.w));
    }
}
__device__ __forceinline__ void x3_pass(const Frame& F) {
    const int gw = F.vcu * NWAVES + F.wave, NGW = F.G * NWAVES;
    const bf16* Y0 = WSP(bf16, WS_Y0); const bf16* Y1 = WSP(bf16, WS_Y1); bf16* HP = WSP(bf16, WS_ACT);
    for (int m = gw; m < T; m += NGW) {
        float* xr = F.out + (size_t)m * D + F.lane * 8; f32x4 v[4]; float ss = 0.f;
#pragma unroll
        for (int j = 0; j < 2; ++j) { const size_t o = (size_t)m * D + F.lane * 8 + 512 * j; const v4u a = *(const v4u*)(Y0 + o), b = *(const v4u*)(Y1 + o);
            v[2 * j] = *(const f32x4*)(xr + 512 * j) + up4(a.x, a.y) + up4(b.x, b.y); v[2 * j + 1] = *(const f32x4*)(xr + 512 * j + 4) + up4(a.z, a.w) + up4(b.z, b.w);
            *(f32x4*)(xr + 512 * j) = v[2 * j]; *(f32x4*)(xr + 512 * j + 4) = v[2 * j + 1]; ss += dot4(v[2 * j]) + dot4(v[2 * j + 1]); }
        const float rs = rsqrtf(wave_sum(ss) * (1.0f / D) + EPS);
#pragma unroll
        for (int j = 0; j < 2; ++j) st8(HP + (size_t)m * D + F.lane * 8 + 512 * j, v[2 * j] * rs, v[2 * j + 1] * rs);
    }
}
__device__ __forceinline__ void moe_build_table(const Frame& F) {
    LAS int* tab = (LAS int*)(F.lds + TAB_OFF); LAS int* cnts = tab + 16 + 4 * MAXROWT;
    if (F.tid < NE) cnts[F.tid] = (int)__hip_atomic_load(F.ctl + CW_CNT + 64 * F.tid, RLX_AGENT);
    __syncthreads();
    if (F.tid == 0) { int rt = 0;
        for (int e = 0; e < NE; ++e) { const int cnt = cnts[e]; const int nt = (cnt + 255) >> 8;
            for (int lt = 0; lt < nt; ++lt) { tab[16 + 4 * rt] = e; tab[16 + 4 * rt + 1] = e * T + 256 * lt; const int rem = cnt - 256 * lt; tab[16 + 4 * rt + 2] = rem < 256 ? rem : 256; ++rt; } }
        tab[0] = rt; }
    __syncthreads();
}
__device__ __forceinline__ void hgrn_naive(const Frame& F) {
    float* Qs = (float*)F.gl; float* Ks = Qs + 64 * 128; float* Vs = Ks + 64 * 128; float* Ps = Vs + 64 * 64; float* Os = Ps + 64 * 64;
    const int v = F.tid & 63, kq = F.tid >> 6;
    for (int item = blockIdx.x; item < NB * HGH * 2 * 2; item += F.G) {
        const int vh = item & 1, dir = (item >> 1) & 1, hh = (item >> 2) & 3, b = item >> 4;
        const bf16* Qd = DOP(bf16, dir ? DO_QB : DO_QF); const bf16* Kd = DOP(bf16, dir ? DO_KB : DO_KF); const bf16* Va = WSP(bf16, WS_VA);
        bf16* Od = WSP(bf16, WS_ACT) + (dir ? (size_t)T * 512 : 0);
        const float* ER = WSP(float, WS_EREF) + (size_t)dir * NCHUNK * 512; const float* EL = WSP(float, WS_ELAST) + (size_t)dir * NCHUNK * 512;
        float M[16];
#pragma unroll
        for (int i = 0; i < 16; ++i) M[i] = 0.f;
        for (int cc = 0; cc < 32; ++cc) {
            const int c = dir ? 31 - cc : cc, gc = b * 32 + c, t0 = gc * 64;
            __syncthreads();
            for (int idx = F.tid; idx < 64 * 128; idx += NTHR) { const int t = idx >> 7, ch = idx & 127; const size_t o = (size_t)(t0 + t) * 512 + hh * 128 + ch; Qs[idx] = bf2f(Qd[o]); Ks[idx] = bf2f(Kd[o]); }
            for (int idx = F.tid; idx < 64 * 64; idx += NTHR) { const int t = idx >> 6, vv = idx & 63; Vs[idx] = bf2f(Va[(size_t)(t0 + t) * 512 + hh * 128 + vh * 64 + vv]); Os[idx] = 0.f; }
            __syncthreads();
            for (int idx = F.tid; idx < 64 * 64; idx += NTHR) { const int t = idx >> 6, s = idx & 63; const bool ok = dir ? (s >= t) : (s <= t); float a = 0.f;
                if (ok) for (int ch = 0; ch < 128; ++ch) a += Qs[t * 128 + ch] * Ks[s * 128 + ch];
                Ps[idx] = a; }
            __syncthreads();
            for (int t = 0; t < 64; ++t) { float a = 0.f;
#pragma unroll
                for (int i = 0; i < 16; ++i) a += Qs[t * 128 + kq * 16 + i] * M[i];
#pragma unroll
                for (int s = 0; s < 8; ++s) a += Ps[t * 64 + kq * 8 + s] * Vs[(kq * 8 + s) * 64 + v];
                atomicAdd(&Os[t * 64 + v], a); }
            __syncthreads();
            for (int idx = F.tid; idx < 64 * 64; idx += NTHR) { const int t = idx >> 6, vv = idx & 63; Od[(size_t)(t0 + t) * 512 + hh * 128 + vh * 64 + vv] = (bf16)f2bf(Os[idx]); }
            const int cn = dir ? c - 1 : c + 1; const bool has = cc < 31;
#pragma unroll
            for (int i = 0; i < 16; ++i) { float u = 0.f; const int ch = kq * 16 + i;
                for (int t = 0; t < 64; ++t) u += Ks[t * 128 + ch] * Vs[t * 64 + v];
                const float d = has ? EL[(size_t)gc * 512 + hh * 128 + ch] * ER[(size_t)(b * 32 + cn) * 512 + hh * 128 + ch] : 0.f;
                M[i] = (M[i] + u) * d; }
        }
    }
    __syncthreads();
}
__device__ __forceinline__ void attn_naive(const Frame& F) {
    const bf16* QM = WSP(bf16, WS_QM); const bf16* KH = WSP(bf16, WS_KH); const bf16* VH = WSP(bf16, WS_VH); bf16* OM = DOP(bf16, DO_OM);
    const float* RT = WSP(float, WS_ROPE); const float* QN = F.in[I_QN];
    for (int item = blockIdx.x; item < NB * MH * 4; item += F.G) {
        const int qb = item & 3, h = (item >> 2) & 7, b = item >> 5; const int t = b * SEQ + qb * 512 + F.tid;
        float q[96]; float ss = 0.f;
#pragma unroll
        for (int c = 0; c < 12; ++c) { const v4u w = *(const v4u*)(QM + (size_t)t * 768 + h * 96 + c * 8);
            q[c * 8 + 0] = bflo(w.x); q[c * 8 + 1] = bfhi(w.x); q[c * 8 + 2] = bflo(w.y); q[c * 8 + 3] = bfhi(w.y); q[c * 8 + 4] = bflo(w.z); q[c * 8 + 5] = bfhi(w.z); q[c * 8 + 6] = bflo(w.w); q[c * 8 + 7] = bfhi(w.w); }
#pragma unroll
        for (int d = 0; d < 96; ++d) ss += q[d] * q[d];
        const float rs = rsqrtf(ss * (1.0f / 96.0f) + EPS) ;
#pragma unroll
        for (int d = 0; d < 96; ++d) q[d] = q[d] * rs * QN[d];
#pragma unroll
        for (int i = 0; i < 16; ++i) { const float c = RT[(size_t)t * 32 + i], s = RT[(size_t)t * 32 + 16 + i]; const float x1 = q[64 + i], x2 = q[80 + i]; q[64 + i] = x1 * c - x2 * s; q[80 + i] = x2 * c + x1 * s; }
        const float sc = 0.10206207261596577f;
        unsigned qp[48];
#pragma unroll
        for (int d = 0; d < 48; ++d) qp[d] = pk2(q[2 * d] * sc, q[2 * d + 1] * sc);
        float o[64]; float mx = -1e30f, l = 0.f;
#pragma unroll
        for (int d = 0; d < 64; ++d) o[d] = 0.f;
        for (int s = 0; s < SEQ; ++s) {
            const bf16* kp = KH + ((size_t)(b * SEQ + s) * 8 + h) * 96; float a = 0.f;
#pragma unroll
            for (int c = 0; c < 12; ++c) { const v4u w = *(const v4u*)(kp + c * 8);
                a = dot2bf(qp[c * 4 + 0], w.x, a); a = dot2bf(qp[c * 4 + 1], w.y, a); a = dot2bf(qp[c * 4 + 2], w.z, a); a = dot2bf(qp[c * 4 + 3], w.w, a);
                if (c & 1) asm volatile("" ::: "memory"); }
            const float mn = fmaxf(mx, a), al = __expf(mx - mn), p = __expf(a - mn); mx = mn; l = l * al + p;
            const bf16* vp = VH + ((size_t)(b * SEQ + s) * 8 + h) * 64;
#pragma unroll
            for (int c = 0; c < 8; ++c) { const v4u w = *(const v4u*)(vp + c * 8);
                o[c * 8 + 0] = o[c * 8 + 0] * al + p * bflo(w.x); o[c * 8 + 1] = o[c * 8 + 1] * al + p * bfhi(w.x); o[c * 8 + 2] = o[c * 8 + 2] * al + p * bflo(w.y); o[c * 8 + 3] = o[c * 8 + 3] * al + p * bfhi(w.y);
                o[c * 8 + 4] = o[c * 8 + 4] * al + p * bflo(w.z); o[c * 8 + 5] = o[c * 8 + 5] * al + p * bfhi(w.z); o[c * 8 + 6] = o[c * 8 + 6] * al + p * bflo(w.w); o[c * 8 + 7] = o[c * 8 + 7] * al + p * bfhi(w.w); if (c & 1) asm volatile("" ::: "memory"); }
        }
        const float il = 1.0f / l;
#pragma unroll
        for (int c = 0; c < 8; ++c) st8(OM + (size_t)t * 512 + h * 64 + c * 8, (f32x4){o[c * 8] * il, o[c * 8 + 1] * il, o[c * 8 + 2] * il, o[c * 8 + 3] * il}, (f32x4){o[c * 8 + 4] * il, o[c * 8 + 5] * il, o[c * 8 + 6] * il, o[c * 8 + 7] * il});
    }
}
namespace att {
using f32x16 = __attribute__((ext_vector_type(16))) float;
using s16x4 = __attribute__((ext_vector_type(4))) short;
constexpr int QBLK = 32, KVBLK = 64;
constexpr float SCALE = 0.10206207261596577f;
constexpr float THR = 8.f;
constexpr int SHM_V = 16384, SHM_K = 16384, SHM_ATTN = 2 * SHM_V + 2 * SHM_K + NWAVES * 64 * 4;
#define KSWZ(row, colB) ((row) * 256 + ((colB) ^ (((row) & 7) << 4)))
#define SBAR() __builtin_amdgcn_sched_barrier(0)
__device__ __forceinline__ int crow(int r, int hi) { return (r & 3) + 8 * (r >> 2) + 4 * hi; }
__device__ __forceinline__ unsigned cvtpk(float lo, float hi) { unsigned r; asm volatile("v_cvt_pk_bf16_f32 %0, %1, %2" : "=v"(r) : "v"(lo), "v"(hi)); return r; }
__device__ __forceinline__ void partialSM(f32x16& p0, f32x16& p1, float& m_reg, float& mn, float& alpha) {
    constexpr float C = SCALE * 1.4426950408889634f;
    float pmax = p0[0];
#pragma unroll
    for (int r = 1; r < 16; ++r) pmax = fmaxf(pmax, p0[r]);
#pragma unroll
    for (int r = 0; r < 16; ++r) pmax = fmaxf(pmax, p1[r]);
    { auto rr = __builtin_amdgcn_permlane32_swap(__float_as_uint(pmax), __float_as_uint(pmax), false, false); pmax = fmaxf(__uint_as_float(rr[0]), __uint_as_float(rr[1])); }
    if (__builtin_expect(__all(pmax - m_reg <= THR / SCALE), 1)) { mn = m_reg; alpha = 1.f; }
    else { mn = fmaxf(m_reg, pmax); alpha = __builtin_amdgcn_exp2f((m_reg - mn) * C); m_reg = mn; }
    const float mnC = -mn * C;
#pragma unroll
    for (int r = 0; r < 16; ++r) p0[r] = fmaf(p0[r], C, mnC);
#pragma unroll
    for (int r = 0; r < 16; ++r) p1[r] = fmaf(p1[r], C, mnC);
#pragma unroll
    for (int r = 0; r < 16; ++r) p0[r] = __builtin_amdgcn_exp2f(p0[r]);
}
__device__ __forceinline__ void finishSM(f32x16& p0, f32x16& p1, float alpha, float& l_reg, bf16x8& pa0, bf16x8& pa1, bf16x8& pa2, bf16x8& pa3) {
#pragma unroll
    for (int r = 0; r < 16; ++r) p1[r] = __builtin_amdgcn_exp2f(p1[r]);
    float ps = 0;
#pragma unroll
    for (int r = 0; r < 16; ++r) ps += p0[r];
#pragma unroll
    for (int r = 0; r < 16; ++r) ps += p1[r];
    { auto rr = __builtin_amdgcn_permlane32_swap(__float_as_uint(ps), __float_as_uint(ps), false, false); ps = __uint_as_float(rr[0]) + __uint_as_float(rr[1]); }
    l_reg = l_reg * alpha + ps;
#define PK4(P, BASE, OUT) do { unsigned a0 = cvtpk(P[BASE + 0], P[BASE + 1]), a1 = cvtpk(P[BASE + 2], P[BASE + 3]);   \
    unsigned b0 = cvtpk(P[BASE + 4], P[BASE + 5]), b1 = cvtpk(P[BASE + 6], P[BASE + 7]);                              \
    auto r0 = __builtin_amdgcn_permlane32_swap(a0, b0, false, false); auto r1 = __builtin_amdgcn_permlane32_swap(a1, b1, false, false); \
    v4u w = {r0[0], r1[0], r0[1], r1[1]}; OUT = __builtin_bit_cast(bf16x8, w); } while (0)
    PK4(p0, 0, pa0); PK4(p0, 8, pa1); PK4(p1, 0, pa2); PK4(p1, 8, pa3);
#undef PK4
}
__device__ __forceinline__ void qkt(f32x16& p0, f32x16& p1, const char* Ks, const bf16x8* qr, int r32, int hi) {
    p0 = f32x16{}; p1 = f32x16{};
#pragma unroll
    for (int d0 = 0; d0 < 6; ++d0) { const int cb = (d0 * 16 + hi * 8) * 2;
        const bf16x8 b0 = *reinterpret_cast<const bf16x8*>(Ks + KSWZ(r32, cb));
        const bf16x8 b1 = *reinterpret_cast<const bf16x8*>(Ks + KSWZ(32 + r32, cb));
        p0 = __builtin_amdgcn_mfma_f32_32x32x16_bf16(b0, qr[d0], p0, 0, 0, 0);
        p1 = __builtin_amdgcn_mfma_f32_32x32x16_bf16(b1, qr[d0], p1, 0, 0, 0); }
}
__device__ __forceinline__ int v_st(int k, int c) { const int kk = (k & ~0xC) | ((k & 4) << 1) | ((k & 8) >> 1); return ((kk >> 3) * 4 + (c >> 5)) * 512 + ((kk & 7) * 32 + (c & 31)) * 2; }
__device__ __forceinline__ int v_rd_base(int lane) { return ((lane & 3) << 3) | (((lane >> 2) & 3) << 6) | (((lane >> 4) & 1) << 5) | (((lane >> 5) & 1) << 8); }
constexpr int v_rd_off(int d0, int ks, int half) { return d0 * 512 + ks * 4096 + half * 2048; }
template <int OFF> __device__ __forceinline__ s16x4 tr_read(int vb) { s16x4 r; asm volatile("ds_read_b64_tr_b16 %0, %1 offset:%2" : "=&v"(r) : "v"(vb), "i"(OFF) : "memory"); return r; }
template <int D0> __device__ __forceinline__ void pv_one(f32x16& od, int vb, bf16x8 pa0, bf16x8 pa1, bf16x8 pa2, bf16x8 pa3) {
    const s16x4 l0 = tr_read<v_rd_off(D0, 0, 0)>(vb), h0 = tr_read<v_rd_off(D0, 0, 1)>(vb), l1 = tr_read<v_rd_off(D0, 1, 0)>(vb), h1 = tr_read<v_rd_off(D0, 1, 1)>(vb);
    const s16x4 l2 = tr_read<v_rd_off(D0, 2, 0)>(vb), h2 = tr_read<v_rd_off(D0, 2, 1)>(vb), l3 = tr_read<v_rd_off(D0, 3, 0)>(vb), h3 = tr_read<v_rd_off(D0, 3, 1)>(vb);
    asm volatile("s_waitcnt lgkmcnt(0)" ::: "memory"); SBAR();
#define PK(L, H) (bf16x8){L[0], L[1], L[2], L[3], H[0], H[1], H[2], H[3]}
    od = __builtin_amdgcn_mfma_f32_32x32x16_bf16(pa0, PK(l0, h0), od, 0, 0, 0);
    od = __builtin_amdgcn_mfma_f32_32x32x16_bf16(pa1, PK(l1, h1), od, 0, 0, 0);
    od = __builtin_amdgcn_mfma_f32_32x32x16_bf16(pa2, PK(l2, h2), od, 0, 0, 0);
    od = __builtin_amdgcn_mfma_f32_32x32x16_bf16(pa3, PK(l3, h3), od, 0, 0, 0);
#undef PK
}
__device__ __forceinline__ void pv_d0(f32x16* o, int vb, bf16x8 pa0, bf16x8 pa1, bf16x8 pa2, bf16x8 pa3) { pv_one<0>(o[0], vb, pa0, pa1, pa2, pa3); pv_one<1>(o[1], vb, pa0, pa1, pa2, pa3); }

__device__ __forceinline__ void attn_unit(const bf16* __restrict__ QM, const bf16* __restrict__ KH, const bf16* __restrict__ VH, bf16* __restrict__ OM, const float* __restrict__ RT, const float* __restrict__ QN,
                                          int t0, int kb, int h, char* lds) {
    int tid_ = threadIdx.x; asm volatile("" : "+v"(tid_));
    const int tid = tid_, wid = __builtin_amdgcn_readfirstlane(tid >> 6), lane = tid & 63, r32 = lane & 31, hi = lane >> 5;
    char* V_lds = lds; char* K_lds = lds + 2 * SHM_V;
    float* wsf = (float*)(lds + 2 * SHM_V + 2 * SHM_K) + wid * 64; float* li_l = wsf; float* al_l = wsf + 32;
    float m_reg = -1e30f, l_reg = 0; f32x16 o[2] = {}; bf16x8 qr[6];
    {
        const int tq = t0 + wid * QBLK + r32; const bf16* qp = QM + (size_t)tq * 768 + h * 96 + hi * 8;
        float qf[6][8]; float ss = 0.f;
#pragma unroll
        for (int d0 = 0; d0 < 6; ++d0) { const v4u w = *(const v4u*)(qp + d0 * 16);
            qf[d0][0] = bflo(w.x); qf[d0][1] = bfhi(w.x); qf[d0][2] = bflo(w.y); qf[d0][3] = bfhi(w.y); qf[d0][4] = bflo(w.z); qf[d0][5] = bfhi(w.z); qf[d0][6] = bflo(w.w); qf[d0][7] = bfhi(w.w);
#pragma unroll
            for (int j = 0; j < 8; ++j) ss += qf[d0][j] * qf[d0][j]; }
        { auto rr = __builtin_amdgcn_permlane32_swap(__float_as_uint(ss), __float_as_uint(ss), false, false); ss = __uint_as_float(rr[0]) + __uint_as_float(rr[1]); }
        const float rs = rsqrtf(ss * (1.0f / 96.0f) + EPS);
#pragma unroll
        for (int d0 = 0; d0 < 6; ++d0) { const f32x4 g0 = *(const f32x4*)(QN + d0 * 16 + hi * 8), g1 = *(const f32x4*)(QN + d0 * 16 + hi * 8 + 4);
#pragma unroll
            for (int j = 0; j < 4; ++j) { qf[d0][j] *= rs * g0[j]; qf[d0][4 + j] *= rs * g1[j]; } }
        { const float* rt = RT + (size_t)tq * 32 + hi * 8; const f32x4 c0 = *(const f32x4*)rt, c1 = *(const f32x4*)(rt + 4), s0 = *(const f32x4*)(rt + 16), s1 = *(const f32x4*)(rt + 20);
#pragma unroll
          for (int j = 0; j < 8; ++j) { const float c = j < 4 ? c0[j & 3] : c1[j & 3], s = j < 4 ? s0[j & 3] : s1[j & 3]; const float x1 = qf[4][j], x2 = qf[5][j]; qf[4][j] = x1 * c - x2 * s; qf[5][j] = x2 * c + x1 * s; } }
#pragma unroll
        for (int d0 = 0; d0 < 6; ++d0) { v4u w = {cvtpk(qf[d0][0], qf[d0][1]), cvtpk(qf[d0][2], qf[d0][3]), cvtpk(qf[d0][4], qf[d0][5]), cvtpk(qf[d0][6], qf[d0][7])}; qr[d0] = __builtin_bit_cast(bf16x8, w); }
    }
    const int vrow = tid >> 3, vch = tid & 7, k0row = tid / 12, k0ch = tid - 12 * k0row, k1row = (tid + 512) / 12, k1ch = (tid + 512) - 12 * k1row; const bool two = wid < 4;
    const bf16* Kg = KH + ((size_t)kb * 8 + h) * 96; const bf16* Vg = VH + ((size_t)kb * 8 + h) * 64;
    const int vst0 = v_st(vrow, vch * 8), kst0 = KSWZ(k0row, k0ch * 16), kst1 = KSWZ(k1row, k1ch * 16);
    const int vb0 = (int)(uintptr_t)V_lds + v_rd_base(lane);
    struct { bf16x8 vs, ks0, ks1; } sr_[2];
#define SLOAD(i, kk) do { sr_[i].vs = *(const bf16x8*)(Vg + (size_t)((kk) + vrow) * 512 + vch * 8); sr_[i].ks0 = *(const bf16x8*)(Kg + (size_t)((kk) + k0row) * 768 + k0ch * 8); \
    if (two) sr_[i].ks1 = *(const bf16x8*)(Kg + (size_t)((kk) + k1row) * 768 + k1ch * 8); } while (0)
#define SWRITE(b, i) do { *(bf16x8*)(V_lds + (b) * SHM_V + vst0) = sr_[i].vs; *(bf16x8*)(K_lds + (b) * SHM_K + kst0) = sr_[i].ks0; if (two) *(bf16x8*)(K_lds + (b) * SHM_K + kst1) = sr_[i].ks1; } while (0)
#define SWAIT() do { if (two) asm volatile("s_waitcnt vmcnt(3)" ::: "memory"); else asm volatile("s_waitcnt vmcnt(2)" ::: "memory"); } while (0)
#define RESC(a) do { if (__any((a) < 1.f)) { if (hi == 0) al_l[r32] = (a); asm volatile("s_waitcnt lgkmcnt(0)" ::: "memory"); \
    _Pragma("unroll") for (int d = 0; d < 2; ++d) _Pragma("unroll") for (int r = 0; r < 16; ++r) o[d][r] *= al_l[crow(r, hi)]; } } while (0)
    f32x16 pA0, pA1, pB0, pB1; float mnA, mnB, alA, alB; bf16x8 pa0, pa1, pa2, pa3; constexpr int NT = SEQ / KVBLK;
    SLOAD(0, 0); asm volatile("s_waitcnt vmcnt(0)" ::: "memory"); SWRITE(0, 0); __syncthreads();
    qkt(pA0, pA1, K_lds, qr, r32, hi); partialSM(pA0, pA1, m_reg, mnA, alA);
    SLOAD(1, KVBLK); SLOAD(0, 2 * KVBLK);
    SWAIT(); SWRITE(1, 1); __syncthreads();
    for (int j = 1; j + 1 < NT; j += 2) {
        SBAR(); qkt(pB0, pB1, K_lds + SHM_K, qr, r32, hi);
        finishSM(pA0, pA1, alA, l_reg, pa0, pa1, pa2, pa3); SBAR();
        SLOAD(1, (j + 2) * KVBLK); SBAR();
        pv_d0(o, vb0, pa0, pa1, pa2, pa3); partialSM(pB0, pB1, m_reg, mnB, alB);
        __syncthreads(); SWAIT(); SWRITE(0, 0);
        RESC(alB); __syncthreads();
        SBAR(); qkt(pA0, pA1, K_lds, qr, r32, hi);
        finishSM(pB0, pB1, alB, l_reg, pa0, pa1, pa2, pa3); SBAR();
        if (j + 3 < NT) SLOAD(0, (j + 3) * KVBLK); SBAR();
        pv_d0(o, vb0 + SHM_V, pa0, pa1, pa2, pa3); partialSM(pA0, pA1, m_reg, mnA, alA);
        __syncthreads(); SWAIT(); SWRITE(1, 1);
        RESC(alA); __syncthreads();
    }
    SBAR(); qkt(pB0, pB1, K_lds + SHM_K, qr, r32, hi);
    finishSM(pA0, pA1, alA, l_reg, pa0, pa1, pa2, pa3); SBAR();
    pv_d0(o, vb0, pa0, pa1, pa2, pa3); partialSM(pB0, pB1, m_reg, mnB, alB);
    __syncthreads(); RESC(alB);
    finishSM(pB0, pB1, alB, l_reg, pa0, pa1, pa2, pa3); SBAR();
    pv_d0(o, vb0 + SHM_V, pa0, pa1, pa2, pa3);
    if (hi == 0) li_l[r32] = l_reg; asm volatile("s_waitcnt lgkmcnt(0)" ::: "memory");
    bf16* Ow = OM + (size_t)(t0 + wid * QBLK) * 512 + h * 64;
#pragma unroll
    for (int r = 0; r < 16; ++r) { const int orow = crow(r, hi); const float rl = __builtin_amdgcn_rcpf(li_l[orow]);
#pragma unroll
        for (int d0 = 0; d0 < 2; ++d0) Ow[(size_t)orow * 512 + d0 * 32 + r32] = (bf16)f2bf(o[d0][r] * rl); }
    asm volatile("s_waitcnt vmcnt(0)" ::: "memory");
    __syncthreads();
#undef SLOAD
#undef SWRITE
#undef SWAIT
#undef RESC
}
#undef KSWZ
#undef SBAR
}
__device__ __forceinline__ void attn_fast(const Frame& F) {
    const bf16* QM = WSP(bf16, WS_QM); const bf16* KH = WSP(bf16, WS_KH); const bf16* VH = WSP(bf16, WS_VH); bf16* OM = DOP(bf16, DO_OM);
    for (int item = F.vcu; item < NB * MH * 8; item += F.G) {
        const int qb = item & 7, h = (item >> 3) & 7, b = item >> 6;
        att::attn_unit(QM, KH, VH, OM, WSP(float, WS_ROPE), F.in[I_QN], b * SEQ + qb * 256, b * SEQ, h, (char*)F.gl);
    }
}
namespace hg {
typedef short v4i16_t __attribute__((ext_vector_type(4)));
constexpr int IN_BYTES = 40960, OFF_Q = 0, OFF_K = 16384, OFF_V = 32768, OFF_P = 2 * IN_BYTES, OFF_MT = OFF_P + 8192;
__device__ __forceinline__ unsigned off256(unsigned row, unsigned ch) { return 256u * row + 16u * (ch ^ (((row & 3) << 2) | ((row >> 2) & 3))); }
__device__ __forceinline__ unsigned off128(unsigned row, unsigned ch) { return 128u * row + 16u * (ch ^ (row & 7)); }
__device__ __forceinline__ bf16x8 ldrow(const LAS unsigned char* p) { return *(const LAS bf16x8*)p; }
__device__ __forceinline__ bf16x8 ldtr(const LAS unsigned char* p0, const LAS unsigned char* p1) {
    const v4i16_t a = __builtin_amdgcn_ds_read_tr16_b64_v4i16((LAS v4i16_t*)p0), b = __builtin_amdgcn_ds_read_tr16_b64_v4i16((LAS v4i16_t*)p1);
    return (bf16x8){a[0], a[1], a[2], a[3], b[0], b[1], b[2], b[3]};
}
}
__device__ __forceinline__ void hgrn_fast(const Frame& F) {
    using namespace hg;
    int tid_ = threadIdx.x; asm volatile("" : "+v"(tid_));
    const int tid = tid_, lane = tid & 63, w = __builtin_amdgcn_readfirstlane(tid >> 6), l15 = lane & 15, g = lane >> 4, q4 = (lane & 15) >> 2, p4 = lane & 3;
    const LAS unsigned char* L = F.lds;
    const unsigned qrow0 = tid >> 4, qch = tid & 15, qrow1 = qrow0 + 32, vrow = tid >> 3, vch = tid & 7;
    const unsigned sq0 = off256(qrow0, qch), sq1 = off256(qrow1, qch), sv = off128(vrow, vch);
    const int tb = w >> 1, sb0 = 2 * (w & 1);
    for (int item = blockIdx.x; item < NB * HGH * 2 * 2; item += F.G) {
        const int vh = item & 1, dir = (item >> 1) & 1, hh = (item >> 2) & 3, b = item >> 4;
        const bf16* Qd = DOP(bf16, dir ? DO_QB : DO_QF) + hh * 128 + qch * 8; const bf16* Kd = DOP(bf16, dir ? DO_KB : DO_KF) + hh * 128 + qch * 8;
        const bf16* Va = WSP(bf16, WS_VA) + hh * 128 + vh * 64 + vch * 8;
        bf16* Od = WSP(bf16, WS_ACT) + (dir ? (size_t)T * 512 : (size_t)0) + hh * 128 + vh * 64;
        const float* ER = WSP(float, WS_EREF) + (size_t)dir * NCHUNK * 512 + hh * 128 + 16 * w + 4 * g; const float* EL = WSP(float, WS_ELAST) + (size_t)dir * NCHUNK * 512 + hh * 128 + 16 * w + 4 * g;
#define HG_BAR() asm volatile("s_waitcnt lgkmcnt(0)\n\ts_barrier" ::: "memory")
        f32x4 M[4];
#pragma unroll
        for (int i = 0; i < 4; ++i) M[i] = (f32x4){0.f, 0.f, 0.f, 0.f};
        v4u rq0, rq1, rk0, rk1, rv;
#define HG_LOAD(gc_) do { const size_t t0_ = (size_t)(gc_) * 64; rq0 = *(const v4u*)(Qd + (t0_ + qrow0) * 512); rq1 = *(const v4u*)(Qd + (t0_ + qrow1) * 512); \
        rk0 = *(const v4u*)(Kd + (t0_ + qrow0) * 512); rk1 = *(const v4u*)(Kd + (t0_ + qrow1) * 512); rv = *(const v4u*)(Va + (t0_ + vrow) * 512); } while (0)
#define HG_WRITE(buf_) do { LAS unsigned char* B_ = (LAS unsigned char*)L + (buf_) * IN_BYTES; *(LAS v4u*)(B_ + OFF_Q + sq0) = rq0; *(LAS v4u*)(B_ + OFF_Q + sq1) = rq1; \
        *(LAS v4u*)(B_ + OFF_K + sq0) = rk0; *(LAS v4u*)(B_ + OFF_K + sq1) = rk1; *(LAS v4u*)(B_ + OFF_V + sv) = rv; } while (0)
        __syncthreads();
        { const int c0 = dir ? 31 : 0; HG_LOAD(b * 32 + c0); HG_WRITE(0); }
        __syncthreads();
        for (int cc = 0; cc < 32; ++cc) {
            const int c = dir ? 31 - cc : cc, gc = b * 32 + c, cn = dir ? c - 1 : c + 1, buf = cc & 1; const bool has = cc < 31;
            const LAS unsigned char* Bq = L + buf * IN_BYTES + OFF_Q; const LAS unsigned char* Bk = L + buf * IN_BYTES + OFF_K; const LAS unsigned char* Bv = L + buf * IN_BYTES + OFF_V;
            if (has) HG_LOAD(b * 32 + cn);
            f32x4 dv = (f32x4){0.f, 0.f, 0.f, 0.f};
            if (has) dv = *(const f32x4*)(EL + (size_t)gc * 512) * *(const f32x4*)(ER + (size_t)(b * 32 + cn) * 512);
            {
                f32x4 pa[2] = {(f32x4){0.f, 0.f, 0.f, 0.f}, (f32x4){0.f, 0.f, 0.f, 0.f}};
#pragma unroll
                for (int ks = 0; ks < 4; ++ks) { const bf16x8 qf = ldrow(Bq + off256(16 * tb + l15, 4 * ks + g));
#pragma unroll
                    for (int i = 0; i < 2; ++i) { const bf16x8 kf = ldrow(Bk + off256(16 * (sb0 + i) + l15, 4 * ks + g)); pa[i] = __builtin_amdgcn_mfma_f32_16x16x32_bf16(kf, qf, pa[i], 0, 0, 0); } }
                const int t = 16 * tb + l15;
#pragma unroll
                for (int i = 0; i < 2; ++i) { const int s0 = 16 * (sb0 + i) + 4 * g; f32x4 v = pa[i];
#pragma unroll
                    for (int r = 0; r < 4; ++r) { const bool ok = dir ? (s0 + r >= t) : (s0 + r <= t); v[r] = ok ? v[r] : 0.f; }
                    v2u pk; pk.x = pk2(v[0], v[1]); pk.y = pk2(v[2], v[3]);
                    *(LAS v2u*)((LAS unsigned char*)L + OFF_P + off128(t, 2 * (sb0 + i) + (g >> 1)) + (g & 1) * 8) = pk; }
#pragma unroll
                for (int vb = 0; vb < 4; ++vb) { v2u pk; pk.x = pk2(M[vb][0], M[vb][1]); pk.y = pk2(M[vb][2], M[vb][3]);
                    *(LAS v2u*)((LAS unsigned char*)L + OFF_MT + off256(16 * vb + l15, 2 * w + (g >> 1)) + (g & 1) * 8) = pk; }
            }
            HG_BAR();
            {
                f32x4 oa[2] = {(f32x4){0.f, 0.f, 0.f, 0.f}, (f32x4){0.f, 0.f, 0.f, 0.f}};
#pragma unroll
                for (int ks = 0; ks < 2; ++ks) { const bf16x8 pf = ldrow(L + OFF_P + off128(16 * tb + l15, 4 * ks + g));
#pragma unroll
                    for (int i = 0; i < 2; ++i) { const unsigned c = sb0 + i;
                        const bf16x8 vf = ldtr(Bv + off128(32 * ks + 8 * g + q4, 2 * c + (p4 >> 1)) + 8 * (p4 & 1), Bv + off128(32 * ks + 8 * g + 4 + q4, 2 * c + (p4 >> 1)) + 8 * (p4 & 1));
                        oa[i] = __builtin_amdgcn_mfma_f32_16x16x32_bf16(vf, pf, oa[i], 0, 0, 0); } }
#pragma unroll
                for (int ks = 0; ks < 4; ++ks) { const bf16x8 qf = ldrow(Bq + off256(16 * tb + l15, 4 * ks + g));
#pragma unroll
                    for (int i = 0; i < 2; ++i) { const bf16x8 mf = ldrow(L + OFF_MT + off256(16 * (sb0 + i) + l15, 4 * ks + g)); oa[i] = __builtin_amdgcn_mfma_f32_16x16x32_bf16(mf, qf, oa[i], 0, 0, 0); } }
                const size_t orow = ((size_t)gc * 64 + 16 * tb + l15) * 512;
#pragma unroll
                for (int i = 0; i < 2; ++i) st4(Od + orow + 16 * (sb0 + i) + 4 * g, oa[i]);
#pragma unroll
                for (int ks = 0; ks < 2; ++ks) {
                    const bf16x8 kf = ldtr(Bk + off256(32 * ks + 8 * g + q4, 2 * w + (p4 >> 1)) + 8 * (p4 & 1), Bk + off256(32 * ks + 8 * g + 4 + q4, 2 * w + (p4 >> 1)) + 8 * (p4 & 1));
#pragma unroll
                    for (int vb = 0; vb < 4; ++vb) {
                        const bf16x8 vf = ldtr(Bv + off128(32 * ks + 8 * g + q4, 2 * vb + (p4 >> 1)) + 8 * (p4 & 1), Bv + off128(32 * ks + 8 * g + 4 + q4, 2 * vb + (p4 >> 1)) + 8 * (p4 & 1));
                        M[vb] = __builtin_amdgcn_mfma_f32_16x16x32_bf16(kf, vf, M[vb], 0, 0, 0); } }
#pragma unroll
                for (int vb = 0; vb < 4; ++vb) M[vb] = M[vb] * dv;
            }
            if (has) HG_WRITE(buf ^ 1);
            HG_BAR();
        }
#undef HG_LOAD
#undef HG_WRITE
#undef HG_BAR
    }
}
__device__ __forceinline__ void route_fast(const Frame& F) {
    int tid_ = threadIdx.x; asm volatile("" : "+v"(tid_));
    const int tid = tid_, lane = tid & 63, w = __builtin_amdgcn_readfirstlane(tid >> 6), l15 = lane & 15, g = lane >> 4;
    LAS float* lg = (LAS float*)F.lds + w * 16 * 80;
    LAS int* cntL = (LAS int*)(F.lds + 40960); LAS int* baseL = cntL + 64;
    const bf16* WRH = WSP(bf16, WS_WRH); const bf16* WRL = WSP(bf16, WS_WRL); const float* BR = WSP(float, WS_BR);
    bf16* HM = WSP(bf16, WS_ACT); int* EIDX = WSP(int, WS_EIDX); float* EW = WSP(float, WS_EW); int* LIST = WSP(int, WS_LIST); float* RS2 = WSP(float, WS_RS2);
    for (int round = 0; round * F.G * 128 < T; ++round) {
        const int m0 = (round * F.G + F.vcu) * 128 + w * 16;
        if (tid < 64) cntL[tid] = 0;
        __syncthreads();
        f32x4 acc[5];
#pragma unroll
        for (int cb = 0; cb < 5; ++cb) acc[cb] = (f32x4){0.f, 0.f, 0.f, 0.f};
        float ss = 0.f;
        const float* xr = F.out + (size_t)(m0 + l15) * 1024 + 8 * g; bf16* hr = HM + (size_t)(m0 + l15) * 1024 + 8 * g;
        const bf16* wh = WRH + (size_t)l15 * 1024 + 8 * g; const bf16* wl = WRL + (size_t)l15 * 1024 + 8 * g;
#pragma unroll 2
        for (int ks = 0; ks < 32; ++ks) {
            const f32x4 a0 = *(const f32x4*)(xr + 32 * ks), a1 = *(const f32x4*)(xr + 32 * ks + 4);
            ss += dot4(a0) + dot4(a1);
            v4u hi; hi.x = pk2(a0[0], a0[1]); hi.y = pk2(a0[2], a0[3]); hi.z = pk2(a1[0], a1[1]); hi.w = pk2(a1[2], a1[3]);
            v4u lo; lo.x = pk2(a0[0] - bflo(hi.x), a0[1] - bfhi(hi.x)); lo.y = pk2(a0[2] - bflo(hi.y), a0[3] - bfhi(hi.y)); lo.z = pk2(a1[0] - bflo(hi.z), a1[1] - bfhi(hi.z)); lo.w = pk2(a1[2] - bflo(hi.w), a1[3] - bfhi(hi.w));
            *(v4u*)(hr + 32 * ks) = hi;
            const bf16x8 xh = __builtin_bit_cast(bf16x8, hi), xl = __builtin_bit_cast(bf16x8, lo);
#pragma unroll
            for (int cb = 0; cb < 5; ++cb) { const bf16x8 bh = *(const bf16x8*)(wh + (size_t)cb * 16 * 1024 + 32 * ks), bl = *(const bf16x8*)(wl + (size_t)cb * 16 * 1024 + 32 * ks);
                acc[cb] = __builtin_amdgcn_mfma_f32_16x16x32_bf16(xh, bh, acc[cb], 0, 0, 0);
                acc[cb] = __builtin_amdgcn_mfma_f32_16x16x32_bf16(xh, bl, acc[cb], 0, 0, 0);
                acc[cb] = __builtin_amdgcn_mfma_f32_16x16x32_bf16(xl, bh, acc[cb], 0, 0, 0); }
        }
        ss += __shfl_xor(ss, 16); ss += __shfl_xor(ss, 32);
        const float rs = rsqrtf(ss * (1.0f / D) + EPS);
        if (g == 0) RS2[m0 + l15] = rs;
        float rsr[4];
#pragma unroll
        for (int r = 0; r < 4; ++r) rsr[r] = __shfl(rs, 4 * g + r);
#pragma unroll
        for (int cb = 0; cb < 5; ++cb) { const float bias = BR[16 * cb + l15];
#pragma unroll
            for (int r = 0; r < 4; ++r) lg[(4 * g + r) * 80 + 16 * cb + l15] = acc[cb][r] * rsr[r] + bias; }
        LDS_WAIT(); asm volatile("" ::: "memory");
        int e0 = 0, e1 = 0, r0 = 0, r1 = 0; const int m = m0 + lane;
        if (lane < 16) {
            const LAS float* lt = lg + lane * 80;
            float gl[8];
#pragma unroll
            for (int i = 0; i < 8; ++i) gl[i] = lt[i];
            float gm = gl[0]; int gs = 0;
#pragma unroll
            for (int i = 1; i < 8; ++i) if (gl[i] > gm) { gm = gl[i]; gs = i; }
            float ge = 0.f;
#pragma unroll
            for (int i = 0; i < 8; ++i) ge += __expf(gl[i] - gm);
            const float pg = 1.0f / ge;
            float el[8];
#pragma unroll
            for (int i = 0; i < 8; ++i) el[i] = lt[8 + 8 * gs + i];
            float m1 = el[0]; int i1 = 0;
#pragma unroll
            for (int i = 1; i < 8; ++i) if (el[i] > m1) { m1 = el[i]; i1 = i; }
            float m2 = -3e38f; int i2 = 0;
#pragma unroll
            for (int i = 0; i < 8; ++i) if (i != i1 && el[i] > m2) { m2 = el[i]; i2 = i; }
            const float e2 = __expf(m2 - m1), w0 = pg / (1.0f + e2), w1 = pg * e2 / (1.0f + e2);
            e0 = 8 * gs + i1; e1 = 8 * gs + i2;
            EIDX[m * 2] = e0; EIDX[m * 2 + 1] = e1; EW[m * 2] = w0; EW[m * 2 + 1] = w1;
            r0 = __hip_atomic_fetch_add(cntL + e0, 1, __ATOMIC_RELAXED, __HIP_MEMORY_SCOPE_WORKGROUP);
            r1 = __hip_atomic_fetch_add(cntL + e1, 1, __ATOMIC_RELAXED, __HIP_MEMORY_SCOPE_WORKGROUP);
        }
        __syncthreads();
        if (tid < 64) { const int c = cntL[tid]; baseL[tid] = c ? (int)__hip_atomic_fetch_add(F.ctl + CW_CNT + 64 * tid, (unsigned)c, RLX_AGENT) : 0; }
        __syncthreads();
        if (lane < 16) { LIST[(size_t)e0 * T + baseL[e0] + r0] = m * 2; LIST[(size_t)e1 * T + baseL[e1] + r1] = m * 2 + 1; }
        __syncthreads();
    }
}
struct Args { const float* in[27]; float* out; unsigned char* ws; int ph_lo, ph_hi, use_bar, pad; };
constexpr int NPHASE = 11;
__device__ __forceinline__ void frame_init(Frame& F, const Args& args, unsigned char* lds) {
    F.lds = (LAS unsigned char*)lds; F.gl = lds;
    F.MISC = (volatile LAS unsigned*)(F.lds + MISC_OFF);
    F.tid = threadIdx.x; F.lane = F.tid & 63; F.wave = __builtin_amdgcn_readfirstlane(F.tid >> 6);
    F.G = gridDim.x; { const int bx = blockIdx.x; F.vcu = (F.G % 8 == 0) ? (bx % 8) * (F.G / 8) + bx / 8 : bx; }
    F.ws = args.ws; F.out = args.out; F.ctl = (gu32*)(args.ws + WS_CTL);
#pragma unroll
    for (int i = 0; i < 27; ++i) F.in[i] = args.in[i];
    for (int u = F.tid; u < 1024 / 4; u += NTHR) ((LAS unsigned*)(F.lds + LDSCTL_OFF))[u] = 0u;
    __syncthreads();
}
template <int PH> __device__ __forceinline__ void run_phase(const Frame& F) {
    if constexpr (PH == 0) { p0_prologue(F); }
    if constexpr (PH == 1) {
        Gemm g{WSP(bf16, WS_ACT), WSP(bf16, WS_WIN), 1024, nullptr}; StaticOrder S; S.init(T, NIN, F.G, (int)blockIdx.x);
        EpiIn E{F.ws, (unsigned char*)F.out};
        GEMM_PHASE(EpiIn, StaticOrder, g, S, E);
    }
    if constexpr (PH == 2) {
        { Gemm g{WSP(bf16, WS_CQ), WSP(bf16, WS_WUQ), 256, nullptr}; StaticOrder S; S.init(T, 768, F.G, (int)blockIdx.x); EpiQ E{WSP(bf16, WS_QM), WSP(float, WS_CQSS)}; GEMM_PHASE(EpiQ, StaticOrder, g, S, E); }
        { Gemm g{WSP(bf16, WS_CKVR), WSP(bf16, WS_WUKV), 256, nullptr}; StaticOrder S; S.init(T, 1024, F.G, (int)blockIdx.x);
          EpiKV E{WSP(bf16, WS_KH), WSP(bf16, WS_VH), WSP(float, WS_CKVSS), WSP(float, WS_KR), WSP(float, WS_ROPE), F.in[I_KN]}; GEMM_PHASE(EpiKV, StaticOrder, g, S, E); }
        HGRN_PHASE(F);
    }
    if constexpr (PH == 3) { oa_pass(F); ATTN_PHASE(F); }
    if constexpr (PH == 4) {
        Gemm g{DOP(bf16, DO_OA), WSP(bf16, WS_WOAB), 512, nullptr}; PairOrder S; S.init(F.G, (int)blockIdx.x); EpiMerge E{WSP(bf16, WS_ACT), WSP(bf16, WS_GA), WSP(bf16, WS_GB)};
        GEMM_PHASE(EpiMerge, PairOrder, g, S, E);
    }
    if constexpr (PH == 5) {
        Gemm g{WSP(bf16, WS_ACT), WSP(bf16, WS_WOUT), 1024, nullptr}; StaticOrder S; S.init(T, D, F.G, (int)blockIdx.x); EpiX2 E{F.in[I_X], F.out};
        GEMM_PHASE(EpiX2, StaticOrder, g, S, E);
    }
    if constexpr (PH == 6) { ROUTE_PHASE(F); __syncthreads(); conv_mat<M_W13>(F); conv_mat<M_W2T>(F); }
    if constexpr (PH == 7) {
        moe_build_table(F);
        Gemm g{WSP(bf16, WS_ACT), WSP(bf16, WS_W13), 1024, WSP(int, WS_LIST)}; MoeOrder S{(const LAS int*)(F.lds + TAB_OFF), 2, F.G, (int)blockIdx.x}; EpiUp E{WSP(bf16, WS_H1), WSP(int, WS_LIST), WSP(float, WS_RS2)};
        GEMM_PHASE_GATHER(EpiUp, MoeOrder, g, S, E);
    }
    if constexpr (PH == 8) {
        moe_build_table(F);
        Gemm g{WSP(bf16, WS_H1), WSP(bf16, WS_W2T), 256, nullptr}; MoeOrder S{(const LAS int*)(F.lds + TAB_OFF), 4, F.G, (int)blockIdx.x}; EpiDown E{WSP(bf16, WS_Y0), WSP(bf16, WS_Y1), WSP(int, WS_LIST), WSP(float, WS_EW)};
        GEMM_PHASE(EpiDown, MoeOrder, g, S, E);
    }
    if constexpr (PH == 9) {
        Gemm g{WSP(bf16, WS_PB), WSP(bf16, WS_WPP), 256, nullptr}; StaticOrder S; S.init(T, D, F.G, (int)blockIdx.x); EpiProj E{WSP(bf16, WS_PROJ)};
        GEMM_PHASE(EpiProj, StaticOrder, g, S, E);
        x3_pass(F);
    }
    if constexpr (PH == 10) {
        Gemm g{WSP(bf16, WS_ACT), WSP(bf16, WS_WPG), 1024, nullptr}; StaticOrder S; S.init(T, D, F.G, (int)blockIdx.x); EpiFinal E{F.out, WSP(bf16, WS_PROJ)};
        GEMM_PHASE(EpiFinal, StaticOrder, g, S, E);
    }
}

template <int PH> __global__ void __launch_bounds__(NTHR, 2) phase_kernel(Args args) {
    extern __shared__ __attribute__((aligned(16))) unsigned char lds[];
    Frame F; frame_init(F, args, lds);
    run_phase<PH>(F);
}
#if N_LAUNCHES == 1
__global__ void __launch_bounds__(NTHR, 2) mega(Args args) {
    extern __shared__ __attribute__((aligned(16))) unsigned char lds[];
    Frame F; frame_init(F, args, lds);
    XcdBarrier bar = xcd_barrier_post((unsigned*)(F.ctl + CW_BAR), F.MISC + 8);
#ifndef DOUBLE_MASK
#define DOUBLE_MASK 0
#endif
#define PHASE1(k) do { Frame Fk = F; int t_ = threadIdx.x; asm volatile("" : "+v"(t_)); Fk.tid = t_; Fk.lane = t_ & 63; Fk.wave = __builtin_amdgcn_readfirstlane(t_ >> 6); run_phase<k>(Fk); } while (0)
#define PHASE(k) do { PHASE1(k); if ((DOUBLE_MASK >> (k)) & 1) { xcd_barrier(bar); PHASE1(k); } } while (0)
    PHASE(0); xcd_barrier(bar);
    PHASE(1); xcd_barrier(bar);
    PHASE(2); xcd_barrier(bar);
    PHASE(3); xcd_barrier(bar);
    PHASE(4); xcd_barrier(bar);
    PHASE(5); xcd_barrier(bar);
    PHASE(6); xcd_barrier(bar);
    PHASE(7); xcd_barrier(bar);
    PHASE(8); xcd_barrier(bar);
    PHASE(9); xcd_barrier(bar);
    PHASE(10);
#undef PHASE
}
#endif
extern "C" void kernel_launch(void* const* d_in, const int* in_sizes, int n_in, void* d_out, int out_size, void* d_ws, size_t ws_size, hipStream_t stream) {
    static int grid = 0;
    if (grid == 0) {
        if (n_in != 27 || in_sizes[0] != T * D || out_size != T * D || ws_size < WS_END) { fprintf(stderr, "kernel_launch: unexpected shapes (n_in %d, in0 %d, out %d, ws %zu)\n", n_in, n_in > 0 ? in_sizes[0] : -1, out_size, ws_size); grid = -1; return; }
        int dev = 0, cus = 0;
        if (hipGetDevice(&dev) != hipSuccess || hipDeviceGetAttribute(&cus, hipDeviceAttributeMultiprocessorCount, dev) != hipSuccess) { grid = -1; return; }
#if N_LAUNCHES == 1
        if (hipFuncSetAttribute((const void*)mega, hipFuncAttributeMaxDynamicSharedMemorySize, LDS_BYTES) != hipSuccess) { fprintf(stderr, "kernel_launch: hipFuncSetAttribute failed\n"); grid = -1; return; }
#else
#define SETATTR(k) if (hipFuncSetAttribute((const void*)phase_kernel<k>, hipFuncAttributeMaxDynamicSharedMemorySize, LDS_BYTES) != hipSuccess) { fprintf(stderr, "kernel_launch: hipFuncSetAttribute failed\n"); grid = -1; return; }
        SETATTR(0) SETATTR(1) SETATTR(2) SETATTR(3) SETATTR(4) SETATTR(5) SETATTR(6) SETATTR(7) SETATTR(8) SETATTR(9) SETATTR(10)
#endif
        grid = cus;
    }
    if (grid < 0) return;
    (void)hipMemsetAsync((char*)d_ws + WS_CTL, 0, CTL_ZERO_BYTES, stream);
    Args a{};
    for (int i = 0; i < 27; ++i) a.in[i] = (const float*)d_in[i];
    a.out = (float*)d_out; a.ws = (unsigned char*)d_ws;
#if N_LAUNCHES == 1
    a.ph_lo = 0; a.ph_hi = NPHASE; a.use_bar = 1;
    hipLaunchKernelGGL(mega, dim3(grid), dim3(NTHR), LDS_BYTES, stream, a);
#else
#define LAUNCH_PH(k) hipLaunchKernelGGL(phase_kernel<k>, dim3(grid), dim3(NTHR), LDS_BYTES, stream, a)
#ifndef LAST_PHASE
#define LAST_PHASE 10
#endif
    LAUNCH_PH(0); LAUNCH_PH(1); LAUNCH_PH(2); LAUNCH_PH(3); LAUNCH_PH(4); LAUNCH_PH(5);
    if (LAST_PHASE >= 6) { LAUNCH_PH(6); } if (LAST_PHASE >= 7) { LAUNCH_PH(7); } if (LAST_PHASE >= 8) { LAUNCH_PH(8); } if (LAST_PHASE >= 9) { LAUNCH_PH(9); } if (LAST_PHASE >= 10) { LAUNCH_PH(10); }
#endif
    const hipError_t le = hipPeekAtLastError();
    if (le != hipSuccess) fprintf(stderr, "kernel_launch: launch failed: %s\n", hipGetErrorName(le));
}
```

```cpp
#define N_LAUNCHES 1
#define NAIVE_MOE 0
#define GEMM_PHASE(EPI, SCHED, g, S, E) gemm_fast<EPI, SCHED, false>(F.lds, g, S, E)
#define GEMM_PHASE_GATHER(EPI, SCHED, g, S, E) gemm_fast<EPI, SCHED, true>(F.lds, g, S, E)
#define HGRN_PHASE(F) hgrn_fast2(F)
#define ATTN_PHASE(F) attn_fast(F)
#define ROUTE_PHASE(F) route_fast<false>(F)
#define SKEW_K1024 0
#define SKEW_K512 0
#define SKEW_K256 0
#define I8_P10 1
#define I8_P1 1
#define I8_P7 1
#define FUSE_PROJ 1
#define STAGGER_CONV 1
#define MERGE_QKV 1
#define GATE_U8 1
#define GATE_FIRST 1
#define ATT_OTR 1
#include <hip/hip_runtime.h>
#include <cstdio>
#include <cstdint>

#define GAS __attribute__((address_space(1)))
#define LAS __attribute__((address_space(3)))
typedef unsigned short bf16;
typedef unsigned v4u __attribute__((ext_vector_type(4)));
typedef unsigned v2u __attribute__((ext_vector_type(2)));
typedef float f32x4 __attribute__((ext_vector_type(4)));
typedef float f32x2 __attribute__((ext_vector_type(2)));
typedef short bf16x8 __attribute__((ext_vector_type(8)));
typedef GAS unsigned gu32;
#define RLX_AGENT __ATOMIC_RELAXED, __HIP_MEMORY_SCOPE_AGENT
#define LDS_WAIT() asm volatile("s_waitcnt lgkmcnt(0)" ::: "memory")
#define VM_WAIT() asm volatile("s_waitcnt vmcnt(0)" ::: "memory")

constexpr int NB = 16, SEQ = 2048, T = NB * SEQ, D = 1024;
constexpr int HGH = 4, HGK = 128, HGV = 128, HGF = 512, CHUNK = 64, NCHUNK = T / CHUNK;
constexpr int MH = 8, NOPE = 64, ROPE = 32, QK = 96, VD = 64, QR = 256, KVR = 128;
constexpr int NG = 8, EPG = 8, NE = 64, DE = 256, PLE = 256;
constexpr int DIN = 5024, NIN = 5120;
constexpr float EPS = 1e-6f;
constexpr int NWAVES = 8, NTHR = 512;

__device__ __forceinline__ unsigned f2bf(float f) { unsigned u = __builtin_bit_cast(unsigned, f); return (u + 0x7fffu + ((u >> 16) & 1u)) >> 16; }
typedef __bf16 bf16pair_t __attribute__((ext_vector_type(2)));
__device__ __forceinline__ unsigned pk2(float lo, float hi) { const f32x2 v = {lo, hi}; return __builtin_bit_cast(unsigned, __builtin_convertvector(v, bf16pair_t)); }
__device__ __forceinline__ float bf2f(unsigned b) { return __builtin_bit_cast(float, b << 16); }
__device__ __forceinline__ float bflo(unsigned w) { return __builtin_bit_cast(float, w << 16); }
__device__ __forceinline__ float bfhi(unsigned w) { return __builtin_bit_cast(float, w & 0xffff0000u); }
__device__ __forceinline__ float sigm(float x) { return __builtin_amdgcn_rcpf(1.0f + __expf(-x)); }
__device__ __forceinline__ float silu_(float x) { return x * __builtin_amdgcn_rcpf(1.0f + __expf(-x)); }
__device__ __forceinline__ float wave_sum(float v) {
#pragma unroll
    for (int o = 1; o < 64; o <<= 1) v += __shfl_xor(v, o);
    return v;
}
__device__ __forceinline__ float wave_max(float v) {
#pragma unroll
    for (int o = 1; o < 64; o <<= 1) v = fmaxf(v, __shfl_xor(v, o));
    return v;
}
__host__ __device__ __forceinline__ int perm8(int p) { const int r = p & 31, n = r >> 4, fq = (r >> 2) & 3, j = r & 3; return (p & ~31) + 8 * fq + 4 * n + j; }
__host__ __device__ __forceinline__ int iperm8(int l) { const int r = l & 31, fq = r >> 3, n = (r >> 2) & 1, j = r & 3; return (l & ~31) + 16 * n + 4 * fq + j; }

#ifndef STAGGER_CONV
#define STAGGER_CONV 0
#endif
#ifndef STAGGER_OA
#define STAGGER_OA 0
#endif
constexpr size_t MiB = 1u << 20;
constexpr size_t WS_CTL = 0, CTL_ZERO_BYTES = 65536;
constexpr size_t WS_LB = 1 * MiB;
constexpr size_t WS_WRH = 1 * MiB + 65536, WS_WRL = WS_WRH + 80 * 1024 * 2;
constexpr size_t WS_BR = WS_WRL + 80 * 1024 * 2;
constexpr size_t WS_SAQ = 1 * MiB + 512 * 1024, WS_SAKV = WS_SAQ + 128 * 1024, WS_SBUQ = 1 * MiB + 768 * 1024, WS_SBUKV = WS_SBUQ + 4096;
constexpr size_t WS_RS2 = 2 * MiB;
constexpr size_t WS_CQSS = 2 * MiB;
constexpr size_t WS_CKVSS = 2 * MiB + 512 * 1024;
constexpr size_t WS_SA3 = 3 * MiB, WS_SA1 = 3 * MiB + 128 * 1024;
constexpr size_t WS_SBPG = 3 * MiB + 256 * 1024, WS_SBIN = WS_SBPG + 4096, WS_SB13 = 3 * MiB + 512 * 1024;
constexpr size_t WS_SAP = 3 * MiB + 640 * 1024, WS_SBPP = 3 * MiB + 768 * 1024;
constexpr size_t WS_ROPE = 4 * MiB;
constexpr size_t WS_EREF = 8 * MiB, WS_ELAST = 10 * MiB;
constexpr size_t WS_EIDX = 12 * MiB;
constexpr size_t WS_EW = 12 * MiB + 512 * 1024;
constexpr size_t WS_KR = 13 * MiB;
constexpr size_t WS_XMAX = 13 * MiB;
constexpr size_t WS_LIST = 4 * MiB;
constexpr size_t WS_WIN = 17 * MiB, WS_WOAB = 27 * MiB, WS_WUQ = 29 * MiB, WS_WUKV = 29 * MiB + 512 * 1024, WS_WOUT = 30 * MiB, WS_WPG = 32 * MiB, WS_WPP = 34 * MiB;
constexpr size_t WS_ACT = 36 * MiB;
constexpr size_t WS_VA = 100 * MiB, WS_OG = 132 * MiB, WS_CQ = 164 * MiB, WS_CKVR = 180 * MiB, WS_GA = 196 * MiB, WS_GB = 260 * MiB;
constexpr size_t WS_QM = 324 * MiB, WS_KH = 372 * MiB, WS_VH = 420 * MiB, WS_PB = 452 * MiB, WS_END = 468 * MiB;
#if STAGGER_CONV
constexpr size_t WS_W13 = 100 * MiB, WS_W2T = 164 * MiB;
#else
constexpr size_t WS_W13 = 196 * MiB, WS_W2T = 260 * MiB;
#endif
constexpr size_t WS_H1 = 324 * MiB;
constexpr size_t WS_Y0 = 100 * MiB, WS_Y1 = 372 * MiB;
constexpr size_t WS_PROJ = 292 * MiB;
constexpr size_t DO_QF = 0, DO_KF = 32 * MiB, DO_QB = 64 * MiB, DO_KB = 96 * MiB, DO_OA = 0, DO_OM = 32 * MiB;
constexpr size_t DO_X2B = 64 * MiB;
constexpr size_t WS_X3B = 196 * MiB;
constexpr int CW_TMO = 0, CW_CODE = 1, CW_BAR = 4096, CW_CNT = 8192  ;
constexpr int MAXROWT = 320;
constexpr int RING_BYTES = 131072, LDSCTL_OFF = RING_BYTES, MISC_OFF = LDSCTL_OFF + 320, TAB_OFF = RING_BYTES + 1024, LDS_BYTES = 147456;
#define XB_TMO      128
#define XB_XCNT(j)  (256  + 64 * (j))
#define XB_XSUB(j)  (1280 + 64 * (j))
#define XB_XGEN(j)  (2304 + 64 * (j))
#define XB_TOP      3328
#define XB_TOPGEN   3392
#define XCD_BAR_WORDS 3456
#define XB_SPIN_CAP (1u << 18)

__device__ __forceinline__ unsigned xb_ld(unsigned* p)              { return __hip_atomic_load(p, __ATOMIC_RELAXED, __HIP_MEMORY_SCOPE_AGENT); }
__device__ __forceinline__ unsigned xb_add(unsigned* p, unsigned v) { return __hip_atomic_fetch_add(p, v, __ATOMIC_RELAXED, __HIP_MEMORY_SCOPE_AGENT); }
__device__ __forceinline__ unsigned xb_xcc_id() { return (unsigned)__builtin_amdgcn_s_getreg((3 << 11) | 20) & 0xFu; }
#define XB_SPIN(cond, bar) do { unsigned _sp = 0; while (cond) { __builtin_amdgcn_s_sleep(1); \
    if ((++_sp & 255u) == 0u) { if (xb_ld(&(bar)[XB_TMO])) break; if (_sp > XB_SPIN_CAP) { atomicAdd(&(bar)[XB_TMO], 1u); break; } } } } while (0)

struct XcdBarrier {
    unsigned* bar; unsigned x;
    volatile LAS unsigned* st;
};

__device__ __forceinline__ XcdBarrier xcd_barrier_post(unsigned* bar, volatile LAS unsigned* st) {
    XcdBarrier b; b.bar = bar; b.x = xb_xcc_id(); b.st = st;
    if (threadIdx.x == 0) (void)xb_add(&bar[XB_XCNT(b.x)], 1u);
    return b;
}
__device__ __forceinline__ void xcd_barrier_complete(unsigned* bar, unsigned x, unsigned& nloc, unsigned& nx) {
    const unsigned G = gridDim.x * gridDim.y * gridDim.z;
    unsigned sum, cnt, mine, sp = 0u;
    for (;;) {
        sum = 0u; cnt = 0u; mine = 0u;
#pragma unroll
        for (unsigned j = 0; j < 16; ++j) { const unsigned c = xb_ld(&bar[XB_XCNT(j)]); sum += c; cnt += (c > 0u) ? 1u : 0u; mine = (j == x) ? c : mine; }
        if (sum == G) break;
        __builtin_amdgcn_s_sleep(1);
        if ((++sp & 255u) == 0u) { if (xb_ld(&bar[XB_TMO])) break; if (sp > XB_SPIN_CAP) { atomicAdd(&bar[XB_TMO], 1u); break; } }
    }
    nloc = mine > 0u ? mine : 1u; nx = cnt > 0u ? cnt : 1u;
}

__device__ __forceinline__ void xcd_barrier(const XcdBarrier& b) {
    asm volatile("s_waitcnt vmcnt(0)" ::: "memory");
    __syncthreads();
    if (threadIdx.x == 0) {
        unsigned* bar = b.bar;
        __builtin_amdgcn_s_waitcnt(0);
        unsigned nloc = b.st[0], nx = b.st[1];
        if (nloc == 0u) { xcd_barrier_complete(bar, b.x, nloc, nx); b.st[0] = nloc; b.st[1] = nx; }
        const unsigned old = xb_add(&bar[XB_XSUB(b.x)], 1u);
        const unsigned gen = old / nloc;
        if (old + 1u == (gen + 1u) * nloc) {
            __builtin_amdgcn_fence(__ATOMIC_RELEASE, "agent");
            asm volatile("s_waitcnt vmcnt(0)" ::: "memory");
            const unsigned og = xb_add(&bar[XB_TOP], 1u);
            const unsigned tg = og / nx;
            if (og + 1u == (tg + 1u) * nx) xb_add(&bar[XB_TOPGEN], 1u);
            else XB_SPIN(xb_ld(&bar[XB_TOPGEN]) == tg, bar);
            __builtin_amdgcn_fence(__ATOMIC_ACQUIRE, "agent");
            xb_add(&bar[XB_XGEN(b.x)], 1u);
            asm volatile("s_waitcnt vmcnt(0)" ::: "memory");
        } else {
            XB_SPIN(xb_ld(&bar[XB_XGEN(b.x)]) == gen, bar);
            __builtin_amdgcn_fence(__ATOMIC_ACQUIRE, "agent");
            asm volatile("s_waitcnt vmcnt(0)" ::: "memory");
        }
    }
    __syncthreads();
}
struct Unit { int pm, pn, lbase, nvalid, kind; };
struct Gemm { const bf16* A; const bf16* Bt; int K; const int* list; int skew; const bf16* A2; const bf16* Bt2; int K2; };
typedef __bf16 bf16x2_t __attribute__((ext_vector_type(2)));
__device__ __forceinline__ float dot2bf(unsigned a, unsigned b, float c) { return __builtin_amdgcn_fdot2_f32_bf16(__builtin_bit_cast(bf16x2_t, a), __builtin_bit_cast(bf16x2_t, b), c, false); }

#ifndef I8_P10
#define I8_P10 0
#endif
#ifndef I8_P1
#define I8_P1 0
#endif
#ifndef I8_P7
#define I8_P7 0
#endif
#ifndef I8_QKV
#define I8_QKV 0
#endif
#ifndef MERGE_QKV
#define MERGE_QKV 0
#endif
#ifndef GATE_U8
#define GATE_U8 0
#endif
#ifndef GATE_FIRST
#define GATE_FIRST 0
#endif
#ifndef FUSE_PROJ
#define FUSE_PROJ 0
#endif
typedef int i32x4 __attribute__((ext_vector_type(4)));
template <bool I8> struct AccSel { typedef f32x4 type; };
template <> struct AccSel<true> { typedef i32x4 type; };
constexpr int NXCD = 8, WGM = 8;
struct StaticOrder {
    int nM, nN, nwg, G, c;
    __device__ void init(int M, int N, int G_, int c_) { nM = M / 256; nN = N / 256; nwg = nM * nN; G = G_; c = c_; }
    __device__ __forceinline__ bool next(int i, Unit& u) const {
        const long L = (long)i * G + c; if (L >= nwg) return false;
        int wgid = (int)L; { const int q = nwg / NXCD, r = nwg % NXCD, xcd = wgid % NXCD, off = wgid / NXCD; wgid = (xcd < r ? xcd * (q + 1) : r * (q + 1) + (xcd - r) * q) + off; }
        const int nig = WGM * nN, gid = wgid / nig, fm = gid * WGM, gsz = (nM - fm) < WGM ? (nM - fm) : WGM;
        u.pm = fm + ((wgid % nig) % gsz); u.pn = (wgid % nig) / gsz; u.lbase = 0; u.nvalid = 256; u.kind = 0; return true;
    }
};
struct PairOrder {
    StaticOrder so;
    __device__ void init(int G_, int c_) { so.init(T, D, G_, c_); }
    __device__ __forceinline__ bool next(int i, Unit& u) const { if (!so.next(i >> 1, u)) return false; if (i & 1) { u.pm += T / 256; u.pn += D / 256; } return true; }
};
struct ProjGateOrder {
    StaticOrder so;
    __device__ void init(int G_, int c_) { so.init(T, D, G_, c_); }
    __device__ __forceinline__ bool next(int i, Unit& u) const { if (!so.next(i >> 1, u)) return false; u.kind = i & 1; return true; }
};
struct QKVOrder {
    int G, c;
    __device__ void init(int G_, int c_) { G = G_; c = c_; }
    __device__ __forceinline__ bool next(int i, Unit& u) const {
        constexpr int NQ = (T / 256) * 3, NKV = (T / 256) * 4;
        const int L = i * G + c; if (L >= NQ + NKV) return false;
        StaticOrder so;
        if (L < NQ) { so.init(T, 768, 1, 0); so.next(L, u); u.kind = 0; } else { so.init(T, 1024, 1, 0); so.next(L - NQ, u); u.kind = 1; }
        return true;
    }
};
struct MoeOrder {
    const LAS int* tab; int npn, G, c;
    __device__ __forceinline__ bool next(int i, Unit& u) const {
        const int L = i * G + c; const int nt = tab[0]; if (L >= nt * npn) return false;
        const int rt = L / npn, pl = L - rt * npn; const int e = tab[16 + 4 * rt];
        u.pm = rt; u.pn = e * npn + pl; u.lbase = tab[16 + 4 * rt + 1]; u.nvalid = tab[16 + 4 * rt + 2]; u.kind = 0; return true;
    }
};

constexpr int BM = 256, BK = 64, HALF = 128, HTB = HALF * BK * 2, STAGE_BYTES = 8 * HTB;
__host__ __device__ __forceinline__ int lds_byte(int r, int c) { const int st = (r >> 4) * 2 + (c >> 5), rr = r & 15, cc = c & 31, ob = rr * 64 + cc * 2; return st * 1024 + (ob ^ (((ob >> 9) & 1) << 5)); }
__host__ __device__ __forceinline__ void stage_rc(int b, int& R, int& C) { const int st = b / 1024, sb = b % 1024, swz = sb ^ (((sb >> 9) & 1) << 5); R = (st >> 1) * 16 + swz / 64; C = (st & 1) * 32 + (swz % 64) / 2; }
#ifndef GF_SP2
#define GF_SP2 true
#endif
#ifndef GF_ALIGN
#define GF_ALIGN true
#endif
template <class Epi, class Sched, bool GATHER = false, bool ALIGN_EPI = GF_ALIGN, bool SP2 = GF_SP2, bool I8 = false, bool DUAL = false>
__device__ __forceinline__ void gemm_fast(LAS unsigned char* lds, const Gemm g, const Sched& S, const Epi& E) {
    int tid_ = threadIdx.x; asm volatile("" : "+v"(tid_));
    const int tid = tid_, wid = __builtin_amdgcn_readfirstlane(tid >> 6), lane = tid & 63, wr = wid >> 2, wc = wid & 3, fr = lane & 15, fq = lane >> 4;
    static_assert(!(DUAL && (GATHER || !SP2)), "DUAL: plain A rows, SP2 schedule only");
    const int K = g.K;
#define PG8_UK(u) ((DUAL && (u).kind) ? g.K2 : g.K)
    unsigned v0[2], v1[2], nv0[2], nv1[2], voffB[2]; int sR[2], sC[2];
#pragma unroll
    for (int i = 0; i < 2; ++i) { stage_rc(tid * 16 + i * 8192, sR[i], sC[i]); voffB[i] = (unsigned)(sR[i] * K + sC[i]) * 2u; }
#define PG8_AOFF(u, o0, o1) do { _Pragma("unroll") for (int _i = 0; _i < 2; ++_i) { \
        if constexpr (GATHER) { const int r0_ = sR[_i] < (u).nvalid ? sR[_i] : (u).nvalid - 1, r1_ = (128 + sR[_i]) < (u).nvalid ? 128 + sR[_i] : (u).nvalid - 1; \
            o0[_i] = ((unsigned)(g.list[(u).lbase + r0_] >> 1) * (unsigned)K + (unsigned)sC[_i]) * 2u; o1[_i] = ((unsigned)(g.list[(u).lbase + r1_] >> 1) * (unsigned)K + (unsigned)sC[_i]) * 2u; } \
        else { const int K_ = PG8_UK(u); o0[_i] = (unsigned)(sR[_i] * K_ + sC[_i]) * 2u; o1[_i] = o0[_i] + (unsigned)(HALF * K_ * 2); } } } while (0)
    const size_t kstep = (size_t)(BK * 2);
    size_t hstep = (size_t)HALF * K * 2;
    const size_t tstep = 2 * hstep;
    size_t nhstep = hstep; int nt = K / BK, nnt = nt;
    const unsigned ldsw = (unsigned)wid * 1024u;
    const int aoff = lds_byte(wr * 64 + fr, fq * 8), boff = lds_byte(wc * 32 + fr, fq * 8);
#define PG8_SA(b, h) (((b) * 2 + (h)) * HTB)
#define PG8_SB(b, h) ((4 + (b) * 2 + (h)) * HTB)
#define PG8_STAGE(bufoff, gbase, voff) do { _Pragma("unroll") for (int _i = 0; _i < 2; ++_i) \
        __builtin_amdgcn_global_load_lds((const unsigned*)((const char*)(gbase) + (voff)[_i]), (LAS unsigned*)(lds + (bufoff) + ldsw + _i * 8192), 16, 0, 0); } while (0)
#define PG8_LDA(dst, b, h) do { _Pragma("unroll") for (int m = 0; m < 4; ++m) _Pragma("unroll") for (int k = 0; k < 2; ++k) dst[m][k] = *(const LAS bf16x8*)(lds + PG8_SA(b, h) + aoff + m * 2048 + k * 1024); } while (0)
#define PG8_LDB(dst, b, h) do { _Pragma("unroll") for (int n = 0; n < 2; ++n) _Pragma("unroll") for (int k = 0; k < 2; ++k) dst[n][k] = *(const LAS bf16x8*)(lds + PG8_SB(b, h) + boff + n * 2048 + k * 1024); } while (0)
#define PG8_MMA(ai, bj, At, Bt) do { __builtin_amdgcn_s_setprio(1); _Pragma("unroll") for (int m = 0; m < 4; ++m) _Pragma("unroll") for (int n = 0; n < 2; ++n) _Pragma("unroll") for (int k = 0; k < 2; ++k) \
        { if constexpr (I8) acc[ai][bj][m][n] = __builtin_amdgcn_mfma_i32_16x16x64_i8(__builtin_bit_cast(i32x4, Bt[n][k]), __builtin_bit_cast(i32x4, At[m][k]), acc[ai][bj][m][n], 0, 0, 0); \
          else acc[ai][bj][m][n] = __builtin_amdgcn_mfma_f32_16x16x32_bf16(Bt[n][k], At[m][k], acc[ai][bj][m][n], 0, 0, 0); } __builtin_amdgcn_s_setprio(0); } while (0)
#define PG8_WAIT_V(n) asm volatile("s_waitcnt vmcnt(" #n ")" ::: "memory")
#define PG8_WAIT_L(n) asm volatile("s_waitcnt lgkmcnt(" #n ")" ::: "memory")
#define PG8_BAR __builtin_amdgcn_s_barrier()
#define PG8_SCHED __builtin_amdgcn_sched_barrier(0)
    Unit cur, nxt; int ui = 0;
    if (!S.next(0, cur)) return;
    if (g.skew > 0) {
        const unsigned bx = blockIdx.x, idx = ((bx >> 3) & 31u) * 8u + (bx & 7u);
        const unsigned long long t0 = __builtin_amdgcn_s_memrealtime(); const unsigned long long d = ((unsigned long long)idx * (unsigned)g.skew) >> 8;
        while (__builtin_amdgcn_s_memrealtime() - t0 < d) __builtin_amdgcn_s_sleep(8);
    }
    typedef typename AccSel<I8>::type acc_t;
    acc_t acc[2][2][4][2];
#pragma unroll
    for (int a = 0; a < 2; ++a)
#pragma unroll
        for (int b = 0; b < 2; ++b)
#pragma unroll
            for (int m = 0; m < 4; ++m)
#pragma unroll
                for (int n = 0; n < 2; ++n) acc[a][b][m][n] = (acc_t){0, 0, 0, 0};
    bf16x8 At[4][2], B0[2][2], B1[2][2];
#define PG8_ABASE(u) (DUAL ? (const char*)g.A + ((u).kind ? (size_t)((const char*)g.A2 - (const char*)g.A) : (size_t)0) + (size_t)(u).pm * (size_t)(2 * HALF * 2) * PG8_UK(u) : (const char*)g.A + (GATHER ? (size_t)0 : (size_t)(u).pm * tstep))
#define PG8_BBASE(u) (DUAL ? (const char*)g.Bt + ((u).kind ? (size_t)((const char*)g.Bt2 - (const char*)g.Bt) : (size_t)0) + (size_t)(u).pn * (size_t)(2 * HALF * 2) * PG8_UK(u) : (const char*)g.Bt + (size_t)(u).pn * tstep)
    const char* cA = PG8_ABASE(cur); const char* cB = PG8_BBASE(cur);
    unsigned v0s = 0u, nv0s = 0u;
#define PG8_BASEOFF(u, o) do { int R_, C_; stage_rc(tid * 16, R_, C_); o = (unsigned)(R_ * PG8_UK(u) + C_) * 2u; } while (0)
    if constexpr (DUAL) { const int K_ = PG8_UK(cur); hstep = (size_t)HALF * K_ * 2; nt = K_ / BK; PG8_BASEOFF(cur, v0s);
    }
    else { PG8_AOFF(cur, v0, v1); }
    if constexpr (SP2 && DUAL) {
#define PG8_STAGE1(bufoff, gbase, o0_) do { unsigned t_[2] = {(o0_), (o0_) + (unsigned)(hstep >> 1)}; PG8_STAGE(bufoff, gbase, t_); } while (0)
        PG8_STAGE1(PG8_SB(0, 0), cB, v0s); PG8_STAGE1(PG8_SB(0, 1), cB + hstep, v0s); PG8_STAGE1(PG8_SA(0, 0), cA, v0s); PG8_STAGE1(PG8_SA(0, 1), cA + hstep, v0s);
        if (wr == 1) PG8_BAR;
        PG8_WAIT_V(2); PG8_BAR;
        PG8_STAGE1(PG8_SB(1, 0), cB + kstep, v0s); PG8_STAGE1(PG8_SA(1, 0), cA + kstep, v0s); PG8_STAGE1(PG8_SB(1, 1), cB + hstep + kstep, v0s);
        PG8_WAIT_V(6); PG8_BAR;
#undef PG8_STAGE1
    } else if constexpr (SP2) {
        PG8_STAGE(PG8_SB(0, 0), cB, voffB); PG8_STAGE(PG8_SB(0, 1), cB + hstep, voffB); PG8_STAGE(PG8_SA(0, 0), cA, v0); PG8_STAGE(PG8_SA(0, 1), cA, v1);
        if (wr == 1) PG8_BAR;
        PG8_WAIT_V(2); PG8_BAR;
        PG8_STAGE(PG8_SB(1, 0), cB + kstep, voffB); PG8_STAGE(PG8_SA(1, 0), cA + kstep, v0); PG8_STAGE(PG8_SB(1, 1), cB + hstep + kstep, voffB);
        PG8_WAIT_V(6); PG8_BAR;
    } else {
        PG8_STAGE(PG8_SB(0, 0), cB, voffB); PG8_STAGE(PG8_SA(0, 0), cA, v0); PG8_STAGE(PG8_SB(0, 1), cB + hstep, voffB); PG8_STAGE(PG8_SA(0, 1), cA, v1);
        if (wr == 1) PG8_BAR;
        PG8_WAIT_V(4); PG8_BAR;
        PG8_STAGE(PG8_SB(1, 0), cB + kstep, voffB); PG8_STAGE(PG8_SA(1, 0), cA + kstep, v0); PG8_STAGE(PG8_SB(1, 1), cB + hstep + kstep, voffB);
        PG8_WAIT_V(6); PG8_BAR;
    }
    for (;;) {
        const bool has_next = S.next(ui + 1, nxt);
        const char* nA = (has_next && !GATHER) ? PG8_ABASE(nxt) : cA; const char* nB = has_next ? PG8_BBASE(nxt) : cB;
        if constexpr (DUAL) { if (has_next) { const int K_ = PG8_UK(nxt); nhstep = (size_t)HALF * K_ * 2; nnt = K_ / BK; } else { nhstep = hstep; nnt = nt; } }
        if constexpr (DUAL) { if (has_next) { PG8_BASEOFF(nxt, nv0s); } else nv0s = v0s; }
        else { if (has_next) { PG8_AOFF(nxt, nv0, nv1); } else { _Pragma("unroll") for (int _i = 0; _i < 2; ++_i) { nv0[_i] = v0[_i]; nv1[_i] = v1[_i]; } } }
#pragma unroll 1
        for (int t = 0; t < nt; t += 2) {
            const bool last = (t == nt - 2);
            const char* a1 = cA + (size_t)(t + 1) * kstep;
            const char* a2 = last ? nA : cA + (size_t)(t + 2) * kstep; const char* b2 = last ? nB : cB + (size_t)(t + 2) * kstep;
            const char* a3 = a2 + kstep; const char* b3 = b2 + kstep;
            unsigned w0[2], w1[2];
#pragma unroll
            for (int _i = 0; _i < 2; ++_i) { if constexpr (DUAL) w0[_i] = (last ? nv0s : v0s) + (_i ? (unsigned)((last ? nhstep : hstep) >> 1) : 0u); else { w0[_i] = last ? nv0[_i] : v0[_i]; w1[_i] = last ? nv1[_i] : v1[_i]; } }
            unsigned wB[2], x1[2]; size_t hB = hstep;
            if constexpr (DUAL) { if (last) hB = nhstep; }
#pragma unroll
            for (int _i = 0; _i < 2; ++_i) { if constexpr (DUAL) { wB[_i] = w0[_i]; w1[_i] = w0[_i] + (unsigned)hB; x1[_i] = v0s + (unsigned)hstep + (_i ? (unsigned)(hstep >> 1) : 0u); } else { wB[_i] = voffB[_i]; x1[_i] = v1[_i]; } }
            if constexpr (SP2) {
            PG8_LDB(B0, 0, 0); PG8_LDB(B1, 0, 1); PG8_SCHED; PG8_LDA(At, 0, 0); PG8_STAGE(PG8_SA(1, 1), a1, x1);
            PG8_WAIT_V(8); PG8_WAIT_L(0); PG8_BAR; PG8_MMA(0, 0, At, B0); PG8_MMA(0, 1, At, B1); PG8_BAR; PG8_SCHED;
            PG8_LDA(At, 0, 1); PG8_STAGE(PG8_SB(0, 0), b2, wB); PG8_STAGE(PG8_SB(0, 1), b2 + hB, wB); PG8_STAGE(PG8_SA(0, 0), a2, w0);
            PG8_WAIT_V(8); PG8_WAIT_L(0); PG8_BAR; PG8_MMA(1, 0, At, B0); PG8_MMA(1, 1, At, B1); PG8_BAR; PG8_SCHED;
            PG8_LDB(B0, 1, 0); PG8_LDB(B1, 1, 1); PG8_SCHED; PG8_LDA(At, 1, 0); PG8_STAGE(PG8_SA(0, 1), a2, w1);
            PG8_WAIT_V(8); PG8_WAIT_L(0); PG8_BAR; PG8_MMA(0, 0, At, B0); PG8_MMA(0, 1, At, B1); PG8_BAR; PG8_SCHED;
            PG8_LDA(At, 1, 1); PG8_STAGE(PG8_SB(1, 0), b3, wB); PG8_STAGE(PG8_SB(1, 1), b3 + hB, wB); PG8_STAGE(PG8_SA(1, 0), a3, w0);
            PG8_WAIT_V(8); PG8_WAIT_L(0); PG8_BAR; PG8_MMA(1, 0, At, B0); PG8_MMA(1, 1, At, B1); PG8_BAR; PG8_SCHED;
            } else {
            PG8_LDB(B0, 0, 0); PG8_SCHED; PG8_LDA(At, 0, 0); PG8_STAGE(PG8_SA(1, 1), a1, v1);
            PG8_WAIT_L(8); PG8_BAR; PG8_WAIT_L(0); PG8_MMA(0, 0, At, B0); PG8_BAR; PG8_SCHED;
            PG8_LDB(B1, 0, 1); PG8_STAGE(PG8_SB(0, 0), b2, voffB);
            PG8_BAR; PG8_WAIT_L(0); PG8_MMA(0, 1, At, B1); PG8_BAR;
            PG8_LDA(At, 0, 1); PG8_STAGE(PG8_SA(0, 0), a2, w0);
            PG8_BAR; PG8_WAIT_L(0); PG8_MMA(1, 0, At, B0); PG8_BAR; PG8_SCHED;
            PG8_STAGE(PG8_SB(0, 1), b2 + hstep, voffB);
            PG8_WAIT_V(6); PG8_BAR; PG8_MMA(1, 1, At, B1); PG8_BAR;
            PG8_LDB(B0, 1, 0); PG8_SCHED; PG8_LDA(At, 1, 0); PG8_STAGE(PG8_SA(0, 1), a2, w1);
            PG8_WAIT_L(8); PG8_BAR; PG8_WAIT_L(0); PG8_MMA(0, 0, At, B0); PG8_BAR; PG8_SCHED;
            PG8_LDB(B1, 1, 1); PG8_STAGE(PG8_SB(1, 0), b3, voffB);
            PG8_BAR; PG8_WAIT_L(0); PG8_MMA(0, 1, At, B1); PG8_BAR;
            PG8_LDA(At, 1, 1); PG8_STAGE(PG8_SA(1, 0), a3, w0);
            PG8_BAR; PG8_WAIT_L(0); PG8_MMA(1, 0, At, B0); PG8_BAR; PG8_SCHED;
            PG8_STAGE(PG8_SB(1, 1), b3 + hstep, voffB);
            PG8_WAIT_V(6); PG8_BAR; PG8_MMA(1, 1, At, B1); PG8_BAR;
            }
        }
        if constexpr (ALIGN_EPI) { if (wr == 0) PG8_BAR; }
        E(acc, cur, wr, wc, fr, fq);
        if (!has_next) break;
#pragma unroll
        for (int a = 0; a < 2; ++a)
#pragma unroll
            for (int b = 0; b < 2; ++b)
#pragma unroll
                for (int m = 0; m < 4; ++m)
#pragma unroll
                    for (int n = 0; n < 2; ++n) acc[a][b][m][n] = (acc_t){0, 0, 0, 0};
        cur = nxt; cA = nA; cB = nB; ++ui;
#pragma unroll
        for (int _i = 0; _i < 2; ++_i) { if constexpr (!DUAL) { v0[_i] = nv0[_i]; v1[_i] = nv1[_i]; } }
        if constexpr (DUAL) { hstep = nhstep; nt = nnt; v0s = nv0s; }
        if constexpr (ALIGN_EPI) { if (wr == 1) PG8_BAR; }
    }
    PG8_WAIT_V(0);
    if constexpr (!ALIGN_EPI) { if (wr == 0) PG8_BAR; }
    PG8_BAR;
#undef PG8_AOFF
#undef PG8_BASEOFF
#undef PG8_UK
#undef PG8_ABASE
#undef PG8_BBASE
#undef PG8_SA
#undef PG8_SB
#undef PG8_STAGE
#undef PG8_LDA
#undef PG8_LDB
#undef PG8_MMA
#undef PG8_WAIT_V
#undef PG8_WAIT_L
#undef PG8_BAR
#undef PG8_SCHED
}
#ifdef NT_STORES
#define ST_V(ptr, val) __builtin_nontemporal_store((val), (ptr))
#else
#define ST_V(ptr, val) (*(ptr) = (val))
#endif
__device__ __forceinline__ void st8(bf16* p, f32x4 a, f32x4 b) { v4u w; w.x = pk2(a[0], a[1]); w.y = pk2(a[2], a[3]); w.z = pk2(b[0], b[1]); w.w = pk2(b[2], b[3]); ST_V((v4u*)p, w); }
__device__ __forceinline__ void st4(bf16* p, f32x4 a) { v2u w; w.x = pk2(a[0], a[1]); w.y = pk2(a[2], a[3]); ST_V((v2u*)p, w); }
__device__ __forceinline__ unsigned q8pack(float a, float b, float c, float d) {
    const int ia = (int)__builtin_rintf(a), ib = (int)__builtin_rintf(b), ic = (int)__builtin_rintf(c), id = (int)__builtin_rintf(d);
    return (unsigned)(ia & 255) | ((unsigned)(ib & 255) << 8) | ((unsigned)(ic & 255) << 16) | ((unsigned)id << 24);
}
__device__ __forceinline__ f32x4 ub4(unsigned w) { return (f32x4){(float)(w & 255u), (float)((w >> 8) & 255u), (float)((w >> 16) & 255u), (float)(w >> 24)} * (1.0f / 255.0f); }
__device__ __forceinline__ f32x4 up4(unsigned lo, unsigned hi) { return (f32x4){bflo(lo), bfhi(lo), bflo(hi), bfhi(hi)}; }
__device__ __forceinline__ float dot4(f32x4 a) { return (a[0] * a[0] + a[1] * a[1]) + (a[2] * a[2] + a[3] * a[3]); }
template <int CTRL> __device__ __forceinline__ float dppf(float v) { return __builtin_bit_cast(float, __builtin_amdgcn_update_dpp(0, __builtin_bit_cast(int, v), CTRL, 0xf, 0xf, true)); }
__device__ __forceinline__ float scan16(float v, int) { v += dppf<0x111>(v); v += dppf<0x112>(v); v += dppf<0x114>(v); v += dppf<0x118>(v); return v; }
__device__ __forceinline__ float bcast15(float v) { return dppf<0x15F>(v); }
__device__ __forceinline__ float bcast0(float v) { return dppf<0x150>(v); }

struct EpiIn {
    unsigned char *wsb, *dob; LAS float* xch;
#define EI_W(type, off) ((type*)(wsb + (off)))
#define EI_D(type, off) ((type*)(dob + (off)))
    __device__ __forceinline__ void hgrn(const f32x4 (&acc)[2][2][4][2], const Unit& u, int wr, int wc, int fr, int fq) const {
        const int hh = u.pn >> 1, cb = u.pn & 1;
        const int gch0 = hh * 128 + cb * 64 + wc * 16 + fq * 4;
        bf16* const QF = EI_D(bf16, DO_QF); bf16* const KF = EI_D(bf16, DO_KF); bf16* const QB = EI_D(bf16, DO_QB); bf16* const KB = EI_D(bf16, DO_KB); bf16* const VA = EI_W(bf16, WS_VA);
        float* const EREF = EI_W(float, WS_EREF); float* const ELAST = EI_W(float, WS_ELAST); const float* const LB = EI_W(float, WS_LB);
        const f32x4 lbf = *(const f32x4*)(LB + gch0), lbb = *(const f32x4*)(LB + 512 + gch0);
#pragma unroll
        for (int ai = 0; ai < 2; ++ai) {
            const int cidx = u.pm * 4 + ai * 2 + wr;
            const size_t off0 = (size_t)(u.pm * 256 + ai * 128 + wr * 64 + fr) * 512 + gch0;
#pragma unroll
            for (int m = 0; m < 4; ++m) st4(VA + off0 + (size_t)m * 16 * 512, acc[ai][1][m][1]);
            {
                f32x4 qo[4], ko[4];
#pragma unroll
                for (int j = 0; j < 4; ++j) {
                    float lf[4], kk[4];
#pragma unroll
                    for (int m = 0; m < 4; ++m) { const float z = fminf(fmaxf(acc[ai][0][m][1][j], -30.f), 30.f), e = __expf(-z), s = __builtin_amdgcn_rcpf(1.0f + e); kk[m] = (1.0f - lbf[j]) * e * s; lf[m] = __logf(lbf[j] + (1.0f - lbf[j]) * s); }
                    float G[4], carry = 0.f;
#pragma unroll
                    for (int m = 0; m < 4; ++m) { G[m] = scan16(lf[m], fr) + carry; carry = bcast15(G[m]); }
                    const float Gref = bcast15(G[1]);
#pragma unroll
                    for (int m = 0; m < 4; ++m) { qo[m][j] = silu_(acc[ai][0][m][0][j]) * __expf(fminf(G[m] - Gref, 80.f)); ko[m][j] = kk[m] * __expf(fminf(Gref - G[m], 80.f)); }
                    if (fr == 0) { EREF[(size_t)cidx * 512 + gch0 + j] = __expf(Gref); ELAST[(size_t)cidx * 512 + gch0 + j] = __expf(carry - Gref); }
                }
#pragma unroll
                for (int m = 0; m < 4; ++m) { st4(QF + off0 + (size_t)m * 16 * 512, qo[m]); st4(KF + off0 + (size_t)m * 16 * 512, ko[m]); }
                asm volatile("" ::: "memory");
            }
            {
                f32x4 qo[4], ko[4];
#pragma unroll
                for (int j = 0; j < 4; ++j) {
                    float lw[4], kk[4];
#pragma unroll
                    for (int m = 0; m < 4; ++m) { const float z = fminf(fmaxf(acc[ai][1][m][0][j], -30.f), 30.f), e = __expf(-z), s = __builtin_amdgcn_rcpf(1.0f + e); kk[m] = (1.0f - lbb[j]) * e * s; lw[m] = __logf(lbb[j] + (1.0f - lbb[j]) * s); }
                    float P[4], carry = 0.f;
#pragma unroll
                    for (int m = 0; m < 4; ++m) { P[m] = scan16(lw[m], fr) + carry; carry = bcast15(P[m]); }
                    float Gb[4];
#pragma unroll
                    for (int m = 0; m < 4; ++m) Gb[m] = carry - (P[m] - lw[m]);
                    const float Gbref = bcast0(Gb[2]);
#pragma unroll
                    for (int m = 0; m < 4; ++m) { qo[m][j] = silu_(acc[ai][0][m][0][j]) * __expf(fminf(Gb[m] - Gbref, 80.f)); ko[m][j] = kk[m] * __expf(fminf(Gbref - Gb[m], 80.f)); }
                    if (fr == 0) { EREF[(size_t)(NCHUNK + cidx) * 512 + gch0 + j] = __expf(Gbref); ELAST[(size_t)(NCHUNK + cidx) * 512 + gch0 + j] = __expf(carry - Gbref); }
                }
#pragma unroll
                for (int m = 0; m < 4; ++m) { st4(QB + off0 + (size_t)m * 16 * 512, qo[m]); st4(KB + off0 + (size_t)m * 16 * 512, ko[m]); }
                asm volatile("" ::: "memory");
            }
        }
    }
    __device__ __forceinline__ void operator()(const f32x4 (&acc)[2][2][4][2], const Unit& u, int wr, int wc, int fr, int fq) const {
        const int pn = u.pn, row0 = u.pm * 256 + wr * 64 + fr;
        if (pn < 8) { hgrn(acc, u, wr, wc, fr, fq); return; }
        bf16* const OG = EI_W(bf16, WS_OG); bf16* const CQ = EI_W(bf16, WS_CQ); bf16* const CKVR = EI_W(bf16, WS_CKVR); bf16* const GA = EI_W(bf16, WS_GA); bf16* const GB = EI_W(bf16, WS_GB);
        float* const CQSS = EI_W(float, WS_CQSS); float* const CKVSS = EI_W(float, WS_CKVSS); float* const KR = EI_W(float, WS_KR);
#if I8_QKV
        if (pn == 10 || pn == 11) {
            const bool isq = pn == 10; float ssv[2][4];
#pragma unroll
            for (int ai = 0; ai < 2; ++ai)
#pragma unroll
                for (int m = 0; m < 4; ++m) { const int row = row0 + ai * 128 + m * 16; float ss = 0.f, mx = 0.f;
#pragma unroll
                    for (int bj = 0; bj < 2; ++bj) { if (bj == 0 || isq) { const f32x4 a = acc[ai][bj][m][0], b = acc[ai][bj][m][1]; ss += dot4(a) + dot4(b);
#pragma unroll
                        for (int j = 0; j < 4; ++j) mx = fmaxf(mx, fmaxf(fabsf(a[j]), fabsf(b[j]))); } }
                    ss += __shfl_xor(ss, 16); ss += __shfl_xor(ss, 32); mx = fmaxf(mx, __shfl_xor(mx, 16)); mx = fmaxf(mx, __shfl_xor(mx, 32));
                    if (fq == 0) { (isq ? CQSS : CKVSS)[(size_t)row * 4 + wc] = ss; xch[(wr * 4 + wc) * 128 + ai * 64 + m * 16 + fr] = mx; }
                    if (!isq && wc == 0) { *(f32x4*)(KR + (size_t)row * 32 + 8 * fq) = acc[ai][1][m][0]; *(f32x4*)(KR + (size_t)row * 32 + 8 * fq + 4) = acc[ai][1][m][1]; } }
            asm volatile("s_waitcnt lgkmcnt(0)\n\ts_barrier" ::: "memory");
            unsigned char* const dst8 = wsb + (isq ? WS_CQ : WS_CKVR); float* const SAr = (float*)(wsb + (isq ? WS_SAQ : WS_SAKV));
#pragma unroll
            for (int ai = 0; ai < 2; ++ai)
#pragma unroll
                for (int m = 0; m < 4; ++m) { const int row = row0 + ai * 128 + m * 16; const int xi = ai * 64 + m * 16 + fr;
                    const float rm = fmaxf(fmaxf(xch[(wr * 4 + 0) * 128 + xi], xch[(wr * 4 + 1) * 128 + xi]), fmaxf(xch[(wr * 4 + 2) * 128 + xi], xch[(wr * 4 + 3) * 128 + xi]));
                    const float inv = rm > 0.f ? 127.0f / rm : 0.f; if (wc == 0 && fq == 0) SAr[row] = rm * (1.0f / 127.0f);
#pragma unroll
                    for (int bj = 0; bj < 2; ++bj) { if (bj == 0 || isq) { const f32x4 a = acc[ai][bj][m][0] * inv, b = acc[ai][bj][m][1] * inv; v2u o; o.x = q8pack(a[0], a[1], a[2], a[3]); o.y = q8pack(b[0], b[1], b[2], b[3]);
                        *(v2u*)(dst8 + (size_t)row * 256 + bj * 128 + wc * 32 + 8 * fq) = o; } } }
            return;
        }
#else
        if (pn == 10) {
#pragma unroll
            for (int ai = 0; ai < 2; ++ai)
#pragma unroll
                for (int m = 0; m < 4; ++m) { const int row = row0 + ai * 128 + m * 16; float ss = 0.f;
#pragma unroll
                    for (int bj = 0; bj < 2; ++bj) { const f32x4 a = acc[ai][bj][m][0], b = acc[ai][bj][m][1]; ss += dot4(a) + dot4(b); st8(CQ + (size_t)row * 256 + bj * 128 + wc * 32 + 8 * fq, a, b); }
                    ss += __shfl_xor(ss, 16); ss += __shfl_xor(ss, 32); if (fq == 0) CQSS[(size_t)row * 4 + wc] = ss; }
            return;
        }
        if (pn == 11) {
#pragma unroll
            for (int ai = 0; ai < 2; ++ai)
#pragma unroll
                for (int m = 0; m < 4; ++m) { const int row = row0 + ai * 128 + m * 16;
                    const f32x4 a0 = acc[ai][0][m][0], b0 = acc[ai][0][m][1], a1 = acc[ai][1][m][0], b1 = acc[ai][1][m][1];
                    float ss = dot4(a0) + dot4(b0); ss += __shfl_xor(ss, 16); ss += __shfl_xor(ss, 32); if (fq == 0) CKVSS[(size_t)row * 4 + wc] = ss;
                    st8(CKVR + (size_t)row * 256 + wc * 32 + 8 * fq, a0, b0); st8(CKVR + (size_t)row * 256 + 128 + wc * 32 + 8 * fq, a1, b1);
                    if (wc == 0) { *(f32x4*)(KR + (size_t)row * 32 + 8 * fq) = a1; *(f32x4*)(KR + (size_t)row * 32 + 8 * fq + 4) = b1; } }
            return;
        }
#endif
        const bool sil = pn < 10; const int ld = sil ? 512 : 1024, cb = (sil ? pn - 8 : (pn - 12) & 3) * 256;
        const size_t dsto = sil ? (size_t)0 : (pn < 16 ? (size_t)((unsigned char*)GA - (unsigned char*)OG) : (size_t)((unsigned char*)GB - (unsigned char*)OG));
        bf16* dst = (bf16*)((unsigned char*)OG + dsto);
#pragma unroll
        for (int ai = 0; ai < 2; ++ai)
#pragma unroll
            for (int m = 0; m < 4; ++m)
#pragma unroll
                for (int bj = 0; bj < 2; ++bj) { f32x4 a = acc[ai][bj][m][0], b = acc[ai][bj][m][1];
#pragma unroll
                    for (int j = 0; j < 4; ++j) { a[j] = sil ? silu_(a[j]) : sigm(a[j]); b[j] = sil ? silu_(b[j]) : sigm(b[j]); }
#if GATE_U8
                    if (!sil) { v2u o; o.x = q8pack(a[0] * 255.f, a[1] * 255.f, a[2] * 255.f, a[3] * 255.f); o.y = q8pack(b[0] * 255.f, b[1] * 255.f, b[2] * 255.f, b[3] * 255.f);
                        *(v2u*)((unsigned char*)dst + (size_t)(row0 + ai * 128 + m * 16) * 1024 + cb + bj * 128 + wc * 32 + 8 * fq) = o; }
                    else
#endif
                    st8(dst + (size_t)(row0 + ai * 128 + m * 16) * ld + cb + bj * 128 + wc * 32 + 8 * fq, a, b); }
    }
};

struct EpiQ {
    bf16* QM; const float* CQSS;
    __device__ __forceinline__ void operator()(const f32x4 (&acc)[2][2][4][2], const Unit& u, int wr, int wc, int fr, int fq) const {
        float rsv[2][4];
#pragma unroll
        for (int ai = 0; ai < 2; ++ai)
#pragma unroll
            for (int m = 0; m < 4; ++m) { const f32x4 s4 = *(const f32x4*)(CQSS + (size_t)(u.pm * 256 + ai * 128 + wr * 64 + m * 16 + fr) * 4); rsv[ai][m] = rsqrtf(((s4[0] + s4[1]) + (s4[2] + s4[3])) * (1.0f / 256.0f) + EPS); }
#pragma unroll
        for (int ai = 0; ai < 2; ++ai)
#pragma unroll
            for (int m = 0; m < 4; ++m) { const int row = u.pm * 256 + ai * 128 + wr * 64 + m * 16 + fr; const float rs = rsv[ai][m];
#pragma unroll
                for (int bj = 0; bj < 2; ++bj) st8(QM + (size_t)row * 768 + u.pn * 256 + bj * 128 + wc * 32 + 8 * fq, acc[ai][bj][m][0] * rs, acc[ai][bj][m][1] * rs); }
    }
};
struct EpiKV {
    bf16 *KH, *VH; const float *CKVSS, *KR, *ROPE_, *KN;
    __device__ __forceinline__ void operator()(const f32x4 (&acc)[2][2][4][2], const Unit& u, int wr, int wc, int fr, int fq) const {
        const int pn = u.pn, head = (pn & 1) * 4 + wc;
        float rsv[2][4];
#pragma unroll
        for (int ai = 0; ai < 2; ++ai)
#pragma unroll
            for (int m = 0; m < 4; ++m) { const f32x4 s4 = *(const f32x4*)(CKVSS + (size_t)(u.pm * 256 + ai * 128 + wr * 64 + m * 16 + fr) * 4); rsv[ai][m] = rsqrtf(((s4[0] + s4[1]) + (s4[2] + s4[3])) * (1.0f / 128.0f) + EPS); }
        if (pn >= 2) {
#pragma unroll
            for (int ai = 0; ai < 2; ++ai)
#pragma unroll
                for (int m = 0; m < 4; ++m) { const int row = u.pm * 256 + ai * 128 + wr * 64 + m * 16 + fr; const float rs = rsv[ai][m];
#pragma unroll
                    for (int bj = 0; bj < 2; ++bj) st8(VH + ((size_t)row * 8 + head) * 64 + bj * 32 + 8 * fq, acc[ai][bj][m][0] * rs, acc[ai][bj][m][1] * rs); }
            return;
        }
#pragma unroll
        for (int ai = 0; ai < 2; ++ai)
#pragma unroll
            for (int m = 0; m < 4; ++m) { const int row = u.pm * 256 + ai * 128 + wr * 64 + m * 16 + fr; const float rs = rsv[ai][m]; const size_t ro = (size_t)row * 32;
                const f32x4 x1 = *(const f32x4*)(KR + ro + 4 * fq), x2 = *(const f32x4*)(KR + ro + 16 + 4 * fq), cc = *(const f32x4*)(ROPE_ + ro + 4 * fq), sn = *(const f32x4*)(ROPE_ + ro + 16 + 4 * fq);
                float ss = 0.f;
#pragma unroll
                for (int bj = 0; bj < 2; ++bj)
#pragma unroll
                    for (int n = 0; n < 2; ++n) ss += dot4(acc[ai][bj][m][n]);
                ss = ss * rs * rs + dot4(x1) + dot4(x2);
                ss += __shfl_xor(ss, 16); ss += __shfl_xor(ss, 32);
                const float rk = rsqrtf(ss * (1.0f / 96.0f) + EPS), rr = rs * rk;
                bf16* kp = KH + ((size_t)row * 8 + head) * 96;
#pragma unroll
                for (int bj = 0; bj < 2; ++bj) st8(kp + bj * 32 + 8 * fq, acc[ai][bj][m][0] * rr * *(const f32x4*)(KN + bj * 32 + 8 * fq), acc[ai][bj][m][1] * rr * *(const f32x4*)(KN + bj * 32 + 8 * fq + 4));
                const f32x4 y1 = x1 * rk * *(const f32x4*)(KN + 64 + 4 * fq), y2 = x2 * rk * *(const f32x4*)(KN + 80 + 4 * fq);
                st4(kp + 64 + 4 * fq, y1 * cc - y2 * sn); st4(kp + 80 + 4 * fq, y2 * cc + y1 * sn);
                if (m & 1) asm volatile("" ::: "memory"); }
    }
};
struct EpiQKV {
    EpiQ q; EpiKV kv;
    __device__ __forceinline__ void operator()(const f32x4 (&acc)[2][2][4][2], const Unit& u, int wr, int wc, int fr, int fq) const { if (u.kind) kv(acc, u, wr, wc, fr, fq); else q(acc, u, wr, wc, fr, fq); }
};
struct EpiQKV8 {
    unsigned char* wsb; const float* KN;
    __device__ __forceinline__ void operator()(const i32x4 (&acc)[2][2][4][2], const Unit& u, int wr, int wc, int fr_in, int fq_in) const {
        int fr = fr_in, fq = fq_in; asm volatile("" : "+v"(fr), "+v"(fq));
        unsigned char* W = wsb; asm volatile("" : "+s"(W));
        const float* SA = (const float*)(W + (u.kind ? WS_SAKV : WS_SAQ)); const float* SB = (const float*)(W + (u.kind ? WS_SBUKV : WS_SBUQ));
        int lo_ = wc * 32 + 4 * fq, ro_ = wr * 64 + fr; asm volatile("" : "+v"(lo_), "+v"(ro_));
        const int lo = lo_, ro = ro_;
        f32x4 f[2][2][4][2]; f32x4 sb[2][2];
#pragma unroll
        for (int bj = 0; bj < 2; ++bj)
#pragma unroll
            for (int n = 0; n < 2; ++n) sb[bj][n] = *(const f32x4*)(SB + u.pn * 256 + bj * 128 + n * 16 + lo);
#pragma unroll
        for (int ai = 0; ai < 2; ++ai) { float sa[4];
#pragma unroll
            for (int m = 0; m < 4; ++m) sa[m] = SA[u.pm * 256 + ai * 128 + m * 16 + ro];
#pragma unroll
            for (int bj = 0; bj < 2; ++bj)
#pragma unroll
                for (int m = 0; m < 4; ++m)
#pragma unroll
                    for (int n = 0; n < 2; ++n) f[ai][bj][m][n] = __builtin_convertvector(acc[ai][bj][m][n], f32x4) * sb[bj][n] * sa[m]; }
        if (u.kind) { const EpiKV kv{(bf16*)(W + WS_KH), (bf16*)(W + WS_VH), (const float*)(W + WS_CKVSS), (const float*)(W + WS_KR), (const float*)(W + WS_ROPE), KN}; kv(f, u, wr, wc, fr, fq); }
        else { const EpiQ q{(bf16*)(W + WS_QM), (const float*)(W + WS_CQSS)}; q(f, u, wr, wc, fr, fq); }
    }
};
struct EpiMerge {
    bf16* MG; const bf16 *GA, *GB;
    __device__ __forceinline__ void operator()(const f32x4 (&acc)[2][2][4][2], const Unit& u, int wr, int wc, int fr, int fq) const {
        const bool which = u.pm >= T / 256; const int pm = u.pm - (which ? T / 256 : 0), pn = u.pn - (which ? D / 256 : 0);
        const bf16* Gt = (const bf16*)((const unsigned char*)GA + (which ? (size_t)((const unsigned char*)GB - (const unsigned char*)GA) : (size_t)0));
#pragma unroll
        for (int ai = 0; ai < 2; ++ai)
#pragma unroll
            for (int mp = 0; mp < 2; ++mp) {
                v4u gv[2][2], ov[2][2];
#pragma unroll
                for (int mm = 0; mm < 2; ++mm)
#pragma unroll
                    for (int bj = 0; bj < 2; ++bj) { const size_t off = (size_t)(pm * 256 + ai * 128 + wr * 64 + (2 * mp + mm) * 16 + fr) * 1024 + pn * 256 + bj * 128 + wc * 32 + 8 * fq;
#if GATE_U8
                        { const v2u g8 = *(const v2u*)((const unsigned char*)Gt + off); gv[mm][bj] = (v4u){g8.x, g8.y, 0u, 0u}; }
#else
                        gv[mm][bj] = *(const v4u*)(Gt + off);
#endif
                        ov[mm][bj] = which ? *(const v4u*)(MG + off) : (v4u){0u, 0u, 0u, 0u}; }
#pragma unroll
                for (int mm = 0; mm < 2; ++mm)
#pragma unroll
                    for (int bj = 0; bj < 2; ++bj) { const int m = 2 * mp + mm; const size_t off = (size_t)(pm * 256 + ai * 128 + wr * 64 + m * 16 + fr) * 1024 + pn * 256 + bj * 128 + wc * 32 + 8 * fq;
                        const v4u g = gv[mm][bj], o = ov[mm][bj];
#if GATE_U8
                        const f32x4 a = acc[ai][bj][m][0] * ub4(g.x) + up4(o.x, o.y), b = acc[ai][bj][m][1] * ub4(g.y) + up4(o.z, o.w);
#else
                        const f32x4 a = acc[ai][bj][m][0] * up4(g.x, g.y) + up4(o.x, o.y), b = acc[ai][bj][m][1] * up4(g.z, g.w) + up4(o.z, o.w);
#endif
                        st8(MG + off, a, b); }
                asm volatile("" ::: "memory"); }
    }
};
struct EpiX2 {
    const float* X; bf16* O; float* XM;
    __device__ __forceinline__ void operator()(const f32x4 (&acc)[2][2][4][2], const Unit& u, int wr, int wc, int fr, int fq) const {
#pragma unroll
        for (int ai = 0; ai < 2; ++ai)
#pragma unroll
            for (int mp = 0; mp < 2; ++mp) {
                f32x4 xv[2][2][2];
#pragma unroll
                for (int mm = 0; mm < 2; ++mm)
#pragma unroll
                    for (int bj = 0; bj < 2; ++bj) { const float* xp = X + (size_t)(u.pm * 256 + ai * 128 + wr * 64 + (2 * mp + mm) * 16 + fr) * 1024 + u.pn * 256 + bj * 128 + wc * 32 + 8 * fq;
                        xv[mm][bj][0] = *(const f32x4*)xp; xv[mm][bj][1] = *(const f32x4*)(xp + 4); }
#pragma unroll
                for (int mm = 0; mm < 2; ++mm)
#pragma unroll
                    for (int bj = 0; bj < 2; ++bj) { xv[mm][bj][0] += acc[ai][bj][2 * mp + mm][0]; xv[mm][bj][1] += acc[ai][bj][2 * mp + mm][1];
                        st8(O + (size_t)(u.pm * 256 + ai * 128 + wr * 64 + (2 * mp + mm) * 16 + fr) * 1024 + u.pn * 256 + bj * 128 + wc * 32 + 8 * fq, xv[mm][bj][0], xv[mm][bj][1]); }
#pragma unroll
                for (int mm = 0; mm < 2; ++mm) { float mx = 0.f;
#pragma unroll
                    for (int bj = 0; bj < 2; ++bj)
#pragma unroll
                        for (int n = 0; n < 2; ++n)
#pragma unroll
                            for (int j = 0; j < 4; ++j) mx = fmaxf(mx, fabsf(xv[mm][bj][n][j]));
                    mx = fmaxf(mx, __shfl_xor(mx, 16)); mx = fmaxf(mx, __shfl_xor(mx, 32));
                    if (fq == 0) XM[(size_t)(u.pm * 256 + ai * 128 + wr * 64 + (2 * mp + mm) * 16 + fr) * 16 + u.pn * 4 + wc] = mx; }
                asm volatile("" ::: "memory"); }
    }
};
struct EpiUp {
    bf16* H1; const int* LIST; const float* RS2;
    __device__ __forceinline__ void operator()(const f32x4 (&acc)[2][2][4][2], const Unit& u, int wr, int wc, int fr, int fq) const {
        const int pl = u.pn & 1; int tk[2][4]; float rsv[2][4];
#pragma unroll
        for (int ai = 0; ai < 2; ++ai)
#pragma unroll
            for (int m = 0; m < 4; ++m) { const int r = ai * 128 + wr * 64 + m * 16 + fr; tk[ai][m] = LIST[u.lbase + (r < u.nvalid ? r : u.nvalid - 1)] >> 1; }
#pragma unroll
        for (int ai = 0; ai < 2; ++ai)
#pragma unroll
            for (int m = 0; m < 4; ++m) rsv[ai][m] = RS2[tk[ai][m]];
#pragma unroll
        for (int ai = 0; ai < 2; ++ai)
#pragma unroll
            for (int m = 0; m < 4; ++m) { const int r = ai * 128 + wr * 64 + m * 16 + fr; const float rs = rsv[ai][m];
                f32x4 a = acc[ai][0][m][0] * rs, b = acc[ai][0][m][1] * rs;
#pragma unroll
                for (int j = 0; j < 4; ++j) { a[j] = silu_(a[j]) * (acc[ai][1][m][0][j] * rs); b[j] = silu_(b[j]) * (acc[ai][1][m][1][j] * rs); }
                st8(H1 + (size_t)(u.pm * 256 + r) * 256 + pl * 128 + wc * 32 + 8 * fq, a, b); }
    }
};
struct EpiDown {
    bf16 *Y0, *Y1; const int* LIST; const float* EW;
    __device__ __forceinline__ void operator()(const f32x4 (&acc)[2][2][4][2], const Unit& u, int wr, int wc, int fr, int fq) const {
        const int pl = u.pn & 3; int en[2][4]; float wv[2][4];
#pragma unroll
        for (int ai = 0; ai < 2; ++ai)
#pragma unroll
            for (int m = 0; m < 4; ++m) { const int r = ai * 128 + wr * 64 + m * 16 + fr; en[ai][m] = r < u.nvalid ? LIST[u.lbase + r] : -1; }
#pragma unroll
        for (int ai = 0; ai < 2; ++ai)
#pragma unroll
            for (int m = 0; m < 4; ++m) wv[ai][m] = en[ai][m] >= 0 ? EW[en[ai][m]] : 0.f;
#pragma unroll
        for (int ai = 0; ai < 2; ++ai)
#pragma unroll
            for (int m = 0; m < 4; ++m) { const int ent = en[ai][m]; const float w = wv[ai][m];
                if (ent >= 0) {
                    const unsigned eo = (unsigned)(ent >> 1) * 1024u + (unsigned)(pl * 256 + wc * 32 + 8 * fq) + ((ent & 1) ? (unsigned)(((unsigned char*)Y1 - (unsigned char*)Y0) / 2) : 0u);
#pragma unroll
                    for (int bj = 0; bj < 2; ++bj) st8(Y0 + eo + bj * 128, acc[ai][bj][m][0] * w, acc[ai][bj][m][1] * w); } }
    }
};
struct EpiProj {
    bf16* PR;
    __device__ __forceinline__ void operator()(const f32x4 (&acc)[2][2][4][2], const Unit& u, int wr, int wc, int fr, int fq) const {
#pragma unroll
        for (int ai = 0; ai < 2; ++ai)
#pragma unroll
            for (int m = 0; m < 4; ++m)
#pragma unroll
                for (int bj = 0; bj < 2; ++bj) st8(PR + (size_t)(u.pm * 256 + ai * 128 + wr * 64 + m * 16 + fr) * 1024 + u.pn * 256 + bj * 128 + wc * 32 + 8 * fq, acc[ai][bj][m][0], acc[ai][bj][m][1]);
    }
};
template <class Epi, bool ROWS = true> struct EpiScaled {
    Epi inner; const float* SA; const float* SB;
    __device__ __forceinline__ void operator()(const i32x4 (&acc)[2][2][4][2], const Unit& u, int wr, int wc, int fr, int fq) const {
        f32x4 f[2][2][4][2]; f32x4 sb[2][2];
#pragma unroll
        for (int bj = 0; bj < 2; ++bj)
#pragma unroll
            for (int n = 0; n < 2; ++n) sb[bj][n] = *(const f32x4*)(SB + u.pn * 256 + bj * 128 + wc * 32 + n * 16 + 4 * fq);
#pragma unroll
        for (int ai = 0; ai < 2; ++ai) { float sa[4];
#pragma unroll
            for (int m = 0; m < 4; ++m) sa[m] = ROWS ? SA[u.pm * 256 + ai * 128 + wr * 64 + m * 16 + fr] : 1.0f;
#pragma unroll
            for (int bj = 0; bj < 2; ++bj)
#pragma unroll
                for (int m = 0; m < 4; ++m)
#pragma unroll
                    for (int n = 0; n < 2; ++n) { f[ai][bj][m][n] = __builtin_convertvector(acc[ai][bj][m][n], f32x4) * sb[bj][n]; if constexpr (ROWS) f[ai][bj][m][n] *= sa[m]; } }
        inner(f, u, wr, wc, fr, fq);
    }
};
struct EpiGateProj {
    float* O; const bf16* X3; unsigned char* SCR; const float* SA3; const float* SBG; const float* SAP; const float* SBP;
    __device__ __forceinline__ void operator()(const i32x4 (&acc)[2][2][4][2], const Unit& u, int wr, int wc, int fr, int fq) const {
        int tid_ = (wr * 4 + wc) * 64 + fq * 16 + fr, lo_ = wc * 32 + 4 * fq, lc_ = wc * 32 + 8 * fq; asm volatile("" : "+v"(tid_), "+v"(lo_), "+v"(lc_));
        const int tid = tid_, lo = lo_, lc = lc_;
        f32x4 sb[2][2];
        { const float* SB = (const float*)((const unsigned char*)SBG + (u.kind ? (size_t)((const unsigned char*)SBP - (const unsigned char*)SBG) : (size_t)0));
#pragma unroll
        for (int bj = 0; bj < 2; ++bj)
#pragma unroll
            for (int n = 0; n < 2; ++n) sb[bj][n] = *(const f32x4*)(SB + u.pn * 256 + bj * 128 + n * 16 + lo); }
        if (u.kind == 0) {
#pragma unroll
            for (int ai = 0; ai < 2; ++ai) { float sa[4];
#pragma unroll
                for (int m = 0; m < 4; ++m) sa[m] = SA3[u.pm * 256 + ai * 128 + wr * 64 + m * 16 + fr];
#pragma unroll
                for (int bj = 0; bj < 2; ++bj)
#pragma unroll
                    for (int m = 0; m < 4; ++m) { f32x4 a = __builtin_convertvector(acc[ai][bj][m][0], f32x4) * sb[bj][0] * sa[m], b = __builtin_convertvector(acc[ai][bj][m][1], f32x4) * sb[bj][1] * sa[m];
#pragma unroll
                        for (int j = 0; j < 4; ++j) { a[j] = sigm(a[j]) * 255.f; b[j] = sigm(b[j]) * 255.f; }
                        v2u w; w.x = q8pack(a[0], a[1], a[2], a[3]); w.y = q8pack(b[0], b[1], b[2], b[3]);
                        *(v2u*)(SCR + (size_t)(((ai * 2 + bj) * 4 + m) * 512 + tid) * 8) = w; } }
        } else {
#pragma unroll
            for (int ai = 0; ai < 2; ++ai) {
                v4u xv[4][2]; v2u gv[4][2]; float sa[4];
#pragma unroll
                for (int m = 0; m < 4; ++m) { sa[m] = SAP[u.pm * 256 + ai * 128 + wr * 64 + m * 16 + fr];
#pragma unroll
                    for (int bj = 0; bj < 2; ++bj) { gv[m][bj] = *(const v2u*)(SCR + (size_t)(((ai * 2 + bj) * 4 + m) * 512 + tid) * 8);
                        xv[m][bj] = *(const v4u*)(X3 + (size_t)(u.pm * 256 + ai * 128 + wr * 64 + m * 16 + fr) * 1024 + u.pn * 256 + bj * 128 + lc); } }
#pragma unroll
                for (int m = 0; m < 4; ++m)
#pragma unroll
                    for (int bj = 0; bj < 2; ++bj) { float* op = O + (size_t)(u.pm * 256 + ai * 128 + wr * 64 + m * 16 + fr) * 1024 + u.pn * 256 + bj * 128 + lc;
                        const f32x4 p0 = __builtin_convertvector(acc[ai][bj][m][0], f32x4) * sb[bj][0] * sa[m], p1 = __builtin_convertvector(acc[ai][bj][m][1], f32x4) * sb[bj][1] * sa[m];
                        *(f32x4*)op = up4(xv[m][bj].x, xv[m][bj].y) + p0 * ub4(gv[m][bj].x); *(f32x4*)(op + 4) = up4(xv[m][bj].z, xv[m][bj].w) + p1 * ub4(gv[m][bj].y); }
                asm volatile("" ::: "memory"); }
        }
    }
};
struct EpiProjGate {
    float* O; const bf16* X3; unsigned char* SCR; const float* SA3; const float* SBG; const float* SAP; const float* SBP;
    __device__ __forceinline__ void operator()(const i32x4 (&acc)[2][2][4][2], const Unit& u, int wr, int wc, int fr, int fq) const {
        int tid_ = (wr * 4 + wc) * 64 + fq * 16 + fr, lo_ = wc * 32 + 4 * fq; asm volatile("" : "+v"(tid_), "+v"(lo_));
        const int tid = tid_, lo = lo_;
        f32x4 sb[2][2];
        { const float* SB = (const float*)((const unsigned char*)SBP + (u.kind ? (size_t)((const unsigned char*)SBG - (const unsigned char*)SBP) : (size_t)0));
#pragma unroll
        for (int bj = 0; bj < 2; ++bj)
#pragma unroll
            for (int n = 0; n < 2; ++n) sb[bj][n] = *(const f32x4*)(SB + u.pn * 256 + bj * 128 + n * 16 + lo); }
        if (u.kind == 0) {
#pragma unroll
            for (int ai = 0; ai < 2; ++ai) { float sa[4];
#pragma unroll
                for (int m = 0; m < 4; ++m) sa[m] = SAP[u.pm * 256 + ai * 128 + wr * 64 + m * 16 + fr];
#pragma unroll
                for (int bj = 0; bj < 2; ++bj)
#pragma unroll
                    for (int m = 0; m < 4; ++m) { const f32x4 a = __builtin_convertvector(acc[ai][bj][m][0], f32x4) * sb[bj][0] * sa[m], b = __builtin_convertvector(acc[ai][bj][m][1], f32x4) * sb[bj][1] * sa[m];
                        v4u w; w.x = pk2(a[0], a[1]); w.y = pk2(a[2], a[3]); w.z = pk2(b[0], b[1]); w.w = pk2(b[2], b[3]);
                        *(v4u*)(SCR + (size_t)(((ai * 2 + bj) * 4 + m) * 512 + tid) * 16) = w; } }
        } else {
#pragma unroll
            for (int ai = 0; ai < 2; ++ai)
#pragma unroll
                for (int mp = 0; mp < 2; ++mp) {
                    v2u xv[2][2][2]; v4u pv[2][2]; float sa[2];
#pragma unroll
                    for (int mm = 0; mm < 2; ++mm) { sa[mm] = SA3[u.pm * 256 + ai * 128 + wr * 64 + (2 * mp + mm) * 16 + fr];
#pragma unroll
                        for (int bj = 0; bj < 2; ++bj) { pv[mm][bj] = *(const v4u*)(SCR + (size_t)(((ai * 2 + bj) * 4 + 2 * mp + mm) * 512 + tid) * 16);
#pragma unroll
                            for (int n = 0; n < 2; ++n) xv[mm][bj][n] = *(const v2u*)(X3 + (size_t)(u.pm * 256 + ai * 128 + wr * 64 + (2 * mp + mm) * 16 + fr) * 1024 + u.pn * 256 + bj * 128 + n * 16 + lo); } }
#pragma unroll
                    for (int mm = 0; mm < 2; ++mm)
#pragma unroll
                        for (int bj = 0; bj < 2; ++bj)
#pragma unroll
                            for (int n = 0; n < 2; ++n) { const size_t off = (size_t)(u.pm * 256 + ai * 128 + wr * 64 + (2 * mp + mm) * 16 + fr) * 1024 + u.pn * 256 + bj * 128 + n * 16 + lo;
                                f32x4 g = __builtin_convertvector(acc[ai][bj][2 * mp + mm][n], f32x4) * sb[bj][n] * sa[mm];
#pragma unroll
                                for (int j = 0; j < 4; ++j) g[j] = sigm(g[j]);
                                const f32x4 pr = n ? up4(pv[mm][bj].z, pv[mm][bj].w) : up4(pv[mm][bj].x, pv[mm][bj].y);
                                *(f32x4*)(O + off) = up4(xv[mm][bj][n].x, xv[mm][bj][n].y) + pr * g; }
                    asm volatile("" ::: "memory"); }
        }
    }
};
struct EpiFinal8 {
    float* O; const bf16* X3; const bf16* PR; const float* SA; const float* SB;
    __device__ __forceinline__ void operator()(const i32x4 (&acc)[2][2][4][2], const Unit& u, int wr, int wc, int fr, int fq) const {
        f32x4 sb[2][2];
#pragma unroll
        for (int bj = 0; bj < 2; ++bj)
#pragma unroll
            for (int n = 0; n < 2; ++n) sb[bj][n] = *(const f32x4*)(SB + u.pn * 256 + bj * 128 + wc * 32 + n * 16 + 4 * fq);
#pragma unroll
        for (int ai = 0; ai < 2; ++ai)
#pragma unroll
            for (int mp = 0; mp < 2; ++mp) {
                v2u xv[2][2][2]; v2u pv[2][2][2]; float sa[2];
#pragma unroll
                for (int mm = 0; mm < 2; ++mm) { sa[mm] = SA[u.pm * 256 + ai * 128 + wr * 64 + (2 * mp + mm) * 16 + fr];
#pragma unroll
                    for (int bj = 0; bj < 2; ++bj)
#pragma unroll
                        for (int n = 0; n < 2; ++n) { const size_t off = (size_t)(u.pm * 256 + ai * 128 + wr * 64 + (2 * mp + mm) * 16 + fr) * 1024 + u.pn * 256 + bj * 128 + wc * 32 + n * 16 + 4 * fq;
                            xv[mm][bj][n] = *(const v2u*)(X3 + off); pv[mm][bj][n] = *(const v2u*)(PR + off); } }
#pragma unroll
                for (int mm = 0; mm < 2; ++mm)
#pragma unroll
                    for (int bj = 0; bj < 2; ++bj)
#pragma unroll
                        for (int n = 0; n < 2; ++n) { const size_t off = (size_t)(u.pm * 256 + ai * 128 + wr * 64 + (2 * mp + mm) * 16 + fr) * 1024 + u.pn * 256 + bj * 128 + wc * 32 + n * 16 + 4 * fq;
                            f32x4 g = __builtin_convertvector(acc[ai][bj][2 * mp + mm][n], f32x4) * sb[bj][n] * sa[mm];
#pragma unroll
                            for (int j = 0; j < 4; ++j) g[j] = sigm(g[j]);
                            *(f32x4*)(O + off) = up4(xv[mm][bj][n].x, xv[mm][bj][n].y) + up4(pv[mm][bj][n].x, pv[mm][bj][n].y) * g; }
                asm volatile("" ::: "memory"); }
    }
};
struct EpiFinal {
    float* O; const bf16* PR;
    __device__ __forceinline__ void operator()(const f32x4 (&acc)[2][2][4][2], const Unit& u, int wr, int wc, int fr, int fq) const {
#pragma unroll
        for (int ai = 0; ai < 2; ++ai)
#pragma unroll
            for (int mp = 0; mp < 2; ++mp) {
                f32x4 xv[2][2][2]; v2u pv[2][2][2];
#pragma unroll
                for (int mm = 0; mm < 2; ++mm)
#pragma unroll
                    for (int bj = 0; bj < 2; ++bj)
#pragma unroll
                        for (int n = 0; n < 2; ++n) { const size_t off = (size_t)(u.pm * 256 + ai * 128 + wr * 64 + (2 * mp + mm) * 16 + fr) * 1024 + u.pn * 256 + bj * 128 + wc * 32 + n * 16 + 4 * fq;
                            xv[mm][bj][n] = *(const f32x4*)(O + off); pv[mm][bj][n] = *(const v2u*)(PR + off); }
#pragma unroll
                for (int mm = 0; mm < 2; ++mm)
#pragma unroll
                    for (int bj = 0; bj < 2; ++bj)
#pragma unroll
                        for (int n = 0; n < 2; ++n) { const size_t off = (size_t)(u.pm * 256 + ai * 128 + wr * 64 + (2 * mp + mm) * 16 + fr) * 1024 + u.pn * 256 + bj * 128 + wc * 32 + n * 16 + 4 * fq;
                            f32x4 g = acc[ai][bj][2 * mp + mm][n];
#pragma unroll
                            for (int j = 0; j < 4; ++j) g[j] = sigm(g[j]);
                            *(f32x4*)(O + off) = xv[mm][bj][n] + up4(pv[mm][bj][n].x, pv[mm][bj][n].y) * g; }
                asm volatile("" ::: "memory"); }
    }
};

struct Frame {
    LAS unsigned char* lds; unsigned char* gl;
    volatile LAS unsigned* MISC; gu32* ctl;
    int tid, lane, wave, vcu, G;
    const float* in[27]; float* out; unsigned char* ws;
};
#define WSP(type, off) ((type*)(F.ws + (off)))
#define DOP(type, off) ((type*)((unsigned char*)F.out + (off)))
enum { I_X = 0, I_P, I_POS, I_LNMIX, I_WIN, I_HGLB, I_HGON, I_WOA, I_QAN, I_KVAN, I_WUQ, I_WUKV, I_QN, I_KN, I_WOB, I_WOUT, I_LNMOE, I_WRG, I_BRG, I_WRE, I_BRE, I_W1, I_W3, I_W2, I_LNPLE, I_WPG, I_WPP };

enum { M_WIN = 0, M_WOAB, M_WUQ, M_WUKV, M_WOUT, M_WPG, M_WPP, M_W13, M_W2T };
template <int MAT> struct MatInfo;
template <> struct MatInfo<M_WIN>  { static constexpr int K = 1024, NP = NIN; };
template <> struct MatInfo<M_WOAB> { static constexpr int K = 512,  NP = 2048; };
template <> struct MatInfo<M_WUQ>  { static constexpr int K = 256,  NP = 768; };
template <> struct MatInfo<M_WUKV> { static constexpr int K = 256,  NP = 1024; };
template <> struct MatInfo<M_WOUT> { static constexpr int K = 1024, NP = 1024; };
template <> struct MatInfo<M_WPG>  { static constexpr int K = 1024, NP = 1024; };
template <> struct MatInfo<M_WPP>  { static constexpr int K = 256,  NP = 1024; };
template <> struct MatInfo<M_W13>  { static constexpr int K = 1024, NP = NE * 512; };
template <> struct MatInfo<M_W2T>  { static constexpr int K = 256,  NP = NE * 1024; };
template <int MAT> __device__ __forceinline__ void conv_map(const Frame& F, int p, const float*& src, size_t& ld, const float*& gain, int& kvalid) {
    constexpr int K = MatInfo<MAT>::K; src = nullptr; ld = 0; gain = nullptr; kvalid = K;
    if constexpr (MAT == M_WIN) {
        const int pn = p >> 8; int col;
        if (pn < 8) { const int q = p & 255, bj = q >> 7, wc = (q >> 5) & 3, n = (q >> 4) & 1, fq = (q >> 2) & 3, j = q & 3; const int kind = 2 * bj + n;
            col = kind * 512 + (pn >> 1) * 128 + (pn & 1) * 64 + wc * 16 + fq * 4 + j; }
        else if (pn < 10) col = 2048 + perm8(p - 2048);
        else if (pn == 10) col = 2560 + perm8(p - 2560);
        else if (pn == 11) { const int l = perm8(p - 2816); col = l < 128 ? 2816 + l : (l < 160 ? 2944 + (l - 128) : -1); }
        else if (pn < 16) col = 2976 + perm8(p - 3072);
        else col = 4000 + perm8(p - 4096);
        if (col >= 0) src = F.in[I_WIN] + col; ld = DIN; gain = F.in[I_LNMIX];
    } else if constexpr (MAT == M_WOAB) { { const float* sa = F.in[I_WOA]; const float* sb = F.in[I_WOB]; src = (const float*)((const unsigned char*)sa + ((p >> 10) ? (size_t)((const unsigned char*)sb - (const unsigned char*)sa) : (size_t)0)) + perm8(p & 1023); } ld = 1024; }
    else if constexpr (MAT == M_WUQ) { src = F.in[I_WUQ] + perm8(p); ld = 768; gain = F.in[I_QAN]; }
    else if constexpr (MAT == M_WUKV) { const int pn = p >> 8, q = p & 255, bj = q >> 7, wc = (q >> 5) & 3, n = (q >> 4) & 1, fq = (q >> 2) & 3, j = q & 3;
        const int head = (pn & 1) * 4 + wc, d = 32 * bj + 8 * fq + 4 * n + j; src = F.in[I_WUKV] + head * 128 + (pn >= 2 ? 64 : 0) + d; ld = 1024; gain = F.in[I_KVAN]; kvalid = 128; }
    else if constexpr (MAT == M_WOUT) { src = F.in[I_WOUT] + perm8(p); ld = 1024; }
    else if constexpr (MAT == M_WPG) { src = F.in[I_WPG] + (GATE_FIRST ? perm8(p) : p); ld = 1024; gain = F.in[I_LNPLE]; }
    else if constexpr (MAT == M_WPP) { src = F.in[I_WPP] + ((FUSE_PROJ && !GATE_FIRST) ? p : perm8(p)); ld = 1024; }
    else if constexpr (MAT == M_W13) { const int e = p >> 9, q = p & 511, pl = q >> 8, bj = (q >> 7) & 1, r = q & 127;
        { const float* sa = F.in[I_W1]; const float* sb = F.in[I_W3]; src = (const float*)((const unsigned char*)sa + (bj ? (size_t)((const unsigned char*)sb - (const unsigned char*)sa) : (size_t)0)) + (size_t)e * 1024 * 256 + pl * 128 + perm8(r); } ld = 256; gain = F.in[I_LNMOE]; }
    else { const int e = p >> 10, q = p & 1023; src = F.in[I_W2] + (size_t)e * 256 * 1024 + perm8(q); ld = 1024; }
}
template <int MAT> __device__ __forceinline__ bf16* conv_dst(const Frame& F) {
    constexpr size_t off = MAT == M_WIN ? WS_WIN : MAT == M_WOAB ? WS_WOAB : MAT == M_WUQ ? WS_WUQ : MAT == M_WUKV ? WS_WUKV : MAT == M_WOUT ? WS_WOUT : MAT == M_WPG ? WS_WPG : MAT == M_WPP ? WS_WPP : MAT == M_W13 ? WS_W13 : WS_W2T;
    return WSP(bf16, off);
}
template <int MAT> __device__ __forceinline__ void conv_item(const Frame& F, int item, int lane, LAS float* scr) {
    constexpr int K = MatInfo<MAT>::K; constexpr int KB = K / 64;
    const int kb = item % KB, p0 = (item / KB) * 32, p = p0 + (lane & 31), k0 = kb * 64;
    const float* src; size_t ld; const float* gain; int kvalid; conv_map<MAT>(F, p, src, ld, gain, kvalid); bf16* dst = conv_dst<MAT>(F);
    float tv[32];
#pragma unroll
    for (int i = 0; i < 32; ++i) { const int k = k0 + 2 * i + (lane >> 5); tv[i] = (src && k < kvalid) ? src[(size_t)k * ld] : 0.0f; }
#pragma unroll
    for (int i = 0; i < 32; ++i) { const int kk = 2 * i + (lane >> 5); scr[kk * 33 + (lane & 31)] = gain ? tv[i] * gain[k0 + kk] : tv[i]; }
    LDS_WAIT(); asm volatile("" ::: "memory");
    const int c = lane & 7;
#pragma unroll
    for (int j = 0; j < 4; ++j) { const int n = (lane >> 3) + 8 * j; const LAS float* sp = scr + (8 * c) * 33 + n;
        v4u o; o.x = pk2(sp[0 * 33], sp[1 * 33]); o.y = pk2(sp[2 * 33], sp[3 * 33]); o.z = pk2(sp[4 * 33], sp[5 * 33]); o.w = pk2(sp[6 * 33], sp[7 * 33]);
        *(v4u*)(dst + (size_t)(p0 + n) * K + k0 + 8 * c) = o; }
    LDS_WAIT(); asm volatile("" ::: "memory");
}
template <int MAT> __device__ __forceinline__ void conv_mat(const Frame& F) {
    constexpr int NITEMS = (MatInfo<MAT>::NP / 32) * (MatInfo<MAT>::K / 64);
    const int gw = F.vcu * NWAVES + F.wave, NGW = F.G * NWAVES;
    LAS float* scr = (LAS float*)(F.lds + F.wave * 16384);
    for (int it = gw; it < NITEMS; it += NGW) conv_item<MAT>(F, it, F.lane, scr);
}

template <int MAT> __device__ __forceinline__ void conv8_mat(const Frame& F, unsigned char* dst8, float* SB, int wg_shift) {
    constexpr int K = MatInfo<MAT>::K, KPT = K / 16;
    static_assert(K == 1024 || K == 256, "conv8: K = 1024 or 256");
    constexpr int NITEMS = MatInfo<MAT>::NP / 32;
    int t_ = threadIdx.x; asm volatile("" : "+v"(t_));
    const int tid = t_, nl = tid & 31, kg = tid >> 5;
    LAS float* red = (LAS float*)F.lds;
    int first = F.vcu - wg_shift; if (first < 0) first += F.G;
    for (int it = first; it < NITEMS; it += F.G) {
        const int p = it * 32 + nl;
        const float* src; size_t ld; const float* gain; int kvalid; conv_map<MAT>(F, p, src, ld, gain, kvalid);
        float tv[KPT];
#pragma unroll
        for (int i = 0; i < KPT; ++i) tv[i] = (src && kg * KPT + i < kvalid) ? src[(size_t)(kg * KPT + i) * ld] : 0.0f;
        float mx = 0.f;
#pragma unroll
        for (int i = 0; i < KPT; ++i) { if (gain) tv[i] *= gain[kg * KPT + i]; mx = fmaxf(mx, fabsf(tv[i])); }
        red[kg * 32 + nl] = mx;
        __syncthreads();
        float cm = 0.f;
#pragma unroll
        for (int i = 0; i < 16; ++i) cm = fmaxf(cm, red[i * 32 + nl]);
        const float inv = cm > 0.f ? 127.0f / cm : 0.f;
        if (kg == 0) SB[p] = cm * (1.0f / 127.0f);
        unsigned char* dp = dst8 + (size_t)p * K + kg * KPT;
#pragma unroll
        for (int i = 0; i < KPT / 16; ++i) { v4u o;
            o.x = q8pack(tv[16 * i + 0] * inv, tv[16 * i + 1] * inv, tv[16 * i + 2] * inv, tv[16 * i + 3] * inv); o.y = q8pack(tv[16 * i + 4] * inv, tv[16 * i + 5] * inv, tv[16 * i + 6] * inv, tv[16 * i + 7] * inv);
            o.z = q8pack(tv[16 * i + 8] * inv, tv[16 * i + 9] * inv, tv[16 * i + 10] * inv, tv[16 * i + 11] * inv); o.w = q8pack(tv[16 * i + 12] * inv, tv[16 * i + 13] * inv, tv[16 * i + 14] * inv, tv[16 * i + 15] * inv);
            *(v4u*)(dp + 16 * i) = o; }
        __syncthreads();
    }
}

__device__ __forceinline__ void conv13_db(const Frame& F) {
    constexpr int NITEMS = MatInfo<M_W13>::NP / 16;
    int t_ = threadIdx.x; asm volatile("" : "+v"(t_));
    const int tid = t_, nl = tid & 15, kg = tid >> 4;
    LAS float* red = (LAS float*)F.lds; unsigned char* dst8 = F.ws + WS_W13; float* SB = WSP(float, WS_SB13);
    if (NITEMS % (2 * F.G) != 0) { conv8_mat<M_W13>(F, dst8, SB, 0); return; }
    const float* gain = F.in[I_LNMOE] + kg * 32;
#define C13_LOAD(tv_, it_) do { const float* src_; size_t ld_; const float* g_; int kv_; conv_map<M_W13>(F, (it_) * 16 + nl, src_, ld_, g_, kv_); \
        _Pragma("unroll") for (int i_ = 0; i_ < 32; ++i_) tv_[i_] = src_[(size_t)(kg * 32 + i_) * ld_]; } while (0)
#define C13_PROC(tv_, it_) do { const int p_ = (it_) * 16 + nl; float mx_ = 0.f; \
        _Pragma("unroll") for (int i_ = 0; i_ < 32; ++i_) { tv_[i_] *= gain[i_]; mx_ = fmaxf(mx_, fabsf(tv_[i_])); } \
        red[kg * 16 + nl] = mx_; __syncthreads(); float cm_ = 0.f; \
        _Pragma("unroll") for (int i_ = 0; i_ < 32; ++i_) cm_ = fmaxf(cm_, red[i_ * 16 + nl]); \
        const float inv_ = cm_ > 0.f ? 127.0f / cm_ : 0.f; if (kg == 0) SB[p_] = cm_ * (1.0f / 127.0f); \
        unsigned char* dp_ = dst8 + (size_t)p_ * 1024 + kg * 32; \
        _Pragma("unroll") for (int i_ = 0; i_ < 2; ++i_) { v4u o_; \
            o_.x = q8pack(tv_[16 * i_ + 0] * inv_, tv_[16 * i_ + 1] * inv_, tv_[16 * i_ + 2] * inv_, tv_[16 * i_ + 3] * inv_); o_.y = q8pack(tv_[16 * i_ + 4] * inv_, tv_[16 * i_ + 5] * inv_, tv_[16 * i_ + 6] * inv_, tv_[16 * i_ + 7] * inv_); \
            o_.z = q8pack(tv_[16 * i_ + 8] * inv_, tv_[16 * i_ + 9] * inv_, tv_[16 * i_ + 10] * inv_, tv_[16 * i_ + 11] * inv_); o_.w = q8pack(tv_[16 * i_ + 12] * inv_, tv_[16 * i_ + 13] * inv_, tv_[16 * i_ + 14] * inv_, tv_[16 * i_ + 15] * inv_); \
            *(v4u*)(dp_ + 16 * i_) = o_; } \
        __syncthreads(); } while (0)
    float tA[32], tB[32];
    C13_LOAD(tA, F.vcu);
#pragma unroll 1
    for (int it = F.vcu; it < NITEMS; it += 2 * F.G) {
        C13_LOAD(tB, it + F.G); C13_PROC(tA, it);
        if (it + 2 * F.G < NITEMS) C13_LOAD(tA, it + 2 * F.G);
        C13_PROC(tB, it + F.G);
    }
#undef C13_LOAD
#undef C13_PROC
}
__device__ __forceinline__ void conv_w2t_strips(const Frame& F) {
    constexpr int NITEMS = MatInfo<M_W2T>::NP / 32;
    int t_ = threadIdx.x; asm volatile("" : "+v"(t_));
    const int tid = t_, nl = tid & 31, kg = tid >> 5;
    bf16* dst = WSP(bf16, WS_W2T);
    for (int it0 = F.vcu; it0 < NITEMS; it0 += 4 * F.G) {
        float tv[4][16];
#pragma unroll
        for (int q = 0; q < 4; ++q) { const int it = it0 + q * F.G; if (it < NITEMS) { const float* src; size_t ld; const float* g; int kv; conv_map<M_W2T>(F, it * 32 + nl, src, ld, g, kv);
#pragma unroll
            for (int i = 0; i < 16; ++i) tv[q][i] = src[(size_t)(kg * 16 + i) * ld]; } }
#pragma unroll
        for (int q = 0; q < 4; ++q) { const int it = it0 + q * F.G; if (it < NITEMS) { bf16* dp = dst + (size_t)(it * 32 + nl) * 256 + kg * 16;
            v4u o0, o1; o0.x = pk2(tv[q][0], tv[q][1]); o0.y = pk2(tv[q][2], tv[q][3]); o0.z = pk2(tv[q][4], tv[q][5]); o0.w = pk2(tv[q][6], tv[q][7]);
            o1.x = pk2(tv[q][8], tv[q][9]); o1.y = pk2(tv[q][10], tv[q][11]); o1.z = pk2(tv[q][12], tv[q][13]); o1.w = pk2(tv[q][14], tv[q][15]);
            *(v4u*)dp = o0; *(v4u*)(dp + 8) = o1; } }
    }
}

__device__ __forceinline__ void p0_prologue(const Frame& F) {
    #if I8_P1
    conv8_mat<M_WIN>(F, F.ws + WS_WIN, WSP(float, WS_SBIN), 0);
#else
    conv_mat<M_WIN>(F);
#endif
    conv_mat<M_WOAB>(F);
#if I8_QKV
    conv8_mat<M_WUQ>(F, F.ws + WS_WUQ, WSP(float, WS_SBUQ), 160); conv8_mat<M_WUKV>(F, F.ws + WS_WUKV, WSP(float, WS_SBUKV), 184);
#else
    conv_mat<M_WUQ>(F); conv_mat<M_WUKV>(F);
#endif
    conv_mat<M_WOUT>(F);
#if I8_P10
    conv8_mat<M_WPG>(F, F.ws + WS_WPG, WSP(float, WS_SBPG), 192);
#else
    conv_mat<M_WPG>(F);
#endif
#if FUSE_PROJ
    conv8_mat<M_WPP>(F, F.ws + WS_WPP, WSP(float, WS_SBPP), 224);
#else
    conv_mat<M_WPP>(F);
#endif
    const int gt = F.vcu * NTHR + F.tid, NGT = F.G * NTHR;
    for (int i = gt; i < 80 * 1024; i += NGT) { const int j = i & 7, lane_ = (i >> 3) & 63, r = i >> 9, cb = r % 5, ks = r / 5; const int o = 16 * cb + (lane_ & 15), k = 32 * ks + 8 * (lane_ >> 4) + j;
        const float wv = o >= 72 ? 0.f : F.in[I_LNMOE][k] * (o < 8 ? F.in[I_WRG][k * 8 + o] : F.in[I_WRE][k * 64 + (o - 8)]);
        const unsigned h = f2bf(wv); WSP(bf16, WS_WRH)[i] = (bf16)h; WSP(bf16, WS_WRL)[i] = (bf16)f2bf(wv - bf2f(h)); }
    for (int i = gt; i < 80; i += NGT) WSP(float, WS_BR)[i] = i < 8 ? F.in[I_BRG][i] : (i < 72 ? F.in[I_BRE][i - 8] : 0.f);
    for (int i = gt; i < 1024; i += NGT) { const int d = i >> 9, f = i & 511; const float a0 = F.in[I_HGLB][d * 1024 + f], a1 = F.in[I_HGLB][d * 1024 + 512 + f]; WSP(float, WS_LB)[i] = 1.0f / (1.0f + expf(a1 - a0)); }
    for (int i = gt; i < T * 16; i += NGT) { const int t = i >> 4, f = i & 15; const float pos = (float)((const int*)F.in[I_POS])[t]; const float inv = exp2f(-(float)f * (13.287712379549449f / 16.0f));
        const float ang = pos * inv;
        const float kq = rintf(ang * 0.15915494309189535f); float r = fmaf(-kq, 6.28318548202514648f, ang); r = fmaf(-kq, -1.7484555e-7f, r);
        WSP(float, WS_ROPE)[t * 32 + f] = __cosf(r); WSP(float, WS_ROPE)[t * 32 + 16 + f] = __sinf(r); }
    const int gw = F.vcu * NWAVES + F.wave, NGW = F.G * NWAVES;
    for (int m = gw; m < T; m += NGW) {
        const float* xr = F.in[I_X] + (size_t)m * D + F.lane * 8; f32x4 v[4]; float ss = 0.f;
#pragma unroll
        for (int j = 0; j < 2; ++j) { v[2 * j] = *(const f32x4*)(xr + 512 * j); v[2 * j + 1] = *(const f32x4*)(xr + 512 * j + 4); ss += dot4(v[2 * j]) + dot4(v[2 * j + 1]); }
        const float rs = rsqrtf(wave_sum(ss) * (1.0f / D) + EPS);
#if I8_P1
        float mx = 0.f;
#pragma unroll
        for (int i = 0; i < 4; ++i)
#pragma unroll
            for (int j = 0; j < 4; ++j) mx = fmaxf(mx, fabsf(v[i][j]));
        mx = wave_max(mx); const float inv = mx > 0.f ? 127.0f / mx : 0.f;
        if (F.lane == 0) WSP(float, WS_SA1)[m] = mx * rs * (1.0f / 127.0f);
#pragma unroll
        for (int j = 0; j < 2; ++j) { v2u o; o.x = q8pack(v[2 * j][0] * inv, v[2 * j][1] * inv, v[2 * j][2] * inv, v[2 * j][3] * inv); o.y = q8pack(v[2 * j + 1][0] * inv, v[2 * j + 1][1] * inv, v[2 * j + 1][2] * inv, v[2 * j + 1][3] * inv);
            *(v2u*)(F.ws + WS_ACT + (size_t)m * D + F.lane * 8 + 512 * j) = o; }
#else
#pragma unroll
        for (int j = 0; j < 2; ++j) st8(WSP(bf16, WS_ACT) + (size_t)m * D + F.lane * 8 + 512 * j, v[2 * j] * rs, v[2 * j + 1] * rs);
#endif
#if FUSE_PROJ
        { f32x4 p0 = (f32x4){0.f, 0.f, 0.f, 0.f}, p1 = p0; if (F.lane < 32) { const float* pr = F.in[I_P] + (size_t)m * PLE + F.lane * 8; p0 = *(const f32x4*)pr; p1 = *(const f32x4*)(pr + 4); }
          float pm = 0.f;
#pragma unroll
          for (int j = 0; j < 4; ++j) pm = fmaxf(pm, fmaxf(fabsf(p0[j]), fabsf(p1[j])));
          pm = wave_max(pm); const float pinv = pm > 0.f ? 127.0f / pm : 0.f;
          if (F.lane == 0) WSP(float, WS_SAP)[m] = pm * (1.0f / 127.0f);
          if (F.lane < 32) { v2u o; o.x = q8pack(p0[0] * pinv, p0[1] * pinv, p0[2] * pinv, p0[3] * pinv); o.y = q8pack(p1[0] * pinv, p1[1] * pinv, p1[2] * pinv, p1[3] * pinv); *(v2u*)(F.ws + WS_PB + (size_t)m * PLE + F.lane * 8) = o; } }
#else
        if (F.lane < 32) { const float* pr = F.in[I_P] + (size_t)m * PLE + F.lane * 8; st8(WSP(bf16, WS_PB) + (size_t)m * PLE + F.lane * 8, *(const f32x4*)pr, *(const f32x4*)(pr + 4)); }
#endif
    }
}

__device__ __forceinline__ void oa_pass(const Frame& F) {
    const int gw = F.vcu * NWAVES + F.wave, NGW = F.G * NWAVES;
    const bf16* OFp = WSP(bf16, WS_ACT); const bf16* OBp = OFp + (size_t)T * 512; const bf16* OGp = WSP(bf16, WS_OG); bf16* OA = DOP(bf16, DO_OA);
    const int c0 = F.lane * 8; const f32x4 g0 = *(const f32x4*)(F.in[I_HGON] + (c0 & 127)), g1 = *(const f32x4*)(F.in[I_HGON] + (c0 & 127) + 4);
    for (int m = gw; m < T; m += NGW) {
        const size_t off = (size_t)m * 512 + c0;
        const v4u a = *(const v4u*)(OFp + off), b = *(const v4u*)(OBp + off), g = *(const v4u*)(OGp + off);
        f32x4 s0 = up4(a.x, a.y) + up4(b.x, b.y), s1 = up4(a.z, a.w) + up4(b.z, b.w);
        float ss = dot4(s0) + dot4(s1); ss += __shfl_xor(ss, 1); ss += __shfl_xor(ss, 2); ss += __shfl_xor(ss, 4); ss += __shfl_xor(ss, 8);
        const float rs = rsqrtf(ss * (1.0f / 128.0f) + EPS);
        st8(OA + off, s0 * rs * g0 * up4(g.x, g.y), s1 * rs * g1 * up4(g.z, g.w));
    }
}
__device__ __forceinline__ void x3_pass(const Frame& F) {
    const int gw = F.vcu * NWAVES + F.wave, NGW = F.G * NWAVES;
    const bf16* Y0 = WSP(bf16, WS_Y0); const bf16* Y1 = WSP(bf16, WS_Y1); const bf16* X2 = DOP(bf16, DO_X2B); bf16* X3 = WSP(bf16, WS_X3B); unsigned char* HP = F.ws + WS_ACT;
    for (int m = gw; m < T; m += NGW) {
        f32x4 v[4]; float ss = 0.f;
#pragma unroll
        for (int j = 0; j < 2; ++j) { const size_t o = (size_t)m * D + F.lane * 8 + 512 * j; const v4u a = *(const v4u*)(Y0 + o), b = *(const v4u*)(Y1 + o), x = *(const v4u*)(X2 + o);
            v[2 * j] = up4(x.x, x.y) + up4(a.x, a.y) + up4(b.x, b.y); v[2 * j + 1] = up4(x.z, x.w) + up4(a.z, a.w) + up4(b.z, b.w);
            st8(X3 + o, v[2 * j], v[2 * j + 1]); ss += dot4(v[2 * j]) + dot4(v[2 * j + 1]); }
        const float rs = rsqrtf(wave_sum(ss) * (1.0f / D) + EPS);
        float mx = 0.f;
#pragma unroll
        for (int i = 0; i < 4; ++i)
#pragma unroll
            for (int j = 0; j < 4; ++j) mx = fmaxf(mx, fabsf(v[i][j]));
        mx = wave_max(mx); const float inv = mx > 0.f ? 127.0f / mx : 0.f;
        if (F.lane == 0) WSP(float, WS_SA3)[m] = mx * rs * (1.0f / 127.0f);
#pragma unroll
        for (int j = 0; j < 2; ++j) { v2u o; o.x = q8pack(v[2 * j][0] * inv, v[2 * j][1] * inv, v[2 * j][2] * inv, v[2 * j][3] * inv); o.y = q8pack(v[2 * j + 1][0] * inv, v[2 * j + 1][1] * inv, v[2 * j + 1][2] * inv, v[2 * j + 1][3] * inv);
            *(v2u*)(HP + (size_t)m * D + F.lane * 8 + 512 * j) = o; }
    }
}
__device__ __forceinline__ void moe_build_table(const Frame& F) {
    LAS int* tab = (LAS int*)(F.lds + TAB_OFF); LAS int* cnts = tab + 16 + 4 * MAXROWT;
    if (F.tid < NE) cnts[F.tid] = (int)__hip_atomic_load(F.ctl + CW_CNT + 64 * F.tid, RLX_AGENT);
    __syncthreads();
    LAS int* starts = cnts + NE;
    if (F.tid == 0) { int rt = 0; for (int e = 0; e < NE; ++e) { starts[e] = rt; rt += (cnts[e] + 255) >> 8; } tab[0] = rt; }
    __syncthreads();
    if (F.tid < NE) { const int e = F.tid, cnt = cnts[e], nt = (cnt + 255) >> 8, r0 = starts[e];
        for (int lt = 0; lt < nt; ++lt) { const int rt = r0 + lt; tab[16 + 4 * rt] = e; tab[16 + 4 * rt + 1] = e * T + 256 * lt; const int rem = cnt - 256 * lt; tab[16 + 4 * rt + 2] = rem < 256 ? rem : 256; } }
    __syncthreads();
}
#ifndef ATT_OTR
#define ATT_OTR 0
#endif
#ifndef ATT_FIXSM
#define ATT_FIXSM 0
#endif
namespace att {
using f32x16 = __attribute__((ext_vector_type(16))) float;
using s16x4 = __attribute__((ext_vector_type(4))) short;
constexpr int QBLK = 32, KVBLK = 64;
constexpr float SCALE = 0.10206207261596577f;
constexpr float THR = 8.f;
constexpr int SHM_V = 16384, SHM_K = 16384, SHM_ATTN = 2 * SHM_V + 2 * SHM_K + NWAVES * 64 * 4;
#define KSWZ(row, colB) ((row) * 256 + ((colB) ^ (((row) & 7) << 4)))
#define SBAR() __builtin_amdgcn_sched_barrier(0)
__device__ __forceinline__ int crow(int r, int hi) { return (r & 3) + 8 * (r >> 2) + 4 * hi; }
__device__ __forceinline__ unsigned cvtpk(float lo, float hi) { unsigned r; asm volatile("v_cvt_pk_bf16_f32 %0, %1, %2" : "=v"(r) : "v"(lo), "v"(hi)); return r; }
__device__ __forceinline__ void partialSM(f32x16& p0, f32x16& p1, float& m_reg, float& mn, float& alpha) {
    constexpr float C = SCALE * 1.4426950408889634f;
    float pmax = p0[0];
#pragma unroll
    for (int r = 1; r < 16; ++r) pmax = fmaxf(pmax, p0[r]);
#pragma unroll
    for (int r = 0; r < 16; ++r) pmax = fmaxf(pmax, p1[r]);
    { auto rr = __builtin_amdgcn_permlane32_swap(__float_as_uint(pmax), __float_as_uint(pmax), false, false); pmax = fmaxf(__uint_as_float(rr[0]), __uint_as_float(rr[1])); }
    if (__builtin_expect(__all(pmax - m_reg <= THR / SCALE), 1)) { mn = m_reg; alpha = 1.f; }
    else { mn = fmaxf(m_reg, pmax); alpha = __builtin_amdgcn_exp2f((m_reg - mn) * C); m_reg = mn; }
    const float mnC = -mn * C;
#pragma unroll
    for (int r = 0; r < 16; ++r) p0[r] = fmaf(p0[r], C, mnC);
#pragma unroll
    for (int r = 0; r < 16; ++r) p1[r] = fmaf(p1[r], C, mnC);
#pragma unroll
    for (int r = 0; r < 16; ++r) p0[r] = __builtin_amdgcn_exp2f(p0[r]);
}
__device__ __forceinline__ void partialSM_fix(f32x16& p0, f32x16& p1, float mnC) {
    constexpr float C = SCALE * 1.4426950408889634f;
#pragma unroll
    for (int r = 0; r < 16; ++r) p0[r] = fmaf(p0[r], C, mnC);
#pragma unroll
    for (int r = 0; r < 16; ++r) p1[r] = fmaf(p1[r], C, mnC);
#pragma unroll
    for (int r = 0; r < 16; ++r) p0[r] = __builtin_amdgcn_exp2f(p0[r]);
}
__device__ __forceinline__ void finishSM(f32x16& p0, f32x16& p1, float alpha, float& l_reg, bf16x8& pa0, bf16x8& pa1, bf16x8& pa2, bf16x8& pa3) {
#pragma unroll
    for (int r = 0; r < 16; ++r) p1[r] = __builtin_amdgcn_exp2f(p1[r]);
    float ps = 0;
#pragma unroll
    for (int r = 0; r < 16; ++r) ps += p0[r];
#pragma unroll
    for (int r = 0; r < 16; ++r) ps += p1[r];
    { auto rr = __builtin_amdgcn_permlane32_swap(__float_as_uint(ps), __float_as_uint(ps), false, false); ps = __uint_as_float(rr[0]) + __uint_as_float(rr[1]); }
    l_reg = l_reg * alpha + ps;
#define PK4(P, BASE, OUT) do { unsigned a0 = cvtpk(P[BASE + 0], P[BASE + 1]), a1 = cvtpk(P[BASE + 2], P[BASE + 3]);   \
    unsigned b0 = cvtpk(P[BASE + 4], P[BASE + 5]), b1 = cvtpk(P[BASE + 6], P[BASE + 7]);                              \
    auto r0 = __builtin_amdgcn_permlane32_swap(a0, b0, false, false); auto r1 = __builtin_amdgcn_permlane32_swap(a1, b1, false, false); \
    v4u w = {r0[0], r1[0], r0[1], r1[1]}; OUT = __builtin_bit_cast(bf16x8, w); } while (0)
    PK4(p0, 0, pa0); PK4(p0, 8, pa1); PK4(p1, 0, pa2); PK4(p1, 8, pa3);
#undef PK4
}
__device__ __forceinline__ void qkt(f32x16& p0, f32x16& p1, const char* Ks, const bf16x8* qr, int r32, int hi) {
    p0 = f32x16{}; p1 = f32x16{};
#pragma unroll
    for (int d0 = 0; d0 < 6; ++d0) { const int cb = (d0 * 16 + hi * 8) * 2;
        const bf16x8 b0 = *reinterpret_cast<const bf16x8*>(Ks + KSWZ(r32, cb));
        const bf16x8 b1 = *reinterpret_cast<const bf16x8*>(Ks + KSWZ(32 + r32, cb));
        p0 = __builtin_amdgcn_mfma_f32_32x32x16_bf16(b0, qr[d0], p0, 0, 0, 0);
        p1 = __builtin_amdgcn_mfma_f32_32x32x16_bf16(b1, qr[d0], p1, 0, 0, 0); }
}
__device__ __forceinline__ int v_st(int k, int c) { const int kk = (k & ~0xC) | ((k & 4) << 1) | ((k & 8) >> 1); return ((kk >> 3) * 4 + (c >> 5)) * 512 + ((kk & 7) * 32 + (c & 31)) * 2; }
__device__ __forceinline__ int v_rd_base(int lane) { return ((lane & 3) << 3) | (((lane >> 2) & 3) << 6) | (((lane >> 4) & 1) << 5) | (((lane >> 5) & 1) << 8); }
constexpr int v_rd_off(int d0, int ks, int half) { return d0 * 512 + ks * 4096 + half * 2048; }
template <int OFF> __device__ __forceinline__ s16x4 tr_read(int vb) { s16x4 r; asm volatile("ds_read_b64_tr_b16 %0, %1 offset:%2" : "=&v"(r) : "v"(vb), "i"(OFF) : "memory"); return r; }
template <int D0> __device__ __forceinline__ void pv_one(f32x16& od, int vb, bf16x8 pa0, bf16x8 pa1, bf16x8 pa2, bf16x8 pa3) {
    const s16x4 l0 = tr_read<v_rd_off(D0, 0, 0)>(vb), h0 = tr_read<v_rd_off(D0, 0, 1)>(vb), l1 = tr_read<v_rd_off(D0, 1, 0)>(vb), h1 = tr_read<v_rd_off(D0, 1, 1)>(vb);
    const s16x4 l2 = tr_read<v_rd_off(D0, 2, 0)>(vb), h2 = tr_read<v_rd_off(D0, 2, 1)>(vb), l3 = tr_read<v_rd_off(D0, 3, 0)>(vb), h3 = tr_read<v_rd_off(D0, 3, 1)>(vb);
    asm volatile("s_waitcnt lgkmcnt(0)" ::: "memory"); SBAR();
#define PK(L, H) (bf16x8){L[0], L[1], L[2], L[3], H[0], H[1], H[2], H[3]}
    od = __builtin_amdgcn_mfma_f32_32x32x16_bf16(pa0, PK(l0, h0), od, 0, 0, 0);
    od = __builtin_amdgcn_mfma_f32_32x32x16_bf16(pa1, PK(l1, h1), od, 0, 0, 0);
    od = __builtin_amdgcn_mfma_f32_32x32x16_bf16(pa2, PK(l2, h2), od, 0, 0, 0);
    od = __builtin_amdgcn_mfma_f32_32x32x16_bf16(pa3, PK(l3, h3), od, 0, 0, 0);
#undef PK
}
__device__ __forceinline__ void pv_d0(f32x16* o, int vb, bf16x8 pa0, bf16x8 pa1, bf16x8 pa2, bf16x8 pa3) { pv_one<0>(o[0], vb, pa0, pa1, pa2, pa3); pv_one<1>(o[1], vb, pa0, pa1, pa2, pa3); }

__device__ __forceinline__ void attn_unit(const bf16* __restrict__ QM, const bf16* __restrict__ KH, const bf16* __restrict__ VH, bf16* __restrict__ OM, const float* __restrict__ RT, const float* __restrict__ QN,
                                          int t0, int kb, int h, char* lds, const float* __restrict__ KN = nullptr) {
    int tid_ = threadIdx.x; asm volatile("" : "+v"(tid_));
    const int tid = tid_, wid = __builtin_amdgcn_readfirstlane(tid >> 6), lane = tid & 63, r32 = lane & 31, hi = lane >> 5;
    char* V_lds = lds; char* K_lds = lds + 2 * SHM_V;
    float* wsf = (float*)(lds + 2 * SHM_V + 2 * SHM_K) + wid * 64; float* li_l = wsf; float* al_l = wsf + 32;
    float m_reg = -1e30f, l_reg = 0; f32x16 o[2] = {}; bf16x8 qr[6];
    {
        const int tq = t0 + wid * QBLK + r32; const bf16* qp = QM + (size_t)tq * 768 + h * 96 + hi * 8;
        float qf[6][8]; float ss = 0.f;
#pragma unroll
        for (int d0 = 0; d0 < 6; ++d0) { const v4u w = *(const v4u*)(qp + d0 * 16);
            qf[d0][0] = bflo(w.x); qf[d0][1] = bfhi(w.x); qf[d0][2] = bflo(w.y); qf[d0][3] = bfhi(w.y); qf[d0][4] = bflo(w.z); qf[d0][5] = bfhi(w.z); qf[d0][6] = bflo(w.w); qf[d0][7] = bfhi(w.w);
#pragma unroll
            for (int j = 0; j < 8; ++j) ss += qf[d0][j] * qf[d0][j]; }
        { auto rr = __builtin_amdgcn_permlane32_swap(__float_as_uint(ss), __float_as_uint(ss), false, false); ss = __uint_as_float(rr[0]) + __uint_as_float(rr[1]); }
        const float rs = rsqrtf(ss * (1.0f / 96.0f) + EPS);
#pragma unroll
        for (int d0 = 0; d0 < 6; ++d0) { const f32x4 g0 = *(const f32x4*)(QN + d0 * 16 + hi * 8), g1 = *(const f32x4*)(QN + d0 * 16 + hi * 8 + 4);
#pragma unroll
            for (int j = 0; j < 4; ++j) { qf[d0][j] *= rs * g0[j]; qf[d0][4 + j] *= rs * g1[j]; } }
        { const float* rt = RT + (size_t)tq * 32 + hi * 8; const f32x4 c0 = *(const f32x4*)rt, c1 = *(const f32x4*)(rt + 4), s0 = *(const f32x4*)(rt + 16), s1 = *(const f32x4*)(rt + 20);
#pragma unroll
          for (int j = 0; j < 8; ++j) { const float c = j < 4 ? c0[j & 3] : c1[j & 3], s = j < 4 ? s0[j & 3] : s1[j & 3]; const float x1 = qf[4][j], x2 = qf[5][j]; qf[4][j] = x1 * c - x2 * s; qf[5][j] = x2 * c + x1 * s; } }
#pragma unroll
        for (int d0 = 0; d0 < 6; ++d0) { v4u w = {cvtpk(qf[d0][0], qf[d0][1]), cvtpk(qf[d0][2], qf[d0][3]), cvtpk(qf[d0][4], qf[d0][5]), cvtpk(qf[d0][6], qf[d0][7])}; qr[d0] = __builtin_bit_cast(bf16x8, w); }
    }
#if ATT_FIXSM
    float mnC;
    {   float gq = fabsf(QN[lane]), gk = fabsf(KN[lane]); if (lane < 32) { gq = fmaxf(gq, fabsf(QN[64 + lane])); gk = fmaxf(gk, fabsf(KN[64 + lane])); }
#pragma unroll
        for (int o_ = 1; o_ < 64; o_ <<= 1) { gq = fmaxf(gq, __shfl_xor(gq, o_)); gk = fmaxf(gk, __shfl_xor(gk, o_)); }
        const float bound = fminf(96.0f * 1.01f * gq * gk, 60.0f / SCALE);
        mnC = -bound * (SCALE * 1.4426950408889634f); }
#define PSM(p0_, p1_, mn_, al_) do { partialSM_fix(p0_, p1_, mnC); al_ = 1.f; } while (0)
#else
#define PSM(p0_, p1_, mn_, al_) partialSM(p0_, p1_, m_reg, mn_, al_)
#endif
    const int vrow = tid >> 3, vch = tid & 7, k0row = tid / 12, k0ch = tid - 12 * k0row, k1row = (tid + 512) / 12, k1ch = (tid + 512) - 12 * k1row; const bool two = wid < 4;
    const bf16* Kg = KH + ((size_t)kb * 8 + h) * 96; const bf16* Vg = VH + ((size_t)kb * 8 + h) * 64;
    const int vst0 = v_st(vrow, vch * 8), kst0 = KSWZ(k0row, k0ch * 16), kst1 = KSWZ(k1row, k1ch * 16);
    const int vb0 = (int)(uintptr_t)V_lds + v_rd_base(lane);
    struct { bf16x8 vs, ks0, ks1; } sr_[2];
#define SLOAD(i, kk) do { sr_[i].vs = *(const bf16x8*)(Vg + (size_t)((kk) + vrow) * 512 + vch * 8); sr_[i].ks0 = *(const bf16x8*)(Kg + (size_t)((kk) + k0row) * 768 + k0ch * 8); \
    if (two) sr_[i].ks1 = *(const bf16x8*)(Kg + (size_t)((kk) + k1row) * 768 + k1ch * 8); } while (0)
#define SWRITE(b, i) do { *(bf16x8*)(V_lds + (b) * SHM_V + vst0) = sr_[i].vs; *(bf16x8*)(K_lds + (b) * SHM_K + kst0) = sr_[i].ks0; if (two) *(bf16x8*)(K_lds + (b) * SHM_K + kst1) = sr_[i].ks1; } while (0)
#define SWAIT() do { if (two) asm volatile("s_waitcnt vmcnt(3)" ::: "memory"); else asm volatile("s_waitcnt vmcnt(2)" ::: "memory"); } while (0)
#if ATT_FIXSM
#define RESC(a) do { } while (0)
#else
#define RESC(a) do { if (__any((a) < 1.f)) { if (hi == 0) al_l[r32] = (a); asm volatile("s_waitcnt lgkmcnt(0)" ::: "memory"); \
    _Pragma("unroll") for (int d = 0; d < 2; ++d) _Pragma("unroll") for (int r = 0; r < 16; ++r) o[d][r] *= al_l[crow(r, hi)]; } } while (0)
#endif
    f32x16 pA0, pA1, pB0, pB1; float mnA, mnB, alA, alB; bf16x8 pa0, pa1, pa2, pa3; constexpr int NT = SEQ / KVBLK;
    SLOAD(0, 0); asm volatile("s_waitcnt vmcnt(0)" ::: "memory"); SWRITE(0, 0); __syncthreads();
    qkt(pA0, pA1, K_lds, qr, r32, hi); PSM(pA0, pA1, mnA, alA);
    SLOAD(1, KVBLK); SLOAD(0, 2 * KVBLK);
    SWAIT(); SWRITE(1, 1); __syncthreads();
    for (int j = 1; j + 1 < NT; j += 2) {
        SBAR(); qkt(pB0, pB1, K_lds + SHM_K, qr, r32, hi);
        finishSM(pA0, pA1, alA, l_reg, pa0, pa1, pa2, pa3); SBAR();
        SLOAD(1, (j + 2) * KVBLK); SBAR();
        pv_d0(o, vb0, pa0, pa1, pa2, pa3); PSM(pB0, pB1, mnB, alB);
        __syncthreads(); SWAIT(); SWRITE(0, 0);
        RESC(alB); __syncthreads();
        SBAR(); qkt(pA0, pA1, K_lds, qr, r32, hi);
        finishSM(pB0, pB1, alB, l_reg, pa0, pa1, pa2, pa3); SBAR();
        if (j + 3 < NT) SLOAD(0, (j + 3) * KVBLK); SBAR();
        pv_d0(o, vb0 + SHM_V, pa0, pa1, pa2, pa3); PSM(pA0, pA1, mnA, alA);
        __syncthreads(); SWAIT(); SWRITE(1, 1);
        RESC(alA); __syncthreads();
    }
    SBAR(); qkt(pB0, pB1, K_lds + SHM_K, qr, r32, hi);
    finishSM(pA0, pA1, alA, l_reg, pa0, pa1, pa2, pa3); SBAR();
    pv_d0(o, vb0, pa0, pa1, pa2, pa3); PSM(pB0, pB1, mnB, alB);
    __syncthreads(); RESC(alB);
    finishSM(pB0, pB1, alB, l_reg, pa0, pa1, pa2, pa3); SBAR();
    pv_d0(o, vb0 + SHM_V, pa0, pa1, pa2, pa3);
    if (hi == 0) li_l[r32] = l_reg; asm volatile("s_waitcnt lgkmcnt(0)" ::: "memory");
    bf16* Ow = OM + (size_t)(t0 + wid * QBLK) * 512 + h * 64;
#if ATT_OTR
    {
        char* ot = lds + 73728 + wid * 4608;
#pragma unroll
        for (int r = 0; r < 16; ++r) { const int orow = crow(r, hi); const float rl = __builtin_amdgcn_rcpf(li_l[orow]);
#pragma unroll
            for (int d0 = 0; d0 < 2; ++d0) *(unsigned short*)(ot + orow * 144 + (d0 * 32 + r32) * 2) = (unsigned short)f2bf(o[d0][r] * rl); }
        asm volatile("s_waitcnt lgkmcnt(0)" ::: "memory");
        const int orow = lane >> 1, oh = lane & 1;
#pragma unroll
        for (int k = 0; k < 4; ++k) *(v4u*)(Ow + (size_t)orow * 512 + oh * 32 + 8 * k) = *(const v4u*)(ot + orow * 144 + oh * 64 + 16 * k);
    }
#else
#pragma unroll
    for (int r = 0; r < 16; ++r) { const int orow = crow(r, hi); const float rl = __builtin_amdgcn_rcpf(li_l[orow]);
#pragma unroll
        for (int d0 = 0; d0 < 2; ++d0) Ow[(size_t)orow * 512 + d0 * 32 + r32] = (bf16)f2bf(o[d0][r] * rl); }
#endif
    asm volatile("s_waitcnt vmcnt(0)" ::: "memory");
    __syncthreads();
#undef SLOAD
#undef SWRITE
#undef SWAIT
#undef RESC
#undef PSM
}
#undef KSWZ
#undef SBAR
}
__device__ __forceinline__ void attn_fast(const Frame& F) {
    const bf16* QM = WSP(bf16, WS_QM); const bf16* KH = WSP(bf16, WS_KH); const bf16* VH = WSP(bf16, WS_VH); bf16* OM = DOP(bf16, DO_OM);
    for (int item = F.vcu; item < NB * MH * 8; item += F.G) {
        const int qb = item & 7, h = (item >> 3) & 7, b = item >> 6;
        att::attn_unit(QM, KH, VH, OM, WSP(float, WS_ROPE), F.in[I_QN], b * SEQ + qb * 256, b * SEQ, h, (char*)F.gl);
    }
}
namespace hg {
typedef short v4i16_t __attribute__((ext_vector_type(4)));
constexpr int IN_BYTES = 40960, OFF_Q = 0, OFF_K = 16384, OFF_V = 32768, OFF_P = 2 * IN_BYTES, OFF_MT = OFF_P + 8192;
__device__ __forceinline__ unsigned off256(unsigned row, unsigned ch) { return 256u * row + 16u * (ch ^ (((row & 3) << 2) | ((row >> 2) & 3))); }
__device__ __forceinline__ unsigned off128(unsigned row, unsigned ch) { return 128u * row + 16u * (ch ^ (row & 7)); }
__device__ __forceinline__ bf16x8 ldrow(const LAS unsigned char* p) { return *(const LAS bf16x8*)p; }
__device__ __forceinline__ bf16x8 ldtr(const LAS unsigned char* p0, const LAS unsigned char* p1) {
    const v4i16_t a = __builtin_amdgcn_ds_read_tr16_b64_v4i16((LAS v4i16_t*)p0), b = __builtin_amdgcn_ds_read_tr16_b64_v4i16((LAS v4i16_t*)p1);
    return (bf16x8){a[0], a[1], a[2], a[3], b[0], b[1], b[2], b[3]};
}
}
__device__ __forceinline__ void hgrn_fast(const Frame& F) {
    using namespace hg;
    int tid_ = threadIdx.x; asm volatile("" : "+v"(tid_));
    const int tid = tid_, lane = tid & 63, w = __builtin_amdgcn_readfirstlane(tid >> 6), l15 = lane & 15, g = lane >> 4, q4 = (lane & 15) >> 2, p4 = lane & 3;
    const LAS unsigned char* L = F.lds;
    const unsigned qrow0 = tid >> 4, qch = tid & 15, qrow1 = qrow0 + 32, vrow = tid >> 3, vch = tid & 7;
    const unsigned sq0 = off256(qrow0, qch), sq1 = off256(qrow1, qch), sv = off128(vrow, vch);
    const int tb = w >> 1, sb0 = 2 * (w & 1);
    for (int item = blockIdx.x; item < NB * HGH * 2 * 2; item += F.G) {
        const int vh = item & 1, dir = (item >> 1) & 1, hh = (item >> 2) & 3, b = item >> 4;
        const bf16* Qd = DOP(bf16, dir ? DO_QB : DO_QF) + hh * 128 + qch * 8; const bf16* Kd = DOP(bf16, dir ? DO_KB : DO_KF) + hh * 128 + qch * 8;
        const bf16* Va = WSP(bf16, WS_VA) + hh * 128 + vh * 64 + vch * 8;
        bf16* Od = WSP(bf16, WS_ACT) + (dir ? (size_t)T * 512 : (size_t)0) + hh * 128 + vh * 64;
        const float* ER = WSP(float, WS_EREF) + (size_t)dir * NCHUNK * 512 + hh * 128 + 16 * w + 4 * g; const float* EL = WSP(float, WS_ELAST) + (size_t)dir * NCHUNK * 512 + hh * 128 + 16 * w + 4 * g;
#define HG_BAR() asm volatile("s_waitcnt lgkmcnt(0)\n\ts_barrier" ::: "memory")
        f32x4 M[4];
#pragma unroll
        for (int i = 0; i < 4; ++i) M[i] = (f32x4){0.f, 0.f, 0.f, 0.f};
        v4u rq0, rq1, rk0, rk1, rv;
#define HG_LOAD(gc_) do { const size_t t0_ = (size_t)(gc_) * 64; rq0 = *(const v4u*)(Qd + (t0_ + qrow0) * 512); rq1 = *(const v4u*)(Qd + (t0_ + qrow1) * 512); \
        rk0 = *(const v4u*)(Kd + (t0_ + qrow0) * 512); rk1 = *(const v4u*)(Kd + (t0_ + qrow1) * 512); rv = *(const v4u*)(Va + (t0_ + vrow) * 512); } while (0)
#define HG_WRITE(buf_) do { LAS unsigned char* B_ = (LAS unsigned char*)L + (buf_) * IN_BYTES; *(LAS v4u*)(B_ + OFF_Q + sq0) = rq0; *(LAS v4u*)(B_ + OFF_Q + sq1) = rq1; \
        *(LAS v4u*)(B_ + OFF_K + sq0) = rk0; *(LAS v4u*)(B_ + OFF_K + sq1) = rk1; *(LAS v4u*)(B_ + OFF_V + sv) = rv; } while (0)
        __syncthreads();
        { const int c0 = dir ? 31 : 0; HG_LOAD(b * 32 + c0); HG_WRITE(0); }
        __syncthreads();
        for (int cc = 0; cc < 32; ++cc) {
            const int c = dir ? 31 - cc : cc, gc = b * 32 + c, cn = dir ? c - 1 : c + 1, buf = cc & 1; const bool has = cc < 31;
            const LAS unsigned char* Bq = L + buf * IN_BYTES + OFF_Q; const LAS unsigned char* Bk = L + buf * IN_BYTES + OFF_K; const LAS unsigned char* Bv = L + buf * IN_BYTES + OFF_V;
            if (has) HG_LOAD(b * 32 + cn);
            f32x4 dv = (f32x4){0.f, 0.f, 0.f, 0.f};
            if (has) dv = *(const f32x4*)(EL + (size_t)gc * 512) * *(const f32x4*)(ER + (size_t)(b * 32 + cn) * 512);
            bf16x8 qfr[4];
            {
                f32x4 pa[2] = {(f32x4){0.f, 0.f, 0.f, 0.f}, (f32x4){0.f, 0.f, 0.f, 0.f}};
#pragma unroll
                for (int ks = 0; ks < 4; ++ks) { qfr[ks] = ldrow(Bq + off256(16 * tb + l15, 4 * ks + g));
#pragma unroll
                    for (int i = 0; i < 2; ++i) { const bf16x8 kf = ldrow(Bk + off256(16 * (sb0 + i) + l15, 4 * ks + g)); pa[i] = __builtin_amdgcn_mfma_f32_16x16x32_bf16(kf, qfr[ks], pa[i], 0, 0, 0); } }
                const int t = 16 * tb + l15;
#pragma unroll
                for (int i = 0; i < 2; ++i) { const int s0 = 16 * (sb0 + i) + 4 * g; f32x4 v = pa[i];
#pragma unroll
                    for (int r = 0; r < 4; ++r) { const bool ok = dir ? (s0 + r >= t) : (s0 + r <= t); v[r] = ok ? v[r] : 0.f; }
                    v2u pk; pk.x = pk2(v[0], v[1]); pk.y = pk2(v[2], v[3]);
                    *(LAS v2u*)((LAS unsigned char*)L + OFF_P + off128(t, 2 * (sb0 + i) + (g >> 1)) + (g & 1) * 8) = pk; }
#pragma unroll
                for (int vb = 0; vb < 4; ++vb) { v2u pk; pk.x = pk2(M[vb][0], M[vb][1]); pk.y = pk2(M[vb][2], M[vb][3]);
                    *(LAS v2u*)((LAS unsigned char*)L + OFF_MT + off256(16 * vb + l15, 2 * w + (g >> 1)) + (g & 1) * 8) = pk; }
            }
            HG_BAR();
            {
                f32x4 oa[2] = {(f32x4){0.f, 0.f, 0.f, 0.f}, (f32x4){0.f, 0.f, 0.f, 0.f}};
#pragma unroll
                for (int ks = 0; ks < 2; ++ks) { const bf16x8 pf = ldrow(L + OFF_P + off128(16 * tb + l15, 4 * ks + g));
#pragma unroll
                    for (int i = 0; i < 2; ++i) { const unsigned c = sb0 + i;
                        const bf16x8 vf = ldtr(Bv + off128(32 * ks + 8 * g + q4, 2 * c + (p4 >> 1)) + 8 * (p4 & 1), Bv + off128(32 * ks + 8 * g + 4 + q4, 2 * c + (p4 >> 1)) + 8 * (p4 & 1));
                        oa[i] = __builtin_amdgcn_mfma_f32_16x16x32_bf16(vf, pf, oa[i], 0, 0, 0); } }
#pragma unroll
                for (int ks = 0; ks < 4; ++ks) {
#pragma unroll
                    for (int i = 0; i < 2; ++i) { const bf16x8 mf = ldrow(L + OFF_MT + off256(16 * (sb0 + i) + l15, 4 * ks + g)); oa[i] = __builtin_amdgcn_mfma_f32_16x16x32_bf16(mf, qfr[ks], oa[i], 0, 0, 0); } }
                const size_t orow = ((size_t)gc * 64 + 16 * tb + l15) * 512;
#pragma unroll
                for (int i = 0; i < 2; ++i) st4(Od + orow + 16 * (sb0 + i) + 4 * g, oa[i]);
#pragma unroll
                for (int ks = 0; ks < 2; ++ks) {
                    const bf16x8 kf = ldtr(Bk + off256(32 * ks + 8 * g + q4, 2 * w + (p4 >> 1)) + 8 * (p4 & 1), Bk + off256(32 * ks + 8 * g + 4 + q4, 2 * w + (p4 >> 1)) + 8 * (p4 & 1));
#pragma unroll
                    for (int vb = 0; vb < 4; ++vb) {
                        const bf16x8 vf = ldtr(Bv + off128(32 * ks + 8 * g + q4, 2 * vb + (p4 >> 1)) + 8 * (p4 & 1), Bv + off128(32 * ks + 8 * g + 4 + q4, 2 * vb + (p4 >> 1)) + 8 * (p4 & 1));
                        M[vb] = __builtin_amdgcn_mfma_f32_16x16x32_bf16(kf, vf, M[vb], 0, 0, 0); } }
#pragma unroll
                for (int vb = 0; vb < 4; ++vb) M[vb] = M[vb] * dv;
            }
            if (has) HG_WRITE(buf ^ 1);
            HG_BAR();
        }
#undef HG_LOAD
#undef HG_WRITE
#undef HG_BAR
    }
}
namespace hg2 {
constexpr int QKB = 32768, H2_V = 3 * QKB, H2_P = H2_V + 2 * 8192, H2_D = TAB_OFF;
}
__device__ __forceinline__ void hgrn_fast2(const Frame& F) {
    using namespace hg; using namespace hg2;
    const int w = __builtin_amdgcn_readfirstlane((int)threadIdx.x >> 6);
    const LAS unsigned char* L = F.lds; LAS unsigned char* Lw = (LAS unsigned char*)F.lds;
#define HG_BAR() asm volatile("s_waitcnt lgkmcnt(0)\n\ts_barrier" ::: "memory")
#define CH(cc_) (dir ? 31 - (cc_) : (cc_))
    for (int item = blockIdx.x; item < NB * HGH * 2 * 2; item += F.G) {
        const int vh = item & 1, dir = (item >> 1) & 1, hh = (item >> 2) & 3, b = item >> 4;
        __syncthreads();
        if (w < 4) {
            int t_ = threadIdx.x; asm volatile("" : "+v"(t_));
            const int lane = t_ & 63, l15 = lane & 15, g = lane >> 4, q4 = (lane & 15) >> 2, p4 = lane & 3;
            bf16* Od = WSP(bf16, WS_ACT) + (dir ? (size_t)T * 512 : (size_t)0) + hh * 128 + vh * 64 + 16 * w + 4 * g;
            f32x4 Mb[8];
#pragma unroll
            for (int i = 0; i < 8; ++i) Mb[i] = (f32x4){0.f, 0.f, 0.f, 0.f};
            HG_BAR(); HG_BAR();
#pragma unroll 1
            for (int cc = 0; cc < 32; ++cc) {
                const LAS unsigned char* Bq = L + (cc % 3) * QKB; const LAS unsigned char* Bk = Bq + 16384; const LAS unsigned char* Bv = L + H2_V + (cc & 1) * 8192; const LAS unsigned char* Bp = L + H2_P + (cc & 1) * 8192;
                const int gc = b * 32 + CH(cc);
                bf16x8 vf[2];
#pragma unroll
                for (int ks = 0; ks < 2; ++ks) vf[ks] = ldtr(Bv + off128(32 * ks + 8 * g + q4, 2 * w + (p4 >> 1)) + 8 * (p4 & 1), Bv + off128(32 * ks + 8 * g + 4 + q4, 2 * w + (p4 >> 1)) + 8 * (p4 & 1));
                f32x4 oa[4];
#pragma unroll
                for (int tb = 0; tb < 4; ++tb) oa[tb] = (f32x4){0.f, 0.f, 0.f, 0.f};
#pragma unroll
                for (int tb = 0; tb < 4; ++tb)
#pragma unroll
                    for (int ks = 0; ks < 2; ++ks) { const bf16x8 pf = ldrow(Bp + off128(16 * tb + l15, 4 * ks + g)); oa[tb] = __builtin_amdgcn_mfma_f32_16x16x32_bf16(vf[ks], pf, oa[tb], 0, 0, 0); }
#pragma unroll
                for (int ks = 0; ks < 4; ++ks) { v4u mw; mw.x = pk2(Mb[2 * ks][0], Mb[2 * ks][1]); mw.y = pk2(Mb[2 * ks][2], Mb[2 * ks][3]); mw.z = pk2(Mb[2 * ks + 1][0], Mb[2 * ks + 1][1]); mw.w = pk2(Mb[2 * ks + 1][2], Mb[2 * ks + 1][3]);
                    const bf16x8 mf = __builtin_bit_cast(bf16x8, mw);
#pragma unroll
                    for (int tb = 0; tb < 4; ++tb) { const v2u qa = *(const LAS v2u*)(Bq + off256(16 * tb + l15, 4 * ks + (g >> 1)) + 8 * (g & 1)), qb = *(const LAS v2u*)(Bq + off256(16 * tb + l15, 4 * ks + 2 + (g >> 1)) + 8 * (g & 1));
                        v4u qw; qw.x = qa.x; qw.y = qa.y; qw.z = qb.x; qw.w = qb.y;
                        oa[tb] = __builtin_amdgcn_mfma_f32_16x16x32_bf16(mf, __builtin_bit_cast(bf16x8, qw), oa[tb], 0, 0, 0); } }
#ifdef PROBE_HG_LDS
                { unsigned dm = 0;
#pragma unroll
                  for (int ks = 0; ks < 4; ++ks)
#pragma unroll
                    for (int tb = 0; tb < 4; ++tb) { const v2u qa = *(const volatile LAS v2u*)(Bq + off256(16 * tb + l15, 4 * ks + (g >> 1)) + 8 * (g & 1)), qb = *(const volatile LAS v2u*)(Bq + off256(16 * tb + l15, 4 * ks + 2 + (g >> 1)) + 8 * (g & 1)); dm ^= qa.x ^ qa.y ^ qb.x ^ qb.y; }
                  if (dm == 0x12345678u && gc < 0) Od[0] = (bf16)dm; }
#endif
#pragma unroll
                for (int tb = 0; tb < 4; ++tb) st4(Od + ((size_t)gc * 64 + 16 * tb + l15) * 512, oa[tb]);
                if (cc < 31) {
#pragma unroll
                    for (int ks = 0; ks < 2; ++ks)
#pragma unroll
                        for (int cb = 0; cb < 8; ++cb) { const bf16x8 kf = ldtr(Bk + off256(32 * ks + 8 * g + q4, 2 * cb + (p4 >> 1)) + 8 * (p4 & 1), Bk + off256(32 * ks + 8 * g + 4 + q4, 2 * cb + (p4 >> 1)) + 8 * (p4 & 1));
                            Mb[cb] = __builtin_amdgcn_mfma_f32_16x16x32_bf16(kf, vf[ks], Mb[cb], 0, 0, 0); }
#pragma unroll
                    for (int cb = 0; cb < 8; ++cb) Mb[cb] = Mb[cb] * *(const LAS f32x4*)(L + H2_D + (cc & 1) * 512 + (16 * cb + 4 * g) * 4);
                }
                HG_BAR();
            }
        } else {
            int t_ = threadIdx.x; asm volatile("" : "+v"(t_));
            const int lane = t_ & 63, l15 = lane & 15, g = lane >> 4, pt = t_ & 255;
            const bf16* Qd = DOP(bf16, dir ? DO_QB : DO_QF) + hh * 128 + (pt & 15) * 8 + (size_t)(pt >> 4) * 512; const bf16* Kd = DOP(bf16, dir ? DO_KB : DO_KF) + hh * 128 + (pt & 15) * 8 + (size_t)(pt >> 4) * 512;
            const bf16* Va = WSP(bf16, WS_VA) + hh * 128 + vh * 64 + (pt & 7) * 8 + (size_t)(pt >> 3) * 512;
            const float* ER = WSP(float, WS_EREF) + (size_t)dir * NCHUNK * 512 + hh * 128 + (pt & 127); const float* EL = WSP(float, WS_ELAST) + (size_t)dir * NCHUNK * 512 + hh * 128 + (pt & 127);
            const unsigned sq0 = off256(pt >> 4, pt & 15), sv0 = off128(pt >> 3, pt & 7);
            v4u rqA[4], rkA[4], rvA[2], rqB[4], rkB[4], rvB[2]; float elA = 0.f, erA = 0.f, elB = 0.f, erB = 0.f;
#define LOAD_QK(cc_, S) do { const size_t t0_ = (size_t)(b * 32 + CH(cc_)) * 64; _Pragma("unroll") for (int i_ = 0; i_ < 4; ++i_) { rq##S[i_] = *(const v4u*)(Qd + (t0_ + 16 * i_) * 512); rk##S[i_] = *(const v4u*)(Kd + (t0_ + 16 * i_) * 512); } } while (0)
#define LOAD_V(cc_, S) do { const size_t t0_ = (size_t)(b * 32 + CH(cc_)) * 64; _Pragma("unroll") for (int i_ = 0; i_ < 2; ++i_) rv##S[i_] = *(const v4u*)(Va + (t0_ + 32 * i_) * 512); } while (0)
#define WRITE_QK(cc_, S) do { LAS unsigned char* B_ = Lw + ((cc_) % 3) * QKB + sq0; _Pragma("unroll") for (int i_ = 0; i_ < 4; ++i_) { *(LAS v4u*)(B_ + 4096 * i_) = rq##S[i_]; *(LAS v4u*)(B_ + 16384 + 4096 * i_) = rk##S[i_]; } } while (0)
#define WRITE_V(cc_, S) do { LAS unsigned char* B_ = Lw + H2_V + ((cc_) & 1) * 8192 + sv0; _Pragma("unroll") for (int i_ = 0; i_ < 2; ++i_) *(LAS v4u*)(B_ + 4096 * i_) = rv##S[i_]; } while (0)
#define LOAD_D(cc_, S) do { el##S = EL[(size_t)(b * 32 + CH(cc_)) * 512]; er##S = ER[(size_t)(b * 32 + CH((cc_) + 1)) * 512]; } while (0)
#define WRITE_D(cc_, S) do { if (pt < 128) *(LAS float*)(Lw + H2_D + ((cc_) & 1) * 512 + pt * 4) = el##S * er##S; } while (0)
#define MAKE_P(cc_) do { const LAS unsigned char* Bq_ = L + ((cc_) % 3) * QKB; const LAS unsigned char* Bk_ = Bq_ + 16384; LAS unsigned char* Bp_ = Lw + H2_P + ((cc_) & 1) * 8192; const int tb_ = w - 4; \
            f32x4 pa_[4]; _Pragma("unroll") for (int i_ = 0; i_ < 4; ++i_) pa_[i_] = (f32x4){0.f, 0.f, 0.f, 0.f}; \
            _Pragma("unroll") for (int ks_ = 0; ks_ < 4; ++ks_) { const bf16x8 qf_ = ldrow(Bq_ + off256(16 * tb_ + l15, 4 * ks_ + g)); \
                _Pragma("unroll") for (int i_ = 0; i_ < 4; ++i_) { const bf16x8 kf_ = ldrow(Bk_ + off256(16 * i_ + l15, 4 * ks_ + g)); pa_[i_] = __builtin_amdgcn_mfma_f32_16x16x32_bf16(kf_, qf_, pa_[i_], 0, 0, 0); } } \
            const int tt_ = 16 * tb_ + l15; \
            _Pragma("unroll") for (int i_ = 0; i_ < 4; ++i_) { const int s0_ = 16 * i_ + 4 * g; f32x4 v_ = pa_[i_]; \
                _Pragma("unroll") for (int r_ = 0; r_ < 4; ++r_) { const bool ok_ = dir ? (s0_ + r_ >= tt_) : (s0_ + r_ <= tt_); v_[r_] = ok_ ? v_[r_] : 0.f; } \
                v2u pk_; pk_.x = pk2(v_[0], v_[1]); pk_.y = pk2(v_[2], v_[3]); *(LAS v2u*)(Bp_ + off128(tt_, 2 * i_ + (g >> 1)) + (g & 1) * 8) = pk_; } } while (0)
            LOAD_QK(0, A); LOAD_V(0, A); LOAD_D(0, A); LOAD_QK(1, B); WRITE_QK(0, A); WRITE_V(0, A); WRITE_D(0, A); WRITE_QK(1, B);
            LOAD_QK(2, A); LOAD_V(1, A); LOAD_D(1, A); LOAD_QK(3, B); LOAD_V(2, B); LOAD_D(2, B);
            HG_BAR();
            MAKE_P(0);
            HG_BAR();
#define P_STEP(S) do { if (cc + 2 < 32) WRITE_QK(cc + 2, S); if (cc + 1 < 32) WRITE_V(cc + 1, S); if (cc + 2 < 32) WRITE_D(cc + 1, S); \
            if (cc + 4 < 32) LOAD_QK(cc + 4, S); if (cc + 3 < 32) LOAD_V(cc + 3, S); if (cc + 4 < 32) LOAD_D(cc + 3, S); if (cc + 1 < 32) MAKE_P(cc + 1); } while (0)
#pragma unroll 1
            for (int c2 = 0; c2 < 32; c2 += 2) {
                { const int cc = c2; P_STEP(A); HG_BAR(); }
                { const int cc = c2 + 1; P_STEP(B); HG_BAR(); }
            }
#undef P_STEP
#undef LOAD_QK
#undef LOAD_V
#undef WRITE_QK
#undef WRITE_V
#undef LOAD_D
#undef WRITE_D
#undef MAKE_P
        }
    }
#undef CH
#undef HG_BAR
}

typedef float f32x16 __attribute__((ext_vector_type(16)));
__device__ __forceinline__ void hgrn_fast3(const Frame& F) {
    using namespace hg; using namespace hg2;
    const int w = __builtin_amdgcn_readfirstlane((int)threadIdx.x >> 6);
    const LAS unsigned char* L = F.lds; LAS unsigned char* Lw = (LAS unsigned char*)F.lds;
#define HG_BAR() asm volatile("s_waitcnt lgkmcnt(0)\n\ts_barrier" ::: "memory")
#define CH(cc_) (dir ? 31 - (cc_) : (cc_))
    for (int item = blockIdx.x; item < NB * HGH * 2 * 2; item += F.G) {
        const int vh = item & 1, dir = (item >> 1) & 1, hh = (item >> 2) & 3, b = item >> 4;
        __syncthreads();
        if (w < 2) {
            int t_ = threadIdx.x; asm volatile("" : "+v"(t_));
            const int lane = t_ & 63, r32 = lane & 31, h = lane >> 5, blk = (lane >> 4) & 1, q4 = (lane & 15) >> 2, p4 = lane & 3;
            bf16* Od = WSP(bf16, WS_ACT) + (dir ? (size_t)T * 512 : (size_t)0) + hh * 128 + vh * 64 + 32 * w + 4 * h;
            f32x16 Mb[4];
#pragma unroll
            for (int i = 0; i < 4; ++i) Mb[i] = f32x16{};
            HG_BAR(); HG_BAR();
#pragma unroll 1
            for (int cc = 0; cc < 32; ++cc) {
                const LAS unsigned char* Bq = L + (cc % 3) * QKB; const LAS unsigned char* Bk = Bq + 16384; const LAS unsigned char* Bv = L + H2_V + (cc & 1) * 8192; const LAS unsigned char* Bp = L + H2_P + (cc & 1) * 8192;
                const int gc = b * 32 + CH(cc);
                bf16x8 vf[4];
#pragma unroll
                for (int ks = 0; ks < 4; ++ks) vf[ks] = ldtr(Bv + off128(16 * ks + 8 * h + q4, 4 * w + 2 * blk + (p4 >> 1)) + 8 * (p4 & 1), Bv + off128(16 * ks + 8 * h + 4 + q4, 4 * w + 2 * blk + (p4 >> 1)) + 8 * (p4 & 1));
                f32x16 oa[2] = {f32x16{}, f32x16{}};
#pragma unroll
                for (int tb = 0; tb < 2; ++tb)
#pragma unroll
                    for (int ks = 0; ks < 4; ++ks) { const bf16x8 pf = ldrow(Bp + off128(32 * tb + r32, 2 * ks + h)); oa[tb] = __builtin_amdgcn_mfma_f32_32x32x16_bf16(vf[ks], pf, oa[tb], 0, 0, 0); }
#pragma unroll
                for (int cb = 0; cb < 4; ++cb)
#pragma unroll
                    for (int s2 = 0; s2 < 2; ++s2) {
                        v4u mw; mw.x = pk2(Mb[cb][8 * s2 + 0], Mb[cb][8 * s2 + 1]); mw.y = pk2(Mb[cb][8 * s2 + 2], Mb[cb][8 * s2 + 3]); mw.z = pk2(Mb[cb][8 * s2 + 4], Mb[cb][8 * s2 + 5]); mw.w = pk2(Mb[cb][8 * s2 + 6], Mb[cb][8 * s2 + 7]);
                        const bf16x8 mf = __builtin_bit_cast(bf16x8, mw);
#pragma unroll
                        for (int tb = 0; tb < 2; ++tb) { const v2u qa = *(const LAS v2u*)(Bq + off256(32 * tb + r32, 4 * cb + 2 * s2) + 8 * h), qb = *(const LAS v2u*)(Bq + off256(32 * tb + r32, 4 * cb + 2 * s2 + 1) + 8 * h);
                            v4u qw; qw.x = qa.x; qw.y = qa.y; qw.z = qb.x; qw.w = qb.y;
                            oa[tb] = __builtin_amdgcn_mfma_f32_32x32x16_bf16(mf, __builtin_bit_cast(bf16x8, qw), oa[tb], 0, 0, 0); } }
#pragma unroll
                for (int tb = 0; tb < 2; ++tb)
#pragma unroll
                    for (int i = 0; i < 4; ++i) st4(Od + ((size_t)gc * 64 + 32 * tb + r32) * 512 + 8 * i, (f32x4){oa[tb][4 * i], oa[tb][4 * i + 1], oa[tb][4 * i + 2], oa[tb][4 * i + 3]});
                if (cc < 31) {
#pragma unroll
                    for (int ks = 0; ks < 4; ++ks)
#pragma unroll
                        for (int cb = 0; cb < 4; ++cb) { const bf16x8 kf = ldtr(Bk + off256(16 * ks + 8 * h + q4, 4 * cb + 2 * blk + (p4 >> 1)) + 8 * (p4 & 1), Bk + off256(16 * ks + 8 * h + 4 + q4, 4 * cb + 2 * blk + (p4 >> 1)) + 8 * (p4 & 1));
                            Mb[cb] = __builtin_amdgcn_mfma_f32_32x32x16_bf16(kf, vf[ks], Mb[cb], 0, 0, 0); }
#pragma unroll
                    for (int cb = 0; cb < 4; ++cb)
#pragma unroll
                        for (int i = 0; i < 4; ++i) { const f32x4 dv = *(const LAS f32x4*)(L + H2_D + (cc & 1) * 512 + (32 * cb + 8 * i + 4 * h) * 4);
#pragma unroll
                            for (int e = 0; e < 4; ++e) Mb[cb][4 * i + e] *= dv[e]; }
                }
                HG_BAR();
            }
        } else if (w < 4) {
            HG_BAR(); HG_BAR();
#pragma unroll 1
            for (int cc = 0; cc < 32; ++cc) HG_BAR();
        } else {
            int t_ = threadIdx.x; asm volatile("" : "+v"(t_));
            const int lane = t_ & 63, r32 = lane & 31, h = lane >> 5, pt = t_ & 255;
            const bf16* Qd = DOP(bf16, dir ? DO_QB : DO_QF) + hh * 128 + (pt & 15) * 8 + (size_t)(pt >> 4) * 512; const bf16* Kd = DOP(bf16, dir ? DO_KB : DO_KF) + hh * 128 + (pt & 15) * 8 + (size_t)(pt >> 4) * 512;
            const bf16* Va = WSP(bf16, WS_VA) + hh * 128 + vh * 64 + (pt & 7) * 8 + (size_t)(pt >> 3) * 512;
            const float* ER = WSP(float, WS_EREF) + (size_t)dir * NCHUNK * 512 + hh * 128 + (pt & 127); const float* EL = WSP(float, WS_ELAST) + (size_t)dir * NCHUNK * 512 + hh * 128 + (pt & 127);
            const unsigned sq0 = off256(pt >> 4, pt & 15), sv0 = off128(pt >> 3, pt & 7);
            v4u rqA[4], rkA[4], rvA[2], rqB[4], rkB[4], rvB[2]; float elA = 0.f, erA = 0.f, elB = 0.f, erB = 0.f;
#define LOAD_QK(cc_, S) do { const size_t t0_ = (size_t)(b * 32 + CH(cc_)) * 64; _Pragma("unroll") for (int i_ = 0; i_ < 4; ++i_) { rq##S[i_] = *(const v4u*)(Qd + (t0_ + 16 * i_) * 512); rk##S[i_] = *(const v4u*)(Kd + (t0_ + 16 * i_) * 512); } } while (0)
#define LOAD_V(cc_, S) do { const size_t t0_ = (size_t)(b * 32 + CH(cc_)) * 64; _Pragma("unroll") for (int i_ = 0; i_ < 2; ++i_) rv##S[i_] = *(const v4u*)(Va + (t0_ + 32 * i_) * 512); } while (0)
#define WRITE_QK(cc_, S) do { LAS unsigned char* B_ = Lw + ((cc_) % 3) * QKB + sq0; _Pragma("unroll") for (int i_ = 0; i_ < 4; ++i_) { *(LAS v4u*)(B_ + 4096 * i_) = rq##S[i_]; *(LAS v4u*)(B_ + 16384 + 4096 * i_) = rk##S[i_]; } } while (0)
#define WRITE_V(cc_, S) do { LAS unsigned char* B_ = Lw + H2_V + ((cc_) & 1) * 8192 + sv0; _Pragma("unroll") for (int i_ = 0; i_ < 2; ++i_) *(LAS v4u*)(B_ + 4096 * i_) = rv##S[i_]; } while (0)
#define LOAD_D(cc_, S) do { el##S = EL[(size_t)(b * 32 + CH(cc_)) * 512]; er##S = ER[(size_t)(b * 32 + CH((cc_) + 1)) * 512]; } while (0)
#define WRITE_D(cc_, S) do { if (pt < 128) *(LAS float*)(Lw + H2_D + ((cc_) & 1) * 512 + pt * 4) = el##S * er##S; } while (0)
#define MAKE_P(cc_) do { if (w < 6) { const LAS unsigned char* Bq_ = L + ((cc_) % 3) * QKB; const LAS unsigned char* Bk_ = Bq_ + 16384; LAS unsigned char* Bp_ = Lw + H2_P + ((cc_) & 1) * 8192; const int tb_ = w - 4; \
            f32x16 pa_[2] = {f32x16{}, f32x16{}}; \
            _Pragma("unroll") for (int ks_ = 0; ks_ < 8; ++ks_) { const bf16x8 qf_ = ldrow(Bq_ + off256(32 * tb_ + r32, 2 * ks_ + h)); \
                _Pragma("unroll") for (int i_ = 0; i_ < 2; ++i_) { const bf16x8 kf_ = ldrow(Bk_ + off256(32 * i_ + r32, 2 * ks_ + h)); pa_[i_] = __builtin_amdgcn_mfma_f32_32x32x16_bf16(kf_, qf_, pa_[i_], 0, 0, 0); } } \
            const int tt_ = 32 * tb_ + r32; \
            _Pragma("unroll") for (int i_ = 0; i_ < 2; ++i_) _Pragma("unroll") for (int q_ = 0; q_ < 4; ++q_) { const int s0_ = 32 * i_ + 8 * q_ + 4 * h; float v_[4]; \
                _Pragma("unroll") for (int e_ = 0; e_ < 4; ++e_) { const bool ok_ = dir ? (s0_ + e_ >= tt_) : (s0_ + e_ <= tt_); v_[e_] = ok_ ? pa_[i_][4 * q_ + e_] : 0.f; } \
                v2u pk_; pk_.x = pk2(v_[0], v_[1]); pk_.y = pk2(v_[2], v_[3]); *(LAS v2u*)(Bp_ + off128(tt_, 4 * i_ + q_) + 8 * h) = pk_; } } } while (0)
            LOAD_QK(0, A); LOAD_V(0, A); LOAD_D(0, A); LOAD_QK(1, B); WRITE_QK(0, A); WRITE_V(0, A); WRITE_D(0, A); WRITE_QK(1, B);
            LOAD_QK(2, A); LOAD_V(1, A); LOAD_D(1, A); LOAD_QK(3, B); LOAD_V(2, B); LOAD_D(2, B);
            HG_BAR();
            MAKE_P(0);
            HG_BAR();
#define P_STEP(S) do { if (cc + 2 < 32) WRITE_QK(cc + 2, S); if (cc + 1 < 32) WRITE_V(cc + 1, S); if (cc + 2 < 32) WRITE_D(cc + 1, S); \
            if (cc + 4 < 32) LOAD_QK(cc + 4, S); if (cc + 3 < 32) LOAD_V(cc + 3, S); if (cc + 4 < 32) LOAD_D(cc + 3, S); if (cc + 1 < 32) MAKE_P(cc + 1); } while (0)
#pragma unroll 1
            for (int c2 = 0; c2 < 32; c2 += 2) {
                { const int cc = c2; P_STEP(A); HG_BAR(); }
                { const int cc = c2 + 1; P_STEP(B); HG_BAR(); }
            }
#undef P_STEP
#undef LOAD_QK
#undef LOAD_V
#undef WRITE_QK
#undef WRITE_V
#undef LOAD_D
#undef WRITE_D
#undef MAKE_P
        }
    }
#undef CH
#undef HG_BAR
}
template <bool DRY = false> __device__ __forceinline__ void route_fast(const Frame& F) {
    int tid_ = threadIdx.x; asm volatile("" : "+v"(tid_));
    const int tid = tid_, lane = tid & 63, w = __builtin_amdgcn_readfirstlane(tid >> 6), l15 = lane & 15, g = lane >> 4;
    LAS float* lg = (LAS float*)F.lds + w * 16 * 80;
    LAS int* cntL = (LAS int*)(F.lds + 40960); LAS int* baseL = cntL + 64;
    const bf16* WRH = WSP(bf16, WS_WRH); const bf16* WRL = WSP(bf16, WS_WRL); const float* BR = WSP(float, WS_BR);
    const bf16* X2 = DOP(bf16, DO_X2B); int* EIDX = WSP(int, WS_EIDX); float* EW = WSP(float, WS_EW); int* LIST = WSP(int, WS_LIST); float* RS2 = WSP(float, WS_RS2);
    for (int round = 0; round * F.G * 128 < T; ++round) {
        const int m0 = (round * F.G + F.vcu) * 128 + w * 16;
        if (tid < 64) cntL[tid] = 0;
        __syncthreads();
        f32x4 acc[5];
#pragma unroll
        for (int cb = 0; cb < 5; ++cb) acc[cb] = (f32x4){0.f, 0.f, 0.f, 0.f};
        float ss = 0.f;
        const bf16* wh = WRH + lane * 8; const bf16* wl = WRL + lane * 8;
        LAS unsigned char* stg = F.lds + 49152 + w * 8448;
        const int srow = lane >> 5;
        const bf16* xg = X2 + (size_t)(m0 + srow) * 1024 + (lane & 31) * 8;
#if I8_P7
        float mxt; { const f32x4 pm = *(const f32x4*)(WSP(float, WS_XMAX) + (size_t)(m0 + (lane >> 2)) * 16 + (lane & 3) * 4); mxt = fmaxf(fmaxf(pm[0], pm[1]), fmaxf(pm[2], pm[3])); mxt = fmaxf(mxt, __shfl_xor(mxt, 1)); mxt = fmaxf(mxt, __shfl_xor(mxt, 2)); }
        float invr[8];
#pragma unroll
        for (int i_ = 0; i_ < 8; ++i_) { const float mr = __shfl(mxt, 4 * (2 * i_ + srow)); invr[i_] = mr > 0.f ? 127.0f / mr : 0.f; }
        unsigned char* hq = F.ws + WS_ACT + (size_t)(m0 + srow) * 1024 + (lane & 31) * 8;
#endif
        v4u R[8];
#define RT_LOADG(c_) do { _Pragma("unroll") for (int i_ = 0; i_ < 8; ++i_) R[i_] = *(const v4u*)(xg + (size_t)(2 * i_) * 1024 + 256 * (c_)); } while (0)
        RT_LOADG(0);
#pragma unroll 1
        for (int c = 0; c < 4; ++c) {
#pragma unroll
            for (int i_ = 0; i_ < 8; ++i_) { *(LAS v4u*)(stg + (2 * i_ + srow) * 528 + (lane & 31) * 16) = R[i_];
#if I8_P7
                { const f32x4 a = up4(R[i_].x, R[i_].y) * invr[i_], b = up4(R[i_].z, R[i_].w) * invr[i_]; v2u o; o.x = q8pack(a[0], a[1], a[2], a[3]); o.y = q8pack(b[0], b[1], b[2], b[3]);
                  *(v2u*)(hq + (size_t)(2 * i_) * 1024 + 256 * c) = o; }
#endif
            }
            LDS_WAIT(); asm volatile("" ::: "memory");
            if (c < 3) RT_LOADG(c + 1);
#pragma unroll
            for (int h_ = 0; h_ < 4; ++h_) {
                bf16x8 bh[2][5], bl[2][5];
#pragma unroll
                for (int j_ = 0; j_ < 2; ++j_)
#pragma unroll
                    for (int cb = 0; cb < 5; ++cb) { const int ks_ = 8 * c + 2 * h_ + j_; bh[j_][cb] = *(const bf16x8*)(wh + (ks_ * 5 + cb) * 512); bl[j_][cb] = *(const bf16x8*)(wl + (ks_ * 5 + cb) * 512); }
#pragma unroll
                for (int j_ = 0; j_ < 2; ++j_) { const v4u xa = *(const LAS v4u*)(stg + l15 * 528 + 64 * (2 * h_ + j_) + 16 * g);
                    ss = dot2bf(xa.x, xa.x, ss); ss = dot2bf(xa.y, xa.y, ss); ss = dot2bf(xa.z, xa.z, ss); ss = dot2bf(xa.w, xa.w, ss);
                    const bf16x8 xh = __builtin_bit_cast(bf16x8, xa);
#pragma unroll
                    for (int cb = 0; cb < 5; ++cb) {
                        acc[cb] = __builtin_amdgcn_mfma_f32_16x16x32_bf16(xh, bh[j_][cb], acc[cb], 0, 0, 0);
                        acc[cb] = __builtin_amdgcn_mfma_f32_16x16x32_bf16(xh, bl[j_][cb], acc[cb], 0, 0, 0); } }
            }
            LDS_WAIT(); asm volatile("" ::: "memory");
        }
#undef RT_LOADG
        ss += __shfl_xor(ss, 16); ss += __shfl_xor(ss, 32);
        const float rs = rsqrtf(ss * (1.0f / D) + EPS);
#if I8_P7
        { const float ml = __shfl(mxt, 4 * l15); if (g == 0) RS2[m0 + l15] = rs * ml * (1.0f / 127.0f); }
#else
        if (g == 0) RS2[m0 + l15] = rs;
#endif
        float rsr[4];
#pragma unroll
        for (int r = 0; r < 4; ++r) rsr[r] = __shfl(rs, 4 * g + r);
#pragma unroll
        for (int cb = 0; cb < 5; ++cb) { const float bias = BR[16 * cb + l15];
#pragma unroll
            for (int r = 0; r < 4; ++r) lg[(4 * g + r) * 80 + 16 * cb + l15] = acc[cb][r] * rsr[r] + bias; }
        LDS_WAIT(); asm volatile("" ::: "memory");
        int e0 = 0, e1 = 0, r0 = 0, r1 = 0; const int m = m0 + lane;
        if (lane < 16) {
            const LAS float* lt = lg + lane * 80;
            float gl[8];
#pragma unroll
            for (int i = 0; i < 8; ++i) gl[i] = lt[i];
            float gm = gl[0]; int gs = 0;
#pragma unroll
            for (int i = 1; i < 8; ++i) if (gl[i] > gm) { gm = gl[i]; gs = i; }
            float ge = 0.f;
#pragma unroll
            for (int i = 0; i < 8; ++i) ge += __expf(gl[i] - gm);
            const float pg = 1.0f / ge;
            float el[8];
#pragma unroll
            for (int i = 0; i < 8; ++i) el[i] = lt[8 + 8 * gs + i];
            float m1 = el[0]; int i1 = 0;
#pragma unroll
            for (int i = 1; i < 8; ++i) if (el[i] > m1) { m1 = el[i]; i1 = i; }
            float m2 = -3e38f; int i2 = 0;
#pragma unroll
            for (int i = 0; i < 8; ++i) if (i != i1 && el[i] > m2) { m2 = el[i]; i2 = i; }
            const float e2 = __expf(m2 - m1), w0 = pg / (1.0f + e2), w1 = pg * e2 / (1.0f + e2);
            e0 = 8 * gs + i1; e1 = 8 * gs + i2;
            EIDX[m * 2] = e0; EIDX[m * 2 + 1] = e1; EW[m * 2] = w0; EW[m * 2 + 1] = w1;
            if (!DRY) { r0 = __hip_atomic_fetch_add(cntL + e0, 1, __ATOMIC_RELAXED, __HIP_MEMORY_SCOPE_WORKGROUP);
            r1 = __hip_atomic_fetch_add(cntL + e1, 1, __ATOMIC_RELAXED, __HIP_MEMORY_SCOPE_WORKGROUP); }
        }
        __syncthreads();
        if (!DRY && tid < 64) { const int c = cntL[tid]; baseL[tid] = c ? (int)__hip_atomic_fetch_add(F.ctl + CW_CNT + 64 * tid, (unsigned)c, RLX_AGENT) : 0; }
        __syncthreads();
        if (!DRY && lane < 16) { LIST[(size_t)e0 * T + baseL[e0] + r0] = m * 2; LIST[(size_t)e1 * T + baseL[e1] + r1] = m * 2 + 1; }
        __syncthreads();
    }
}
struct Args { const float* in[27]; float* out; unsigned char* ws; int ph_lo, ph_hi, use_bar, pad; };
constexpr int NPHASE = 11;
__device__ __forceinline__ void frame_init(Frame& F, const Args& args, unsigned char* lds) {
    F.lds = (LAS unsigned char*)lds; F.gl = lds;
    F.MISC = (volatile LAS unsigned*)(F.lds + MISC_OFF);
    F.tid = threadIdx.x; F.lane = F.tid & 63; F.wave = __builtin_amdgcn_readfirstlane(F.tid >> 6);
    F.G = gridDim.x; { const int bx = blockIdx.x; F.vcu = (F.G % 8 == 0) ? (bx % 8) * (F.G / 8) + bx / 8 : bx; }
    F.ws = args.ws; F.out = args.out; F.ctl = (gu32*)(args.ws + WS_CTL);
#pragma unroll
    for (int i = 0; i < 27; ++i) F.in[i] = args.in[i];
    for (int u = F.tid; u < 1024 / 4; u += NTHR) ((LAS unsigned*)(F.lds + LDSCTL_OFF))[u] = 0u;
    __syncthreads();
}
template <int PH> __device__ __forceinline__ void run_phase(const Frame& F) {
    if constexpr (PH == 0) { p0_prologue(F); }
    if constexpr (PH == 1) {
#if I8_P1
        Gemm g{WSP(bf16, WS_ACT), WSP(bf16, WS_WIN), 512, nullptr, 0}; StaticOrder S; S.init(T, NIN, F.G, (int)blockIdx.x);
        EpiScaled<EpiIn> E{EpiIn{F.ws, (unsigned char*)F.out, (LAS float*)(F.lds + TAB_OFF)}, WSP(float, WS_SA1), WSP(float, WS_SBIN)};
        gemm_fast<EpiScaled<EpiIn>, StaticOrder, false, GF_ALIGN, GF_SP2, true>(F.lds, g, S, E);
#else
        Gemm g{WSP(bf16, WS_ACT), WSP(bf16, WS_WIN), 1024, nullptr, SKEW_K1024}; StaticOrder S; S.init(T, NIN, F.G, (int)blockIdx.x);
        EpiIn E{F.ws, (unsigned char*)F.out, (LAS float*)(F.lds + TAB_OFF)};
        GEMM_PHASE(EpiIn, StaticOrder, g, S, E);
#endif
    }
    if constexpr (PH == 2) {
#if I8_QKV
        { Gemm g{WSP(bf16, WS_CQ), WSP(bf16, WS_WUQ), 128, nullptr, 0, WSP(bf16, WS_CKVR), WSP(bf16, WS_WUKV), 128}; QKVOrder S; S.init(F.G, (int)blockIdx.x);
          EpiQKV8 E{F.ws, F.in[I_KN]};
          gemm_fast<EpiQKV8, QKVOrder, false, GF_ALIGN, GF_SP2, true, true>(F.lds, g, S, E); }
#elif MERGE_QKV
        { Gemm g{WSP(bf16, WS_CQ), WSP(bf16, WS_WUQ), 256, nullptr, 0, WSP(bf16, WS_CKVR), WSP(bf16, WS_WUKV), 256}; QKVOrder S; S.init(F.G, (int)blockIdx.x);
          EpiQKV E{EpiQ{WSP(bf16, WS_QM), WSP(float, WS_CQSS)}, EpiKV{WSP(bf16, WS_KH), WSP(bf16, WS_VH), WSP(float, WS_CKVSS), WSP(float, WS_KR), WSP(float, WS_ROPE), F.in[I_KN]}};
          gemm_fast<EpiQKV, QKVOrder, false, GF_ALIGN, GF_SP2, false, true>(F.lds, g, S, E); }
#else
        { Gemm g{WSP(bf16, WS_CQ), WSP(bf16, WS_WUQ), 256, nullptr, SKEW_K256}; StaticOrder S; S.init(T, 768, F.G, (int)blockIdx.x); EpiQ E{WSP(bf16, WS_QM), WSP(float, WS_CQSS)}; GEMM_PHASE(EpiQ, StaticOrder, g, S, E); }
        { Gemm g{WSP(bf16, WS_CKVR), WSP(bf16, WS_WUKV), 256, nullptr, SKEW_K256}; StaticOrder S; S.init(T, 1024, F.G, (int)blockIdx.x);
          EpiKV E{WSP(bf16, WS_KH), WSP(bf16, WS_VH), WSP(float, WS_CKVSS), WSP(float, WS_KR), WSP(float, WS_ROPE), F.in[I_KN]}; GEMM_PHASE(EpiKV, StaticOrder, g, S, E); }
#endif
#ifdef PROBE_QKV2
        __syncthreads();
        { Gemm g{WSP(bf16, WS_CQ), WSP(bf16, WS_WUQ), 256, nullptr, SKEW_K256}; StaticOrder S; S.init(T, 768, F.G, (int)blockIdx.x); EpiQ E{WSP(bf16, WS_QM), WSP(float, WS_CQSS)}; GEMM_PHASE(EpiQ, StaticOrder, g, S, E); }
        { Gemm g{WSP(bf16, WS_CKVR), WSP(bf16, WS_WUKV), 256, nullptr, SKEW_K256}; StaticOrder S; S.init(T, 1024, F.G, (int)blockIdx.x);
          EpiKV E{WSP(bf16, WS_KH), WSP(bf16, WS_VH), WSP(float, WS_CKVSS), WSP(float, WS_KR), WSP(float, WS_ROPE), F.in[I_KN]}; GEMM_PHASE(EpiKV, StaticOrder, g, S, E); }
#endif
        HGRN_PHASE(F);
#ifdef PROBE_HGRN2
        __syncthreads(); HGRN_PHASE(F);
#endif
    }
    if constexpr (PH == 3) {
#if STAGGER_CONV
        if (!STAGGER_OA) oa_pass(F);
        const bf16* QM = WSP(bf16, WS_QM); const bf16* KH = WSP(bf16, WS_KH); const bf16* VH = WSP(bf16, WS_VH); bf16* OM = DOP(bf16, DO_OM);
        int it = 0; bool side_done = false;
        for (int item = F.vcu; item < NB * MH * 8; item += F.G, ++it) {
            if (it == (F.vcu & 3)) { side_done = true; __syncthreads(); if (STAGGER_OA) oa_pass(F); conv13_db(F); conv_w2t_strips(F); __syncthreads();
#ifdef PROBE_CONV2
                conv13_db(F); conv_w2t_strips(F); __syncthreads();
#endif
            }
            const int qb = item & 7, h = (item >> 3) & 7, b = item >> 6;
            att::attn_unit(QM, KH, VH, OM, WSP(float, WS_ROPE), F.in[I_QN], b * SEQ + qb * 256, b * SEQ, h, (char*)F.gl, F.in[I_KN]);
        }
        if (!side_done) { __syncthreads(); if (STAGGER_OA) oa_pass(F); conv13_db(F); conv_w2t_strips(F); }
#else
        oa_pass(F); ATTN_PHASE(F);
#endif
    }
    if constexpr (PH == 4) {
        Gemm g{DOP(bf16, DO_OA), WSP(bf16, WS_WOAB), 512, nullptr, SKEW_K512}; PairOrder S; S.init(F.G, (int)blockIdx.x); EpiMerge E{WSP(bf16, WS_ACT), WSP(bf16, WS_GA), WSP(bf16, WS_GB)};
        GEMM_PHASE(EpiMerge, PairOrder, g, S, E);
    }
    if constexpr (PH == 5) {
        Gemm g{WSP(bf16, WS_ACT), WSP(bf16, WS_WOUT), 1024, nullptr, SKEW_K1024}; StaticOrder S; S.init(T, D, F.G, (int)blockIdx.x); EpiX2 E{F.in[I_X], DOP(bf16, DO_X2B), WSP(float, WS_XMAX)};
        GEMM_PHASE(EpiX2, StaticOrder, g, S, E);
    }
    if constexpr (PH == 6) { ROUTE_PHASE(F); __syncthreads();
#if !STAGGER_CONV
#if I8_P7
        conv8_mat<M_W13>(F, F.ws + WS_W13, WSP(float, WS_SB13), 0);
#else
        conv_mat<M_W13>(F);
#endif
        conv_mat<M_W2T>(F);
#endif
    }
    if constexpr (PH == 7) {
        moe_build_table(F);
#if I8_P7
        Gemm g{WSP(bf16, WS_ACT), WSP(bf16, WS_W13), 512, WSP(int, WS_LIST), 0}; MoeOrder S{(const LAS int*)(F.lds + TAB_OFF), 2, F.G, (int)blockIdx.x};
        EpiScaled<EpiUp, false> E{EpiUp{WSP(bf16, WS_H1), WSP(int, WS_LIST), WSP(float, WS_RS2)}, nullptr, WSP(float, WS_SB13)};
        gemm_fast<EpiScaled<EpiUp, false>, MoeOrder, true, GF_ALIGN, GF_SP2, true>(F.lds, g, S, E);
#else
        Gemm g{DOP(bf16, DO_X2B), WSP(bf16, WS_W13), 1024, WSP(int, WS_LIST), SKEW_K1024}; MoeOrder S{(const LAS int*)(F.lds + TAB_OFF), 2, F.G, (int)blockIdx.x}; EpiUp E{WSP(bf16, WS_H1), WSP(int, WS_LIST), WSP(float, WS_RS2)};
        GEMM_PHASE_GATHER(EpiUp, MoeOrder, g, S, E);
#endif
    }
    if constexpr (PH == 8) {
#if N_LAUNCHES != 1
        moe_build_table(F);
#endif
        Gemm g{WSP(bf16, WS_H1), WSP(bf16, WS_W2T), 256, nullptr, SKEW_K256}; MoeOrder S{(const LAS int*)(F.lds + TAB_OFF), 4, F.G, (int)blockIdx.x}; EpiDown E{WSP(bf16, WS_Y0), WSP(bf16, WS_Y1), WSP(int, WS_LIST), WSP(float, WS_EW)};
        GEMM_PHASE(EpiDown, MoeOrder, g, S, E);
    }
    if constexpr (PH == 9) {
#if !FUSE_PROJ
        Gemm g{WSP(bf16, WS_PB), WSP(bf16, WS_WPP), 256, nullptr, SKEW_K256}; StaticOrder S; S.init(T, D, F.G, (int)blockIdx.x); EpiProj E{WSP(bf16, WS_PROJ)};
        GEMM_PHASE(EpiProj, StaticOrder, g, S, E);
#endif
        x3_pass(F);
    }
    if constexpr (PH == 10) {
#if FUSE_PROJ && GATE_FIRST
        Gemm g{WSP(bf16, WS_ACT), WSP(bf16, WS_WPG), 512, nullptr, 0, WSP(bf16, WS_PB), WSP(bf16, WS_WPP), 128}; ProjGateOrder S; S.init(F.G, (int)blockIdx.x);
        EpiGateProj E{F.out, WSP(bf16, WS_X3B), F.ws + WS_PROJ + (size_t)blockIdx.x * 65536, WSP(float, WS_SA3), WSP(float, WS_SBPG), WSP(float, WS_SAP), WSP(float, WS_SBPP)};
        gemm_fast<EpiGateProj, ProjGateOrder, false, GF_ALIGN, GF_SP2, true, true>(F.lds, g, S, E);
#elif FUSE_PROJ
        Gemm g{WSP(bf16, WS_PB), WSP(bf16, WS_WPP), 128, nullptr, 0, WSP(bf16, WS_ACT), WSP(bf16, WS_WPG), 512}; ProjGateOrder S; S.init(F.G, (int)blockIdx.x);
        EpiProjGate E{F.out, WSP(bf16, WS_X3B), F.ws + WS_PROJ + (size_t)blockIdx.x * 131072, WSP(float, WS_SA3), WSP(float, WS_SBPG), WSP(float, WS_SAP), WSP(float, WS_SBPP)};
        gemm_fast<EpiProjGate, ProjGateOrder, false, GF_ALIGN, GF_SP2, true, true>(F.lds, g, S, E);
#elif I8_P10
        Gemm g{WSP(bf16, WS_ACT), WSP(bf16, WS_WPG), 512, nullptr, 0}; StaticOrder S; S.init(T, D, F.G, (int)blockIdx.x); EpiFinal8 E{F.out, WSP(bf16, WS_X3B), WSP(bf16, WS_PROJ), WSP(float, WS_SA3), WSP(float, WS_SBPG)};
        gemm_fast<EpiFinal8, StaticOrder, false, GF_ALIGN, GF_SP2, true>(F.lds, g, S, E);
#else
        Gemm g{WSP(bf16, WS_ACT), WSP(bf16, WS_WPG), 1024, nullptr, SKEW_K1024}; StaticOrder S; S.init(T, D, F.G, (int)blockIdx.x); EpiFinal E{F.out, WSP(bf16, WS_PROJ)};
        GEMM_PHASE(EpiFinal, StaticOrder, g, S, E);
#endif
    }
}

template <int PH> __global__ void __launch_bounds__(NTHR, 2) phase_kernel(Args args) {
    extern __shared__ __attribute__((aligned(16))) unsigned char lds[];
    Frame F; frame_init(F, args, lds);
    run_phase<PH>(F);
}
#if N_LAUNCHES == 1
__global__ void __launch_bounds__(NTHR, 2) mega(Args args) {
    extern __shared__ __attribute__((aligned(16))) unsigned char lds[];
    Frame F; frame_init(F, args, lds);
    XcdBarrier bar = xcd_barrier_post((unsigned*)(F.ctl + CW_BAR), F.MISC + 8);
#define PHASE(k) do { Frame Fk = F; int t_ = threadIdx.x; asm volatile("" : "+v"(t_)); Fk.tid = t_; Fk.lane = t_ & 63; Fk.wave = __builtin_amdgcn_readfirstlane(t_ >> 6); run_phase<k>(Fk); } while (0)
#define XBAR() xcd_barrier(bar)
    PHASE(0); XBAR();
    PHASE(1); XBAR();
    PHASE(2); XBAR();
    PHASE(3); XBAR();
    PHASE(4); XBAR();
    PHASE(5); XBAR();
    PHASE(6); XBAR();
    PHASE(7); XBAR();
    PHASE(8); XBAR();
    PHASE(9); XBAR();
    PHASE(10);
#undef PHASE
#undef XBAR
}
#endif
extern "C" void kernel_launch(void* const* d_in, const int* in_sizes, int n_in, void* d_out, int out_size, void* d_ws, size_t ws_size, hipStream_t stream) {
    static int grid = 0;
    if (grid == 0) {
        if (n_in != 27 || in_sizes[0] != T * D || out_size != T * D || ws_size < WS_END) { fprintf(stderr, "kernel_launch: unexpected shapes (n_in %d, in0 %d, out %d, ws %zu)\n", n_in, n_in > 0 ? in_sizes[0] : -1, out_size, ws_size); grid = -1; return; }
        int dev = 0, cus = 0;
        if (hipGetDevice(&dev) != hipSuccess || hipDeviceGetAttribute(&cus, hipDeviceAttributeMultiprocessorCount, dev) != hipSuccess) { grid = -1; return; }
#if N_LAUNCHES == 1
        if (hipFuncSetAttribute((const void*)mega, hipFuncAttributeMaxDynamicSharedMemorySize, LDS_BYTES) != hipSuccess) { fprintf(stderr, "kernel_launch: hipFuncSetAttribute failed\n"); grid = -1; return; }
#else
#define SETATTR(k) if (hipFuncSetAttribute((const void*)phase_kernel<k>, hipFuncAttributeMaxDynamicSharedMemorySize, LDS_BYTES) != hipSuccess) { fprintf(stderr, "kernel_launch: hipFuncSetAttribute failed\n"); grid = -1; return; }
        SETATTR(0) SETATTR(1) SETATTR(2) SETATTR(3) SETATTR(4) SETATTR(5) SETATTR(6) SETATTR(7) SETATTR(8) SETATTR(9) SETATTR(10)
#endif
        grid = cus;
    }
    if (grid < 0) return;
    (void)hipMemsetAsync((char*)d_ws + WS_CTL, 0, CTL_ZERO_BYTES, stream);
    Args a{};
    for (int i = 0; i < 27; ++i) a.in[i] = (const float*)d_in[i];
    a.out = (float*)d_out; a.ws = (unsigned char*)d_ws;
#if N_LAUNCHES == 1
    a.ph_lo = 0; a.ph_hi = NPHASE; a.use_bar = 1;
    hipLaunchKernelGGL(mega, dim3(grid), dim3(NTHR), LDS_BYTES, stream, a);
#else
#define LAUNCH_PH(k) hipLaunchKernelGGL(phase_kernel<k>, dim3(grid), dim3(NTHR), LDS_BYTES, stream, a)
#ifndef LAST_PHASE
#define LAST_PHASE 10
#endif
    LAUNCH_PH(0); LAUNCH_PH(1); LAUNCH_PH(2); LAUNCH_PH(3); LAUNCH_PH(4); LAUNCH_PH(5);
    if (LAST_PHASE >= 6) { LAUNCH_PH(6); } if (LAST_PHASE >= 7) { LAUNCH_PH(7); } if (LAST_PHASE >= 8) { LAUNCH_PH(8); } if (LAST_PHASE >= 9) { LAUNCH_PH(9); } if (LAST_PHASE >= 10) { LAUNCH_PH(10); }
#endif
    const hipError_t le = hipPeekAtLastError();
    if (le != hipSuccess) fprintf(stderr, "kernel_launch: launch failed: %s\n", hipGetErrorName(le));
}
```

```cpp
#define N_LAUNCHES 1
#define NAIVE_MOE 0
#define GEMM_PHASE(EPI, SCHED, g, S, E) gemm_fast<EPI, SCHED, false>(F.lds, g, S, E)
#define GEMM_PHASE_GATHER(EPI, SCHED, g, S, E) gemm_fast<EPI, SCHED, true>(F.lds, g, S, E)
#define HGRN_PHASE(F) hgrn_fast3(F)
#define ATTN_PHASE(F) attn_fast(F)
#define ROUTE_PHASE(F) route_fast<false>(F)
#define SKEW_K1024 0
#define SKEW_K512 0
#define SKEW_K256 0
#define I8_P10 1
#define I8_P1 1
#define I8_P7 1
#define FUSE_PROJ 1
#define STAGGER_CONV 1
#define MERGE_QKV 1
#define GATE_U8 1
#define GATE_FIRST 1
#include <hip/hip_runtime.h>
#include <cstdio>
#include <cstdint>

#define GAS __attribute__((address_space(1)))
#define LAS __attribute__((address_space(3)))
typedef unsigned short bf16;
typedef unsigned v4u __attribute__((ext_vector_type(4)));
typedef unsigned v2u __attribute__((ext_vector_type(2)));
typedef float f32x4 __attribute__((ext_vector_type(4)));
typedef float f32x2 __attribute__((ext_vector_type(2)));
typedef short bf16x8 __attribute__((ext_vector_type(8)));
typedef GAS unsigned gu32;
#define RLX_AGENT __ATOMIC_RELAXED, __HIP_MEMORY_SCOPE_AGENT
#define LDS_WAIT() asm volatile("s_waitcnt lgkmcnt(0)" ::: "memory")
#define VM_WAIT() asm volatile("s_waitcnt vmcnt(0)" ::: "memory")

constexpr int NB = 16, SEQ = 2048, T = NB * SEQ, D = 1024;
constexpr int HGH = 4, HGK = 128, HGV = 128, HGF = 512, CHUNK = 64, NCHUNK = T / CHUNK;
constexpr int MH = 8, NOPE = 64, ROPE = 32, QK = 96, VD = 64, QR = 256, KVR = 128;
constexpr int NG = 8, EPG = 8, NE = 64, DE = 256, PLE = 256;
constexpr int DIN = 5024, NIN = 5120;
constexpr float EPS = 1e-6f;
constexpr int NWAVES = 8, NTHR = 512;

__device__ __forceinline__ unsigned f2bf(float f) { unsigned u = __builtin_bit_cast(unsigned, f); return (u + 0x7fffu + ((u >> 16) & 1u)) >> 16; }
typedef __bf16 bf16pair_t __attribute__((ext_vector_type(2)));
__device__ __forceinline__ unsigned pk2(float lo, float hi) { const f32x2 v = {lo, hi}; return __builtin_bit_cast(unsigned, __builtin_convertvector(v, bf16pair_t)); }
__device__ __forceinline__ float bf2f(unsigned b) { return __builtin_bit_cast(float, b << 16); }
__device__ __forceinline__ float bflo(unsigned w) { return __builtin_bit_cast(float, w << 16); }
__device__ __forceinline__ float bfhi(unsigned w) { return __builtin_bit_cast(float, w & 0xffff0000u); }
__device__ __forceinline__ float sigm(float x) { return __builtin_amdgcn_rcpf(1.0f + __expf(-x)); }
__device__ __forceinline__ float silu_(float x) { return x * __builtin_amdgcn_rcpf(1.0f + __expf(-x)); }
__device__ __forceinline__ float wave_sum(float v) {
#pragma unroll
    for (int o = 1; o < 64; o <<= 1) v += __shfl_xor(v, o);
    return v;
}
__device__ __forceinline__ float wave_max(float v) {
#pragma unroll
    for (int o = 1; o < 64; o <<= 1) v = fmaxf(v, __shfl_xor(v, o));
    return v;
}
__host__ __device__ __forceinline__ int perm8(int p) { const int r = p & 31, n = r >> 4, fq = (r >> 2) & 3, j = r & 3; return (p & ~31) + 8 * fq + 4 * n + j; }
__host__ __device__ __forceinline__ int iperm8(int l) { const int r = l & 31, fq = r >> 3, n = (r >> 2) & 1, j = r & 3; return (l & ~31) + 16 * n + 4 * fq + j; }

#ifndef STAGGER_CONV
#define STAGGER_CONV 0
#endif
#ifndef STAGGER_OA
#define STAGGER_OA 0
#endif
constexpr size_t MiB = 1u << 20;
constexpr size_t WS_CTL = 0, CTL_ZERO_BYTES = 65536;
constexpr size_t WS_LB = 1 * MiB;
constexpr size_t WS_WRH = 1 * MiB + 65536, WS_WRL = WS_WRH + 80 * 1024 * 2;
constexpr size_t WS_BR = WS_WRL + 80 * 1024 * 2;
constexpr size_t WS_SAQ = 1 * MiB + 512 * 1024, WS_SAKV = WS_SAQ + 128 * 1024, WS_SBUQ = 1 * MiB + 768 * 1024, WS_SBUKV = WS_SBUQ + 4096;
constexpr size_t WS_RS2 = 2 * MiB;
constexpr size_t WS_CQSS = 2 * MiB;
constexpr size_t WS_CKVSS = 2 * MiB + 512 * 1024;
constexpr size_t WS_SA3 = 3 * MiB, WS_SA1 = 3 * MiB + 128 * 1024;
constexpr size_t WS_SBPG = 3 * MiB + 256 * 1024, WS_SBIN = WS_SBPG + 4096, WS_SB13 = 3 * MiB + 512 * 1024;
constexpr size_t WS_SAP = 3 * MiB + 640 * 1024, WS_SBPP = 3 * MiB + 768 * 1024;
constexpr size_t WS_ROPE = 4 * MiB;
constexpr size_t WS_EREF = 8 * MiB, WS_ELAST = 10 * MiB;
constexpr size_t WS_EIDX = 12 * MiB;
constexpr size_t WS_EW = 12 * MiB + 512 * 1024;
constexpr size_t WS_KR = 13 * MiB;
constexpr size_t WS_XMAX = 13 * MiB;
constexpr size_t WS_LIST = 4 * MiB;
constexpr size_t WS_WIN = 17 * MiB, WS_WOAB = 27 * MiB, WS_WUQ = 29 * MiB, WS_WUKV = 29 * MiB + 512 * 1024, WS_WOUT = 30 * MiB, WS_WPG = 32 * MiB, WS_WPP = 34 * MiB;
constexpr size_t WS_ACT = 36 * MiB;
constexpr size_t WS_VA = 100 * MiB, WS_OG = 132 * MiB, WS_CQ = 164 * MiB, WS_CKVR = 180 * MiB, WS_GA = 196 * MiB, WS_GB = 260 * MiB;
constexpr size_t WS_QM = 324 * MiB, WS_KH = 372 * MiB, WS_VH = 420 * MiB, WS_PB = 452 * MiB, WS_END = 468 * MiB;
#if STAGGER_CONV
constexpr size_t WS_W13 = 100 * MiB, WS_W2T = 164 * MiB;
#else
constexpr size_t WS_W13 = 196 * MiB, WS_W2T = 260 * MiB;
#endif
constexpr size_t WS_H1 = 324 * MiB;
constexpr size_t WS_Y0 = 100 * MiB, WS_Y1 = 372 * MiB;
constexpr size_t WS_PROJ = 292 * MiB;
constexpr size_t DO_QF = 0, DO_KF = 32 * MiB, DO_QB = 64 * MiB, DO_KB = 96 * MiB, DO_OA = 0, DO_OM = 32 * MiB;
constexpr size_t DO_X2B = 64 * MiB;
constexpr size_t WS_X3B = 196 * MiB;
constexpr int CW_TMO = 0, CW_CODE = 1, CW_BAR = 4096, CW_CNT = 8192  ;
constexpr int MAXROWT = 320;
constexpr int RING_BYTES = 131072, LDSCTL_OFF = RING_BYTES, MISC_OFF = LDSCTL_OFF + 320, TAB_OFF = RING_BYTES + 1024, LDS_BYTES = 147456;
#define XB_TMO      128
#define XB_XCNT(j)  (256  + 64 * (j))
#define XB_XSUB(j)  (1280 + 64 * (j))
#define XB_XGEN(j)  (2304 + 64 * (j))
#define XB_TOP      3328
#define XB_TOPGEN   3392
#define XCD_BAR_WORDS 3456
#define XB_SPIN_CAP (1u << 18)

__device__ __forceinline__ unsigned xb_ld(unsigned* p)              { return __hip_atomic_load(p, __ATOMIC_RELAXED, __HIP_MEMORY_SCOPE_AGENT); }
__device__ __forceinline__ unsigned xb_add(unsigned* p, unsigned v) { return __hip_atomic_fetch_add(p, v, __ATOMIC_RELAXED, __HIP_MEMORY_SCOPE_AGENT); }
__device__ __forceinline__ unsigned xb_xcc_id() { return (unsigned)__builtin_amdgcn_s_getreg((3 << 11) | 20) & 0xFu; }
#define XB_SPIN(cond, bar) do { unsigned _sp = 0; while (cond) { __builtin_amdgcn_s_sleep(1); \
    if ((++_sp & 255u) == 0u) { if (xb_ld(&(bar)[XB_TMO])) break; if (_sp > XB_SPIN_CAP) { atomicAdd(&(bar)[XB_TMO], 1u); break; } } } } while (0)

struct XcdBarrier {
    unsigned* bar; unsigned x;
    volatile LAS unsigned* st;
};

__device__ __forceinline__ XcdBarrier xcd_barrier_post(unsigned* bar, volatile LAS unsigned* st) {
    XcdBarrier b; b.bar = bar; b.x = xb_xcc_id(); b.st = st;
    if (threadIdx.x == 0) (void)xb_add(&bar[XB_XCNT(b.x)], 1u);
    return b;
}
__device__ __forceinline__ void xcd_barrier_complete(unsigned* bar, unsigned x, unsigned& nloc, unsigned& nx) {
    const unsigned G = gridDim.x * gridDim.y * gridDim.z;
    unsigned sum, cnt, mine, sp = 0u;
    for (;;) {
        sum = 0u; cnt = 0u; mine = 0u;
#pragma unroll
        for (unsigned j = 0; j < 16; ++j) { const unsigned c = xb_ld(&bar[XB_XCNT(j)]); sum += c; cnt += (c > 0u) ? 1u : 0u; mine = (j == x) ? c : mine; }
        if (sum == G) break;
        __builtin_amdgcn_s_sleep(1);
        if ((++sp & 255u) == 0u) { if (xb_ld(&bar[XB_TMO])) break; if (sp > XB_SPIN_CAP) { atomicAdd(&bar[XB_TMO], 1u); break; } }
    }
    nloc = mine > 0u ? mine : 1u; nx = cnt > 0u ? cnt : 1u;
}

__device__ __forceinline__ void xcd_barrier(const XcdBarrier& b) {
    asm volatile("s_waitcnt vmcnt(0)" ::: "memory");
    __syncthreads();
    if (threadIdx.x == 0) {
        unsigned* bar = b.bar;
        __builtin_amdgcn_s_waitcnt(0);
        unsigned nloc = b.st[0], nx = b.st[1];
        if (nloc == 0u) { xcd_barrier_complete(bar, b.x, nloc, nx); b.st[0] = nloc; b.st[1] = nx; }
        const unsigned old = xb_add(&bar[XB_XSUB(b.x)], 1u);
        const unsigned gen = old / nloc;
        if (old + 1u == (gen + 1u) * nloc) {
            __builtin_amdgcn_fence(__ATOMIC_RELEASE, "agent");
            asm volatile("s_waitcnt vmcnt(0)" ::: "memory");
            const unsigned og = xb_add(&bar[XB_TOP], 1u);
            const unsigned tg = og / nx;
            if (og + 1u == (tg + 1u) * nx) xb_add(&bar[XB_TOPGEN], 1u);
            else XB_SPIN(xb_ld(&bar[XB_TOPGEN]) == tg, bar);
            __builtin_amdgcn_fence(__ATOMIC_ACQUIRE, "agent");
            xb_add(&bar[XB_XGEN(b.x)], 1u);
            asm volatile("s_waitcnt vmcnt(0)" ::: "memory");
        } else {
            XB_SPIN(xb_ld(&bar[XB_XGEN(b.x)]) == gen, bar);
            __builtin_amdgcn_fence(__ATOMIC_ACQUIRE, "agent");
            asm volatile("s_waitcnt vmcnt(0)" ::: "memory");
        }
    }
    __syncthreads();
}
struct Unit { int pm, pn, lbase, nvalid, kind; };
struct Gemm { const bf16* A; const bf16* Bt; int K; const int* list; int skew; const bf16* A2; const bf16* Bt2; int K2; };
typedef __bf16 bf16x2_t __attribute__((ext_vector_type(2)));
__device__ __forceinline__ float dot2bf(unsigned a, unsigned b, float c) { return __builtin_amdgcn_fdot2_f32_bf16(__builtin_bit_cast(bf16x2_t, a), __builtin_bit_cast(bf16x2_t, b), c, false); }

#ifndef I8_P10
#define I8_P10 0
#endif
#ifndef I8_P1
#define I8_P1 0
#endif
#ifndef I8_P7
#define I8_P7 0
#endif
#ifndef I8_QKV
#define I8_QKV 0
#endif
#ifndef MERGE_QKV
#define MERGE_QKV 0
#endif
#ifndef GATE_U8
#define GATE_U8 0
#endif
#ifndef GATE_FIRST
#define GATE_FIRST 0
#endif
#ifndef FUSE_PROJ
#define FUSE_PROJ 0
#endif
typedef int i32x4 __attribute__((ext_vector_type(4)));
template <bool I8> struct AccSel { typedef f32x4 type; };
template <> struct AccSel<true> { typedef i32x4 type; };
constexpr int NXCD = 8, WGM = 8;
struct StaticOrder {
    int nM, nN, nwg, G, c;
    __device__ void init(int M, int N, int G_, int c_) { nM = M / 256; nN = N / 256; nwg = nM * nN; G = G_; c = c_; }
    __device__ __forceinline__ bool next(int i, Unit& u) const {
        const long L = (long)i * G + c; if (L >= nwg) return false;
        int wgid = (int)L; { const int q = nwg / NXCD, r = nwg % NXCD, xcd = wgid % NXCD, off = wgid / NXCD; wgid = (xcd < r ? xcd * (q + 1) : r * (q + 1) + (xcd - r) * q) + off; }
        const int nig = WGM * nN, gid = wgid / nig, fm = gid * WGM, gsz = (nM - fm) < WGM ? (nM - fm) : WGM;
        u.pm = fm + ((wgid % nig) % gsz); u.pn = (wgid % nig) / gsz; u.lbase = 0; u.nvalid = 256; u.kind = 0; return true;
    }
};
struct PairOrder {
    StaticOrder so;
    __device__ void init(int G_, int c_) { so.init(T, D, G_, c_); }
    __device__ __forceinline__ bool next(int i, Unit& u) const { if (!so.next(i >> 1, u)) return false; if (i & 1) { u.pm += T / 256; u.pn += D / 256; } return true; }
};
struct ProjGateOrder {
    StaticOrder so;
    __device__ void init(int G_, int c_) { so.init(T, D, G_, c_); }
    __device__ __forceinline__ bool next(int i, Unit& u) const { if (!so.next(i >> 1, u)) return false; u.kind = i & 1; return true; }
};
struct QKVOrder {
    int G, c;
    __device__ void init(int G_, int c_) { G = G_; c = c_; }
    __device__ __forceinline__ bool next(int i, Unit& u) const {
        constexpr int NQ = (T / 256) * 3, NKV = (T / 256) * 4;
        const int L = i * G + c; if (L >= NQ + NKV) return false;
        StaticOrder so;
        if (L < NQ) { so.init(T, 768, 1, 0); so.next(L, u); u.kind = 0; } else { so.init(T, 1024, 1, 0); so.next(L - NQ, u); u.kind = 1; }
        return true;
    }
};
struct MoeOrder {
    const LAS int* tab; int npn, G, c;
    __device__ __forceinline__ bool next(int i, Unit& u) const {
        const int L = i * G + c; const int nt = tab[0]; if (L >= nt * npn) return false;
        const int rt = L / npn, pl = L - rt * npn; const int e = tab[16 + 4 * rt];
        u.pm = rt; u.pn = e * npn + pl; u.lbase = tab[16 + 4 * rt + 1]; u.nvalid = tab[16 + 4 * rt + 2]; u.kind = 0; return true;
    }
};

constexpr int BM = 256, BK = 64, HALF = 128, HTB = HALF * BK * 2, STAGE_BYTES = 8 * HTB;
__host__ __device__ __forceinline__ int lds_byte(int r, int c) { const int st = (r >> 4) * 2 + (c >> 5), rr = r & 15, cc = c & 31, ob = rr * 64 + cc * 2; return st * 1024 + (ob ^ (((ob >> 9) & 1) << 5)); }
__host__ __device__ __forceinline__ void stage_rc(int b, int& R, int& C) { const int st = b / 1024, sb = b % 1024, swz = sb ^ (((sb >> 9) & 1) << 5); R = (st >> 1) * 16 + swz / 64; C = (st & 1) * 32 + (swz % 64) / 2; }
#ifndef GF_SP2
#define GF_SP2 true
#endif
#ifndef GF_ALIGN
#define GF_ALIGN true
#endif
template <class Epi, class Sched, bool GATHER = false, bool ALIGN_EPI = GF_ALIGN, bool SP2 = GF_SP2, bool I8 = false, bool DUAL = false>
__device__ __forceinline__ void gemm_fast(LAS unsigned char* lds, const Gemm g, const Sched& S, const Epi& E) {
    int tid_ = threadIdx.x; asm volatile("" : "+v"(tid_));
    const int tid = tid_, wid = __builtin_amdgcn_readfirstlane(tid >> 6), lane = tid & 63, wr = wid >> 2, wc = wid & 3, fr = lane & 15, fq = lane >> 4;
    static_assert(!(DUAL && (GATHER || !SP2)), "DUAL: plain A rows, SP2 schedule only");
    const int K = g.K;
#define PG8_UK(u) ((DUAL && (u).kind) ? g.K2 : g.K)
    unsigned v0[2], v1[2], nv0[2], nv1[2], voffB[2]; int sR[2], sC[2];
#pragma unroll
    for (int i = 0; i < 2; ++i) { stage_rc(tid * 16 + i * 8192, sR[i], sC[i]); voffB[i] = (unsigned)(sR[i] * K + sC[i]) * 2u; }
#define PG8_AOFF(u, o0, o1) do { _Pragma("unroll") for (int _i = 0; _i < 2; ++_i) { \
        if constexpr (GATHER) { const int r0_ = sR[_i] < (u).nvalid ? sR[_i] : (u).nvalid - 1, r1_ = (128 + sR[_i]) < (u).nvalid ? 128 + sR[_i] : (u).nvalid - 1; \
            o0[_i] = ((unsigned)(g.list[(u).lbase + r0_] >> 1) * (unsigned)K + (unsigned)sC[_i]) * 2u; o1[_i] = ((unsigned)(g.list[(u).lbase + r1_] >> 1) * (unsigned)K + (unsigned)sC[_i]) * 2u; } \
        else { const int K_ = PG8_UK(u); o0[_i] = (unsigned)(sR[_i] * K_ + sC[_i]) * 2u; o1[_i] = o0[_i] + (unsigned)(HALF * K_ * 2); } } } while (0)
    const size_t kstep = (size_t)(BK * 2);
    size_t hstep = (size_t)HALF * K * 2;
    const size_t tstep = 2 * hstep;
    size_t nhstep = hstep; int nt = K / BK, nnt = nt;
    const unsigned ldsw = (unsigned)wid * 1024u;
    const int aoff = lds_byte(wr * 64 + fr, fq * 8), boff = lds_byte(wc * 32 + fr, fq * 8);
#define PG8_SA(b, h) (((b) * 2 + (h)) * HTB)
#define PG8_SB(b, h) ((4 + (b) * 2 + (h)) * HTB)
#define PG8_STAGE(bufoff, gbase, voff) do { _Pragma("unroll") for (int _i = 0; _i < 2; ++_i) \
        __builtin_amdgcn_global_load_lds((const unsigned*)((const char*)(gbase) + (voff)[_i]), (LAS unsigned*)(lds + (bufoff) + ldsw + _i * 8192), 16, 0, 0); } while (0)
#define PG8_LDA(dst, b, h) do { _Pragma("unroll") for (int m = 0; m < 4; ++m) _Pragma("unroll") for (int k = 0; k < 2; ++k) dst[m][k] = *(const LAS bf16x8*)(lds + PG8_SA(b, h) + aoff + m * 2048 + k * 1024); } while (0)
#define PG8_LDB(dst, b, h) do { _Pragma("unroll") for (int n = 0; n < 2; ++n) _Pragma("unroll") for (int k = 0; k < 2; ++k) dst[n][k] = *(const LAS bf16x8*)(lds + PG8_SB(b, h) + boff + n * 2048 + k * 1024); } while (0)
#define PG8_MMA(ai, bj, At, Bt) do { __builtin_amdgcn_s_setprio(1); _Pragma("unroll") for (int m = 0; m < 4; ++m) _Pragma("unroll") for (int n = 0; n < 2; ++n) _Pragma("unroll") for (int k = 0; k < 2; ++k) \
        { if constexpr (I8) acc[ai][bj][m][n] = __builtin_amdgcn_mfma_i32_16x16x64_i8(__builtin_bit_cast(i32x4, Bt[n][k]), __builtin_bit_cast(i32x4, At[m][k]), acc[ai][bj][m][n], 0, 0, 0); \
          else acc[ai][bj][m][n] = __builtin_amdgcn_mfma_f32_16x16x32_bf16(Bt[n][k], At[m][k], acc[ai][bj][m][n], 0, 0, 0); } __builtin_amdgcn_s_setprio(0); } while (0)
#define PG8_WAIT_V(n) asm volatile("s_waitcnt vmcnt(" #n ")" ::: "memory")
#define PG8_WAIT_L(n) asm volatile("s_waitcnt lgkmcnt(" #n ")" ::: "memory")
#define PG8_BAR __builtin_amdgcn_s_barrier()
#define PG8_SCHED __builtin_amdgcn_sched_barrier(0)
    Unit cur, nxt; int ui = 0;
    if (!S.next(0, cur)) return;
    if (g.skew > 0) {
        const unsigned bx = blockIdx.x, idx = ((bx >> 3) & 31u) * 8u + (bx & 7u);
        const unsigned long long t0 = __builtin_amdgcn_s_memrealtime(); const unsigned long long d = ((unsigned long long)idx * (unsigned)g.skew) >> 8;
        while (__builtin_amdgcn_s_memrealtime() - t0 < d) __builtin_amdgcn_s_sleep(8);
    }
    typedef typename AccSel<I8>::type acc_t;
    acc_t acc[2][2][4][2];
#pragma unroll
    for (int a = 0; a < 2; ++a)
#pragma unroll
        for (int b = 0; b < 2; ++b)
#pragma unroll
            for (int m = 0; m < 4; ++m)
#pragma unroll
                for (int n = 0; n < 2; ++n) acc[a][b][m][n] = (acc_t){0, 0, 0, 0};
    bf16x8 At[4][2], B0[2][2], B1[2][2];
#define PG8_ABASE(u) (DUAL ? (const char*)g.A + ((u).kind ? (size_t)((const char*)g.A2 - (const char*)g.A) : (size_t)0) + (size_t)(u).pm * (size_t)(2 * HALF * 2) * PG8_UK(u) : (const char*)g.A + (GATHER ? (size_t)0 : (size_t)(u).pm * tstep))
#define PG8_BBASE(u) (DUAL ? (const char*)g.Bt + ((u).kind ? (size_t)((const char*)g.Bt2 - (const char*)g.Bt) : (size_t)0) + (size_t)(u).pn * (size_t)(2 * HALF * 2) * PG8_UK(u) : (const char*)g.Bt + (size_t)(u).pn * tstep)
    const char* cA = PG8_ABASE(cur); const char* cB = PG8_BBASE(cur);
    unsigned v0s = 0u, nv0s = 0u;
#define PG8_BASEOFF(u, o) do { int R_, C_; stage_rc(tid * 16, R_, C_); o = (unsigned)(R_ * PG8_UK(u) + C_) * 2u; } while (0)
    if constexpr (DUAL) { const int K_ = PG8_UK(cur); hstep = (size_t)HALF * K_ * 2; nt = K_ / BK; PG8_BASEOFF(cur, v0s);
    }
    else { PG8_AOFF(cur, v0, v1); }
    if constexpr (SP2 && DUAL) {
#define PG8_STAGE1(bufoff, gbase, o0_) do { unsigned t_[2] = {(o0_), (o0_) + (unsigned)(hstep >> 1)}; PG8_STAGE(bufoff, gbase, t_); } while (0)
        PG8_STAGE1(PG8_SB(0, 0), cB, v0s); PG8_STAGE1(PG8_SB(0, 1), cB + hstep, v0s); PG8_STAGE1(PG8_SA(0, 0), cA, v0s); PG8_STAGE1(PG8_SA(0, 1), cA + hstep, v0s);
        if (wr == 1) PG8_BAR;
        PG8_WAIT_V(2); PG8_BAR;
        PG8_STAGE1(PG8_SB(1, 0), cB + kstep, v0s); PG8_STAGE1(PG8_SA(1, 0), cA + kstep, v0s); PG8_STAGE1(PG8_SB(1, 1), cB + hstep + kstep, v0s);
        PG8_WAIT_V(6); PG8_BAR;
#undef PG8_STAGE1
    } else if constexpr (SP2) {
        PG8_STAGE(PG8_SB(0, 0), cB, voffB); PG8_STAGE(PG8_SB(0, 1), cB + hstep, voffB); PG8_STAGE(PG8_SA(0, 0), cA, v0); PG8_STAGE(PG8_SA(0, 1), cA, v1);
        if (wr == 1) PG8_BAR;
        PG8_WAIT_V(2); PG8_BAR;
        PG8_STAGE(PG8_SB(1, 0), cB + kstep, voffB); PG8_STAGE(PG8_SA(1, 0), cA + kstep, v0); PG8_STAGE(PG8_SB(1, 1), cB + hstep + kstep, voffB);
        PG8_WAIT_V(6); PG8_BAR;
    } else {
        PG8_STAGE(PG8_SB(0, 0), cB, voffB); PG8_STAGE(PG8_SA(0, 0), cA, v0); PG8_STAGE(PG8_SB(0, 1), cB + hstep, voffB); PG8_STAGE(PG8_SA(0, 1), cA, v1);
        if (wr == 1) PG8_BAR;
        PG8_WAIT_V(4); PG8_BAR;
        PG8_STAGE(PG8_SB(1, 0), cB + kstep, voffB); PG8_STAGE(PG8_SA(1, 0), cA + kstep, v0); PG8_STAGE(PG8_SB(1, 1), cB + hstep + kstep, voffB);
        PG8_WAIT_V(6); PG8_BAR;
    }
    for (;;) {
        const bool has_next = S.next(ui + 1, nxt);
        const char* nA = (has_next && !GATHER) ? PG8_ABASE(nxt) : cA; const char* nB = has_next ? PG8_BBASE(nxt) : cB;
        if constexpr (DUAL) { if (has_next) { const int K_ = PG8_UK(nxt); nhstep = (size_t)HALF * K_ * 2; nnt = K_ / BK; } else { nhstep = hstep; nnt = nt; } }
        if constexpr (DUAL) { if (has_next) { PG8_BASEOFF(nxt, nv0s); } else nv0s = v0s; }
        else { if (has_next) { PG8_AOFF(nxt, nv0, nv1); } else { _Pragma("unroll") for (int _i = 0; _i < 2; ++_i) { nv0[_i] = v0[_i]; nv1[_i] = v1[_i]; } } }
#pragma unroll 1
        for (int t = 0; t < nt; t += 2) {
            const bool last = (t == nt - 2);
            const char* a1 = cA + (size_t)(t + 1) * kstep;
            const char* a2 = last ? nA : cA + (size_t)(t + 2) * kstep; const char* b2 = last ? nB : cB + (size_t)(t + 2) * kstep;
            const char* a3 = a2 + kstep; const char* b3 = b2 + kstep;
            unsigned w0[2], w1[2];
#pragma unroll
            for (int _i = 0; _i < 2; ++_i) { if constexpr (DUAL) w0[_i] = (last ? nv0s : v0s) + (_i ? (unsigned)((last ? nhstep : hstep) >> 1) : 0u); else { w0[_i] = last ? nv0[_i] : v0[_i]; w1[_i] = last ? nv1[_i] : v1[_i]; } }
            unsigned wB[2], x1[2]; size_t hB = hstep;
            if constexpr (DUAL) { if (last) hB = nhstep; }
#pragma unroll
            for (int _i = 0; _i < 2; ++_i) { if constexpr (DUAL) { wB[_i] = w0[_i]; w1[_i] = w0[_i] + (unsigned)hB; x1[_i] = v0s + (unsigned)hstep + (_i ? (unsigned)(hstep >> 1) : 0u); } else { wB[_i] = voffB[_i]; x1[_i] = v1[_i]; } }
            if constexpr (SP2) {
            PG8_LDB(B0, 0, 0); PG8_LDB(B1, 0, 1); PG8_SCHED; PG8_LDA(At, 0, 0); PG8_STAGE(PG8_SA(1, 1), a1, x1);
            PG8_WAIT_V(8); PG8_WAIT_L(0); PG8_BAR; PG8_MMA(0, 0, At, B0); PG8_MMA(0, 1, At, B1); PG8_BAR; PG8_SCHED;
            PG8_LDA(At, 0, 1); PG8_STAGE(PG8_SB(0, 0), b2, wB); PG8_STAGE(PG8_SB(0, 1), b2 + hB, wB); PG8_STAGE(PG8_SA(0, 0), a2, w0);
            PG8_WAIT_V(8); PG8_WAIT_L(0); PG8_BAR; PG8_MMA(1, 0, At, B0); PG8_MMA(1, 1, At, B1); PG8_BAR; PG8_SCHED;
            PG8_LDB(B0, 1, 0); PG8_LDB(B1, 1, 1); PG8_SCHED; PG8_LDA(At, 1, 0); PG8_STAGE(PG8_SA(0, 1), a2, w1);
            PG8_WAIT_V(8); PG8_WAIT_L(0); PG8_BAR; PG8_MMA(0, 0, At, B0); PG8_MMA(0, 1, At, B1); PG8_BAR; PG8_SCHED;
            PG8_LDA(At, 1, 1); PG8_STAGE(PG8_SB(1, 0), b3, wB); PG8_STAGE(PG8_SB(1, 1), b3 + hB, wB); PG8_STAGE(PG8_SA(1, 0), a3, w0);
            PG8_WAIT_V(8); PG8_WAIT_L(0); PG8_BAR; PG8_MMA(1, 0, At, B0); PG8_MMA(1, 1, At, B1); PG8_BAR; PG8_SCHED;
            } else {
            PG8_LDB(B0, 0, 0); PG8_SCHED; PG8_LDA(At, 0, 0); PG8_STAGE(PG8_SA(1, 1), a1, v1);
            PG8_WAIT_L(8); PG8_BAR; PG8_WAIT_L(0); PG8_MMA(0, 0, At, B0); PG8_BAR; PG8_SCHED;
            PG8_LDB(B1, 0, 1); PG8_STAGE(PG8_SB(0, 0), b2, voffB);
            PG8_BAR; PG8_WAIT_L(0); PG8_MMA(0, 1, At, B1); PG8_BAR;
            PG8_LDA(At, 0, 1); PG8_STAGE(PG8_SA(0, 0), a2, w0);
            PG8_BAR; PG8_WAIT_L(0); PG8_MMA(1, 0, At, B0); PG8_BAR; PG8_SCHED;
            PG8_STAGE(PG8_SB(0, 1), b2 + hstep, voffB);
            PG8_WAIT_V(6); PG8_BAR; PG8_MMA(1, 1, At, B1); PG8_BAR;
            PG8_LDB(B0, 1, 0); PG8_SCHED; PG8_LDA(At, 1, 0); PG8_STAGE(PG8_SA(0, 1), a2, w1);
            PG8_WAIT_L(8); PG8_BAR; PG8_WAIT_L(0); PG8_MMA(0, 0, At, B0); PG8_BAR; PG8_SCHED;
            PG8_LDB(B1, 1, 1); PG8_STAGE(PG8_SB(1, 0), b3, voffB);
            PG8_BAR; PG8_WAIT_L(0); PG8_MMA(0, 1, At, B1); PG8_BAR;
            PG8_LDA(At, 1, 1); PG8_STAGE(PG8_SA(1, 0), a3, w0);
            PG8_BAR; PG8_WAIT_L(0); PG8_MMA(1, 0, At, B0); PG8_BAR; PG8_SCHED;
            PG8_STAGE(PG8_SB(1, 1), b3 + hstep, voffB);
            PG8_WAIT_V(6); PG8_BAR; PG8_MMA(1, 1, At, B1); PG8_BAR;
            }
        }
        if constexpr (ALIGN_EPI) { if (wr == 0) PG8_BAR; }
        E(acc, cur, wr, wc, fr, fq);
        if (!has_next) break;
#pragma unroll
        for (int a = 0; a < 2; ++a)
#pragma unroll
            for (int b = 0; b < 2; ++b)
#pragma unroll
                for (int m = 0; m < 4; ++m)
#pragma unroll
                    for (int n = 0; n < 2; ++n) acc[a][b][m][n] = (acc_t){0, 0, 0, 0};
        cur = nxt; cA = nA; cB = nB; ++ui;
#pragma unroll
        for (int _i = 0; _i < 2; ++_i) { if constexpr (!DUAL) { v0[_i] = nv0[_i]; v1[_i] = nv1[_i]; } }
        if constexpr (DUAL) { hstep = nhstep; nt = nnt; v0s = nv0s; }
        if constexpr (ALIGN_EPI) { if (wr == 1) PG8_BAR; }
    }
    PG8_WAIT_V(0);
    if constexpr (!ALIGN_EPI) { if (wr == 0) PG8_BAR; }
    PG8_BAR;
#undef PG8_AOFF
#undef PG8_BASEOFF
#undef PG8_UK
#undef PG8_ABASE
#undef PG8_BBASE
#undef PG8_SA
#undef PG8_SB
#undef PG8_STAGE
#undef PG8_LDA
#undef PG8_LDB
#undef PG8_MMA
#undef PG8_WAIT_V
#undef PG8_WAIT_L
#undef PG8_BAR
#undef PG8_SCHED
}
#ifdef NT_STORES
#define ST_V(ptr, val) __builtin_nontemporal_store((val), (ptr))
#else
#define ST_V(ptr, val) (*(ptr) = (val))
#endif
__device__ __forceinline__ void st8(bf16* p, f32x4 a, f32x4 b) { v4u w; w.x = pk2(a[0], a[1]); w.y = pk2(a[2], a[3]); w.z = pk2(b[0], b[1]); w.w = pk2(b[2], b[3]); ST_V((v4u*)p, w); }
__device__ __forceinline__ void st4(bf16* p, f32x4 a) { v2u w; w.x = pk2(a[0], a[1]); w.y = pk2(a[2], a[3]); ST_V((v2u*)p, w); }
__device__ __forceinline__ unsigned q8pack(float a, float b, float c, float d) {
    const int ia = (int)__builtin_rintf(a), ib = (int)__builtin_rintf(b), ic = (int)__builtin_rintf(c), id = (int)__builtin_rintf(d);
    return (unsigned)(ia & 255) | ((unsigned)(ib & 255) << 8) | ((unsigned)(ic & 255) << 16) | ((unsigned)id << 24);
}
__device__ __forceinline__ f32x4 ub4(unsigned w) { return (f32x4){(float)(w & 255u), (float)((w >> 8) & 255u), (float)((w >> 16) & 255u), (float)(w >> 24)} * (1.0f / 255.0f); }
__device__ __forceinline__ f32x4 up4(unsigned lo, unsigned hi) { return (f32x4){bflo(lo), bfhi(lo), bflo(hi), bfhi(hi)}; }
__device__ __forceinline__ float dot4(f32x4 a) { return (a[0] * a[0] + a[1] * a[1]) + (a[2] * a[2] + a[3] * a[3]); }
template <int CTRL> __device__ __forceinline__ float dppf(float v) { return __builtin_bit_cast(float, __builtin_amdgcn_update_dpp(0, __builtin_bit_cast(int, v), CTRL, 0xf, 0xf, true)); }
__device__ __forceinline__ float scan16(float v, int) { v += dppf<0x111>(v); v += dppf<0x112>(v); v += dppf<0x114>(v); v += dppf<0x118>(v); return v; }
__device__ __forceinline__ float bcast15(float v) { return dppf<0x15F>(v); }
__device__ __forceinline__ float bcast0(float v) { return dppf<0x150>(v); }

struct EpiIn {
    unsigned char *wsb, *dob; LAS float* xch;
#define EI_W(type, off) ((type*)(wsb + (off)))
#define EI_D(type, off) ((type*)(dob + (off)))
    __device__ __forceinline__ void hgrn(const f32x4 (&acc)[2][2][4][2], const Unit& u, int wr, int wc, int fr, int fq) const {
        const int hh = u.pn >> 1, cb = u.pn & 1;
        const int gch0 = hh * 128 + cb * 64 + wc * 16 + fq * 4;
        bf16* const QF = EI_D(bf16, DO_QF); bf16* const KF = EI_D(bf16, DO_KF); bf16* const QB = EI_D(bf16, DO_QB); bf16* const KB = EI_D(bf16, DO_KB); bf16* const VA = EI_W(bf16, WS_VA);
        float* const EREF = EI_W(float, WS_EREF); float* const ELAST = EI_W(float, WS_ELAST); const float* const LB = EI_W(float, WS_LB);
        const f32x4 lbf = *(const f32x4*)(LB + gch0), lbb = *(const f32x4*)(LB + 512 + gch0);
#pragma unroll
        for (int ai = 0; ai < 2; ++ai) {
            const int cidx = u.pm * 4 + ai * 2 + wr;
            const size_t off0 = (size_t)(u.pm * 256 + ai * 128 + wr * 64 + fr) * 512 + gch0;
#pragma unroll
            for (int m = 0; m < 4; ++m) st4(VA + off0 + (size_t)m * 16 * 512, acc[ai][1][m][1]);
            {
                f32x4 qo[4], ko[4];
#pragma unroll
                for (int j = 0; j < 4; ++j) {
                    float lf[4], kk[4];
#pragma unroll
                    for (int m = 0; m < 4; ++m) { const float z = fminf(fmaxf(acc[ai][0][m][1][j], -30.f), 30.f), e = __expf(-z), s = __builtin_amdgcn_rcpf(1.0f + e); kk[m] = (1.0f - lbf[j]) * e * s; lf[m] = __logf(lbf[j] + (1.0f - lbf[j]) * s); }
                    float G[4], carry = 0.f;
#pragma unroll
                    for (int m = 0; m < 4; ++m) { G[m] = scan16(lf[m], fr) + carry; carry = bcast15(G[m]); }
                    const float Gref = bcast15(G[1]);
#pragma unroll
                    for (int m = 0; m < 4; ++m) { qo[m][j] = silu_(acc[ai][0][m][0][j]) * __expf(fminf(G[m] - Gref, 80.f)); ko[m][j] = kk[m] * __expf(fminf(Gref - G[m], 80.f)); }
                    if (fr == 0) { EREF[(size_t)cidx * 512 + gch0 + j] = __expf(Gref); ELAST[(size_t)cidx * 512 + gch0 + j] = __expf(carry - Gref); }
                }
#pragma unroll
                for (int m = 0; m < 4; ++m) { st4(QF + off0 + (size_t)m * 16 * 512, qo[m]); st4(KF + off0 + (size_t)m * 16 * 512, ko[m]); }
                asm volatile("" ::: "memory");
            }
            {
                f32x4 qo[4], ko[4];
#pragma unroll
                for (int j = 0; j < 4; ++j) {
                    float lw[4], kk[4];
#pragma unroll
                    for (int m = 0; m < 4; ++m) { const float z = fminf(fmaxf(acc[ai][1][m][0][j], -30.f), 30.f), e = __expf(-z), s = __builtin_amdgcn_rcpf(1.0f + e); kk[m] = (1.0f - lbb[j]) * e * s; lw[m] = __logf(lbb[j] + (1.0f - lbb[j]) * s); }
                    float P[4], carry = 0.f;
#pragma unroll
                    for (int m = 0; m < 4; ++m) { P[m] = scan16(lw[m], fr) + carry; carry = bcast15(P[m]); }
                    float Gb[4];
#pragma unroll
                    for (int m = 0; m < 4; ++m) Gb[m] = carry - (P[m] - lw[m]);
                    const float Gbref = bcast0(Gb[2]);
#pragma unroll
                    for (int m = 0; m < 4; ++m) { qo[m][j] = silu_(acc[ai][0][m][0][j]) * __expf(fminf(Gb[m] - Gbref, 80.f)); ko[m][j] = kk[m] * __expf(fminf(Gbref - Gb[m], 80.f)); }
                    if (fr == 0) { EREF[(size_t)(NCHUNK + cidx) * 512 + gch0 + j] = __expf(Gbref); ELAST[(size_t)(NCHUNK + cidx) * 512 + gch0 + j] = __expf(carry - Gbref); }
                }
#pragma unroll
                for (int m = 0; m < 4; ++m) { st4(QB + off0 + (size_t)m * 16 * 512, qo[m]); st4(KB + off0 + (size_t)m * 16 * 512, ko[m]); }
                asm volatile("" ::: "memory");
            }
        }
    }
    __device__ __forceinline__ void operator()(const f32x4 (&acc)[2][2][4][2], const Unit& u, int wr, int wc, int fr, int fq) const {
        const int pn = u.pn, row0 = u.pm * 256 + wr * 64 + fr;
        if (pn < 8) { hgrn(acc, u, wr, wc, fr, fq); return; }
        bf16* const OG = EI_W(bf16, WS_OG); bf16* const CQ = EI_W(bf16, WS_CQ); bf16* const CKVR = EI_W(bf16, WS_CKVR); bf16* const GA = EI_W(bf16, WS_GA); bf16* const GB = EI_W(bf16, WS_GB);
        float* const CQSS = EI_W(float, WS_CQSS); float* const CKVSS = EI_W(float, WS_CKVSS); float* const KR = EI_W(float, WS_KR);
#if I8_QKV
        if (pn == 10 || pn == 11) {
            const bool isq = pn == 10; float ssv[2][4];
#pragma unroll
            for (int ai = 0; ai < 2; ++ai)
#pragma unroll
                for (int m = 0; m < 4; ++m) { const int row = row0 + ai * 128 + m * 16; float ss = 0.f, mx = 0.f;
#pragma unroll
                    for (int bj = 0; bj < 2; ++bj) { if (bj == 0 || isq) { const f32x4 a = acc[ai][bj][m][0], b = acc[ai][bj][m][1]; ss += dot4(a) + dot4(b);
#pragma unroll
                        for (int j = 0; j < 4; ++j) mx = fmaxf(mx, fmaxf(fabsf(a[j]), fabsf(b[j]))); } }
                    ss += __shfl_xor(ss, 16); ss += __shfl_xor(ss, 32); mx = fmaxf(mx, __shfl_xor(mx, 16)); mx = fmaxf(mx, __shfl_xor(mx, 32));
                    if (fq == 0) { (isq ? CQSS : CKVSS)[(size_t)row * 4 + wc] = ss; xch[(wr * 4 + wc) * 128 + ai * 64 + m * 16 + fr] = mx; }
                    if (!isq && wc == 0) { *(f32x4*)(KR + (size_t)row * 32 + 8 * fq) = acc[ai][1][m][0]; *(f32x4*)(KR + (size_t)row * 32 + 8 * fq + 4) = acc[ai][1][m][1]; } }
            asm volatile("s_waitcnt lgkmcnt(0)\n\ts_barrier" ::: "memory");
            unsigned char* const dst8 = wsb + (isq ? WS_CQ : WS_CKVR); float* const SAr = (float*)(wsb + (isq ? WS_SAQ : WS_SAKV));
#pragma unroll
            for (int ai = 0; ai < 2; ++ai)
#pragma unroll
                for (int m = 0; m < 4; ++m) { const int row = row0 + ai * 128 + m * 16; const int xi = ai * 64 + m * 16 + fr;
                    const float rm = fmaxf(fmaxf(xch[(wr * 4 + 0) * 128 + xi], xch[(wr * 4 + 1) * 128 + xi]), fmaxf(xch[(wr * 4 + 2) * 128 + xi], xch[(wr * 4 + 3) * 128 + xi]));
                    const float inv = rm > 0.f ? 127.0f / rm : 0.f; if (wc == 0 && fq == 0) SAr[row] = rm * (1.0f / 127.0f);
#pragma unroll
                    for (int bj = 0; bj < 2; ++bj) { if (bj == 0 || isq) { const f32x4 a = acc[ai][bj][m][0] * inv, b = acc[ai][bj][m][1] * inv; v2u o; o.x = q8pack(a[0], a[1], a[2], a[3]); o.y = q8pack(b[0], b[1], b[2], b[3]);
                        *(v2u*)(dst8 + (size_t)row * 256 + bj * 128 + wc * 32 + 8 * fq) = o; } } }
            return;
        }
#else
        if (pn == 10) {
#pragma unroll
            for (int ai = 0; ai < 2; ++ai)
#pragma unroll
                for (int m = 0; m < 4; ++m) { const int row = row0 + ai * 128 + m * 16; float ss = 0.f;
#pragma unroll
                    for (int bj = 0; bj < 2; ++bj) { const f32x4 a = acc[ai][bj][m][0], b = acc[ai][bj][m][1]; ss += dot4(a) + dot4(b); st8(CQ + (size_t)row * 256 + bj * 128 + wc * 32 + 8 * fq, a, b); }
                    ss += __shfl_xor(ss, 16); ss += __shfl_xor(ss, 32); if (fq == 0) CQSS[(size_t)row * 4 + wc] = ss; }
            return;
        }
        if (pn == 11) {
#pragma unroll
            for (int ai = 0; ai < 2; ++ai)
#pragma unroll
                for (int m = 0; m < 4; ++m) { const int row = row0 + ai * 128 + m * 16;
                    const f32x4 a0 = acc[ai][0][m][0], b0 = acc[ai][0][m][1], a1 = acc[ai][1][m][0], b1 = acc[ai][1][m][1];
                    float ss = dot4(a0) + dot4(b0); ss += __shfl_xor(ss, 16); ss += __shfl_xor(ss, 32); if (fq == 0) CKVSS[(size_t)row * 4 + wc] = ss;
                    st8(CKVR + (size_t)row * 256 + wc * 32 + 8 * fq, a0, b0); st8(CKVR + (size_t)row * 256 + 128 + wc * 32 + 8 * fq, a1, b1);
                    if (wc == 0) { *(f32x4*)(KR + (size_t)row * 32 + 8 * fq) = a1; *(f32x4*)(KR + (size_t)row * 32 + 8 * fq + 4) = b1; } }
            return;
        }
#endif
        const bool sil = pn < 10; const int ld = sil ? 512 : 1024, cb = (sil ? pn - 8 : (pn - 12) & 3) * 256;
        const size_t dsto = sil ? (size_t)0 : (pn < 16 ? (size_t)((unsigned char*)GA - (unsigned char*)OG) : (size_t)((unsigned char*)GB - (unsigned char*)OG));
        bf16* dst = (bf16*)((unsigned char*)OG + dsto);
#pragma unroll
        for (int ai = 0; ai < 2; ++ai)
#pragma unroll
            for (int m = 0; m < 4; ++m)
#pragma unroll
                for (int bj = 0; bj < 2; ++bj) { f32x4 a = acc[ai][bj][m][0], b = acc[ai][bj][m][1];
#pragma unroll
                    for (int j = 0; j < 4; ++j) { a[j] = sil ? silu_(a[j]) : sigm(a[j]); b[j] = sil ? silu_(b[j]) : sigm(b[j]); }
#if GATE_U8
                    if (!sil) { v2u o; o.x = q8pack(a[0] * 255.f, a[1] * 255.f, a[2] * 255.f, a[3] * 255.f); o.y = q8pack(b[0] * 255.f, b[1] * 255.f, b[2] * 255.f, b[3] * 255.f);
                        *(v2u*)((unsigned char*)dst + (size_t)(row0 + ai * 128 + m * 16) * 1024 + cb + bj * 128 + wc * 32 + 8 * fq) = o; }
                    else
#endif
                    st8(dst + (size_t)(row0 + ai * 128 + m * 16) * ld + cb + bj * 128 + wc * 32 + 8 * fq, a, b); }
    }
};

struct EpiQ {
    bf16* QM; const float* CQSS;
    __device__ __forceinline__ void operator()(const f32x4 (&acc)[2][2][4][2], const Unit& u, int wr, int wc, int fr, int fq) const {
        float rsv[2][4];
#pragma unroll
        for (int ai = 0; ai < 2; ++ai)
#pragma unroll
            for (int m = 0; m < 4; ++m) { const f32x4 s4 = *(const f32x4*)(CQSS + (size_t)(u.pm * 256 + ai * 128 + wr * 64 + m * 16 + fr) * 4); rsv[ai][m] = rsqrtf(((s4[0] + s4[1]) + (s4[2] + s4[3])) * (1.0f / 256.0f) + EPS); }
#pragma unroll
        for (int ai = 0; ai < 2; ++ai)
#pragma unroll
            for (int m = 0; m < 4; ++m) { const int row = u.pm * 256 + ai * 128 + wr * 64 + m * 16 + fr; const float rs = rsv[ai][m];
#pragma unroll
                for (int bj = 0; bj < 2; ++bj) st8(QM + (size_t)row * 768 + u.pn * 256 + bj * 128 + wc * 32 + 8 * fq, acc[ai][bj][m][0] * rs, acc[ai][bj][m][1] * rs); }
    }
};
struct EpiKV {
    bf16 *KH, *VH; const float *CKVSS, *KR, *ROPE_, *KN;
    __device__ __forceinline__ void operator()(const f32x4 (&acc)[2][2][4][2], const Unit& u, int wr, int wc, int fr, int fq) const {
        const int pn = u.pn, head = (pn & 1) * 4 + wc;
        float rsv[2][4];
#pragma unroll
        for (int ai = 0; ai < 2; ++ai)
#pragma unroll
            for (int m = 0; m < 4; ++m) { const f32x4 s4 = *(const f32x4*)(CKVSS + (size_t)(u.pm * 256 + ai * 128 + wr * 64 + m * 16 + fr) * 4); rsv[ai][m] = rsqrtf(((s4[0] + s4[1]) + (s4[2] + s4[3])) * (1.0f / 128.0f) + EPS); }
        if (pn >= 2) {
#pragma unroll
            for (int ai = 0; ai < 2; ++ai)
#pragma unroll
                for (int m = 0; m < 4; ++m) { const int row = u.pm * 256 + ai * 128 + wr * 64 + m * 16 + fr; const float rs = rsv[ai][m];
#pragma unroll
                    for (int bj = 0; bj < 2; ++bj) st8(VH + ((size_t)row * 8 + head) * 64 + bj * 32 + 8 * fq, acc[ai][bj][m][0] * rs, acc[ai][bj][m][1] * rs); }
            return;
        }
#pragma unroll
        for (int ai = 0; ai < 2; ++ai)
#pragma unroll
            for (int m = 0; m < 4; ++m) { const int row = u.pm * 256 + ai * 128 + wr * 64 + m * 16 + fr; const float rs = rsv[ai][m]; const size_t ro = (size_t)row * 32;
                const f32x4 x1 = *(const f32x4*)(KR + ro + 4 * fq), x2 = *(const f32x4*)(KR + ro + 16 + 4 * fq), cc = *(const f32x4*)(ROPE_ + ro + 4 * fq), sn = *(const f32x4*)(ROPE_ + ro + 16 + 4 * fq);
                float ss = 0.f;
#pragma unroll
                for (int bj = 0; bj < 2; ++bj)
#pragma unroll
                    for (int n = 0; n < 2; ++n) ss += dot4(acc[ai][bj][m][n]);
                ss = ss * rs * rs + dot4(x1) + dot4(x2);
                ss += __shfl_xor(ss, 16); ss += __shfl_xor(ss, 32);
                const float rk = rsqrtf(ss * (1.0f / 96.0f) + EPS), rr = rs * rk;
                bf16* kp = KH + ((size_t)row * 8 + head) * 96;
#pragma unroll
                for (int bj = 0; bj < 2; ++bj) st8(kp + bj * 32 + 8 * fq, acc[ai][bj][m][0] * rr * *(const f32x4*)(KN + bj * 32 + 8 * fq), acc[ai][bj][m][1] * rr * *(const f32x4*)(KN + bj * 32 + 8 * fq + 4));
                const f32x4 y1 = x1 * rk * *(const f32x4*)(KN + 64 + 4 * fq), y2 = x2 * rk * *(const f32x4*)(KN + 80 + 4 * fq);
                st4(kp + 64 + 4 * fq, y1 * cc - y2 * sn); st4(kp + 80 + 4 * fq, y2 * cc + y1 * sn);
                if (m & 1) asm volatile("" ::: "memory"); }
    }
};
struct EpiQKV {
    EpiQ q; EpiKV kv;
    __device__ __forceinline__ void operator()(const f32x4 (&acc)[2][2][4][2], const Unit& u, int wr, int wc, int fr, int fq) const { if (u.kind) kv(acc, u, wr, wc, fr, fq); else q(acc, u, wr, wc, fr, fq); }
};
struct EpiQKV8 {
    unsigned char* wsb; const float* KN;
    __device__ __forceinline__ void operator()(const i32x4 (&acc)[2][2][4][2], const Unit& u, int wr, int wc, int fr_in, int fq_in) const {
        int fr = fr_in, fq = fq_in; asm volatile("" : "+v"(fr), "+v"(fq));
        unsigned char* W = wsb; asm volatile("" : "+s"(W));
        const float* SA = (const float*)(W + (u.kind ? WS_SAKV : WS_SAQ)); const float* SB = (const float*)(W + (u.kind ? WS_SBUKV : WS_SBUQ));
        int lo_ = wc * 32 + 4 * fq, ro_ = wr * 64 + fr; asm volatile("" : "+v"(lo_), "+v"(ro_));
        const int lo = lo_, ro = ro_;
        f32x4 f[2][2][4][2]; f32x4 sb[2][2];
#pragma unroll
        for (int bj = 0; bj < 2; ++bj)
#pragma unroll
            for (int n = 0; n < 2; ++n) sb[bj][n] = *(const f32x4*)(SB + u.pn * 256 + bj * 128 + n * 16 + lo);
#pragma unroll
        for (int ai = 0; ai < 2; ++ai) { float sa[4];
#pragma unroll
            for (int m = 0; m < 4; ++m) sa[m] = SA[u.pm * 256 + ai * 128 + m * 16 + ro];
#pragma unroll
            for (int bj = 0; bj < 2; ++bj)
#pragma unroll
                for (int m = 0; m < 4; ++m)
#pragma unroll
                    for (int n = 0; n < 2; ++n) f[ai][bj][m][n] = __builtin_convertvector(acc[ai][bj][m][n], f32x4) * sb[bj][n] * sa[m]; }
        if (u.kind) { const EpiKV kv{(bf16*)(W + WS_KH), (bf16*)(W + WS_VH), (const float*)(W + WS_CKVSS), (const float*)(W + WS_KR), (const float*)(W + WS_ROPE), KN}; kv(f, u, wr, wc, fr, fq); }
        else { const EpiQ q{(bf16*)(W + WS_QM), (const float*)(W + WS_CQSS)}; q(f, u, wr, wc, fr, fq); }
    }
};
struct EpiMerge {
    bf16* MG; const bf16 *GA, *GB;
    __device__ __forceinline__ void operator()(const f32x4 (&acc)[2][2][4][2], const Unit& u, int wr, int wc, int fr, int fq) const {
        const bool which = u.pm >= T / 256; const int pm = u.pm - (which ? T / 256 : 0), pn = u.pn - (which ? D / 256 : 0);
        const bf16* Gt = (const bf16*)((const unsigned char*)GA + (which ? (size_t)((const unsigned char*)GB - (const unsigned char*)GA) : (size_t)0));
#pragma unroll
        for (int ai = 0; ai < 2; ++ai)
#pragma unroll
            for (int mp = 0; mp < 2; ++mp) {
                v4u gv[2][2], ov[2][2];
#pragma unroll
                for (int mm = 0; mm < 2; ++mm)
#pragma unroll
                    for (int bj = 0; bj < 2; ++bj) { const size_t off = (size_t)(pm * 256 + ai * 128 + wr * 64 + (2 * mp + mm) * 16 + fr) * 1024 + pn * 256 + bj * 128 + wc * 32 + 8 * fq;
#if GATE_U8
                        { const v2u g8 = *(const v2u*)((const unsigned char*)Gt + off); gv[mm][bj] = (v4u){g8.x, g8.y, 0u, 0u}; }
#else
                        gv[mm][bj] = *(const v4u*)(Gt + off);
#endif
                        ov[mm][bj] = which ? *(const v4u*)(MG + off) : (v4u){0u, 0u, 0u, 0u}; }
#pragma unroll
                for (int mm = 0; mm < 2; ++mm)
#pragma unroll
                    for (int bj = 0; bj < 2; ++bj) { const int m = 2 * mp + mm; const size_t off = (size_t)(pm * 256 + ai * 128 + wr * 64 + m * 16 + fr) * 1024 + pn * 256 + bj * 128 + wc * 32 + 8 * fq;
                        const v4u g = gv[mm][bj], o = ov[mm][bj];
#if GATE_U8
                        const f32x4 a = acc[ai][bj][m][0] * ub4(g.x) + up4(o.x, o.y), b = acc[ai][bj][m][1] * ub4(g.y) + up4(o.z, o.w);
#else
                        const f32x4 a = acc[ai][bj][m][0] * up4(g.x, g.y) + up4(o.x, o.y), b = acc[ai][bj][m][1] * up4(g.z, g.w) + up4(o.z, o.w);
#endif
                        st8(MG + off, a, b); }
                asm volatile("" ::: "memory"); }
    }
};
struct EpiX2 {
    const float* X; bf16* O; float* XM;
    __device__ __forceinline__ void operator()(const f32x4 (&acc)[2][2][4][2], const Unit& u, int wr, int wc, int fr, int fq) const {
#pragma unroll
        for (int ai = 0; ai < 2; ++ai)
#pragma unroll
            for (int mp = 0; mp < 2; ++mp) {
                f32x4 xv[2][2][2];
#pragma unroll
                for (int mm = 0; mm < 2; ++mm)
#pragma unroll
                    for (int bj = 0; bj < 2; ++bj) { const float* xp = X + (size_t)(u.pm * 256 + ai * 128 + wr * 64 + (2 * mp + mm) * 16 + fr) * 1024 + u.pn * 256 + bj * 128 + wc * 32 + 8 * fq;
                        xv[mm][bj][0] = *(const f32x4*)xp; xv[mm][bj][1] = *(const f32x4*)(xp + 4); }
#pragma unroll
                for (int mm = 0; mm < 2; ++mm)
#pragma unroll
                    for (int bj = 0; bj < 2; ++bj) { xv[mm][bj][0] += acc[ai][bj][2 * mp + mm][0]; xv[mm][bj][1] += acc[ai][bj][2 * mp + mm][1];
                        st8(O + (size_t)(u.pm * 256 + ai * 128 + wr * 64 + (2 * mp + mm) * 16 + fr) * 1024 + u.pn * 256 + bj * 128 + wc * 32 + 8 * fq, xv[mm][bj][0], xv[mm][bj][1]); }
#pragma unroll
                for (int mm = 0; mm < 2; ++mm) { float mx = 0.f;
#pragma unroll
                    for (int bj = 0; bj < 2; ++bj)
#pragma unroll
                        for (int n = 0; n < 2; ++n)
#pragma unroll
                            for (int j = 0; j < 4; ++j) mx = fmaxf(mx, fabsf(xv[mm][bj][n][j]));
                    mx = fmaxf(mx, __shfl_xor(mx, 16)); mx = fmaxf(mx, __shfl_xor(mx, 32));
                    if (fq == 0) XM[(size_t)(u.pm * 256 + ai * 128 + wr * 64 + (2 * mp + mm) * 16 + fr) * 16 + u.pn * 4 + wc] = mx; }
                asm volatile("" ::: "memory"); }
    }
};
struct EpiUp {
    bf16* H1; const int* LIST; const float* RS2;
    __device__ __forceinline__ void operator()(const f32x4 (&acc)[2][2][4][2], const Unit& u, int wr, int wc, int fr, int fq) const {
        const int pl = u.pn & 1; int tk[2][4]; float rsv[2][4];
#pragma unroll
        for (int ai = 0; ai < 2; ++ai)
#pragma unroll
            for (int m = 0; m < 4; ++m) { const int r = ai * 128 + wr * 64 + m * 16 + fr; tk[ai][m] = LIST[u.lbase + (r < u.nvalid ? r : u.nvalid - 1)] >> 1; }
#pragma unroll
        for (int ai = 0; ai < 2; ++ai)
#pragma unroll
            for (int m = 0; m < 4; ++m) rsv[ai][m] = RS2[tk[ai][m]];
#pragma unroll
        for (int ai = 0; ai < 2; ++ai)
#pragma unroll
            for (int m = 0; m < 4; ++m) { const int r = ai * 128 + wr * 64 + m * 16 + fr; const float rs = rsv[ai][m];
                f32x4 a = acc[ai][0][m][0] * rs, b = acc[ai][0][m][1] * rs;
#pragma unroll
                for (int j = 0; j < 4; ++j) { a[j] = silu_(a[j]) * (acc[ai][1][m][0][j] * rs); b[j] = silu_(b[j]) * (acc[ai][1][m][1][j] * rs); }
                st8(H1 + (size_t)(u.pm * 256 + r) * 256 + pl * 128 + wc * 32 + 8 * fq, a, b); }
    }
};
struct EpiDown {
    bf16 *Y0, *Y1; const int* LIST; const float* EW;
    __device__ __forceinline__ void operator()(const f32x4 (&acc)[2][2][4][2], const Unit& u, int wr, int wc, int fr, int fq) const {
        const int pl = u.pn & 3; int en[2][4]; float wv[2][4];
#pragma unroll
        for (int ai = 0; ai < 2; ++ai)
#pragma unroll
            for (int m = 0; m < 4; ++m) { const int r = ai * 128 + wr * 64 + m * 16 + fr; en[ai][m] = r < u.nvalid ? LIST[u.lbase + r] : -1; }
#pragma unroll
        for (int ai = 0; ai < 2; ++ai)
#pragma unroll
            for (int m = 0; m < 4; ++m) wv[ai][m] = en[ai][m] >= 0 ? EW[en[ai][m]] : 0.f;
#pragma unroll
        for (int ai = 0; ai < 2; ++ai)
#pragma unroll
            for (int m = 0; m < 4; ++m) { const int ent = en[ai][m]; const float w = wv[ai][m];
                if (ent >= 0) {
                    const unsigned eo = (unsigned)(ent >> 1) * 1024u + (unsigned)(pl * 256 + wc * 32 + 8 * fq) + ((ent & 1) ? (unsigned)(((unsigned char*)Y1 - (unsigned char*)Y0) / 2) : 0u);
#pragma unroll
                    for (int bj = 0; bj < 2; ++bj) st8(Y0 + eo + bj * 128, acc[ai][bj][m][0] * w, acc[ai][bj][m][1] * w); } }
    }
};
struct EpiProj {
    bf16* PR;
    __device__ __forceinline__ void operator()(const f32x4 (&acc)[2][2][4][2], const Unit& u, int wr, int wc, int fr, int fq) const {
#pragma unroll
        for (int ai = 0; ai < 2; ++ai)
#pragma unroll
            for (int m = 0; m < 4; ++m)
#pragma unroll
                for (int bj = 0; bj < 2; ++bj) st8(PR + (size_t)(u.pm * 256 + ai * 128 + wr * 64 + m * 16 + fr) * 1024 + u.pn * 256 + bj * 128 + wc * 32 + 8 * fq, acc[ai][bj][m][0], acc[ai][bj][m][1]);
    }
};
template <class Epi, bool ROWS = true> struct EpiScaled {
    Epi inner; const float* SA; const float* SB;
    __device__ __forceinline__ void operator()(const i32x4 (&acc)[2][2][4][2], const Unit& u, int wr, int wc, int fr, int fq) const {
        f32x4 f[2][2][4][2]; f32x4 sb[2][2];
#pragma unroll
        for (int bj = 0; bj < 2; ++bj)
#pragma unroll
            for (int n = 0; n < 2; ++n) sb[bj][n] = *(const f32x4*)(SB + u.pn * 256 + bj * 128 + wc * 32 + n * 16 + 4 * fq);
#pragma unroll
        for (int ai = 0; ai < 2; ++ai) { float sa[4];
#pragma unroll
            for (int m = 0; m < 4; ++m) sa[m] = ROWS ? SA[u.pm * 256 + ai * 128 + wr * 64 + m * 16 + fr] : 1.0f;
#pragma unroll
            for (int bj = 0; bj < 2; ++bj)
#pragma unroll
                for (int m = 0; m < 4; ++m)
#pragma unroll
                    for (int n = 0; n < 2; ++n) { f[ai][bj][m][n] = __builtin_convertvector(acc[ai][bj][m][n], f32x4) * sb[bj][n]; if constexpr (ROWS) f[ai][bj][m][n] *= sa[m]; } }
        inner(f, u, wr, wc, fr, fq);
    }
};
struct EpiGateProj {
    float* O; const bf16* X3; unsigned char* SCR; const float* SA3; const float* SBG; const float* SAP; const float* SBP;
    __device__ __forceinline__ void operator()(const i32x4 (&acc)[2][2][4][2], const Unit& u, int wr, int wc, int fr, int fq) const {
        int tid_ = (wr * 4 + wc) * 64 + fq * 16 + fr, lo_ = wc * 32 + 4 * fq, lc_ = wc * 32 + 8 * fq; asm volatile("" : "+v"(tid_), "+v"(lo_), "+v"(lc_));
        const int tid = tid_, lo = lo_, lc = lc_;
        f32x4 sb[2][2];
        { const float* SB = (const float*)((const unsigned char*)SBG + (u.kind ? (size_t)((const unsigned char*)SBP - (const unsigned char*)SBG) : (size_t)0));
#pragma unroll
        for (int bj = 0; bj < 2; ++bj)
#pragma unroll
            for (int n = 0; n < 2; ++n) sb[bj][n] = *(const f32x4*)(SB + u.pn * 256 + bj * 128 + n * 16 + lo); }
        if (u.kind == 0) {
#pragma unroll
            for (int ai = 0; ai < 2; ++ai) { float sa[4];
#pragma unroll
                for (int m = 0; m < 4; ++m) sa[m] = SA3[u.pm * 256 + ai * 128 + wr * 64 + m * 16 + fr];
#pragma unroll
                for (int bj = 0; bj < 2; ++bj)
#pragma unroll
                    for (int m = 0; m < 4; ++m) { f32x4 a = __builtin_convertvector(acc[ai][bj][m][0], f32x4) * sb[bj][0] * sa[m], b = __builtin_convertvector(acc[ai][bj][m][1], f32x4) * sb[bj][1] * sa[m];
#pragma unroll
                        for (int j = 0; j < 4; ++j) { a[j] = sigm(a[j]) * 255.f; b[j] = sigm(b[j]) * 255.f; }
                        v2u w; w.x = q8pack(a[0], a[1], a[2], a[3]); w.y = q8pack(b[0], b[1], b[2], b[3]);
                        *(v2u*)(SCR + (size_t)(((ai * 2 + bj) * 4 + m) * 512 + tid) * 8) = w; } }
        } else {
#pragma unroll
            for (int ai = 0; ai < 2; ++ai) {
                v4u xv[4][2]; v2u gv[4][2]; float sa[4];
#pragma unroll
                for (int m = 0; m < 4; ++m) { sa[m] = SAP[u.pm * 256 + ai * 128 + wr * 64 + m * 16 + fr];
#pragma unroll
                    for (int bj = 0; bj < 2; ++bj) { gv[m][bj] = *(const v2u*)(SCR + (size_t)(((ai * 2 + bj) * 4 + m) * 512 + tid) * 8);
                        xv[m][bj] = *(const v4u*)(X3 + (size_t)(u.pm * 256 + ai * 128 + wr * 64 + m * 16 + fr) * 1024 + u.pn * 256 + bj * 128 + lc); } }
#pragma unroll
                for (int m = 0; m < 4; ++m)
#pragma unroll
                    for (int bj = 0; bj < 2; ++bj) { float* op = O + (size_t)(u.pm * 256 + ai * 128 + wr * 64 + m * 16 + fr) * 1024 + u.pn * 256 + bj * 128 + lc;
                        const f32x4 p0 = __builtin_convertvector(acc[ai][bj][m][0], f32x4) * sb[bj][0] * sa[m], p1 = __builtin_convertvector(acc[ai][bj][m][1], f32x4) * sb[bj][1] * sa[m];
                        *(f32x4*)op = up4(xv[m][bj].x, xv[m][bj].y) + p0 * ub4(gv[m][bj].x); *(f32x4*)(op + 4) = up4(xv[m][bj].z, xv[m][bj].w) + p1 * ub4(gv[m][bj].y); }
                asm volatile("" ::: "memory"); }
        }
    }
};
struct EpiProjGate {
    float* O; const bf16* X3; unsigned char* SCR; const float* SA3; const float* SBG; const float* SAP; const float* SBP;
    __device__ __forceinline__ void operator()(const i32x4 (&acc)[2][2][4][2], const Unit& u, int wr, int wc, int fr, int fq) const {
        int tid_ = (wr * 4 + wc) * 64 + fq * 16 + fr, lo_ = wc * 32 + 4 * fq; asm volatile("" : "+v"(tid_), "+v"(lo_));
        const int tid = tid_, lo = lo_;
        f32x4 sb[2][2];
        { const float* SB = (const float*)((const unsigned char*)SBP + (u.kind ? (size_t)((const unsigned char*)SBG - (const unsigned char*)SBP) : (size_t)0));
#pragma unroll
        for (int bj = 0; bj < 2; ++bj)
#pragma unroll
            for (int n = 0; n < 2; ++n) sb[bj][n] = *(const f32x4*)(SB + u.pn * 256 + bj * 128 + n * 16 + lo); }
        if (u.kind == 0) {
#pragma unroll
            for (int ai = 0; ai < 2; ++ai) { float sa[4];
#pragma unroll
                for (int m = 0; m < 4; ++m) sa[m] = SAP[u.pm * 256 + ai * 128 + wr * 64 + m * 16 + fr];
#pragma unroll
                for (int bj = 0; bj < 2; ++bj)
#pragma unroll
                    for (int m = 0; m < 4; ++m) { const f32x4 a = __builtin_convertvector(acc[ai][bj][m][0], f32x4) * sb[bj][0] * sa[m], b = __builtin_convertvector(acc[ai][bj][m][1], f32x4) * sb[bj][1] * sa[m];
                        v4u w; w.x = pk2(a[0], a[1]); w.y = pk2(a[2], a[3]); w.z = pk2(b[0], b[1]); w.w = pk2(b[2], b[3]);
                        *(v4u*)(SCR + (size_t)(((ai * 2 + bj) * 4 + m) * 512 + tid) * 16) = w; } }
        } else {
#pragma unroll
            for (int ai = 0; ai < 2; ++ai)
#pragma unroll
                for (int mp = 0; mp < 2; ++mp) {
                    v2u xv[2][2][2]; v4u pv[2][2]; float sa[2];
#pragma unroll
                    for (int mm = 0; mm < 2; ++mm) { sa[mm] = SA3[u.pm * 256 + ai * 128 + wr * 64 + (2 * mp + mm) * 16 + fr];
#pragma unroll
                        for (int bj = 0; bj < 2; ++bj) { pv[mm][bj] = *(const v4u*)(SCR + (size_t)(((ai * 2 + bj) * 4 + 2 * mp + mm) * 512 + tid) * 16);
#pragma unroll
                            for (int n = 0; n < 2; ++n) xv[mm][bj][n] = *(const v2u*)(X3 + (size_t)(u.pm * 256 + ai * 128 + wr * 64 + (2 * mp + mm) * 16 + fr) * 1024 + u.pn * 256 + bj * 128 + n * 16 + lo); } }
#pragma unroll
                    for (int mm = 0; mm < 2; ++mm)
#pragma unroll
                        for (int bj = 0; bj < 2; ++bj)
#pragma unroll
                            for (int n = 0; n < 2; ++n) { const size_t off = (size_t)(u.pm * 256 + ai * 128 + wr * 64 + (2 * mp + mm) * 16 + fr) * 1024 + u.pn * 256 + bj * 128 + n * 16 + lo;
                                f32x4 g = __builtin_convertvector(acc[ai][bj][2 * mp + mm][n], f32x4) * sb[bj][n] * sa[mm];
#pragma unroll
                                for (int j = 0; j < 4; ++j) g[j] = sigm(g[j]);
                                const f32x4 pr = n ? up4(pv[mm][bj].z, pv[mm][bj].w) : up4(pv[mm][bj].x, pv[mm][bj].y);
                                *(f32x4*)(O + off) = up4(xv[mm][bj][n].x, xv[mm][bj][n].y) + pr * g; }
                    asm volatile("" ::: "memory"); }
        }
    }
};
struct EpiFinal8 {
    float* O; const bf16* X3; const bf16* PR; const float* SA; const float* SB;
    __device__ __forceinline__ void operator()(const i32x4 (&acc)[2][2][4][2], const Unit& u, int wr, int wc, int fr, int fq) const {
        f32x4 sb[2][2];
#pragma unroll
        for (int bj = 0; bj < 2; ++bj)
#pragma unroll
            for (int n = 0; n < 2; ++n) sb[bj][n] = *(const f32x4*)(SB + u.pn * 256 + bj * 128 + wc * 32 + n * 16 + 4 * fq);
#pragma unroll
        for (int ai = 0; ai < 2; ++ai)
#pragma unroll
            for (int mp = 0; mp < 2; ++mp) {
                v2u xv[2][2][2]; v2u pv[2][2][2]; float sa[2];
#pragma unroll
                for (int mm = 0; mm < 2; ++mm) { sa[mm] = SA[u.pm * 256 + ai * 128 + wr * 64 + (2 * mp + mm) * 16 + fr];
#pragma unroll
                    for (int bj = 0; bj < 2; ++bj)
#pragma unroll
                        for (int n = 0; n < 2; ++n) { const size_t off = (size_t)(u.pm * 256 + ai * 128 + wr * 64 + (2 * mp + mm) * 16 + fr) * 1024 + u.pn * 256 + bj * 128 + wc * 32 + n * 16 + 4 * fq;
                            xv[mm][bj][n] = *(const v2u*)(X3 + off); pv[mm][bj][n] = *(const v2u*)(PR + off); } }
#pragma unroll
                for (int mm = 0; mm < 2; ++mm)
#pragma unroll
                    for (int bj = 0; bj < 2; ++bj)
#pragma unroll
                        for (int n = 0; n < 2; ++n) { const size_t off = (size_t)(u.pm * 256 + ai * 128 + wr * 64 + (2 * mp + mm) * 16 + fr) * 1024 + u.pn * 256 + bj * 128 + wc * 32 + n * 16 + 4 * fq;
                            f32x4 g = __builtin_convertvector(acc[ai][bj][2 * mp + mm][n], f32x4) * sb[bj][n] * sa[mm];
#pragma unroll
                            for (int j = 0; j < 4; ++j) g[j] = sigm(g[j]);
                            *(f32x4*)(O + off) = up4(xv[mm][bj][n].x, xv[mm][bj][n].y) + up4(pv[mm][bj][n].x, pv[mm][bj][n].y) * g; }
                asm volatile("" ::: "memory"); }
    }
};
struct EpiFinal {
    float* O; const bf16* PR;
    __device__ __forceinline__ void operator()(const f32x4 (&acc)[2][2][4][2], const Unit& u, int wr, int wc, int fr, int fq) const {
#pragma unroll
        for (int ai = 0; ai < 2; ++ai)
#pragma unroll
            for (int mp = 0; mp < 2; ++mp) {
                f32x4 xv[2][2][2]; v2u pv[2][2][2];
#pragma unroll
                for (int mm = 0; mm < 2; ++mm)
#pragma unroll
                    for (int bj = 0; bj < 2; ++bj)
#pragma unroll
                        for (int n = 0; n < 2; ++n) { const size_t off = (size_t)(u.pm * 256 + ai * 128 + wr * 64 + (2 * mp + mm) * 16 + fr) * 1024 + u.pn * 256 + bj * 128 + wc * 32 + n * 16 + 4 * fq;
                            xv[mm][bj][n] = *(const f32x4*)(O + off); pv[mm][bj][n] = *(const v2u*)(PR + off); }
#pragma unroll
                for (int mm = 0; mm < 2; ++mm)
#pragma unroll
                    for (int bj = 0; bj < 2; ++bj)
#pragma unroll
                        for (int n = 0; n < 2; ++n) { const size_t off = (size_t)(u.pm * 256 + ai * 128 + wr * 64 + (2 * mp + mm) * 16 + fr) * 1024 + u.pn * 256 + bj * 128 + wc * 32 + n * 16 + 4 * fq;
                            f32x4 g = acc[ai][bj][2 * mp + mm][n];
#pragma unroll
                            for (int j = 0; j < 4; ++j) g[j] = sigm(g[j]);
                            *(f32x4*)(O + off) = xv[mm][bj][n] + up4(pv[mm][bj][n].x, pv[mm][bj][n].y) * g; }
                asm volatile("" ::: "memory"); }
    }
};

struct Frame {
    LAS unsigned char* lds; unsigned char* gl;
    volatile LAS unsigned* MISC; gu32* ctl;
    int tid, lane, wave, vcu, G;
    const float* in[27]; float* out; unsigned char* ws;
};
#define WSP(type, off) ((type*)(F.ws + (off)))
#define DOP(type, off) ((type*)((unsigned char*)F.out + (off)))
enum { I_X = 0, I_P, I_POS, I_LNMIX, I_WIN, I_HGLB, I_HGON, I_WOA, I_QAN, I_KVAN, I_WUQ, I_WUKV, I_QN, I_KN, I_WOB, I_WOUT, I_LNMOE, I_WRG, I_BRG, I_WRE, I_BRE, I_W1, I_W3, I_W2, I_LNPLE, I_WPG, I_WPP };

enum { M_WIN = 0, M_WOAB, M_WUQ, M_WUKV, M_WOUT, M_WPG, M_WPP, M_W13, M_W2T };
template <int MAT> struct MatInfo;
template <> struct MatInfo<M_WIN>  { static constexpr int K = 1024, NP = NIN; };
template <> struct MatInfo<M_WOAB> { static constexpr int K = 512,  NP = 2048; };
template <> struct MatInfo<M_WUQ>  { static constexpr int K = 256,  NP = 768; };
template <> struct MatInfo<M_WUKV> { static constexpr int K = 256,  NP = 1024; };
template <> struct MatInfo<M_WOUT> { static constexpr int K = 1024, NP = 1024; };
template <> struct MatInfo<M_WPG>  { static constexpr int K = 1024, NP = 1024; };
template <> struct MatInfo<M_WPP>  { static constexpr int K = 256,  NP = 1024; };
template <> struct MatInfo<M_W13>  { static constexpr int K = 1024, NP = NE * 512; };
template <> struct MatInfo<M_W2T>  { static constexpr int K = 256,  NP = NE * 1024; };
template <int MAT> __device__ __forceinline__ void conv_map(const Frame& F, int p, const float*& src, size_t& ld, const float*& gain, int& kvalid) {
    constexpr int K = MatInfo<MAT>::K; src = nullptr; ld = 0; gain = nullptr; kvalid = K;
    if constexpr (MAT == M_WIN) {
        const int pn = p >> 8; int col;
        if (pn < 8) { const int q = p & 255, bj = q >> 7, wc = (q >> 5) & 3, n = (q >> 4) & 1, fq = (q >> 2) & 3, j = q & 3; const int kind = 2 * bj + n;
            col = kind * 512 + (pn >> 1) * 128 + (pn & 1) * 64 + wc * 16 + fq * 4 + j; }
        else if (pn < 10) col = 2048 + perm8(p - 2048);
        else if (pn == 10) col = 2560 + perm8(p - 2560);
        else if (pn == 11) { const int l = perm8(p - 2816); col = l < 128 ? 2816 + l : (l < 160 ? 2944 + (l - 128) : -1); }
        else if (pn < 16) col = 2976 + perm8(p - 3072);
        else col = 4000 + perm8(p - 4096);
        if (col >= 0) src = F.in[I_WIN] + col; ld = DIN; gain = F.in[I_LNMIX];
    } else if constexpr (MAT == M_WOAB) { { const float* sa = F.in[I_WOA]; const float* sb = F.in[I_WOB]; src = (const float*)((const unsigned char*)sa + ((p >> 10) ? (size_t)((const unsigned char*)sb - (const unsigned char*)sa) : (size_t)0)) + perm8(p & 1023); } ld = 1024; }
    else if constexpr (MAT == M_WUQ) { src = F.in[I_WUQ] + perm8(p); ld = 768; gain = F.in[I_QAN]; }
    else if constexpr (MAT == M_WUKV) { const int pn = p >> 8, q = p & 255, bj = q >> 7, wc = (q >> 5) & 3, n = (q >> 4) & 1, fq = (q >> 2) & 3, j = q & 3;
        const int head = (pn & 1) * 4 + wc, d = 32 * bj + 8 * fq + 4 * n + j; src = F.in[I_WUKV] + head * 128 + (pn >= 2 ? 64 : 0) + d; ld = 1024; gain = F.in[I_KVAN]; kvalid = 128; }
    else if constexpr (MAT == M_WOUT) { src = F.in[I_WOUT] + perm8(p); ld = 1024; }
    else if constexpr (MAT == M_WPG) { src = F.in[I_WPG] + (GATE_FIRST ? perm8(p) : p); ld = 1024; gain = F.in[I_LNPLE]; }
    else if constexpr (MAT == M_WPP) { src = F.in[I_WPP] + ((FUSE_PROJ && !GATE_FIRST) ? p : perm8(p)); ld = 1024; }
    else if constexpr (MAT == M_W13) { const int e = p >> 9, q = p & 511, pl = q >> 8, bj = (q >> 7) & 1, r = q & 127;
        { const float* sa = F.in[I_W1]; const float* sb = F.in[I_W3]; src = (const float*)((const unsigned char*)sa + (bj ? (size_t)((const unsigned char*)sb - (const unsigned char*)sa) : (size_t)0)) + (size_t)e * 1024 * 256 + pl * 128 + perm8(r); } ld = 256; gain = F.in[I_LNMOE]; }
    else { const int e = p >> 10, q = p & 1023; src = F.in[I_W2] + (size_t)e * 256 * 1024 + perm8(q); ld = 1024; }
}
template <int MAT> __device__ __forceinline__ bf16* conv_dst(const Frame& F) {
    constexpr size_t off = MAT == M_WIN ? WS_WIN : MAT == M_WOAB ? WS_WOAB : MAT == M_WUQ ? WS_WUQ : MAT == M_WUKV ? WS_WUKV : MAT == M_WOUT ? WS_WOUT : MAT == M_WPG ? WS_WPG : MAT == M_WPP ? WS_WPP : MAT == M_W13 ? WS_W13 : WS_W2T;
    return WSP(bf16, off);
}
template <int MAT> __device__ __forceinline__ void conv_item(const Frame& F, int item, int lane, LAS float* scr) {
    constexpr int K = MatInfo<MAT>::K; constexpr int KB = K / 64;
    const int kb = item % KB, p0 = (item / KB) * 32, p = p0 + (lane & 31), k0 = kb * 64;
    const float* src; size_t ld; const float* gain; int kvalid; conv_map<MAT>(F, p, src, ld, gain, kvalid); bf16* dst = conv_dst<MAT>(F);
    float tv[32];
#pragma unroll
    for (int i = 0; i < 32; ++i) { const int k = k0 + 2 * i + (lane >> 5); tv[i] = (src && k < kvalid) ? src[(size_t)k * ld] : 0.0f; }
#pragma unroll
    for (int i = 0; i < 32; ++i) { const int kk = 2 * i + (lane >> 5); scr[kk * 33 + (lane & 31)] = gain ? tv[i] * gain[k0 + kk] : tv[i]; }
    LDS_WAIT(); asm volatile("" ::: "memory");
    const int c = lane & 7;
#pragma unroll
    for (int j = 0; j < 4; ++j) { const int n = (lane >> 3) + 8 * j; const LAS float* sp = scr + (8 * c) * 33 + n;
        v4u o; o.x = pk2(sp[0 * 33], sp[1 * 33]); o.y = pk2(sp[2 * 33], sp[3 * 33]); o.z = pk2(sp[4 * 33], sp[5 * 33]); o.w = pk2(sp[6 * 33], sp[7 * 33]);
        *(v4u*)(dst + (size_t)(p0 + n) * K + k0 + 8 * c) = o; }
    LDS_WAIT(); asm volatile("" ::: "memory");
}
template <int MAT> __device__ __forceinline__ void conv_mat(const Frame& F) {
    constexpr int NITEMS = (MatInfo<MAT>::NP / 32) * (MatInfo<MAT>::K / 64);
    const int gw = F.vcu * NWAVES + F.wave, NGW = F.G * NWAVES;
    LAS float* scr = (LAS float*)(F.lds + F.wave * 16384);
    for (int it = gw; it < NITEMS; it += NGW) conv_item<MAT>(F, it, F.lane, scr);
}

template <int MAT> __device__ __forceinline__ void conv8_mat(const Frame& F, unsigned char* dst8, float* SB, int wg_shift) {
    constexpr int K = MatInfo<MAT>::K, KPT = K / 16;
    static_assert(K == 1024 || K == 256, "conv8: K = 1024 or 256");
    constexpr int NITEMS = MatInfo<MAT>::NP / 32;
    int t_ = threadIdx.x; asm volatile("" : "+v"(t_));
    const int tid = t_, nl = tid & 31, kg = tid >> 5;
    LAS float* red = (LAS float*)F.lds;
    int first = F.vcu - wg_shift; if (first < 0) first += F.G;
    for (int it = first; it < NITEMS; it += F.G) {
        const int p = it * 32 + nl;
        const float* src; size_t ld; const float* gain; int kvalid; conv_map<MAT>(F, p, src, ld, gain, kvalid);
        float tv[KPT];
#pragma unroll
        for (int i = 0; i < KPT; ++i) tv[i] = (src && kg * KPT + i < kvalid) ? src[(size_t)(kg * KPT + i) * ld] : 0.0f;
        float mx = 0.f;
#pragma unroll
        for (int i = 0; i < KPT; ++i) { if (gain) tv[i] *= gain[kg * KPT + i]; mx = fmaxf(mx, fabsf(tv[i])); }
        red[kg * 32 + nl] = mx;
        __syncthreads();
        float cm = 0.f;
#pragma unroll
        for (int i = 0; i < 16; ++i) cm = fmaxf(cm, red[i * 32 + nl]);
        const float inv = cm > 0.f ? 127.0f / cm : 0.f;
        if (kg == 0) SB[p] = cm * (1.0f / 127.0f);
        unsigned char* dp = dst8 + (size_t)p * K + kg * KPT;
#pragma unroll
        for (int i = 0; i < KPT / 16; ++i) { v4u o;
            o.x = q8pack(tv[16 * i + 0] * inv, tv[16 * i + 1] * inv, tv[16 * i + 2] * inv, tv[16 * i + 3] * inv); o.y = q8pack(tv[16 * i + 4] * inv, tv[16 * i + 5] * inv, tv[16 * i + 6] * inv, tv[16 * i + 7] * inv);
            o.z = q8pack(tv[16 * i + 8] * inv, tv[16 * i + 9] * inv, tv[16 * i + 10] * inv, tv[16 * i + 11] * inv); o.w = q8pack(tv[16 * i + 12] * inv, tv[16 * i + 13] * inv, tv[16 * i + 14] * inv, tv[16 * i + 15] * inv);
            *(v4u*)(dp + 16 * i) = o; }
        __syncthreads();
    }
}

__device__ __forceinline__ void conv13_db(const Frame& F) {
    constexpr int NITEMS = MatInfo<M_W13>::NP / 16;
    int t_ = threadIdx.x; asm volatile("" : "+v"(t_));
    const int tid = t_, nl = tid & 15, kg = tid >> 4;
    LAS float* red = (LAS float*)F.lds; unsigned char* dst8 = F.ws + WS_W13; float* SB = WSP(float, WS_SB13);
    if (NITEMS % (2 * F.G) != 0) { conv8_mat<M_W13>(F, dst8, SB, 0); return; }
    const float* gain = F.in[I_LNMOE] + kg * 32;
#define C13_LOAD(tv_, it_) do { const float* src_; size_t ld_; const float* g_; int kv_; conv_map<M_W13>(F, (it_) * 16 + nl, src_, ld_, g_, kv_); \
        _Pragma("unroll") for (int i_ = 0; i_ < 32; ++i_) tv_[i_] = src_[(size_t)(kg * 32 + i_) * ld_]; } while (0)
#define C13_PROC(tv_, it_) do { const int p_ = (it_) * 16 + nl; float mx_ = 0.f; \
        _Pragma("unroll") for (int i_ = 0; i_ < 32; ++i_) { tv_[i_] *= gain[i_]; mx_ = fmaxf(mx_, fabsf(tv_[i_])); } \
        red[kg * 16 + nl] = mx_; __syncthreads(); float cm_ = 0.f; \
        _Pragma("unroll") for (int i_ = 0; i_ < 32; ++i_) cm_ = fmaxf(cm_, red[i_ * 16 + nl]); \
        const float inv_ = cm_ > 0.f ? 127.0f / cm_ : 0.f; if (kg == 0) SB[p_] = cm_ * (1.0f / 127.0f); \
        unsigned char* dp_ = dst8 + (size_t)p_ * 1024 + kg * 32; \
        _Pragma("unroll") for (int i_ = 0; i_ < 2; ++i_) { v4u o_; \
            o_.x = q8pack(tv_[16 * i_ + 0] * inv_, tv_[16 * i_ + 1] * inv_, tv_[16 * i_ + 2] * inv_, tv_[16 * i_ + 3] * inv_); o_.y = q8pack(tv_[16 * i_ + 4] * inv_, tv_[16 * i_ + 5] * inv_, tv_[16 * i_ + 6] * inv_, tv_[16 * i_ + 7] * inv_); \
            o_.z = q8pack(tv_[16 * i_ + 8] * inv_, tv_[16 * i_ + 9] * inv_, tv_[16 * i_ + 10] * inv_, tv_[16 * i_ + 11] * inv_); o_.w = q8pack(tv_[16 * i_ + 12] * inv_, tv_[16 * i_ + 13] * inv_, tv_[16 * i_ + 14] * inv_, tv_[16 * i_ + 15] * inv_); \
            *(v4u*)(dp_ + 16 * i_) = o_; } \
        __syncthreads(); } while (0)
    float tA[32], tB[32];
    C13_LOAD(tA, F.vcu);
#pragma unroll 1
    for (int it = F.vcu; it < NITEMS; it += 2 * F.G) {
        C13_LOAD(tB, it + F.G); C13_PROC(tA, it);
        if (it + 2 * F.G < NITEMS) C13_LOAD(tA, it + 2 * F.G);
        C13_PROC(tB, it + F.G);
    }
#undef C13_LOAD
#undef C13_PROC
}
__device__ __forceinline__ void conv_w2t_strips(const Frame& F) {
    constexpr int NITEMS = MatInfo<M_W2T>::NP / 32;
    int t_ = threadIdx.x; asm volatile("" : "+v"(t_));
    const int tid = t_, nl = tid & 31, kg = tid >> 5;
    bf16* dst = WSP(bf16, WS_W2T);
    for (int it0 = F.vcu; it0 < NITEMS; it0 += 4 * F.G) {
        float tv[4][16];
#pragma unroll
        for (int q = 0; q < 4; ++q) { const int it = it0 + q * F.G; if (it < NITEMS) { const float* src; size_t ld; const float* g; int kv; conv_map<M_W2T>(F, it * 32 + nl, src, ld, g, kv);
#pragma unroll
            for (int i = 0; i < 16; ++i) tv[q][i] = src[(size_t)(kg * 16 + i) * ld]; } }
#pragma unroll
        for (int q = 0; q < 4; ++q) { const int it = it0 + q * F.G; if (it < NITEMS) { bf16* dp = dst + (size_t)(it * 32 + nl) * 256 + kg * 16;
            v4u o0, o1; o0.x = pk2(tv[q][0], tv[q][1]); o0.y = pk2(tv[q][2], tv[q][3]); o0.z = pk2(tv[q][4], tv[q][5]); o0.w = pk2(tv[q][6], tv[q][7]);
            o1.x = pk2(tv[q][8], tv[q][9]); o1.y = pk2(tv[q][10], tv[q][11]); o1.z = pk2(tv[q][12], tv[q][13]); o1.w = pk2(tv[q][14], tv[q][15]);
            *(v4u*)dp = o0; *(v4u*)(dp + 8) = o1; } }
    }
}

__device__ __forceinline__ void p0_prologue(const Frame& F) {
    #if I8_P1
    conv8_mat<M_WIN>(F, F.ws + WS_WIN, WSP(float, WS_SBIN), 0);
#else
    conv_mat<M_WIN>(F);
#endif
    conv_mat<M_WOAB>(F);
#if I8_QKV
    conv8_mat<M_WUQ>(F, F.ws + WS_WUQ, WSP(float, WS_SBUQ), 160); conv8_mat<M_WUKV>(F, F.ws + WS_WUKV, WSP(float, WS_SBUKV), 184);
#else
    conv_mat<M_WUQ>(F); conv_mat<M_WUKV>(F);
#endif
    conv_mat<M_WOUT>(F);
#if I8_P10
    conv8_mat<M_WPG>(F, F.ws + WS_WPG, WSP(float, WS_SBPG), 192);
#else
    conv_mat<M_WPG>(F);
#endif
#if FUSE_PROJ
    conv8_mat<M_WPP>(F, F.ws + WS_WPP, WSP(float, WS_SBPP), 224);
#else
    conv_mat<M_WPP>(F);
#endif
    const int gt = F.vcu * NTHR + F.tid, NGT = F.G * NTHR;
    for (int i = gt; i < 80 * 1024; i += NGT) { const int j = i & 7, lane_ = (i >> 3) & 63, r = i >> 9, cb = r % 5, ks = r / 5; const int o = 16 * cb + (lane_ & 15), k = 32 * ks + 8 * (lane_ >> 4) + j;
        const float wv = o >= 72 ? 0.f : F.in[I_LNMOE][k] * (o < 8 ? F.in[I_WRG][k * 8 + o] : F.in[I_WRE][k * 64 + (o - 8)]);
        const unsigned h = f2bf(wv); WSP(bf16, WS_WRH)[i] = (bf16)h; WSP(bf16, WS_WRL)[i] = (bf16)f2bf(wv - bf2f(h)); }
    for (int i = gt; i < 80; i += NGT) WSP(float, WS_BR)[i] = i < 8 ? F.in[I_BRG][i] : (i < 72 ? F.in[I_BRE][i - 8] : 0.f);
    for (int i = gt; i < 1024; i += NGT) { const int d = i >> 9, f = i & 511; const float a0 = F.in[I_HGLB][d * 1024 + f], a1 = F.in[I_HGLB][d * 1024 + 512 + f]; WSP(float, WS_LB)[i] = 1.0f / (1.0f + expf(a1 - a0)); }
    for (int i = gt; i < T * 16; i += NGT) { const int t = i >> 4, f = i & 15; const float pos = (float)((const int*)F.in[I_POS])[t]; const float inv = exp2f(-(float)f * (13.287712379549449f / 16.0f));
        const float ang = pos * inv;
        const float kq = rintf(ang * 0.15915494309189535f); float r = fmaf(-kq, 6.28318548202514648f, ang); r = fmaf(-kq, -1.7484555e-7f, r);
        WSP(float, WS_ROPE)[t * 32 + f] = __cosf(r); WSP(float, WS_ROPE)[t * 32 + 16 + f] = __sinf(r); }
    const int gw = F.vcu * NWAVES + F.wave, NGW = F.G * NWAVES;
    for (int m = gw; m < T; m += NGW) {
        const float* xr = F.in[I_X] + (size_t)m * D + F.lane * 8; f32x4 v[4]; float ss = 0.f;
#pragma unroll
        for (int j = 0; j < 2; ++j) { v[2 * j] = *(const f32x4*)(xr + 512 * j); v[2 * j + 1] = *(const f32x4*)(xr + 512 * j + 4); ss += dot4(v[2 * j]) + dot4(v[2 * j + 1]); }
        const float rs = rsqrtf(wave_sum(ss) * (1.0f / D) + EPS);
#if I8_P1
        float mx = 0.f;
#pragma unroll
        for (int i = 0; i < 4; ++i)
#pragma unroll
            for (int j = 0; j < 4; ++j) mx = fmaxf(mx, fabsf(v[i][j]));
        mx = wave_max(mx); const float inv = mx > 0.f ? 127.0f / mx : 0.f;
        if (F.lane == 0) WSP(float, WS_SA1)[m] = mx * rs * (1.0f / 127.0f);
#pragma unroll
        for (int j = 0; j < 2; ++j) { v2u o; o.x = q8pack(v[2 * j][0] * inv, v[2 * j][1] * inv, v[2 * j][2] * inv, v[2 * j][3] * inv); o.y = q8pack(v[2 * j + 1][0] * inv, v[2 * j + 1][1] * inv, v[2 * j + 1][2] * inv, v[2 * j + 1][3] * inv);
            *(v2u*)(F.ws + WS_ACT + (size_t)m * D + F.lane * 8 + 512 * j) = o; }
#else
#pragma unroll
        for (int j = 0; j < 2; ++j) st8(WSP(bf16, WS_ACT) + (size_t)m * D + F.lane * 8 + 512 * j, v[2 * j] * rs, v[2 * j + 1] * rs);
#endif
#if FUSE_PROJ
        { f32x4 p0 = (f32x4){0.f, 0.f, 0.f, 0.f}, p1 = p0; if (F.lane < 32) { const float* pr = F.in[I_P] + (size_t)m * PLE + F.lane * 8; p0 = *(const f32x4*)pr; p1 = *(const f32x4*)(pr + 4); }
          float pm = 0.f;
#pragma unroll
          for (int j = 0; j < 4; ++j) pm = fmaxf(pm, fmaxf(fabsf(p0[j]), fabsf(p1[j])));
          pm = wave_max(pm); const float pinv = pm > 0.f ? 127.0f / pm : 0.f;
          if (F.lane == 0) WSP(float, WS_SAP)[m] = pm * (1.0f / 127.0f);
          if (F.lane < 32) { v2u o; o.x = q8pack(p0[0] * pinv, p0[1] * pinv, p0[2] * pinv, p0[3] * pinv); o.y = q8pack(p1[0] * pinv, p1[1] * pinv, p1[2] * pinv, p1[3] * pinv); *(v2u*)(F.ws + WS_PB + (size_t)m * PLE + F.lane * 8) = o; } }
#else
        if (F.lane < 32) { const float* pr = F.in[I_P] + (size_t)m * PLE + F.lane * 8; st8(WSP(bf16, WS_PB) + (size_t)m * PLE + F.lane * 8, *(const f32x4*)pr, *(const f32x4*)(pr + 4)); }
#endif
    }
}

__device__ __forceinline__ void oa_pass(const Frame& F) {
    const int gw = F.vcu * NWAVES + F.wave, NGW = F.G * NWAVES;
    const bf16* OFp = WSP(bf16, WS_ACT); const bf16* OBp = OFp + (size_t)T * 512; const bf16* OGp = WSP(bf16, WS_OG); bf16* OA = DOP(bf16, DO_OA);
    const int c0 = F.lane * 8; const f32x4 g0 = *(const f32x4*)(F.in[I_HGON] + (c0 & 127)), g1 = *(const f32x4*)(F.in[I_HGON] + (c0 & 127) + 4);
    for (int m = gw; m < T; m += NGW) {
        const size_t off = (size_t)m * 512 + c0;
        const v4u a = *(const v4u*)(OFp + off), b = *(const v4u*)(OBp + off), g = *(const v4u*)(OGp + off);
        f32x4 s0 = up4(a.x, a.y) + up4(b.x, b.y), s1 = up4(a.z, a.w) + up4(b.z, b.w);
        float ss = dot4(s0) + dot4(s1); ss += __shfl_xor(ss, 1); ss += __shfl_xor(ss, 2); ss += __shfl_xor(ss, 4); ss += __shfl_xor(ss, 8);
        const float rs = rsqrtf(ss * (1.0f / 128.0f) + EPS);
        st8(OA + off, s0 * rs * g0 * up4(g.x, g.y), s1 * rs * g1 * up4(g.z, g.w));
    }
}
__device__ __forceinline__ void x3_pass(const Frame& F) {
    const int gw = F.vcu * NWAVES + F.wave, NGW = F.G * NWAVES;
    const bf16* Y0 = WSP(bf16, WS_Y0); const bf16* Y1 = WSP(bf16, WS_Y1); const bf16* X2 = DOP(bf16, DO_X2B); bf16* X3 = WSP(bf16, WS_X3B); unsigned char* HP = F.ws + WS_ACT;
    for (int m = gw; m < T; m += NGW) {
        f32x4 v[4]; float ss = 0.f;
#pragma unroll
        for (int j = 0; j < 2; ++j) { const size_t o = (size_t)m * D + F.lane * 8 + 512 * j; const v4u a = *(const v4u*)(Y0 + o), b = *(const v4u*)(Y1 + o), x = *(const v4u*)(X2 + o);
            v[2 * j] = up4(x.x, x.y) + up4(a.x, a.y) + up4(b.x, b.y); v[2 * j + 1] = up4(x.z, x.w) + up4(a.z, a.w) + up4(b.z, b.w);
            st8(X3 + o, v[2 * j], v[2 * j + 1]); ss += dot4(v[2 * j]) + dot4(v[2 * j + 1]); }
        const float rs = rsqrtf(wave_sum(ss) * (1.0f / D) + EPS);
        float mx = 0.f;
#pragma unroll
        for (int i = 0; i < 4; ++i)
#pragma unroll
            for (int j = 0; j < 4; ++j) mx = fmaxf(mx, fabsf(v[i][j]));
        mx = wave_max(mx); const float inv = mx > 0.f ? 127.0f / mx : 0.f;
        if (F.lane == 0) WSP(float, WS_SA3)[m] = mx * rs * (1.0f / 127.0f);
#pragma unroll
        for (int j = 0; j < 2; ++j) { v2u o; o.x = q8pack(v[2 * j][0] * inv, v[2 * j][1] * inv, v[2 * j][2] * inv, v[2 * j][3] * inv); o.y = q8pack(v[2 * j + 1][0] * inv, v[2 * j + 1][1] * inv, v[2 * j + 1][2] * inv, v[2 * j + 1][3] * inv);
            *(v2u*)(HP + (size_t)m * D + F.lane * 8 + 512 * j) = o; }
    }
}
__device__ __forceinline__ void moe_build_table(const Frame& F) {
    LAS int* tab = (LAS int*)(F.lds + TAB_OFF); LAS int* cnts = tab + 16 + 4 * MAXROWT;
    if (F.tid < NE) cnts[F.tid] = (int)__hip_atomic_load(F.ctl + CW_CNT + 64 * F.tid, RLX_AGENT);
    __syncthreads();
    LAS int* starts = cnts + NE;
    if (F.tid == 0) { int rt = 0; for (int e = 0; e < NE; ++e) { starts[e] = rt; rt += (cnts[e] + 255) >> 8; } tab[0] = rt; }
    __syncthreads();
    if (F.tid < NE) { const int e = F.tid, cnt = cnts[e], nt = (cnt + 255) >> 8, r0 = starts[e];
        for (int lt = 0; lt < nt; ++lt) { const int rt = r0 + lt; tab[16 + 4 * rt] = e; tab[16 + 4 * rt + 1] = e * T + 256 * lt; const int rem = cnt - 256 * lt; tab[16 + 4 * rt + 2] = rem < 256 ? rem : 256; } }
    __syncthreads();
}
#ifndef ATT_OTR
#define ATT_OTR 0
#endif
#ifndef ATT_FIXSM
#define ATT_FIXSM 0
#endif
namespace att {
using f32x16 = __attribute__((ext_vector_type(16))) float;
using s16x4 = __attribute__((ext_vector_type(4))) short;
constexpr int QBLK = 32, KVBLK = 64;
constexpr float SCALE = 0.10206207261596577f;
constexpr float THR = 8.f;
constexpr int SHM_V = 16384, SHM_K = 16384, SHM_ATTN = 2 * SHM_V + 2 * SHM_K + NWAVES * 64 * 4;
#define KSWZ(row, colB) ((row) * 256 + ((colB) ^ (((row) & 7) << 4)))
#define SBAR() __builtin_amdgcn_sched_barrier(0)
__device__ __forceinline__ int crow(int r, int hi) { return (r & 3) + 8 * (r >> 2) + 4 * hi; }
__device__ __forceinline__ unsigned cvtpk(float lo, float hi) { unsigned r; asm volatile("v_cvt_pk_bf16_f32 %0, %1, %2" : "=v"(r) : "v"(lo), "v"(hi)); return r; }
__device__ __forceinline__ void partialSM(f32x16& p0, f32x16& p1, float& m_reg, float& mn, float& alpha) {
    constexpr float C = SCALE * 1.4426950408889634f;
    float pmax = p0[0];
#pragma unroll
    for (int r = 1; r < 16; ++r) pmax = fmaxf(pmax, p0[r]);
#pragma unroll
    for (int r = 0; r < 16; ++r) pmax = fmaxf(pmax, p1[r]);
    { auto rr = __builtin_amdgcn_permlane32_swap(__float_as_uint(pmax), __float_as_uint(pmax), false, false); pmax = fmaxf(__uint_as_float(rr[0]), __uint_as_float(rr[1])); }
    if (__builtin_expect(__all(pmax - m_reg <= THR / SCALE), 1)) { mn = m_reg; alpha = 1.f; }
    else { mn = fmaxf(m_reg, pmax); alpha = __builtin_amdgcn_exp2f((m_reg - mn) * C); m_reg = mn; }
    const float mnC = -mn * C;
#pragma unroll
    for (int r = 0; r < 16; ++r) p0[r] = fmaf(p0[r], C, mnC);
#pragma unroll
    for (int r = 0; r < 16; ++r) p1[r] = fmaf(p1[r], C, mnC);
#pragma unroll
    for (int r = 0; r < 16; ++r) p0[r] = __builtin_amdgcn_exp2f(p0[r]);
}
__device__ __forceinline__ void partialSM_fix(f32x16& p0, f32x16& p1, float mnC) {
    constexpr float C = SCALE * 1.4426950408889634f;
#pragma unroll
    for (int r = 0; r < 16; ++r) p0[r] = fmaf(p0[r], C, mnC);
#pragma unroll
    for (int r = 0; r < 16; ++r) p1[r] = fmaf(p1[r], C, mnC);
#pragma unroll
    for (int r = 0; r < 16; ++r) p0[r] = __builtin_amdgcn_exp2f(p0[r]);
}
__device__ __forceinline__ void finishSM(f32x16& p0, f32x16& p1, float alpha, float& l_reg, bf16x8& pa0, bf16x8& pa1, bf16x8& pa2, bf16x8& pa3) {
#pragma unroll
    for (int r = 0; r < 16; ++r) p1[r] = __builtin_amdgcn_exp2f(p1[r]);
    float ps = 0;
#pragma unroll
    for (int r = 0; r < 16; ++r) ps += p0[r];
#pragma unroll
    for (int r = 0; r < 16; ++r) ps += p1[r];
    { auto rr = __builtin_amdgcn_permlane32_swap(__float_as_uint(ps), __float_as_uint(ps), false, false); ps = __uint_as_float(rr[0]) + __uint_as_float(rr[1]); }
    l_reg = l_reg * alpha + ps;
#define PK4(P, BASE, OUT) do { unsigned a0 = cvtpk(P[BASE + 0], P[BASE + 1]), a1 = cvtpk(P[BASE + 2], P[BASE + 3]);   \
    unsigned b0 = cvtpk(P[BASE + 4], P[BASE + 5]), b1 = cvtpk(P[BASE + 6], P[BASE + 7]);                              \
    auto r0 = __builtin_amdgcn_permlane32_swap(a0, b0, false, false); auto r1 = __builtin_amdgcn_permlane32_swap(a1, b1, false, false); \
    v4u w = {r0[0], r1[0], r0[1], r1[1]}; OUT = __builtin_bit_cast(bf16x8, w); } while (0)
    PK4(p0, 0, pa0); PK4(p0, 8, pa1); PK4(p1, 0, pa2); PK4(p1, 8, pa3);
#undef PK4
}
__device__ __forceinline__ void qkt(f32x16& p0, f32x16& p1, const char* Ks, const bf16x8* qr, int r32, int hi) {
    p0 = f32x16{}; p1 = f32x16{};
#pragma unroll
    for (int d0 = 0; d0 < 6; ++d0) { const int cb = (d0 * 16 + hi * 8) * 2;
        const bf16x8 b0 = *reinterpret_cast<const bf16x8*>(Ks + KSWZ(r32, cb));
        const bf16x8 b1 = *reinterpret_cast<const bf16x8*>(Ks + KSWZ(32 + r32, cb));
        p0 = __builtin_amdgcn_mfma_f32_32x32x16_bf16(b0, qr[d0], p0, 0, 0, 0);
        p1 = __builtin_amdgcn_mfma_f32_32x32x16_bf16(b1, qr[d0], p1, 0, 0, 0); }
}
__device__ __forceinline__ int v_st(int k, int c) { const int kk = (k & ~0xC) | ((k & 4) << 1) | ((k & 8) >> 1); return ((kk >> 3) * 4 + (c >> 5)) * 512 + ((kk & 7) * 32 + (c & 31)) * 2; }
__device__ __forceinline__ int v_rd_base(int lane) { return ((lane & 3) << 3) | (((lane >> 2) & 3) << 6) | (((lane >> 4) & 1) << 5) | (((lane >> 5) & 1) << 8); }
constexpr int v_rd_off(int d0, int ks, int half) { return d0 * 512 + ks * 4096 + half * 2048; }
template <int OFF> __device__ __forceinline__ s16x4 tr_read(int vb) { s16x4 r; asm volatile("ds_read_b64_tr_b16 %0, %1 offset:%2" : "=&v"(r) : "v"(vb), "i"(OFF) : "memory"); return r; }
template <int D0> __device__ __forceinline__ void pv_one(f32x16& od, int vb, bf16x8 pa0, bf16x8 pa1, bf16x8 pa2, bf16x8 pa3) {
    const s16x4 l0 = tr_read<v_rd_off(D0, 0, 0)>(vb), h0 = tr_read<v_rd_off(D0, 0, 1)>(vb), l1 = tr_read<v_rd_off(D0, 1, 0)>(vb), h1 = tr_read<v_rd_off(D0, 1, 1)>(vb);
    const s16x4 l2 = tr_read<v_rd_off(D0, 2, 0)>(vb), h2 = tr_read<v_rd_off(D0, 2, 1)>(vb), l3 = tr_read<v_rd_off(D0, 3, 0)>(vb), h3 = tr_read<v_rd_off(D0, 3, 1)>(vb);
    asm volatile("s_waitcnt lgkmcnt(0)" ::: "memory"); SBAR();
#define PK(L, H) (bf16x8){L[0], L[1], L[2], L[3], H[0], H[1], H[2], H[3]}
    od = __builtin_amdgcn_mfma_f32_32x32x16_bf16(pa0, PK(l0, h0), od, 0, 0, 0);
    od = __builtin_amdgcn_mfma_f32_32x32x16_bf16(pa1, PK(l1, h1), od, 0, 0, 0);
    od = __builtin_amdgcn_mfma_f32_32x32x16_bf16(pa2, PK(l2, h2), od, 0, 0, 0);
    od = __builtin_amdgcn_mfma_f32_32x32x16_bf16(pa3, PK(l3, h3), od, 0, 0, 0);
#undef PK
}
__device__ __forceinline__ void pv_d0(f32x16* o, int vb, bf16x8 pa0, bf16x8 pa1, bf16x8 pa2, bf16x8 pa3) { pv_one<0>(o[0], vb, pa0, pa1, pa2, pa3); pv_one<1>(o[1], vb, pa0, pa1, pa2, pa3); }

__device__ __forceinline__ void attn_unit(const bf16* __restrict__ QM, const bf16* __restrict__ KH, const bf16* __restrict__ VH, bf16* __restrict__ OM, const float* __restrict__ RT, const float* __restrict__ QN,
                                          int t0, int kb, int h, char* lds, const float* __restrict__ KN = nullptr) {
    int tid_ = threadIdx.x; asm volatile("" : "+v"(tid_));
    const int tid = tid_, wid = __builtin_amdgcn_readfirstlane(tid >> 6), lane = tid & 63, r32 = lane & 31, hi = lane >> 5;
    char* V_lds = lds; char* K_lds = lds + 2 * SHM_V;
    float* wsf = (float*)(lds + 2 * SHM_V + 2 * SHM_K) + wid * 64; float* li_l = wsf; float* al_l = wsf + 32;
    float m_reg = -1e30f, l_reg = 0; f32x16 o[2] = {}; bf16x8 qr[6];
    {
        const int tq = t0 + wid * QBLK + r32; const bf16* qp = QM + (size_t)tq * 768 + h * 96 + hi * 8;
        float qf[6][8]; float ss = 0.f;
#pragma unroll
        for (int d0 = 0; d0 < 6; ++d0) { const v4u w = *(const v4u*)(qp + d0 * 16);
            qf[d0][0] = bflo(w.x); qf[d0][1] = bfhi(w.x); qf[d0][2] = bflo(w.y); qf[d0][3] = bfhi(w.y); qf[d0][4] = bflo(w.z); qf[d0][5] = bfhi(w.z); qf[d0][6] = bflo(w.w); qf[d0][7] = bfhi(w.w);
#pragma unroll
            for (int j = 0; j < 8; ++j) ss += qf[d0][j] * qf[d0][j]; }
        { auto rr = __builtin_amdgcn_permlane32_swap(__float_as_uint(ss), __float_as_uint(ss), false, false); ss = __uint_as_float(rr[0]) + __uint_as_float(rr[1]); }
        const float rs = rsqrtf(ss * (1.0f / 96.0f) + EPS);
#pragma unroll
        for (int d0 = 0; d0 < 6; ++d0) { const f32x4 g0 = *(const f32x4*)(QN + d0 * 16 + hi * 8), g1 = *(const f32x4*)(QN + d0 * 16 + hi * 8 + 4);
#pragma unroll
            for (int j = 0; j < 4; ++j) { qf[d0][j] *= rs * g0[j]; qf[d0][4 + j] *= rs * g1[j]; } }
        { const float* rt = RT + (size_t)tq * 32 + hi * 8; const f32x4 c0 = *(const f32x4*)rt, c1 = *(const f32x4*)(rt + 4), s0 = *(const f32x4*)(rt + 16), s1 = *(const f32x4*)(rt + 20);
#pragma unroll
          for (int j = 0; j < 8; ++j) { const float c = j < 4 ? c0[j & 3] : c1[j & 3], s = j < 4 ? s0[j & 3] : s1[j & 3]; const float x1 = qf[4][j], x2 = qf[5][j]; qf[4][j] = x1 * c - x2 * s; qf[5][j] = x2 * c + x1 * s; } }
#pragma unroll
        for (int d0 = 0; d0 < 6; ++d0) { v4u w = {cvtpk(qf[d0][0], qf[d0][1]), cvtpk(qf[d0][2], qf[d0][3]), cvtpk(qf[d0][4], qf[d0][5]), cvtpk(qf[d0][6], qf[d0][7])}; qr[d0] = __builtin_bit_cast(bf16x8, w); }
    }
#if ATT_FIXSM
    float mnC;
    {   float gq = fabsf(QN[lane]), gk = fabsf(KN[lane]); if (lane < 32) { gq = fmaxf(gq, fabsf(QN[64 + lane])); gk = fmaxf(gk, fabsf(KN[64 + lane])); }
#pragma unroll
        for (int o_ = 1; o_ < 64; o_ <<= 1) { gq = fmaxf(gq, __shfl_xor(gq, o_)); gk = fmaxf(gk, __shfl_xor(gk, o_)); }
        const float bound = fminf(96.0f * 1.01f * gq * gk, 60.0f / SCALE);
        mnC = -bound * (SCALE * 1.4426950408889634f); }
#define PSM(p0_, p1_, mn_, al_) do { partialSM_fix(p0_, p1_, mnC); al_ = 1.f; } while (0)
#else
#define PSM(p0_, p1_, mn_, al_) partialSM(p0_, p1_, m_reg, mn_, al_)
#endif
    const int vrow = tid >> 3, vch = tid & 7, k0row = tid / 12, k0ch = tid - 12 * k0row, k1row = (tid + 512) / 12, k1ch = (tid + 512) - 12 * k1row; const bool two = wid < 4;
    const bf16* Kg = KH + ((size_t)kb * 8 + h) * 96; const bf16* Vg = VH + ((size_t)kb * 8 + h) * 64;
    const int vst0 = v_st(vrow, vch * 8), kst0 = KSWZ(k0row, k0ch * 16), kst1 = KSWZ(k1row, k1ch * 16);
    const int vb0 = (int)(uintptr_t)V_lds + v_rd_base(lane);
    struct { bf16x8 vs, ks0, ks1; } sr_[2];
#define SLOAD(i, kk) do { sr_[i].vs = *(const bf16x8*)(Vg + (size_t)((kk) + vrow) * 512 + vch * 8); sr_[i].ks0 = *(const bf16x8*)(Kg + (size_t)((kk) + k0row) * 768 + k0ch * 8); \
    if (two) sr_[i].ks1 = *(const bf16x8*)(Kg + (size_t)((kk) + k1row) * 768 + k1ch * 8); } while (0)
#define SWRITE(b, i) do { *(bf16x8*)(V_lds + (b) * SHM_V + vst0) = sr_[i].vs; *(bf16x8*)(K_lds + (b) * SHM_K + kst0) = sr_[i].ks0; if (two) *(bf16x8*)(K_lds + (b) * SHM_K + kst1) = sr_[i].ks1; } while (0)
#define SWAIT() do { if (two) asm volatile("s_waitcnt vmcnt(3)" ::: "memory"); else asm volatile("s_waitcnt vmcnt(2)" ::: "memory"); } while (0)
#if ATT_FIXSM
#define RESC(a) do { } while (0)
#else
#define RESC(a) do { if (__any((a) < 1.f)) { if (hi == 0) al_l[r32] = (a); asm volatile("s_waitcnt lgkmcnt(0)" ::: "memory"); \
    _Pragma("unroll") for (int d = 0; d < 2; ++d) _Pragma("unroll") for (int r = 0; r < 16; ++r) o[d][r] *= al_l[crow(r, hi)]; } } while (0)
#endif
    f32x16 pA0, pA1, pB0, pB1; float mnA, mnB, alA, alB; bf16x8 pa0, pa1, pa2, pa3; constexpr int NT = SEQ / KVBLK;
    SLOAD(0, 0); asm volatile("s_waitcnt vmcnt(0)" ::: "memory"); SWRITE(0, 0); __syncthreads();
    qkt(pA0, pA1, K_lds, qr, r32, hi); PSM(pA0, pA1, mnA, alA);
    SLOAD(1, KVBLK); SLOAD(0, 2 * KVBLK);
    SWAIT(); SWRITE(1, 1); __syncthreads();
    for (int j = 1; j + 1 < NT; j += 2) {
        SBAR(); qkt(pB0, pB1, K_lds + SHM_K, qr, r32, hi);
        finishSM(pA0, pA1, alA, l_reg, pa0, pa1, pa2, pa3); SBAR();
        SLOAD(1, (j + 2) * KVBLK); SBAR();
        pv_d0(o, vb0, pa0, pa1, pa2, pa3); PSM(pB0, pB1, mnB, alB);
        __syncthreads(); SWAIT(); SWRITE(0, 0);
        RESC(alB); __syncthreads();
        SBAR(); qkt(pA0, pA1, K_lds, qr, r32, hi);
        finishSM(pB0, pB1, alB, l_reg, pa0, pa1, pa2, pa3); SBAR();
        if (j + 3 < NT) SLOAD(0, (j + 3) * KVBLK); SBAR();
        pv_d0(o, vb0 + SHM_V, pa0, pa1, pa2, pa3); PSM(pA0, pA1, mnA, alA);
        __syncthreads(); SWAIT(); SWRITE(1, 1);
        RESC(alA); __syncthreads();
    }
    SBAR(); qkt(pB0, pB1, K_lds + SHM_K, qr, r32, hi);
    finishSM(pA0, pA1, alA, l_reg, pa0, pa1, pa2, pa3); SBAR();
    pv_d0(o, vb0, pa0, pa1, pa2, pa3); PSM(pB0, pB1, mnB, alB);
    __syncthreads(); RESC(alB);
    finishSM(pB0, pB1, alB, l_reg, pa0, pa1, pa2, pa3); SBAR();
    pv_d0(o, vb0 + SHM_V, pa0, pa1, pa2, pa3);
    if (hi == 0) li_l[r32] = l_reg; asm volatile("s_waitcnt lgkmcnt(0)" ::: "memory");
    bf16* Ow = OM + (size_t)(t0 + wid * QBLK) * 512 + h * 64;
#if ATT_OTR
    {
        char* ot = lds + 73728 + wid * 4608;
#pragma unroll
        for (int r = 0; r < 16; ++r) { const int orow = crow(r, hi); const float rl = __builtin_amdgcn_rcpf(li_l[orow]);
#pragma unroll
            for (int d0 = 0; d0 < 2; ++d0) *(unsigned short*)(ot + orow * 144 + (d0 * 32 + r32) * 2) = (unsigned short)f2bf(o[d0][r] * rl); }
        asm volatile("s_waitcnt lgkmcnt(0)" ::: "memory");
        const int orow = lane >> 1, oh = lane & 1;
#pragma unroll
        for (int k = 0; k < 4; ++k) *(v4u*)(Ow + (size_t)orow * 512 + oh * 32 + 8 * k) = *(const v4u*)(ot + orow * 144 + oh * 64 + 16 * k);
    }
#else
#pragma unroll
    for (int r = 0; r < 16; ++r) { const int orow = crow(r, hi); const float rl = __builtin_amdgcn_rcpf(li_l[orow]);
#pragma unroll
        for (int d0 = 0; d0 < 2; ++d0) Ow[(size_t)orow * 512 + d0 * 32 + r32] = (bf16)f2bf(o[d0][r] * rl); }
#endif
    asm volatile("s_waitcnt vmcnt(0)" ::: "memory");
    __syncthreads();
#undef SLOAD
#undef SWRITE
#undef SWAIT
#undef RESC
#undef PSM
}
#undef KSWZ
#undef SBAR
}
__device__ __forceinline__ void attn_fast(const Frame& F) {
    const bf16* QM = WSP(bf16, WS_QM); const bf16* KH = WSP(bf16, WS_KH); const bf16* VH = WSP(bf16, WS_VH); bf16* OM = DOP(bf16, DO_OM);
    for (int item = F.vcu; item < NB * MH * 8; item += F.G) {
        const int qb = item & 7, h = (item >> 3) & 7, b = item >> 6;
        att::attn_unit(QM, KH, VH, OM, WSP(float, WS_ROPE), F.in[I_QN], b * SEQ + qb * 256, b * SEQ, h, (char*)F.gl);
    }
}
namespace hg {
typedef short v4i16_t __attribute__((ext_vector_type(4)));
constexpr int IN_BYTES = 40960, OFF_Q = 0, OFF_K = 16384, OFF_V = 32768, OFF_P = 2 * IN_BYTES, OFF_MT = OFF_P + 8192;
__device__ __forceinline__ unsigned off256(unsigned row, unsigned ch) { return 256u * row + 16u * (ch ^ (((row & 3) << 2) | ((row >> 2) & 3))); }
__device__ __forceinline__ unsigned off128(unsigned row, unsigned ch) { return 128u * row + 16u * (ch ^ (row & 7)); }
__device__ __forceinline__ bf16x8 ldrow(const LAS unsigned char* p) { return *(const LAS bf16x8*)p; }
__device__ __forceinline__ bf16x8 ldtr(const LAS unsigned char* p0, const LAS unsigned char* p1) {
    const v4i16_t a = __builtin_amdgcn_ds_read_tr16_b64_v4i16((LAS v4i16_t*)p0), b = __builtin_amdgcn_ds_read_tr16_b64_v4i16((LAS v4i16_t*)p1);
    return (bf16x8){a[0], a[1], a[2], a[3], b[0], b[1], b[2], b[3]};
}
}
__device__ __forceinline__ void hgrn_fast(const Frame& F) {
    using namespace hg;
    int tid_ = threadIdx.x; asm volatile("" : "+v"(tid_));
    const int tid = tid_, lane = tid & 63, w = __builtin_amdgcn_readfirstlane(tid >> 6), l15 = lane & 15, g = lane >> 4, q4 = (lane & 15) >> 2, p4 = lane & 3;
    const LAS unsigned char* L = F.lds;
    const unsigned qrow0 = tid >> 4, qch = tid & 15, qrow1 = qrow0 + 32, vrow = tid >> 3, vch = tid & 7;
    const unsigned sq0 = off256(qrow0, qch), sq1 = off256(qrow1, qch), sv = off128(vrow, vch);
    const int tb = w >> 1, sb0 = 2 * (w & 1);
    for (int item = blockIdx.x; item < NB * HGH * 2 * 2; item += F.G) {
        const int vh = item & 1, dir = (item >> 1) & 1, hh = (item >> 2) & 3, b = item >> 4;
        const bf16* Qd = DOP(bf16, dir ? DO_QB : DO_QF) + hh * 128 + qch * 8; const bf16* Kd = DOP(bf16, dir ? DO_KB : DO_KF) + hh * 128 + qch * 8;
        const bf16* Va = WSP(bf16, WS_VA) + hh * 128 + vh * 64 + vch * 8;
        bf16* Od = WSP(bf16, WS_ACT) + (dir ? (size_t)T * 512 : (size_t)0) + hh * 128 + vh * 64;
        const float* ER = WSP(float, WS_EREF) + (size_t)dir * NCHUNK * 512 + hh * 128 + 16 * w + 4 * g; const float* EL = WSP(float, WS_ELAST) + (size_t)dir * NCHUNK * 512 + hh * 128 + 16 * w + 4 * g;
#define HG_BAR() asm volatile("s_waitcnt lgkmcnt(0)\n\ts_barrier" ::: "memory")
        f32x4 M[4];
#pragma unroll
        for (int i = 0; i < 4; ++i) M[i] = (f32x4){0.f, 0.f, 0.f, 0.f};
        v4u rq0, rq1, rk0, rk1, rv;
#define HG_LOAD(gc_) do { const size_t t0_ = (size_t)(gc_) * 64; rq0 = *(const v4u*)(Qd + (t0_ + qrow0) * 512); rq1 = *(const v4u*)(Qd + (t0_ + qrow1) * 512); \
        rk0 = *(const v4u*)(Kd + (t0_ + qrow0) * 512); rk1 = *(const v4u*)(Kd + (t0_ + qrow1) * 512); rv = *(const v4u*)(Va + (t0_ + vrow) * 512); } while (0)
#define HG_WRITE(buf_) do { LAS unsigned char* B_ = (LAS unsigned char*)L + (buf_) * IN_BYTES; *(LAS v4u*)(B_ + OFF_Q + sq0) = rq0; *(LAS v4u*)(B_ + OFF_Q + sq1) = rq1; \
        *(LAS v4u*)(B_ + OFF_K + sq0) = rk0; *(LAS v4u*)(B_ + OFF_K + sq1) = rk1; *(LAS v4u*)(B_ + OFF_V + sv) = rv; } while (0)
        __syncthreads();
        { const int c0 = dir ? 31 : 0; HG_LOAD(b * 32 + c0); HG_WRITE(0); }
        __syncthreads();
        for (int cc = 0; cc < 32; ++cc) {
            const int c = dir ? 31 - cc : cc, gc = b * 32 + c, cn = dir ? c - 1 : c + 1, buf = cc & 1; const bool has = cc < 31;
            const LAS unsigned char* Bq = L + buf * IN_BYTES + OFF_Q; const LAS unsigned char* Bk = L + buf * IN_BYTES + OFF_K; const LAS unsigned char* Bv = L + buf * IN_BYTES + OFF_V;
            if (has) HG_LOAD(b * 32 + cn);
            f32x4 dv = (f32x4){0.f, 0.f, 0.f, 0.f};
            if (has) dv = *(const f32x4*)(EL + (size_t)gc * 512) * *(const f32x4*)(ER + (size_t)(b * 32 + cn) * 512);
            bf16x8 qfr[4];
            {
                f32x4 pa[2] = {(f32x4){0.f, 0.f, 0.f, 0.f}, (f32x4){0.f, 0.f, 0.f, 0.f}};
#pragma unroll
                for (int ks = 0; ks < 4; ++ks) { qfr[ks] = ldrow(Bq + off256(16 * tb + l15, 4 * ks + g));
#pragma unroll
                    for (int i = 0; i < 2; ++i) { const bf16x8 kf = ldrow(Bk + off256(16 * (sb0 + i) + l15, 4 * ks + g)); pa[i] = __builtin_amdgcn_mfma_f32_16x16x32_bf16(kf, qfr[ks], pa[i], 0, 0, 0); } }
                const int t = 16 * tb + l15;
#pragma unroll
                for (int i = 0; i < 2; ++i) { const int s0 = 16 * (sb0 + i) + 4 * g; f32x4 v = pa[i];
#pragma unroll
                    for (int r = 0; r < 4; ++r) { const bool ok = dir ? (s0 + r >= t) : (s0 + r <= t); v[r] = ok ? v[r] : 0.f; }
                    v2u pk; pk.x = pk2(v[0], v[1]); pk.y = pk2(v[2], v[3]);
                    *(LAS v2u*)((LAS unsigned char*)L + OFF_P + off128(t, 2 * (sb0 + i) + (g >> 1)) + (g & 1) * 8) = pk; }
#pragma unroll
                for (int vb = 0; vb < 4; ++vb) { v2u pk; pk.x = pk2(M[vb][0], M[vb][1]); pk.y = pk2(M[vb][2], M[vb][3]);
                    *(LAS v2u*)((LAS unsigned char*)L + OFF_MT + off256(16 * vb + l15, 2 * w + (g >> 1)) + (g & 1) * 8) = pk; }
            }
            HG_BAR();
            {
                f32x4 oa[2] = {(f32x4){0.f, 0.f, 0.f, 0.f}, (f32x4){0.f, 0.f, 0.f, 0.f}};
#pragma unroll
                for (int ks = 0; ks < 2; ++ks) { const bf16x8 pf = ldrow(L + OFF_P + off128(16 * tb + l15, 4 * ks + g));
#pragma unroll
                    for (int i = 0; i < 2; ++i) { const unsigned c = sb0 + i;
                        const bf16x8 vf = ldtr(Bv + off128(32 * ks + 8 * g + q4, 2 * c + (p4 >> 1)) + 8 * (p4 & 1), Bv + off128(32 * ks + 8 * g + 4 + q4, 2 * c + (p4 >> 1)) + 8 * (p4 & 1));
                        oa[i] = __builtin_amdgcn_mfma_f32_16x16x32_bf16(vf, pf, oa[i], 0, 0, 0); } }
#pragma unroll
                for (int ks = 0; ks < 4; ++ks) {
#pragma unroll
                    for (int i = 0; i < 2; ++i) { const bf16x8 mf = ldrow(L + OFF_MT + off256(16 * (sb0 + i) + l15, 4 * ks + g)); oa[i] = __builtin_amdgcn_mfma_f32_16x16x32_bf16(mf, qfr[ks], oa[i], 0, 0, 0); } }
                const size_t orow = ((size_t)gc * 64 + 16 * tb + l15) * 512;
#pragma unroll
                for (int i = 0; i < 2; ++i) st4(Od + orow + 16 * (sb0 + i) + 4 * g, oa[i]);
#pragma unroll
                for (int ks = 0; ks < 2; ++ks) {
                    const bf16x8 kf = ldtr(Bk + off256(32 * ks + 8 * g + q4, 2 * w + (p4 >> 1)) + 8 * (p4 & 1), Bk + off256(32 * ks + 8 * g + 4 + q4, 2 * w + (p4 >> 1)) + 8 * (p4 & 1));
#pragma unroll
                    for (int vb = 0; vb < 4; ++vb) {
                        const bf16x8 vf = ldtr(Bv + off128(32 * ks + 8 * g + q4, 2 * vb + (p4 >> 1)) + 8 * (p4 & 1), Bv + off128(32 * ks + 8 * g + 4 + q4, 2 * vb + (p4 >> 1)) + 8 * (p4 & 1));
                        M[vb] = __builtin_amdgcn_mfma_f32_16x16x32_bf16(kf, vf, M[vb], 0, 0, 0); } }
#pragma unroll
                for (int vb = 0; vb < 4; ++vb) M[vb] = M[vb] * dv;
            }
            if (has) HG_WRITE(buf ^ 1);
            HG_BAR();
        }
#undef HG_LOAD
#undef HG_WRITE
#undef HG_BAR
    }
}
namespace hg2 {
constexpr int QKB = 32768, H2_V = 3 * QKB, H2_P = H2_V + 2 * 8192, H2_D = TAB_OFF;
}
__device__ __forceinline__ void hgrn_fast2(const Frame& F) {
    using namespace hg; using namespace hg2;
    const int w = __builtin_amdgcn_readfirstlane((int)threadIdx.x >> 6);
    const LAS unsigned char* L = F.lds; LAS unsigned char* Lw = (LAS unsigned char*)F.lds;
#define HG_BAR() asm volatile("s_waitcnt lgkmcnt(0)\n\ts_barrier" ::: "memory")
#define CH(cc_) (dir ? 31 - (cc_) : (cc_))
    for (int item = blockIdx.x; item < NB * HGH * 2 * 2; item += F.G) {
        const int vh = item & 1, dir = (item >> 1) & 1, hh = (item >> 2) & 3, b = item >> 4;
        __syncthreads();
        if (w < 4) {
            int t_ = threadIdx.x; asm volatile("" : "+v"(t_));
            const int lane = t_ & 63, l15 = lane & 15, g = lane >> 4, q4 = (lane & 15) >> 2, p4 = lane & 3;
            bf16* Od = WSP(bf16, WS_ACT) + (dir ? (size_t)T * 512 : (size_t)0) + hh * 128 + vh * 64 + 16 * w + 4 * g;
            f32x4 Mb[8];
#pragma unroll
            for (int i = 0; i < 8; ++i) Mb[i] = (f32x4){0.f, 0.f, 0.f, 0.f};
            HG_BAR(); HG_BAR();
#pragma unroll 1
            for (int cc = 0; cc < 32; ++cc) {
                const LAS unsigned char* Bq = L + (cc % 3) * QKB; const LAS unsigned char* Bk = Bq + 16384; const LAS unsigned char* Bv = L + H2_V + (cc & 1) * 8192; const LAS unsigned char* Bp = L + H2_P + (cc & 1) * 8192;
                const int gc = b * 32 + CH(cc);
                bf16x8 vf[2];
#pragma unroll
                for (int ks = 0; ks < 2; ++ks) vf[ks] = ldtr(Bv + off128(32 * ks + 8 * g + q4, 2 * w + (p4 >> 1)) + 8 * (p4 & 1), Bv + off128(32 * ks + 8 * g + 4 + q4, 2 * w + (p4 >> 1)) + 8 * (p4 & 1));
                f32x4 oa[4];
#pragma unroll
                for (int tb = 0; tb < 4; ++tb) oa[tb] = (f32x4){0.f, 0.f, 0.f, 0.f};
#pragma unroll
                for (int tb = 0; tb < 4; ++tb)
#pragma unroll
                    for (int ks = 0; ks < 2; ++ks) { const bf16x8 pf = ldrow(Bp + off128(16 * tb + l15, 4 * ks + g)); oa[tb] = __builtin_amdgcn_mfma_f32_16x16x32_bf16(vf[ks], pf, oa[tb], 0, 0, 0); }
#pragma unroll
                for (int ks = 0; ks < 4; ++ks) { v4u mw; mw.x = pk2(Mb[2 * ks][0], Mb[2 * ks][1]); mw.y = pk2(Mb[2 * ks][2], Mb[2 * ks][3]); mw.z = pk2(Mb[2 * ks + 1][0], Mb[2 * ks + 1][1]); mw.w = pk2(Mb[2 * ks + 1][2], Mb[2 * ks + 1][3]);
                    const bf16x8 mf = __builtin_bit_cast(bf16x8, mw);
#pragma unroll
                    for (int tb = 0; tb < 4; ++tb) { const v2u qa = *(const LAS v2u*)(Bq + off256(16 * tb + l15, 4 * ks + (g >> 1)) + 8 * (g & 1)), qb = *(const LAS v2u*)(Bq + off256(16 * tb + l15, 4 * ks + 2 + (g >> 1)) + 8 * (g & 1));
                        v4u qw; qw.x = qa.x; qw.y = qa.y; qw.z = qb.x; qw.w = qb.y;
                        oa[tb] = __builtin_amdgcn_mfma_f32_16x16x32_bf16(mf, __builtin_bit_cast(bf16x8, qw), oa[tb], 0, 0, 0); } }
#ifdef PROBE_HG_LDS
                { unsigned dm = 0;
#pragma unroll
                  for (int ks = 0; ks < 4; ++ks)
#pragma unroll
                    for (int tb = 0; tb < 4; ++tb) { const v2u qa = *(const volatile LAS v2u*)(Bq + off256(16 * tb + l15, 4 * ks + (g >> 1)) + 8 * (g & 1)), qb = *(const volatile LAS v2u*)(Bq + off256(16 * tb + l15, 4 * ks + 2 + (g >> 1)) + 8 * (g & 1)); dm ^= qa.x ^ qa.y ^ qb.x ^ qb.y; }
                  if (dm == 0x12345678u && gc < 0) Od[0] = (bf16)dm; }
#endif
#pragma unroll
                for (int tb = 0; tb < 4; ++tb) st4(Od + ((size_t)gc * 64 + 16 * tb + l15) * 512, oa[tb]);
                if (cc < 31) {
#pragma unroll
                    for (int ks = 0; ks < 2; ++ks)
#pragma unroll
                        for (int cb = 0; cb < 8; ++cb) { const bf16x8 kf = ldtr(Bk + off256(32 * ks + 8 * g + q4, 2 * cb + (p4 >> 1)) + 8 * (p4 & 1), Bk + off256(32 * ks + 8 * g + 4 + q4, 2 * cb + (p4 >> 1)) + 8 * (p4 & 1));
                            Mb[cb] = __builtin_amdgcn_mfma_f32_16x16x32_bf16(kf, vf[ks], Mb[cb], 0, 0, 0); }
#pragma unroll
                    for (int cb = 0; cb < 8; ++cb) Mb[cb] = Mb[cb] * *(const LAS f32x4*)(L + H2_D + (cc & 1) * 512 + (16 * cb + 4 * g) * 4);
                }
                HG_BAR();
            }
        } else {
            int t_ = threadIdx.x; asm volatile("" : "+v"(t_));
            const int lane = t_ & 63, l15 = lane & 15, g = lane >> 4, pt = t_ & 255;
            const bf16* Qd = DOP(bf16, dir ? DO_QB : DO_QF) + hh * 128 + (pt & 15) * 8 + (size_t)(pt >> 4) * 512; const bf16* Kd = DOP(bf16, dir ? DO_KB : DO_KF) + hh * 128 + (pt & 15) * 8 + (size_t)(pt >> 4) * 512;
            const bf16* Va = WSP(bf16, WS_VA) + hh * 128 + vh * 64 + (pt & 7) * 8 + (size_t)(pt >> 3) * 512;
            const float* ER = WSP(float, WS_EREF) + (size_t)dir * NCHUNK * 512 + hh * 128 + (pt & 127); const float* EL = WSP(float, WS_ELAST) + (size_t)dir * NCHUNK * 512 + hh * 128 + (pt & 127);
            const unsigned sq0 = off256(pt >> 4, pt & 15), sv0 = off128(pt >> 3, pt & 7);
            v4u rqA[4], rkA[4], rvA[2], rqB[4], rkB[4], rvB[2]; float elA = 0.f, erA = 0.f, elB = 0.f, erB = 0.f;
#define LOAD_QK(cc_, S) do { const size_t t0_ = (size_t)(b * 32 + CH(cc_)) * 64; _Pragma("unroll") for (int i_ = 0; i_ < 4; ++i_) { rq##S[i_] = *(const v4u*)(Qd + (t0_ + 16 * i_) * 512); rk##S[i_] = *(const v4u*)(Kd + (t0_ + 16 * i_) * 512); } } while (0)
#define LOAD_V(cc_, S) do { const size_t t0_ = (size_t)(b * 32 + CH(cc_)) * 64; _Pragma("unroll") for (int i_ = 0; i_ < 2; ++i_) rv##S[i_] = *(const v4u*)(Va + (t0_ + 32 * i_) * 512); } while (0)
#define WRITE_QK(cc_, S) do { LAS unsigned char* B_ = Lw + ((cc_) % 3) * QKB + sq0; _Pragma("unroll") for (int i_ = 0; i_ < 4; ++i_) { *(LAS v4u*)(B_ + 4096 * i_) = rq##S[i_]; *(LAS v4u*)(B_ + 16384 + 4096 * i_) = rk##S[i_]; } } while (0)
#define WRITE_V(cc_, S) do { LAS unsigned char* B_ = Lw + H2_V + ((cc_) & 1) * 8192 + sv0; _Pragma("unroll") for (int i_ = 0; i_ < 2; ++i_) *(LAS v4u*)(B_ + 4096 * i_) = rv##S[i_]; } while (0)
#define LOAD_D(cc_, S) do { el##S = EL[(size_t)(b * 32 + CH(cc_)) * 512]; er##S = ER[(size_t)(b * 32 + CH((cc_) + 1)) * 512]; } while (0)
#define WRITE_D(cc_, S) do { if (pt < 128) *(LAS float*)(Lw + H2_D + ((cc_) & 1) * 512 + pt * 4) = el##S * er##S; } while (0)
#define MAKE_P(cc_) do { const LAS unsigned char* Bq_ = L + ((cc_) % 3) * QKB; const LAS unsigned char* Bk_ = Bq_ + 16384; LAS unsigned char* Bp_ = Lw + H2_P + ((cc_) & 1) * 8192; const int tb_ = w - 4; \
            f32x4 pa_[4]; _Pragma("unroll") for (int i_ = 0; i_ < 4; ++i_) pa_[i_] = (f32x4){0.f, 0.f, 0.f, 0.f}; \
            _Pragma("unroll") for (int ks_ = 0; ks_ < 4; ++ks_) { const bf16x8 qf_ = ldrow(Bq_ + off256(16 * tb_ + l15, 4 * ks_ + g)); \
                _Pragma("unroll") for (int i_ = 0; i_ < 4; ++i_) { const bf16x8 kf_ = ldrow(Bk_ + off256(16 * i_ + l15, 4 * ks_ + g)); pa_[i_] = __builtin_amdgcn_mfma_f32_16x16x32_bf16(kf_, qf_, pa_[i_], 0, 0, 0); } } \
            const int tt_ = 16 * tb_ + l15; \
            _Pragma("unroll") for (int i_ = 0; i_ < 4; ++i_) { const int s0_ = 16 * i_ + 4 * g; f32x4 v_ = pa_[i_]; \
                _Pragma("unroll") for (int r_ = 0; r_ < 4; ++r_) { const bool ok_ = dir ? (s0_ + r_ >= tt_) : (s0_ + r_ <= tt_); v_[r_] = ok_ ? v_[r_] : 0.f; } \
                v2u pk_; pk_.x = pk2(v_[0], v_[1]); pk_.y = pk2(v_[2], v_[3]); *(LAS v2u*)(Bp_ + off128(tt_, 2 * i_ + (g >> 1)) + (g & 1) * 8) = pk_; } } while (0)
            LOAD_QK(0, A); LOAD_V(0, A); LOAD_D(0, A); LOAD_QK(1, B); WRITE_QK(0, A); WRITE_V(0, A); WRITE_D(0, A); WRITE_QK(1, B);
            LOAD_QK(2, A); LOAD_V(1, A); LOAD_D(1, A); LOAD_QK(3, B); LOAD_V(2, B); LOAD_D(2, B);
            HG_BAR();
            MAKE_P(0);
            HG_BAR();
#define P_STEP(S) do { if (cc + 2 < 32) WRITE_QK(cc + 2, S); if (cc + 1 < 32) WRITE_V(cc + 1, S); if (cc + 2 < 32) WRITE_D(cc + 1, S); \
            if (cc + 4 < 32) LOAD_QK(cc + 4, S); if (cc + 3 < 32) LOAD_V(cc + 3, S); if (cc + 4 < 32) LOAD_D(cc + 3, S); if (cc + 1 < 32) MAKE_P(cc + 1); } while (0)
#pragma unroll 1
            for (int c2 = 0; c2 < 32; c2 += 2) {
                { const int cc = c2; P_STEP(A); HG_BAR(); }
                { const int cc = c2 + 1; P_STEP(B); HG_BAR(); }
            }
#undef P_STEP
#undef LOAD_QK
#undef LOAD_V
#undef WRITE_QK
#undef WRITE_V
#undef LOAD_D
#undef WRITE_D
#undef MAKE_P
        }
    }
#undef CH
#undef HG_BAR
}

typedef float f32x16 __attribute__((ext_vector_type(16)));
__device__ __forceinline__ void hgrn_fast3(const Frame& F) {
    using namespace hg; using namespace hg2;
    const int w = __builtin_amdgcn_readfirstlane((int)threadIdx.x >> 6);
    const LAS unsigned char* L = F.lds; LAS unsigned char* Lw = (LAS unsigned char*)F.lds;
#define HG_BAR() asm volatile("s_waitcnt lgkmcnt(0)\n\ts_barrier" ::: "memory")
#define CH(cc_) (dir ? 31 - (cc_) : (cc_))
    for (int item = blockIdx.x; item < NB * HGH * 2 * 2; item += F.G) {
        const int vh = item & 1, dir = (item >> 1) & 1, hh = (item >> 2) & 3, b = item >> 4;
        __syncthreads();
        if (w < 2) {
            int t_ = threadIdx.x; asm volatile("" : "+v"(t_));
            const int lane = t_ & 63, r32 = lane & 31, h = lane >> 5, blk = (lane >> 4) & 1, q4 = (lane & 15) >> 2, p4 = lane & 3;
            bf16* Od = WSP(bf16, WS_ACT) + (dir ? (size_t)T * 512 : (size_t)0) + hh * 128 + vh * 64 + 32 * w + 4 * h;
            f32x16 Mb[4];
#pragma unroll
            for (int i = 0; i < 4; ++i) Mb[i] = f32x16{};
            HG_BAR(); HG_BAR();
#pragma unroll 1
            for (int cc = 0; cc < 32; ++cc) {
                const LAS unsigned char* Bq = L + (cc % 3) * QKB; const LAS unsigned char* Bk = Bq + 16384; const LAS unsigned char* Bv = L + H2_V + (cc & 1) * 8192; const LAS unsigned char* Bp = L + H2_P + (cc & 1) * 8192;
                const int gc = b * 32 + CH(cc);
                bf16x8 vf[4];
#pragma unroll
                for (int ks = 0; ks < 4; ++ks) vf[ks] = ldtr(Bv + off128(16 * ks + 8 * h + q4, 4 * w + 2 * blk + (p4 >> 1)) + 8 * (p4 & 1), Bv + off128(16 * ks + 8 * h + 4 + q4, 4 * w + 2 * blk + (p4 >> 1)) + 8 * (p4 & 1));
                f32x16 oa[2] = {f32x16{}, f32x16{}};
#pragma unroll
                for (int tb = 0; tb < 2; ++tb)
#pragma unroll
                    for (int ks = 0; ks < 4; ++ks) { const bf16x8 pf = ldrow(Bp + off128(32 * tb + r32, 2 * ks + h)); oa[tb] = __builtin_amdgcn_mfma_f32_32x32x16_bf16(vf[ks], pf, oa[tb], 0, 0, 0); }
#pragma unroll
                for (int cb = 0; cb < 4; ++cb)
#pragma unroll
                    for (int s2 = 0; s2 < 2; ++s2) {
                        v4u mw; mw.x = pk2(Mb[cb][8 * s2 + 0], Mb[cb][8 * s2 + 1]); mw.y = pk2(Mb[cb][8 * s2 + 2], Mb[cb][8 * s2 + 3]); mw.z = pk2(Mb[cb][8 * s2 + 4], Mb[cb][8 * s2 + 5]); mw.w = pk2(Mb[cb][8 * s2 + 6], Mb[cb][8 * s2 + 7]);
                        const bf16x8 mf = __builtin_bit_cast(bf16x8, mw);
#pragma unroll
                        for (int tb = 0; tb < 2; ++tb) { const v2u qa = *(const LAS v2u*)(Bq + off256(32 * tb + r32, 4 * cb + 2 * s2) + 8 * h), qb = *(const LAS v2u*)(Bq + off256(32 * tb + r32, 4 * cb + 2 * s2 + 1) + 8 * h);
                            v4u qw; qw.x = qa.x; qw.y = qa.y; qw.z = qb.x; qw.w = qb.y;
                            oa[tb] = __builtin_amdgcn_mfma_f32_32x32x16_bf16(mf, __builtin_bit_cast(bf16x8, qw), oa[tb], 0, 0, 0); } }
#pragma unroll
                for (int tb = 0; tb < 2; ++tb)
#pragma unroll
                    for (int i = 0; i < 4; ++i) st4(Od + ((size_t)gc * 64 + 32 * tb + r32) * 512 + 8 * i, (f32x4){oa[tb][4 * i], oa[tb][4 * i + 1], oa[tb][4 * i + 2], oa[tb][4 * i + 3]});
                if (cc < 31) {
#pragma unroll
                    for (int ks = 0; ks < 4; ++ks)
#pragma unroll
                        for (int cb = 0; cb < 4; ++cb) { const bf16x8 kf = ldtr(Bk + off256(16 * ks + 8 * h + q4, 4 * cb + 2 * blk + (p4 >> 1)) + 8 * (p4 & 1), Bk + off256(16 * ks + 8 * h + 4 + q4, 4 * cb + 2 * blk + (p4 >> 1)) + 8 * (p4 & 1));
                            Mb[cb] = __builtin_amdgcn_mfma_f32_32x32x16_bf16(kf, vf[ks], Mb[cb], 0, 0, 0); }
#pragma unroll
                    for (int cb = 0; cb < 4; ++cb)
#pragma unroll
                        for (int i = 0; i < 4; ++i) { const f32x4 dv = *(const LAS f32x4*)(L + H2_D + (cc & 1) * 512 + (32 * cb + 8 * i + 4 * h) * 4);
#pragma unroll
                            for (int e = 0; e < 4; ++e) Mb[cb][4 * i + e] *= dv[e]; }
                }
                HG_BAR();
            }
        } else if (w < 4) {
            HG_BAR(); HG_BAR();
#pragma unroll 1
            for (int cc = 0; cc < 32; ++cc) HG_BAR();
        } else {
            int t_ = threadIdx.x; asm volatile("" : "+v"(t_));
            const int lane = t_ & 63, r32 = lane & 31, h = lane >> 5, pt = t_ & 255;
            const bf16* Qd = DOP(bf16, dir ? DO_QB : DO_QF) + hh * 128 + (pt & 15) * 8 + (size_t)(pt >> 4) * 512; const bf16* Kd = DOP(bf16, dir ? DO_KB : DO_KF) + hh * 128 + (pt & 15) * 8 + (size_t)(pt >> 4) * 512;
            const bf16* Va = WSP(bf16, WS_VA) + hh * 128 + vh * 64 + (pt & 7) * 8 + (size_t)(pt >> 3) * 512;
            const float* ER = WSP(float, WS_EREF) + (size_t)dir * NCHUNK * 512 + hh * 128 + (pt & 127); const float* EL = WSP(float, WS_ELAST) + (size_t)dir * NCHUNK * 512 + hh * 128 + (pt & 127);
            const unsigned sq0 = off256(pt >> 4, pt & 15), sv0 = off128(pt >> 3, pt & 7);
            v4u rqA[4], rkA[4], rvA[2], rqB[4], rkB[4], rvB[2]; float elA = 0.f, erA = 0.f, elB = 0.f, erB = 0.f;
#define LOAD_QK(cc_, S) do { const size_t t0_ = (size_t)(b * 32 + CH(cc_)) * 64; _Pragma("unroll") for (int i_ = 0; i_ < 4; ++i_) { rq##S[i_] = *(const v4u*)(Qd + (t0_ + 16 * i_) * 512); rk##S[i_] = *(const v4u*)(Kd + (t0_ + 16 * i_) * 512); } } while (0)
#define LOAD_V(cc_, S) do { const size_t t0_ = (size_t)(b * 32 + CH(cc_)) * 64; _Pragma("unroll") for (int i_ = 0; i_ < 2; ++i_) rv##S[i_] = *(const v4u*)(Va + (t0_ + 32 * i_) * 512); } while (0)
#define WRITE_QK(cc_, S) do { LAS unsigned char* B_ = Lw + ((cc_) % 3) * QKB + sq0; _Pragma("unroll") for (int i_ = 0; i_ < 4; ++i_) { *(LAS v4u*)(B_ + 4096 * i_) = rq##S[i_]; *(LAS v4u*)(B_ + 16384 + 4096 * i_) = rk##S[i_]; } } while (0)
#define WRITE_V(cc_, S) do { LAS unsigned char* B_ = Lw + H2_V + ((cc_) & 1) * 8192 + sv0; _Pragma("unroll") for (int i_ = 0; i_ < 2; ++i_) *(LAS v4u*)(B_ + 4096 * i_) = rv##S[i_]; } while (0)
#define LOAD_D(cc_, S) do { el##S = EL[(size_t)(b * 32 + CH(cc_)) * 512]; er##S = ER[(size_t)(b * 32 + CH((cc_) + 1)) * 512]; } while (0)
#define WRITE_D(cc_, S) do { if (pt < 128) *(LAS float*)(Lw + H2_D + ((cc_) & 1) * 512 + pt * 4) = el##S * er##S; } while (0)
#define MAKE_P(cc_) do { if (w < 6) { const LAS unsigned char* Bq_ = L + ((cc_) % 3) * QKB; const LAS unsigned char* Bk_ = Bq_ + 16384; LAS unsigned char* Bp_ = Lw + H2_P + ((cc_) & 1) * 8192; const int tb_ = w - 4; \
            f32x16 pa_[2] = {f32x16{}, f32x16{}}; \
            _Pragma("unroll") for (int ks_ = 0; ks_ < 8; ++ks_) { const bf16x8 qf_ = ldrow(Bq_ + off256(32 * tb_ + r32, 2 * ks_ + h)); \
                _Pragma("unroll") for (int i_ = 0; i_ < 2; ++i_) { const bf16x8 kf_ = ldrow(Bk_ + off256(32 * i_ + r32, 2 * ks_ + h)); pa_[i_] = __builtin_amdgcn_mfma_f32_32x32x16_bf16(kf_, qf_, pa_[i_], 0, 0, 0); } } \
            const int tt_ = 32 * tb_ + r32; \
            _Pragma("unroll") for (int i_ = 0; i_ < 2; ++i_) _Pragma("unroll") for (int q_ = 0; q_ < 4; ++q_) { const int s0_ = 32 * i_ + 8 * q_ + 4 * h; float v_[4]; \
                _Pragma("unroll") for (int e_ = 0; e_ < 4; ++e_) { const bool ok_ = dir ? (s0_ + e_ >= tt_) : (s0_ + e_ <= tt_); v_[e_] = ok_ ? pa_[i_][4 * q_ + e_] : 0.f; } \
                v2u pk_; pk_.x = pk2(v_[0], v_[1]); pk_.y = pk2(v_[2], v_[3]); *(LAS v2u*)(Bp_ + off128(tt_, 4 * i_ + q_) + 8 * h) = pk_; } } } while (0)
            LOAD_QK(0, A); LOAD_V(0, A); LOAD_D(0, A); LOAD_QK(1, B); WRITE_QK(0, A); WRITE_V(0, A); WRITE_D(0, A); WRITE_QK(1, B);
            LOAD_QK(2, A); LOAD_V(1, A); LOAD_D(1, A); LOAD_QK(3, B); LOAD_V(2, B); LOAD_D(2, B);
            HG_BAR();
            MAKE_P(0);
            HG_BAR();
#define P_STEP(S) do { if (cc + 2 < 32) WRITE_QK(cc + 2, S); if (cc + 1 < 32) WRITE_V(cc + 1, S); if (cc + 2 < 32) WRITE_D(cc + 1, S); \
            if (cc + 4 < 32) LOAD_QK(cc + 4, S); if (cc + 3 < 32) LOAD_V(cc + 3, S); if (cc + 4 < 32) LOAD_D(cc + 3, S); if (cc + 1 < 32) MAKE_P(cc + 1); } while (0)
#pragma unroll 1
            for (int c2 = 0; c2 < 32; c2 += 2) {
                { const int cc = c2; P_STEP(A); HG_BAR(); }
                { const int cc = c2 + 1; P_STEP(B); HG_BAR(); }
            }
#undef P_STEP
#undef LOAD_QK
#undef LOAD_V
#undef WRITE_QK
#undef WRITE_V
#undef LOAD_D
#undef WRITE_D
#undef MAKE_P
        }
    }
#undef CH
#undef HG_BAR
}
template <bool DRY = false> __device__ __forceinline__ void route_fast(const Frame& F) {
    int tid_ = threadIdx.x; asm volatile("" : "+v"(tid_));
    const int tid = tid_, lane = tid & 63, w = __builtin_amdgcn_readfirstlane(tid >> 6), l15 = lane & 15, g = lane >> 4;
    LAS float* lg = (LAS float*)F.lds + w * 16 * 80;
    LAS int* cntL = (LAS int*)(F.lds + 40960); LAS int* baseL = cntL + 64;
    const bf16* WRH = WSP(bf16, WS_WRH); const bf16* WRL = WSP(bf16, WS_WRL); const float* BR = WSP(float, WS_BR);
    const bf16* X2 = DOP(bf16, DO_X2B); int* EIDX = WSP(int, WS_EIDX); float* EW = WSP(float, WS_EW); int* LIST = WSP(int, WS_LIST); float* RS2 = WSP(float, WS_RS2);
    for (int round = 0; round * F.G * 128 < T; ++round) {
        const int m0 = (round * F.G + F.vcu) * 128 + w * 16;
        if (tid < 64) cntL[tid] = 0;
        __syncthreads();
        f32x4 acc[5];
#pragma unroll
        for (int cb = 0; cb < 5; ++cb) acc[cb] = (f32x4){0.f, 0.f, 0.f, 0.f};
        float ss = 0.f;
        const bf16* wh = WRH + lane * 8; const bf16* wl = WRL + lane * 8;
        LAS unsigned char* stg = F.lds + 49152 + w * 8448;
        const int srow = lane >> 5;
        const bf16* xg = X2 + (size_t)(m0 + srow) * 1024 + (lane & 31) * 8;
#if I8_P7
        float mxt; { const f32x4 pm = *(const f32x4*)(WSP(float, WS_XMAX) + (size_t)(m0 + (lane >> 2)) * 16 + (lane & 3) * 4); mxt = fmaxf(fmaxf(pm[0], pm[1]), fmaxf(pm[2], pm[3])); mxt = fmaxf(mxt, __shfl_xor(mxt, 1)); mxt = fmaxf(mxt, __shfl_xor(mxt, 2)); }
        float invr[8];
#pragma unroll
        for (int i_ = 0; i_ < 8; ++i_) { const float mr = __shfl(mxt, 4 * (2 * i_ + srow)); invr[i_] = mr > 0.f ? 127.0f / mr : 0.f; }
        unsigned char* hq = F.ws + WS_ACT + (size_t)(m0 + srow) * 1024 + (lane & 31) * 8;
#endif
        v4u R[8];
#define RT_LOADG(c_) do { _Pragma("unroll") for (int i_ = 0; i_ < 8; ++i_) R[i_] = *(const v4u*)(xg + (size_t)(2 * i_) * 1024 + 256 * (c_)); } while (0)
        RT_LOADG(0);
#pragma unroll 1
        for (int c = 0; c < 4; ++c) {
#pragma unroll
            for (int i_ = 0; i_ < 8; ++i_) { *(LAS v4u*)(stg + (2 * i_ + srow) * 528 + (lane & 31) * 16) = R[i_];
#if I8_P7
                { const f32x4 a = up4(R[i_].x, R[i_].y) * invr[i_], b = up4(R[i_].z, R[i_].w) * invr[i_]; v2u o; o.x = q8pack(a[0], a[1], a[2], a[3]); o.y = q8pack(b[0], b[1], b[2], b[3]);
                  *(v2u*)(hq + (size_t)(2 * i_) * 1024 + 256 * c) = o; }
#endif
            }
            LDS_WAIT(); asm volatile("" ::: "memory");
            if (c < 3) RT_LOADG(c + 1);
#pragma unroll
            for (int h_ = 0; h_ < 4; ++h_) {
                bf16x8 bh[2][5], bl[2][5];
#pragma unroll
                for (int j_ = 0; j_ < 2; ++j_)
#pragma unroll
                    for (int cb = 0; cb < 5; ++cb) { const int ks_ = 8 * c + 2 * h_ + j_; bh[j_][cb] = *(const bf16x8*)(wh + (ks_ * 5 + cb) * 512); bl[j_][cb] = *(const bf16x8*)(wl + (ks_ * 5 + cb) * 512); }
#pragma unroll
                for (int j_ = 0; j_ < 2; ++j_) { const v4u xa = *(const LAS v4u*)(stg + l15 * 528 + 64 * (2 * h_ + j_) + 16 * g);
                    ss = dot2bf(xa.x, xa.x, ss); ss = dot2bf(xa.y, xa.y, ss); ss = dot2bf(xa.z, xa.z, ss); ss = dot2bf(xa.w, xa.w, ss);
                    const bf16x8 xh = __builtin_bit_cast(bf16x8, xa);
#pragma unroll
                    for (int cb = 0; cb < 5; ++cb) {
                        acc[cb] = __builtin_amdgcn_mfma_f32_16x16x32_bf16(xh, bh[j_][cb], acc[cb], 0, 0, 0);
                        acc[cb] = __builtin_amdgcn_mfma_f32_16x16x32_bf16(xh, bl[j_][cb], acc[cb], 0, 0, 0); } }
            }
            LDS_WAIT(); asm volatile("" ::: "memory");
        }
#undef RT_LOADG
        ss += __shfl_xor(ss, 16); ss += __shfl_xor(ss, 32);
        const float rs = rsqrtf(ss * (1.0f / D) + EPS);
#if I8_P7
        { const float ml = __shfl(mxt, 4 * l15); if (g == 0) RS2[m0 + l15] = rs * ml * (1.0f / 127.0f); }
#else
        if (g == 0) RS2[m0 + l15] = rs;
#endif
        float rsr[4];
#pragma unroll
        for (int r = 0; r < 4; ++r) rsr[r] = __shfl(rs, 4 * g + r);
#pragma unroll
        for (int cb = 0; cb < 5; ++cb) { const float bias = BR[16 * cb + l15];
#pragma unroll
            for (int r = 0; r < 4; ++r) lg[(4 * g + r) * 80 + 16 * cb + l15] = acc[cb][r] * rsr[r] + bias; }
        LDS_WAIT(); asm volatile("" ::: "memory");
        int e0 = 0, e1 = 0, r0 = 0, r1 = 0; const int m = m0 + lane;
        if (lane < 16) {
            const LAS float* lt = lg + lane * 80;
            float gl[8];
#pragma unroll
            for (int i = 0; i < 8; ++i) gl[i] = lt[i];
            float gm = gl[0]; int gs = 0;
#pragma unroll
            for (int i = 1; i < 8; ++i) if (gl[i] > gm) { gm = gl[i]; gs = i; }
            float ge = 0.f;
#pragma unroll
            for (int i = 0; i < 8; ++i) ge += __expf(gl[i] - gm);
            const float pg = 1.0f / ge;
            float el[8];
#pragma unroll
            for (int i = 0; i < 8; ++i) el[i] = lt[8 + 8 * gs + i];
            float m1 = el[0]; int i1 = 0;
#pragma unroll
            for (int i = 1; i < 8; ++i) if (el[i] > m1) { m1 = el[i]; i1 = i; }
            float m2 = -3e38f; int i2 = 0;
#pragma unroll
            for (int i = 0; i < 8; ++i) if (i != i1 && el[i] > m2) { m2 = el[i]; i2 = i; }
            const float e2 = __expf(m2 - m1), w0 = pg / (1.0f + e2), w1 = pg * e2 / (1.0f + e2);
            e0 = 8 * gs + i1; e1 = 8 * gs + i2;
            EIDX[m * 2] = e0; EIDX[m * 2 + 1] = e1; EW[m * 2] = w0; EW[m * 2 + 1] = w1;
            if (!DRY) { r0 = __hip_atomic_fetch_add(cntL + e0, 1, __ATOMIC_RELAXED, __HIP_MEMORY_SCOPE_WORKGROUP);
            r1 = __hip_atomic_fetch_add(cntL + e1, 1, __ATOMIC_RELAXED, __HIP_MEMORY_SCOPE_WORKGROUP); }
        }
        __syncthreads();
        if (!DRY && tid < 64) { const int c = cntL[tid]; baseL[tid] = c ? (int)__hip_atomic_fetch_add(F.ctl + CW_CNT + 64 * tid, (unsigned)c, RLX_AGENT) : 0; }
        __syncthreads();
        if (!DRY && lane < 16) { LIST[(size_t)e0 * T + baseL[e0] + r0] = m * 2; LIST[(size_t)e1 * T + baseL[e1] + r1] = m * 2 + 1; }
        __syncthreads();
    }
}
struct Args { const float* in[27]; float* out; unsigned char* ws; int ph_lo, ph_hi, use_bar, pad; };
constexpr int NPHASE = 11;
__device__ __forceinline__ void frame_init(Frame& F, const Args& args, unsigned char* lds) {
    F.lds = (LAS unsigned char*)lds; F.gl = lds;
    F.MISC = (volatile LAS unsigned*)(F.lds + MISC_OFF);
    F.tid = threadIdx.x; F.lane = F.tid & 63; F.wave = __builtin_amdgcn_readfirstlane(F.tid >> 6);
    F.G = gridDim.x; { const int bx = blockIdx.x; F.vcu = (F.G % 8 == 0) ? (bx % 8) * (F.G / 8) + bx / 8 : bx; }
    F.ws = args.ws; F.out = args.out; F.ctl = (gu32*)(args.ws + WS_CTL);
#pragma unroll
    for (int i = 0; i < 27; ++i) F.in[i] = args.in[i];
    for (int u = F.tid; u < 1024 / 4; u += NTHR) ((LAS unsigned*)(F.lds + LDSCTL_OFF))[u] = 0u;
    __syncthreads();
}
template <int PH> __device__ __forceinline__ void run_phase(const Frame& F) {
    if constexpr (PH == 0) { p0_prologue(F); }
    if constexpr (PH == 1) {
#if I8_P1
        Gemm g{WSP(bf16, WS_ACT), WSP(bf16, WS_WIN), 512, nullptr, 0}; StaticOrder S; S.init(T, NIN, F.G, (int)blockIdx.x);
        EpiScaled<EpiIn> E{EpiIn{F.ws, (unsigned char*)F.out, (LAS float*)(F.lds + TAB_OFF)}, WSP(float, WS_SA1), WSP(float, WS_SBIN)};
        gemm_fast<EpiScaled<EpiIn>, StaticOrder, false, GF_ALIGN, GF_SP2, true>(F.lds, g, S, E);
#else
        Gemm g{WSP(bf16, WS_ACT), WSP(bf16, WS_WIN), 1024, nullptr, SKEW_K1024}; StaticOrder S; S.init(T, NIN, F.G, (int)blockIdx.x);
        EpiIn E{F.ws, (unsigned char*)F.out, (LAS float*)(F.lds + TAB_OFF)};
        GEMM_PHASE(EpiIn, StaticOrder, g, S, E);
#endif
    }
    if constexpr (PH == 2) {
#if I8_QKV
        { Gemm g{WSP(bf16, WS_CQ), WSP(bf16, WS_WUQ), 128, nullptr, 0, WSP(bf16, WS_CKVR), WSP(bf16, WS_WUKV), 128}; QKVOrder S; S.init(F.G, (int)blockIdx.x);
          EpiQKV8 E{F.ws, F.in[I_KN]};
          gemm_fast<EpiQKV8, QKVOrder, false, GF_ALIGN, GF_SP2, true, true>(F.lds, g, S, E); }
#elif MERGE_QKV
        { Gemm g{WSP(bf16, WS_CQ), WSP(bf16, WS_WUQ), 256, nullptr, 0, WSP(bf16, WS_CKVR), WSP(bf16, WS_WUKV), 256}; QKVOrder S; S.init(F.G, (int)blockIdx.x);
          EpiQKV E{EpiQ{WSP(bf16, WS_QM), WSP(float, WS_CQSS)}, EpiKV{WSP(bf16, WS_KH), WSP(bf16, WS_VH), WSP(float, WS_CKVSS), WSP(float, WS_KR), WSP(float, WS_ROPE), F.in[I_KN]}};
          gemm_fast<EpiQKV, QKVOrder, false, GF_ALIGN, GF_SP2, false, true>(F.lds, g, S, E); }
#else
        { Gemm g{WSP(bf16, WS_CQ), WSP(bf16, WS_WUQ), 256, nullptr, SKEW_K256}; StaticOrder S; S.init(T, 768, F.G, (int)blockIdx.x); EpiQ E{WSP(bf16, WS_QM), WSP(float, WS_CQSS)}; GEMM_PHASE(EpiQ, StaticOrder, g, S, E); }
        { Gemm g{WSP(bf16, WS_CKVR), WSP(bf16, WS_WUKV), 256, nullptr, SKEW_K256}; StaticOrder S; S.init(T, 1024, F.G, (int)blockIdx.x);
          EpiKV E{WSP(bf16, WS_KH), WSP(bf16, WS_VH), WSP(float, WS_CKVSS), WSP(float, WS_KR), WSP(float, WS_ROPE), F.in[I_KN]}; GEMM_PHASE(EpiKV, StaticOrder, g, S, E); }
#endif
#ifdef PROBE_QKV2
        __syncthreads();
        { Gemm g{WSP(bf16, WS_CQ), WSP(bf16, WS_WUQ), 256, nullptr, SKEW_K256}; StaticOrder S; S.init(T, 768, F.G, (int)blockIdx.x); EpiQ E{WSP(bf16, WS_QM), WSP(float, WS_CQSS)}; GEMM_PHASE(EpiQ, StaticOrder, g, S, E); }
        { Gemm g{WSP(bf16, WS_CKVR), WSP(bf16, WS_WUKV), 256, nullptr, SKEW_K256}; StaticOrder S; S.init(T, 1024, F.G, (int)blockIdx.x);
          EpiKV E{WSP(bf16, WS_KH), WSP(bf16, WS_VH), WSP(float, WS_CKVSS), WSP(float, WS_KR), WSP(float, WS_ROPE), F.in[I_KN]}; GEMM_PHASE(EpiKV, StaticOrder, g, S, E); }
#endif
        HGRN_PHASE(F);
#ifdef PROBE_HGRN2
        __syncthreads(); HGRN_PHASE(F);
#endif
    }
    if constexpr (PH == 3) {
#if STAGGER_CONV
        if (!STAGGER_OA) oa_pass(F);
        const bf16* QM = WSP(bf16, WS_QM); const bf16* KH = WSP(bf16, WS_KH); const bf16* VH = WSP(bf16, WS_VH); bf16* OM = DOP(bf16, DO_OM);
        int it = 0; bool side_done = false;
        for (int item = F.vcu; item < NB * MH * 8; item += F.G, ++it) {
            if (it == (F.vcu & 3)) { side_done = true; __syncthreads(); if (STAGGER_OA) oa_pass(F); conv13_db(F); conv_w2t_strips(F); __syncthreads();
#ifdef PROBE_CONV2
                conv13_db(F); conv_w2t_strips(F); __syncthreads();
#endif
            }
            const int qb = item & 7, h = (item >> 3) & 7, b = item >> 6;
            att::attn_unit(QM, KH, VH, OM, WSP(float, WS_ROPE), F.in[I_QN], b * SEQ + qb * 256, b * SEQ, h, (char*)F.gl, F.in[I_KN]);
        }
        if (!side_done) { __syncthreads(); if (STAGGER_OA) oa_pass(F); conv13_db(F); conv_w2t_strips(F); }
#else
        oa_pass(F); ATTN_PHASE(F);
#endif
    }
    if constexpr (PH == 4) {
        Gemm g{DOP(bf16, DO_OA), WSP(bf16, WS_WOAB), 512, nullptr, SKEW_K512}; PairOrder S; S.init(F.G, (int)blockIdx.x); EpiMerge E{WSP(bf16, WS_ACT), WSP(bf16, WS_GA), WSP(bf16, WS_GB)};
        GEMM_PHASE(EpiMerge, PairOrder, g, S, E);
    }
    if constexpr (PH == 5) {
        Gemm g{WSP(bf16, WS_ACT), WSP(bf16, WS_WOUT), 1024, nullptr, SKEW_K1024}; StaticOrder S; S.init(T, D, F.G, (int)blockIdx.x); EpiX2 E{F.in[I_X], DOP(bf16, DO_X2B), WSP(float, WS_XMAX)};
        GEMM_PHASE(EpiX2, StaticOrder, g, S, E);
    }
    if constexpr (PH == 6) { ROUTE_PHASE(F); __syncthreads();
#if !STAGGER_CONV
#if I8_P7
        conv8_mat<M_W13>(F, F.ws + WS_W13, WSP(float, WS_SB13), 0);
#else
        conv_mat<M_W13>(F);
#endif
        conv_mat<M_W2T>(F);
#endif
    }
    if constexpr (PH == 7) {
        moe_build_table(F);
#if I8_P7
        Gemm g{WSP(bf16, WS_ACT), WSP(bf16, WS_W13), 512, WSP(int, WS_LIST), 0}; MoeOrder S{(const LAS int*)(F.lds + TAB_OFF), 2, F.G, (int)blockIdx.x};
        EpiScaled<EpiUp, false> E{EpiUp{WSP(bf16, WS_H1), WSP(int, WS_LIST), WSP(float, WS_RS2)}, nullptr, WSP(float, WS_SB13)};
        gemm_fast<EpiScaled<EpiUp, false>, MoeOrder, true, GF_ALIGN, GF_SP2, true>(F.lds, g, S, E);
#else
        Gemm g{DOP(bf16, DO_X2B), WSP(bf16, WS_W13), 1024, WSP(int, WS_LIST), SKEW_K1024}; MoeOrder S{(const LAS int*)(F.lds + TAB_OFF), 2, F.G, (int)blockIdx.x}; EpiUp E{WSP(bf16, WS_H1), WSP(int, WS_LIST), WSP(float, WS_RS2)};
        GEMM_PHASE_GATHER(EpiUp, MoeOrder, g, S, E);
#endif
    }
    if constexpr (PH == 8) {
#if N_LAUNCHES != 1
        moe_build_table(F);
#endif
        Gemm g{WSP(bf16, WS_H1), WSP(bf16, WS_W2T), 256, nullptr, SKEW_K256}; MoeOrder S{(const LAS int*)(F.lds + TAB_OFF), 4, F.G, (int)blockIdx.x}; EpiDown E{WSP(bf16, WS_Y0), WSP(bf16, WS_Y1), WSP(int, WS_LIST), WSP(float, WS_EW)};
        GEMM_PHASE(EpiDown, MoeOrder, g, S, E);
    }
    if constexpr (PH == 9) {
#if !FUSE_PROJ
        Gemm g{WSP(bf16, WS_PB), WSP(bf16, WS_WPP), 256, nullptr, SKEW_K256}; StaticOrder S; S.init(T, D, F.G, (int)blockIdx.x); EpiProj E{WSP(bf16, WS_PROJ)};
        GEMM_PHASE(EpiProj, StaticOrder, g, S, E);
#endif
        x3_pass(F);
    }
    if constexpr (PH == 10) {
#if FUSE_PROJ && GATE_FIRST
        Gemm g{WSP(bf16, WS_ACT), WSP(bf16, WS_WPG), 512, nullptr, 0, WSP(bf16, WS_PB), WSP(bf16, WS_WPP), 128}; ProjGateOrder S; S.init(F.G, (int)blockIdx.x);
        EpiGateProj E{F.out, WSP(bf16, WS_X3B), F.ws + WS_PROJ + (size_t)blockIdx.x * 65536, WSP(float, WS_SA3), WSP(float, WS_SBPG), WSP(float, WS_SAP), WSP(float, WS_SBPP)};
        gemm_fast<EpiGateProj, ProjGateOrder, false, GF_ALIGN, GF_SP2, true, true>(F.lds, g, S, E);
#elif FUSE_PROJ
        Gemm g{WSP(bf16, WS_PB), WSP(bf16, WS_WPP), 128, nullptr, 0, WSP(bf16, WS_ACT), WSP(bf16, WS_WPG), 512}; ProjGateOrder S; S.init(F.G, (int)blockIdx.x);
        EpiProjGate E{F.out, WSP(bf16, WS_X3B), F.ws + WS_PROJ + (size_t)blockIdx.x * 131072, WSP(float, WS_SA3), WSP(float, WS_SBPG), WSP(float, WS_SAP), WSP(float, WS_SBPP)};
        gemm_fast<EpiProjGate, ProjGateOrder, false, GF_ALIGN, GF_SP2, true, true>(F.lds, g, S, E);
#elif I8_P10
        Gemm g{WSP(bf16, WS_ACT), WSP(bf16, WS_WPG), 512, nullptr, 0}; StaticOrder S; S.init(T, D, F.G, (int)blockIdx.x); EpiFinal8 E{F.out, WSP(bf16, WS_X3B), WSP(bf16, WS_PROJ), WSP(float, WS_SA3), WSP(float, WS_SBPG)};
        gemm_fast<EpiFinal8, StaticOrder, false, GF_ALIGN, GF_SP2, true>(F.lds, g, S, E);
#else
        Gemm g{WSP(bf16, WS_ACT), WSP(bf16, WS_WPG), 1024, nullptr, SKEW_K1024}; StaticOrder S; S.init(T, D, F.G, (int)blockIdx.x); EpiFinal E{F.out, WSP(bf16, WS_PROJ)};
        GEMM_PHASE(EpiFinal, StaticOrder, g, S, E);
#endif
    }
}

template <int PH> __global__ void __launch_bounds__(NTHR, 2) phase_kernel(Args args) {
    extern __shared__ __attribute__((aligned(16))) unsigned char lds[];
    Frame F; frame_init(F, args, lds);
    run_phase<PH>(F);
}
#if N_LAUNCHES == 1
__global__ void __launch_bounds__(NTHR, 2) mega(Args args) {
    extern __shared__ __attribute__((aligned(16))) unsigned char lds[];
    Frame F; frame_init(F, args, lds);
    XcdBarrier bar = xcd_barrier_post((unsigned*)(F.ctl + CW_BAR), F.MISC + 8);
#define PHASE(k) do { Frame Fk = F; int t_ = threadIdx.x; asm volatile("" : "+v"(t_)); Fk.tid = t_; Fk.lane = t_ & 63; Fk.wave = __builtin_amdgcn_readfirstlane(t_ >> 6); run_phase<k>(Fk); } while (0)
#define XBAR() xcd_barrier(bar)
    PHASE(0); XBAR();
    PHASE(1); XBAR();
    PHASE(2); XBAR();
    PHASE(3); XBAR();
    PHASE(4); XBAR();
    PHASE(5); XBAR();
    PHASE(6); XBAR();
    PHASE(7); XBAR();
    PHASE(8); XBAR();
    PHASE(9); XBAR();
    PHASE(10);
#undef PHASE
#undef XBAR
}
#endif
extern "C" void kernel_launch(void* const* d_in, const int* in_sizes, int n_in, void* d_out, int out_size, void* d_ws, size_t ws_size, hipStream_t stream) {
    static int grid = 0;
    if (grid == 0) {
        if (n_in != 27 || in_sizes[0] != T * D || out_size != T * D || ws_size < WS_END) { fprintf(stderr, "kernel_launch: unexpected shapes (n_in %d, in0 %d, out %d, ws %zu)\n", n_in, n_in > 0 ? in_sizes[0] : -1, out_size, ws_size); grid = -1; return; }
        int dev = 0, cus = 0;
        if (hipGetDevice(&dev) != hipSuccess || hipDeviceGetAttribute(&cus, hipDeviceAttributeMultiprocessorCount, dev) != hipSuccess) { grid = -1; return; }
#if N_LAUNCHES == 1
        if (hipFuncSetAttribute((const void*)mega, hipFuncAttributeMaxDynamicSharedMemorySize, LDS_BYTES) != hipSuccess) { fprintf(stderr, "kernel_launch: hipFuncSetAttribute failed\n"); grid = -1; return; }
#else
#define SETATTR(k) if (hipFuncSetAttribute((const void*)phase_kernel<k>, hipFuncAttributeMaxDynamicSharedMemorySize, LDS_BYTES) != hipSuccess) { fprintf(stderr, "kernel_launch: hipFuncSetAttribute failed\n"); grid = -1; return; }
        SETATTR(0) SETATTR(1) SETATTR(2) SETATTR(3) SETATTR(4) SETATTR(5) SETATTR(6) SETATTR(7) SETATTR(8) SETATTR(9) SETATTR(10)
#endif
        grid = cus;
    }
    if (grid < 0) return;
    (void)hipMemsetAsync((char*)d_ws + WS_CTL, 0, CTL_ZERO_BYTES, stream);
    Args a{};
    for (int i = 0; i < 27; ++i) a.in[i] = (const float*)d_in[i];
    a.out = (float*)d_out; a.ws = (unsigned char*)d_ws;
#if N_LAUNCHES == 1
    a.ph_lo = 0; a.ph_hi = NPHASE; a.use_bar = 1;
    hipLaunchKernelGGL(mega, dim3(grid), dim3(NTHR), LDS_BYTES, stream, a);
#else
#define LAUNCH_PH(k) hipLaunchKernelGGL(phase_kernel<k>, dim3(grid), dim3(NTHR), LDS_BYTES, stream, a)
#ifndef LAST_PHASE
#define LAST_PHASE 10
#endif
    LAUNCH_PH(0); LAUNCH_PH(1); LAUNCH_PH(2); LAUNCH_PH(3); LAUNCH_PH(4); LAUNCH_PH(5);
    if (LAST_PHASE >= 6) { LAUNCH_PH(6); } if (LAST_PHASE >= 7) { LAUNCH_PH(7); } if (LAST_PHASE >= 8) { LAUNCH_PH(8); } if (LAST_PHASE >= 9) { LAUNCH_PH(9); } if (LAST_PHASE >= 10) { LAUNCH_PH(10); }
#endif
    const hipError_t le = hipPeekAtLastError();
    if (le != hipSuccess) fprintf(stderr, "kernel_launch: launch failed: %s\n", hipGetErrorName(le));
}
```

```cpp
#define N_LAUNCHES 1
#define NAIVE_MOE 0
#define GEMM_PHASE(EPI, SCHED, g, S, E) gemm_fast<EPI, SCHED, false>(F.lds, g, S, E)
#define GEMM_PHASE_GATHER(EPI, SCHED, g, S, E) gemm_fast<EPI, SCHED, true>(F.lds, g, S, E)
#define HGRN_PHASE(F) hgrn_fast2(F)
#define ATTN_PHASE(F) attn_fast(F)
#define ROUTE_PHASE(F) route_fast<false>(F)
#define SKEW_K1024 0
#define SKEW_K512 0
#define SKEW_K256 0
#define I8_P10 1
#define I8_P1 1
#define I8_P7 1
#define FUSE_PROJ 1
#define STAGGER_CONV 1
#define MERGE_QKV 1
#define GATE_U8 1
#define GATE_FIRST 1
#include <hip/hip_runtime.h>
#include <cstdio>
#include <cstdint>

#define GAS __attribute__((address_space(1)))
#define LAS __attribute__((address_space(3)))
typedef unsigned short bf16;
typedef unsigned v4u __attribute__((ext_vector_type(4)));
typedef unsigned v2u __attribute__((ext_vector_type(2)));
typedef float f32x4 __attribute__((ext_vector_type(4)));
typedef float f32x2 __attribute__((ext_vector_type(2)));
typedef short bf16x8 __attribute__((ext_vector_type(8)));
typedef GAS unsigned gu32;
#define RLX_AGENT __ATOMIC_RELAXED, __HIP_MEMORY_SCOPE_AGENT
#define LDS_WAIT() asm volatile("s_waitcnt lgkmcnt(0)" ::: "memory")
#define VM_WAIT() asm volatile("s_waitcnt vmcnt(0)" ::: "memory")

constexpr int NB = 16, SEQ = 2048, T = NB * SEQ, D = 1024;
constexpr int HGH = 4, HGK = 128, HGV = 128, HGF = 512, CHUNK = 64, NCHUNK = T / CHUNK;
constexpr int MH = 8, NOPE = 64, ROPE = 32, QK = 96, VD = 64, QR = 256, KVR = 128;
constexpr int NG = 8, EPG = 8, NE = 64, DE = 256, PLE = 256;
constexpr int DIN = 5024, NIN = 5120;
constexpr float EPS = 1e-6f;
constexpr int NWAVES = 8, NTHR = 512;

__device__ __forceinline__ unsigned f2bf(float f) { unsigned u = __builtin_bit_cast(unsigned, f); return (u + 0x7fffu + ((u >> 16) & 1u)) >> 16; }
typedef __bf16 bf16pair_t __attribute__((ext_vector_type(2)));
__device__ __forceinline__ unsigned pk2(float lo, float hi) { const f32x2 v = {lo, hi}; return __builtin_bit_cast(unsigned, __builtin_convertvector(v, bf16pair_t)); }
__device__ __forceinline__ float bf2f(unsigned b) { return __builtin_bit_cast(float, b << 16); }
__device__ __forceinline__ float bflo(unsigned w) { return __builtin_bit_cast(float, w << 16); }
__device__ __forceinline__ float bfhi(unsigned w) { return __builtin_bit_cast(float, w & 0xffff0000u); }
__device__ __forceinline__ float sigm(float x) { return __builtin_amdgcn_rcpf(1.0f + __expf(-x)); }
__device__ __forceinline__ float silu_(float x) { return x * __builtin_amdgcn_rcpf(1.0f + __expf(-x)); }
__device__ __forceinline__ float wave_sum(float v) {
#pragma unroll
    for (int o = 1; o < 64; o <<= 1) v += __shfl_xor(v, o);
    return v;
}
__device__ __forceinline__ float wave_max(float v) {
#pragma unroll
    for (int o = 1; o < 64; o <<= 1) v = fmaxf(v, __shfl_xor(v, o));
    return v;
}
__host__ __device__ __forceinline__ int perm8(int p) { const int r = p & 31, n = r >> 4, fq = (r >> 2) & 3, j = r & 3; return (p & ~31) + 8 * fq + 4 * n + j; }
__host__ __device__ __forceinline__ int iperm8(int l) { const int r = l & 31, fq = r >> 3, n = (r >> 2) & 1, j = r & 3; return (l & ~31) + 16 * n + 4 * fq + j; }

#ifndef STAGGER_CONV
#define STAGGER_CONV 0
#endif
#ifndef STAGGER_OA
#define STAGGER_OA 0
#endif
constexpr size_t MiB = 1u << 20;
constexpr size_t WS_CTL = 0, CTL_ZERO_BYTES = 65536;
constexpr size_t WS_LB = 1 * MiB;
constexpr size_t WS_WRH = 1 * MiB + 65536, WS_WRL = WS_WRH + 80 * 1024 * 2;
constexpr size_t WS_BR = WS_WRL + 80 * 1024 * 2;
constexpr size_t WS_SAQ = 1 * MiB + 512 * 1024, WS_SAKV = WS_SAQ + 128 * 1024, WS_SBUQ = 1 * MiB + 768 * 1024, WS_SBUKV = WS_SBUQ + 4096;
constexpr size_t WS_RS2 = 2 * MiB;
constexpr size_t WS_CQSS = 2 * MiB;
constexpr size_t WS_CKVSS = 2 * MiB + 512 * 1024;
constexpr size_t WS_SA3 = 3 * MiB, WS_SA1 = 3 * MiB + 128 * 1024;
constexpr size_t WS_SBPG = 3 * MiB + 256 * 1024, WS_SBIN = WS_SBPG + 4096, WS_SB13 = 3 * MiB + 512 * 1024;
constexpr size_t WS_SAP = 3 * MiB + 640 * 1024, WS_SBPP = 3 * MiB + 768 * 1024;
constexpr size_t WS_ROPE = 4 * MiB;
constexpr size_t WS_EREF = 8 * MiB, WS_ELAST = 10 * MiB;
constexpr size_t WS_EIDX = 12 * MiB;
constexpr size_t WS_EW = 12 * MiB + 512 * 1024;
constexpr size_t WS_KR = 13 * MiB;
constexpr size_t WS_XMAX = 13 * MiB;
constexpr size_t WS_LIST = 4 * MiB;
constexpr size_t WS_WIN = 17 * MiB, WS_WOAB = 27 * MiB, WS_WUQ = 29 * MiB, WS_WUKV = 29 * MiB + 512 * 1024, WS_WOUT = 30 * MiB, WS_WPG = 32 * MiB, WS_WPP = 34 * MiB;
constexpr size_t WS_ACT = 36 * MiB;
constexpr size_t WS_VA = 100 * MiB, WS_OG = 132 * MiB, WS_CQ = 164 * MiB, WS_CKVR = 180 * MiB, WS_GA = 196 * MiB, WS_GB = 260 * MiB;
constexpr size_t WS_QM = 324 * MiB, WS_KH = 372 * MiB, WS_VH = 420 * MiB, WS_PB = 452 * MiB, WS_END = 468 * MiB;
#if STAGGER_CONV
constexpr size_t WS_W13 = 100 * MiB, WS_W2T = 164 * MiB;
#else
constexpr size_t WS_W13 = 196 * MiB, WS_W2T = 260 * MiB;
#endif
constexpr size_t WS_H1 = 324 * MiB;
constexpr size_t WS_Y0 = 100 * MiB, WS_Y1 = 372 * MiB;
constexpr size_t WS_PROJ = 292 * MiB;
constexpr size_t DO_QF = 0, DO_KF = 32 * MiB, DO_QB = 64 * MiB, DO_KB = 96 * MiB, DO_OA = 0, DO_OM = 32 * MiB;
constexpr size_t DO_X2B = 64 * MiB;
constexpr size_t WS_X3B = 196 * MiB;
constexpr int CW_TMO = 0, CW_CODE = 1, CW_BAR = 4096, CW_CNT = 8192  ;
constexpr int MAXROWT = 320;
constexpr int RING_BYTES = 131072, LDSCTL_OFF = RING_BYTES, MISC_OFF = LDSCTL_OFF + 320, TAB_OFF = RING_BYTES + 1024, LDS_BYTES = 147456;
#define XB_TMO      128
#define XB_XCNT(j)  (256  + 64 * (j))
#define XB_XSUB(j)  (1280 + 64 * (j))
#define XB_XGEN(j)  (2304 + 64 * (j))
#define XB_TOP      3328
#define XB_TOPGEN   3392
#define XCD_BAR_WORDS 3456
#define XB_SPIN_CAP (1u << 18)

__device__ __forceinline__ unsigned xb_ld(unsigned* p)              { return __hip_atomic_load(p, __ATOMIC_RELAXED, __HIP_MEMORY_SCOPE_AGENT); }
__device__ __forceinline__ unsigned xb_add(unsigned* p, unsigned v) { return __hip_atomic_fetch_add(p, v, __ATOMIC_RELAXED, __HIP_MEMORY_SCOPE_AGENT); }
__device__ __forceinline__ unsigned xb_xcc_id() { return (unsigned)__builtin_amdgcn_s_getreg((3 << 11) | 20) & 0xFu; }
#define XB_SPIN(cond, bar) do { unsigned _sp = 0; while (cond) { __builtin_amdgcn_s_sleep(1); \
    if ((++_sp & 255u) == 0u) { if (xb_ld(&(bar)[XB_TMO])) break; if (_sp > XB_SPIN_CAP) { atomicAdd(&(bar)[XB_TMO], 1u); break; } } } } while (0)

struct XcdBarrier {
    unsigned* bar; unsigned x;
    volatile LAS unsigned* st;
};

__device__ __forceinline__ XcdBarrier xcd_barrier_post(unsigned* bar, volatile LAS unsigned* st) {
    XcdBarrier b; b.bar = bar; b.x = xb_xcc_id(); b.st = st;
    if (threadIdx.x == 0) (void)xb_add(&bar[XB_XCNT(b.x)], 1u);
    return b;
}
__device__ __forceinline__ void xcd_barrier_complete(unsigned* bar, unsigned x, unsigned& nloc, unsigned& nx) {
    const unsigned G = gridDim.x * gridDim.y * gridDim.z;
    unsigned sum, cnt, mine, sp = 0u;
    for (;;) {
        sum = 0u; cnt = 0u; mine = 0u;
#pragma unroll
        for (unsigned j = 0; j < 16; ++j) { const unsigned c = xb_ld(&bar[XB_XCNT(j)]); sum += c; cnt += (c > 0u) ? 1u : 0u; mine = (j == x) ? c : mine; }
        if (sum == G) break;
        __builtin_amdgcn_s_sleep(1);
        if ((++sp & 255u) == 0u) { if (xb_ld(&bar[XB_TMO])) break; if (sp > XB_SPIN_CAP) { atomicAdd(&bar[XB_TMO], 1u); break; } }
    }
    nloc = mine > 0u ? mine : 1u; nx = cnt > 0u ? cnt : 1u;
}

__device__ __forceinline__ void xcd_barrier(const XcdBarrier& b) {
    asm volatile("s_waitcnt vmcnt(0)" ::: "memory");
    __syncthreads();
    if (threadIdx.x == 0) {
        unsigned* bar = b.bar;
        __builtin_amdgcn_s_waitcnt(0);
        unsigned nloc = b.st[0], nx = b.st[1];
        if (nloc == 0u) { xcd_barrier_complete(bar, b.x, nloc, nx); b.st[0] = nloc; b.st[1] = nx; }
        const unsigned old = xb_add(&bar[XB_XSUB(b.x)], 1u);
        const unsigned gen = old / nloc;
        if (old + 1u == (gen + 1u) * nloc) {
            __builtin_amdgcn_fence(__ATOMIC_RELEASE, "agent");
            asm volatile("s_waitcnt vmcnt(0)" ::: "memory");
            const unsigned og = xb_add(&bar[XB_TOP], 1u);
            const unsigned tg = og / nx;
            if (og + 1u == (tg + 1u) * nx) xb_add(&bar[XB_TOPGEN], 1u);
            else XB_SPIN(xb_ld(&bar[XB_TOPGEN]) == tg, bar);
            __builtin_amdgcn_fence(__ATOMIC_ACQUIRE, "agent");
            xb_add(&bar[XB_XGEN(b.x)], 1u);
            asm volatile("s_waitcnt vmcnt(0)" ::: "memory");
        } else {
            XB_SPIN(xb_ld(&bar[XB_XGEN(b.x)]) == gen, bar);
            __builtin_amdgcn_fence(__ATOMIC_ACQUIRE, "agent");
            asm volatile("s_waitcnt vmcnt(0)" ::: "memory");
        }
    }
    __syncthreads();
}
struct Unit { int pm, pn, lbase, nvalid, kind; };
struct Gemm { const bf16* A; const bf16* Bt; int K; const int* list; int skew; const bf16* A2; const bf16* Bt2; int K2; };
typedef __bf16 bf16x2_t __attribute__((ext_vector_type(2)));
__device__ __forceinline__ float dot2bf(unsigned a, unsigned b, float c) { return __builtin_amdgcn_fdot2_f32_bf16(__builtin_bit_cast(bf16x2_t, a), __builtin_bit_cast(bf16x2_t, b), c, false); }

#ifndef I8_P10
#define I8_P10 0
#endif
#ifndef I8_P1
#define I8_P1 0
#endif
#ifndef I8_P7
#define I8_P7 0
#endif
#ifndef I8_QKV
#define I8_QKV 0
#endif
#ifndef MERGE_QKV
#define MERGE_QKV 0
#endif
#ifndef GATE_U8
#define GATE_U8 0
#endif
#ifndef GATE_FIRST
#define GATE_FIRST 0
#endif
#ifndef FUSE_PROJ
#define FUSE_PROJ 0
#endif
typedef int i32x4 __attribute__((ext_vector_type(4)));
template <bool I8> struct AccSel { typedef f32x4 type; };
template <> struct AccSel<true> { typedef i32x4 type; };
constexpr int NXCD = 8, WGM = 8;
struct StaticOrder {
    int nM, nN, nwg, G, c;
    __device__ void init(int M, int N, int G_, int c_) { nM = M / 256; nN = N / 256; nwg = nM * nN; G = G_; c = c_; }
    __device__ __forceinline__ bool next(int i, Unit& u) const {
        const long L = (long)i * G + c; if (L >= nwg) return false;
        int wgid = (int)L; { const int q = nwg / NXCD, r = nwg % NXCD, xcd = wgid % NXCD, off = wgid / NXCD; wgid = (xcd < r ? xcd * (q + 1) : r * (q + 1) + (xcd - r) * q) + off; }
        const int nig = WGM * nN, gid = wgid / nig, fm = gid * WGM, gsz = (nM - fm) < WGM ? (nM - fm) : WGM;
        u.pm = fm + ((wgid % nig) % gsz); u.pn = (wgid % nig) / gsz; u.lbase = 0; u.nvalid = 256; u.kind = 0; return true;
    }
};
struct PairOrder {
    StaticOrder so;
    __device__ void init(int G_, int c_) { so.init(T, D, G_, c_); }
    __device__ __forceinline__ bool next(int i, Unit& u) const { if (!so.next(i >> 1, u)) return false; if (i & 1) { u.pm += T / 256; u.pn += D / 256; } return true; }
};
struct ProjGateOrder {
    StaticOrder so;
    __device__ void init(int G_, int c_) { so.init(T, D, G_, c_); }
    __device__ __forceinline__ bool next(int i, Unit& u) const { if (!so.next(i >> 1, u)) return false; u.kind = i & 1; return true; }
};
struct QKVOrder {
    int G, c;
    __device__ void init(int G_, int c_) { G = G_; c = c_; }
    __device__ __forceinline__ bool next(int i, Unit& u) const {
        constexpr int NQ = (T / 256) * 3, NKV = (T / 256) * 4;
        const int L = i * G + c; if (L >= NQ + NKV) return false;
        StaticOrder so;
        if (L < NQ) { so.init(T, 768, 1, 0); so.next(L, u); u.kind = 0; } else { so.init(T, 1024, 1, 0); so.next(L - NQ, u); u.kind = 1; }
        return true;
    }
};
struct MoeOrder {
    const LAS int* tab; int npn, G, c;
    __device__ __forceinline__ bool next(int i, Unit& u) const {
        const int L = i * G + c; const int nt = tab[0]; if (L >= nt * npn) return false;
        const int rt = L / npn, pl = L - rt * npn; const int e = tab[16 + 4 * rt];
        u.pm = rt; u.pn = e * npn + pl; u.lbase = tab[16 + 4 * rt + 1]; u.nvalid = tab[16 + 4 * rt + 2]; u.kind = 0; return true;
    }
};

constexpr int BM = 256, BK = 64, HALF = 128, HTB = HALF * BK * 2, STAGE_BYTES = 8 * HTB;
__host__ __device__ __forceinline__ int lds_byte(int r, int c) { const int st = (r >> 4) * 2 + (c >> 5), rr = r & 15, cc = c & 31, ob = rr * 64 + cc * 2; return st * 1024 + (ob ^ (((ob >> 9) & 1) << 5)); }
__host__ __device__ __forceinline__ void stage_rc(int b, int& R, int& C) { const int st = b / 1024, sb = b % 1024, swz = sb ^ (((sb >> 9) & 1) << 5); R = (st >> 1) * 16 + swz / 64; C = (st & 1) * 32 + (swz % 64) / 2; }
#ifndef GF_SP2
#define GF_SP2 true
#endif
#ifndef GF_ALIGN
#define GF_ALIGN true
#endif
template <class Epi, class Sched, bool GATHER = false, bool ALIGN_EPI = GF_ALIGN, bool SP2 = GF_SP2, bool I8 = false, bool DUAL = false>
__device__ __forceinline__ void gemm_fast(LAS unsigned char* lds, const Gemm g, const Sched& S, const Epi& E) {
    int tid_ = threadIdx.x; asm volatile("" : "+v"(tid_));
    const int tid = tid_, wid = __builtin_amdgcn_readfirstlane(tid >> 6), lane = tid & 63, wr = wid >> 2, wc = wid & 3, fr = lane & 15, fq = lane >> 4;
    static_assert(!(DUAL && (GATHER || !SP2)), "DUAL: plain A rows, SP2 schedule only");
    const int K = g.K;
#define PG8_UK(u) ((DUAL && (u).kind) ? g.K2 : g.K)
    unsigned v0[2], v1[2], nv0[2], nv1[2], voffB[2]; int sR[2], sC[2];
#pragma unroll
    for (int i = 0; i < 2; ++i) { stage_rc(tid * 16 + i * 8192, sR[i], sC[i]); voffB[i] = (unsigned)(sR[i] * K + sC[i]) * 2u; }
#define PG8_AOFF(u, o0, o1) do { _Pragma("unroll") for (int _i = 0; _i < 2; ++_i) { \
        if constexpr (GATHER) { const int r0_ = sR[_i] < (u).nvalid ? sR[_i] : (u).nvalid - 1, r1_ = (128 + sR[_i]) < (u).nvalid ? 128 + sR[_i] : (u).nvalid - 1; \
            o0[_i] = ((unsigned)(g.list[(u).lbase + r0_] >> 1) * (unsigned)K + (unsigned)sC[_i]) * 2u; o1[_i] = ((unsigned)(g.list[(u).lbase + r1_] >> 1) * (unsigned)K + (unsigned)sC[_i]) * 2u; } \
        else { const int K_ = PG8_UK(u); o0[_i] = (unsigned)(sR[_i] * K_ + sC[_i]) * 2u; o1[_i] = o0[_i] + (unsigned)(HALF * K_ * 2); } } } while (0)
    const size_t kstep = (size_t)(BK * 2);
    size_t hstep = (size_t)HALF * K * 2;
    const size_t tstep = 2 * hstep;
    size_t nhstep = hstep; int nt = K / BK, nnt = nt;
    const unsigned ldsw = (unsigned)wid * 1024u;
    const int aoff = lds_byte(wr * 64 + fr, fq * 8), boff = lds_byte(wc * 32 + fr, fq * 8);
#define PG8_SA(b, h) (((b) * 2 + (h)) * HTB)
#define PG8_SB(b, h) ((4 + (b) * 2 + (h)) * HTB)
#define PG8_STAGE(bufoff, gbase, voff) do { _Pragma("unroll") for (int _i = 0; _i < 2; ++_i) \
        __builtin_amdgcn_global_load_lds((const unsigned*)((const char*)(gbase) + (voff)[_i]), (LAS unsigned*)(lds + (bufoff) + ldsw + _i * 8192), 16, 0, 0); } while (0)
#define PG8_LDA(dst, b, h) do { _Pragma("unroll") for (int m = 0; m < 4; ++m) _Pragma("unroll") for (int k = 0; k < 2; ++k) dst[m][k] = *(const LAS bf16x8*)(lds + PG8_SA(b, h) + aoff + m * 2048 + k * 1024); } while (0)
#define PG8_LDB(dst, b, h) do { _Pragma("unroll") for (int n = 0; n < 2; ++n) _Pragma("unroll") for (int k = 0; k < 2; ++k) dst[n][k] = *(const LAS bf16x8*)(lds + PG8_SB(b, h) + boff + n * 2048 + k * 1024); } while (0)
#define PG8_MMA(ai, bj, At, Bt) do { __builtin_amdgcn_s_setprio(1); _Pragma("unroll") for (int m = 0; m < 4; ++m) _Pragma("unroll") for (int n = 0; n < 2; ++n) _Pragma("unroll") for (int k = 0; k < 2; ++k) \
        { if constexpr (I8) acc[ai][bj][m][n] = __builtin_amdgcn_mfma_i32_16x16x64_i8(__builtin_bit_cast(i32x4, Bt[n][k]), __builtin_bit_cast(i32x4, At[m][k]), acc[ai][bj][m][n], 0, 0, 0); \
          else acc[ai][bj][m][n] = __builtin_amdgcn_mfma_f32_16x16x32_bf16(Bt[n][k], At[m][k], acc[ai][bj][m][n], 0, 0, 0); } __builtin_amdgcn_s_setprio(0); } while (0)
#define PG8_WAIT_V(n) asm volatile("s_waitcnt vmcnt(" #n ")" ::: "memory")
#define PG8_WAIT_L(n) asm volatile("s_waitcnt lgkmcnt(" #n ")" ::: "memory")
#define PG8_BAR __builtin_amdgcn_s_barrier()
#define PG8_SCHED __builtin_amdgcn_sched_barrier(0)
    Unit cur, nxt; int ui = 0;
    if (!S.next(0, cur)) return;
    if (g.skew > 0) {
        const unsigned bx = blockIdx.x, idx = ((bx >> 3) & 31u) * 8u + (bx & 7u);
        const unsigned long long t0 = __builtin_amdgcn_s_memrealtime(); const unsigned long long d = ((unsigned long long)idx * (unsigned)g.skew) >> 8;
        while (__builtin_amdgcn_s_memrealtime() - t0 < d) __builtin_amdgcn_s_sleep(8);
    }
    typedef typename AccSel<I8>::type acc_t;
    acc_t acc[2][2][4][2];
#pragma unroll
    for (int a = 0; a < 2; ++a)
#pragma unroll
        for (int b = 0; b < 2; ++b)
#pragma unroll
            for (int m = 0; m < 4; ++m)
#pragma unroll
                for (int n = 0; n < 2; ++n) acc[a][b][m][n] = (acc_t){0, 0, 0, 0};
    bf16x8 At[4][2], B0[2][2], B1[2][2];
#define PG8_ABASE(u) (DUAL ? (const char*)g.A + ((u).kind ? (size_t)((const char*)g.A2 - (const char*)g.A) : (size_t)0) + (size_t)(u).pm * (size_t)(2 * HALF * 2) * PG8_UK(u) : (const char*)g.A + (GATHER ? (size_t)0 : (size_t)(u).pm * tstep))
#define PG8_BBASE(u) (DUAL ? (const char*)g.Bt + ((u).kind ? (size_t)((const char*)g.Bt2 - (const char*)g.Bt) : (size_t)0) + (size_t)(u).pn * (size_t)(2 * HALF * 2) * PG8_UK(u) : (const char*)g.Bt + (size_t)(u).pn * tstep)
    const char* cA = PG8_ABASE(cur); const char* cB = PG8_BBASE(cur);
    unsigned v0s = 0u, nv0s = 0u;
#define PG8_BASEOFF(u, o) do { int R_, C_; stage_rc(tid * 16, R_, C_); o = (unsigned)(R_ * PG8_UK(u) + C_) * 2u; } while (0)
    if constexpr (DUAL) { const int K_ = PG8_UK(cur); hstep = (size_t)HALF * K_ * 2; nt = K_ / BK; PG8_BASEOFF(cur, v0s);
    }
    else { PG8_AOFF(cur, v0, v1); }
    if constexpr (SP2 && DUAL) {
#define PG8_STAGE1(bufoff, gbase, o0_) do { unsigned t_[2] = {(o0_), (o0_) + (unsigned)(hstep >> 1)}; PG8_STAGE(bufoff, gbase, t_); } while (0)
        PG8_STAGE1(PG8_SB(0, 0), cB, v0s); PG8_STAGE1(PG8_SB(0, 1), cB + hstep, v0s); PG8_STAGE1(PG8_SA(0, 0), cA, v0s); PG8_STAGE1(PG8_SA(0, 1), cA + hstep, v0s);
        if (wr == 1) PG8_BAR;
        PG8_WAIT_V(2); PG8_BAR;
        PG8_STAGE1(PG8_SB(1, 0), cB + kstep, v0s); PG8_STAGE1(PG8_SA(1, 0), cA + kstep, v0s); PG8_STAGE1(PG8_SB(1, 1), cB + hstep + kstep, v0s);
        PG8_WAIT_V(6); PG8_BAR;
#undef PG8_STAGE1
    } else if constexpr (SP2) {
        PG8_STAGE(PG8_SB(0, 0), cB, voffB); PG8_STAGE(PG8_SB(0, 1), cB + hstep, voffB); PG8_STAGE(PG8_SA(0, 0), cA, v0); PG8_STAGE(PG8_SA(0, 1), cA, v1);
        if (wr == 1) PG8_BAR;
        PG8_WAIT_V(2); PG8_BAR;
        PG8_STAGE(PG8_SB(1, 0), cB + kstep, voffB); PG8_STAGE(PG8_SA(1, 0), cA + kstep, v0); PG8_STAGE(PG8_SB(1, 1), cB + hstep + kstep, voffB);
        PG8_WAIT_V(6); PG8_BAR;
    } else {
        PG8_STAGE(PG8_SB(0, 0), cB, voffB); PG8_STAGE(PG8_SA(0, 0), cA, v0); PG8_STAGE(PG8_SB(0, 1), cB + hstep, voffB); PG8_STAGE(PG8_SA(0, 1), cA, v1);
        if (wr == 1) PG8_BAR;
        PG8_WAIT_V(4); PG8_BAR;
        PG8_STAGE(PG8_SB(1, 0), cB + kstep, voffB); PG8_STAGE(PG8_SA(1, 0), cA + kstep, v0); PG8_STAGE(PG8_SB(1, 1), cB + hstep + kstep, voffB);
        PG8_WAIT_V(6); PG8_BAR;
    }
    for (;;) {
        const bool has_next = S.next(ui + 1, nxt);
        const char* nA = (has_next && !GATHER) ? PG8_ABASE(nxt) : cA; const char* nB = has_next ? PG8_BBASE(nxt) : cB;
        if constexpr (DUAL) { if (has_next) { const int K_ = PG8_UK(nxt); nhstep = (size_t)HALF * K_ * 2; nnt = K_ / BK; } else { nhstep = hstep; nnt = nt; } }
        if constexpr (DUAL) { if (has_next) { PG8_BASEOFF(nxt, nv0s); } else nv0s = v0s; }
        else { if (has_next) { PG8_AOFF(nxt, nv0, nv1); } else { _Pragma("unroll") for (int _i = 0; _i < 2; ++_i) { nv0[_i] = v0[_i]; nv1[_i] = v1[_i]; } } }
#pragma unroll 1
        for (int t = 0; t < nt; t += 2) {
            const bool last = (t == nt - 2);
            const char* a1 = cA + (size_t)(t + 1) * kstep;
            const char* a2 = last ? nA : cA + (size_t)(t + 2) * kstep; const char* b2 = last ? nB : cB + (size_t)(t + 2) * kstep;
            const char* a3 = a2 + kstep; const char* b3 = b2 + kstep;
            unsigned w0[2], w1[2];
#pragma unroll
            for (int _i = 0; _i < 2; ++_i) { if constexpr (DUAL) w0[_i] = (last ? nv0s : v0s) + (_i ? (unsigned)((last ? nhstep : hstep) >> 1) : 0u); else { w0[_i] = last ? nv0[_i] : v0[_i]; w1[_i] = last ? nv1[_i] : v1[_i]; } }
            unsigned wB[2], x1[2]; size_t hB = hstep;
            if constexpr (DUAL) { if (last) hB = nhstep; }
#pragma unroll
            for (int _i = 0; _i < 2; ++_i) { if constexpr (DUAL) { wB[_i] = w0[_i]; w1[_i] = w0[_i] + (unsigned)hB; x1[_i] = v0s + (unsigned)hstep + (_i ? (unsigned)(hstep >> 1) : 0u); } else { wB[_i] = voffB[_i]; x1[_i] = v1[_i]; } }
            if constexpr (SP2) {
            PG8_LDB(B0, 0, 0); PG8_LDB(B1, 0, 1); PG8_SCHED; PG8_LDA(At, 0, 0); PG8_STAGE(PG8_SA(1, 1), a1, x1);
            PG8_WAIT_V(8); PG8_WAIT_L(0); PG8_BAR; PG8_MMA(0, 0, At, B0); PG8_MMA(0, 1, At, B1); PG8_BAR; PG8_SCHED;
            PG8_LDA(At, 0, 1); PG8_STAGE(PG8_SB(0, 0), b2, wB); PG8_STAGE(PG8_SB(0, 1), b2 + hB, wB); PG8_STAGE(PG8_SA(0, 0), a2, w0);
            PG8_WAIT_V(8); PG8_WAIT_L(0); PG8_BAR; PG8_MMA(1, 0, At, B0); PG8_MMA(1, 1, At, B1); PG8_BAR; PG8_SCHED;
            PG8_LDB(B0, 1, 0); PG8_LDB(B1, 1, 1); PG8_SCHED; PG8_LDA(At, 1, 0); PG8_STAGE(PG8_SA(0, 1), a2, w1);
            PG8_WAIT_V(8); PG8_WAIT_L(0); PG8_BAR; PG8_MMA(0, 0, At, B0); PG8_MMA(0, 1, At, B1); PG8_BAR; PG8_SCHED;
            PG8_LDA(At, 1, 1); PG8_STAGE(PG8_SB(1, 0), b3, wB); PG8_STAGE(PG8_SB(1, 1), b3 + hB, wB); PG8_STAGE(PG8_SA(1, 0), a3, w0);
            PG8_WAIT_V(8); PG8_WAIT_L(0); PG8_BAR; PG8_MMA(1, 0, At, B0); PG8_MMA(1, 1, At, B1); PG8_BAR; PG8_SCHED;
            } else {
            PG8_LDB(B0, 0, 0); PG8_SCHED; PG8_LDA(At, 0, 0); PG8_STAGE(PG8_SA(1, 1), a1, v1);
            PG8_WAIT_L(8); PG8_BAR; PG8_WAIT_L(0); PG8_MMA(0, 0, At, B0); PG8_BAR; PG8_SCHED;
            PG8_LDB(B1, 0, 1); PG8_STAGE(PG8_SB(0, 0), b2, voffB);
            PG8_BAR; PG8_WAIT_L(0); PG8_MMA(0, 1, At, B1); PG8_BAR;
            PG8_LDA(At, 0, 1); PG8_STAGE(PG8_SA(0, 0), a2, w0);
            PG8_BAR; PG8_WAIT_L(0); PG8_MMA(1, 0, At, B0); PG8_BAR; PG8_SCHED;
            PG8_STAGE(PG8_SB(0, 1), b2 + hstep, voffB);
            PG8_WAIT_V(6); PG8_BAR; PG8_MMA(1, 1, At, B1); PG8_BAR;
            PG8_LDB(B0, 1, 0); PG8_SCHED; PG8_LDA(At, 1, 0); PG8_STAGE(PG8_SA(0, 1), a2, w1);
            PG8_WAIT_L(8); PG8_BAR; PG8_WAIT_L(0); PG8_MMA(0, 0, At, B0); PG8_BAR; PG8_SCHED;
            PG8_LDB(B1, 1, 1); PG8_STAGE(PG8_SB(1, 0), b3, voffB);
            PG8_BAR; PG8_WAIT_L(0); PG8_MMA(0, 1, At, B1); PG8_BAR;
            PG8_LDA(At, 1, 1); PG8_STAGE(PG8_SA(1, 0), a3, w0);
            PG8_BAR; PG8_WAIT_L(0); PG8_MMA(1, 0, At, B0); PG8_BAR; PG8_SCHED;
            PG8_STAGE(PG8_SB(1, 1), b3 + hstep, voffB);
            PG8_WAIT_V(6); PG8_BAR; PG8_MMA(1, 1, At, B1); PG8_BAR;
            }
        }
        if constexpr (ALIGN_EPI) { if (wr == 0) PG8_BAR; }
        E(acc, cur, wr, wc, fr, fq);
        if (!has_next) break;
#pragma unroll
        for (int a = 0; a < 2; ++a)
#pragma unroll
            for (int b = 0; b < 2; ++b)
#pragma unroll
                for (int m = 0; m < 4; ++m)
#pragma unroll
                    for (int n = 0; n < 2; ++n) acc[a][b][m][n] = (acc_t){0, 0, 0, 0};
        cur = nxt; cA = nA; cB = nB; ++ui;
#pragma unroll
        for (int _i = 0; _i < 2; ++_i) { if constexpr (!DUAL) { v0[_i] = nv0[_i]; v1[_i] = nv1[_i]; } }
        if constexpr (DUAL) { hstep = nhstep; nt = nnt; v0s = nv0s; }
        if constexpr (ALIGN_EPI) { if (wr == 1) PG8_BAR; }
    }
    PG8_WAIT_V(0);
    if constexpr (!ALIGN_EPI) { if (wr == 0) PG8_BAR; }
    PG8_BAR;
#undef PG8_AOFF
#undef PG8_BASEOFF
#undef PG8_UK
#undef PG8_ABASE
#undef PG8_BBASE
#undef PG8_SA
#undef PG8_SB
#undef PG8_STAGE
#undef PG8_LDA
#undef PG8_LDB
#undef PG8_MMA
#undef PG8_WAIT_V
#undef PG8_WAIT_L
#undef PG8_BAR
#undef PG8_SCHED
}
#ifdef NT_STORES
#define ST_V(ptr, val) __builtin_nontemporal_store((val), (ptr))
#else
#define ST_V(ptr, val) (*(ptr) = (val))
#endif
__device__ __forceinline__ void st8(bf16* p, f32x4 a, f32x4 b) { v4u w; w.x = pk2(a[0], a[1]); w.y = pk2(a[2], a[3]); w.z = pk2(b[0], b[1]); w.w = pk2(b[2], b[3]); ST_V((v4u*)p, w); }
__device__ __forceinline__ void st4(bf16* p, f32x4 a) { v2u w; w.x = pk2(a[0], a[1]); w.y = pk2(a[2], a[3]); ST_V((v2u*)p, w); }
__device__ __forceinline__ unsigned q8pack(float a, float b, float c, float d) {
    const int ia = (int)__builtin_rintf(a), ib = (int)__builtin_rintf(b), ic = (int)__builtin_rintf(c), id = (int)__builtin_rintf(d);
    return (unsigned)(ia & 255) | ((unsigned)(ib & 255) << 8) | ((unsigned)(ic & 255) << 16) | ((unsigned)id << 24);
}
__device__ __forceinline__ f32x4 ub4(unsigned w) { return (f32x4){(float)(w & 255u), (float)((w >> 8) & 255u), (float)((w >> 16) & 255u), (float)(w >> 24)} * (1.0f / 255.0f); }
__device__ __forceinline__ f32x4 up4(unsigned lo, unsigned hi) { return (f32x4){bflo(lo), bfhi(lo), bflo(hi), bfhi(hi)}; }
__device__ __forceinline__ float dot4(f32x4 a) { return (a[0] * a[0] + a[1] * a[1]) + (a[2] * a[2] + a[3] * a[3]); }
template <int CTRL> __device__ __forceinline__ float dppf(float v) { return __builtin_bit_cast(float, __builtin_amdgcn_update_dpp(0, __builtin_bit_cast(int, v), CTRL, 0xf, 0xf, true)); }
__device__ __forceinline__ float scan16(float v, int) { v += dppf<0x111>(v); v += dppf<0x112>(v); v += dppf<0x114>(v); v += dppf<0x118>(v); return v; }
__device__ __forceinline__ float bcast15(float v) { return dppf<0x15F>(v); }
__device__ __forceinline__ float bcast0(float v) { return dppf<0x150>(v); }

struct EpiIn {
    unsigned char *wsb, *dob; LAS float* xch;
#define EI_W(type, off) ((type*)(wsb + (off)))
#define EI_D(type, off) ((type*)(dob + (off)))
    __device__ __forceinline__ void hgrn(const f32x4 (&acc)[2][2][4][2], const Unit& u, int wr, int wc, int fr, int fq) const {
        const int hh = u.pn >> 1, cb = u.pn & 1;
        const int gch0 = hh * 128 + cb * 64 + wc * 16 + fq * 4;
        bf16* const QF = EI_D(bf16, DO_QF); bf16* const KF = EI_D(bf16, DO_KF); bf16* const QB = EI_D(bf16, DO_QB); bf16* const KB = EI_D(bf16, DO_KB); bf16* const VA = EI_W(bf16, WS_VA);
        float* const EREF = EI_W(float, WS_EREF); float* const ELAST = EI_W(float, WS_ELAST); const float* const LB = EI_W(float, WS_LB);
        const f32x4 lbf = *(const f32x4*)(LB + gch0), lbb = *(const f32x4*)(LB + 512 + gch0);
#pragma unroll
        for (int ai = 0; ai < 2; ++ai) {
            const int cidx = u.pm * 4 + ai * 2 + wr;
            const size_t off0 = (size_t)(u.pm * 256 + ai * 128 + wr * 64 + fr) * 512 + gch0;
#pragma unroll
            for (int m = 0; m < 4; ++m) st4(VA + off0 + (size_t)m * 16 * 512, acc[ai][1][m][1]);
            {
                f32x4 qo[4], ko[4];
#pragma unroll
                for (int j = 0; j < 4; ++j) {
                    float lf[4], kk[4];
#pragma unroll
                    for (int m = 0; m < 4; ++m) { const float z = fminf(fmaxf(acc[ai][0][m][1][j], -30.f), 30.f), e = __expf(-z), s = __builtin_amdgcn_rcpf(1.0f + e); kk[m] = (1.0f - lbf[j]) * e * s; lf[m] = __logf(lbf[j] + (1.0f - lbf[j]) * s); }
                    float G[4], carry = 0.f;
#pragma unroll
                    for (int m = 0; m < 4; ++m) { G[m] = scan16(lf[m], fr) + carry; carry = bcast15(G[m]); }
                    const float Gref = bcast15(G[1]);
#pragma unroll
                    for (int m = 0; m < 4; ++m) { qo[m][j] = silu_(acc[ai][0][m][0][j]) * __expf(fminf(G[m] - Gref, 80.f)); ko[m][j] = kk[m] * __expf(fminf(Gref - G[m], 80.f)); }
                    if (fr == 0) { EREF[(size_t)cidx * 512 + gch0 + j] = __expf(Gref); ELAST[(size_t)cidx * 512 + gch0 + j] = __expf(carry - Gref); }
                }
#pragma unroll
                for (int m = 0; m < 4; ++m) { st4(QF + off0 + (size_t)m * 16 * 512, qo[m]); st4(KF + off0 + (size_t)m * 16 * 512, ko[m]); }
                asm volatile("" ::: "memory");
            }
            {
                f32x4 qo[4], ko[4];
#pragma unroll
                for (int j = 0; j < 4; ++j) {
                    float lw[4], kk[4];
#pragma unroll
                    for (int m = 0; m < 4; ++m) { const float z = fminf(fmaxf(acc[ai][1][m][0][j], -30.f), 30.f), e = __expf(-z), s = __builtin_amdgcn_rcpf(1.0f + e); kk[m] = (1.0f - lbb[j]) * e * s; lw[m] = __logf(lbb[j] + (1.0f - lbb[j]) * s); }
                    float P[4], carry = 0.f;
#pragma unroll
                    for (int m = 0; m < 4; ++m) { P[m] = scan16(lw[m], fr) + carry; carry = bcast15(P[m]); }
                    float Gb[4];
#pragma unroll
                    for (int m = 0; m < 4; ++m) Gb[m] = carry - (P[m] - lw[m]);
                    const float Gbref = bcast0(Gb[2]);
#pragma unroll
                    for (int m = 0; m < 4; ++m) { qo[m][j] = silu_(acc[ai][0][m][0][j]) * __expf(fminf(Gb[m] - Gbref, 80.f)); ko[m][j] = kk[m] * __expf(fminf(Gbref - Gb[m], 80.f)); }
                    if (fr == 0) { EREF[(size_t)(NCHUNK + cidx) * 512 + gch0 + j] = __expf(Gbref); ELAST[(size_t)(NCHUNK + cidx) * 512 + gch0 + j] = __expf(carry - Gbref); }
                }
#pragma unroll
                for (int m = 0; m < 4; ++m) { st4(QB + off0 + (size_t)m * 16 * 512, qo[m]); st4(KB + off0 + (size_t)m * 16 * 512, ko[m]); }
                asm volatile("" ::: "memory");
            }
        }
    }
    __device__ __forceinline__ void operator()(const f32x4 (&acc)[2][2][4][2], const Unit& u, int wr, int wc, int fr, int fq) const {
        const int pn = u.pn, row0 = u.pm * 256 + wr * 64 + fr;
        if (pn < 8) { hgrn(acc, u, wr, wc, fr, fq); return; }
        bf16* const OG = EI_W(bf16, WS_OG); bf16* const CQ = EI_W(bf16, WS_CQ); bf16* const CKVR = EI_W(bf16, WS_CKVR); bf16* const GA = EI_W(bf16, WS_GA); bf16* const GB = EI_W(bf16, WS_GB);
        float* const CQSS = EI_W(float, WS_CQSS); float* const CKVSS = EI_W(float, WS_CKVSS); float* const KR = EI_W(float, WS_KR);
#if I8_QKV
        if (pn == 10 || pn == 11) {
            const bool isq = pn == 10; float ssv[2][4];
#pragma unroll
            for (int ai = 0; ai < 2; ++ai)
#pragma unroll
                for (int m = 0; m < 4; ++m) { const int row = row0 + ai * 128 + m * 16; float ss = 0.f, mx = 0.f;
#pragma unroll
                    for (int bj = 0; bj < 2; ++bj) { if (bj == 0 || isq) { const f32x4 a = acc[ai][bj][m][0], b = acc[ai][bj][m][1]; ss += dot4(a) + dot4(b);
#pragma unroll
                        for (int j = 0; j < 4; ++j) mx = fmaxf(mx, fmaxf(fabsf(a[j]), fabsf(b[j]))); } }
                    ss += __shfl_xor(ss, 16); ss += __shfl_xor(ss, 32); mx = fmaxf(mx, __shfl_xor(mx, 16)); mx = fmaxf(mx, __shfl_xor(mx, 32));
                    if (fq == 0) { (isq ? CQSS : CKVSS)[(size_t)row * 4 + wc] = ss; xch[(wr * 4 + wc) * 128 + ai * 64 + m * 16 + fr] = mx; }
                    if (!isq && wc == 0) { *(f32x4*)(KR + (size_t)row * 32 + 8 * fq) = acc[ai][1][m][0]; *(f32x4*)(KR + (size_t)row * 32 + 8 * fq + 4) = acc[ai][1][m][1]; } }
            asm volatile("s_waitcnt lgkmcnt(0)\n\ts_barrier" ::: "memory");
            unsigned char* const dst8 = wsb + (isq ? WS_CQ : WS_CKVR); float* const SAr = (float*)(wsb + (isq ? WS_SAQ : WS_SAKV));
#pragma unroll
            for (int ai = 0; ai < 2; ++ai)
#pragma unroll
                for (int m = 0; m < 4; ++m) { const int row = row0 + ai * 128 + m * 16; const int xi = ai * 64 + m * 16 + fr;
                    const float rm = fmaxf(fmaxf(xch[(wr * 4 + 0) * 128 + xi], xch[(wr * 4 + 1) * 128 + xi]), fmaxf(xch[(wr * 4 + 2) * 128 + xi], xch[(wr * 4 + 3) * 128 + xi]));
                    const float inv = rm > 0.f ? 127.0f / rm : 0.f; if (wc == 0 && fq == 0) SAr[row] = rm * (1.0f / 127.0f);
#pragma unroll
                    for (int bj = 0; bj < 2; ++bj) { if (bj == 0 || isq) { const f32x4 a = acc[ai][bj][m][0] * inv, b = acc[ai][bj][m][1] * inv; v2u o; o.x = q8pack(a[0], a[1], a[2], a[3]); o.y = q8pack(b[0], b[1], b[2], b[3]);
                        *(v2u*)(dst8 + (size_t)row * 256 + bj * 128 + wc * 32 + 8 * fq) = o; } } }
            return;
        }
#else
        if (pn == 10) {
#pragma unroll
            for (int ai = 0; ai < 2; ++ai)
#pragma unroll
                for (int m = 0; m < 4; ++m) { const int row = row0 + ai * 128 + m * 16; float ss = 0.f;
#pragma unroll
                    for (int bj = 0; bj < 2; ++bj) { const f32x4 a = acc[ai][bj][m][0], b = acc[ai][bj][m][1]; ss += dot4(a) + dot4(b); st8(CQ + (size_t)row * 256 + bj * 128 + wc * 32 + 8 * fq, a, b); }
                    ss += __shfl_xor(ss, 16); ss += __shfl_xor(ss, 32); if (fq == 0) CQSS[(size_t)row * 4 + wc] = ss; }
            return;
        }
        if (pn == 11) {
#pragma unroll
            for (int ai = 0; ai < 2; ++ai)
#pragma unroll
                for (int m = 0; m < 4; ++m) { const int row = row0 + ai * 128 + m * 16;
                    const f32x4 a0 = acc[ai][0][m][0], b0 = acc[ai][0][m][1], a1 = acc[ai][1][m][0], b1 = acc[ai][1][m][1];
                    float ss = dot4(a0) + dot4(b0); ss += __shfl_xor(ss, 16); ss += __shfl_xor(ss, 32); if (fq == 0) CKVSS[(size_t)row * 4 + wc] = ss;
                    st8(CKVR + (size_t)row * 256 + wc * 32 + 8 * fq, a0, b0); st8(CKVR + (size_t)row * 256 + 128 + wc * 32 + 8 * fq, a1, b1);
                    if (wc == 0) { *(f32x4*)(KR + (size_t)row * 32 + 8 * fq) = a1; *(f32x4*)(KR + (size_t)row * 32 + 8 * fq + 4) = b1; } }
            return;
        }
#endif
        const bool sil = pn < 10; const int ld = sil ? 512 : 1024, cb = (sil ? pn - 8 : (pn - 12) & 3) * 256;
        const size_t dsto = sil ? (size_t)0 : (pn < 16 ? (size_t)((unsigned char*)GA - (unsigned char*)OG) : (size_t)((unsigned char*)GB - (unsigned char*)OG));
        bf16* dst = (bf16*)((unsigned char*)OG + dsto);
#pragma unroll
        for (int ai = 0; ai < 2; ++ai)
#pragma unroll
            for (int m = 0; m < 4; ++m)
#pragma unroll
                for (int bj = 0; bj < 2; ++bj) { f32x4 a = acc[ai][bj][m][0], b = acc[ai][bj][m][1];
#pragma unroll
                    for (int j = 0; j < 4; ++j) { a[j] = sil ? silu_(a[j]) : sigm(a[j]); b[j] = sil ? silu_(b[j]) : sigm(b[j]); }
#if GATE_U8
                    if (!sil) { v2u o; o.x = q8pack(a[0] * 255.f, a[1] * 255.f, a[2] * 255.f, a[3] * 255.f); o.y = q8pack(b[0] * 255.f, b[1] * 255.f, b[2] * 255.f, b[3] * 255.f);
                        *(v2u*)((unsigned char*)dst + (size_t)(row0 + ai * 128 + m * 16) * 1024 + cb + bj * 128 + wc * 32 + 8 * fq) = o; }
                    else
#endif
                    st8(dst + (size_t)(row0 + ai * 128 + m * 16) * ld + cb + bj * 128 + wc * 32 + 8 * fq, a, b); }
    }
};

struct EpiQ {
    bf16* QM; const float* CQSS;
    __device__ __forceinline__ void operator()(const f32x4 (&acc)[2][2][4][2], const Unit& u, int wr, int wc, int fr, int fq) const {
        float rsv[2][4];
#pragma unroll
        for (int ai = 0; ai < 2; ++ai)
#pragma unroll
            for (int m = 0; m < 4; ++m) { const f32x4 s4 = *(const f32x4*)(CQSS + (size_t)(u.pm * 256 + ai * 128 + wr * 64 + m * 16 + fr) * 4); rsv[ai][m] = rsqrtf(((s4[0] + s4[1]) + (s4[2] + s4[3])) * (1.0f / 256.0f) + EPS); }
#pragma unroll
        for (int ai = 0; ai < 2; ++ai)
#pragma unroll
            for (int m = 0; m < 4; ++m) { const int row = u.pm * 256 + ai * 128 + wr * 64 + m * 16 + fr; const float rs = rsv[ai][m];
#pragma unroll
                for (int bj = 0; bj < 2; ++bj) st8(QM + (size_t)row * 768 + u.pn * 256 + bj * 128 + wc * 32 + 8 * fq, acc[ai][bj][m][0] * rs, acc[ai][bj][m][1] * rs); }
    }
};
struct EpiKV {
    bf16 *KH, *VH; const float *CKVSS, *KR, *ROPE_, *KN;
    __device__ __forceinline__ void operator()(const f32x4 (&acc)[2][2][4][2], const Unit& u, int wr, int wc, int fr, int fq) const {
        const int pn = u.pn, head = (pn & 1) * 4 + wc;
        float rsv[2][4];
#pragma unroll
        for (int ai = 0; ai < 2; ++ai)
#pragma unroll
            for (int m = 0; m < 4; ++m) { const f32x4 s4 = *(const f32x4*)(CKVSS + (size_t)(u.pm * 256 + ai * 128 + wr * 64 + m * 16 + fr) * 4); rsv[ai][m] = rsqrtf(((s4[0] + s4[1]) + (s4[2] + s4[3])) * (1.0f / 128.0f) + EPS); }
        if (pn >= 2) {
#pragma unroll
            for (int ai = 0; ai < 2; ++ai)
#pragma unroll
                for (int m = 0; m < 4; ++m) { const int row = u.pm * 256 + ai * 128 + wr * 64 + m * 16 + fr; const float rs = rsv[ai][m];
#pragma unroll
                    for (int bj = 0; bj < 2; ++bj) st8(VH + ((size_t)row * 8 + head) * 64 + bj * 32 + 8 * fq, acc[ai][bj][m][0] * rs, acc[ai][bj][m][1] * rs); }
            return;
        }
#pragma unroll
        for (int ai = 0; ai < 2; ++ai)
#pragma unroll
            for (int m = 0; m < 4; ++m) { const int row = u.pm * 256 + ai * 128 + wr * 64 + m * 16 + fr; const float rs = rsv[ai][m]; const size_t ro = (size_t)row * 32;
                const f32x4 x1 = *(const f32x4*)(KR + ro + 4 * fq), x2 = *(const f32x4*)(KR + ro + 16 + 4 * fq), cc = *(const f32x4*)(ROPE_ + ro + 4 * fq), sn = *(const f32x4*)(ROPE_ + ro + 16 + 4 * fq);
                float ss = 0.f;
#pragma unroll
                for (int bj = 0; bj < 2; ++bj)
#pragma unroll
                    for (int n = 0; n < 2; ++n) ss += dot4(acc[ai][bj][m][n]);
                ss = ss * rs * rs + dot4(x1) + dot4(x2);
                ss += __shfl_xor(ss, 16); ss += __shfl_xor(ss, 32);
                const float rk = rsqrtf(ss * (1.0f / 96.0f) + EPS), rr = rs * rk;
                bf16* kp = KH + ((size_t)row * 8 + head) * 96;
#pragma unroll
                for (int bj = 0; bj < 2; ++bj) st8(kp + bj * 32 + 8 * fq, acc[ai][bj][m][0] * rr * *(const f32x4*)(KN + bj * 32 + 8 * fq), acc[ai][bj][m][1] * rr * *(const f32x4*)(KN + bj * 32 + 8 * fq + 4));
                const f32x4 y1 = x1 * rk * *(const f32x4*)(KN + 64 + 4 * fq), y2 = x2 * rk * *(const f32x4*)(KN + 80 + 4 * fq);
                st4(kp + 64 + 4 * fq, y1 * cc - y2 * sn); st4(kp + 80 + 4 * fq, y2 * cc + y1 * sn);
                if (m & 1) asm volatile("" ::: "memory"); }
    }
};
struct EpiQKV {
    EpiQ q; EpiKV kv;
    __device__ __forceinline__ void operator()(const f32x4 (&acc)[2][2][4][2], const Unit& u, int wr, int wc, int fr, int fq) const { if (u.kind) kv(acc, u, wr, wc, fr, fq); else q(acc, u, wr, wc, fr, fq); }
};
struct EpiQKV8 {
    unsigned char* wsb; const float* KN;
    __device__ __forceinline__ void operator()(const i32x4 (&acc)[2][2][4][2], const Unit& u, int wr, int wc, int fr_in, int fq_in) const {
        int fr = fr_in, fq = fq_in; asm volatile("" : "+v"(fr), "+v"(fq));
        unsigned char* W = wsb; asm volatile("" : "+s"(W));
        const float* SA = (const float*)(W + (u.kind ? WS_SAKV : WS_SAQ)); const float* SB = (const float*)(W + (u.kind ? WS_SBUKV : WS_SBUQ));
        int lo_ = wc * 32 + 4 * fq, ro_ = wr * 64 + fr; asm volatile("" : "+v"(lo_), "+v"(ro_));
        const int lo = lo_, ro = ro_;
        f32x4 f[2][2][4][2]; f32x4 sb[2][2];
#pragma unroll
        for (int bj = 0; bj < 2; ++bj)
#pragma unroll
            for (int n = 0; n < 2; ++n) sb[bj][n] = *(const f32x4*)(SB + u.pn * 256 + bj * 128 + n * 16 + lo);
#pragma unroll
        for (int ai = 0; ai < 2; ++ai) { float sa[4];
#pragma unroll
            for (int m = 0; m < 4; ++m) sa[m] = SA[u.pm * 256 + ai * 128 + m * 16 + ro];
#pragma unroll
            for (int bj = 0; bj < 2; ++bj)
#pragma unroll
                for (int m = 0; m < 4; ++m)
#pragma unroll
                    for (int n = 0; n < 2; ++n) f[ai][bj][m][n] = __builtin_convertvector(acc[ai][bj][m][n], f32x4) * sb[bj][n] * sa[m]; }
        if (u.kind) { const EpiKV kv{(bf16*)(W + WS_KH), (bf16*)(W + WS_VH), (const float*)(W + WS_CKVSS), (const float*)(W + WS_KR), (const float*)(W + WS_ROPE), KN}; kv(f, u, wr, wc, fr, fq); }
        else { const EpiQ q{(bf16*)(W + WS_QM), (const float*)(W + WS_CQSS)}; q(f, u, wr, wc, fr, fq); }
    }
};
struct EpiMerge {
    bf16* MG; const bf16 *GA, *GB;
    __device__ __forceinline__ void operator()(const f32x4 (&acc)[2][2][4][2], const Unit& u, int wr, int wc, int fr, int fq) const {
        const bool which = u.pm >= T / 256; const int pm = u.pm - (which ? T / 256 : 0), pn = u.pn - (which ? D / 256 : 0);
        const bf16* Gt = (const bf16*)((const unsigned char*)GA + (which ? (size_t)((const unsigned char*)GB - (const unsigned char*)GA) : (size_t)0));
#pragma unroll
        for (int ai = 0; ai < 2; ++ai)
#pragma unroll
            for (int mp = 0; mp < 2; ++mp) {
                v4u gv[2][2], ov[2][2];
#pragma unroll
                for (int mm = 0; mm < 2; ++mm)
#pragma unroll
                    for (int bj = 0; bj < 2; ++bj) { const size_t off = (size_t)(pm * 256 + ai * 128 + wr * 64 + (2 * mp + mm) * 16 + fr) * 1024 + pn * 256 + bj * 128 + wc * 32 + 8 * fq;
#if GATE_U8
                        { const v2u g8 = *(const v2u*)((const unsigned char*)Gt + off); gv[mm][bj] = (v4u){g8.x, g8.y, 0u, 0u}; }
#else
                        gv[mm][bj] = *(const v4u*)(Gt + off);
#endif
                        ov[mm][bj] = which ? *(const v4u*)(MG + off) : (v4u){0u, 0u, 0u, 0u}; }
#pragma unroll
                for (int mm = 0; mm < 2; ++mm)
#pragma unroll
                    for (int bj = 0; bj < 2; ++bj) { const int m = 2 * mp + mm; const size_t off = (size_t)(pm * 256 + ai * 128 + wr * 64 + m * 16 + fr) * 1024 + pn * 256 + bj * 128 + wc * 32 + 8 * fq;
                        const v4u g = gv[mm][bj], o = ov[mm][bj];
#if GATE_U8
                        const f32x4 a = acc[ai][bj][m][0] * ub4(g.x) + up4(o.x, o.y), b = acc[ai][bj][m][1] * ub4(g.y) + up4(o.z, o.w);
#else
                        const f32x4 a = acc[ai][bj][m][0] * up4(g.x, g.y) + up4(o.x, o.y), b = acc[ai][bj][m][1] * up4(g.z, g.w) + up4(o.z, o.w);
#endif
                        st8(MG + off, a, b); }
                asm volatile("" ::: "memory"); }
    }
};
struct EpiX2 {
    const float* X; bf16* O; float* XM;
    __device__ __forceinline__ void operator()(const f32x4 (&acc)[2][2][4][2], const Unit& u, int wr, int wc, int fr, int fq) const {
#pragma unroll
        for (int ai = 0; ai < 2; ++ai)
#pragma unroll
            for (int mp = 0; mp < 2; ++mp) {
                f32x4 xv[2][2][2];
#pragma unroll
                for (int mm = 0; mm < 2; ++mm)
#pragma unroll
                    for (int bj = 0; bj < 2; ++bj) { const float* xp = X + (size_t)(u.pm * 256 + ai * 128 + wr * 64 + (2 * mp + mm) * 16 + fr) * 1024 + u.pn * 256 + bj * 128 + wc * 32 + 8 * fq;
                        xv[mm][bj][0] = *(const f32x4*)xp; xv[mm][bj][1] = *(const f32x4*)(xp + 4); }
#pragma unroll
                for (int mm = 0; mm < 2; ++mm)
#pragma unroll
                    for (int bj = 0; bj < 2; ++bj) { xv[mm][bj][0] += acc[ai][bj][2 * mp + mm][0]; xv[mm][bj][1] += acc[ai][bj][2 * mp + mm][1];
                        st8(O + (size_t)(u.pm * 256 + ai * 128 + wr * 64 + (2 * mp + mm) * 16 + fr) * 1024 + u.pn * 256 + bj * 128 + wc * 32 + 8 * fq, xv[mm][bj][0], xv[mm][bj][1]); }
#pragma unroll
                for (int mm = 0; mm < 2; ++mm) { float mx = 0.f;
#pragma unroll
                    for (int bj = 0; bj < 2; ++bj)
#pragma unroll
                        for (int n = 0; n < 2; ++n)
#pragma unroll
                            for (int j = 0; j < 4; ++j) mx = fmaxf(mx, fabsf(xv[mm][bj][n][j]));
                    mx = fmaxf(mx, __shfl_xor(mx, 16)); mx = fmaxf(mx, __shfl_xor(mx, 32));
                    if (fq == 0) XM[(size_t)(u.pm * 256 + ai * 128 + wr * 64 + (2 * mp + mm) * 16 + fr) * 16 + u.pn * 4 + wc] = mx; }
                asm volatile("" ::: "memory"); }
    }
};
struct EpiUp {
    bf16* H1; const int* LIST; const float* RS2;
    __device__ __forceinline__ void operator()(const f32x4 (&acc)[2][2][4][2], const Unit& u, int wr, int wc, int fr, int fq) const {
        const int pl = u.pn & 1; int tk[2][4]; float rsv[2][4];
#pragma unroll
        for (int ai = 0; ai < 2; ++ai)
#pragma unroll
            for (int m = 0; m < 4; ++m) { const int r = ai * 128 + wr * 64 + m * 16 + fr; tk[ai][m] = LIST[u.lbase + (r < u.nvalid ? r : u.nvalid - 1)] >> 1; }
#pragma unroll
        for (int ai = 0; ai < 2; ++ai)
#pragma unroll
            for (int m = 0; m < 4; ++m) rsv[ai][m] = RS2[tk[ai][m]];
#pragma unroll
        for (int ai = 0; ai < 2; ++ai)
#pragma unroll
            for (int m = 0; m < 4; ++m) { const int r = ai * 128 + wr * 64 + m * 16 + fr; const float rs = rsv[ai][m];
                f32x4 a = acc[ai][0][m][0] * rs, b = acc[ai][0][m][1] * rs;
#pragma unroll
                for (int j = 0; j < 4; ++j) { a[j] = silu_(a[j]) * (acc[ai][1][m][0][j] * rs); b[j] = silu_(b[j]) * (acc[ai][1][m][1][j] * rs); }
                st8(H1 + (size_t)(u.pm * 256 + r) * 256 + pl * 128 + wc * 32 + 8 * fq, a, b); }
    }
};
struct EpiDown {
    bf16 *Y0, *Y1; const int* LIST; const float* EW;
    __device__ __forceinline__ void operator()(const f32x4 (&acc)[2][2][4][2], const Unit& u, int wr, int wc, int fr, int fq) const {
        const int pl = u.pn & 3; int en[2][4]; float wv[2][4];
#pragma unroll
        for (int ai = 0; ai < 2; ++ai)
#pragma unroll
            for (int m = 0; m < 4; ++m) { const int r = ai * 128 + wr * 64 + m * 16 + fr; en[ai][m] = r < u.nvalid ? LIST[u.lbase + r] : -1; }
#pragma unroll
        for (int ai = 0; ai < 2; ++ai)
#pragma unroll
            for (int m = 0; m < 4; ++m) wv[ai][m] = en[ai][m] >= 0 ? EW[en[ai][m]] : 0.f;
#pragma unroll
        for (int ai = 0; ai < 2; ++ai)
#pragma unroll
            for (int m = 0; m < 4; ++m) { const int ent = en[ai][m]; const float w = wv[ai][m];
                if (ent >= 0) {
                    const unsigned eo = (unsigned)(ent >> 1) * 1024u + (unsigned)(pl * 256 + wc * 32 + 8 * fq) + ((ent & 1) ? (unsigned)(((unsigned char*)Y1 - (unsigned char*)Y0) / 2) : 0u);
#pragma unroll
                    for (int bj = 0; bj < 2; ++bj) st8(Y0 + eo + bj * 128, acc[ai][bj][m][0] * w, acc[ai][bj][m][1] * w); } }
    }
};
struct EpiProj {
    bf16* PR;
    __device__ __forceinline__ void operator()(const f32x4 (&acc)[2][2][4][2], const Unit& u, int wr, int wc, int fr, int fq) const {
#pragma unroll
        for (int ai = 0; ai < 2; ++ai)
#pragma unroll
            for (int m = 0; m < 4; ++m)
#pragma unroll
                for (int bj = 0; bj < 2; ++bj) st8(PR + (size_t)(u.pm * 256 + ai * 128 + wr * 64 + m * 16 + fr) * 1024 + u.pn * 256 + bj * 128 + wc * 32 + 8 * fq, acc[ai][bj][m][0], acc[ai][bj][m][1]);
    }
};
template <class Epi, bool ROWS = true> struct EpiScaled {
    Epi inner; const float* SA; const float* SB;
    __device__ __forceinline__ void operator()(const i32x4 (&acc)[2][2][4][2], const Unit& u, int wr, int wc, int fr, int fq) const {
        f32x4 f[2][2][4][2]; f32x4 sb[2][2];
#pragma unroll
        for (int bj = 0; bj < 2; ++bj)
#pragma unroll
            for (int n = 0; n < 2; ++n) sb[bj][n] = *(const f32x4*)(SB + u.pn * 256 + bj * 128 + wc * 32 + n * 16 + 4 * fq);
#pragma unroll
        for (int ai = 0; ai < 2; ++ai) { float sa[4];
#pragma unroll
            for (int m = 0; m < 4; ++m) sa[m] = ROWS ? SA[u.pm * 256 + ai * 128 + wr * 64 + m * 16 + fr] : 1.0f;
#pragma unroll
            for (int bj = 0; bj < 2; ++bj)
#pragma unroll
                for (int m = 0; m < 4; ++m)
#pragma unroll
                    for (int n = 0; n < 2; ++n) { f[ai][bj][m][n] = __builtin_convertvector(acc[ai][bj][m][n], f32x4) * sb[bj][n]; if constexpr (ROWS) f[ai][bj][m][n] *= sa[m]; } }
        inner(f, u, wr, wc, fr, fq);
    }
};
struct EpiGateProj {
    float* O; const bf16* X3; unsigned char* SCR; const float* SA3; const float* SBG; const float* SAP; const float* SBP;
    __device__ __forceinline__ void operator()(const i32x4 (&acc)[2][2][4][2], const Unit& u, int wr, int wc, int fr, int fq) const {
        int tid_ = (wr * 4 + wc) * 64 + fq * 16 + fr, lo_ = wc * 32 + 4 * fq, lc_ = wc * 32 + 8 * fq; asm volatile("" : "+v"(tid_), "+v"(lo_), "+v"(lc_));
        const int tid = tid_, lo = lo_, lc = lc_;
        f32x4 sb[2][2];
        { const float* SB = (const float*)((const unsigned char*)SBG + (u.kind ? (size_t)((const unsigned char*)SBP - (const unsigned char*)SBG) : (size_t)0));
#pragma unroll
        for (int bj = 0; bj < 2; ++bj)
#pragma unroll
            for (int n = 0; n < 2; ++n) sb[bj][n] = *(const f32x4*)(SB + u.pn * 256 + bj * 128 + n * 16 + lo); }
        if (u.kind == 0) {
#pragma unroll
            for (int ai = 0; ai < 2; ++ai) { float sa[4];
#pragma unroll
                for (int m = 0; m < 4; ++m) sa[m] = SA3[u.pm * 256 + ai * 128 + wr * 64 + m * 16 + fr];
#pragma unroll
                for (int bj = 0; bj < 2; ++bj)
#pragma unroll
                    for (int m = 0; m < 4; ++m) { f32x4 a = __builtin_convertvector(acc[ai][bj][m][0], f32x4) * sb[bj][0] * sa[m], b = __builtin_convertvector(acc[ai][bj][m][1], f32x4) * sb[bj][1] * sa[m];
#pragma unroll
                        for (int j = 0; j < 4; ++j) { a[j] = sigm(a[j]) * 255.f; b[j] = sigm(b[j]) * 255.f; }
                        v2u w; w.x = q8pack(a[0], a[1], a[2], a[3]); w.y = q8pack(b[0], b[1], b[2], b[3]);
                        *(v2u*)(SCR + (size_t)(((ai * 2 + bj) * 4 + m) * 512 + tid) * 8) = w; } }
        } else {
#pragma unroll
            for (int ai = 0; ai < 2; ++ai) {
                v4u xv[4][2]; v2u gv[4][2]; float sa[4];
#pragma unroll
                for (int m = 0; m < 4; ++m) { sa[m] = SAP[u.pm * 256 + ai * 128 + wr * 64 + m * 16 + fr];
#pragma unroll
                    for (int bj = 0; bj < 2; ++bj) { gv[m][bj] = *(const v2u*)(SCR + (size_t)(((ai * 2 + bj) * 4 + m) * 512 + tid) * 8);
                        xv[m][bj] = *(const v4u*)(X3 + (size_t)(u.pm * 256 + ai * 128 + wr * 64 + m * 16 + fr) * 1024 + u.pn * 256 + bj * 128 + lc); } }
#pragma unroll
                for (int m = 0; m < 4; ++m)
#pragma unroll
                    for (int bj = 0; bj < 2; ++bj) { float* op = O + (size_t)(u.pm * 256 + ai * 128 + wr * 64 + m * 16 + fr) * 1024 + u.pn * 256 + bj * 128 + lc;
                        const f32x4 p0 = __builtin_convertvector(acc[ai][bj][m][0], f32x4) * sb[bj][0] * sa[m], p1 = __builtin_convertvector(acc[ai][bj][m][1], f32x4) * sb[bj][1] * sa[m];
                        *(f32x4*)op = up4(xv[m][bj].x, xv[m][bj].y) + p0 * ub4(gv[m][bj].x); *(f32x4*)(op + 4) = up4(xv[m][bj].z, xv[m][bj].w) + p1 * ub4(gv[m][bj].y); }
                asm volatile("" ::: "memory"); }
        }
    }
};
struct EpiProjGate {
    float* O; const bf16* X3; unsigned char* SCR; const float* SA3; const float* SBG; const float* SAP; const float* SBP;
    __device__ __forceinline__ void operator()(const i32x4 (&acc)[2][2][4][2], const Unit& u, int wr, int wc, int fr, int fq) const {
        int tid_ = (wr * 4 + wc) * 64 + fq * 16 + fr, lo_ = wc * 32 + 4 * fq; asm volatile("" : "+v"(tid_), "+v"(lo_));
        const int tid = tid_, lo = lo_;
        f32x4 sb[2][2];
        { const float* SB = (const float*)((const unsigned char*)SBP + (u.kind ? (size_t)((const unsigned char*)SBG - (const unsigned char*)SBP) : (size_t)0));
#pragma unroll
        for (int bj = 0; bj < 2; ++bj)
#pragma unroll
            for (int n = 0; n < 2; ++n) sb[bj][n] = *(const f32x4*)(SB + u.pn * 256 + bj * 128 + n * 16 + lo); }
        if (u.kind == 0) {
#pragma unroll
            for (int ai = 0; ai < 2; ++ai) { float sa[4];
#pragma unroll
                for (int m = 0; m < 4; ++m) sa[m] = SAP[u.pm * 256 + ai * 128 + wr * 64 + m * 16 + fr];
#pragma unroll
                for (int bj = 0; bj < 2; ++bj)
#pragma unroll
                    for (int m = 0; m < 4; ++m) { const f32x4 a = __builtin_convertvector(acc[ai][bj][m][0], f32x4) * sb[bj][0] * sa[m], b = __builtin_convertvector(acc[ai][bj][m][1], f32x4) * sb[bj][1] * sa[m];
                        v4u w; w.x = pk2(a[0], a[1]); w.y = pk2(a[2], a[3]); w.z = pk2(b[0], b[1]); w.w = pk2(b[2], b[3]);
                        *(v4u*)(SCR + (size_t)(((ai * 2 + bj) * 4 + m) * 512 + tid) * 16) = w; } }
        } else {
#pragma unroll
            for (int ai = 0; ai < 2; ++ai)
#pragma unroll
                for (int mp = 0; mp < 2; ++mp) {
                    v2u xv[2][2][2]; v4u pv[2][2]; float sa[2];
#pragma unroll
                    for (int mm = 0; mm < 2; ++mm) { sa[mm] = SA3[u.pm * 256 + ai * 128 + wr * 64 + (2 * mp + mm) * 16 + fr];
#pragma unroll
                        for (int bj = 0; bj < 2; ++bj) { pv[mm][bj] = *(const v4u*)(SCR + (size_t)(((ai * 2 + bj) * 4 + 2 * mp + mm) * 512 + tid) * 16);
#pragma unroll
                            for (int n = 0; n < 2; ++n) xv[mm][bj][n] = *(const v2u*)(X3 + (size_t)(u.pm * 256 + ai * 128 + wr * 64 + (2 * mp + mm) * 16 + fr) * 1024 + u.pn * 256 + bj * 128 + n * 16 + lo); } }
#pragma unroll
                    for (int mm = 0; mm < 2; ++mm)
#pragma unroll
                        for (int bj = 0; bj < 2; ++bj)
#pragma unroll
                            for (int n = 0; n < 2; ++n) { const size_t off = (size_t)(u.pm * 256 + ai * 128 + wr * 64 + (2 * mp + mm) * 16 + fr) * 1024 + u.pn * 256 + bj * 128 + n * 16 + lo;
                                f32x4 g = __builtin_convertvector(acc[ai][bj][2 * mp + mm][n], f32x4) * sb[bj][n] * sa[mm];
#pragma unroll
                                for (int j = 0; j < 4; ++j) g[j] = sigm(g[j]);
                                const f32x4 pr = n ? up4(pv[mm][bj].z, pv[mm][bj].w) : up4(pv[mm][bj].x, pv[mm][bj].y);
                                *(f32x4*)(O + off) = up4(xv[mm][bj][n].x, xv[mm][bj][n].y) + pr * g; }
                    asm volatile("" ::: "memory"); }
        }
    }
};
struct EpiFinal8 {
    float* O; const bf16* X3; const bf16* PR; const float* SA; const float* SB;
    __device__ __forceinline__ void operator()(const i32x4 (&acc)[2][2][4][2], const Unit& u, int wr, int wc, int fr, int fq) const {
        f32x4 sb[2][2];
#pragma unroll
        for (int bj = 0; bj < 2; ++bj)
#pragma unroll
            for (int n = 0; n < 2; ++n) sb[bj][n] = *(const f32x4*)(SB + u.pn * 256 + bj * 128 + wc * 32 + n * 16 + 4 * fq);
#pragma unroll
        for (int ai = 0; ai < 2; ++ai)
#pragma unroll
            for (int mp = 0; mp < 2; ++mp) {
                v2u xv[2][2][2]; v2u pv[2][2][2]; float sa[2];
#pragma unroll
                for (int mm = 0; mm < 2; ++mm) { sa[mm] = SA[u.pm * 256 + ai * 128 + wr * 64 + (2 * mp + mm) * 16 + fr];
#pragma unroll
                    for (int bj = 0; bj < 2; ++bj)
#pragma unroll
                        for (int n = 0; n < 2; ++n) { const size_t off = (size_t)(u.pm * 256 + ai * 128 + wr * 64 + (2 * mp + mm) * 16 + fr) * 1024 + u.pn * 256 + bj * 128 + wc * 32 + n * 16 + 4 * fq;
                            xv[mm][bj][n] = *(const v2u*)(X3 + off); pv[mm][bj][n] = *(const v2u*)(PR + off); } }
#pragma unroll
                for (int mm = 0; mm < 2; ++mm)
#pragma unroll
                    for (int bj = 0; bj < 2; ++bj)
#pragma unroll
                        for (int n = 0; n < 2; ++n) { const size_t off = (size_t)(u.pm * 256 + ai * 128 + wr * 64 + (2 * mp + mm) * 16 + fr) * 1024 + u.pn * 256 + bj * 128 + wc * 32 + n * 16 + 4 * fq;
                            f32x4 g = __builtin_convertvector(acc[ai][bj][2 * mp + mm][n], f32x4) * sb[bj][n] * sa[mm];
#pragma unroll
                            for (int j = 0; j < 4; ++j) g[j] = sigm(g[j]);
                            *(f32x4*)(O + off) = up4(xv[mm][bj][n].x, xv[mm][bj][n].y) + up4(pv[mm][bj][n].x, pv[mm][bj][n].y) * g; }
                asm volatile("" ::: "memory"); }
    }
};
struct EpiFinal {
    float* O; const bf16* PR;
    __device__ __forceinline__ void operator()(const f32x4 (&acc)[2][2][4][2], const Unit& u, int wr, int wc, int fr, int fq) const {
#pragma unroll
        for (int ai = 0; ai < 2; ++ai)
#pragma unroll
            for (int mp = 0; mp < 2; ++mp) {
                f32x4 xv[2][2][2]; v2u pv[2][2][2];
#pragma unroll
                for (int mm = 0; mm < 2; ++mm)
#pragma unroll
                    for (int bj = 0; bj < 2; ++bj)
#pragma unroll
                        for (int n = 0; n < 2; ++n) { const size_t off = (size_t)(u.pm * 256 + ai * 128 + wr * 64 + (2 * mp + mm) * 16 + fr) * 1024 + u.pn * 256 + bj * 128 + wc * 32 + n * 16 + 4 * fq;
                            xv[mm][bj][n] = *(const f32x4*)(O + off); pv[mm][bj][n] = *(const v2u*)(PR + off); }
#pragma unroll
                for (int mm = 0; mm < 2; ++mm)
#pragma unroll
                    for (int bj = 0; bj < 2; ++bj)
#pragma unroll
                        for (int n = 0; n < 2; ++n) { const size_t off = (size_t)(u.pm * 256 + ai * 128 + wr * 64 + (2 * mp + mm) * 16 + fr) * 1024 + u.pn * 256 + bj * 128 + wc * 32 + n * 16 + 4 * fq;
                            f32x4 g = acc[ai][bj][2 * mp + mm][n];
#pragma unroll
                            for (int j = 0; j < 4; ++j) g[j] = sigm(g[j]);
                            *(f32x4*)(O + off) = xv[mm][bj][n] + up4(pv[mm][bj][n].x, pv[mm][bj][n].y) * g; }
                asm volatile("" ::: "memory"); }
    }
};

struct Frame {
    LAS unsigned char* lds; unsigned char* gl;
    volatile LAS unsigned* MISC; gu32* ctl;
    int tid, lane, wave, vcu, G;
    const float* in[27]; float* out; unsigned char* ws;
};
#define WSP(type, off) ((type*)(F.ws + (off)))
#define DOP(type, off) ((type*)((unsigned char*)F.out + (off)))
enum { I_X = 0, I_P, I_POS, I_LNMIX, I_WIN, I_HGLB, I_HGON, I_WOA, I_QAN, I_KVAN, I_WUQ, I_WUKV, I_QN, I_KN, I_WOB, I_WOUT, I_LNMOE, I_WRG, I_BRG, I_WRE, I_BRE, I_W1, I_W3, I_W2, I_LNPLE, I_WPG, I_WPP };

enum { M_WIN = 0, M_WOAB, M_WUQ, M_WUKV, M_WOUT, M_WPG, M_WPP, M_W13, M_W2T };
template <int MAT> struct MatInfo;
template <> struct MatInfo<M_WIN>  { static constexpr int K = 1024, NP = NIN; };
template <> struct MatInfo<M_WOAB> { static constexpr int K = 512,  NP = 2048; };
template <> struct MatInfo<M_WUQ>  { static constexpr int K = 256,  NP = 768; };
template <> struct MatInfo<M_WUKV> { static constexpr int K = 256,  NP = 1024; };
template <> struct MatInfo<M_WOUT> { static constexpr int K = 1024, NP = 1024; };
template <> struct MatInfo<M_WPG>  { static constexpr int K = 1024, NP = 1024; };
template <> struct MatInfo<M_WPP>  { static constexpr int K = 256,  NP = 1024; };
template <> struct MatInfo<M_W13>  { static constexpr int K = 1024, NP = NE * 512; };
template <> struct MatInfo<M_W2T>  { static constexpr int K = 256,  NP = NE * 1024; };
template <int MAT> __device__ __forceinline__ void conv_map(const Frame& F, int p, const float*& src, size_t& ld, const float*& gain, int& kvalid) {
    constexpr int K = MatInfo<MAT>::K; src = nullptr; ld = 0; gain = nullptr; kvalid = K;
    if constexpr (MAT == M_WIN) {
        const int pn = p >> 8; int col;
        if (pn < 8) { const int q = p & 255, bj = q >> 7, wc = (q >> 5) & 3, n = (q >> 4) & 1, fq = (q >> 2) & 3, j = q & 3; const int kind = 2 * bj + n;
            col = kind * 512 + (pn >> 1) * 128 + (pn & 1) * 64 + wc * 16 + fq * 4 + j; }
        else if (pn < 10) col = 2048 + perm8(p - 2048);
        else if (pn == 10) col = 2560 + perm8(p - 2560);
        else if (pn == 11) { const int l = perm8(p - 2816); col = l < 128 ? 2816 + l : (l < 160 ? 2944 + (l - 128) : -1); }
        else if (pn < 16) col = 2976 + perm8(p - 3072);
        else col = 4000 + perm8(p - 4096);
        if (col >= 0) src = F.in[I_WIN] + col; ld = DIN; gain = F.in[I_LNMIX];
    } else if constexpr (MAT == M_WOAB) { { const float* sa = F.in[I_WOA]; const float* sb = F.in[I_WOB]; src = (const float*)((const unsigned char*)sa + ((p >> 10) ? (size_t)((const unsigned char*)sb - (const unsigned char*)sa) : (size_t)0)) + perm8(p & 1023); } ld = 1024; }
    else if constexpr (MAT == M_WUQ) { src = F.in[I_WUQ] + perm8(p); ld = 768; gain = F.in[I_QAN]; }
    else if constexpr (MAT == M_WUKV) { const int pn = p >> 8, q = p & 255, bj = q >> 7, wc = (q >> 5) & 3, n = (q >> 4) & 1, fq = (q >> 2) & 3, j = q & 3;
        const int head = (pn & 1) * 4 + wc, d = 32 * bj + 8 * fq + 4 * n + j; src = F.in[I_WUKV] + head * 128 + (pn >= 2 ? 64 : 0) + d; ld = 1024; gain = F.in[I_KVAN]; kvalid = 128; }
    else if constexpr (MAT == M_WOUT) { src = F.in[I_WOUT] + perm8(p); ld = 1024; }
    else if constexpr (MAT == M_WPG) { src = F.in[I_WPG] + (GATE_FIRST ? perm8(p) : p); ld = 1024; gain = F.in[I_LNPLE]; }
    else if constexpr (MAT == M_WPP) { src = F.in[I_WPP] + ((FUSE_PROJ && !GATE_FIRST) ? p : perm8(p)); ld = 1024; }
    else if constexpr (MAT == M_W13) { const int e = p >> 9, q = p & 511, pl = q >> 8, bj = (q >> 7) & 1, r = q & 127;
        { const float* sa = F.in[I_W1]; const float* sb = F.in[I_W3]; src = (const float*)((const unsigned char*)sa + (bj ? (size_t)((const unsigned char*)sb - (const unsigned char*)sa) : (size_t)0)) + (size_t)e * 1024 * 256 + pl * 128 + perm8(r); } ld = 256; gain = F.in[I_LNMOE]; }
    else { const int e = p >> 10, q = p & 1023; src = F.in[I_W2] + (size_t)e * 256 * 1024 + perm8(q); ld = 1024; }
}
template <int MAT> __device__ __forceinline__ bf16* conv_dst(const Frame& F) {
    constexpr size_t off = MAT == M_WIN ? WS_WIN : MAT == M_WOAB ? WS_WOAB : MAT == M_WUQ ? WS_WUQ : MAT == M_WUKV ? WS_WUKV : MAT == M_WOUT ? WS_WOUT : MAT == M_WPG ? WS_WPG : MAT == M_WPP ? WS_WPP : MAT == M_W13 ? WS_W13 : WS_W2T;
    return WSP(bf16, off);
}
template <int MAT> __device__ __forceinline__ void conv_item(const Frame& F, int item, int lane, LAS float* scr) {
    constexpr int K = MatInfo<MAT>::K; constexpr int KB = K / 64;
    const int kb = item % KB, p0 = (item / KB) * 32, p = p0 + (lane & 31), k0 = kb * 64;
    const float* src; size_t ld; const float* gain; int kvalid; conv_map<MAT>(F, p, src, ld, gain, kvalid); bf16* dst = conv_dst<MAT>(F);
    float tv[32];
#pragma unroll
    for (int i = 0; i < 32; ++i) { const int k = k0 + 2 * i + (lane >> 5); tv[i] = (src && k < kvalid) ? src[(size_t)k * ld] : 0.0f; }
#pragma unroll
    for (int i = 0; i < 32; ++i) { const int kk = 2 * i + (lane >> 5); scr[kk * 33 + (lane & 31)] = gain ? tv[i] * gain[k0 + kk] : tv[i]; }
    LDS_WAIT(); asm volatile("" ::: "memory");
    const int c = lane & 7;
#pragma unroll
    for (int j = 0; j < 4; ++j) { const int n = (lane >> 3) + 8 * j; const LAS float* sp = scr + (8 * c) * 33 + n;
        v4u o; o.x = pk2(sp[0 * 33], sp[1 * 33]); o.y = pk2(sp[2 * 33], sp[3 * 33]); o.z = pk2(sp[4 * 33], sp[5 * 33]); o.w = pk2(sp[6 * 33], sp[7 * 33]);
        *(v4u*)(dst + (size_t)(p0 + n) * K + k0 + 8 * c) = o; }
    LDS_WAIT(); asm volatile("" ::: "memory");
}
template <int MAT> __device__ __forceinline__ void conv_mat(const Frame& F) {
    constexpr int NITEMS = (MatInfo<MAT>::NP / 32) * (MatInfo<MAT>::K / 64);
    const int gw = F.vcu * NWAVES + F.wave, NGW = F.G * NWAVES;
    LAS float* scr = (LAS float*)(F.lds + F.wave * 16384);
    for (int it = gw; it < NITEMS; it += NGW) conv_item<MAT>(F, it, F.lane, scr);
}

template <int MAT> __device__ __forceinline__ void conv8_mat(const Frame& F, unsigned char* dst8, float* SB, int wg_shift) {
    constexpr int K = MatInfo<MAT>::K, KPT = K / 16;
    static_assert(K == 1024 || K == 256, "conv8: K = 1024 or 256");
    constexpr int NITEMS = MatInfo<MAT>::NP / 32;
    int t_ = threadIdx.x; asm volatile("" : "+v"(t_));
    const int tid = t_, nl = tid & 31, kg = tid >> 5;
    LAS float* red = (LAS float*)F.lds;
    int first = F.vcu - wg_shift; if (first < 0) first += F.G;
    for (int it = first; it < NITEMS; it += F.G) {
        const int p = it * 32 + nl;
        const float* src; size_t ld; const float* gain; int kvalid; conv_map<MAT>(F, p, src, ld, gain, kvalid);
        float tv[KPT];
#pragma unroll
        for (int i = 0; i < KPT; ++i) tv[i] = (src && kg * KPT + i < kvalid) ? src[(size_t)(kg * KPT + i) * ld] : 0.0f;
        float mx = 0.f;
#pragma unroll
        for (int i = 0; i < KPT; ++i) { if (gain) tv[i] *= gain[kg * KPT + i]; mx = fmaxf(mx, fabsf(tv[i])); }
        red[kg * 32 + nl] = mx;
        __syncthreads();
        float cm = 0.f;
#pragma unroll
        for (int i = 0; i < 16; ++i) cm = fmaxf(cm, red[i * 32 + nl]);
        const float inv = cm > 0.f ? 127.0f / cm : 0.f;
        if (kg == 0) SB[p] = cm * (1.0f / 127.0f);
        unsigned char* dp = dst8 + (size_t)p * K + kg * KPT;
#pragma unroll
        for (int i = 0; i < KPT / 16; ++i) { v4u o;
            o.x = q8pack(tv[16 * i + 0] * inv, tv[16 * i + 1] * inv, tv[16 * i + 2] * inv, tv[16 * i + 3] * inv); o.y = q8pack(tv[16 * i + 4] * inv, tv[16 * i + 5] * inv, tv[16 * i + 6] * inv, tv[16 * i + 7] * inv);
            o.z = q8pack(tv[16 * i + 8] * inv, tv[16 * i + 9] * inv, tv[16 * i + 10] * inv, tv[16 * i + 11] * inv); o.w = q8pack(tv[16 * i + 12] * inv, tv[16 * i + 13] * inv, tv[16 * i + 14] * inv, tv[16 * i + 15] * inv);
            *(v4u*)(dp + 16 * i) = o; }
        __syncthreads();
    }
}

__device__ __forceinline__ void conv13_db(const Frame& F) {
    constexpr int NITEMS = MatInfo<M_W13>::NP / 16;
    int t_ = threadIdx.x; asm volatile("" : "+v"(t_));
    const int tid = t_, nl = tid & 15, kg = tid >> 4;
    LAS float* red = (LAS float*)F.lds; unsigned char* dst8 = F.ws + WS_W13; float* SB = WSP(float, WS_SB13);
    if (NITEMS % (2 * F.G) != 0) { conv8_mat<M_W13>(F, dst8, SB, 0); return; }
    const float* gain = F.in[I_LNMOE] + kg * 32;
#define C13_LOAD(tv_, it_) do { const float* src_; size_t ld_; const float* g_; int kv_; conv_map<M_W13>(F, (it_) * 16 + nl, src_, ld_, g_, kv_); \
        _Pragma("unroll") for (int i_ = 0; i_ < 32; ++i_) tv_[i_] = src_[(size_t)(kg * 32 + i_) * ld_]; } while (0)
#define C13_PROC(tv_, it_) do { const int p_ = (it_) * 16 + nl; float mx_ = 0.f; \
        _Pragma("unroll") for (int i_ = 0; i_ < 32; ++i_) { tv_[i_] *= gain[i_]; mx_ = fmaxf(mx_, fabsf(tv_[i_])); } \
        red[kg * 16 + nl] = mx_; __syncthreads(); float cm_ = 0.f; \
        _Pragma("unroll") for (int i_ = 0; i_ < 32; ++i_) cm_ = fmaxf(cm_, red[i_ * 16 + nl]); \
        const float inv_ = cm_ > 0.f ? 127.0f / cm_ : 0.f; if (kg == 0) SB[p_] = cm_ * (1.0f / 127.0f); \
        unsigned char* dp_ = dst8 + (size_t)p_ * 1024 + kg * 32; \
        _Pragma("unroll") for (int i_ = 0; i_ < 2; ++i_) { v4u o_; \
            o_.x = q8pack(tv_[16 * i_ + 0] * inv_, tv_[16 * i_ + 1] * inv_, tv_[16 * i_ + 2] * inv_, tv_[16 * i_ + 3] * inv_); o_.y = q8pack(tv_[16 * i_ + 4] * inv_, tv_[16 * i_ + 5] * inv_, tv_[16 * i_ + 6] * inv_, tv_[16 * i_ + 7] * inv_); \
            o_.z = q8pack(tv_[16 * i_ + 8] * inv_, tv_[16 * i_ + 9] * inv_, tv_[16 * i_ + 10] * inv_, tv_[16 * i_ + 11] * inv_); o_.w = q8pack(tv_[16 * i_ + 12] * inv_, tv_[16 * i_ + 13] * inv_, tv_[16 * i_ + 14] * inv_, tv_[16 * i_ + 15] * inv_); \
            *(v4u*)(dp_ + 16 * i_) = o_; } \
        __syncthreads(); } while (0)
    float tA[32], tB[32];
    C13_LOAD(tA, F.vcu);
#pragma unroll 1
    for (int it = F.vcu; it < NITEMS; it += 2 * F.G) {
        C13_LOAD(tB, it + F.G); C13_PROC(tA, it);
        if (it + 2 * F.G < NITEMS) C13_LOAD(tA, it + 2 * F.G);
        C13_PROC(tB, it + F.G);
    }
#undef C13_LOAD
#undef C13_PROC
}
__device__ __forceinline__ void conv_w2t_strips(const Frame& F) {
    constexpr int NITEMS = MatInfo<M_W2T>::NP / 32;
    int t_ = threadIdx.x; asm volatile("" : "+v"(t_));
    const int tid = t_, nl = tid & 31, kg = tid >> 5;
    bf16* dst = WSP(bf16, WS_W2T);
    for (int it0 = F.vcu; it0 < NITEMS; it0 += 4 * F.G) {
        float tv[4][16];
#pragma unroll
        for (int q = 0; q < 4; ++q) { const int it = it0 + q * F.G; if (it < NITEMS) { const float* src; size_t ld; const float* g; int kv; conv_map<M_W2T>(F, it * 32 + nl, src, ld, g, kv);
#pragma unroll
            for (int i = 0; i < 16; ++i) tv[q][i] = src[(size_t)(kg * 16 + i) * ld]; } }
#pragma unroll
        for (int q = 0; q < 4; ++q) { const int it = it0 + q * F.G; if (it < NITEMS) { bf16* dp = dst + (size_t)(it * 32 + nl) * 256 + kg * 16;
            v4u o0, o1; o0.x = pk2(tv[q][0], tv[q][1]); o0.y = pk2(tv[q][2], tv[q][3]); o0.z = pk2(tv[q][4], tv[q][5]); o0.w = pk2(tv[q][6], tv[q][7]);
            o1.x = pk2(tv[q][8], tv[q][9]); o1.y = pk2(tv[q][10], tv[q][11]); o1.z = pk2(tv[q][12], tv[q][13]); o1.w = pk2(tv[q][14], tv[q][15]);
            *(v4u*)dp = o0; *(v4u*)(dp + 8) = o1; } }
    }
}

__device__ __forceinline__ void p0_prologue(const Frame& F) {
    #if I8_P1
    conv8_mat<M_WIN>(F, F.ws + WS_WIN, WSP(float, WS_SBIN), 0);
#else
    conv_mat<M_WIN>(F);
#endif
    conv_mat<M_WOAB>(F);
#if I8_QKV
    conv8_mat<M_WUQ>(F, F.ws + WS_WUQ, WSP(float, WS_SBUQ), 160); conv8_mat<M_WUKV>(F, F.ws + WS_WUKV, WSP(float, WS_SBUKV), 184);
#else
    conv_mat<M_WUQ>(F); conv_mat<M_WUKV>(F);
#endif
    conv_mat<M_WOUT>(F);
#if I8_P10
    conv8_mat<M_WPG>(F, F.ws + WS_WPG, WSP(float, WS_SBPG), 192);
#else
    conv_mat<M_WPG>(F);
#endif
#if FUSE_PROJ
    conv8_mat<M_WPP>(F, F.ws + WS_WPP, WSP(float, WS_SBPP), 224);
#else
    conv_mat<M_WPP>(F);
#endif
    const int gt = F.vcu * NTHR + F.tid, NGT = F.G * NTHR;
    for (int i = gt; i < 80 * 1024; i += NGT) { const int j = i & 7, lane_ = (i >> 3) & 63, r = i >> 9, cb = r % 5, ks = r / 5; const int o = 16 * cb + (lane_ & 15), k = 32 * ks + 8 * (lane_ >> 4) + j;
        const float wv = o >= 72 ? 0.f : F.in[I_LNMOE][k] * (o < 8 ? F.in[I_WRG][k * 8 + o] : F.in[I_WRE][k * 64 + (o - 8)]);
        const unsigned h = f2bf(wv); WSP(bf16, WS_WRH)[i] = (bf16)h; WSP(bf16, WS_WRL)[i] = (bf16)f2bf(wv - bf2f(h)); }
    for (int i = gt; i < 80; i += NGT) WSP(float, WS_BR)[i] = i < 8 ? F.in[I_BRG][i] : (i < 72 ? F.in[I_BRE][i - 8] : 0.f);
    for (int i = gt; i < 1024; i += NGT) { const int d = i >> 9, f = i & 511; const float a0 = F.in[I_HGLB][d * 1024 + f], a1 = F.in[I_HGLB][d * 1024 + 512 + f]; WSP(float, WS_LB)[i] = 1.0f / (1.0f + expf(a1 - a0)); }
    for (int i = gt; i < T * 16; i += NGT) { const int t = i >> 4, f = i & 15; const float pos = (float)((const int*)F.in[I_POS])[t]; const float inv = exp2f(-(float)f * (13.287712379549449f / 16.0f));
        const float ang = pos * inv;
        const float kq = rintf(ang * 0.15915494309189535f); float r = fmaf(-kq, 6.28318548202514648f, ang); r = fmaf(-kq, -1.7484555e-7f, r);
        WSP(float, WS_ROPE)[t * 32 + f] = __cosf(r); WSP(float, WS_ROPE)[t * 32 + 16 + f] = __sinf(r); }
    const int gw = F.vcu * NWAVES + F.wave, NGW = F.G * NWAVES;
    for (int m = gw; m < T; m += NGW) {
        const float* xr = F.in[I_X] + (size_t)m * D + F.lane * 8; f32x4 v[4]; float ss = 0.f;
#pragma unroll
        for (int j = 0; j < 2; ++j) { v[2 * j] = *(const f32x4*)(xr + 512 * j); v[2 * j + 1] = *(const f32x4*)(xr + 512 * j + 4); ss += dot4(v[2 * j]) + dot4(v[2 * j + 1]); }
        const float rs = rsqrtf(wave_sum(ss) * (1.0f / D) + EPS);
#if I8_P1
        float mx = 0.f;
#pragma unroll
        for (int i = 0; i < 4; ++i)
#pragma unroll
            for (int j = 0; j < 4; ++j) mx = fmaxf(mx, fabsf(v[i][j]));
        mx = wave_max(mx); const float inv = mx > 0.f ? 127.0f / mx : 0.f;
        if (F.lane == 0) WSP(float, WS_SA1)[m] = mx * rs * (1.0f / 127.0f);
#pragma unroll
        for (int j = 0; j < 2; ++j) { v2u o; o.x = q8pack(v[2 * j][0] * inv, v[2 * j][1] * inv, v[2 * j][2] * inv, v[2 * j][3] * inv); o.y = q8pack(v[2 * j + 1][0] * inv, v[2 * j + 1][1] * inv, v[2 * j + 1][2] * inv, v[2 * j + 1][3] * inv);
            *(v2u*)(F.ws + WS_ACT + (size_t)m * D + F.lane * 8 + 512 * j) = o; }
#else
#pragma unroll
        for (int j = 0; j < 2; ++j) st8(WSP(bf16, WS_ACT) + (size_t)m * D + F.lane * 8 + 512 * j, v[2 * j] * rs, v[2 * j + 1] * rs);
#endif
#if FUSE_PROJ
        { f32x4 p0 = (f32x4){0.f, 0.f, 0.f, 0.f}, p1 = p0; if (F.lane < 32) { const float* pr = F.in[I_P] + (size_t)m * PLE + F.lane * 8; p0 = *(const f32x4*)pr; p1 = *(const f32x4*)(pr + 4); }
          float pm = 0.f;
#pragma unroll
          for (int j = 0; j < 4; ++j) pm = fmaxf(pm, fmaxf(fabsf(p0[j]), fabsf(p1[j])));
          pm = wave_max(pm); const float pinv = pm > 0.f ? 127.0f / pm : 0.f;
          if (F.lane == 0) WSP(float, WS_SAP)[m] = pm * (1.0f / 127.0f);
          if (F.lane < 32) { v2u o; o.x = q8pack(p0[0] * pinv, p0[1] * pinv, p0[2] * pinv, p0[3] * pinv); o.y = q8pack(p1[0] * pinv, p1[1] * pinv, p1[2] * pinv, p1[3] * pinv); *(v2u*)(F.ws + WS_PB + (size_t)m * PLE + F.lane * 8) = o; } }
#else
        if (F.lane < 32) { const float* pr = F.in[I_P] + (size_t)m * PLE + F.lane * 8; st8(WSP(bf16, WS_PB) + (size_t)m * PLE + F.lane * 8, *(const f32x4*)pr, *(const f32x4*)(pr + 4)); }
#endif
    }
}

__device__ __forceinline__ void oa_pass(const Frame& F) {
    const int gw = F.vcu * NWAVES + F.wave, NGW = F.G * NWAVES;
    const bf16* OFp = WSP(bf16, WS_ACT); const bf16* OBp = OFp + (size_t)T * 512; const bf16* OGp = WSP(bf16, WS_OG); bf16* OA = DOP(bf16, DO_OA);
    const int c0 = F.lane * 8; const f32x4 g0 = *(const f32x4*)(F.in[I_HGON] + (c0 & 127)), g1 = *(const f32x4*)(F.in[I_HGON] + (c0 & 127) + 4);
    for (int m = gw; m < T; m += NGW) {
        const size_t off = (size_t)m * 512 + c0;
        const v4u a = *(const v4u*)(OFp + off), b = *(const v4u*)(OBp + off), g = *(const v4u*)(OGp + off);
        f32x4 s0 = up4(a.x, a.y) + up4(b.x, b.y), s1 = up4(a.z, a.w) + up4(b.z, b.w);
        float ss = dot4(s0) + dot4(s1); ss += __shfl_xor(ss, 1); ss += __shfl_xor(ss, 2); ss += __shfl_xor(ss, 4); ss += __shfl_xor(ss, 8);
        const float rs = rsqrtf(ss * (1.0f / 128.0f) + EPS);
        st8(OA + off, s0 * rs * g0 * up4(g.x, g.y), s1 * rs * g1 * up4(g.z, g.w));
    }
}
__device__ __forceinline__ void x3_pass(const Frame& F) {
    const int gw = F.vcu * NWAVES + F.wave, NGW = F.G * NWAVES;
    const bf16* Y0 = WSP(bf16, WS_Y0); const bf16* Y1 = WSP(bf16, WS_Y1); const bf16* X2 = DOP(bf16, DO_X2B); bf16* X3 = WSP(bf16, WS_X3B); unsigned char* HP = F.ws + WS_ACT;
    for (int m = gw; m < T; m += NGW) {
        f32x4 v[4]; float ss = 0.f;
#pragma unroll
        for (int j = 0; j < 2; ++j) { const size_t o = (size_t)m * D + F.lane * 8 + 512 * j; const v4u a = *(const v4u*)(Y0 + o), b = *(const v4u*)(Y1 + o), x = *(const v4u*)(X2 + o);
            v[2 * j] = up4(x.x, x.y) + up4(a.x, a.y) + up4(b.x, b.y); v[2 * j + 1] = up4(x.z, x.w) + up4(a.z, a.w) + up4(b.z, b.w);
            st8(X3 + o, v[2 * j], v[2 * j + 1]); ss += dot4(v[2 * j]) + dot4(v[2 * j + 1]); }
        const float rs = rsqrtf(wave_sum(ss) * (1.0f / D) + EPS);
        float mx = 0.f;
#pragma unroll
        for (int i = 0; i < 4; ++i)
#pragma unroll
            for (int j = 0; j < 4; ++j) mx = fmaxf(mx, fabsf(v[i][j]));
        mx = wave_max(mx); const float inv = mx > 0.f ? 127.0f / mx : 0.f;
        if (F.lane == 0) WSP(float, WS_SA3)[m] = mx * rs * (1.0f / 127.0f);
#pragma unroll
        for (int j = 0; j < 2; ++j) { v2u o; o.x = q8pack(v[2 * j][0] * inv, v[2 * j][1] * inv, v[2 * j][2] * inv, v[2 * j][3] * inv); o.y = q8pack(v[2 * j + 1][0] * inv, v[2 * j + 1][1] * inv, v[2 * j + 1][2] * inv, v[2 * j + 1][3] * inv);
            *(v2u*)(HP + (size_t)m * D + F.lane * 8 + 512 * j) = o; }
    }
}
__device__ __forceinline__ void moe_build_table(const Frame& F) {
    LAS int* tab = (LAS int*)(F.lds + TAB_OFF); LAS int* cnts = tab + 16 + 4 * MAXROWT;
    if (F.tid < NE) cnts[F.tid] = (int)__hip_atomic_load(F.ctl + CW_CNT + 64 * F.tid, RLX_AGENT);
    __syncthreads();
    LAS int* starts = cnts + NE;
    if (F.tid == 0) { int rt = 0; for (int e = 0; e < NE; ++e) { starts[e] = rt; rt += (cnts[e] + 255) >> 8; } tab[0] = rt; }
    __syncthreads();
    if (F.tid < NE) { const int e = F.tid, cnt = cnts[e], nt = (cnt + 255) >> 8, r0 = starts[e];
        for (int lt = 0; lt < nt; ++lt) { const int rt = r0 + lt; tab[16 + 4 * rt] = e; tab[16 + 4 * rt + 1] = e * T + 256 * lt; const int rem = cnt - 256 * lt; tab[16 + 4 * rt + 2] = rem < 256 ? rem : 256; } }
    __syncthreads();
}
#ifndef ATT_OTR
#define ATT_OTR 0
#endif
#ifndef ATT_FIXSM
#define ATT_FIXSM 0
#endif
namespace att {
using f32x16 = __attribute__((ext_vector_type(16))) float;
using s16x4 = __attribute__((ext_vector_type(4))) short;
constexpr int QBLK = 32, KVBLK = 64;
constexpr float SCALE = 0.10206207261596577f;
constexpr float THR = 8.f;
constexpr int SHM_V = 16384, SHM_K = 16384, SHM_ATTN = 2 * SHM_V + 2 * SHM_K + NWAVES * 64 * 4;
#define KSWZ(row, colB) ((row) * 256 + ((colB) ^ (((row) & 7) << 4)))
#define SBAR() __builtin_amdgcn_sched_barrier(0)
__device__ __forceinline__ int crow(int r, int hi) { return (r & 3) + 8 * (r >> 2) + 4 * hi; }
__device__ __forceinline__ unsigned cvtpk(float lo, float hi) { unsigned r; asm volatile("v_cvt_pk_bf16_f32 %0, %1, %2" : "=v"(r) : "v"(lo), "v"(hi)); return r; }
__device__ __forceinline__ void partialSM(f32x16& p0, f32x16& p1, float& m_reg, float& mn, float& alpha) {
    constexpr float C = SCALE * 1.4426950408889634f;
    float pmax = p0[0];
#pragma unroll
    for (int r = 1; r < 16; ++r) pmax = fmaxf(pmax, p0[r]);
#pragma unroll
    for (int r = 0; r < 16; ++r) pmax = fmaxf(pmax, p1[r]);
    { auto rr = __builtin_amdgcn_permlane32_swap(__float_as_uint(pmax), __float_as_uint(pmax), false, false); pmax = fmaxf(__uint_as_float(rr[0]), __uint_as_float(rr[1])); }
    if (__builtin_expect(__all(pmax - m_reg <= THR / SCALE), 1)) { mn = m_reg; alpha = 1.f; }
    else { mn = fmaxf(m_reg, pmax); alpha = __builtin_amdgcn_exp2f((m_reg - mn) * C); m_reg = mn; }
    const float mnC = -mn * C;
#pragma unroll
    for (int r = 0; r < 16; ++r) p0[r] = fmaf(p0[r], C, mnC);
#pragma unroll
    for (int r = 0; r < 16; ++r) p1[r] = fmaf(p1[r], C, mnC);
#pragma unroll
    for (int r = 0; r < 16; ++r) p0[r] = __builtin_amdgcn_exp2f(p0[r]);
}
__device__ __forceinline__ void partialSM_fix(f32x16& p0, f32x16& p1, float mnC) {
    constexpr float C = SCALE * 1.4426950408889634f;
#pragma unroll
    for (int r = 0; r < 16; ++r) p0[r] = fmaf(p0[r], C, mnC);
#pragma unroll
    for (int r = 0; r < 16; ++r) p1[r] = fmaf(p1[r], C, mnC);
#pragma unroll
    for (int r = 0; r < 16; ++r) p0[r] = __builtin_amdgcn_exp2f(p0[r]);
}
__device__ __forceinline__ void finishSM(f32x16& p0, f32x16& p1, float alpha, float& l_reg, bf16x8& pa0, bf16x8& pa1, bf16x8& pa2, bf16x8& pa3) {
#pragma unroll
    for (int r = 0; r < 16; ++r) p1[r] = __builtin_amdgcn_exp2f(p1[r]);
    float ps = 0;
#pragma unroll
    for (int r = 0; r < 16; ++r) ps += p0[r];
#pragma unroll
    for (int r = 0; r < 16; ++r) ps += p1[r];
    { auto rr = __builtin_amdgcn_permlane32_swap(__float_as_uint(ps), __float_as_uint(ps), false, false); ps = __uint_as_float(rr[0]) + __uint_as_float(rr[1]); }
    l_reg = l_reg * alpha + ps;
#define PK4(P, BASE, OUT) do { unsigned a0 = cvtpk(P[BASE + 0], P[BASE + 1]), a1 = cvtpk(P[BASE + 2], P[BASE + 3]);   \
    unsigned b0 = cvtpk(P[BASE + 4], P[BASE + 5]), b1 = cvtpk(P[BASE + 6], P[BASE + 7]);                              \
    auto r0 = __builtin_amdgcn_permlane32_swap(a0, b0, false, false); auto r1 = __builtin_amdgcn_permlane32_swap(a1, b1, false, false); \
    v4u w = {r0[0], r1[0], r0[1], r1[1]}; OUT = __builtin_bit_cast(bf16x8, w); } while (0)
    PK4(p0, 0, pa0); PK4(p0, 8, pa1); PK4(p1, 0, pa2); PK4(p1, 8, pa3);
#undef PK4
}
__device__ __forceinline__ void qkt(f32x16& p0, f32x16& p1, const char* Ks, const bf16x8* qr, int r32, int hi) {
    p0 = f32x16{}; p1 = f32x16{};
#pragma unroll
    for (int d0 = 0; d0 < 6; ++d0) { const int cb = (d0 * 16 + hi * 8) * 2;
        const bf16x8 b0 = *reinterpret_cast<const bf16x8*>(Ks + KSWZ(r32, cb));
        const bf16x8 b1 = *reinterpret_cast<const bf16x8*>(Ks + KSWZ(32 + r32, cb));
        p0 = __builtin_amdgcn_mfma_f32_32x32x16_bf16(b0, qr[d0], p0, 0, 0, 0);
        p1 = __builtin_amdgcn_mfma_f32_32x32x16_bf16(b1, qr[d0], p1, 0, 0, 0); }
}
__device__ __forceinline__ int v_st(int k, int c) { const int kk = (k & ~0xC) | ((k & 4) << 1) | ((k & 8) >> 1); return ((kk >> 3) * 4 + (c >> 5)) * 512 + ((kk & 7) * 32 + (c & 31)) * 2; }
__device__ __forceinline__ int v_rd_base(int lane) { return ((lane & 3) << 3) | (((lane >> 2) & 3) << 6) | (((lane >> 4) & 1) << 5) | (((lane >> 5) & 1) << 8); }
constexpr int v_rd_off(int d0, int ks, int half) { return d0 * 512 + ks * 4096 + half * 2048; }
template <int OFF> __device__ __forceinline__ s16x4 tr_read(int vb) { s16x4 r; asm volatile("ds_read_b64_tr_b16 %0, %1 offset:%2" : "=&v"(r) : "v"(vb), "i"(OFF) : "memory"); return r; }
template <int D0> __device__ __forceinline__ void pv_one(f32x16& od, int vb, bf16x8 pa0, bf16x8 pa1, bf16x8 pa2, bf16x8 pa3) {
    const s16x4 l0 = tr_read<v_rd_off(D0, 0, 0)>(vb), h0 = tr_read<v_rd_off(D0, 0, 1)>(vb), l1 = tr_read<v_rd_off(D0, 1, 0)>(vb), h1 = tr_read<v_rd_off(D0, 1, 1)>(vb);
    const s16x4 l2 = tr_read<v_rd_off(D0, 2, 0)>(vb), h2 = tr_read<v_rd_off(D0, 2, 1)>(vb), l3 = tr_read<v_rd_off(D0, 3, 0)>(vb), h3 = tr_read<v_rd_off(D0, 3, 1)>(vb);
    asm volatile("s_waitcnt lgkmcnt(0)" ::: "memory"); SBAR();
#define PK(L, H) (bf16x8){L[0], L[1], L[2], L[3], H[0], H[1], H[2], H[3]}
    od = __builtin_amdgcn_mfma_f32_32x32x16_bf16(pa0, PK(l0, h0), od, 0, 0, 0);
    od = __builtin_amdgcn_mfma_f32_32x32x16_bf16(pa1, PK(l1, h1), od, 0, 0, 0);
    od = __builtin_amdgcn_mfma_f32_32x32x16_bf16(pa2, PK(l2, h2), od, 0, 0, 0);
    od = __builtin_amdgcn_mfma_f32_32x32x16_bf16(pa3, PK(l3, h3), od, 0, 0, 0);
#undef PK
}
__device__ __forceinline__ void pv_d0(f32x16* o, int vb, bf16x8 pa0, bf16x8 pa1, bf16x8 pa2, bf16x8 pa3) { pv_one<0>(o[0], vb, pa0, pa1, pa2, pa3); pv_one<1>(o[1], vb, pa0, pa1, pa2, pa3); }

__device__ __forceinline__ void attn_unit(const bf16* __restrict__ QM, const bf16* __restrict__ KH, const bf16* __restrict__ VH, bf16* __restrict__ OM, const float* __restrict__ RT, const float* __restrict__ QN,
                                          int t0, int kb, int h, char* lds, const float* __restrict__ KN = nullptr) {
    int tid_ = threadIdx.x; asm volatile("" : "+v"(tid_));
    const int tid = tid_, wid = __builtin_amdgcn_readfirstlane(tid >> 6), lane = tid & 63, r32 = lane & 31, hi = lane >> 5;
    char* V_lds = lds; char* K_lds = lds + 2 * SHM_V;
    float* wsf = (float*)(lds + 2 * SHM_V + 2 * SHM_K) + wid * 64; float* li_l = wsf; float* al_l = wsf + 32;
    float m_reg = -1e30f, l_reg = 0; f32x16 o[2] = {}; bf16x8 qr[6];
    {
        const int tq = t0 + wid * QBLK + r32; const bf16* qp = QM + (size_t)tq * 768 + h * 96 + hi * 8;
        float qf[6][8]; float ss = 0.f;
#pragma unroll
        for (int d0 = 0; d0 < 6; ++d0) { const v4u w = *(const v4u*)(qp + d0 * 16);
            qf[d0][0] = bflo(w.x); qf[d0][1] = bfhi(w.x); qf[d0][2] = bflo(w.y); qf[d0][3] = bfhi(w.y); qf[d0][4] = bflo(w.z); qf[d0][5] = bfhi(w.z); qf[d0][6] = bflo(w.w); qf[d0][7] = bfhi(w.w);
#pragma unroll
            for (int j = 0; j < 8; ++j) ss += qf[d0][j] * qf[d0][j]; }
        { auto rr = __builtin_amdgcn_permlane32_swap(__float_as_uint(ss), __float_as_uint(ss), false, false); ss = __uint_as_float(rr[0]) + __uint_as_float(rr[1]); }
        const float rs = rsqrtf(ss * (1.0f / 96.0f) + EPS);
#pragma unroll
        for (int d0 = 0; d0 < 6; ++d0) { const f32x4 g0 = *(const f32x4*)(QN + d0 * 16 + hi * 8), g1 = *(const f32x4*)(QN + d0 * 16 + hi * 8 + 4);
#pragma unroll
            for (int j = 0; j < 4; ++j) { qf[d0][j] *= rs * g0[j]; qf[d0][4 + j] *= rs * g1[j]; } }
        { const float* rt = RT + (size_t)tq * 32 + hi * 8; const f32x4 c0 = *(const f32x4*)rt, c1 = *(const f32x4*)(rt + 4), s0 = *(const f32x4*)(rt + 16), s1 = *(const f32x4*)(rt + 20);
#pragma unroll
          for (int j = 0; j < 8; ++j) { const float c = j < 4 ? c0[j & 3] : c1[j & 3], s = j < 4 ? s0[j & 3] : s1[j & 3]; const float x1 = qf[4][j], x2 = qf[5][j]; qf[4][j] = x1 * c - x2 * s; qf[5][j] = x2 * c + x1 * s; } }
#pragma unroll
        for (int d0 = 0; d0 < 6; ++d0) { v4u w = {cvtpk(qf[d0][0], qf[d0][1]), cvtpk(qf[d0][2], qf[d0][3]), cvtpk(qf[d0][4], qf[d0][5]), cvtpk(qf[d0][6], qf[d0][7])}; qr[d0] = __builtin_bit_cast(bf16x8, w); }
    }
#if ATT_FIXSM
    float mnC;
    {   float gq = fabsf(QN[lane]), gk = fabsf(KN[lane]); if (lane < 32) { gq = fmaxf(gq, fabsf(QN[64 + lane])); gk = fmaxf(gk, fabsf(KN[64 + lane])); }
#pragma unroll
        for (int o_ = 1; o_ < 64; o_ <<= 1) { gq = fmaxf(gq, __shfl_xor(gq, o_)); gk = fmaxf(gk, __shfl_xor(gk, o_)); }
        const float bound = fminf(96.0f * 1.01f * gq * gk, 60.0f / SCALE);
        mnC = -bound * (SCALE * 1.4426950408889634f); }
#define PSM(p0_, p1_, mn_, al_) do { partialSM_fix(p0_, p1_, mnC); al_ = 1.f; } while (0)
#else
#define PSM(p0_, p1_, mn_, al_) partialSM(p0_, p1_, m_reg, mn_, al_)
#endif
    const int vrow = tid >> 3, vch = tid & 7, k0row = tid / 12, k0ch = tid - 12 * k0row, k1row = (tid + 512) / 12, k1ch = (tid + 512) - 12 * k1row; const bool two = wid < 4;
    const bf16* Kg = KH + ((size_t)kb * 8 + h) * 96; const bf16* Vg = VH + ((size_t)kb * 8 + h) * 64;
    const int vst0 = v_st(vrow, vch * 8), kst0 = KSWZ(k0row, k0ch * 16), kst1 = KSWZ(k1row, k1ch * 16);
    const int vb0 = (int)(uintptr_t)V_lds + v_rd_base(lane);
    struct { bf16x8 vs, ks0, ks1; } sr_[2];
#define SLOAD(i, kk) do { sr_[i].vs = *(const bf16x8*)(Vg + (size_t)((kk) + vrow) * 512 + vch * 8); sr_[i].ks0 = *(const bf16x8*)(Kg + (size_t)((kk) + k0row) * 768 + k0ch * 8); \
    if (two) sr_[i].ks1 = *(const bf16x8*)(Kg + (size_t)((kk) + k1row) * 768 + k1ch * 8); } while (0)
#define SWRITE(b, i) do { *(bf16x8*)(V_lds + (b) * SHM_V + vst0) = sr_[i].vs; *(bf16x8*)(K_lds + (b) * SHM_K + kst0) = sr_[i].ks0; if (two) *(bf16x8*)(K_lds + (b) * SHM_K + kst1) = sr_[i].ks1; } while (0)
#define SWAIT() do { if (two) asm volatile("s_waitcnt vmcnt(3)" ::: "memory"); else asm volatile("s_waitcnt vmcnt(2)" ::: "memory"); } while (0)
#if ATT_FIXSM
#define RESC(a) do { } while (0)
#else
#define RESC(a) do { if (__any((a) < 1.f)) { if (hi == 0) al_l[r32] = (a); asm volatile("s_waitcnt lgkmcnt(0)" ::: "memory"); \
    _Pragma("unroll") for (int d = 0; d < 2; ++d) _Pragma("unroll") for (int r = 0; r < 16; ++r) o[d][r] *= al_l[crow(r, hi)]; } } while (0)
#endif
    f32x16 pA0, pA1, pB0, pB1; float mnA, mnB, alA, alB; bf16x8 pa0, pa1, pa2, pa3; constexpr int NT = SEQ / KVBLK;
    SLOAD(0, 0); asm volatile("s_waitcnt vmcnt(0)" ::: "memory"); SWRITE(0, 0); __syncthreads();
    qkt(pA0, pA1, K_lds, qr, r32, hi); PSM(pA0, pA1, mnA, alA);
    SLOAD(1, KVBLK); SLOAD(0, 2 * KVBLK);
    SWAIT(); SWRITE(1, 1); __syncthreads();
    for (int j = 1; j + 1 < NT; j += 2) {
        SBAR(); qkt(pB0, pB1, K_lds + SHM_K, qr, r32, hi);
        finishSM(pA0, pA1, alA, l_reg, pa0, pa1, pa2, pa3); SBAR();
        SLOAD(1, (j + 2) * KVBLK); SBAR();
        pv_d0(o, vb0, pa0, pa1, pa2, pa3); PSM(pB0, pB1, mnB, alB);
        __syncthreads(); SWAIT(); SWRITE(0, 0);
        RESC(alB); __syncthreads();
        SBAR(); qkt(pA0, pA1, K_lds, qr, r32, hi);
        finishSM(pB0, pB1, alB, l_reg, pa0, pa1, pa2, pa3); SBAR();
        if (j + 3 < NT) SLOAD(0, (j + 3) * KVBLK); SBAR();
        pv_d0(o, vb0 + SHM_V, pa0, pa1, pa2, pa3); PSM(pA0, pA1, mnA, alA);
        __syncthreads(); SWAIT(); SWRITE(1, 1);
        RESC(alA); __syncthreads();
    }
    SBAR(); qkt(pB0, pB1, K_lds + SHM_K, qr, r32, hi);
    finishSM(pA0, pA1, alA, l_reg, pa0, pa1, pa2, pa3); SBAR();
    pv_d0(o, vb0, pa0, pa1, pa2, pa3); PSM(pB0, pB1, mnB, alB);
    __syncthreads(); RESC(alB);
    finishSM(pB0, pB1, alB, l_reg, pa0, pa1, pa2, pa3); SBAR();
    pv_d0(o, vb0 + SHM_V, pa0, pa1, pa2, pa3);
    if (hi == 0) li_l[r32] = l_reg; asm volatile("s_waitcnt lgkmcnt(0)" ::: "memory");
    bf16* Ow = OM + (size_t)(t0 + wid * QBLK) * 512 + h * 64;
#if ATT_OTR
    {
        char* ot = lds + 73728 + wid * 4608;
#pragma unroll
        for (int r = 0; r < 16; ++r) { const int orow = crow(r, hi); const float rl = __builtin_amdgcn_rcpf(li_l[orow]);
#pragma unroll
            for (int d0 = 0; d0 < 2; ++d0) *(unsigned short*)(ot + orow * 144 + (d0 * 32 + r32) * 2) = (unsigned short)f2bf(o[d0][r] * rl); }
        asm volatile("s_waitcnt lgkmcnt(0)" ::: "memory");
        const int orow = lane >> 1, oh = lane & 1;
#pragma unroll
        for (int k = 0; k < 4; ++k) *(v4u*)(Ow + (size_t)orow * 512 + oh * 32 + 8 * k) = *(const v4u*)(ot + orow * 144 + oh * 64 + 16 * k);
    }
#else
#pragma unroll
    for (int r = 0; r < 16; ++r) { const int orow = crow(r, hi); const float rl = __builtin_amdgcn_rcpf(li_l[orow]);
#pragma unroll
        for (int d0 = 0; d0 < 2; ++d0) Ow[(size_t)orow * 512 + d0 * 32 + r32] = (bf16)f2bf(o[d0][r] * rl); }
#endif
    asm volatile("s_waitcnt vmcnt(0)" ::: "memory");
    __syncthreads();
#undef SLOAD
#undef SWRITE
#undef SWAIT
#undef RESC
#undef PSM
}
#undef KSWZ
#undef SBAR
}
__device__ __forceinline__ void attn_fast(const Frame& F) {
    const bf16* QM = WSP(bf16, WS_QM); const bf16* KH = WSP(bf16, WS_KH); const bf16* VH = WSP(bf16, WS_VH); bf16* OM = DOP(bf16, DO_OM);
    for (int item = F.vcu; item < NB * MH * 8; item += F.G) {
        const int qb = item & 7, h = (item >> 3) & 7, b = item >> 6;
        att::attn_unit(QM, KH, VH, OM, WSP(float, WS_ROPE), F.in[I_QN], b * SEQ + qb * 256, b * SEQ, h, (char*)F.gl);
    }
}
namespace hg {
typedef short v4i16_t __attribute__((ext_vector_type(4)));
constexpr int IN_BYTES = 40960, OFF_Q = 0, OFF_K = 16384, OFF_V = 32768, OFF_P = 2 * IN_BYTES, OFF_MT = OFF_P + 8192;
__device__ __forceinline__ unsigned off256(unsigned row, unsigned ch) { return 256u * row + 16u * (ch ^ (((row & 3) << 2) | ((row >> 2) & 3))); }
__device__ __forceinline__ unsigned off128(unsigned row, unsigned ch) { return 128u * row + 16u * (ch ^ (row & 7)); }
__device__ __forceinline__ bf16x8 ldrow(const LAS unsigned char* p) { return *(const LAS bf16x8*)p; }
__device__ __forceinline__ bf16x8 ldtr(const LAS unsigned char* p0, const LAS unsigned char* p1) {
    const v4i16_t a = __builtin_amdgcn_ds_read_tr16_b64_v4i16((LAS v4i16_t*)p0), b = __builtin_amdgcn_ds_read_tr16_b64_v4i16((LAS v4i16_t*)p1);
    return (bf16x8){a[0], a[1], a[2], a[3], b[0], b[1], b[2], b[3]};
}
}
__device__ __forceinline__ void hgrn_fast(const Frame& F) {
    using namespace hg;
    int tid_ = threadIdx.x; asm volatile("" : "+v"(tid_));
    const int tid = tid_, lane = tid & 63, w = __builtin_amdgcn_readfirstlane(tid >> 6), l15 = lane & 15, g = lane >> 4, q4 = (lane & 15) >> 2, p4 = lane & 3;
    const LAS unsigned char* L = F.lds;
    const unsigned qrow0 = tid >> 4, qch = tid & 15, qrow1 = qrow0 + 32, vrow = tid >> 3, vch = tid & 7;
    const unsigned sq0 = off256(qrow0, qch), sq1 = off256(qrow1, qch), sv = off128(vrow, vch);
    const int tb = w >> 1, sb0 = 2 * (w & 1);
    for (int item = blockIdx.x; item < NB * HGH * 2 * 2; item += F.G) {
        const int vh = item & 1, dir = (item >> 1) & 1, hh = (item >> 2) & 3, b = item >> 4;
        const bf16* Qd = DOP(bf16, dir ? DO_QB : DO_QF) + hh * 128 + qch * 8; const bf16* Kd = DOP(bf16, dir ? DO_KB : DO_KF) + hh * 128 + qch * 8;
        const bf16* Va = WSP(bf16, WS_VA) + hh * 128 + vh * 64 + vch * 8;
        bf16* Od = WSP(bf16, WS_ACT) + (dir ? (size_t)T * 512 : (size_t)0) + hh * 128 + vh * 64;
        const float* ER = WSP(float, WS_EREF) + (size_t)dir * NCHUNK * 512 + hh * 128 + 16 * w + 4 * g; const float* EL = WSP(float, WS_ELAST) + (size_t)dir * NCHUNK * 512 + hh * 128 + 16 * w + 4 * g;
#define HG_BAR() asm volatile("s_waitcnt lgkmcnt(0)\n\ts_barrier" ::: "memory")
        f32x4 M[4];
#pragma unroll
        for (int i = 0; i < 4; ++i) M[i] = (f32x4){0.f, 0.f, 0.f, 0.f};
        v4u rq0, rq1, rk0, rk1, rv;
#define HG_LOAD(gc_) do { const size_t t0_ = (size_t)(gc_) * 64; rq0 = *(const v4u*)(Qd + (t0_ + qrow0) * 512); rq1 = *(const v4u*)(Qd + (t0_ + qrow1) * 512); \
        rk0 = *(const v4u*)(Kd + (t0_ + qrow0) * 512); rk1 = *(const v4u*)(Kd + (t0_ + qrow1) * 512); rv = *(const v4u*)(Va + (t0_ + vrow) * 512); } while (0)
#define HG_WRITE(buf_) do { LAS unsigned char* B_ = (LAS unsigned char*)L + (buf_) * IN_BYTES; *(LAS v4u*)(B_ + OFF_Q + sq0) = rq0; *(LAS v4u*)(B_ + OFF_Q + sq1) = rq1; \
        *(LAS v4u*)(B_ + OFF_K + sq0) = rk0; *(LAS v4u*)(B_ + OFF_K + sq1) = rk1; *(LAS v4u*)(B_ + OFF_V + sv) = rv; } while (0)
        __syncthreads();
        { const int c0 = dir ? 31 : 0; HG_LOAD(b * 32 + c0); HG_WRITE(0); }
        __syncthreads();
        for (int cc = 0; cc < 32; ++cc) {
            const int c = dir ? 31 - cc : cc, gc = b * 32 + c, cn = dir ? c - 1 : c + 1, buf = cc & 1; const bool has = cc < 31;
            const LAS unsigned char* Bq = L + buf * IN_BYTES + OFF_Q; const LAS unsigned char* Bk = L + buf * IN_BYTES + OFF_K; const LAS unsigned char* Bv = L + buf * IN_BYTES + OFF_V;
            if (has) HG_LOAD(b * 32 + cn);
            f32x4 dv = (f32x4){0.f, 0.f, 0.f, 0.f};
            if (has) dv = *(const f32x4*)(EL + (size_t)gc * 512) * *(const f32x4*)(ER + (size_t)(b * 32 + cn) * 512);
            bf16x8 qfr[4];
            {
                f32x4 pa[2] = {(f32x4){0.f, 0.f, 0.f, 0.f}, (f32x4){0.f, 0.f, 0.f, 0.f}};
#pragma unroll
                for (int ks = 0; ks < 4; ++ks) { qfr[ks] = ldrow(Bq + off256(16 * tb + l15, 4 * ks + g));
#pragma unroll
                    for (int i = 0; i < 2; ++i) { const bf16x8 kf = ldrow(Bk + off256(16 * (sb0 + i) + l15, 4 * ks + g)); pa[i] = __builtin_amdgcn_mfma_f32_16x16x32_bf16(kf, qfr[ks], pa[i], 0, 0, 0); } }
                const int t = 16 * tb + l15;
#pragma unroll
                for (int i = 0; i < 2; ++i) { const int s0 = 16 * (sb0 + i) + 4 * g; f32x4 v = pa[i];
#pragma unroll
                    for (int r = 0; r < 4; ++r) { const bool ok = dir ? (s0 + r >= t) : (s0 + r <= t); v[r] = ok ? v[r] : 0.f; }
                    v2u pk; pk.x = pk2(v[0], v[1]); pk.y = pk2(v[2], v[3]);
                    *(LAS v2u*)((LAS unsigned char*)L + OFF_P + off128(t, 2 * (sb0 + i) + (g >> 1)) + (g & 1) * 8) = pk; }
#pragma unroll
                for (int vb = 0; vb < 4; ++vb) { v2u pk; pk.x = pk2(M[vb][0], M[vb][1]); pk.y = pk2(M[vb][2], M[vb][3]);
                    *(LAS v2u*)((LAS unsigned char*)L + OFF_MT + off256(16 * vb + l15, 2 * w + (g >> 1)) + (g & 1) * 8) = pk; }
            }
            HG_BAR();
            {
                f32x4 oa[2] = {(f32x4){0.f, 0.f, 0.f, 0.f}, (f32x4){0.f, 0.f, 0.f, 0.f}};
#pragma unroll
                for (int ks = 0; ks < 2; ++ks) { const bf16x8 pf = ldrow(L + OFF_P + off128(16 * tb + l15, 4 * ks + g));
#pragma unroll
                    for (int i = 0; i < 2; ++i) { const unsigned c = sb0 + i;
                        const bf16x8 vf = ldtr(Bv + off128(32 * ks + 8 * g + q4, 2 * c + (p4 >> 1)) + 8 * (p4 & 1), Bv + off128(32 * ks + 8 * g + 4 + q4, 2 * c + (p4 >> 1)) + 8 * (p4 & 1));
                        oa[i] = __builtin_amdgcn_mfma_f32_16x16x32_bf16(vf, pf, oa[i], 0, 0, 0); } }
#pragma unroll
                for (int ks = 0; ks < 4; ++ks) {
#pragma unroll
                    for (int i = 0; i < 2; ++i) { const bf16x8 mf = ldrow(L + OFF_MT + off256(16 * (sb0 + i) + l15, 4 * ks + g)); oa[i] = __builtin_amdgcn_mfma_f32_16x16x32_bf16(mf, qfr[ks], oa[i], 0, 0, 0); } }
                const size_t orow = ((size_t)gc * 64 + 16 * tb + l15) * 512;
#pragma unroll
                for (int i = 0; i < 2; ++i) st4(Od + orow + 16 * (sb0 + i) + 4 * g, oa[i]);
#pragma unroll
                for (int ks = 0; ks < 2; ++ks) {
                    const bf16x8 kf = ldtr(Bk + off256(32 * ks + 8 * g + q4, 2 * w + (p4 >> 1)) + 8 * (p4 & 1), Bk + off256(32 * ks + 8 * g + 4 + q4, 2 * w + (p4 >> 1)) + 8 * (p4 & 1));
#pragma unroll
                    for (int vb = 0; vb < 4; ++vb) {
                        const bf16x8 vf = ldtr(Bv + off128(32 * ks + 8 * g + q4, 2 * vb + (p4 >> 1)) + 8 * (p4 & 1), Bv + off128(32 * ks + 8 * g + 4 + q4, 2 * vb + (p4 >> 1)) + 8 * (p4 & 1));
                        M[vb] = __builtin_amdgcn_mfma_f32_16x16x32_bf16(kf, vf, M[vb], 0, 0, 0); } }
#pragma unroll
                for (int vb = 0; vb < 4; ++vb) M[vb] = M[vb] * dv;
            }
            if (has) HG_WRITE(buf ^ 1);
            HG_BAR();
        }
#undef HG_LOAD
#undef HG_WRITE
#undef HG_BAR
    }
}
namespace hg2 {
constexpr int QKB = 32768, H2_V = 3 * QKB, H2_P = H2_V + 2 * 8192, H2_D = TAB_OFF;
}
__device__ __forceinline__ void hgrn_fast2(const Frame& F) {
    using namespace hg; using namespace hg2;
    const int w = __builtin_amdgcn_readfirstlane((int)threadIdx.x >> 6);
    const LAS unsigned char* L = F.lds; LAS unsigned char* Lw = (LAS unsigned char*)F.lds;
#define HG_BAR() asm volatile("s_waitcnt lgkmcnt(0)\n\ts_barrier" ::: "memory")
#define CH(cc_) (dir ? 31 - (cc_) : (cc_))
    for (int item = blockIdx.x; item < NB * HGH * 2 * 2; item += F.G) {
        const int vh = item & 1, dir = (item >> 1) & 1, hh = (item >> 2) & 3, b = item >> 4;
        __syncthreads();
        if (w < 4) {
            int t_ = threadIdx.x; asm volatile("" : "+v"(t_));
            const int lane = t_ & 63, l15 = lane & 15, g = lane >> 4, q4 = (lane & 15) >> 2, p4 = lane & 3;
            bf16* Od = WSP(bf16, WS_ACT) + (dir ? (size_t)T * 512 : (size_t)0) + hh * 128 + vh * 64 + 16 * w + 4 * g;
            f32x4 Mb[8];
#pragma unroll
            for (int i = 0; i < 8; ++i) Mb[i] = (f32x4){0.f, 0.f, 0.f, 0.f};
            HG_BAR(); HG_BAR();
#pragma unroll 1
            for (int cc = 0; cc < 32; ++cc) {
                const LAS unsigned char* Bq = L + (cc % 3) * QKB; const LAS unsigned char* Bk = Bq + 16384; const LAS unsigned char* Bv = L + H2_V + (cc & 1) * 8192; const LAS unsigned char* Bp = L + H2_P + (cc & 1) * 8192;
                const int gc = b * 32 + CH(cc);
                bf16x8 vf[2];
#pragma unroll
                for (int ks = 0; ks < 2; ++ks) vf[ks] = ldtr(Bv + off128(32 * ks + 8 * g + q4, 2 * w + (p4 >> 1)) + 8 * (p4 & 1), Bv + off128(32 * ks + 8 * g + 4 + q4, 2 * w + (p4 >> 1)) + 8 * (p4 & 1));
                f32x4 oa[4];
#pragma unroll
                for (int tb = 0; tb < 4; ++tb) oa[tb] = (f32x4){0.f, 0.f, 0.f, 0.f};
#pragma unroll
                for (int tb = 0; tb < 4; ++tb)
#pragma unroll
                    for (int ks = 0; ks < 2; ++ks) { const bf16x8 pf = ldrow(Bp + off128(16 * tb + l15, 4 * ks + g)); oa[tb] = __builtin_amdgcn_mfma_f32_16x16x32_bf16(vf[ks], pf, oa[tb], 0, 0, 0); }
#pragma unroll
                for (int ks = 0; ks < 4; ++ks) { v4u mw; mw.x = pk2(Mb[2 * ks][0], Mb[2 * ks][1]); mw.y = pk2(Mb[2 * ks][2], Mb[2 * ks][3]); mw.z = pk2(Mb[2 * ks + 1][0], Mb[2 * ks + 1][1]); mw.w = pk2(Mb[2 * ks + 1][2], Mb[2 * ks + 1][3]);
                    const bf16x8 mf = __builtin_bit_cast(bf16x8, mw);
#pragma unroll
                    for (int tb = 0; tb < 4; ++tb) { const v2u qa = *(const LAS v2u*)(Bq + off256(16 * tb + l15, 4 * ks + (g >> 1)) + 8 * (g & 1)), qb = *(const LAS v2u*)(Bq + off256(16 * tb + l15, 4 * ks + 2 + (g >> 1)) + 8 * (g & 1));
                        v4u qw; qw.x = qa.x; qw.y = qa.y; qw.z = qb.x; qw.w = qb.y;
                        oa[tb] = __builtin_amdgcn_mfma_f32_16x16x32_bf16(mf, __builtin_bit_cast(bf16x8, qw), oa[tb], 0, 0, 0); } }
#ifdef PROBE_HG_LDS
                { unsigned dm = 0;
#pragma unroll
                  for (int ks = 0; ks < 4; ++ks)
#pragma unroll
                    for (int tb = 0; tb < 4; ++tb) { const v2u qa = *(const volatile LAS v2u*)(Bq + off256(16 * tb + l15, 4 * ks + (g >> 1)) + 8 * (g & 1)), qb = *(const volatile LAS v2u*)(Bq + off256(16 * tb + l15, 4 * ks + 2 + (g >> 1)) + 8 * (g & 1)); dm ^= qa.x ^ qa.y ^ qb.x ^ qb.y; }
                  if (dm == 0x12345678u && gc < 0) Od[0] = (bf16)dm; }
#endif
#pragma unroll
                for (int tb = 0; tb < 4; ++tb) st4(Od + ((size_t)gc * 64 + 16 * tb + l15) * 512, oa[tb]);
                if (cc < 31) {
#pragma unroll
                    for (int ks = 0; ks < 2; ++ks)
#pragma unroll
                        for (int cb = 0; cb < 8; ++cb) { const bf16x8 kf = ldtr(Bk + off256(32 * ks + 8 * g + q4, 2 * cb + (p4 >> 1)) + 8 * (p4 & 1), Bk + off256(32 * ks + 8 * g + 4 + q4, 2 * cb + (p4 >> 1)) + 8 * (p4 & 1));
                            Mb[cb] = __builtin_amdgcn_mfma_f32_16x16x32_bf16(kf, vf[ks], Mb[cb], 0, 0, 0); }
#pragma unroll
                    for (int cb = 0; cb < 8; ++cb) Mb[cb] = Mb[cb] * *(const LAS f32x4*)(L + H2_D + (cc & 1) * 512 + (16 * cb + 4 * g) * 4);
                }
                HG_BAR();
            }
        } else {
            int t_ = threadIdx.x; asm volatile("" : "+v"(t_));
            const int lane = t_ & 63, l15 = lane & 15, g = lane >> 4, pt = t_ & 255;
            const bf16* Qd = DOP(bf16, dir ? DO_QB : DO_QF) + hh * 128 + (pt & 15) * 8 + (size_t)(pt >> 4) * 512; const bf16* Kd = DOP(bf16, dir ? DO_KB : DO_KF) + hh * 128 + (pt & 15) * 8 + (size_t)(pt >> 4) * 512;
            const bf16* Va = WSP(bf16, WS_VA) + hh * 128 + vh * 64 + (pt & 7) * 8 + (size_t)(pt >> 3) * 512;
            const float* ER = WSP(float, WS_EREF) + (size_t)dir * NCHUNK * 512 + hh * 128 + (pt & 127); const float* EL = WSP(float, WS_ELAST) + (size_t)dir * NCHUNK * 512 + hh * 128 + (pt & 127);
            const unsigned sq0 = off256(pt >> 4, pt & 15), sv0 = off128(pt >> 3, pt & 7);
            v4u rqA[4], rkA[4], rvA[2], rqB[4], rkB[4], rvB[2]; float elA = 0.f, erA = 0.f, elB = 0.f, erB = 0.f;
#define LOAD_QK(cc_, S) do { const size_t t0_ = (size_t)(b * 32 + CH(cc_)) * 64; _Pragma("unroll") for (int i_ = 0; i_ < 4; ++i_) { rq##S[i_] = *(const v4u*)(Qd + (t0_ + 16 * i_) * 512); rk##S[i_] = *(const v4u*)(Kd + (t0_ + 16 * i_) * 512); } } while (0)
#define LOAD_V(cc_, S) do { const size_t t0_ = (size_t)(b * 32 + CH(cc_)) * 64; _Pragma("unroll") for (int i_ = 0; i_ < 2; ++i_) rv##S[i_] = *(const v4u*)(Va + (t0_ + 32 * i_) * 512); } while (0)
#define WRITE_QK(cc_, S) do { LAS unsigned char* B_ = Lw + ((cc_) % 3) * QKB + sq0; _Pragma("unroll") for (int i_ = 0; i_ < 4; ++i_) { *(LAS v4u*)(B_ + 4096 * i_) = rq##S[i_]; *(LAS v4u*)(B_ + 16384 + 4096 * i_) = rk##S[i_]; } } while (0)
#define WRITE_V(cc_, S) do { LAS unsigned char* B_ = Lw + H2_V + ((cc_) & 1) * 8192 + sv0; _Pragma("unroll") for (int i_ = 0; i_ < 2; ++i_) *(LAS v4u*)(B_ + 4096 * i_) = rv##S[i_]; } while (0)
#define LOAD_D(cc_, S) do { el##S = EL[(size_t)(b * 32 + CH(cc_)) * 512]; er##S = ER[(size_t)(b * 32 + CH((cc_) + 1)) * 512]; } while (0)
#define WRITE_D(cc_, S) do { if (pt < 128) *(LAS float*)(Lw + H2_D + ((cc_) & 1) * 512 + pt * 4) = el##S * er##S; } while (0)
#define MAKE_P(cc_) do { const LAS unsigned char* Bq_ = L + ((cc_) % 3) * QKB; const LAS unsigned char* Bk_ = Bq_ + 16384; LAS unsigned char* Bp_ = Lw + H2_P + ((cc_) & 1) * 8192; const int tb_ = w - 4; \
            f32x4 pa_[4]; _Pragma("unroll") for (int i_ = 0; i_ < 4; ++i_) pa_[i_] = (f32x4){0.f, 0.f, 0.f, 0.f}; \
            _Pragma("unroll") for (int ks_ = 0; ks_ < 4; ++ks_) { const bf16x8 qf_ = ldrow(Bq_ + off256(16 * tb_ + l15, 4 * ks_ + g)); \
                _Pragma("unroll") for (int i_ = 0; i_ < 4; ++i_) { const bf16x8 kf_ = ldrow(Bk_ + off256(16 * i_ + l15, 4 * ks_ + g)); pa_[i_] = __builtin_amdgcn_mfma_f32_16x16x32_bf16(kf_, qf_, pa_[i_], 0, 0, 0); } } \
            const int tt_ = 16 * tb_ + l15; \
            _Pragma("unroll") for (int i_ = 0; i_ < 4; ++i_) { const int s0_ = 16 * i_ + 4 * g; f32x4 v_ = pa_[i_]; \
                _Pragma("unroll") for (int r_ = 0; r_ < 4; ++r_) { const bool ok_ = dir ? (s0_ + r_ >= tt_) : (s0_ + r_ <= tt_); v_[r_] = ok_ ? v_[r_] : 0.f; } \
                v2u pk_; pk_.x = pk2(v_[0], v_[1]); pk_.y = pk2(v_[2], v_[3]); *(LAS v2u*)(Bp_ + off128(tt_, 2 * i_ + (g >> 1)) + (g & 1) * 8) = pk_; } } while (0)
            LOAD_QK(0, A); LOAD_V(0, A); LOAD_D(0, A); LOAD_QK(1, B); WRITE_QK(0, A); WRITE_V(0, A); WRITE_D(0, A); WRITE_QK(1, B);
            LOAD_QK(2, A); LOAD_V(1, A); LOAD_D(1, A); LOAD_QK(3, B); LOAD_V(2, B); LOAD_D(2, B);
            HG_BAR();
            MAKE_P(0);
            HG_BAR();
#define P_STEP(S) do { if (cc + 2 < 32) WRITE_QK(cc + 2, S); if (cc + 1 < 32) WRITE_V(cc + 1, S); if (cc + 2 < 32) WRITE_D(cc + 1, S); \
            if (cc + 4 < 32) LOAD_QK(cc + 4, S); if (cc + 3 < 32) LOAD_V(cc + 3, S); if (cc + 4 < 32) LOAD_D(cc + 3, S); if (cc + 1 < 32) MAKE_P(cc + 1); } while (0)
#pragma unroll 1
            for (int c2 = 0; c2 < 32; c2 += 2) {
                { const int cc = c2; P_STEP(A); HG_BAR(); }
                { const int cc = c2 + 1; P_STEP(B); HG_BAR(); }
            }
#undef P_STEP
#undef LOAD_QK
#undef LOAD_V
#undef WRITE_QK
#undef WRITE_V
#undef LOAD_D
#undef WRITE_D
#undef MAKE_P
        }
    }
#undef CH
#undef HG_BAR
}

typedef float f32x16 __attribute__((ext_vector_type(16)));
__device__ __forceinline__ void hgrn_fast3(const Frame& F) {
    using namespace hg; using namespace hg2;
    const int w = __builtin_amdgcn_readfirstlane((int)threadIdx.x >> 6);
    const LAS unsigned char* L = F.lds; LAS unsigned char* Lw = (LAS unsigned char*)F.lds;
#define HG_BAR() asm volatile("s_waitcnt lgkmcnt(0)\n\ts_barrier" ::: "memory")
#define CH(cc_) (dir ? 31 - (cc_) : (cc_))
    for (int item = blockIdx.x; item < NB * HGH * 2 * 2; item += F.G) {
        const int vh = item & 1, dir = (item >> 1) & 1, hh = (item >> 2) & 3, b = item >> 4;
        __syncthreads();
        if (w < 2) {
            int t_ = threadIdx.x; asm volatile("" : "+v"(t_));
            const int lane = t_ & 63, r32 = lane & 31, h = lane >> 5, blk = (lane >> 4) & 1, q4 = (lane & 15) >> 2, p4 = lane & 3;
            bf16* Od = WSP(bf16, WS_ACT) + (dir ? (size_t)T * 512 : (size_t)0) + hh * 128 + vh * 64 + 32 * w + 4 * h;
            f32x16 Mb[4];
#pragma unroll
            for (int i = 0; i < 4; ++i) Mb[i] = f32x16{};
            HG_BAR(); HG_BAR();
#pragma unroll 1
            for (int cc = 0; cc < 32; ++cc) {
                const LAS unsigned char* Bq = L + (cc % 3) * QKB; const LAS unsigned char* Bk = Bq + 16384; const LAS unsigned char* Bv = L + H2_V + (cc & 1) * 8192; const LAS unsigned char* Bp = L + H2_P + (cc & 1) * 8192;
                const int gc = b * 32 + CH(cc);
                bf16x8 vf[4];
#pragma unroll
                for (int ks = 0; ks < 4; ++ks) vf[ks] = ldtr(Bv + off128(16 * ks + 8 * h + q4, 4 * w + 2 * blk + (p4 >> 1)) + 8 * (p4 & 1), Bv + off128(16 * ks + 8 * h + 4 + q4, 4 * w + 2 * blk + (p4 >> 1)) + 8 * (p4 & 1));
                f32x16 oa[2] = {f32x16{}, f32x16{}};
#pragma unroll
                for (int tb = 0; tb < 2; ++tb)
#pragma unroll
                    for (int ks = 0; ks < 4; ++ks) { const bf16x8 pf = ldrow(Bp + off128(32 * tb + r32, 2 * ks + h)); oa[tb] = __builtin_amdgcn_mfma_f32_32x32x16_bf16(vf[ks], pf, oa[tb], 0, 0, 0); }
#pragma unroll
                for (int cb = 0; cb < 4; ++cb)
#pragma unroll
                    for (int s2 = 0; s2 < 2; ++s2) {
                        v4u mw; mw.x = pk2(Mb[cb][8 * s2 + 0], Mb[cb][8 * s2 + 1]); mw.y = pk2(Mb[cb][8 * s2 + 2], Mb[cb][8 * s2 + 3]); mw.z = pk2(Mb[cb][8 * s2 + 4], Mb[cb][8 * s2 + 5]); mw.w = pk2(Mb[cb][8 * s2 + 6], Mb[cb][8 * s2 + 7]);
                        const bf16x8 mf = __builtin_bit_cast(bf16x8, mw);
#pragma unroll
                        for (int tb = 0; tb < 2; ++tb) { const v2u qa = *(const LAS v2u*)(Bq + off256(32 * tb + r32, 4 * cb + 2 * s2) + 8 * h), qb = *(const LAS v2u*)(Bq + off256(32 * tb + r32, 4 * cb + 2 * s2 + 1) + 8 * h);
                            v4u qw; qw.x = qa.x; qw.y = qa.y; qw.z = qb.x; qw.w = qb.y;
                            oa[tb] = __builtin_amdgcn_mfma_f32_32x32x16_bf16(mf, __builtin_bit_cast(bf16x8, qw), oa[tb], 0, 0, 0); } }
#pragma unroll
                for (int tb = 0; tb < 2; ++tb)
#pragma unroll
                    for (int i = 0; i < 4; ++i) st4(Od + ((size_t)gc * 64 + 32 * tb + r32) * 512 + 8 * i, (f32x4){oa[tb][4 * i], oa[tb][4 * i + 1], oa[tb][4 * i + 2], oa[tb][4 * i + 3]});
                if (cc < 31) {
#pragma unroll
                    for (int ks = 0; ks < 4; ++ks)
#pragma unroll
                        for (int cb = 0; cb < 4; ++cb) { const bf16x8 kf = ldtr(Bk + off256(16 * ks + 8 * h + q4, 4 * cb + 2 * blk + (p4 >> 1)) + 8 * (p4 & 1), Bk + off256(16 * ks + 8 * h + 4 + q4, 4 * cb + 2 * blk + (p4 >> 1)) + 8 * (p4 & 1));
                            Mb[cb] = __builtin_amdgcn_mfma_f32_32x32x16_bf16(kf, vf[ks], Mb[cb], 0, 0, 0); }
#pragma unroll
                    for (int cb = 0; cb < 4; ++cb)
#pragma unroll
                        for (int i = 0; i < 4; ++i) { const f32x4 dv = *(const LAS f32x4*)(L + H2_D + (cc & 1) * 512 + (32 * cb + 8 * i + 4 * h) * 4);
#pragma unroll
                            for (int e = 0; e < 4; ++e) Mb[cb][4 * i + e] *= dv[e]; }
                }
                HG_BAR();
            }
        } else if (w < 4) {
            HG_BAR(); HG_BAR();
#pragma unroll 1
            for (int cc = 0; cc < 32; ++cc) HG_BAR();
        } else {
            int t_ = threadIdx.x; asm volatile("" : "+v"(t_));
            const int lane = t_ & 63, r32 = lane & 31, h = lane >> 5, pt = t_ & 255;
            const bf16* Qd = DOP(bf16, dir ? DO_QB : DO_QF) + hh * 128 + (pt & 15) * 8 + (size_t)(pt >> 4) * 512; const bf16* Kd = DOP(bf16, dir ? DO_KB : DO_KF) + hh * 128 + (pt & 15) * 8 + (size_t)(pt >> 4) * 512;
            const bf16* Va = WSP(bf16, WS_VA) + hh * 128 + vh * 64 + (pt & 7) * 8 + (size_t)(pt >> 3) * 512;
            const float* ER = WSP(float, WS_EREF) + (size_t)dir * NCHUNK * 512 + hh * 128 + (pt & 127); const float* EL = WSP(float, WS_ELAST) + (size_t)dir * NCHUNK * 512 + hh * 128 + (pt & 127);
            const unsigned sq0 = off256(pt >> 4, pt & 15), sv0 = off128(pt >> 3, pt & 7);
            v4u rqA[4], rkA[4], rvA[2], rqB[4], rkB[4], rvB[2]; float elA = 0.f, erA = 0.f, elB = 0.f, erB = 0.f;
#define LOAD_QK(cc_, S) do { const size_t t0_ = (size_t)(b * 32 + CH(cc_)) * 64; _Pragma("unroll") for (int i_ = 0; i_ < 4; ++i_) { rq##S[i_] = *(const v4u*)(Qd + (t0_ + 16 * i_) * 512); rk##S[i_] = *(const v4u*)(Kd + (t0_ + 16 * i_) * 512); } } while (0)
#define LOAD_V(cc_, S) do { const size_t t0_ = (size_t)(b * 32 + CH(cc_)) * 64; _Pragma("unroll") for (int i_ = 0; i_ < 2; ++i_) rv##S[i_] = *(const v4u*)(Va + (t0_ + 32 * i_) * 512); } while (0)
#define WRITE_QK(cc_, S) do { LAS unsigned char* B_ = Lw + ((cc_) % 3) * QKB + sq0; _Pragma("unroll") for (int i_ = 0; i_ < 4; ++i_) { *(LAS v4u*)(B_ + 4096 * i_) = rq##S[i_]; *(LAS v4u*)(B_ + 16384 + 4096 * i_) = rk##S[i_]; } } while (0)
#define WRITE_V(cc_, S) do { LAS unsigned char* B_ = Lw + H2_V + ((cc_) & 1) * 8192 + sv0; _Pragma("unroll") for (int i_ = 0; i_ < 2; ++i_) *(LAS v4u*)(B_ + 4096 * i_) = rv##S[i_]; } while (0)
#define LOAD_D(cc_, S) do { el##S = EL[(size_t)(b * 32 + CH(cc_)) * 512]; er##S = ER[(size_t)(b * 32 + CH((cc_) + 1)) * 512]; } while (0)
#define WRITE_D(cc_, S) do { if (pt < 128) *(LAS float*)(Lw + H2_D + ((cc_) & 1) * 512 + pt * 4) = el##S * er##S; } while (0)
#define MAKE_P(cc_) do { if (w < 6) { const LAS unsigned char* Bq_ = L + ((cc_) % 3) * QKB; const LAS unsigned char* Bk_ = Bq_ + 16384; LAS unsigned char* Bp_ = Lw + H2_P + ((cc_) & 1) * 8192; const int tb_ = w - 4; \
            f32x16 pa_[2] = {f32x16{}, f32x16{}}; \
            _Pragma("unroll") for (int ks_ = 0; ks_ < 8; ++ks_) { const bf16x8 qf_ = ldrow(Bq_ + off256(32 * tb_ + r32, 2 * ks_ + h)); \
                _Pragma("unroll") for (int i_ = 0; i_ < 2; ++i_) { const bf16x8 kf_ = ldrow(Bk_ + off256(32 * i_ + r32, 2 * ks_ + h)); pa_[i_] = __builtin_amdgcn_mfma_f32_32x32x16_bf16(kf_, qf_, pa_[i_], 0, 0, 0); } } \
            const int tt_ = 32 * tb_ + r32; \
            _Pragma("unroll") for (int i_ = 0; i_ < 2; ++i_) _Pragma("unroll") for (int q_ = 0; q_ < 4; ++q_) { const int s0_ = 32 * i_ + 8 * q_ + 4 * h; float v_[4]; \
                _Pragma("unroll") for (int e_ = 0; e_ < 4; ++e_) { const bool ok_ = dir ? (s0_ + e_ >= tt_) : (s0_ + e_ <= tt_); v_[e_] = ok_ ? pa_[i_][4 * q_ + e_] : 0.f; } \
                v2u pk_; pk_.x = pk2(v_[0], v_[1]); pk_.y = pk2(v_[2], v_[3]); *(LAS v2u*)(Bp_ + off128(tt_, 4 * i_ + q_) + 8 * h) = pk_; } } } while (0)
            LOAD_QK(0, A); LOAD_V(0, A); LOAD_D(0, A); LOAD_QK(1, B); WRITE_QK(0, A); WRITE_V(0, A); WRITE_D(0, A); WRITE_QK(1, B);
            LOAD_QK(2, A); LOAD_V(1, A); LOAD_D(1, A); LOAD_QK(3, B); LOAD_V(2, B); LOAD_D(2, B);
            HG_BAR();
            MAKE_P(0);
            HG_BAR();
#define P_STEP(S) do { if (cc + 2 < 32) WRITE_QK(cc + 2, S); if (cc + 1 < 32) WRITE_V(cc + 1, S); if (cc + 2 < 32) WRITE_D(cc + 1, S); \
            if (cc + 4 < 32) LOAD_QK(cc + 4, S); if (cc + 3 < 32) LOAD_V(cc + 3, S); if (cc + 4 < 32) LOAD_D(cc + 3, S); if (cc + 1 < 32) MAKE_P(cc + 1); } while (0)
#pragma unroll 1
            for (int c2 = 0; c2 < 32; c2 += 2) {
                { const int cc = c2; P_STEP(A); HG_BAR(); }
                { const int cc = c2 + 1; P_STEP(B); HG_BAR(); }
            }
#undef P_STEP
#undef LOAD_QK
#undef LOAD_V
#undef WRITE_QK
#undef WRITE_V
#undef LOAD_D
#undef WRITE_D
#undef MAKE_P
        }
    }
#undef CH
#undef HG_BAR
}
template <bool DRY = false> __device__ __forceinline__ void route_fast(const Frame& F) {
    int tid_ = threadIdx.x; asm volatile("" : "+v"(tid_));
    const int tid = tid_, lane = tid & 63, w = __builtin_amdgcn_readfirstlane(tid >> 6), l15 = lane & 15, g = lane >> 4;
    LAS float* lg = (LAS float*)F.lds + w * 16 * 80;
    LAS int* cntL = (LAS int*)(F.lds + 40960); LAS int* baseL = cntL + 64;
    const bf16* WRH = WSP(bf16, WS_WRH); const bf16* WRL = WSP(bf16, WS_WRL); const float* BR = WSP(float, WS_BR);
    const bf16* X2 = DOP(bf16, DO_X2B); int* EIDX = WSP(int, WS_EIDX); float* EW = WSP(float, WS_EW); int* LIST = WSP(int, WS_LIST); float* RS2 = WSP(float, WS_RS2);
    for (int round = 0; round * F.G * 128 < T; ++round) {
        const int m0 = (round * F.G + F.vcu) * 128 + w * 16;
        if (tid < 64) cntL[tid] = 0;
        __syncthreads();
        f32x4 acc[5];
#pragma unroll
        for (int cb = 0; cb < 5; ++cb) acc[cb] = (f32x4){0.f, 0.f, 0.f, 0.f};
        float ss = 0.f;
        const bf16* wh = WRH + lane * 8; const bf16* wl = WRL + lane * 8;
        LAS unsigned char* stg = F.lds + 49152 + w * 8448;
        const int srow = lane >> 5;
        const bf16* xg = X2 + (size_t)(m0 + srow) * 1024 + (lane & 31) * 8;
#if I8_P7
        float mxt; { const f32x4 pm = *(const f32x4*)(WSP(float, WS_XMAX) + (size_t)(m0 + (lane >> 2)) * 16 + (lane & 3) * 4); mxt = fmaxf(fmaxf(pm[0], pm[1]), fmaxf(pm[2], pm[3])); mxt = fmaxf(mxt, __shfl_xor(mxt, 1)); mxt = fmaxf(mxt, __shfl_xor(mxt, 2)); }
        float invr[8];
#pragma unroll
        for (int i_ = 0; i_ < 8; ++i_) { const float mr = __shfl(mxt, 4 * (2 * i_ + srow)); invr[i_] = mr > 0.f ? 127.0f / mr : 0.f; }
        unsigned char* hq = F.ws + WS_ACT + (size_t)(m0 + srow) * 1024 + (lane & 31) * 8;
#endif
        v4u R[8];
#define RT_LOADG(c_) do { _Pragma("unroll") for (int i_ = 0; i_ < 8; ++i_) R[i_] = *(const v4u*)(xg + (size_t)(2 * i_) * 1024 + 256 * (c_)); } while (0)
        RT_LOADG(0);
#pragma unroll 1
        for (int c = 0; c < 4; ++c) {
#pragma unroll
            for (int i_ = 0; i_ < 8; ++i_) { *(LAS v4u*)(stg + (2 * i_ + srow) * 528 + (lane & 31) * 16) = R[i_];
#if I8_P7
                { const f32x4 a = up4(R[i_].x, R[i_].y) * invr[i_], b = up4(R[i_].z, R[i_].w) * invr[i_]; v2u o; o.x = q8pack(a[0], a[1], a[2], a[3]); o.y = q8pack(b[0], b[1], b[2], b[3]);
                  *(v2u*)(hq + (size_t)(2 * i_) * 1024 + 256 * c) = o; }
#endif
            }
            LDS_WAIT(); asm volatile("" ::: "memory");
            if (c < 3) RT_LOADG(c + 1);
#pragma unroll
            for (int h_ = 0; h_ < 4; ++h_) {
                bf16x8 bh[2][5], bl[2][5];
#pragma unroll
                for (int j_ = 0; j_ < 2; ++j_)
#pragma unroll
                    for (int cb = 0; cb < 5; ++cb) { const int ks_ = 8 * c + 2 * h_ + j_; bh[j_][cb] = *(const bf16x8*)(wh + (ks_ * 5 + cb) * 512); bl[j_][cb] = *(const bf16x8*)(wl + (ks_ * 5 + cb) * 512); }
#pragma unroll
                for (int j_ = 0; j_ < 2; ++j_) { const v4u xa = *(const LAS v4u*)(stg + l15 * 528 + 64 * (2 * h_ + j_) + 16 * g);
                    ss = dot2bf(xa.x, xa.x, ss); ss = dot2bf(xa.y, xa.y, ss); ss = dot2bf(xa.z, xa.z, ss); ss = dot2bf(xa.w, xa.w, ss);
                    const bf16x8 xh = __builtin_bit_cast(bf16x8, xa);
#pragma unroll
                    for (int cb = 0; cb < 5; ++cb) {
                        acc[cb] = __builtin_amdgcn_mfma_f32_16x16x32_bf16(xh, bh[j_][cb], acc[cb], 0, 0, 0);
                        acc[cb] = __builtin_amdgcn_mfma_f32_16x16x32_bf16(xh, bl[j_][cb], acc[cb], 0, 0, 0); } }
            }
            LDS_WAIT(); asm volatile("" ::: "memory");
        }
#undef RT_LOADG
        ss += __shfl_xor(ss, 16); ss += __shfl_xor(ss, 32);
        const float rs = rsqrtf(ss * (1.0f / D) + EPS);
#if I8_P7
        { const float ml = __shfl(mxt, 4 * l15); if (g == 0) RS2[m0 + l15] = rs * ml * (1.0f / 127.0f); }
#else
        if (g == 0) RS2[m0 + l15] = rs;
#endif
        float rsr[4];
#pragma unroll
        for (int r = 0; r < 4; ++r) rsr[r] = __shfl(rs, 4 * g + r);
#pragma unroll
        for (int cb = 0; cb < 5; ++cb) { const float bias = BR[16 * cb + l15];
#pragma unroll
            for (int r = 0; r < 4; ++r) lg[(4 * g + r) * 80 + 16 * cb + l15] = acc[cb][r] * rsr[r] + bias; }
        LDS_WAIT(); asm volatile("" ::: "memory");
        int e0 = 0, e1 = 0, r0 = 0, r1 = 0; const int m = m0 + lane;
        if (lane < 16) {
            const LAS float* lt = lg + lane * 80;
            float gl[8];
#pragma unroll
            for (int i = 0; i < 8; ++i) gl[i] = lt[i];
            float gm = gl[0]; int gs = 0;
#pragma unroll
            for (int i = 1; i < 8; ++i) if (gl[i] > gm) { gm = gl[i]; gs = i; }
            float ge = 0.f;
#pragma unroll
            for (int i = 0; i < 8; ++i) ge += __expf(gl[i] - gm);
            const float pg = 1.0f / ge;
            float el[8];
#pragma unroll
            for (int i = 0; i < 8; ++i) el[i] = lt[8 + 8 * gs + i];
            float m1 = el[0]; int i1 = 0;
#pragma unroll
            for (int i = 1; i < 8; ++i) if (el[i] > m1) { m1 = el[i]; i1 = i; }
            float m2 = -3e38f; int i2 = 0;
#pragma unroll
            for (int i = 0; i < 8; ++i) if (i != i1 && el[i] > m2) { m2 = el[i]; i2 = i; }
            const float e2 = __expf(m2 - m1), w0 = pg / (1.0f + e2), w1 = pg * e2 / (1.0f + e2);
            e0 = 8 * gs + i1; e1 = 8 * gs + i2;
            EIDX[m * 2] = e0; EIDX[m * 2 + 1] = e1; EW[m * 2] = w0; EW[m * 2 + 1] = w1;
            if (!DRY) { r0 = __hip_atomic_fetch_add(cntL + e0, 1, __ATOMIC_RELAXED, __HIP_MEMORY_SCOPE_WORKGROUP);
            r1 = __hip_atomic_fetch_add(cntL + e1, 1, __ATOMIC_RELAXED, __HIP_MEMORY_SCOPE_WORKGROUP); }
        }
        __syncthreads();
        if (!DRY && tid < 64) { const int c = cntL[tid]; baseL[tid] = c ? (int)__hip_atomic_fetch_add(F.ctl + CW_CNT + 64 * tid, (unsigned)c, RLX_AGENT) : 0; }
        __syncthreads();
        if (!DRY && lane < 16) { LIST[(size_t)e0 * T + baseL[e0] + r0] = m * 2; LIST[(size_t)e1 * T + baseL[e1] + r1] = m * 2 + 1; }
        __syncthreads();
    }
}
struct Args { const float* in[27]; float* out; unsigned char* ws; int ph_lo, ph_hi, use_bar, pad; };
constexpr int NPHASE = 11;
__device__ __forceinline__ void frame_init(Frame& F, const Args& args, unsigned char* lds) {
    F.lds = (LAS unsigned char*)lds; F.gl = lds;
    F.MISC = (volatile LAS unsigned*)(F.lds + MISC_OFF);
    F.tid = threadIdx.x; F.lane = F.tid & 63; F.wave = __builtin_amdgcn_readfirstlane(F.tid >> 6);
    F.G = gridDim.x; { const int bx = blockIdx.x; F.vcu = (F.G % 8 == 0) ? (bx % 8) * (F.G / 8) + bx / 8 : bx; }
    F.ws = args.ws; F.out = args.out; F.ctl = (gu32*)(args.ws + WS_CTL);
#pragma unroll
    for (int i = 0; i < 27; ++i) F.in[i] = args.in[i];
    for (int u = F.tid; u < 1024 / 4; u += NTHR) ((LAS unsigned*)(F.lds + LDSCTL_OFF))[u] = 0u;
    __syncthreads();
}
template <int PH> __device__ __forceinline__ void run_phase(const Frame& F) {
    if constexpr (PH == 0) { p0_prologue(F); }
    if constexpr (PH == 1) {
#if I8_P1
        Gemm g{WSP(bf16, WS_ACT), WSP(bf16, WS_WIN), 512, nullptr, 0}; StaticOrder S; S.init(T, NIN, F.G, (int)blockIdx.x);
        EpiScaled<EpiIn> E{EpiIn{F.ws, (unsigned char*)F.out, (LAS float*)(F.lds + TAB_OFF)}, WSP(float, WS_SA1), WSP(float, WS_SBIN)};
        gemm_fast<EpiScaled<EpiIn>, StaticOrder, false, GF_ALIGN, GF_SP2, true>(F.lds, g, S, E);
#else
        Gemm g{WSP(bf16, WS_ACT), WSP(bf16, WS_WIN), 1024, nullptr, SKEW_K1024}; StaticOrder S; S.init(T, NIN, F.G, (int)blockIdx.x);
        EpiIn E{F.ws, (unsigned char*)F.out, (LAS float*)(F.lds + TAB_OFF)};
        GEMM_PHASE(EpiIn, StaticOrder, g, S, E);
#endif
    }
    if constexpr (PH == 2) {
#if I8_QKV
        { Gemm g{WSP(bf16, WS_CQ), WSP(bf16, WS_WUQ), 128, nullptr, 0, WSP(bf16, WS_CKVR), WSP(bf16, WS_WUKV), 128}; QKVOrder S; S.init(F.G, (int)blockIdx.x);
          EpiQKV8 E{F.ws, F.in[I_KN]};
          gemm_fast<EpiQKV8, QKVOrder, false, GF_ALIGN, GF_SP2, true, true>(F.lds, g, S, E); }
#elif MERGE_QKV
        { Gemm g{WSP(bf16, WS_CQ), WSP(bf16, WS_WUQ), 256, nullptr, 0, WSP(bf16, WS_CKVR), WSP(bf16, WS_WUKV), 256}; QKVOrder S; S.init(F.G, (int)blockIdx.x);
          EpiQKV E{EpiQ{WSP(bf16, WS_QM), WSP(float, WS_CQSS)}, EpiKV{WSP(bf16, WS_KH), WSP(bf16, WS_VH), WSP(float, WS_CKVSS), WSP(float, WS_KR), WSP(float, WS_ROPE), F.in[I_KN]}};
          gemm_fast<EpiQKV, QKVOrder, false, GF_ALIGN, GF_SP2, false, true>(F.lds, g, S, E); }
#else
        { Gemm g{WSP(bf16, WS_CQ), WSP(bf16, WS_WUQ), 256, nullptr, SKEW_K256}; StaticOrder S; S.init(T, 768, F.G, (int)blockIdx.x); EpiQ E{WSP(bf16, WS_QM), WSP(float, WS_CQSS)}; GEMM_PHASE(EpiQ, StaticOrder, g, S, E); }
        { Gemm g{WSP(bf16, WS_CKVR), WSP(bf16, WS_WUKV), 256, nullptr, SKEW_K256}; StaticOrder S; S.init(T, 1024, F.G, (int)blockIdx.x);
          EpiKV E{WSP(bf16, WS_KH), WSP(bf16, WS_VH), WSP(float, WS_CKVSS), WSP(float, WS_KR), WSP(float, WS_ROPE), F.in[I_KN]}; GEMM_PHASE(EpiKV, StaticOrder, g, S, E); }
#endif
#ifdef PROBE_QKV2
        __syncthreads();
        { Gemm g{WSP(bf16, WS_CQ), WSP(bf16, WS_WUQ), 256, nullptr, SKEW_K256}; StaticOrder S; S.init(T, 768, F.G, (int)blockIdx.x); EpiQ E{WSP(bf16, WS_QM), WSP(float, WS_CQSS)}; GEMM_PHASE(EpiQ, StaticOrder, g, S, E); }
        { Gemm g{WSP(bf16, WS_CKVR), WSP(bf16, WS_WUKV), 256, nullptr, SKEW_K256}; StaticOrder S; S.init(T, 1024, F.G, (int)blockIdx.x);
          EpiKV E{WSP(bf16, WS_KH), WSP(bf16, WS_VH), WSP(float, WS_CKVSS), WSP(float, WS_KR), WSP(float, WS_ROPE), F.in[I_KN]}; GEMM_PHASE(EpiKV, StaticOrder, g, S, E); }
#endif
        HGRN_PHASE(F);
#ifdef PROBE_HGRN2
        __syncthreads(); HGRN_PHASE(F);
#endif
    }
    if constexpr (PH == 3) {
#if STAGGER_CONV
        if (!STAGGER_OA) oa_pass(F);
        const bf16* QM = WSP(bf16, WS_QM); const bf16* KH = WSP(bf16, WS_KH); const bf16* VH = WSP(bf16, WS_VH); bf16* OM = DOP(bf16, DO_OM);
        int it = 0; bool side_done = false;
        for (int item = F.vcu; item < NB * MH * 8; item += F.G, ++it) {
            if (it == (F.vcu & 3)) { side_done = true; __syncthreads(); if (STAGGER_OA) oa_pass(F); conv13_db(F); conv_w2t_strips(F); __syncthreads();
#ifdef PROBE_CONV2
                conv13_db(F); conv_w2t_strips(F); __syncthreads();
#endif
            }
            const int qb = item & 7, h = (item >> 3) & 7, b = item >> 6;
            att::attn_unit(QM, KH, VH, OM, WSP(float, WS_ROPE), F.in[I_QN], b * SEQ + qb * 256, b * SEQ, h, (char*)F.gl, F.in[I_KN]);
        }
        if (!side_done) { __syncthreads(); if (STAGGER_OA) oa_pass(F); conv13_db(F); conv_w2t_strips(F); }
#else
        oa_pass(F); ATTN_PHASE(F);
#endif
    }
    if constexpr (PH == 4) {
        Gemm g{DOP(bf16, DO_OA), WSP(bf16, WS_WOAB), 512, nullptr, SKEW_K512}; PairOrder S; S.init(F.G, (int)blockIdx.x); EpiMerge E{WSP(bf16, WS_ACT), WSP(bf16, WS_GA), WSP(bf16, WS_GB)};
        GEMM_PHASE(EpiMerge, PairOrder, g, S, E);
    }
    if constexpr (PH == 5) {
        Gemm g{WSP(bf16, WS_ACT), WSP(bf16, WS_WOUT), 1024, nullptr, SKEW_K1024}; StaticOrder S; S.init(T, D, F.G, (int)blockIdx.x); EpiX2 E{F.in[I_X], DOP(bf16, DO_X2B), WSP(float, WS_XMAX)};
        GEMM_PHASE(EpiX2, StaticOrder, g, S, E);
    }
    if constexpr (PH == 6) { ROUTE_PHASE(F); __syncthreads();
#if !STAGGER_CONV
#if I8_P7
        conv8_mat<M_W13>(F, F.ws + WS_W13, WSP(float, WS_SB13), 0);
#else
        conv_mat<M_W13>(F);
#endif
        conv_mat<M_W2T>(F);
#endif
    }
    if constexpr (PH == 7) {
        moe_build_table(F);
#if I8_P7
        Gemm g{WSP(bf16, WS_ACT), WSP(bf16, WS_W13), 512, WSP(int, WS_LIST), 0}; MoeOrder S{(const LAS int*)(F.lds + TAB_OFF), 2, F.G, (int)blockIdx.x};
        EpiScaled<EpiUp, false> E{EpiUp{WSP(bf16, WS_H1), WSP(int, WS_LIST), WSP(float, WS_RS2)}, nullptr, WSP(float, WS_SB13)};
        gemm_fast<EpiScaled<EpiUp, false>, MoeOrder, true, GF_ALIGN, GF_SP2, true>(F.lds, g, S, E);
#else
        Gemm g{DOP(bf16, DO_X2B), WSP(bf16, WS_W13), 1024, WSP(int, WS_LIST), SKEW_K1024}; MoeOrder S{(const LAS int*)(F.lds + TAB_OFF), 2, F.G, (int)blockIdx.x}; EpiUp E{WSP(bf16, WS_H1), WSP(int, WS_LIST), WSP(float, WS_RS2)};
        GEMM_PHASE_GATHER(EpiUp, MoeOrder, g, S, E);
#endif
    }
    if constexpr (PH == 8) {
#if N_LAUNCHES != 1
        moe_build_table(F);
#endif
        Gemm g{WSP(bf16, WS_H1), WSP(bf16, WS_W2T), 256, nullptr, SKEW_K256}; MoeOrder S{(const LAS int*)(F.lds + TAB_OFF), 4, F.G, (int)blockIdx.x}; EpiDown E{WSP(bf16, WS_Y0), WSP(bf16, WS_Y1), WSP(int, WS_LIST), WSP(float, WS_EW)};
        GEMM_PHASE(EpiDown, MoeOrder, g, S, E);
    }
    if constexpr (PH == 9) {
#if !FUSE_PROJ
        Gemm g{WSP(bf16, WS_PB), WSP(bf16, WS_WPP), 256, nullptr, SKEW_K256}; StaticOrder S; S.init(T, D, F.G, (int)blockIdx.x); EpiProj E{WSP(bf16, WS_PROJ)};
        GEMM_PHASE(EpiProj, StaticOrder, g, S, E);
#endif
        x3_pass(F);
    }
    if constexpr (PH == 10) {
#if FUSE_PROJ && GATE_FIRST
        Gemm g{WSP(bf16, WS_ACT), WSP(bf16, WS_WPG), 512, nullptr, 0, WSP(bf16, WS_PB), WSP(bf16, WS_WPP), 128}; ProjGateOrder S; S.init(F.G, (int)blockIdx.x);
        EpiGateProj E{F.out, WSP(bf16, WS_X3B), F.ws + WS_PROJ + (size_t)blockIdx.x * 65536, WSP(float, WS_SA3), WSP(float, WS_SBPG), WSP(float, WS_SAP), WSP(float, WS_SBPP)};
        gemm_fast<EpiGateProj, ProjGateOrder, false, GF_ALIGN, GF_SP2, true, true>(F.lds, g, S, E);
#elif FUSE_PROJ
        Gemm g{WSP(bf16, WS_PB), WSP(bf16, WS_WPP), 128, nullptr, 0, WSP(bf16, WS_ACT), WSP(bf16, WS_WPG), 512}; ProjGateOrder S; S.init(F.G, (int)blockIdx.x);
        EpiProjGate E{F.out, WSP(bf16, WS_X3B), F.ws + WS_PROJ + (size_t)blockIdx.x * 131072, WSP(float, WS_SA3), WSP(float, WS_SBPG), WSP(float, WS_SAP), WSP(float, WS_SBPP)};
        gemm_fast<EpiProjGate, ProjGateOrder, false, GF_ALIGN, GF_SP2, true, true>(F.lds, g, S, E);
#elif I8_P10
        Gemm g{WSP(bf16, WS_ACT), WSP(bf16, WS_WPG), 512, nullptr, 0}; StaticOrder S; S.init(T, D, F.G, (int)blockIdx.x); EpiFinal8 E{F.out, WSP(bf16, WS_X3B), WSP(bf16, WS_PROJ), WSP(float, WS_SA3), WSP(float, WS_SBPG)};
        gemm_fast<EpiFinal8, StaticOrder, false, GF_ALIGN, GF_SP2, true>(F.lds, g, S, E);
#else
        Gemm g{WSP(bf16, WS_ACT), WSP(bf16, WS_WPG), 1024, nullptr, SKEW_K1024}; StaticOrder S; S.init(T, D, F.G, (int)blockIdx.x); EpiFinal E{F.out, WSP(bf16, WS_PROJ)};
        GEMM_PHASE(EpiFinal, StaticOrder, g, S, E);
#endif
    }
}

template <int PH> __global__ void __launch_bounds__(NTHR, 2) phase_kernel(Args args) {
    extern __shared__ __attribute__((aligned(16))) unsigned char lds[];
    Frame F; frame_init(F, args, lds);
    run_phase<PH>(F);
}
#if N_LAUNCHES == 1
__global__ void __launch_bounds__(NTHR, 2) mega(Args args) {
    extern __shared__ __attribute__((aligned(16))) unsigned char lds[];
    Frame F; frame_init(F, args, lds);
    XcdBarrier bar = xcd_barrier_post((unsigned*)(F.ctl + CW_BAR), F.MISC + 8);
#define PHASE(k) do { Frame Fk = F; int t_ = threadIdx.x; asm volatile("" : "+v"(t_)); Fk.tid = t_; Fk.lane = t_ & 63; Fk.wave = __builtin_amdgcn_readfirstlane(t_ >> 6); run_phase<k>(Fk); } while (0)
#define XBAR() xcd_barrier(bar)
    PHASE(0); XBAR();
    PHASE(1); XBAR();
    PHASE(2); XBAR();
    PHASE(3); XBAR();
    PHASE(4); XBAR();
    PHASE(5); XBAR();
    PHASE(6); XBAR();
    PHASE(7); XBAR();
    PHASE(8); XBAR();
    PHASE(9); XBAR();
    PHASE(10);
#undef PHASE
#undef XBAR
}
#endif
extern "C" void kernel_launch(void* const* d_in, const int* in_sizes, int n_in, void* d_out, int out_size, void* d_ws, size_t ws_size, hipStream_t stream) {
    static int grid = 0;
    if (grid == 0) {
        if (n_in != 27 || in_sizes[0] != T * D || out_size != T * D || ws_size < WS_END) { fprintf(stderr, "kernel_launch: unexpected shapes (n_in %d, in0 %d, out %d, ws %zu)\n", n_in, n_in > 0 ? in_sizes[0] : -1, out_size, ws_size); grid = -1; return; }
        int dev = 0, cus = 0;
        if (hipGetDevice(&dev) != hipSuccess || hipDeviceGetAttribute(&cus, hipDeviceAttributeMultiprocessorCount, dev) != hipSuccess) { grid = -1; return; }
#if N_LAUNCHES == 1
        if (hipFuncSetAttribute((const void*)mega, hipFuncAttributeMaxDynamicSharedMemorySize, LDS_BYTES) != hipSuccess) { fprintf(stderr, "kernel_launch: hipFuncSetAttribute failed\n"); grid = -1; return; }
#else
#define SETATTR(k) if (hipFuncSetAttribute((const void*)phase_kernel<k>, hipFuncAttributeMaxDynamicSharedMemorySize, LDS_BYTES) != hipSuccess) { fprintf(stderr, "kernel_launch: hipFuncSetAttribute failed\n"); grid = -1; return; }
        SETATTR(0) SETATTR(1) SETATTR(2) SETATTR(3) SETATTR(4) SETATTR(5) SETATTR(6) SETATTR(7) SETATTR(8) SETATTR(9) SETATTR(10)
#endif
        grid = cus;
    }
    if (grid < 0) return;
    (void)hipMemsetAsync((char*)d_ws + WS_CTL, 0, CTL_ZERO_BYTES, stream);
    Args a{};
    for (int i = 0; i < 27; ++i) a.in[i] = (const float*)d_in[i];
    a.out = (float*)d_out; a.ws = (unsigned char*)d_ws;
#if N_LAUNCHES == 1
    a.ph_lo = 0; a.ph_hi = NPHASE; a.use_bar = 1;
    hipLaunchKernelGGL(mega, dim3(grid), dim3(NTHR), LDS_BYTES, stream, a);
#else
#define LAUNCH_PH(k) hipLaunchKernelGGL(phase_kernel<k>, dim3(grid), dim3(NTHR), LDS_BYTES, stream, a)
#ifndef LAST_PHASE
#define LAST_PHASE 10
#endif
    LAUNCH_PH(0); LAUNCH_PH(1); LAUNCH_PH(2); LAUNCH_PH(3); LAUNCH_PH(4); LAUNCH_PH(5);
    if (LAST_PHASE >= 6) { LAUNCH_PH(6); } if (LAST_PHASE >= 7) { LAUNCH_PH(7); } if (LAST_PHASE >= 8) { LAUNCH_PH(8); } if (LAST_PHASE >= 9) { LAUNCH_PH(9); } if (LAST_PHASE >= 10) { LAUNCH_PH(10); }
#endif
    const hipError_t le = hipPeekAtLastError();
    if (le != hipSuccess) fprintf(stderr, "kernel_launch: launch failed: %s\n", hipGetErrorName(le));
}
```

```cpp
#define N_LAUNCHES 1
#define NAIVE_MOE 0
#define GEMM_PHASE(EPI, SCHED, g, S, E) gemm_fast<EPI, SCHED, false>(F.lds, g, S, E)
#define GEMM_PHASE_GATHER(EPI, SCHED, g, S, E) gemm_fast<EPI, SCHED, true>(F.lds, g, S, E)
#define HGRN_PHASE(F) hgrn_fast2(F)
#define ATTN_PHASE(F) attn_fast(F)
#define ROUTE_PHASE(F) route_fast<false>(F)
#define SKEW_K1024 0
#define SKEW_K512 0
#define SKEW_K256 0
#define I8_P10 1
#define I8_P1 1
#define I8_P7 1
#define FUSE_PROJ 1
#define STAGGER_CONV 1
#define MERGE_QKV 1
#define GATE_U8 1
#define GATE_FIRST 1
#include <hip/hip_runtime.h>
#include <cstdio>
#include <cstdint>

#define GAS __attribute__((address_space(1)))
#define LAS __attribute__((address_space(3)))
typedef unsigned short bf16;
typedef unsigned v4u __attribute__((ext_vector_type(4)));
typedef unsigned v2u __attribute__((ext_vector_type(2)));
typedef float f32x4 __attribute__((ext_vector_type(4)));
typedef float f32x2 __attribute__((ext_vector_type(2)));
typedef short bf16x8 __attribute__((ext_vector_type(8)));
typedef GAS unsigned gu32;
#define RLX_AGENT __ATOMIC_RELAXED, __HIP_MEMORY_SCOPE_AGENT
#define LDS_WAIT() asm volatile("s_waitcnt lgkmcnt(0)" ::: "memory")
#define VM_WAIT() asm volatile("s_waitcnt vmcnt(0)" ::: "memory")

constexpr int NB = 16, SEQ = 2048, T = NB * SEQ, D = 1024;
constexpr int HGH = 4, HGK = 128, HGV = 128, HGF = 512, CHUNK = 64, NCHUNK = T / CHUNK;
constexpr int MH = 8, NOPE = 64, ROPE = 32, QK = 96, VD = 64, QR = 256, KVR = 128;
constexpr int NG = 8, EPG = 8, NE = 64, DE = 256, PLE = 256;
constexpr int DIN = 5024, NIN = 5120;
constexpr float EPS = 1e-6f;
constexpr int NWAVES = 8, NTHR = 512;

__device__ __forceinline__ unsigned f2bf(float f) { unsigned u = __builtin_bit_cast(unsigned, f); return (u + 0x7fffu + ((u >> 16) & 1u)) >> 16; }
typedef __bf16 bf16pair_t __attribute__((ext_vector_type(2)));
__device__ __forceinline__ unsigned pk2(float lo, float hi) { const f32x2 v = {lo, hi}; return __builtin_bit_cast(unsigned, __builtin_convertvector(v, bf16pair_t)); }
__device__ __forceinline__ float bf2f(unsigned b) { return __builtin_bit_cast(float, b << 16); }
__device__ __forceinline__ float bflo(unsigned w) { return __builtin_bit_cast(float, w << 16); }
__device__ __forceinline__ float bfhi(unsigned w) { return __builtin_bit_cast(float, w & 0xffff0000u); }
__device__ __forceinline__ float sigm(float x) { return __builtin_amdgcn_rcpf(1.0f + __expf(-x)); }
__device__ __forceinline__ float silu_(float x) { return x * __builtin_amdgcn_rcpf(1.0f + __expf(-x)); }
__device__ __forceinline__ float wave_sum(float v) {
#pragma unroll
    for (int o = 1; o < 64; o <<= 1) v += __shfl_xor(v, o);
    return v;
}
__device__ __forceinline__ float wave_max(float v) {
#pragma unroll
    for (int o = 1; o < 64; o <<= 1) v = fmaxf(v, __shfl_xor(v, o));
    return v;
}
__host__ __device__ __forceinline__ int perm8(int p) { const int r = p & 31, n = r >> 4, fq = (r >> 2) & 3, j = r & 3; return (p & ~31) + 8 * fq + 4 * n + j; }
__host__ __device__ __forceinline__ int iperm8(int l) { const int r = l & 31, fq = r >> 3, n = (r >> 2) & 1, j = r & 3; return (l & ~31) + 16 * n + 4 * fq + j; }

#ifndef STAGGER_CONV
#define STAGGER_CONV 0
#endif
#ifndef STAGGER_OA
#define STAGGER_OA 0
#endif
constexpr size_t MiB = 1u << 20;
constexpr size_t WS_CTL = 0, CTL_ZERO_BYTES = 65536;
constexpr size_t WS_LB = 1 * MiB;
constexpr size_t WS_WRH = 1 * MiB + 65536, WS_WRL = WS_WRH + 80 * 1024 * 2;
constexpr size_t WS_BR = WS_WRL + 80 * 1024 * 2;
constexpr size_t WS_SAQ = 1 * MiB + 512 * 1024, WS_SAKV = WS_SAQ + 128 * 1024, WS_SBUQ = 1 * MiB + 768 * 1024, WS_SBUKV = WS_SBUQ + 4096;
constexpr size_t WS_RS2 = 2 * MiB;
constexpr size_t WS_CQSS = 2 * MiB;
constexpr size_t WS_CKVSS = 2 * MiB + 512 * 1024;
constexpr size_t WS_SA3 = 3 * MiB, WS_SA1 = 3 * MiB + 128 * 1024;
constexpr size_t WS_SBPG = 3 * MiB + 256 * 1024, WS_SBIN = WS_SBPG + 4096, WS_SB13 = 3 * MiB + 512 * 1024;
constexpr size_t WS_SAP = 3 * MiB + 640 * 1024, WS_SBPP = 3 * MiB + 768 * 1024;
constexpr size_t WS_ROPE = 4 * MiB;
constexpr size_t WS_EREF = 8 * MiB, WS_ELAST = 10 * MiB;
constexpr size_t WS_EIDX = 12 * MiB;
constexpr size_t WS_EW = 12 * MiB + 512 * 1024;
constexpr size_t WS_KR = 13 * MiB;
constexpr size_t WS_XMAX = 13 * MiB;
constexpr size_t WS_LIST = 4 * MiB;
constexpr size_t WS_WIN = 17 * MiB, WS_WOAB = 27 * MiB, WS_WUQ = 29 * MiB, WS_WUKV = 29 * MiB + 512 * 1024, WS_WOUT = 30 * MiB, WS_WPG = 32 * MiB, WS_WPP = 34 * MiB;
constexpr size_t WS_ACT = 36 * MiB;
constexpr size_t WS_VA = 100 * MiB, WS_OG = 132 * MiB, WS_CQ = 164 * MiB, WS_CKVR = 180 * MiB, WS_GA = 196 * MiB, WS_GB = 260 * MiB;
constexpr size_t WS_QM = 324 * MiB, WS_KH = 372 * MiB, WS_VH = 420 * MiB, WS_PB = 452 * MiB, WS_END = 468 * MiB;
#if STAGGER_CONV
constexpr size_t WS_W13 = 100 * MiB, WS_W2T = 164 * MiB;
#else
constexpr size_t WS_W13 = 196 * MiB, WS_W2T = 260 * MiB;
#endif
constexpr size_t WS_H1 = 324 * MiB;
constexpr size_t WS_Y0 = 100 * MiB, WS_Y1 = 372 * MiB;
constexpr size_t WS_PROJ = 292 * MiB;
constexpr size_t DO_QF = 0, DO_KF = 32 * MiB, DO_QB = 64 * MiB, DO_KB = 96 * MiB, DO_OA = 0, DO_OM = 32 * MiB;
constexpr size_t DO_X2B = 64 * MiB;
constexpr size_t WS_X3B = 196 * MiB;
constexpr int CW_TMO = 0, CW_CODE = 1, CW_BAR = 4096, CW_CNT = 8192  ;
constexpr int MAXROWT = 320;
constexpr int RING_BYTES = 131072, LDSCTL_OFF = RING_BYTES, MISC_OFF = LDSCTL_OFF + 320, TAB_OFF = RING_BYTES + 1024, LDS_BYTES = 147456;
#define XB_TMO      128
#define XB_XCNT(j)  (256  + 64 * (j))
#define XB_XSUB(j)  (1280 + 64 * (j))
#define XB_XGEN(j)  (2304 + 64 * (j))
#define XB_TOP      3328
#define XB_TOPGEN   3392
#define XCD_BAR_WORDS 3456
#define XB_SPIN_CAP (1u << 18)

__device__ __forceinline__ unsigned xb_ld(unsigned* p)              { return __hip_atomic_load(p, __ATOMIC_RELAXED, __HIP_MEMORY_SCOPE_AGENT); }
__device__ __forceinline__ unsigned xb_add(unsigned* p, unsigned v) { return __hip_atomic_fetch_add(p, v, __ATOMIC_RELAXED, __HIP_MEMORY_SCOPE_AGENT); }
__device__ __forceinline__ unsigned xb_xcc_id() { return (unsigned)__builtin_amdgcn_s_getreg((3 << 11) | 20) & 0xFu; }
#define XB_SPIN(cond, bar) do { unsigned _sp = 0; while (cond) { __builtin_amdgcn_s_sleep(1); \
    if ((++_sp & 255u) == 0u) { if (xb_ld(&(bar)[XB_TMO])) break; if (_sp > XB_SPIN_CAP) { atomicAdd(&(bar)[XB_TMO], 1u); break; } } } } while (0)

struct XcdBarrier {
    unsigned* bar; unsigned x;
    volatile LAS unsigned* st;
};

__device__ __forceinline__ XcdBarrier xcd_barrier_post(unsigned* bar, volatile LAS unsigned* st) {
    XcdBarrier b; b.bar = bar; b.x = xb_xcc_id(); b.st = st;
    if (threadIdx.x == 0) (void)xb_add(&bar[XB_XCNT(b.x)], 1u);
    return b;
}
__device__ __forceinline__ void xcd_barrier_complete(unsigned* bar, unsigned x, unsigned& nloc, unsigned& nx) {
    const unsigned G = gridDim.x * gridDim.y * gridDim.z;
    unsigned sum, cnt, mine, sp = 0u;
    for (;;) {
        sum = 0u; cnt = 0u; mine = 0u;
#pragma unroll
        for (unsigned j = 0; j < 16; ++j) { const unsigned c = xb_ld(&bar[XB_XCNT(j)]); sum += c; cnt += (c > 0u) ? 1u : 0u; mine = (j == x) ? c : mine; }
        if (sum == G) break;
        __builtin_amdgcn_s_sleep(1);
        if ((++sp & 255u) == 0u) { if (xb_ld(&bar[XB_TMO])) break; if (sp > XB_SPIN_CAP) { atomicAdd(&bar[XB_TMO], 1u); break; } }
    }
    nloc = mine > 0u ? mine : 1u; nx = cnt > 0u ? cnt : 1u;
}

__device__ __forceinline__ void xcd_barrier(const XcdBarrier& b) {
    asm volatile("s_waitcnt vmcnt(0)" ::: "memory");
    __syncthreads();
    if (threadIdx.x == 0) {
        unsigned* bar = b.bar;
        __builtin_amdgcn_s_waitcnt(0);
        unsigned nloc = b.st[0], nx = b.st[1];
        if (nloc == 0u) { xcd_barrier_complete(bar, b.x, nloc, nx); b.st[0] = nloc; b.st[1] = nx; }
        const unsigned old = xb_add(&bar[XB_XSUB(b.x)], 1u);
        const unsigned gen = old / nloc;
        if (old + 1u == (gen + 1u) * nloc) {
            __builtin_amdgcn_fence(__ATOMIC_RELEASE, "agent");
            asm volatile("s_waitcnt vmcnt(0)" ::: "memory");
            const unsigned og = xb_add(&bar[XB_TOP], 1u);
            const unsigned tg = og / nx;
            if (og + 1u == (tg + 1u) * nx) xb_add(&bar[XB_TOPGEN], 1u);
            else XB_SPIN(xb_ld(&bar[XB_TOPGEN]) == tg, bar);
            __builtin_amdgcn_fence(__ATOMIC_ACQUIRE, "agent");
            xb_add(&bar[XB_XGEN(b.x)], 1u);
            asm volatile("s_waitcnt vmcnt(0)" ::: "memory");
        } else {
            XB_SPIN(xb_ld(&bar[XB_XGEN(b.x)]) == gen, bar);
            __builtin_amdgcn_fence(__ATOMIC_ACQUIRE, "agent");
            asm volatile("s_waitcnt vmcnt(0)" ::: "memory");
        }
    }
    __syncthreads();
}
struct Unit { int pm, pn, lbase, nvalid, kind; };
struct Gemm { const bf16* A; const bf16* Bt; int K; const int* list; int skew; const bf16* A2; const bf16* Bt2; int K2; };
typedef __bf16 bf16x2_t __attribute__((ext_vector_type(2)));
__device__ __forceinline__ float dot2bf(unsigned a, unsigned b, float c) { return __builtin_amdgcn_fdot2_f32_bf16(__builtin_bit_cast(bf16x2_t, a), __builtin_bit_cast(bf16x2_t, b), c, false); }

#ifndef I8_P10
#define I8_P10 0
#endif
#ifndef I8_P1
#define I8_P1 0
#endif
#ifndef I8_P7
#define I8_P7 0
#endif
#ifndef I8_QKV
#define I8_QKV 0
#endif
#ifndef MERGE_QKV
#define MERGE_QKV 0
#endif
#ifndef GATE_U8
#define GATE_U8 0
#endif
#ifndef GATE_FIRST
#define GATE_FIRST 0
#endif
#ifndef FUSE_PROJ
#define FUSE_PROJ 0
#endif
typedef int i32x4 __attribute__((ext_vector_type(4)));
template <bool I8> struct AccSel { typedef f32x4 type; };
template <> struct AccSel<true> { typedef i32x4 type; };
constexpr int NXCD = 8, WGM = 8;
struct StaticOrder {
    int nM, nN, nwg, G, c;
    __device__ void init(int M, int N, int G_, int c_) { nM = M / 256; nN = N / 256; nwg = nM * nN; G = G_; c = c_; }
    __device__ __forceinline__ bool next(int i, Unit& u) const {
        const long L = (long)i * G + c; if (L >= nwg) return false;
        int wgid = (int)L; { const int q = nwg / NXCD, r = nwg % NXCD, xcd = wgid % NXCD, off = wgid / NXCD; wgid = (xcd < r ? xcd * (q + 1) : r * (q + 1) + (xcd - r) * q) + off; }
        const int nig = WGM * nN, gid = wgid / nig, fm = gid * WGM, gsz = (nM - fm) < WGM ? (nM - fm) : WGM;
        u.pm = fm + ((wgid % nig) % gsz); u.pn = (wgid % nig) / gsz; u.lbase = 0; u.nvalid = 256; u.kind = 0; return true;
    }
};
struct PairOrder {
    StaticOrder so;
    __device__ void init(int G_, int c_) { so.init(T, D, G_, c_); }
    __device__ __forceinline__ bool next(int i, Unit& u) const { if (!so.next(i >> 1, u)) return false; if (i & 1) { u.pm += T / 256; u.pn += D / 256; } return true; }
};
struct ProjGateOrder {
    StaticOrder so;
    __device__ void init(int G_, int c_) { so.init(T, D, G_, c_); }
    __device__ __forceinline__ bool next(int i, Unit& u) const { if (!so.next(i >> 1, u)) return false; u.kind = i & 1; return true; }
};
struct QKVOrder {
    int G, c;
    __device__ void init(int G_, int c_) { G = G_; c = c_; }
    __device__ __forceinline__ bool next(int i, Unit& u) const {
        constexpr int NQ = (T / 256) * 3, NKV = (T / 256) * 4;
        const int L = i * G + c; if (L >= NQ + NKV) return false;
        StaticOrder so;
        if (L < NQ) { so.init(T, 768, 1, 0); so.next(L, u); u.kind = 0; } else { so.init(T, 1024, 1, 0); so.next(L - NQ, u); u.kind = 1; }
        return true;
    }
};
struct MoeOrder {
    const LAS int* tab; int npn, G, c;
    __device__ __forceinline__ bool next(int i, Unit& u) const {
        const int L = i * G + c; const int nt = tab[0]; if (L >= nt * npn) return false;
        const int rt = L / npn, pl = L - rt * npn; const int e = tab[16 + 4 * rt];
        u.pm = rt; u.pn = e * npn + pl; u.lbase = tab[16 + 4 * rt + 1]; u.nvalid = tab[16 + 4 * rt + 2]; u.kind = 0; return true;
    }
};

constexpr int BM = 256, BK = 64, HALF = 128, HTB = HALF * BK * 2, STAGE_BYTES = 8 * HTB;
__host__ __device__ __forceinline__ int lds_byte(int r, int c) { const int st = (r >> 4) * 2 + (c >> 5), rr = r & 15, cc = c & 31, ob = rr * 64 + cc * 2; return st * 1024 + (ob ^ (((ob >> 9) & 1) << 5)); }
__host__ __device__ __forceinline__ void stage_rc(int b, int& R, int& C) { const int st = b / 1024, sb = b % 1024, swz = sb ^ (((sb >> 9) & 1) << 5); R = (st >> 1) * 16 + swz / 64; C = (st & 1) * 32 + (swz % 64) / 2; }
#ifndef GF_SP2
#define GF_SP2 true
#endif
#ifndef GF_ALIGN
#define GF_ALIGN true
#endif
template <class Epi, class Sched, bool GATHER = false, bool ALIGN_EPI = GF_ALIGN, bool SP2 = GF_SP2, bool I8 = false, bool DUAL = false>
__device__ __forceinline__ void gemm_fast(LAS unsigned char* lds, const Gemm g, const Sched& S, const Epi& E) {
    int tid_ = threadIdx.x; asm volatile("" : "+v"(tid_));
    const int tid = tid_, wid = __builtin_amdgcn_readfirstlane(tid >> 6), lane = tid & 63, wr = wid >> 2, wc = wid & 3, fr = lane & 15, fq = lane >> 4;
    static_assert(!(DUAL && (GATHER || !SP2)), "DUAL: plain A rows, SP2 schedule only");
    const int K = g.K;
#define PG8_UK(u) ((DUAL && (u).kind) ? g.K2 : g.K)
    unsigned v0[2], v1[2], nv0[2], nv1[2], voffB[2]; int sR[2], sC[2];
#pragma unroll
    for (int i = 0; i < 2; ++i) { stage_rc(tid * 16 + i * 8192, sR[i], sC[i]); voffB[i] = (unsigned)(sR[i] * K + sC[i]) * 2u; }
#define PG8_AOFF(u, o0, o1) do { _Pragma("unroll") for (int _i = 0; _i < 2; ++_i) { \
        if constexpr (GATHER) { const int r0_ = sR[_i] < (u).nvalid ? sR[_i] : (u).nvalid - 1, r1_ = (128 + sR[_i]) < (u).nvalid ? 128 + sR[_i] : (u).nvalid - 1; \
            o0[_i] = ((unsigned)(g.list[(u).lbase + r0_] >> 1) * (unsigned)K + (unsigned)sC[_i]) * 2u; o1[_i] = ((unsigned)(g.list[(u).lbase + r1_] >> 1) * (unsigned)K + (unsigned)sC[_i]) * 2u; } \
        else { const int K_ = PG8_UK(u); o0[_i] = (unsigned)(sR[_i] * K_ + sC[_i]) * 2u; o1[_i] = o0[_i] + (unsigned)(HALF * K_ * 2); } } } while (0)
    const size_t kstep = (size_t)(BK * 2);
    size_t hstep = (size_t)HALF * K * 2;
    const size_t tstep = 2 * hstep;
    size_t nhstep = hstep; int nt = K / BK, nnt = nt;
    const unsigned ldsw = (unsigned)wid * 1024u;
    const int aoff = lds_byte(wr * 64 + fr, fq * 8), boff = lds_byte(wc * 32 + fr, fq * 8);
#define PG8_SA(b, h) (((b) * 2 + (h)) * HTB)
#define PG8_SB(b, h) ((4 + (b) * 2 + (h)) * HTB)
#define PG8_STAGE(bufoff, gbase, voff) do { _Pragma("unroll") for (int _i = 0; _i < 2; ++_i) \
        __builtin_amdgcn_global_load_lds((const unsigned*)((const char*)(gbase) + (voff)[_i]), (LAS unsigned*)(lds + (bufoff) + ldsw + _i * 8192), 16, 0, 0); } while (0)
#define PG8_LDA(dst, b, h) do { _Pragma("unroll") for (int m = 0; m < 4; ++m) _Pragma("unroll") for (int k = 0; k < 2; ++k) dst[m][k] = *(const LAS bf16x8*)(lds + PG8_SA(b, h) + aoff + m * 2048 + k * 1024); } while (0)
#define PG8_LDB(dst, b, h) do { _Pragma("unroll") for (int n = 0; n < 2; ++n) _Pragma("unroll") for (int k = 0; k < 2; ++k) dst[n][k] = *(const LAS bf16x8*)(lds + PG8_SB(b, h) + boff + n * 2048 + k * 1024); } while (0)
#define PG8_MMA(ai, bj, At, Bt) do { __builtin_amdgcn_s_setprio(1); _Pragma("unroll") for (int m = 0; m < 4; ++m) _Pragma("unroll") for (int n = 0; n < 2; ++n) _Pragma("unroll") for (int k = 0; k < 2; ++k) \
        { if constexpr (I8) acc[ai][bj][m][n] = __builtin_amdgcn_mfma_i32_16x16x64_i8(__builtin_bit_cast(i32x4, Bt[n][k]), __builtin_bit_cast(i32x4, At[m][k]), acc[ai][bj][m][n], 0, 0, 0); \
          else acc[ai][bj][m][n] = __builtin_amdgcn_mfma_f32_16x16x32_bf16(Bt[n][k], At[m][k], acc[ai][bj][m][n], 0, 0, 0); } __builtin_amdgcn_s_setprio(0); } while (0)
#define PG8_WAIT_V(n) asm volatile("s_waitcnt vmcnt(" #n ")" ::: "memory")
#define PG8_WAIT_L(n) asm volatile("s_waitcnt lgkmcnt(" #n ")" ::: "memory")
#define PG8_BAR __builtin_amdgcn_s_barrier()
#define PG8_SCHED __builtin_amdgcn_sched_barrier(0)
    Unit cur, nxt; int ui = 0;
    if (!S.next(0, cur)) return;
    if (g.skew > 0) {
        const unsigned bx = blockIdx.x, idx = ((bx >> 3) & 31u) * 8u + (bx & 7u);
        const unsigned long long t0 = __builtin_amdgcn_s_memrealtime(); const unsigned long long d = ((unsigned long long)idx * (unsigned)g.skew) >> 8;
        while (__builtin_amdgcn_s_memrealtime() - t0 < d) __builtin_amdgcn_s_sleep(8);
    }
    typedef typename AccSel<I8>::type acc_t;
    acc_t acc[2][2][4][2];
#pragma unroll
    for (int a = 0; a < 2; ++a)
#pragma unroll
        for (int b = 0; b < 2; ++b)
#pragma unroll
            for (int m = 0; m < 4; ++m)
#pragma unroll
                for (int n = 0; n < 2; ++n) acc[a][b][m][n] = (acc_t){0, 0, 0, 0};
    bf16x8 At[4][2], B0[2][2], B1[2][2];
#define PG8_ABASE(u) (DUAL ? (const char*)g.A + ((u).kind ? (size_t)((const char*)g.A2 - (const char*)g.A) : (size_t)0) + (size_t)(u).pm * (size_t)(2 * HALF * 2) * PG8_UK(u) : (const char*)g.A + (GATHER ? (size_t)0 : (size_t)(u).pm * tstep))
#define PG8_BBASE(u) (DUAL ? (const char*)g.Bt + ((u).kind ? (size_t)((const char*)g.Bt2 - (const char*)g.Bt) : (size_t)0) + (size_t)(u).pn * (size_t)(2 * HALF * 2) * PG8_UK(u) : (const char*)g.Bt + (size_t)(u).pn * tstep)
    const char* cA = PG8_ABASE(cur); const char* cB = PG8_BBASE(cur);
    unsigned v0s = 0u, nv0s = 0u;
#define PG8_BASEOFF(u, o) do { int R_, C_; stage_rc(tid * 16, R_, C_); o = (unsigned)(R_ * PG8_UK(u) + C_) * 2u; } while (0)
    if constexpr (DUAL) { const int K_ = PG8_UK(cur); hstep = (size_t)HALF * K_ * 2; nt = K_ / BK; PG8_BASEOFF(cur, v0s);
    }
    else { PG8_AOFF(cur, v0, v1); }
    if constexpr (SP2 && DUAL) {
#define PG8_STAGE1(bufoff, gbase, o0_) do { unsigned t_[2] = {(o0_), (o0_) + (unsigned)(hstep >> 1)}; PG8_STAGE(bufoff, gbase, t_); } while (0)
        PG8_STAGE1(PG8_SB(0, 0), cB, v0s); PG8_STAGE1(PG8_SB(0, 1), cB + hstep, v0s); PG8_STAGE1(PG8_SA(0, 0), cA, v0s); PG8_STAGE1(PG8_SA(0, 1), cA + hstep, v0s);
        if (wr == 1) PG8_BAR;
        PG8_WAIT_V(2); PG8_BAR;
        PG8_STAGE1(PG8_SB(1, 0), cB + kstep, v0s); PG8_STAGE1(PG8_SA(1, 0), cA + kstep, v0s); PG8_STAGE1(PG8_SB(1, 1), cB + hstep + kstep, v0s);
        PG8_WAIT_V(6); PG8_BAR;
#undef PG8_STAGE1
    } else if constexpr (SP2) {
        PG8_STAGE(PG8_SB(0, 0), cB, voffB); PG8_STAGE(PG8_SB(0, 1), cB + hstep, voffB); PG8_STAGE(PG8_SA(0, 0), cA, v0); PG8_STAGE(PG8_SA(0, 1), cA, v1);
        if (wr == 1) PG8_BAR;
        PG8_WAIT_V(2); PG8_BAR;
        PG8_STAGE(PG8_SB(1, 0), cB + kstep, voffB); PG8_STAGE(PG8_SA(1, 0), cA + kstep, v0); PG8_STAGE(PG8_SB(1, 1), cB + hstep + kstep, voffB);
        PG8_WAIT_V(6); PG8_BAR;
    } else {
        PG8_STAGE(PG8_SB(0, 0), cB, voffB); PG8_STAGE(PG8_SA(0, 0), cA, v0); PG8_STAGE(PG8_SB(0, 1), cB + hstep, voffB); PG8_STAGE(PG8_SA(0, 1), cA, v1);
        if (wr == 1) PG8_BAR;
        PG8_WAIT_V(4); PG8_BAR;
        PG8_STAGE(PG8_SB(1, 0), cB + kstep, voffB); PG8_STAGE(PG8_SA(1, 0), cA + kstep, v0); PG8_STAGE(PG8_SB(1, 1), cB + hstep + kstep, voffB);
        PG8_WAIT_V(6); PG8_BAR;
    }
    for (;;) {
        const bool has_next = S.next(ui + 1, nxt);
        const char* nA = (has_next && !GATHER) ? PG8_ABASE(nxt) : cA; const char* nB = has_next ? PG8_BBASE(nxt) : cB;
        if constexpr (DUAL) { if (has_next) { const int K_ = PG8_UK(nxt); nhstep = (size_t)HALF * K_ * 2; nnt = K_ / BK; } else { nhstep = hstep; nnt = nt; } }
        if constexpr (DUAL) { if (has_next) { PG8_BASEOFF(nxt, nv0s); } else nv0s = v0s; }
        else { if (has_next) { PG8_AOFF(nxt, nv0, nv1); } else { _Pragma("unroll") for (int _i = 0; _i < 2; ++_i) { nv0[_i] = v0[_i]; nv1[_i] = v1[_i]; } } }
#pragma unroll 1
        for (int t = 0; t < nt; t += 2) {
            const bool last = (t == nt - 2);
            const char* a1 = cA + (size_t)(t + 1) * kstep;
            const char* a2 = last ? nA : cA + (size_t)(t + 2) * kstep; const char* b2 = last ? nB : cB + (size_t)(t + 2) * kstep;
            const char* a3 = a2 + kstep; const char* b3 = b2 + kstep;
            unsigned w0[2], w1[2];
#pragma unroll
            for (int _i = 0; _i < 2; ++_i) { if constexpr (DUAL) w0[_i] = (last ? nv0s : v0s) + (_i ? (unsigned)((last ? nhstep : hstep) >> 1) : 0u); else { w0[_i] = last ? nv0[_i] : v0[_i]; w1[_i] = last ? nv1[_i] : v1[_i]; } }
            unsigned wB[2], x1[2]; size_t hB = hstep;
            if constexpr (DUAL) { if (last) hB = nhstep; }
#pragma unroll
            for (int _i = 0; _i < 2; ++_i) { if constexpr (DUAL) { wB[_i] = w0[_i]; w1[_i] = w0[_i] + (unsigned)hB; x1[_i] = v0s + (unsigned)hstep + (_i ? (unsigned)(hstep >> 1) : 0u); } else { wB[_i] = voffB[_i]; x1[_i] = v1[_i]; } }
            if constexpr (SP2) {
            PG8_LDB(B0, 0, 0); PG8_LDB(B1, 0, 1); PG8_SCHED; PG8_LDA(At, 0, 0); PG8_STAGE(PG8_SA(1, 1), a1, x1);
            PG8_WAIT_V(8); PG8_WAIT_L(0); PG8_BAR; PG8_MMA(0, 0, At, B0); PG8_MMA(0, 1, At, B1); PG8_BAR; PG8_SCHED;
            PG8_LDA(At, 0, 1); PG8_STAGE(PG8_SB(0, 0), b2, wB); PG8_STAGE(PG8_SB(0, 1), b2 + hB, wB); PG8_STAGE(PG8_SA(0, 0), a2, w0);
            PG8_WAIT_V(8); PG8_WAIT_L(0); PG8_BAR; PG8_MMA(1, 0, At, B0); PG8_MMA(1, 1, At, B1); PG8_BAR; PG8_SCHED;
            PG8_LDB(B0, 1, 0); PG8_LDB(B1, 1, 1); PG8_SCHED; PG8_LDA(At, 1, 0); PG8_STAGE(PG8_SA(0, 1), a2, w1);
            PG8_WAIT_V(8); PG8_WAIT_L(0); PG8_BAR; PG8_MMA(0, 0, At, B0); PG8_MMA(0, 1, At, B1); PG8_BAR; PG8_SCHED;
            PG8_LDA(At, 1, 1); PG8_STAGE(PG8_SB(1, 0), b3, wB); PG8_STAGE(PG8_SB(1, 1), b3 + hB, wB); PG8_STAGE(PG8_SA(1, 0), a3, w0);
            PG8_WAIT_V(8); PG8_WAIT_L(0); PG8_BAR; PG8_MMA(1, 0, At, B0); PG8_MMA(1, 1, At, B1); PG8_BAR; PG8_SCHED;
            } else {
            PG8_LDB(B0, 0, 0); PG8_SCHED; PG8_LDA(At, 0, 0); PG8_STAGE(PG8_SA(1, 1), a1, v1);
            PG8_WAIT_L(8); PG8_BAR; PG8_WAIT_L(0); PG8_MMA(0, 0, At, B0); PG8_BAR; PG8_SCHED;
            PG8_LDB(B1, 0, 1); PG8_STAGE(PG8_SB(0, 0), b2, voffB);
            PG8_BAR; PG8_WAIT_L(0); PG8_MMA(0, 1, At, B1); PG8_BAR;
            PG8_LDA(At, 0, 1); PG8_STAGE(PG8_SA(0, 0), a2, w0);
            PG8_BAR; PG8_WAIT_L(0); PG8_MMA(1, 0, At, B0); PG8_BAR; PG8_SCHED;
            PG8_STAGE(PG8_SB(0, 1), b2 + hstep, voffB);
            PG8_WAIT_V(6); PG8_BAR; PG8_MMA(1, 1, At, B1); PG8_BAR;
            PG8_LDB(B0, 1, 0); PG8_SCHED; PG8_LDA(At, 1, 0); PG8_STAGE(PG8_SA(0, 1), a2, w1);
            PG8_WAIT_L(8); PG8_BAR; PG8_WAIT_L(0); PG8_MMA(0, 0, At, B0); PG8_BAR; PG8_SCHED;
            PG8_LDB(B1, 1, 1); PG8_STAGE(PG8_SB(1, 0), b3, voffB);
            PG8_BAR; PG8_WAIT_L(0); PG8_MMA(0, 1, At, B1); PG8_BAR;
            PG8_LDA(At, 1, 1); PG8_STAGE(PG8_SA(1, 0), a3, w0);
            PG8_BAR; PG8_WAIT_L(0); PG8_MMA(1, 0, At, B0); PG8_BAR; PG8_SCHED;
            PG8_STAGE(PG8_SB(1, 1), b3 + hstep, voffB);
            PG8_WAIT_V(6); PG8_BAR; PG8_MMA(1, 1, At, B1); PG8_BAR;
            }
        }
        if constexpr (ALIGN_EPI) { if (wr == 0) PG8_BAR; }
        E(acc, cur, wr, wc, fr, fq);
        if (!has_next) break;
#pragma unroll
        for (int a = 0; a < 2; ++a)
#pragma unroll
            for (int b = 0; b < 2; ++b)
#pragma unroll
                for (int m = 0; m < 4; ++m)
#pragma unroll
                    for (int n = 0; n < 2; ++n) acc[a][b][m][n] = (acc_t){0, 0, 0, 0};
        cur = nxt; cA = nA; cB = nB; ++ui;
#pragma unroll
        for (int _i = 0; _i < 2; ++_i) { if constexpr (!DUAL) { v0[_i] = nv0[_i]; v1[_i] = nv1[_i]; } }
        if constexpr (DUAL) { hstep = nhstep; nt = nnt; v0s = nv0s; }
        if constexpr (ALIGN_EPI) { if (wr == 1) PG8_BAR; }
    }
    PG8_WAIT_V(0);
    if constexpr (!ALIGN_EPI) { if (wr == 0) PG8_BAR; }
    PG8_BAR;
#undef PG8_AOFF
#undef PG8_BASEOFF
#undef PG8_UK
#undef PG8_ABASE
#undef PG8_BBASE
#undef PG8_SA
#undef PG8_SB
#undef PG8_STAGE
#undef PG8_LDA
#undef PG8_LDB
#undef PG8_MMA
#undef PG8_WAIT_V
#undef PG8_WAIT_L
#undef PG8_BAR
#undef PG8_SCHED
}
#ifdef NT_STORES
#define ST_V(ptr, val) __builtin_nontemporal_store((val), (ptr))
#else
#define ST_V(ptr, val) (*(ptr) = (val))
#endif
__device__ __forceinline__ void st8(bf16* p, f32x4 a, f32x4 b) { v4u w; w.x = pk2(a[0], a[1]); w.y = pk2(a[2], a[3]); w.z = pk2(b[0], b[1]); w.w = pk2(b[2], b[3]); ST_V((v4u*)p, w); }
__device__ __forceinline__ void st4(bf16* p, f32x4 a) { v2u w; w.x = pk2(a[0], a[1]); w.y = pk2(a[2], a[3]); ST_V((v2u*)p, w); }
__device__ __forceinline__ unsigned q8pack(float a, float b, float c, float d) {
    const int ia = (int)__builtin_rintf(a), ib = (int)__builtin_rintf(b), ic = (int)__builtin_rintf(c), id = (int)__builtin_rintf(d);
    return (unsigned)(ia & 255) | ((unsigned)(ib & 255) << 8) | ((unsigned)(ic & 255) << 16) | ((unsigned)id << 24);
}
__device__ __forceinline__ f32x4 ub4(unsigned w) { return (f32x4){(float)(w & 255u), (float)((w >> 8) & 255u), (float)((w >> 16) & 255u), (float)(w >> 24)} * (1.0f / 255.0f); }
__device__ __forceinline__ f32x4 up4(unsigned lo, unsigned hi) { return (f32x4){bflo(lo), bfhi(lo), bflo(hi), bfhi(hi)}; }
__device__ __forceinline__ float dot4(f32x4 a) { return (a[0] * a[0] + a[1] * a[1]) + (a[2] * a[2] + a[3] * a[3]); }
template <int CTRL> __device__ __forceinline__ float dppf(float v) { return __builtin_bit_cast(float, __builtin_amdgcn_update_dpp(0, __builtin_bit_cast(int, v), CTRL, 0xf, 0xf, true)); }
__device__ __forceinline__ float scan16(float v, int) { v += dppf<0x111>(v); v += dppf<0x112>(v); v += dppf<0x114>(v); v += dppf<0x118>(v); return v; }
__device__ __forceinline__ float bcast15(float v) { return dppf<0x15F>(v); }
__device__ __forceinline__ float bcast0(float v) { return dppf<0x150>(v); }

struct EpiIn {
    unsigned char *wsb, *dob; LAS float* xch;
#define EI_W(type, off) ((type*)(wsb + (off)))
#define EI_D(type, off) ((type*)(dob + (off)))
    __device__ __forceinline__ void hgrn(const f32x4 (&acc)[2][2][4][2], const Unit& u, int wr, int wc, int fr, int fq) const {
        const int hh = u.pn >> 1, cb = u.pn & 1;
        const int gch0 = hh * 128 + cb * 64 + wc * 16 + fq * 4;
        bf16* const QF = EI_D(bf16, DO_QF); bf16* const KF = EI_D(bf16, DO_KF); bf16* const QB = EI_D(bf16, DO_QB); bf16* const KB = EI_D(bf16, DO_KB); bf16* const VA = EI_W(bf16, WS_VA);
        float* const EREF = EI_W(float, WS_EREF); float* const ELAST = EI_W(float, WS_ELAST); const float* const LB = EI_W(float, WS_LB);
        const f32x4 lbf = *(const f32x4*)(LB + gch0), lbb = *(const f32x4*)(LB + 512 + gch0);
#pragma unroll
        for (int ai = 0; ai < 2; ++ai) {
            const int cidx = u.pm * 4 + ai * 2 + wr;
            const size_t off0 = (size_t)(u.pm * 256 + ai * 128 + wr * 64 + fr) * 512 + gch0;
#pragma unroll
            for (int m = 0; m < 4; ++m) st4(VA + off0 + (size_t)m * 16 * 512, acc[ai][1][m][1]);
            {
                f32x4 qo[4], ko[4];
#pragma unroll
                for (int j = 0; j < 4; ++j) {
                    float lf[4], kk[4];
#pragma unroll
                    for (int m = 0; m < 4; ++m) { const float z = fminf(fmaxf(acc[ai][0][m][1][j], -30.f), 30.f), e = __expf(-z), s = __builtin_amdgcn_rcpf(1.0f + e); kk[m] = (1.0f - lbf[j]) * e * s; lf[m] = __logf(lbf[j] + (1.0f - lbf[j]) * s); }
                    float G[4], carry = 0.f;
#pragma unroll
                    for (int m = 0; m < 4; ++m) { G[m] = scan16(lf[m], fr) + carry; carry = bcast15(G[m]); }
                    const float Gref = bcast15(G[1]);
#pragma unroll
                    for (int m = 0; m < 4; ++m) { qo[m][j] = silu_(acc[ai][0][m][0][j]) * __expf(fminf(G[m] - Gref, 80.f)); ko[m][j] = kk[m] * __expf(fminf(Gref - G[m], 80.f)); }
                    if (fr == 0) { EREF[(size_t)cidx * 512 + gch0 + j] = __expf(Gref); ELAST[(size_t)cidx * 512 + gch0 + j] = __expf(carry - Gref); }
                }
#pragma unroll
                for (int m = 0; m < 4; ++m) { st4(QF + off0 + (size_t)m * 16 * 512, qo[m]); st4(KF + off0 + (size_t)m * 16 * 512, ko[m]); }
                asm volatile("" ::: "memory");
            }
            {
                f32x4 qo[4], ko[4];
#pragma unroll
                for (int j = 0; j < 4; ++j) {
                    float lw[4], kk[4];
#pragma unroll
                    for (int m = 0; m < 4; ++m) { const float z = fminf(fmaxf(acc[ai][1][m][0][j], -30.f), 30.f), e = __expf(-z), s = __builtin_amdgcn_rcpf(1.0f + e); kk[m] = (1.0f - lbb[j]) * e * s; lw[m] = __logf(lbb[j] + (1.0f - lbb[j]) * s); }
                    float P[4], carry = 0.f;
#pragma unroll
                    for (int m = 0; m < 4; ++m) { P[m] = scan16(lw[m], fr) + carry; carry = bcast15(P[m]); }
                    float Gb[4];
#pragma unroll
                    for (int m = 0; m < 4; ++m) Gb[m] = carry - (P[m] - lw[m]);
                    const float Gbref = bcast0(Gb[2]);
#pragma unroll
                    for (int m = 0; m < 4; ++m) { qo[m][j] = silu_(acc[ai][0][m][0][j]) * __expf(fminf(Gb[m] - Gbref, 80.f)); ko[m][j] = kk[m] * __expf(fminf(Gbref - Gb[m], 80.f)); }
                    if (fr == 0) { EREF[(size_t)(NCHUNK + cidx) * 512 + gch0 + j] = __expf(Gbref); ELAST[(size_t)(NCHUNK + cidx) * 512 + gch0 + j] = __expf(carry - Gbref); }
                }
#pragma unroll
                for (int m = 0; m < 4; ++m) { st4(QB + off0 + (size_t)m * 16 * 512, qo[m]); st4(KB + off0 + (size_t)m * 16 * 512, ko[m]); }
                asm volatile("" ::: "memory");
            }
        }
    }
    __device__ __forceinline__ void operator()(const f32x4 (&acc)[2][2][4][2], const Unit& u, int wr, int wc, int fr, int fq) const {
        const int pn = u.pn, row0 = u.pm * 256 + wr * 64 + fr;
        if (pn < 8) { hgrn(acc, u, wr, wc, fr, fq); return; }
        bf16* const OG = EI_W(bf16, WS_OG); bf16* const CQ = EI_W(bf16, WS_CQ); bf16* const CKVR = EI_W(bf16, WS_CKVR); bf16* const GA = EI_W(bf16, WS_GA); bf16* const GB = EI_W(bf16, WS_GB);
        float* const CQSS = EI_W(float, WS_CQSS); float* const CKVSS = EI_W(float, WS_CKVSS); float* const KR = EI_W(float, WS_KR);
#if I8_QKV
        if (pn == 10 || pn == 11) {
            const bool isq = pn == 10; float ssv[2][4];
#pragma unroll
            for (int ai = 0; ai < 2; ++ai)
#pragma unroll
                for (int m = 0; m < 4; ++m) { const int row = row0 + ai * 128 + m * 16; float ss = 0.f, mx = 0.f;
#pragma unroll
                    for (int bj = 0; bj < 2; ++bj) { if (bj == 0 || isq) { const f32x4 a = acc[ai][bj][m][0], b = acc[ai][bj][m][1]; ss += dot4(a) + dot4(b);
#pragma unroll
                        for (int j = 0; j < 4; ++j) mx = fmaxf(mx, fmaxf(fabsf(a[j]), fabsf(b[j]))); } }
                    ss += __shfl_xor(ss, 16); ss += __shfl_xor(ss, 32); mx = fmaxf(mx, __shfl_xor(mx, 16)); mx = fmaxf(mx, __shfl_xor(mx, 32));
                    if (fq == 0) { (isq ? CQSS : CKVSS)[(size_t)row * 4 + wc] = ss; xch[(wr * 4 + wc) * 128 + ai * 64 + m * 16 + fr] = mx; }
                    if (!isq && wc == 0) { *(f32x4*)(KR + (size_t)row * 32 + 8 * fq) = acc[ai][1][m][0]; *(f32x4*)(KR + (size_t)row * 32 + 8 * fq + 4) = acc[ai][1][m][1]; } }
            asm volatile("s_waitcnt lgkmcnt(0)\n\ts_barrier" ::: "memory");
            unsigned char* const dst8 = wsb + (isq ? WS_CQ : WS_CKVR); float* const SAr = (float*)(wsb + (isq ? WS_SAQ : WS_SAKV));
#pragma unroll
            for (int ai = 0; ai < 2; ++ai)
#pragma unroll
                for (int m = 0; m < 4; ++m) { const int row = row0 + ai * 128 + m * 16; const int xi = ai * 64 + m * 16 + fr;
                    const float rm = fmaxf(fmaxf(xch[(wr * 4 + 0) * 128 + xi], xch[(wr * 4 + 1) * 128 + xi]), fmaxf(xch[(wr * 4 + 2) * 128 + xi], xch[(wr * 4 + 3) * 128 + xi]));
                    const float inv = rm > 0.f ? 127.0f / rm : 0.f; if (wc == 0 && fq == 0) SAr[row] = rm * (1.0f / 127.0f);
#pragma unroll
                    for (int bj = 0; bj < 2; ++bj) { if (bj == 0 || isq) { const f32x4 a = acc[ai][bj][m][0] * inv, b = acc[ai][bj][m][1] * inv; v2u o; o.x = q8pack(a[0], a[1], a[2], a[3]); o.y = q8pack(b[0], b[1], b[2], b[3]);
                        *(v2u*)(dst8 + (size_t)row * 256 + bj * 128 + wc * 32 + 8 * fq) = o; } } }
            return;
        }
#else
        if (pn == 10) {
#pragma unroll
            for (int ai = 0; ai < 2; ++ai)
#pragma unroll
                for (int m = 0; m < 4; ++m) { const int row = row0 + ai * 128 + m * 16; float ss = 0.f;
#pragma unroll
                    for (int bj = 0; bj < 2; ++bj) { const f32x4 a = acc[ai][bj][m][0], b = acc[ai][bj][m][1]; ss += dot4(a) + dot4(b); st8(CQ + (size_t)row * 256 + bj * 128 + wc * 32 + 8 * fq, a, b); }
                    ss += __shfl_xor(ss, 16); ss += __shfl_xor(ss, 32); if (fq == 0) CQSS[(size_t)row * 4 + wc] = ss; }
            return;
        }
        if (pn == 11) {
#pragma unroll
            for (int ai = 0; ai < 2; ++ai)
#pragma unroll
                for (int m = 0; m < 4; ++m) { const int row = row0 + ai * 128 + m * 16;
                    const f32x4 a0 = acc[ai][0][m][0], b0 = acc[ai][0][m][1], a1 = acc[ai][1][m][0], b1 = acc[ai][1][m][1];
                    float ss = dot4(a0) + dot4(b0); ss += __shfl_xor(ss, 16); ss += __shfl_xor(ss, 32); if (fq == 0) CKVSS[(size_t)row * 4 + wc] = ss;
                    st8(CKVR + (size_t)row * 256 + wc * 32 + 8 * fq, a0, b0); st8(CKVR + (size_t)row * 256 + 128 + wc * 32 + 8 * fq, a1, b1);
                    if (wc == 0) { *(f32x4*)(KR + (size_t)row * 32 + 8 * fq) = a1; *(f32x4*)(KR + (size_t)row * 32 + 8 * fq + 4) = b1; } }
            return;
        }
#endif
        const bool sil = pn < 10; const int ld = sil ? 512 : 1024, cb = (sil ? pn - 8 : (pn - 12) & 3) * 256;
        const size_t dsto = sil ? (size_t)0 : (pn < 16 ? (size_t)((unsigned char*)GA - (unsigned char*)OG) : (size_t)((unsigned char*)GB - (unsigned char*)OG));
        bf16* dst = (bf16*)((unsigned char*)OG + dsto);
#pragma unroll
        for (int ai = 0; ai < 2; ++ai)
#pragma unroll
            for (int m = 0; m < 4; ++m)
#pragma unroll
                for (int bj = 0; bj < 2; ++bj) { f32x4 a = acc[ai][bj][m][0], b = acc[ai][bj][m][1];
#pragma unroll
                    for (int j = 0; j < 4; ++j) { a[j] = sil ? silu_(a[j]) : sigm(a[j]); b[j] = sil ? silu_(b[j]) : sigm(b[j]); }
#if GATE_U8
                    if (!sil) { v2u o; o.x = q8pack(a[0] * 255.f, a[1] * 255.f, a[2] * 255.f, a[3] * 255.f); o.y = q8pack(b[0] * 255.f, b[1] * 255.f, b[2] * 255.f, b[3] * 255.f);
                        *(v2u*)((unsigned char*)dst + (size_t)(row0 + ai * 128 + m * 16) * 1024 + cb + bj * 128 + wc * 32 + 8 * fq) = o; }
                    else
#endif
                    st8(dst + (size_t)(row0 + ai * 128 + m * 16) * ld + cb + bj * 128 + wc * 32 + 8 * fq, a, b); }
    }
};

struct EpiQ {
    bf16* QM; const float* CQSS;
    __device__ __forceinline__ void operator()(const f32x4 (&acc)[2][2][4][2], const Unit& u, int wr, int wc, int fr, int fq) const {
        float rsv[2][4];
#pragma unroll
        for (int ai = 0; ai < 2; ++ai)
#pragma unroll
            for (int m = 0; m < 4; ++m) { const f32x4 s4 = *(const f32x4*)(CQSS + (size_t)(u.pm * 256 + ai * 128 + wr * 64 + m * 16 + fr) * 4); rsv[ai][m] = rsqrtf(((s4[0] + s4[1]) + (s4[2] + s4[3])) * (1.0f / 256.0f) + EPS); }
#pragma unroll
        for (int ai = 0; ai < 2; ++ai)
#pragma unroll
            for (int m = 0; m < 4; ++m) { const int row = u.pm * 256 + ai * 128 + wr * 64 + m * 16 + fr; const float rs = rsv[ai][m];
#pragma unroll
                for (int bj = 0; bj < 2; ++bj) st8(QM + (size_t)row * 768 + u.pn * 256 + bj * 128 + wc * 32 + 8 * fq, acc[ai][bj][m][0] * rs, acc[ai][bj][m][1] * rs); }
    }
};
struct EpiKV {
    bf16 *KH, *VH; const float *CKVSS, *KR, *ROPE_, *KN;
    __device__ __forceinline__ void operator()(const f32x4 (&acc)[2][2][4][2], const Unit& u, int wr, int wc, int fr, int fq) const {
        const int pn = u.pn, head = (pn & 1) * 4 + wc;
        float rsv[2][4];
#pragma unroll
        for (int ai = 0; ai < 2; ++ai)
#pragma unroll
            for (int m = 0; m < 4; ++m) { const f32x4 s4 = *(const f32x4*)(CKVSS + (size_t)(u.pm * 256 + ai * 128 + wr * 64 + m * 16 + fr) * 4); rsv[ai][m] = rsqrtf(((s4[0] + s4[1]) + (s4[2] + s4[3])) * (1.0f / 128.0f) + EPS); }
        if (pn >= 2) {
#pragma unroll
            for (int ai = 0; ai < 2; ++ai)
#pragma unroll
                for (int m = 0; m < 4; ++m) { const int row = u.pm * 256 + ai * 128 + wr * 64 + m * 16 + fr; const float rs = rsv[ai][m];
#pragma unroll
                    for (int bj = 0; bj < 2; ++bj) st8(VH + ((size_t)row * 8 + head) * 64 + bj * 32 + 8 * fq, acc[ai][bj][m][0] * rs, acc[ai][bj][m][1] * rs); }
            return;
        }
#pragma unroll
        for (int ai = 0; ai < 2; ++ai)
#pragma unroll
            for (int m = 0; m < 4; ++m) { const int row = u.pm * 256 + ai * 128 + wr * 64 + m * 16 + fr; const float rs = rsv[ai][m]; const size_t ro = (size_t)row * 32;
                const f32x4 x1 = *(const f32x4*)(KR + ro + 4 * fq), x2 = *(const f32x4*)(KR + ro + 16 + 4 * fq), cc = *(const f32x4*)(ROPE_ + ro + 4 * fq), sn = *(const f32x4*)(ROPE_ + ro + 16 + 4 * fq);
                float ss = 0.f;
#pragma unroll
                for (int bj = 0; bj < 2; ++bj)
#pragma unroll
                    for (int n = 0; n < 2; ++n) ss += dot4(acc[ai][bj][m][n]);
                ss = ss * rs * rs + dot4(x1) + dot4(x2);
                ss += __shfl_xor(ss, 16); ss += __shfl_xor(ss, 32);
                const float rk = rsqrtf(ss * (1.0f / 96.0f) + EPS), rr = rs * rk;
                bf16* kp = KH + ((size_t)row * 8 + head) * 96;
#pragma unroll
                for (int bj = 0; bj < 2; ++bj) st8(kp + bj * 32 + 8 * fq, acc[ai][bj][m][0] * rr * *(const f32x4*)(KN + bj * 32 + 8 * fq), acc[ai][bj][m][1] * rr * *(const f32x4*)(KN + bj * 32 + 8 * fq + 4));
                const f32x4 y1 = x1 * rk * *(const f32x4*)(KN + 64 + 4 * fq), y2 = x2 * rk * *(const f32x4*)(KN + 80 + 4 * fq);
                st4(kp + 64 + 4 * fq, y1 * cc - y2 * sn); st4(kp + 80 + 4 * fq, y2 * cc + y1 * sn);
                if (m & 1) asm volatile("" ::: "memory"); }
    }
};
struct EpiQKV {
    EpiQ q; EpiKV kv;
    __device__ __forceinline__ void operator()(const f32x4 (&acc)[2][2][4][2], const Unit& u, int wr, int wc, int fr, int fq) const { if (u.kind) kv(acc, u, wr, wc, fr, fq); else q(acc, u, wr, wc, fr, fq); }
};
struct EpiQKV8 {
    unsigned char* wsb; const float* KN;
    __device__ __forceinline__ void operator()(const i32x4 (&acc)[2][2][4][2], const Unit& u, int wr, int wc, int fr_in, int fq_in) const {
        int fr = fr_in, fq = fq_in; asm volatile("" : "+v"(fr), "+v"(fq));
        unsigned char* W = wsb; asm volatile("" : "+s"(W));
        const float* SA = (const float*)(W + (u.kind ? WS_SAKV : WS_SAQ)); const float* SB = (const float*)(W + (u.kind ? WS_SBUKV : WS_SBUQ));
        int lo_ = wc * 32 + 4 * fq, ro_ = wr * 64 + fr; asm volatile("" : "+v"(lo_), "+v"(ro_));
        const int lo = lo_, ro = ro_;
        f32x4 f[2][2][4][2]; f32x4 sb[2][2];
#pragma unroll
        for (int bj = 0; bj < 2; ++bj)
#pragma unroll
            for (int n = 0; n < 2; ++n) sb[bj][n] = *(const f32x4*)(SB + u.pn * 256 + bj * 128 + n * 16 + lo);
#pragma unroll
        for (int ai = 0; ai < 2; ++ai) { float sa[4];
#pragma unroll
            for (int m = 0; m < 4; ++m) sa[m] = SA[u.pm * 256 + ai * 128 + m * 16 + ro];
#pragma unroll
            for (int bj = 0; bj < 2; ++bj)
#pragma unroll
                for (int m = 0; m < 4; ++m)
#pragma unroll
                    for (int n = 0; n < 2; ++n) f[ai][bj][m][n] = __builtin_convertvector(acc[ai][bj][m][n], f32x4) * sb[bj][n] * sa[m]; }
        if (u.kind) { const EpiKV kv{(bf16*)(W + WS_KH), (bf16*)(W + WS_VH), (const float*)(W + WS_CKVSS), (const float*)(W + WS_KR), (const float*)(W + WS_ROPE), KN}; kv(f, u, wr, wc, fr, fq); }
        else { const EpiQ q{(bf16*)(W + WS_QM), (const float*)(W + WS_CQSS)}; q(f, u, wr, wc, fr, fq); }
    }
};
struct EpiMerge {
    bf16* MG; const bf16 *GA, *GB;
    __device__ __forceinline__ void operator()(const f32x4 (&acc)[2][2][4][2], const Unit& u, int wr, int wc, int fr, int fq) const {
        const bool which = u.pm >= T / 256; const int pm = u.pm - (which ? T / 256 : 0), pn = u.pn - (which ? D / 256 : 0);
        const bf16* Gt = (const bf16*)((const unsigned char*)GA + (which ? (size_t)((const unsigned char*)GB - (const unsigned char*)GA) : (size_t)0));
#pragma unroll
        for (int ai = 0; ai < 2; ++ai)
#pragma unroll
            for (int mp = 0; mp < 2; ++mp) {
                v4u gv[2][2], ov[2][2];
#pragma unroll
                for (int mm = 0; mm < 2; ++mm)
#pragma unroll
                    for (int bj = 0; bj < 2; ++bj) { const size_t off = (size_t)(pm * 256 + ai * 128 + wr * 64 + (2 * mp + mm) * 16 + fr) * 1024 + pn * 256 + bj * 128 + wc * 32 + 8 * fq;
#if GATE_U8
                        { const v2u g8 = *(const v2u*)((const unsigned char*)Gt + off); gv[mm][bj] = (v4u){g8.x, g8.y, 0u, 0u}; }
#else
                        gv[mm][bj] = *(const v4u*)(Gt + off);
#endif
                        ov[mm][bj] = which ? *(const v4u*)(MG + off) : (v4u){0u, 0u, 0u, 0u}; }
#pragma unroll
                for (int mm = 0; mm < 2; ++mm)
#pragma unroll
                    for (int bj = 0; bj < 2; ++bj) { const int m = 2 * mp + mm; const size_t off = (size_t)(pm * 256 + ai * 128 + wr * 64 + m * 16 + fr) * 1024 + pn * 256 + bj * 128 + wc * 32 + 8 * fq;
                        const v4u g = gv[mm][bj], o = ov[mm][bj];
#if GATE_U8
                        const f32x4 a = acc[ai][bj][m][0] * ub4(g.x) + up4(o.x, o.y), b = acc[ai][bj][m][1] * ub4(g.y) + up4(o.z, o.w);
#else
                        const f32x4 a = acc[ai][bj][m][0] * up4(g.x, g.y) + up4(o.x, o.y), b = acc[ai][bj][m][1] * up4(g.z, g.w) + up4(o.z, o.w);
#endif
                        st8(MG + off, a, b); }
                asm volatile("" ::: "memory"); }
    }
};
struct EpiX2 {
    const float* X; bf16* O; float* XM;
    __device__ __forceinline__ void operator()(const f32x4 (&acc)[2][2][4][2], const Unit& u, int wr, int wc, int fr, int fq) const {
#pragma unroll
        for (int ai = 0; ai < 2; ++ai)
#pragma unroll
            for (int mp = 0; mp < 2; ++mp) {
                f32x4 xv[2][2][2];
#pragma unroll
                for (int mm = 0; mm < 2; ++mm)
#pragma unroll
                    for (int bj = 0; bj < 2; ++bj) { const float* xp = X + (size_t)(u.pm * 256 + ai * 128 + wr * 64 + (2 * mp + mm) * 16 + fr) * 1024 + u.pn * 256 + bj * 128 + wc * 32 + 8 * fq;
                        xv[mm][bj][0] = *(const f32x4*)xp; xv[mm][bj][1] = *(const f32x4*)(xp + 4); }
#pragma unroll
                for (int mm = 0; mm < 2; ++mm)
#pragma unroll
                    for (int bj = 0; bj < 2; ++bj) { xv[mm][bj][0] += acc[ai][bj][2 * mp + mm][0]; xv[mm][bj][1] += acc[ai][bj][2 * mp + mm][1];
                        st8(O + (size_t)(u.pm * 256 + ai * 128 + wr * 64 + (2 * mp + mm) * 16 + fr) * 1024 + u.pn * 256 + bj * 128 + wc * 32 + 8 * fq, xv[mm][bj][0], xv[mm][bj][1]); }
#pragma unroll
                for (int mm = 0; mm < 2; ++mm) { float mx = 0.f;
#pragma unroll
                    for (int bj = 0; bj < 2; ++bj)
#pragma unroll
                        for (int n = 0; n < 2; ++n)
#pragma unroll
                            for (int j = 0; j < 4; ++j) mx = fmaxf(mx, fabsf(xv[mm][bj][n][j]));
                    mx = fmaxf(mx, __shfl_xor(mx, 16)); mx = fmaxf(mx, __shfl_xor(mx, 32));
                    if (fq == 0) XM[(size_t)(u.pm * 256 + ai * 128 + wr * 64 + (2 * mp + mm) * 16 + fr) * 16 + u.pn * 4 + wc] = mx; }
                asm volatile("" ::: "memory"); }
    }
};
struct EpiUp {
    bf16* H1; const int* LIST; const float* RS2;
    __device__ __forceinline__ void operator()(const f32x4 (&acc)[2][2][4][2], const Unit& u, int wr, int wc, int fr, int fq) const {
        const int pl = u.pn & 1; int tk[2][4]; float rsv[2][4];
#pragma unroll
        for (int ai = 0; ai < 2; ++ai)
#pragma unroll
            for (int m = 0; m < 4; ++m) { const int r = ai * 128 + wr * 64 + m * 16 + fr; tk[ai][m] = LIST[u.lbase + (r < u.nvalid ? r : u.nvalid - 1)] >> 1; }
#pragma unroll
        for (int ai = 0; ai < 2; ++ai)
#pragma unroll
            for (int m = 0; m < 4; ++m) rsv[ai][m] = RS2[tk[ai][m]];
#pragma unroll
        for (int ai = 0; ai < 2; ++ai)
#pragma unroll
            for (int m = 0; m < 4; ++m) { const int r = ai * 128 + wr * 64 + m * 16 + fr; const float rs = rsv[ai][m];
                f32x4 a = acc[ai][0][m][0] * rs, b = acc[ai][0][m][1] * rs;
#pragma unroll
                for (int j = 0; j < 4; ++j) { a[j] = silu_(a[j]) * (acc[ai][1][m][0][j] * rs); b[j] = silu_(b[j]) * (acc[ai][1][m][1][j] * rs); }
                st8(H1 + (size_t)(u.pm * 256 + r) * 256 + pl * 128 + wc * 32 + 8 * fq, a, b); }
    }
};
struct EpiDown {
    bf16 *Y0, *Y1; const int* LIST; const float* EW;
    __device__ __forceinline__ void operator()(const f32x4 (&acc)[2][2][4][2], const Unit& u, int wr, int wc, int fr, int fq) const {
        const int pl = u.pn & 3; int en[2][4]; float wv[2][4];
#pragma unroll
        for (int ai = 0; ai < 2; ++ai)
#pragma unroll
            for (int m = 0; m < 4; ++m) { const int r = ai * 128 + wr * 64 + m * 16 + fr; en[ai][m] = r < u.nvalid ? LIST[u.lbase + r] : -1; }
#pragma unroll
        for (int ai = 0; ai < 2; ++ai)
#pragma unroll
            for (int m = 0; m < 4; ++m) wv[ai][m] = en[ai][m] >= 0 ? EW[en[ai][m]] : 0.f;
#pragma unroll
        for (int ai = 0; ai < 2; ++ai)
#pragma unroll
            for (int m = 0; m < 4; ++m) { const int ent = en[ai][m]; const float w = wv[ai][m];
                if (ent >= 0) {
                    const unsigned eo = (unsigned)(ent >> 1) * 1024u + (unsigned)(pl * 256 + wc * 32 + 8 * fq) + ((ent & 1) ? (unsigned)(((unsigned char*)Y1 - (unsigned char*)Y0) / 2) : 0u);
#pragma unroll
                    for (int bj = 0; bj < 2; ++bj) st8(Y0 + eo + bj * 128, acc[ai][bj][m][0] * w, acc[ai][bj][m][1] * w); } }
    }
};
struct EpiProj {
    bf16* PR;
    __device__ __forceinline__ void operator()(const f32x4 (&acc)[2][2][4][2], const Unit& u, int wr, int wc, int fr, int fq) const {
#pragma unroll
        for (int ai = 0; ai < 2; ++ai)
#pragma unroll
            for (int m = 0; m < 4; ++m)
#pragma unroll
                for (int bj = 0; bj < 2; ++bj) st8(PR + (size_t)(u.pm * 256 + ai * 128 + wr * 64 + m * 16 + fr) * 1024 + u.pn * 256 + bj * 128 + wc * 32 + 8 * fq, acc[ai][bj][m][0], acc[ai][bj][m][1]);
    }
};
template <class Epi, bool ROWS = true> struct EpiScaled {
    Epi inner; const float* SA; const float* SB;
    __device__ __forceinline__ void operator()(const i32x4 (&acc)[2][2][4][2], const Unit& u, int wr, int wc, int fr, int fq) const {
        f32x4 f[2][2][4][2]; f32x4 sb[2][2];
#pragma unroll
        for (int bj = 0; bj < 2; ++bj)
#pragma unroll
            for (int n = 0; n < 2; ++n) sb[bj][n] = *(const f32x4*)(SB + u.pn * 256 + bj * 128 + wc * 32 + n * 16 + 4 * fq);
#pragma unroll
        for (int ai = 0; ai < 2; ++ai) { float sa[4];
#pragma unroll
            for (int m = 0; m < 4; ++m) sa[m] = ROWS ? SA[u.pm * 256 + ai * 128 + wr * 64 + m * 16 + fr] : 1.0f;
#pragma unroll
            for (int bj = 0; bj < 2; ++bj)
#pragma unroll
                for (int m = 0; m < 4; ++m)
#pragma unroll
                    for (int n = 0; n < 2; ++n) { f[ai][bj][m][n] = __builtin_convertvector(acc[ai][bj][m][n], f32x4) * sb[bj][n]; if constexpr (ROWS) f[ai][bj][m][n] *= sa[m]; } }
        inner(f, u, wr, wc, fr, fq);
    }
};
struct EpiGateProj {
    float* O; const bf16* X3; unsigned char* SCR; const float* SA3; const float* SBG; const float* SAP; const float* SBP;
    __device__ __forceinline__ void operator()(const i32x4 (&acc)[2][2][4][2], const Unit& u, int wr, int wc, int fr, int fq) const {
        int tid_ = (wr * 4 + wc) * 64 + fq * 16 + fr, lo_ = wc * 32 + 4 * fq, lc_ = wc * 32 + 8 * fq; asm volatile("" : "+v"(tid_), "+v"(lo_), "+v"(lc_));
        const int tid = tid_, lo = lo_, lc = lc_;
        f32x4 sb[2][2];
        { const float* SB = (const float*)((const unsigned char*)SBG + (u.kind ? (size_t)((const unsigned char*)SBP - (const unsigned char*)SBG) : (size_t)0));
#pragma unroll
        for (int bj = 0; bj < 2; ++bj)
#pragma unroll
            for (int n = 0; n < 2; ++n) sb[bj][n] = *(const f32x4*)(SB + u.pn * 256 + bj * 128 + n * 16 + lo); }
        if (u.kind == 0) {
#pragma unroll
            for (int ai = 0; ai < 2; ++ai) { float sa[4];
#pragma unroll
                for (int m = 0; m < 4; ++m) sa[m] = SA3[u.pm * 256 + ai * 128 + wr * 64 + m * 16 + fr];
#pragma unroll
                for (int bj = 0; bj < 2; ++bj)
#pragma unroll
                    for (int m = 0; m < 4; ++m) { f32x4 a = __builtin_convertvector(acc[ai][bj][m][0], f32x4) * sb[bj][0] * sa[m], b = __builtin_convertvector(acc[ai][bj][m][1], f32x4) * sb[bj][1] * sa[m];
#pragma unroll
                        for (int j = 0; j < 4; ++j) { a[j] = sigm(a[j]) * 255.f; b[j] = sigm(b[j]) * 255.f; }
                        v2u w; w.x = q8pack(a[0], a[1], a[2], a[3]); w.y = q8pack(b[0], b[1], b[2], b[3]);
                        *(v2u*)(SCR + (size_t)(((ai * 2 + bj) * 4 + m) * 512 + tid) * 8) = w; } }
        } else {
#pragma unroll
            for (int ai = 0; ai < 2; ++ai) {
                v4u xv[4][2]; v2u gv[4][2]; float sa[4];
#pragma unroll
                for (int m = 0; m < 4; ++m) { sa[m] = SAP[u.pm * 256 + ai * 128 + wr * 64 + m * 16 + fr];
#pragma unroll
                    for (int bj = 0; bj < 2; ++bj) { gv[m][bj] = *(const v2u*)(SCR + (size_t)(((ai * 2 + bj) * 4 + m) * 512 + tid) * 8);
                        xv[m][bj] = *(const v4u*)(X3 + (size_t)(u.pm * 256 + ai * 128 + wr * 64 + m * 16 + fr) * 1024 + u.pn * 256 + bj * 128 + lc); } }
#pragma unroll
                for (int m = 0; m < 4; ++m)
#pragma unroll
                    for (int bj = 0; bj < 2; ++bj) { float* op = O + (size_t)(u.pm * 256 + ai * 128 + wr * 64 + m * 16 + fr) * 1024 + u.pn * 256 + bj * 128 + lc;
                        const f32x4 p0 = __builtin_convertvector(acc[ai][bj][m][0], f32x4) * sb[bj][0] * sa[m], p1 = __builtin_convertvector(acc[ai][bj][m][1], f32x4) * sb[bj][1] * sa[m];
                        *(f32x4*)op = up4(xv[m][bj].x, xv[m][bj].y) + p0 * ub4(gv[m][bj].x); *(f32x4*)(op + 4) = up4(xv[m][bj].z, xv[m][bj].w) + p1 * ub4(gv[m][bj].y); }
                asm volatile("" ::: "memory"); }
        }
    }
};
struct EpiProjGate {
    float* O; const bf16* X3; unsigned char* SCR; const float* SA3; const float* SBG; const float* SAP; const float* SBP;
    __device__ __forceinline__ void operator()(const i32x4 (&acc)[2][2][4][2], const Unit& u, int wr, int wc, int fr, int fq) const {
        int tid_ = (wr * 4 + wc) * 64 + fq * 16 + fr, lo_ = wc * 32 + 4 * fq; asm volatile("" : "+v"(tid_), "+v"(lo_));
        const int tid = tid_, lo = lo_;
        f32x4 sb[2][2];
        { const float* SB = (const float*)((const unsigned char*)SBP + (u.kind ? (size_t)((const unsigned char*)SBG - (const unsigned char*)SBP) : (size_t)0));
#pragma unroll
        for (int bj = 0; bj < 2; ++bj)
#pragma unroll
            for (int n = 0; n < 2; ++n) sb[bj][n] = *(const f32x4*)(SB + u.pn * 256 + bj * 128 + n * 16 + lo); }
        if (u.kind == 0) {
#pragma unroll
            for (int ai = 0; ai < 2; ++ai) { float sa[4];
#pragma unroll
                for (int m = 0; m < 4; ++m) sa[m] = SAP[u.pm * 256 + ai * 128 + wr * 64 + m * 16 + fr];
#pragma unroll
                for (int bj = 0; bj < 2; ++bj)
#pragma unroll
                    for (int m = 0; m < 4; ++m) { const f32x4 a = __builtin_convertvector(acc[ai][bj][m][0], f32x4) * sb[bj][0] * sa[m], b = __builtin_convertvector(acc[ai][bj][m][1], f32x4) * sb[bj][1] * sa[m];
                        v4u w; w.x = pk2(a[0], a[1]); w.y = pk2(a[2], a[3]); w.z = pk2(b[0], b[1]); w.w = pk2(b[2], b[3]);
                        *(v4u*)(SCR + (size_t)(((ai * 2 + bj) * 4 + m) * 512 + tid) * 16) = w; } }
        } else {
#pragma unroll
            for (int ai = 0; ai < 2; ++ai)
#pragma unroll
                for (int mp = 0; mp < 2; ++mp) {
                    v2u xv[2][2][2]; v4u pv[2][2]; float sa[2];
#pragma unroll
                    for (int mm = 0; mm < 2; ++mm) { sa[mm] = SA3[u.pm * 256 + ai * 128 + wr * 64 + (2 * mp + mm) * 16 + fr];
#pragma unroll
                        for (int bj = 0; bj < 2; ++bj) { pv[mm][bj] = *(const v4u*)(SCR + (size_t)(((ai * 2 + bj) * 4 + 2 * mp + mm) * 512 + tid) * 16);
#pragma unroll
                            for (int n = 0; n < 2; ++n) xv[mm][bj][n] = *(const v2u*)(X3 + (size_t)(u.pm * 256 + ai * 128 + wr * 64 + (2 * mp + mm) * 16 + fr) * 1024 + u.pn * 256 + bj * 128 + n * 16 + lo); } }
#pragma unroll
                    for (int mm = 0; mm < 2; ++mm)
#pragma unroll
                        for (int bj = 0; bj < 2; ++bj)
#pragma unroll
                            for (int n = 0; n < 2; ++n) { const size_t off = (size_t)(u.pm * 256 + ai * 128 + wr * 64 + (2 * mp + mm) * 16 + fr) * 1024 + u.pn * 256 + bj * 128 + n * 16 + lo;
                                f32x4 g = __builtin_convertvector(acc[ai][bj][2 * mp + mm][n], f32x4) * sb[bj][n] * sa[mm];
#pragma unroll
                                for (int j = 0; j < 4; ++j) g[j] = sigm(g[j]);
                                const f32x4 pr = n ? up4(pv[mm][bj].z, pv[mm][bj].w) : up4(pv[mm][bj].x, pv[mm][bj].y);
                                *(f32x4*)(O + off) = up4(xv[mm][bj][n].x, xv[mm][bj][n].y) + pr * g; }
                    asm volatile("" ::: "memory"); }
        }
    }
};
struct EpiFinal8 {
    float* O; const bf16* X3; const bf16* PR; const float* SA; const float* SB;
    __device__ __forceinline__ void operator()(const i32x4 (&acc)[2][2][4][2], const Unit& u, int wr, int wc, int fr, int fq) const {
        f32x4 sb[2][2];
#pragma unroll
        for (int bj = 0; bj < 2; ++bj)
#pragma unroll
            for (int n = 0; n < 2; ++n) sb[bj][n] = *(const f32x4*)(SB + u.pn * 256 + bj * 128 + wc * 32 + n * 16 + 4 * fq);
#pragma unroll
        for (int ai = 0; ai < 2; ++ai)
#pragma unroll
            for (int mp = 0; mp < 2; ++mp) {
                v2u xv[2][2][2]; v2u pv[2][2][2]; float sa[2];
#pragma unroll
                for (int mm = 0; mm < 2; ++mm) { sa[mm] = SA[u.pm * 256 + ai * 128 + wr * 64 + (2 * mp + mm) * 16 + fr];
#pragma unroll
                    for (int bj = 0; bj < 2; ++bj)
#pragma unroll
                        for (int n = 0; n < 2; ++n) { const size_t off = (size_t)(u.pm * 256 + ai * 128 + wr * 64 + (2 * mp + mm) * 16 + fr) * 1024 + u.pn * 256 + bj * 128 + wc * 32 + n * 16 + 4 * fq;
                            xv[mm][bj][n] = *(const v2u*)(X3 + off); pv[mm][bj][n] = *(const v2u*)(PR + off); } }
#pragma unroll
                for (int mm = 0; mm < 2; ++mm)
#pragma unroll
                    for (int bj = 0; bj < 2; ++bj)
#pragma unroll
                        for (int n = 0; n < 2; ++n) { const size_t off = (size_t)(u.pm * 256 + ai * 128 + wr * 64 + (2 * mp + mm) * 16 + fr) * 1024 + u.pn * 256 + bj * 128 + wc * 32 + n * 16 + 4 * fq;
                            f32x4 g = __builtin_convertvector(acc[ai][bj][2 * mp + mm][n], f32x4) * sb[bj][n] * sa[mm];
#pragma unroll
                            for (int j = 0; j < 4; ++j) g[j] = sigm(g[j]);
                            *(f32x4*)(O + off) = up4(xv[mm][bj][n].x, xv[mm][bj][n].y) + up4(pv[mm][bj][n].x, pv[mm][bj][n].y) * g; }
                asm volatile("" ::: "memory"); }
    }
};
struct EpiFinal {
    float* O; const bf16* PR;
    __device__ __forceinline__ void operator()(const f32x4 (&acc)[2][2][4][2], const Unit& u, int wr, int wc, int fr, int fq) const {
#pragma unroll
        for (int ai = 0; ai < 2; ++ai)
#pragma unroll
            for (int mp = 0; mp < 2; ++mp) {
                f32x4 xv[2][2][2]; v2u pv[2][2][2];
#pragma unroll
                for (int mm = 0; mm < 2; ++mm)
#pragma unroll
                    for (int bj = 0; bj < 2; ++bj)
#pragma unroll
                        for (int n = 0; n < 2; ++n) { const size_t off = (size_t)(u.pm * 256 + ai * 128 + wr * 64 + (2 * mp + mm) * 16 + fr) * 1024 + u.pn * 256 + bj * 128 + wc * 32 + n * 16 + 4 * fq;
                            xv[mm][bj][n] = *(const f32x4*)(O + off); pv[mm][bj][n] = *(const v2u*)(PR + off); }
#pragma unroll
                for (int mm = 0; mm < 2; ++mm)
#pragma unroll
                    for (int bj = 0; bj < 2; ++bj)
#pragma unroll
                        for (int n = 0; n < 2; ++n) { const size_t off = (size_t)(u.pm * 256 + ai * 128 + wr * 64 + (2 * mp + mm) * 16 + fr) * 1024 + u.pn * 256 + bj * 128 + wc * 32 + n * 16 + 4 * fq;
                            f32x4 g = acc[ai][bj][2 * mp + mm][n];
#pragma unroll
                            for (int j = 0; j < 4; ++j) g[j] = sigm(g[j]);
                            *(f32x4*)(O + off) = xv[mm][bj][n] + up4(pv[mm][bj][n].x, pv[mm][bj][n].y) * g; }
                asm volatile("" ::: "memory"); }
    }
};

struct Frame {
    LAS unsigned char* lds; unsigned char* gl;
    volatile LAS unsigned* MISC; gu32* ctl;
    int tid, lane, wave, vcu, G;
    const float* in[27]; float* out; unsigned char* ws;
};
#define WSP(type, off) ((type*)(F.ws + (off)))
#define DOP(type, off) ((type*)((unsigned char*)F.out + (off)))
enum { I_X = 0, I_P, I_POS, I_LNMIX, I_WIN, I_HGLB, I_HGON, I_WOA, I_QAN, I_KVAN, I_WUQ, I_WUKV, I_QN, I_KN, I_WOB, I_WOUT, I_LNMOE, I_WRG, I_BRG, I_WRE, I_BRE, I_W1, I_W3, I_W2, I_LNPLE, I_WPG, I_WPP };

enum { M_WIN = 0, M_WOAB, M_WUQ, M_WUKV, M_WOUT, M_WPG, M_WPP, M_W13, M_W2T };
template <int MAT> struct MatInfo;
template <> struct MatInfo<M_WIN>  { static constexpr int K = 1024, NP = NIN; };
template <> struct MatInfo<M_WOAB> { static constexpr int K = 512,  NP = 2048; };
template <> struct MatInfo<M_WUQ>  { static constexpr int K = 256,  NP = 768; };
template <> struct MatInfo<M_WUKV> { static constexpr int K = 256,  NP = 1024; };
template <> struct MatInfo<M_WOUT> { static constexpr int K = 1024, NP = 1024; };
template <> struct MatInfo<M_WPG>  { static constexpr int K = 1024, NP = 1024; };
template <> struct MatInfo<M_WPP>  { static constexpr int K = 256,  NP = 1024; };
template <> struct MatInfo<M_W13>  { static constexpr int K = 1024, NP = NE * 512; };
template <> struct MatInfo<M_W2T>  { static constexpr int K = 256,  NP = NE * 1024; };
template <int MAT> __device__ __forceinline__ void conv_map(const Frame& F, int p, const float*& src, size_t& ld, const float*& gain, int& kvalid) {
    constexpr int K = MatInfo<MAT>::K; src = nullptr; ld = 0; gain = nullptr; kvalid = K;
    if constexpr (MAT == M_WIN) {
        const int pn = p >> 8; int col;
        if (pn < 8) { const int q = p & 255, bj = q >> 7, wc = (q >> 5) & 3, n = (q >> 4) & 1, fq = (q >> 2) & 3, j = q & 3; const int kind = 2 * bj + n;
            col = kind * 512 + (pn >> 1) * 128 + (pn & 1) * 64 + wc * 16 + fq * 4 + j; }
        else if (pn < 10) col = 2048 + perm8(p - 2048);
        else if (pn == 10) col = 2560 + perm8(p - 2560);
        else if (pn == 11) { const int l = perm8(p - 2816); col = l < 128 ? 2816 + l : (l < 160 ? 2944 + (l - 128) : -1); }
        else if (pn < 16) col = 2976 + perm8(p - 3072);
        else col = 4000 + perm8(p - 4096);
        if (col >= 0) src = F.in[I_WIN] + col; ld = DIN; gain = F.in[I_LNMIX];
    } else if constexpr (MAT == M_WOAB) { { const float* sa = F.in[I_WOA]; const float* sb = F.in[I_WOB]; src = (const float*)((const unsigned char*)sa + ((p >> 10) ? (size_t)((const unsigned char*)sb - (const unsigned char*)sa) : (size_t)0)) + perm8(p & 1023); } ld = 1024; }
    else if constexpr (MAT == M_WUQ) { src = F.in[I_WUQ] + perm8(p); ld = 768; gain = F.in[I_QAN]; }
    else if constexpr (MAT == M_WUKV) { const int pn = p >> 8, q = p & 255, bj = q >> 7, wc = (q >> 5) & 3, n = (q >> 4) & 1, fq = (q >> 2) & 3, j = q & 3;
        const int head = (pn & 1) * 4 + wc, d = 32 * bj + 8 * fq + 4 * n + j; src = F.in[I_WUKV] + head * 128 + (pn >= 2 ? 64 : 0) + d; ld = 1024; gain = F.in[I_KVAN]; kvalid = 128; }
    else if constexpr (MAT == M_WOUT) { src = F.in[I_WOUT] + perm8(p); ld = 1024; }
    else if constexpr (MAT == M_WPG) { src = F.in[I_WPG] + (GATE_FIRST ? perm8(p) : p); ld = 1024; gain = F.in[I_LNPLE]; }
    else if constexpr (MAT == M_WPP) { src = F.in[I_WPP] + ((FUSE_PROJ && !GATE_FIRST) ? p : perm8(p)); ld = 1024; }
    else if constexpr (MAT == M_W13) { const int e = p >> 9, q = p & 511, pl = q >> 8, bj = (q >> 7) & 1, r = q & 127;
        { const float* sa = F.in[I_W1]; const float* sb = F.in[I_W3]; src = (const float*)((const unsigned char*)sa + (bj ? (size_t)((const unsigned char*)sb - (const unsigned char*)sa) : (size_t)0)) + (size_t)e * 1024 * 256 + pl * 128 + perm8(r); } ld = 256; gain = F.in[I_LNMOE]; }
    else { const int e = p >> 10, q = p & 1023; src = F.in[I_W2] + (size_t)e * 256 * 1024 + perm8(q); ld = 1024; }
}
template <int MAT> __device__ __forceinline__ bf16* conv_dst(const Frame& F) {
    constexpr size_t off = MAT == M_WIN ? WS_WIN : MAT == M_WOAB ? WS_WOAB : MAT == M_WUQ ? WS_WUQ : MAT == M_WUKV ? WS_WUKV : MAT == M_WOUT ? WS_WOUT : MAT == M_WPG ? WS_WPG : MAT == M_WPP ? WS_WPP : MAT == M_W13 ? WS_W13 : WS_W2T;
    return WSP(bf16, off);
}
template <int MAT> __device__ __forceinline__ void conv_item(const Frame& F, int item, int lane, LAS float* scr) {
    constexpr int K = MatInfo<MAT>::K; constexpr int KB = K / 64;
    const int kb = item % KB, p0 = (item / KB) * 32, p = p0 + (lane & 31), k0 = kb * 64;
    const float* src; size_t ld; const float* gain; int kvalid; conv_map<MAT>(F, p, src, ld, gain, kvalid); bf16* dst = conv_dst<MAT>(F);
    float tv[32];
#pragma unroll
    for (int i = 0; i < 32; ++i) { const int k = k0 + 2 * i + (lane >> 5); tv[i] = (src && k < kvalid) ? src[(size_t)k * ld] : 0.0f; }
#pragma unroll
    for (int i = 0; i < 32; ++i) { const int kk = 2 * i + (lane >> 5); scr[kk * 33 + (lane & 31)] = gain ? tv[i] * gain[k0 + kk] : tv[i]; }
    LDS_WAIT(); asm volatile("" ::: "memory");
    const int c = lane & 7;
#pragma unroll
    for (int j = 0; j < 4; ++j) { const int n = (lane >> 3) + 8 * j; const LAS float* sp = scr + (8 * c) * 33 + n;
        v4u o; o.x = pk2(sp[0 * 33], sp[1 * 33]); o.y = pk2(sp[2 * 33], sp[3 * 33]); o.z = pk2(sp[4 * 33], sp[5 * 33]); o.w = pk2(sp[6 * 33], sp[7 * 33]);
        *(v4u*)(dst + (size_t)(p0 + n) * K + k0 + 8 * c) = o; }
    LDS_WAIT(); asm volatile("" ::: "memory");
}
template <int MAT> __device__ __forceinline__ void conv_mat(const Frame& F) {
    constexpr int NITEMS = (MatInfo<MAT>::NP / 32) * (MatInfo<MAT>::K / 64);
    const int gw = F.vcu * NWAVES + F.wave, NGW = F.G * NWAVES;
    LAS float* scr = (LAS float*)(F.lds + F.wave * 16384);
    for (int it = gw; it < NITEMS; it += NGW) conv_item<MAT>(F, it, F.lane, scr);
}

template <int MAT> __device__ __forceinline__ void conv8_mat(const Frame& F, unsigned char* dst8, float* SB, int wg_shift) {
    constexpr int K = MatInfo<MAT>::K, KPT = K / 16;
    static_assert(K == 1024 || K == 256, "conv8: K = 1024 or 256");
    constexpr int NITEMS = MatInfo<MAT>::NP / 32;
    int t_ = threadIdx.x; asm volatile("" : "+v"(t_));
    const int tid = t_, nl = tid & 31, kg = tid >> 5;
    LAS float* red = (LAS float*)F.lds;
    int first = F.vcu - wg_shift; if (first < 0) first += F.G;
    for (int it = first; it < NITEMS; it += F.G) {
        const int p = it * 32 + nl;
        const float* src; size_t ld; const float* gain; int kvalid; conv_map<MAT>(F, p, src, ld, gain, kvalid);
        float tv[KPT];
#pragma unroll
        for (int i = 0; i < KPT; ++i) tv[i] = (src && kg * KPT + i < kvalid) ? src[(size_t)(kg * KPT + i) * ld] : 0.0f;
        float mx = 0.f;
#pragma unroll
        for (int i = 0; i < KPT; ++i) { if (gain) tv[i] *= gain[kg * KPT + i]; mx = fmaxf(mx, fabsf(tv[i])); }
        red[kg * 32 + nl] = mx;
        __syncthreads();
        float cm = 0.f;
#pragma unroll
        for (int i = 0; i < 16; ++i) cm = fmaxf(cm, red[i * 32 + nl]);
        const float inv = cm > 0.f ? 127.0f / cm : 0.f;
        if (kg == 0) SB[p] = cm * (1.0f / 127.0f);
        unsigned char* dp = dst8 + (size_t)p * K + kg * KPT;
#pragma unroll
        for (int i = 0; i < KPT / 16; ++i) { v4u o;
            o.x = q8pack(tv[16 * i + 0] * inv, tv[16 * i + 1] * inv, tv[16 * i + 2] * inv, tv[16 * i + 3] * inv); o.y = q8pack(tv[16 * i + 4] * inv, tv[16 * i + 5] * inv, tv[16 * i + 6] * inv, tv[16 * i + 7] * inv);
            o.z = q8pack(tv[16 * i + 8] * inv, tv[16 * i + 9] * inv, tv[16 * i + 10] * inv, tv[16 * i + 11] * inv); o.w = q8pack(tv[16 * i + 12] * inv, tv[16 * i + 13] * inv, tv[16 * i + 14] * inv, tv[16 * i + 15] * inv);
            *(v4u*)(dp + 16 * i) = o; }
        __syncthreads();
    }
}

__device__ __forceinline__ void conv13_db(const Frame& F) {
    constexpr int NITEMS = MatInfo<M_W13>::NP / 16;
    int t_ = threadIdx.x; asm volatile("" : "+v"(t_));
    const int tid = t_, nl = tid & 15, kg = tid >> 4;
    LAS float* red = (LAS float*)F.lds; unsigned char* dst8 = F.ws + WS_W13; float* SB = WSP(float, WS_SB13);
    if (NITEMS % (2 * F.G) != 0) { conv8_mat<M_W13>(F, dst8, SB, 0); return; }
    const float* gain = F.in[I_LNMOE] + kg * 32;
#define C13_LOAD(tv_, it_) do { const float* src_; size_t ld_; const float* g_; int kv_; conv_map<M_W13>(F, (it_) * 16 + nl, src_, ld_, g_, kv_); \
        _Pragma("unroll") for (int i_ = 0; i_ < 32; ++i_) tv_[i_] = src_[(size_t)(kg * 32 + i_) * ld_]; } while (0)
#define C13_PROC(tv_, it_) do { const int p_ = (it_) * 16 + nl; float mx_ = 0.f; \
        _Pragma("unroll") for (int i_ = 0; i_ < 32; ++i_) { tv_[i_] *= gain[i_]; mx_ = fmaxf(mx_, fabsf(tv_[i_])); } \
        red[kg * 16 + nl] = mx_; __syncthreads(); float cm_ = 0.f; \
        _Pragma("unroll") for (int i_ = 0; i_ < 32; ++i_) cm_ = fmaxf(cm_, red[i_ * 16 + nl]); \
        const float inv_ = cm_ > 0.f ? 127.0f / cm_ : 0.f; if (kg == 0) SB[p_] = cm_ * (1.0f / 127.0f); \
        unsigned char* dp_ = dst8 + (size_t)p_ * 1024 + kg * 32; \
        _Pragma("unroll") for (int i_ = 0; i_ < 2; ++i_) { v4u o_; \
            o_.x = q8pack(tv_[16 * i_ + 0] * inv_, tv_[16 * i_ + 1] * inv_, tv_[16 * i_ + 2] * inv_, tv_[16 * i_ + 3] * inv_); o_.y = q8pack(tv_[16 * i_ + 4] * inv_, tv_[16 * i_ + 5] * inv_, tv_[16 * i_ + 6] * inv_, tv_[16 * i_ + 7] * inv_); \
            o_.z = q8pack(tv_[16 * i_ + 8] * inv_, tv_[16 * i_ + 9] * inv_, tv_[16 * i_ + 10] * inv_, tv_[16 * i_ + 11] * inv_); o_.w = q8pack(tv_[16 * i_ + 12] * inv_, tv_[16 * i_ + 13] * inv_, tv_[16 * i_ + 14] * inv_, tv_[16 * i_ + 15] * inv_); \
            *(v4u*)(dp_ + 16 * i_) = o_; } \
        __syncthreads(); } while (0)
    float tA[32], tB[32];
    C13_LOAD(tA, F.vcu);
#pragma unroll 1
    for (int it = F.vcu; it < NITEMS; it += 2 * F.G) {
        C13_LOAD(tB, it + F.G); C13_PROC(tA, it);
        if (it + 2 * F.G < NITEMS) C13_LOAD(tA, it + 2 * F.G);
        C13_PROC(tB, it + F.G);
    }
#undef C13_LOAD
#undef C13_PROC
}
__device__ __forceinline__ void conv_w2t_strips(const Frame& F) {
    constexpr int NITEMS = MatInfo<M_W2T>::NP / 32;
    int t_ = threadIdx.x; asm volatile("" : "+v"(t_));
    const int tid = t_, nl = tid & 31, kg = tid >> 5;
    bf16* dst = WSP(bf16, WS_W2T);
    for (int it0 = F.vcu; it0 < NITEMS; it0 += 4 * F.G) {
        float tv[4][16];
#pragma unroll
        for (int q = 0; q < 4; ++q) { const int it = it0 + q * F.G; if (it < NITEMS) { const float* src; size_t ld; const float* g; int kv; conv_map<M_W2T>(F, it * 32 + nl, src, ld, g, kv);
#pragma unroll
            for (int i = 0; i < 16; ++i) tv[q][i] = src[(size_t)(kg * 16 + i) * ld]; } }
#pragma unroll
        for (int q = 0; q < 4; ++q) { const int it = it0 + q * F.G; if (it < NITEMS) { bf16* dp = dst + (size_t)(it * 32 + nl) * 256 + kg * 16;
            v4u o0, o1; o0.x = pk2(tv[q][0], tv[q][1]); o0.y = pk2(tv[q][2], tv[q][3]); o0.z = pk2(tv[q][4], tv[q][5]); o0.w = pk2(tv[q][6], tv[q][7]);
            o1.x = pk2(tv[q][8], tv[q][9]); o1.y = pk2(tv[q][10], tv[q][11]); o1.z = pk2(tv[q][12], tv[q][13]); o1.w = pk2(tv[q][14], tv[q][15]);
            *(v4u*)dp = o0; *(v4u*)(dp + 8) = o1; } }
    }
}

__device__ __forceinline__ void p0_prologue(const Frame& F) {
    #if I8_P1
    conv8_mat<M_WIN>(F, F.ws + WS_WIN, WSP(float, WS_SBIN), 0);
#else
    conv_mat<M_WIN>(F);
#endif
    conv_mat<M_WOAB>(F);
#if I8_QKV
    conv8_mat<M_WUQ>(F, F.ws + WS_WUQ, WSP(float, WS_SBUQ), 160); conv8_mat<M_WUKV>(F, F.ws + WS_WUKV, WSP(float, WS_SBUKV), 184);
#else
    conv_mat<M_WUQ>(F); conv_mat<M_WUKV>(F);
#endif
    conv_mat<M_WOUT>(F);
#if I8_P10
    conv8_mat<M_WPG>(F, F.ws + WS_WPG, WSP(float, WS_SBPG), 192);
#else
    conv_mat<M_WPG>(F);
#endif
#if FUSE_PROJ
    conv8_mat<M_WPP>(F, F.ws + WS_WPP, WSP(float, WS_SBPP), 224);
#else
    conv_mat<M_WPP>(F);
#endif
    const int gt = F.vcu * NTHR + F.tid, NGT = F.G * NTHR;
    for (int i = gt; i < 80 * 1024; i += NGT) { const int j = i & 7, lane_ = (i >> 3) & 63, r = i >> 9, cb = r % 5, ks = r / 5; const int o = 16 * cb + (lane_ & 15), k = 32 * ks + 8 * (lane_ >> 4) + j;
        const float wv = o >= 72 ? 0.f : F.in[I_LNMOE][k] * (o < 8 ? F.in[I_WRG][k * 8 + o] : F.in[I_WRE][k * 64 + (o - 8)]);
        const unsigned h = f2bf(wv); WSP(bf16, WS_WRH)[i] = (bf16)h; WSP(bf16, WS_WRL)[i] = (bf16)f2bf(wv - bf2f(h)); }
    for (int i = gt; i < 80; i += NGT) WSP(float, WS_BR)[i] = i < 8 ? F.in[I_BRG][i] : (i < 72 ? F.in[I_BRE][i - 8] : 0.f);
    for (int i = gt; i < 1024; i += NGT) { const int d = i >> 9, f = i & 511; const float a0 = F.in[I_HGLB][d * 1024 + f], a1 = F.in[I_HGLB][d * 1024 + 512 + f]; WSP(float, WS_LB)[i] = 1.0f / (1.0f + expf(a1 - a0)); }
    for (int i = gt; i < T * 16; i += NGT) { const int t = i >> 4, f = i & 15; const float pos = (float)((const int*)F.in[I_POS])[t]; const float inv = exp2f(-(float)f * (13.287712379549449f / 16.0f));
        const float ang = pos * inv;
        const float kq = rintf(ang * 0.15915494309189535f); float r = fmaf(-kq, 6.28318548202514648f, ang); r = fmaf(-kq, -1.7484555e-7f, r);
        WSP(float, WS_ROPE)[t * 32 + f] = __cosf(r); WSP(float, WS_ROPE)[t * 32 + 16 + f] = __sinf(r); }
    const int gw = F.vcu * NWAVES + F.wave, NGW = F.G * NWAVES;
    for (int m = gw; m < T; m += NGW) {
        const float* xr = F.in[I_X] + (size_t)m * D + F.lane * 8; f32x4 v[4]; float ss = 0.f;
#pragma unroll
        for (int j = 0; j < 2; ++j) { v[2 * j] = *(const f32x4*)(xr + 512 * j); v[2 * j + 1] = *(const f32x4*)(xr + 512 * j + 4); ss += dot4(v[2 * j]) + dot4(v[2 * j + 1]); }
        const float rs = rsqrtf(wave_sum(ss) * (1.0f / D) + EPS);
#if I8_P1
        float mx = 0.f;
#pragma unroll
        for (int i = 0; i < 4; ++i)
#pragma unroll
            for (int j = 0; j < 4; ++j) mx = fmaxf(mx, fabsf(v[i][j]));
        mx = wave_max(mx); const float inv = mx > 0.f ? 127.0f / mx : 0.f;
        if (F.lane == 0) WSP(float, WS_SA1)[m] = mx * rs * (1.0f / 127.0f);
#pragma unroll
        for (int j = 0; j < 2; ++j) { v2u o; o.x = q8pack(v[2 * j][0] * inv, v[2 * j][1] * inv, v[2 * j][2] * inv, v[2 * j][3] * inv); o.y = q8pack(v[2 * j + 1][0] * inv, v[2 * j + 1][1] * inv, v[2 * j + 1][2] * inv, v[2 * j + 1][3] * inv);
            *(v2u*)(F.ws + WS_ACT + (size_t)m * D + F.lane * 8 + 512 * j) = o; }
#else
#pragma unroll
        for (int j = 0; j < 2; ++j) st8(WSP(bf16, WS_ACT) + (size_t)m * D + F.lane * 8 + 512 * j, v[2 * j] * rs, v[2 * j + 1] * rs);
#endif
#if FUSE_PROJ
        { f32x4 p0 = (f32x4){0.f, 0.f, 0.f, 0.f}, p1 = p0; if (F.lane < 32) { const float* pr = F.in[I_P] + (size_t)m * PLE + F.lane * 8; p0 = *(const f32x4*)pr; p1 = *(const f32x4*)(pr + 4); }
          float pm = 0.f;
#pragma unroll
          for (int j = 0; j < 4; ++j) pm = fmaxf(pm, fmaxf(fabsf(p0[j]), fabsf(p1[j])));
          pm = wave_max(pm); const float pinv = pm > 0.f ? 127.0f / pm : 0.f;
          if (F.lane == 0) WSP(float, WS_SAP)[m] = pm * (1.0f / 127.0f);
          if (F.lane < 32) { v2u o; o.x = q8pack(p0[0] * pinv, p0[1] * pinv, p0[2] * pinv, p0[3] * pinv); o.y = q8pack(p1[0] * pinv, p1[1] * pinv, p1[2] * pinv, p1[3] * pinv); *(v2u*)(F.ws + WS_PB + (size_t)m * PLE + F.lane * 8) = o; } }
#else
        if (F.lane < 32) { const float* pr = F.in[I_P] + (size_t)m * PLE + F.lane * 8; st8(WSP(bf16, WS_PB) + (size_t)m * PLE + F.lane * 8, *(const f32x4*)pr, *(const f32x4*)(pr + 4)); }
#endif
    }
}

__device__ __forceinline__ void oa_pass(const Frame& F) {
    const int gw = F.vcu * NWAVES + F.wave, NGW = F.G * NWAVES;
    const bf16* OFp = WSP(bf16, WS_ACT); const bf16* OBp = OFp + (size_t)T * 512; const bf16* OGp = WSP(bf16, WS_OG); bf16* OA = DOP(bf16, DO_OA);
    const int c0 = F.lane * 8; const f32x4 g0 = *(const f32x4*)(F.in[I_HGON] + (c0 & 127)), g1 = *(const f32x4*)(F.in[I_HGON] + (c0 & 127) + 4);
    for (int m = gw; m < T; m += NGW) {
        const size_t off = (size_t)m * 512 + c0;
        const v4u a = *(const v4u*)(OFp + off), b = *(const v4u*)(OBp + off), g = *(const v4u*)(OGp + off);
        f32x4 s0 = up4(a.x, a.y) + up4(b.x, b.y), s1 = up4(a.z, a.w) + up4(b.z, b.w);
        float ss = dot4(s0) + dot4(s1); ss += __shfl_xor(ss, 1); ss += __shfl_xor(ss, 2); ss += __shfl_xor(ss, 4); ss += __shfl_xor(ss, 8);
        const float rs = rsqrtf(ss * (1.0f / 128.0f) + EPS);
        st8(OA + off, s0 * rs * g0 * up4(g.x, g.y), s1 * rs * g1 * up4(g.z, g.w));
    }
}
__device__ __forceinline__ void x3_pass(const Frame& F) {
    const int gw = F.vcu * NWAVES + F.wave, NGW = F.G * NWAVES;
    const bf16* Y0 = WSP(bf16, WS_Y0); const bf16* Y1 = WSP(bf16, WS_Y1); const bf16* X2 = DOP(bf16, DO_X2B); bf16* X3 = WSP(bf16, WS_X3B); unsigned char* HP = F.ws + WS_ACT;
    for (int m = gw; m < T; m += NGW) {
        f32x4 v[4]; float ss = 0.f;
#pragma unroll
        for (int j = 0; j < 2; ++j) { const size_t o = (size_t)m * D + F.lane * 8 + 512 * j; const v4u a = *(const v4u*)(Y0 + o), b = *(const v4u*)(Y1 + o), x = *(const v4u*)(X2 + o);
            v[2 * j] = up4(x.x, x.y) + up4(a.x, a.y) + up4(b.x, b.y); v[2 * j + 1] = up4(x.z, x.w) + up4(a.z, a.w) + up4(b.z, b.w);
            st8(X3 + o, v[2 * j], v[2 * j + 1]); ss += dot4(v[2 * j]) + dot4(v[2 * j + 1]); }
        const float rs = rsqrtf(wave_sum(ss) * (1.0f / D) + EPS);
        float mx = 0.f;
#pragma unroll
        for (int i = 0; i < 4; ++i)
#pragma unroll
            for (int j = 0; j < 4; ++j) mx = fmaxf(mx, fabsf(v[i][j]));
        mx = wave_max(mx); const float inv = mx > 0.f ? 127.0f / mx : 0.f;
        if (F.lane == 0) WSP(float, WS_SA3)[m] = mx * rs * (1.0f / 127.0f);
#pragma unroll
        for (int j = 0; j < 2; ++j) { v2u o; o.x = q8pack(v[2 * j][0] * inv, v[2 * j][1] * inv, v[2 * j][2] * inv, v[2 * j][3] * inv); o.y = q8pack(v[2 * j + 1][0] * inv, v[2 * j + 1][1] * inv, v[2 * j + 1][2] * inv, v[2 * j + 1][3] * inv);
            *(v2u*)(HP + (size_t)m * D + F.lane * 8 + 512 * j) = o; }
    }
}
__device__ __forceinline__ void moe_build_table(const Frame& F) {
    LAS int* tab = (LAS int*)(F.lds + TAB_OFF); LAS int* cnts = tab + 16 + 4 * MAXROWT;
    if (F.tid < NE) cnts[F.tid] = (int)__hip_atomic_load(F.ctl + CW_CNT + 64 * F.tid, RLX_AGENT);
    __syncthreads();
    LAS int* starts = cnts + NE;
    if (F.tid == 0) { int rt = 0; for (int e = 0; e < NE; ++e) { starts[e] = rt; rt += (cnts[e] + 255) >> 8; } tab[0] = rt; }
    __syncthreads();
    if (F.tid < NE) { const int e = F.tid, cnt = cnts[e], nt = (cnt + 255) >> 8, r0 = starts[e];
        for (int lt = 0; lt < nt; ++lt) { const int rt = r0 + lt; tab[16 + 4 * rt] = e; tab[16 + 4 * rt + 1] = e * T + 256 * lt; const int rem = cnt - 256 * lt; tab[16 + 4 * rt + 2] = rem < 256 ? rem : 256; } }
    __syncthreads();
}
#ifndef ATT_OTR
#define ATT_OTR 0
#endif
#ifndef ATT_FIXSM
#define ATT_FIXSM 0
#endif
namespace att {
using f32x16 = __attribute__((ext_vector_type(16))) float;
using s16x4 = __attribute__((ext_vector_type(4))) short;
constexpr int QBLK = 32, KVBLK = 64;
constexpr float SCALE = 0.10206207261596577f;
constexpr float THR = 8.f;
constexpr int SHM_V = 16384, SHM_K = 16384, SHM_ATTN = 2 * SHM_V + 2 * SHM_K + NWAVES * 64 * 4;
#define KSWZ(row, colB) ((row) * 256 + ((colB) ^ (((row) & 7) << 4)))
#define SBAR() __builtin_amdgcn_sched_barrier(0)
__device__ __forceinline__ int crow(int r, int hi) { return (r & 3) + 8 * (r >> 2) + 4 * hi; }
__device__ __forceinline__ unsigned cvtpk(float lo, float hi) { unsigned r; asm volatile("v_cvt_pk_bf16_f32 %0, %1, %2" : "=v"(r) : "v"(lo), "v"(hi)); return r; }
__device__ __forceinline__ void partialSM(f32x16& p0, f32x16& p1, float& m_reg, float& mn, float& alpha) {
    constexpr float C = SCALE * 1.4426950408889634f;
    float pmax = p0[0];
#pragma unroll
    for (int r = 1; r < 16; ++r) pmax = fmaxf(pmax, p0[r]);
#pragma unroll
    for (int r = 0; r < 16; ++r) pmax = fmaxf(pmax, p1[r]);
    { auto rr = __builtin_amdgcn_permlane32_swap(__float_as_uint(pmax), __float_as_uint(pmax), false, false); pmax = fmaxf(__uint_as_float(rr[0]), __uint_as_float(rr[1])); }
    if (__builtin_expect(__all(pmax - m_reg <= THR / SCALE), 1)) { mn = m_reg; alpha = 1.f; }
    else { mn = fmaxf(m_reg, pmax); alpha = __builtin_amdgcn_exp2f((m_reg - mn) * C); m_reg = mn; }
    const float mnC = -mn * C;
#pragma unroll
    for (int r = 0; r < 16; ++r) p0[r] = fmaf(p0[r], C, mnC);
#pragma unroll
    for (int r = 0; r < 16; ++r) p1[r] = fmaf(p1[r], C, mnC);
#pragma unroll
    for (int r = 0; r < 16; ++r) p0[r] = __builtin_amdgcn_exp2f(p0[r]);
}
__device__ __forceinline__ void partialSM_fix(f32x16& p0, f32x16& p1, float mnC) {
    constexpr float C = SCALE * 1.4426950408889634f;
#pragma unroll
    for (int r = 0; r < 16; ++r) p0[r] = fmaf(p0[r], C, mnC);
#pragma unroll
    for (int r = 0; r < 16; ++r) p1[r] = fmaf(p1[r], C, mnC);
#pragma unroll
    for (int r = 0; r < 16; ++r) p0[r] = __builtin_amdgcn_exp2f(p0[r]);
}
__device__ __forceinline__ void finishSM(f32x16& p0, f32x16& p1, float alpha, float& l_reg, bf16x8& pa0, bf16x8& pa1, bf16x8& pa2, bf16x8& pa3) {
#pragma unroll
    for (int r = 0; r < 16; ++r) p1[r] = __builtin_amdgcn_exp2f(p1[r]);
    float ps = 0;
#pragma unroll
    for (int r = 0; r < 16; ++r) ps += p0[r];
#pragma unroll
    for (int r = 0; r < 16; ++r) ps += p1[r];
    { auto rr = __builtin_amdgcn_permlane32_swap(__float_as_uint(ps), __float_as_uint(ps), false, false); ps = __uint_as_float(rr[0]) + __uint_as_float(rr[1]); }
    l_reg = l_reg * alpha + ps;
#define PK4(P, BASE, OUT) do { unsigned a0 = cvtpk(P[BASE + 0], P[BASE + 1]), a1 = cvtpk(P[BASE + 2], P[BASE + 3]);   \
    unsigned b0 = cvtpk(P[BASE + 4], P[BASE + 5]), b1 = cvtpk(P[BASE + 6], P[BASE + 7]);                              \
    auto r0 = __builtin_amdgcn_permlane32_swap(a0, b0, false, false); auto r1 = __builtin_amdgcn_permlane32_swap(a1, b1, false, false); \
    v4u w = {r0[0], r1[0], r0[1], r1[1]}; OUT = __builtin_bit_cast(bf16x8, w); } while (0)
    PK4(p0, 0, pa0); PK4(p0, 8, pa1); PK4(p1, 0, pa2); PK4(p1, 8, pa3);
#undef PK4
}
__device__ __forceinline__ void qkt(f32x16& p0, f32x16& p1, const char* Ks, const bf16x8* qr, int r32, int hi) {
    p0 = f32x16{}; p1 = f32x16{};
#pragma unroll
    for (int d0 = 0; d0 < 6; ++d0) { const int cb = (d0 * 16 + hi * 8) * 2;
        const bf16x8 b0 = *reinterpret_cast<const bf16x8*>(Ks + KSWZ(r32, cb));
        const bf16x8 b1 = *reinterpret_cast<const bf16x8*>(Ks + KSWZ(32 + r32, cb));
        p0 = __builtin_amdgcn_mfma_f32_32x32x16_bf16(b0, qr[d0], p0, 0, 0, 0);
        p1 = __builtin_amdgcn_mfma_f32_32x32x16_bf16(b1, qr[d0], p1, 0, 0, 0); }
}
__device__ __forceinline__ int v_st(int k, int c) { const int kk = (k & ~0xC) | ((k & 4) << 1) | ((k & 8) >> 1); return ((kk >> 3) * 4 + (c >> 5)) * 512 + ((kk & 7) * 32 + (c & 31)) * 2; }
__device__ __forceinline__ int v_rd_base(int lane) { return ((lane & 3) << 3) | (((lane >> 2) & 3) << 6) | (((lane >> 4) & 1) << 5) | (((lane >> 5) & 1) << 8); }
constexpr int v_rd_off(int d0, int ks, int half) { return d0 * 512 + ks * 4096 + half * 2048; }
template <int OFF> __device__ __forceinline__ s16x4 tr_read(int vb) { s16x4 r; asm volatile("ds_read_b64_tr_b16 %0, %1 offset:%2" : "=&v"(r) : "v"(vb), "i"(OFF) : "memory"); return r; }
template <int D0> __device__ __forceinline__ void pv_one(f32x16& od, int vb, bf16x8 pa0, bf16x8 pa1, bf16x8 pa2, bf16x8 pa3) {
    const s16x4 l0 = tr_read<v_rd_off(D0, 0, 0)>(vb), h0 = tr_read<v_rd_off(D0, 0, 1)>(vb), l1 = tr_read<v_rd_off(D0, 1, 0)>(vb), h1 = tr_read<v_rd_off(D0, 1, 1)>(vb);
    const s16x4 l2 = tr_read<v_rd_off(D0, 2, 0)>(vb), h2 = tr_read<v_rd_off(D0, 2, 1)>(vb), l3 = tr_read<v_rd_off(D0, 3, 0)>(vb), h3 = tr_read<v_rd_off(D0, 3, 1)>(vb);
    asm volatile("s_waitcnt lgkmcnt(0)" ::: "memory"); SBAR();
#define PK(L, H) (bf16x8){L[0], L[1], L[2], L[3], H[0], H[1], H[2], H[3]}
    od = __builtin_amdgcn_mfma_f32_32x32x16_bf16(pa0, PK(l0, h0), od, 0, 0, 0);
    od = __builtin_amdgcn_mfma_f32_32x32x16_bf16(pa1, PK(l1, h1), od, 0, 0, 0);
    od = __builtin_amdgcn_mfma_f32_32x32x16_bf16(pa2, PK(l2, h2), od, 0, 0, 0);
    od = __builtin_amdgcn_mfma_f32_32x32x16_bf16(pa3, PK(l3, h3), od, 0, 0, 0);
#undef PK
}
__device__ __forceinline__ void pv_d0(f32x16* o, int vb, bf16x8 pa0, bf16x8 pa1, bf16x8 pa2, bf16x8 pa3) { pv_one<0>(o[0], vb, pa0, pa1, pa2, pa3); pv_one<1>(o[1], vb, pa0, pa1, pa2, pa3); }

__device__ __forceinline__ void attn_unit(const bf16* __restrict__ QM, const bf16* __restrict__ KH, const bf16* __restrict__ VH, bf16* __restrict__ OM, const float* __restrict__ RT, const float* __restrict__ QN,
                                          int t0, int kb, int h, char* lds, const float* __restrict__ KN = nullptr) {
    int tid_ = threadIdx.x; asm volatile("" : "+v"(tid_));
    const int tid = tid_, wid = __builtin_amdgcn_readfirstlane(tid >> 6), lane = tid & 63, r32 = lane & 31, hi = lane >> 5;
    char* V_lds = lds; char* K_lds = lds + 2 * SHM_V;
    float* wsf = (float*)(lds + 2 * SHM_V + 2 * SHM_K) + wid * 64; float* li_l = wsf; float* al_l = wsf + 32;
    float m_reg = -1e30f, l_reg = 0; f32x16 o[2] = {}; bf16x8 qr[6];
    {
        const int tq = t0 + wid * QBLK + r32; const bf16* qp = QM + (size_t)tq * 768 + h * 96 + hi * 8;
        float qf[6][8]; float ss = 0.f;
#pragma unroll
        for (int d0 = 0; d0 < 6; ++d0) { const v4u w = *(const v4u*)(qp + d0 * 16);
            qf[d0][0] = bflo(w.x); qf[d0][1] = bfhi(w.x); qf[d0][2] = bflo(w.y); qf[d0][3] = bfhi(w.y); qf[d0][4] = bflo(w.z); qf[d0][5] = bfhi(w.z); qf[d0][6] = bflo(w.w); qf[d0][7] = bfhi(w.w);
#pragma unroll
            for (int j = 0; j < 8; ++j) ss += qf[d0][j] * qf[d0][j]; }
        { auto rr = __builtin_amdgcn_permlane32_swap(__float_as_uint(ss), __float_as_uint(ss), false, false); ss = __uint_as_float(rr[0]) + __uint_as_float(rr[1]); }
        const float rs = rsqrtf(ss * (1.0f / 96.0f) + EPS);
#pragma unroll
        for (int d0 = 0; d0 < 6; ++d0) { const f32x4 g0 = *(const f32x4*)(QN + d0 * 16 + hi * 8), g1 = *(const f32x4*)(QN + d0 * 16 + hi * 8 + 4);
#pragma unroll
            for (int j = 0; j < 4; ++j) { qf[d0][j] *= rs * g0[j]; qf[d0][4 + j] *= rs * g1[j]; } }
        { const float* rt = RT + (size_t)tq * 32 + hi * 8; const f32x4 c0 = *(const f32x4*)rt, c1 = *(const f32x4*)(rt + 4), s0 = *(const f32x4*)(rt + 16), s1 = *(const f32x4*)(rt + 20);
#pragma unroll
          for (int j = 0; j < 8; ++j) { const float c = j < 4 ? c0[j & 3] : c1[j & 3], s = j < 4 ? s0[j & 3] : s1[j & 3]; const float x1 = qf[4][j], x2 = qf[5][j]; qf[4][j] = x1 * c - x2 * s; qf[5][j] = x2 * c + x1 * s; } }
#pragma unroll
        for (int d0 = 0; d0 < 6; ++d0) { v4u w = {cvtpk(qf[d0][0], qf[d0][1]), cvtpk(qf[d0][2], qf[d0][3]), cvtpk(qf[d0][4], qf[d0][5]), cvtpk(qf[d0][6], qf[d0][7])}; qr[d0] = __builtin_bit_cast(bf16x8, w); }
    }
#if ATT_FIXSM
    float mnC;
    {   float gq = fabsf(QN[lane]), gk = fabsf(KN[lane]); if (lane < 32) { gq = fmaxf(gq, fabsf(QN[64 + lane])); gk = fmaxf(gk, fabsf(KN[64 + lane])); }
#pragma unroll
        for (int o_ = 1; o_ < 64; o_ <<= 1) { gq = fmaxf(gq, __shfl_xor(gq, o_)); gk = fmaxf(gk, __shfl_xor(gk, o_)); }
        const float bound = fminf(96.0f * 1.01f * gq * gk, 60.0f / SCALE);
        mnC = -bound * (SCALE * 1.4426950408889634f); }
#define PSM(p0_, p1_, mn_, al_) do { partialSM_fix(p0_, p1_, mnC); al_ = 1.f; } while (0)
#else
#define PSM(p0_, p1_, mn_, al_) partialSM(p0_, p1_, m_reg, mn_, al_)
#endif
    const int vrow = tid >> 3, vch = tid & 7, k0row = tid / 12, k0ch = tid - 12 * k0row, k1row = (tid + 512) / 12, k1ch = (tid + 512) - 12 * k1row; const bool two = wid < 4;
    const bf16* Kg = KH + ((size_t)kb * 8 + h) * 96; const bf16* Vg = VH + ((size_t)kb * 8 + h) * 64;
    const int vst0 = v_st(vrow, vch * 8), kst0 = KSWZ(k0row, k0ch * 16), kst1 = KSWZ(k1row, k1ch * 16);
    const int vb0 = (int)(uintptr_t)V_lds + v_rd_base(lane);
    struct { bf16x8 vs, ks0, ks1; } sr_[2];
#define SLOAD(i, kk) do { sr_[i].vs = *(const bf16x8*)(Vg + (size_t)((kk) + vrow) * 512 + vch * 8); sr_[i].ks0 = *(const bf16x8*)(Kg + (size_t)((kk) + k0row) * 768 + k0ch * 8); \
    if (two) sr_[i].ks1 = *(const bf16x8*)(Kg + (size_t)((kk) + k1row) * 768 + k1ch * 8); } while (0)
#define SWRITE(b, i) do { *(bf16x8*)(V_lds + (b) * SHM_V + vst0) = sr_[i].vs; *(bf16x8*)(K_lds + (b) * SHM_K + kst0) = sr_[i].ks0; if (two) *(bf16x8*)(K_lds + (b) * SHM_K + kst1) = sr_[i].ks1; } while (0)
#define SWAIT() do { if (two) asm volatile("s_waitcnt vmcnt(3)" ::: "memory"); else asm volatile("s_waitcnt vmcnt(2)" ::: "memory"); } while (0)
#if ATT_FIXSM
#define RESC(a) do { } while (0)
#else
#define RESC(a) do { if (__any((a) < 1.f)) { if (hi == 0) al_l[r32] = (a); asm volatile("s_waitcnt lgkmcnt(0)" ::: "memory"); \
    _Pragma("unroll") for (int d = 0; d < 2; ++d) _Pragma("unroll") for (int r = 0; r < 16; ++r) o[d][r] *= al_l[crow(r, hi)]; } } while (0)
#endif
    f32x16 pA0, pA1, pB0, pB1; float mnA, mnB, alA, alB; bf16x8 pa0, pa1, pa2, pa3; constexpr int NT = SEQ / KVBLK;
    SLOAD(0, 0); asm volatile("s_waitcnt vmcnt(0)" ::: "memory"); SWRITE(0, 0); __syncthreads();
    qkt(pA0, pA1, K_lds, qr, r32, hi); PSM(pA0, pA1, mnA, alA);
    SLOAD(1, KVBLK); SLOAD(0, 2 * KVBLK);
    SWAIT(); SWRITE(1, 1); __syncthreads();
    for (int j = 1; j + 1 < NT; j += 2) {
        SBAR(); qkt(pB0, pB1, K_lds + SHM_K, qr, r32, hi);
        finishSM(pA0, pA1, alA, l_reg, pa0, pa1, pa2, pa3); SBAR();
        SLOAD(1, (j + 2) * KVBLK); SBAR();
        pv_d0(o, vb0, pa0, pa1, pa2, pa3); PSM(pB0, pB1, mnB, alB);
        __syncthreads(); SWAIT(); SWRITE(0, 0);
        RESC(alB); __syncthreads();
        SBAR(); qkt(pA0, pA1, K_lds, qr, r32, hi);
        finishSM(pB0, pB1, alB, l_reg, pa0, pa1, pa2, pa3); SBAR();
        if (j + 3 < NT) SLOAD(0, (j + 3) * KVBLK); SBAR();
        pv_d0(o, vb0 + SHM_V, pa0, pa1, pa2, pa3); PSM(pA0, pA1, mnA, alA);
        __syncthreads(); SWAIT(); SWRITE(1, 1);
        RESC(alA); __syncthreads();
    }
    SBAR(); qkt(pB0, pB1, K_lds + SHM_K, qr, r32, hi);
    finishSM(pA0, pA1, alA, l_reg, pa0, pa1, pa2, pa3); SBAR();
    pv_d0(o, vb0, pa0, pa1, pa2, pa3); PSM(pB0, pB1, mnB, alB);
    __syncthreads(); RESC(alB);
    finishSM(pB0, pB1, alB, l_reg, pa0, pa1, pa2, pa3); SBAR();
    pv_d0(o, vb0 + SHM_V, pa0, pa1, pa2, pa3);
    if (hi == 0) li_l[r32] = l_reg; asm volatile("s_waitcnt lgkmcnt(0)" ::: "memory");
    bf16* Ow = OM + (size_t)(t0 + wid * QBLK) * 512 + h * 64;
#if ATT_OTR
    {
        char* ot = lds + 73728 + wid * 4608;
#pragma unroll
        for (int r = 0; r < 16; ++r) { const int orow = crow(r, hi); const float rl = __builtin_amdgcn_rcpf(li_l[orow]);
#pragma unroll
            for (int d0 = 0; d0 < 2; ++d0) *(unsigned short*)(ot + orow * 144 + (d0 * 32 + r32) * 2) = (unsigned short)f2bf(o[d0][r] * rl); }
        asm volatile("s_waitcnt lgkmcnt(0)" ::: "memory");
        const int orow = lane >> 1, oh = lane & 1;
#pragma unroll
        for (int k = 0; k < 4; ++k) *(v4u*)(Ow + (size_t)orow * 512 + oh * 32 + 8 * k) = *(const v4u*)(ot + orow * 144 + oh * 64 + 16 * k);
    }
#else
#pragma unroll
    for (int r = 0; r < 16; ++r) { const int orow = crow(r, hi); const float rl = __builtin_amdgcn_rcpf(li_l[orow]);
#pragma unroll
        for (int d0 = 0; d0 < 2; ++d0) Ow[(size_t)orow * 512 + d0 * 32 + r32] = (bf16)f2bf(o[d0][r] * rl); }
#endif
    asm volatile("s_waitcnt vmcnt(0)" ::: "memory");
    __syncthreads();
#undef SLOAD
#undef SWRITE
#undef SWAIT
#undef RESC
#undef PSM
}
#undef KSWZ
#undef SBAR
}
__device__ __forceinline__ void attn_fast(const Frame& F) {
    const bf16* QM = WSP(bf16, WS_QM); const bf16* KH = WSP(bf16, WS_KH); const bf16* VH = WSP(bf16, WS_VH); bf16* OM = DOP(bf16, DO_OM);
    for (int item = F.vcu; item < NB * MH * 8; item += F.G) {
        const int qb = item & 7, h = (item >> 3) & 7, b = item >> 6;
        att::attn_unit(QM, KH, VH, OM, WSP(float, WS_ROPE), F.in[I_QN], b * SEQ + qb * 256, b * SEQ, h, (char*)F.gl);
    }
}
namespace hg {
typedef short v4i16_t __attribute__((ext_vector_type(4)));
constexpr int IN_BYTES = 40960, OFF_Q = 0, OFF_K = 16384, OFF_V = 32768, OFF_P = 2 * IN_BYTES, OFF_MT = OFF_P + 8192;
__device__ __forceinline__ unsigned off256(unsigned row, unsigned ch) { return 256u * row + 16u * (ch ^ (((row & 3) << 2) | ((row >> 2) & 3))); }
__device__ __forceinline__ unsigned off128(unsigned row, unsigned ch) { return 128u * row + 16u * (ch ^ (row & 7)); }
__device__ __forceinline__ bf16x8 ldrow(const LAS unsigned char* p) { return *(const LAS bf16x8*)p; }
__device__ __forceinline__ bf16x8 ldtr(const LAS unsigned char* p0, const LAS unsigned char* p1) {
    const v4i16_t a = __builtin_amdgcn_ds_read_tr16_b64_v4i16((LAS v4i16_t*)p0), b = __builtin_amdgcn_ds_read_tr16_b64_v4i16((LAS v4i16_t*)p1);
    return (bf16x8){a[0], a[1], a[2], a[3], b[0], b[1], b[2], b[3]};
}
}
__device__ __forceinline__ void hgrn_fast(const Frame& F) {
    using namespace hg;
    int tid_ = threadIdx.x; asm volatile("" : "+v"(tid_));
    const int tid = tid_, lane = tid & 63, w = __builtin_amdgcn_readfirstlane(tid >> 6), l15 = lane & 15, g = lane >> 4, q4 = (lane & 15) >> 2, p4 = lane & 3;
    const LAS unsigned char* L = F.lds;
    const unsigned qrow0 = tid >> 4, qch = tid & 15, qrow1 = qrow0 + 32, vrow = tid >> 3, vch = tid & 7;
    const unsigned sq0 = off256(qrow0, qch), sq1 = off256(qrow1, qch), sv = off128(vrow, vch);
    const int tb = w >> 1, sb0 = 2 * (w & 1);
    for (int item = blockIdx.x; item < NB * HGH * 2 * 2; item += F.G) {
        const int vh = item & 1, dir = (item >> 1) & 1, hh = (item >> 2) & 3, b = item >> 4;
        const bf16* Qd = DOP(bf16, dir ? DO_QB : DO_QF) + hh * 128 + qch * 8; const bf16* Kd = DOP(bf16, dir ? DO_KB : DO_KF) + hh * 128 + qch * 8;
        const bf16* Va = WSP(bf16, WS_VA) + hh * 128 + vh * 64 + vch * 8;
        bf16* Od = WSP(bf16, WS_ACT) + (dir ? (size_t)T * 512 : (size_t)0) + hh * 128 + vh * 64;
        const float* ER = WSP(float, WS_EREF) + (size_t)dir * NCHUNK * 512 + hh * 128 + 16 * w + 4 * g; const float* EL = WSP(float, WS_ELAST) + (size_t)dir * NCHUNK * 512 + hh * 128 + 16 * w + 4 * g;
#define HG_BAR() asm volatile("s_waitcnt lgkmcnt(0)\n\ts_barrier" ::: "memory")
        f32x4 M[4];
#pragma unroll
        for (int i = 0; i < 4; ++i) M[i] = (f32x4){0.f, 0.f, 0.f, 0.f};
        v4u rq0, rq1, rk0, rk1, rv;
#define HG_LOAD(gc_) do { const size_t t0_ = (size_t)(gc_) * 64; rq0 = *(const v4u*)(Qd + (t0_ + qrow0) * 512); rq1 = *(const v4u*)(Qd + (t0_ + qrow1) * 512); \
        rk0 = *(const v4u*)(Kd + (t0_ + qrow0) * 512); rk1 = *(const v4u*)(Kd + (t0_ + qrow1) * 512); rv = *(const v4u*)(Va + (t0_ + vrow) * 512); } while (0)
#define HG_WRITE(buf_) do { LAS unsigned char* B_ = (LAS unsigned char*)L + (buf_) * IN_BYTES; *(LAS v4u*)(B_ + OFF_Q + sq0) = rq0; *(LAS v4u*)(B_ + OFF_Q + sq1) = rq1; \
        *(LAS v4u*)(B_ + OFF_K + sq0) = rk0; *(LAS v4u*)(B_ + OFF_K + sq1) = rk1; *(LAS v4u*)(B_ + OFF_V + sv) = rv; } while (0)
        __syncthreads();
        { const int c0 = dir ? 31 : 0; HG_LOAD(b * 32 + c0); HG_WRITE(0); }
        __syncthreads();
        for (int cc = 0; cc < 32; ++cc) {
            const int c = dir ? 31 - cc : cc, gc = b * 32 + c, cn = dir ? c - 1 : c + 1, buf = cc & 1; const bool has = cc < 31;
            const LAS unsigned char* Bq = L + buf * IN_BYTES + OFF_Q; const LAS unsigned char* Bk = L + buf * IN_BYTES + OFF_K; const LAS unsigned char* Bv = L + buf * IN_BYTES + OFF_V;
            if (has) HG_LOAD(b * 32 + cn);
            f32x4 dv = (f32x4){0.f, 0.f, 0.f, 0.f};
            if (has) dv = *(const f32x4*)(EL + (size_t)gc * 512) * *(const f32x4*)(ER + (size_t)(b * 32 + cn) * 512);
            bf16x8 qfr[4];
            {
                f32x4 pa[2] = {(f32x4){0.f, 0.f, 0.f, 0.f}, (f32x4){0.f, 0.f, 0.f, 0.f}};
#pragma unroll
                for (int ks = 0; ks < 4; ++ks) { qfr[ks] = ldrow(Bq + off256(16 * tb + l15, 4 * ks + g));
#pragma unroll
                    for (int i = 0; i < 2; ++i) { const bf16x8 kf = ldrow(Bk + off256(16 * (sb0 + i) + l15, 4 * ks + g)); pa[i] = __builtin_amdgcn_mfma_f32_16x16x32_bf16(kf, qfr[ks], pa[i], 0, 0, 0); } }
                const int t = 16 * tb + l15;
#pragma unroll
                for (int i = 0; i < 2; ++i) { const int s0 = 16 * (sb0 + i) + 4 * g; f32x4 v = pa[i];
#pragma unroll
                    for (int r = 0; r < 4; ++r) { const bool ok = dir ? (s0 + r >= t) : (s0 + r <= t); v[r] = ok ? v[r] : 0.f; }
                    v2u pk; pk.x = pk2(v[0], v[1]); pk.y = pk2(v[2], v[3]);
                    *(LAS v2u*)((LAS unsigned char*)L + OFF_P + off128(t, 2 * (sb0 + i) + (g >> 1)) + (g & 1) * 8) = pk; }
#pragma unroll
                for (int vb = 0; vb < 4; ++vb) { v2u pk; pk.x = pk2(M[vb][0], M[vb][1]); pk.y = pk2(M[vb][2], M[vb][3]);
                    *(LAS v2u*)((LAS unsigned char*)L + OFF_MT + off256(16 * vb + l15, 2 * w + (g >> 1)) + (g & 1) * 8) = pk; }
            }
            HG_BAR();
            {
                f32x4 oa[2] = {(f32x4){0.f, 0.f, 0.f, 0.f}, (f32x4){0.f, 0.f, 0.f, 0.f}};
#pragma unroll
                for (int ks = 0; ks < 2; ++ks) { const bf16x8 pf = ldrow(L + OFF_P + off128(16 * tb + l15, 4 * ks + g));
#pragma unroll
                    for (int i = 0; i < 2; ++i) { const unsigned c = sb0 + i;
                        const bf16x8 vf = ldtr(Bv + off128(32 * ks + 8 * g + q4, 2 * c + (p4 >> 1)) + 8 * (p4 & 1), Bv + off128(32 * ks + 8 * g + 4 + q4, 2 * c + (p4 >> 1)) + 8 * (p4 & 1));
                        oa[i] = __builtin_amdgcn_mfma_f32_16x16x32_bf16(vf, pf, oa[i], 0, 0, 0); } }
#pragma unroll
                for (int ks = 0; ks < 4; ++ks) {
#pragma unroll
                    for (int i = 0; i < 2; ++i) { const bf16x8 mf = ldrow(L + OFF_MT + off256(16 * (sb0 + i) + l15, 4 * ks + g)); oa[i] = __builtin_amdgcn_mfma_f32_16x16x32_bf16(mf, qfr[ks], oa[i], 0, 0, 0); } }
                const size_t orow = ((size_t)gc * 64 + 16 * tb + l15) * 512;
#pragma unroll
                for (int i = 0; i < 2; ++i) st4(Od + orow + 16 * (sb0 + i) + 4 * g, oa[i]);
#pragma unroll
                for (int ks = 0; ks < 2; ++ks) {
                    const bf16x8 kf = ldtr(Bk + off256(32 * ks + 8 * g + q4, 2 * w + (p4 >> 1)) + 8 * (p4 & 1), Bk + off256(32 * ks + 8 * g + 4 + q4, 2 * w + (p4 >> 1)) + 8 * (p4 & 1));
#pragma unroll
                    for (int vb = 0; vb < 4; ++vb) {
                        const bf16x8 vf = ldtr(Bv + off128(32 * ks + 8 * g + q4, 2 * vb + (p4 >> 1)) + 8 * (p4 & 1), Bv + off128(32 * ks + 8 * g + 4 + q4, 2 * vb + (p4 >> 1)) + 8 * (p4 & 1));
                        M[vb] = __builtin_amdgcn_mfma_f32_16x16x32_bf16(kf, vf, M[vb], 0, 0, 0); } }
#pragma unroll
                for (int vb = 0; vb < 4; ++vb) M[vb] = M[vb] * dv;
            }
            if (has) HG_WRITE(buf ^ 1);
            HG_BAR();
        }
#undef HG_LOAD
#undef HG_WRITE
#undef HG_BAR
    }
}
namespace hg2 {
constexpr int QKB = 32768, H2_V = 3 * QKB, H2_P = H2_V + 2 * 8192, H2_D = TAB_OFF;
}
__device__ __forceinline__ void hgrn_fast2(const Frame& F) {
    using namespace hg; using namespace hg2;
    const int w = __builtin_amdgcn_readfirstlane((int)threadIdx.x >> 6);
    const LAS unsigned char* L = F.lds; LAS unsigned char* Lw = (LAS unsigned char*)F.lds;
#define HG_BAR() asm volatile("s_waitcnt lgkmcnt(0)\n\ts_barrier" ::: "memory")
#define CH(cc_) (dir ? 31 - (cc_) : (cc_))
    for (int item = blockIdx.x; item < NB * HGH * 2 * 2; item += F.G) {
        const int vh = item & 1, dir = (item >> 1) & 1, hh = (item >> 2) & 3, b = item >> 4;
        __syncthreads();
        if (w < 4) {
            int t_ = threadIdx.x; asm volatile("" : "+v"(t_));
            const int lane = t_ & 63, l15 = lane & 15, g = lane >> 4, q4 = (lane & 15) >> 2, p4 = lane & 3;
            bf16* Od = WSP(bf16, WS_ACT) + (dir ? (size_t)T * 512 : (size_t)0) + hh * 128 + vh * 64 + 16 * w + 4 * g;
            f32x4 Mb[8];
#pragma unroll
            for (int i = 0; i < 8; ++i) Mb[i] = (f32x4){0.f, 0.f, 0.f, 0.f};
            HG_BAR(); HG_BAR();
#pragma unroll 1
            for (int cc = 0; cc < 32; ++cc) {
                const LAS unsigned char* Bq = L + (cc % 3) * QKB; const LAS unsigned char* Bk = Bq + 16384; const LAS unsigned char* Bv = L + H2_V + (cc & 1) * 8192; const LAS unsigned char* Bp = L + H2_P + (cc & 1) * 8192;
                const int gc = b * 32 + CH(cc);
                bf16x8 vf[2];
#pragma unroll
                for (int ks = 0; ks < 2; ++ks) vf[ks] = ldtr(Bv + off128(32 * ks + 8 * g + q4, 2 * w + (p4 >> 1)) + 8 * (p4 & 1), Bv + off128(32 * ks + 8 * g + 4 + q4, 2 * w + (p4 >> 1)) + 8 * (p4 & 1));
                f32x4 oa[4];
#pragma unroll
                for (int tb = 0; tb < 4; ++tb) oa[tb] = (f32x4){0.f, 0.f, 0.f, 0.f};
#pragma unroll
                for (int tb = 0; tb < 4; ++tb)
#pragma unroll
                    for (int ks = 0; ks < 2; ++ks) { const bf16x8 pf = ldrow(Bp + off128(16 * tb + l15, 4 * ks + g)); oa[tb] = __builtin_amdgcn_mfma_f32_16x16x32_bf16(vf[ks], pf, oa[tb], 0, 0, 0); }
#pragma unroll
                for (int ks = 0; ks < 4; ++ks) { v4u mw; mw.x = pk2(Mb[2 * ks][0], Mb[2 * ks][1]); mw.y = pk2(Mb[2 * ks][2], Mb[2 * ks][3]); mw.z = pk2(Mb[2 * ks + 1][0], Mb[2 * ks + 1][1]); mw.w = pk2(Mb[2 * ks + 1][2], Mb[2 * ks + 1][3]);
                    const bf16x8 mf = __builtin_bit_cast(bf16x8, mw);
#pragma unroll
                    for (int tb = 0; tb < 4; ++tb) { const v2u qa = *(const LAS v2u*)(Bq + off256(16 * tb + l15, 4 * ks + (g >> 1)) + 8 * (g & 1)), qb = *(const LAS v2u*)(Bq + off256(16 * tb + l15, 4 * ks + 2 + (g >> 1)) + 8 * (g & 1));
                        v4u qw; qw.x = qa.x; qw.y = qa.y; qw.z = qb.x; qw.w = qb.y;
                        oa[tb] = __builtin_amdgcn_mfma_f32_16x16x32_bf16(mf, __builtin_bit_cast(bf16x8, qw), oa[tb], 0, 0, 0); } }
#ifdef PROBE_HG_LDS
                { unsigned dm = 0;
#pragma unroll
                  for (int ks = 0; ks < 4; ++ks)
#pragma unroll
                    for (int tb = 0; tb < 4; ++tb) { const v2u qa = *(const volatile LAS v2u*)(Bq + off256(16 * tb + l15, 4 * ks + (g >> 1)) + 8 * (g & 1)), qb = *(const volatile LAS v2u*)(Bq + off256(16 * tb + l15, 4 * ks + 2 + (g >> 1)) + 8 * (g & 1)); dm ^= qa.x ^ qa.y ^ qb.x ^ qb.y; }
                  if (dm == 0x12345678u && gc < 0) Od[0] = (bf16)dm; }
#endif
#pragma unroll
                for (int tb = 0; tb < 4; ++tb) st4(Od + ((size_t)gc * 64 + 16 * tb + l15) * 512, oa[tb]);
                if (cc < 31) {
#pragma unroll
                    for (int ks = 0; ks < 2; ++ks)
#pragma unroll
                        for (int cb = 0; cb < 8; ++cb) { const bf16x8 kf = ldtr(Bk + off256(32 * ks + 8 * g + q4, 2 * cb + (p4 >> 1)) + 8 * (p4 & 1), Bk + off256(32 * ks + 8 * g + 4 + q4, 2 * cb + (p4 >> 1)) + 8 * (p4 & 1));
                            Mb[cb] = __builtin_amdgcn_mfma_f32_16x16x32_bf16(kf, vf[ks], Mb[cb], 0, 0, 0); }
#pragma unroll
                    for (int cb = 0; cb < 8; ++cb) Mb[cb] = Mb[cb] * *(const LAS f32x4*)(L + H2_D + (cc & 1) * 512 + (16 * cb + 4 * g) * 4);
                }
                HG_BAR();
            }
        } else {
            int t_ = threadIdx.x; asm volatile("" : "+v"(t_));
            const int lane = t_ & 63, l15 = lane & 15, g = lane >> 4, pt = t_ & 255;
            const bf16* Qd = DOP(bf16, dir ? DO_QB : DO_QF) + hh * 128 + (pt & 15) * 8 + (size_t)(pt >> 4) * 512; const bf16* Kd = DOP(bf16, dir ? DO_KB : DO_KF) + hh * 128 + (pt & 15) * 8 + (size_t)(pt >> 4) * 512;
            const bf16* Va = WSP(bf16, WS_VA) + hh * 128 + vh * 64 + (pt & 7) * 8 + (size_t)(pt >> 3) * 512;
            const float* ER = WSP(float, WS_EREF) + (size_t)dir * NCHUNK * 512 + hh * 128 + (pt & 127); const float* EL = WSP(float, WS_ELAST) + (size_t)dir * NCHUNK * 512 + hh * 128 + (pt & 127);
            const unsigned sq0 = off256(pt >> 4, pt & 15), sv0 = off128(pt >> 3, pt & 7);
            v4u rqA[4], rkA[4], rvA[2], rqB[4], rkB[4], rvB[2]; float elA = 0.f, erA = 0.f, elB = 0.f, erB = 0.f;
#define LOAD_QK(cc_, S) do { const size_t t0_ = (size_t)(b * 32 + CH(cc_)) * 64; _Pragma("unroll") for (int i_ = 0; i_ < 4; ++i_) { rq##S[i_] = *(const v4u*)(Qd + (t0_ + 16 * i_) * 512); rk##S[i_] = *(const v4u*)(Kd + (t0_ + 16 * i_) * 512); } } while (0)
#define LOAD_V(cc_, S) do { const size_t t0_ = (size_t)(b * 32 + CH(cc_)) * 64; _Pragma("unroll") for (int i_ = 0; i_ < 2; ++i_) rv##S[i_] = *(const v4u*)(Va + (t0_ + 32 * i_) * 512); } while (0)
#define WRITE_QK(cc_, S) do { LAS unsigned char* B_ = Lw + ((cc_) % 3) * QKB + sq0; _Pragma("unroll") for (int i_ = 0; i_ < 4; ++i_) { *(LAS v4u*)(B_ + 4096 * i_) = rq##S[i_]; *(LAS v4u*)(B_ + 16384 + 4096 * i_) = rk##S[i_]; } } while (0)
#define WRITE_V(cc_, S) do { LAS unsigned char* B_ = Lw + H2_V + ((cc_) & 1) * 8192 + sv0; _Pragma("unroll") for (int i_ = 0; i_ < 2; ++i_) *(LAS v4u*)(B_ + 4096 * i_) = rv##S[i_]; } while (0)
#define LOAD_D(cc_, S) do { el##S = EL[(size_t)(b * 32 + CH(cc_)) * 512]; er##S = ER[(size_t)(b * 32 + CH((cc_) + 1)) * 512]; } while (0)
#define WRITE_D(cc_, S) do { if (pt < 128) *(LAS float*)(Lw + H2_D + ((cc_) & 1) * 512 + pt * 4) = el##S * er##S; } while (0)
#define MAKE_P(cc_) do { const LAS unsigned char* Bq_ = L + ((cc_) % 3) * QKB; const LAS unsigned char* Bk_ = Bq_ + 16384; LAS unsigned char* Bp_ = Lw + H2_P + ((cc_) & 1) * 8192; const int tb_ = w - 4; \
            f32x4 pa_[4]; _Pragma("unroll") for (int i_ = 0; i_ < 4; ++i_) pa_[i_] = (f32x4){0.f, 0.f, 0.f, 0.f}; \
            _Pragma("unroll") for (int ks_ = 0; ks_ < 4; ++ks_) { const bf16x8 qf_ = ldrow(Bq_ + off256(16 * tb_ + l15, 4 * ks_ + g)); \
                _Pragma("unroll") for (int i_ = 0; i_ < 4; ++i_) { const bf16x8 kf_ = ldrow(Bk_ + off256(16 * i_ + l15, 4 * ks_ + g)); pa_[i_] = __builtin_amdgcn_mfma_f32_16x16x32_bf16(kf_, qf_, pa_[i_], 0, 0, 0); } } \
            const int tt_ = 16 * tb_ + l15; \
            _Pragma("unroll") for (int i_ = 0; i_ < 4; ++i_) { const int s0_ = 16 * i_ + 4 * g; f32x4 v_ = pa_[i_]; \
                _Pragma("unroll") for (int r_ = 0; r_ < 4; ++r_) { const bool ok_ = dir ? (s0_ + r_ >= tt_) : (s0_ + r_ <= tt_); v_[r_] = ok_ ? v_[r_] : 0.f; } \
                v2u pk_; pk_.x = pk2(v_[0], v_[1]); pk_.y = pk2(v_[2], v_[3]); *(LAS v2u*)(Bp_ + off128(tt_, 2 * i_ + (g >> 1)) + (g & 1) * 8) = pk_; } } while (0)
            LOAD_QK(0, A); LOAD_V(0, A); LOAD_D(0, A); LOAD_QK(1, B); WRITE_QK(0, A); WRITE_V(0, A); WRITE_D(0, A); WRITE_QK(1, B);
            LOAD_QK(2, A); LOAD_V(1, A); LOAD_D(1, A); LOAD_QK(3, B); LOAD_V(2, B); LOAD_D(2, B);
            HG_BAR();
            MAKE_P(0);
            HG_BAR();
#define P_STEP(S) do { if (cc + 2 < 32) WRITE_QK(cc + 2, S); if (cc + 1 < 32) WRITE_V(cc + 1, S); if (cc + 2 < 32) WRITE_D(cc + 1, S); \
            if (cc + 4 < 32) LOAD_QK(cc + 4, S); if (cc + 3 < 32) LOAD_V(cc + 3, S); if (cc + 4 < 32) LOAD_D(cc + 3, S); if (cc + 1 < 32) MAKE_P(cc + 1); } while (0)
#pragma unroll 1
            for (int c2 = 0; c2 < 32; c2 += 2) {
                { const int cc = c2; P_STEP(A); HG_BAR(); }
                { const int cc = c2 + 1; P_STEP(B); HG_BAR(); }
            }
#undef P_STEP
#undef LOAD_QK
#undef LOAD_V
#undef WRITE_QK
#undef WRITE_V
#undef LOAD_D
#undef WRITE_D
#undef MAKE_P
        }
    }
#undef CH
#undef HG_BAR
}

typedef float f32x16 __attribute__((ext_vector_type(16)));
__device__ __forceinline__ void hgrn_fast3(const Frame& F) {
    using namespace hg; using namespace hg2;
    const int w = __builtin_amdgcn_readfirstlane((int)threadIdx.x >> 6);
    const LAS unsigned char* L = F.lds; LAS unsigned char* Lw = (LAS unsigned char*)F.lds;
#define HG_BAR() asm volatile("s_waitcnt lgkmcnt(0)\n\ts_barrier" ::: "memory")
#define CH(cc_) (dir ? 31 - (cc_) : (cc_))
    for (int item = blockIdx.x; item < NB * HGH * 2 * 2; item += F.G) {
        const int vh = item & 1, dir = (item >> 1) & 1, hh = (item >> 2) & 3, b = item >> 4;
        __syncthreads();
        if (w < 2) {
            int t_ = threadIdx.x; asm volatile("" : "+v"(t_));
            const int lane = t_ & 63, r32 = lane & 31, h = lane >> 5, blk = (lane >> 4) & 1, q4 = (lane & 15) >> 2, p4 = lane & 3;
            bf16* Od = WSP(bf16, WS_ACT) + (dir ? (size_t)T * 512 : (size_t)0) + hh * 128 + vh * 64 + 32 * w + 4 * h;
            f32x16 Mb[4];
#pragma unroll
            for (int i = 0; i < 4; ++i) Mb[i] = f32x16{};
            HG_BAR(); HG_BAR();
#pragma unroll 1
            for (int cc = 0; cc < 32; ++cc) {
                const LAS unsigned char* Bq = L + (cc % 3) * QKB; const LAS unsigned char* Bk = Bq + 16384; const LAS unsigned char* Bv = L + H2_V + (cc & 1) * 8192; const LAS unsigned char* Bp = L + H2_P + (cc & 1) * 8192;
                const int gc = b * 32 + CH(cc);
                bf16x8 vf[4];
#pragma unroll
                for (int ks = 0; ks < 4; ++ks) vf[ks] = ldtr(Bv + off128(16 * ks + 8 * h + q4, 4 * w + 2 * blk + (p4 >> 1)) + 8 * (p4 & 1), Bv + off128(16 * ks + 8 * h + 4 + q4, 4 * w + 2 * blk + (p4 >> 1)) + 8 * (p4 & 1));
                f32x16 oa[2] = {f32x16{}, f32x16{}};
#pragma unroll
                for (int tb = 0; tb < 2; ++tb)
#pragma unroll
                    for (int ks = 0; ks < 4; ++ks) { const bf16x8 pf = ldrow(Bp + off128(32 * tb + r32, 2 * ks + h)); oa[tb] = __builtin_amdgcn_mfma_f32_32x32x16_bf16(vf[ks], pf, oa[tb], 0, 0, 0); }
#pragma unroll
                for (int cb = 0; cb < 4; ++cb)
#pragma unroll
                    for (int s2 = 0; s2 < 2; ++s2) {
                        v4u mw; mw.x = pk2(Mb[cb][8 * s2 + 0], Mb[cb][8 * s2 + 1]); mw.y = pk2(Mb[cb][8 * s2 + 2], Mb[cb][8 * s2 + 3]); mw.z = pk2(Mb[cb][8 * s2 + 4], Mb[cb][8 * s2 + 5]); mw.w = pk2(Mb[cb][8 * s2 + 6], Mb[cb][8 * s2 + 7]);
                        const bf16x8 mf = __builtin_bit_cast(bf16x8, mw);
#pragma unroll
                        for (int tb = 0; tb < 2; ++tb) { const v2u qa = *(const LAS v2u*)(Bq + off256(32 * tb + r32, 4 * cb + 2 * s2) + 8 * h), qb = *(const LAS v2u*)(Bq + off256(32 * tb + r32, 4 * cb + 2 * s2 + 1) + 8 * h);
                            v4u qw; qw.x = qa.x; qw.y = qa.y; qw.z = qb.x; qw.w = qb.y;
                            oa[tb] = __builtin_amdgcn_mfma_f32_32x32x16_bf16(mf, __builtin_bit_cast(bf16x8, qw), oa[tb], 0, 0, 0); } }
#pragma unroll
                for (int tb = 0; tb < 2; ++tb)
#pragma unroll
                    for (int i = 0; i < 4; ++i) st4(Od + ((size_t)gc * 64 + 32 * tb + r32) * 512 + 8 * i, (f32x4){oa[tb][4 * i], oa[tb][4 * i + 1], oa[tb][4 * i + 2], oa[tb][4 * i + 3]});
                if (cc < 31) {
#pragma unroll
                    for (int ks = 0; ks < 4; ++ks)
#pragma unroll
                        for (int cb = 0; cb < 4; ++cb) { const bf16x8 kf = ldtr(Bk + off256(16 * ks + 8 * h + q4, 4 * cb + 2 * blk + (p4 >> 1)) + 8 * (p4 & 1), Bk + off256(16 * ks + 8 * h + 4 + q4, 4 * cb + 2 * blk + (p4 >> 1)) + 8 * (p4 & 1));
                            Mb[cb] = __builtin_amdgcn_mfma_f32_32x32x16_bf16(kf, vf[ks], Mb[cb], 0, 0, 0); }
#pragma unroll
                    for (int cb = 0; cb < 4; ++cb)
#pragma unroll
                        for (int i = 0; i < 4; ++i) { const f32x4 dv = *(const LAS f32x4*)(L + H2_D + (cc & 1) * 512 + (32 * cb + 8 * i + 4 * h) * 4);
#pragma unroll
                            for (int e = 0; e < 4; ++e) Mb[cb][4 * i + e] *= dv[e]; }
                }
                HG_BAR();
            }
        } else if (w < 4) {
            HG_BAR(); HG_BAR();
#pragma unroll 1
            for (int cc = 0; cc < 32; ++cc) HG_BAR();
        } else {
            int t_ = threadIdx.x; asm volatile("" : "+v"(t_));
            const int lane = t_ & 63, r32 = lane & 31, h = lane >> 5, pt = t_ & 255;
            const bf16* Qd = DOP(bf16, dir ? DO_QB : DO_QF) + hh * 128 + (pt & 15) * 8 + (size_t)(pt >> 4) * 512; const bf16* Kd = DOP(bf16, dir ? DO_KB : DO_KF) + hh * 128 + (pt & 15) * 8 + (size_t)(pt >> 4) * 512;
            const bf16* Va = WSP(bf16, WS_VA) + hh * 128 + vh * 64 + (pt & 7) * 8 + (size_t)(pt >> 3) * 512;
            const float* ER = WSP(float, WS_EREF) + (size_t)dir * NCHUNK * 512 + hh * 128 + (pt & 127); const float* EL = WSP(float, WS_ELAST) + (size_t)dir * NCHUNK * 512 + hh * 128 + (pt & 127);
            const unsigned sq0 = off256(pt >> 4, pt & 15), sv0 = off128(pt >> 3, pt & 7);
            v4u rqA[4], rkA[4], rvA[2], rqB[4], rkB[4], rvB[2]; float elA = 0.f, erA = 0.f, elB = 0.f, erB = 0.f;
#define LOAD_QK(cc_, S) do { const size_t t0_ = (size_t)(b * 32 + CH(cc_)) * 64; _Pragma("unroll") for (int i_ = 0; i_ < 4; ++i_) { rq##S[i_] = *(const v4u*)(Qd + (t0_ + 16 * i_) * 512); rk##S[i_] = *(const v4u*)(Kd + (t0_ + 16 * i_) * 512); } } while (0)
#define LOAD_V(cc_, S) do { const size_t t0_ = (size_t)(b * 32 + CH(cc_)) * 64; _Pragma("unroll") for (int i_ = 0; i_ < 2; ++i_) rv##S[i_] = *(const v4u*)(Va + (t0_ + 32 * i_) * 512); } while (0)
#define WRITE_QK(cc_, S) do { LAS unsigned char* B_ = Lw + ((cc_) % 3) * QKB + sq0; _Pragma("unroll") for (int i_ = 0; i_ < 4; ++i_) { *(LAS v4u*)(B_ + 4096 * i_) = rq##S[i_]; *(LAS v4u*)(B_ + 16384 + 4096 * i_) = rk##S[i_]; } } while (0)
#define WRITE_V(cc_, S) do { LAS unsigned char* B_ = Lw + H2_V + ((cc_) & 1) * 8192 + sv0; _Pragma("unroll") for (int i_ = 0; i_ < 2; ++i_) *(LAS v4u*)(B_ + 4096 * i_) = rv##S[i_]; } while (0)
#define LOAD_D(cc_, S) do { el##S = EL[(size_t)(b * 32 + CH(cc_)) * 512]; er##S = ER[(size_t)(b * 32 + CH((cc_) + 1)) * 512]; } while (0)
#define WRITE_D(cc_, S) do { if (pt < 128) *(LAS float*)(Lw + H2_D + ((cc_) & 1) * 512 + pt * 4) = el##S * er##S; } while (0)
#define MAKE_P(cc_) do { if (w < 6) { const LAS unsigned char* Bq_ = L + ((cc_) % 3) * QKB; const LAS unsigned char* Bk_ = Bq_ + 16384; LAS unsigned char* Bp_ = Lw + H2_P + ((cc_) & 1) * 8192; const int tb_ = w - 4; \
            f32x16 pa_[2] = {f32x16{}, f32x16{}}; \
            _Pragma("unroll") for (int ks_ = 0; ks_ < 8; ++ks_) { const bf16x8 qf_ = ldrow(Bq_ + off256(32 * tb_ + r32, 2 * ks_ + h)); \
                _Pragma("unroll") for (int i_ = 0; i_ < 2; ++i_) { const bf16x8 kf_ = ldrow(Bk_ + off256(32 * i_ + r32, 2 * ks_ + h)); pa_[i_] = __builtin_amdgcn_mfma_f32_32x32x16_bf16(kf_, qf_, pa_[i_], 0, 0, 0); } } \
            const int tt_ = 32 * tb_ + r32; \
            _Pragma("unroll") for (int i_ = 0; i_ < 2; ++i_) _Pragma("unroll") for (int q_ = 0; q_ < 4; ++q_) { const int s0_ = 32 * i_ + 8 * q_ + 4 * h; float v_[4]; \
                _Pragma("unroll") for (int e_ = 0; e_ < 4; ++e_) { const bool ok_ = dir ? (s0_ + e_ >= tt_) : (s0_ + e_ <= tt_); v_[e_] = ok_ ? pa_[i_][4 * q_ + e_] : 0.f; } \
                v2u pk_; pk_.x = pk2(v_[0], v_[1]); pk_.y = pk2(v_[2], v_[3]); *(LAS v2u*)(Bp_ + off128(tt_, 4 * i_ + q_) + 8 * h) = pk_; } } } while (0)
            LOAD_QK(0, A); LOAD_V(0, A); LOAD_D(0, A); LOAD_QK(1, B); WRITE_QK(0, A); WRITE_V(0, A); WRITE_D(0, A); WRITE_QK(1, B);
            LOAD_QK(2, A); LOAD_V(1, A); LOAD_D(1, A); LOAD_QK(3, B); LOAD_V(2, B); LOAD_D(2, B);
            HG_BAR();
            MAKE_P(0);
            HG_BAR();
#define P_STEP(S) do { if (cc + 2 < 32) WRITE_QK(cc + 2, S); if (cc + 1 < 32) WRITE_V(cc + 1, S); if (cc + 2 < 32) WRITE_D(cc + 1, S); \
            if (cc + 4 < 32) LOAD_QK(cc + 4, S); if (cc + 3 < 32) LOAD_V(cc + 3, S); if (cc + 4 < 32) LOAD_D(cc + 3, S); if (cc + 1 < 32) MAKE_P(cc + 1); } while (0)
#pragma unroll 1
            for (int c2 = 0; c2 < 32; c2 += 2) {
                { const int cc = c2; P_STEP(A); HG_BAR(); }
                { const int cc = c2 + 1; P_STEP(B); HG_BAR(); }
            }
#undef P_STEP
#undef LOAD_QK
#undef LOAD_V
#undef WRITE_QK
#undef WRITE_V
#undef LOAD_D
#undef WRITE_D
#undef MAKE_P
        }
    }
#undef CH
#undef HG_BAR
}
template <bool DRY = false> __device__ __forceinline__ void route_fast(const Frame& F) {
    int tid_ = threadIdx.x; asm volatile("" : "+v"(tid_));
    const int tid = tid_, lane = tid & 63, w = __builtin_amdgcn_readfirstlane(tid >> 6), l15 = lane & 15, g = lane >> 4;
    LAS float* lg = (LAS float*)F.lds + w * 16 * 80;
    LAS int* cntL = (LAS int*)(F.lds + 40960); LAS int* baseL = cntL + 64;
    const bf16* WRH = WSP(bf16, WS_WRH); const bf16* WRL = WSP(bf16, WS_WRL); const float* BR = WSP(float, WS_BR);
    const bf16* X2 = DOP(bf16, DO_X2B); int* EIDX = WSP(int, WS_EIDX); float* EW = WSP(float, WS_EW); int* LIST = WSP(int, WS_LIST); float* RS2 = WSP(float, WS_RS2);
    for (int round = 0; round * F.G * 128 < T; ++round) {
        const int m0 = (round * F.G + F.vcu) * 128 + w * 16;
        if (tid < 64) cntL[tid] = 0;
        __syncthreads();
        f32x4 acc[5];
#pragma unroll
        for (int cb = 0; cb < 5; ++cb) acc[cb] = (f32x4){0.f, 0.f, 0.f, 0.f};
        float ss = 0.f;
        const bf16* wh = WRH + lane * 8; const bf16* wl = WRL + lane * 8;
        LAS unsigned char* stg = F.lds + 49152 + w * 8448;
        const int srow = lane >> 5;
        const bf16* xg = X2 + (size_t)(m0 + srow) * 1024 + (lane & 31) * 8;
#if I8_P7
        float mxt; { const f32x4 pm = *(const f32x4*)(WSP(float, WS_XMAX) + (size_t)(m0 + (lane >> 2)) * 16 + (lane & 3) * 4); mxt = fmaxf(fmaxf(pm[0], pm[1]), fmaxf(pm[2], pm[3])); mxt = fmaxf(mxt, __shfl_xor(mxt, 1)); mxt = fmaxf(mxt, __shfl_xor(mxt, 2)); }
        float invr[8];
#pragma unroll
        for (int i_ = 0; i_ < 8; ++i_) { const float mr = __shfl(mxt, 4 * (2 * i_ + srow)); invr[i_] = mr > 0.f ? 127.0f / mr : 0.f; }
        unsigned char* hq = F.ws + WS_ACT + (size_t)(m0 + srow) * 1024 + (lane & 31) * 8;
#endif
        v4u R[8];
#define RT_LOADG(c_) do { _Pragma("unroll") for (int i_ = 0; i_ < 8; ++i_) R[i_] = *(const v4u*)(xg + (size_t)(2 * i_) * 1024 + 256 * (c_)); } while (0)
        RT_LOADG(0);
#pragma unroll 1
        for (int c = 0; c < 4; ++c) {
#pragma unroll
            for (int i_ = 0; i_ < 8; ++i_) { *(LAS v4u*)(stg + (2 * i_ + srow) * 528 + (lane & 31) * 16) = R[i_];
#if I8_P7
                { const f32x4 a = up4(R[i_].x, R[i_].y) * invr[i_], b = up4(R[i_].z, R[i_].w) * invr[i_]; v2u o; o.x = q8pack(a[0], a[1], a[2], a[3]); o.y = q8pack(b[0], b[1], b[2], b[3]);
                  *(v2u*)(hq + (size_t)(2 * i_) * 1024 + 256 * c) = o; }
#endif
            }
            LDS_WAIT(); asm volatile("" ::: "memory");
            if (c < 3) RT_LOADG(c + 1);
#pragma unroll
            for (int h_ = 0; h_ < 4; ++h_) {
                bf16x8 bh[2][5], bl[2][5];
#pragma unroll
                for (int j_ = 0; j_ < 2; ++j_)
#pragma unroll
                    for (int cb = 0; cb < 5; ++cb) { const int ks_ = 8 * c + 2 * h_ + j_; bh[j_][cb] = *(const bf16x8*)(wh + (ks_ * 5 + cb) * 512); bl[j_][cb] = *(const bf16x8*)(wl + (ks_ * 5 + cb) * 512); }
#pragma unroll
                for (int j_ = 0; j_ < 2; ++j_) { const v4u xa = *(const LAS v4u*)(stg + l15 * 528 + 64 * (2 * h_ + j_) + 16 * g);
                    ss = dot2bf(xa.x, xa.x, ss); ss = dot2bf(xa.y, xa.y, ss); ss = dot2bf(xa.z, xa.z, ss); ss = dot2bf(xa.w, xa.w, ss);
                    const bf16x8 xh = __builtin_bit_cast(bf16x8, xa);
#pragma unroll
                    for (int cb = 0; cb < 5; ++cb) {
                        acc[cb] = __builtin_amdgcn_mfma_f32_16x16x32_bf16(xh, bh[j_][cb], acc[cb], 0, 0, 0);
                        acc[cb] = __builtin_amdgcn_mfma_f32_16x16x32_bf16(xh, bl[j_][cb], acc[cb], 0, 0, 0); } }
            }
            LDS_WAIT(); asm volatile("" ::: "memory");
        }
#undef RT_LOADG
        ss += __shfl_xor(ss, 16); ss += __shfl_xor(ss, 32);
        const float rs = rsqrtf(ss * (1.0f / D) + EPS);
#if I8_P7
        { const float ml = __shfl(mxt, 4 * l15); if (g == 0) RS2[m0 + l15] = rs * ml * (1.0f / 127.0f); }
#else
        if (g == 0) RS2[m0 + l15] = rs;
#endif
        float rsr[4];
#pragma unroll
        for (int r = 0; r < 4; ++r) rsr[r] = __shfl(rs, 4 * g + r);
#pragma unroll
        for (int cb = 0; cb < 5; ++cb) { const float bias = BR[16 * cb + l15];
#pragma unroll
            for (int r = 0; r < 4; ++r) lg[(4 * g + r) * 80 + 16 * cb + l15] = acc[cb][r] * rsr[r] + bias; }
        LDS_WAIT(); asm volatile("" ::: "memory");
        int e0 = 0, e1 = 0, r0 = 0, r1 = 0; const int m = m0 + lane;
        if (lane < 16) {
            const LAS float* lt = lg + lane * 80;
            float gl[8];
#pragma unroll
            for (int i = 0; i < 8; ++i) gl[i] = lt[i];
            float gm = gl[0]; int gs = 0;
#pragma unroll
            for (int i = 1; i < 8; ++i) if (gl[i] > gm) { gm = gl[i]; gs = i; }
            float ge = 0.f;
#pragma unroll
            for (int i = 0; i < 8; ++i) ge += __expf(gl[i] - gm);
            const float pg = 1.0f / ge;
            float el[8];
#pragma unroll
            for (int i = 0; i < 8; ++i) el[i] = lt[8 + 8 * gs + i];
            float m1 = el[0]; int i1 = 0;
#pragma unroll
            for (int i = 1; i < 8; ++i) if (el[i] > m1) { m1 = el[i]; i1 = i; }
            float m2 = -3e38f; int i2 = 0;
#pragma unroll
            for (int i = 0; i < 8; ++i) if (i != i1 && el[i] > m2) { m2 = el[i]; i2 = i; }
            const float e2 = __expf(m2 - m1), w0 = pg / (1.0f + e2), w1 = pg * e2 / (1.0f + e2);
            e0 = 8 * gs + i1; e1 = 8 * gs + i2;
            EIDX[m * 2] = e0; EIDX[m * 2 + 1] = e1; EW[m * 2] = w0; EW[m * 2 + 1] = w1;
            if (!DRY) { r0 = __hip_atomic_fetch_add(cntL + e0, 1, __ATOMIC_RELAXED, __HIP_MEMORY_SCOPE_WORKGROUP);
            r1 = __hip_atomic_fetch_add(cntL + e1, 1, __ATOMIC_RELAXED, __HIP_MEMORY_SCOPE_WORKGROUP); }
        }
        __syncthreads();
        if (!DRY && tid < 64) { const int c = cntL[tid]; baseL[tid] = c ? (int)__hip_atomic_fetch_add(F.ctl + CW_CNT + 64 * tid, (unsigned)c, RLX_AGENT) : 0; }
        __syncthreads();
        if (!DRY && lane < 16) { LIST[(size_t)e0 * T + baseL[e0] + r0] = m * 2; LIST[(size_t)e1 * T + baseL[e1] + r1] = m * 2 + 1; }
        __syncthreads();
    }
}
struct Args { const float* in[27]; float* out; unsigned char* ws; int ph_lo, ph_hi, use_bar, pad; };
constexpr int NPHASE = 11;
__device__ __forceinline__ void frame_init(Frame& F, const Args& args, unsigned char* lds) {
    F.lds = (LAS unsigned char*)lds; F.gl = lds;
    F.MISC = (volatile LAS unsigned*)(F.lds + MISC_OFF);
    F.tid = threadIdx.x; F.lane = F.tid & 63; F.wave = __builtin_amdgcn_readfirstlane(F.tid >> 6);
    F.G = gridDim.x; { const int bx = blockIdx.x; F.vcu = (F.G % 8 == 0) ? (bx % 8) * (F.G / 8) + bx / 8 : bx; }
    F.ws = args.ws; F.out = args.out; F.ctl = (gu32*)(args.ws + WS_CTL);
#pragma unroll
    for (int i = 0; i < 27; ++i) F.in[i] = args.in[i];
    for (int u = F.tid; u < 1024 / 4; u += NTHR) ((LAS unsigned*)(F.lds + LDSCTL_OFF))[u] = 0u;
    __syncthreads();
}
template <int PH> __device__ __forceinline__ void run_phase(const Frame& F) {
    if constexpr (PH == 0) { p0_prologue(F); }
    if constexpr (PH == 1) {
#if I8_P1
        Gemm g{WSP(bf16, WS_ACT), WSP(bf16, WS_WIN), 512, nullptr, 0}; StaticOrder S; S.init(T, NIN, F.G, (int)blockIdx.x);
        EpiScaled<EpiIn> E{EpiIn{F.ws, (unsigned char*)F.out, (LAS float*)(F.lds + TAB_OFF)}, WSP(float, WS_SA1), WSP(float, WS_SBIN)};
        gemm_fast<EpiScaled<EpiIn>, StaticOrder, false, GF_ALIGN, GF_SP2, true>(F.lds, g, S, E);
#else
        Gemm g{WSP(bf16, WS_ACT), WSP(bf16, WS_WIN), 1024, nullptr, SKEW_K1024}; StaticOrder S; S.init(T, NIN, F.G, (int)blockIdx.x);
        EpiIn E{F.ws, (unsigned char*)F.out, (LAS float*)(F.lds + TAB_OFF)};
        GEMM_PHASE(EpiIn, StaticOrder, g, S, E);
#endif
    }
    if constexpr (PH == 2) {
#if I8_QKV
        { Gemm g{WSP(bf16, WS_CQ), WSP(bf16, WS_WUQ), 128, nullptr, 0, WSP(bf16, WS_CKVR), WSP(bf16, WS_WUKV), 128}; QKVOrder S; S.init(F.G, (int)blockIdx.x);
          EpiQKV8 E{F.ws, F.in[I_KN]};
          gemm_fast<EpiQKV8, QKVOrder, false, GF_ALIGN, GF_SP2, true, true>(F.lds, g, S, E); }
#elif MERGE_QKV
        { Gemm g{WSP(bf16, WS_CQ), WSP(bf16, WS_WUQ), 256, nullptr, 0, WSP(bf16, WS_CKVR), WSP(bf16, WS_WUKV), 256}; QKVOrder S; S.init(F.G, (int)blockIdx.x);
          EpiQKV E{EpiQ{WSP(bf16, WS_QM), WSP(float, WS_CQSS)}, EpiKV{WSP(bf16, WS_KH), WSP(bf16, WS_VH), WSP(float, WS_CKVSS), WSP(float, WS_KR), WSP(float, WS_ROPE), F.in[I_KN]}};
          gemm_fast<EpiQKV, QKVOrder, false, GF_ALIGN, GF_SP2, false, true>(F.lds, g, S, E); }
#else
        { Gemm g{WSP(bf16, WS_CQ), WSP(bf16, WS_WUQ), 256, nullptr, SKEW_K256}; StaticOrder S; S.init(T, 768, F.G, (int)blockIdx.x); EpiQ E{WSP(bf16, WS_QM), WSP(float, WS_CQSS)}; GEMM_PHASE(EpiQ, StaticOrder, g, S, E); }
        { Gemm g{WSP(bf16, WS_CKVR), WSP(bf16, WS_WUKV), 256, nullptr, SKEW_K256}; StaticOrder S; S.init(T, 1024, F.G, (int)blockIdx.x);
          EpiKV E{WSP(bf16, WS_KH), WSP(bf16, WS_VH), WSP(float, WS_CKVSS), WSP(float, WS_KR), WSP(float, WS_ROPE), F.in[I_KN]}; GEMM_PHASE(EpiKV, StaticOrder, g, S, E); }
#endif
#ifdef PROBE_QKV2
        __syncthreads();
        { Gemm g{WSP(bf16, WS_CQ), WSP(bf16, WS_WUQ), 256, nullptr, SKEW_K256}; StaticOrder S; S.init(T, 768, F.G, (int)blockIdx.x); EpiQ E{WSP(bf16, WS_QM), WSP(float, WS_CQSS)}; GEMM_PHASE(EpiQ, StaticOrder, g, S, E); }
        { Gemm g{WSP(bf16, WS_CKVR), WSP(bf16, WS_WUKV), 256, nullptr, SKEW_K256}; StaticOrder S; S.init(T, 1024, F.G, (int)blockIdx.x);
          EpiKV E{WSP(bf16, WS_KH), WSP(bf16, WS_VH), WSP(float, WS_CKVSS), WSP(float, WS_KR), WSP(float, WS_ROPE), F.in[I_KN]}; GEMM_PHASE(EpiKV, StaticOrder, g, S, E); }
#endif
        HGRN_PHASE(F);
#ifdef PROBE_HGRN2
        __syncthreads(); HGRN_PHASE(F);
#endif
    }
    if constexpr (PH == 3) {
#if STAGGER_CONV
        if (!STAGGER_OA) oa_pass(F);
        const bf16* QM = WSP(bf16, WS_QM); const bf16* KH = WSP(bf16, WS_KH); const bf16* VH = WSP(bf16, WS_VH); bf16* OM = DOP(bf16, DO_OM);
        int it = 0; bool side_done = false;
        for (int item = F.vcu; item < NB * MH * 8; item += F.G, ++it) {
            if (it == (F.vcu & 3)) { side_done = true; __syncthreads(); if (STAGGER_OA) oa_pass(F); conv13_db(F); conv_w2t_strips(F); __syncthreads();
#ifdef PROBE_CONV2
                conv13_db(F); conv_w2t_strips(F); __syncthreads();
#endif
            }
            const int qb = item & 7, h = (item >> 3) & 7, b = item >> 6;
            att::attn_unit(QM, KH, VH, OM, WSP(float, WS_ROPE), F.in[I_QN], b * SEQ + qb * 256, b * SEQ, h, (char*)F.gl, F.in[I_KN]);
        }
        if (!side_done) { __syncthreads(); if (STAGGER_OA) oa_pass(F); conv13_db(F); conv_w2t_strips(F); }
#else
        oa_pass(F); ATTN_PHASE(F);
#endif
    }
    if constexpr (PH == 4) {
        Gemm g{DOP(bf16, DO_OA), WSP(bf16, WS_WOAB), 512, nullptr, SKEW_K512}; PairOrder S; S.init(F.G, (int)blockIdx.x); EpiMerge E{WSP(bf16, WS_ACT), WSP(bf16, WS_GA), WSP(bf16, WS_GB)};
        GEMM_PHASE(EpiMerge, PairOrder, g, S, E);
    }
    if constexpr (PH == 5) {
        Gemm g{WSP(bf16, WS_ACT), WSP(bf16, WS_WOUT), 1024, nullptr, SKEW_K1024}; StaticOrder S; S.init(T, D, F.G, (int)blockIdx.x); EpiX2 E{F.in[I_X], DOP(bf16, DO_X2B), WSP(float, WS_XMAX)};
        GEMM_PHASE(EpiX2, StaticOrder, g, S, E);
    }
    if constexpr (PH == 6) { ROUTE_PHASE(F); __syncthreads();
#if !STAGGER_CONV
#if I8_P7
        conv8_mat<M_W13>(F, F.ws + WS_W13, WSP(float, WS_SB13), 0);
#else
        conv_mat<M_W13>(F);
#endif
        conv_mat<M_W2T>(F);
#endif
    }
    if constexpr (PH == 7) {
        moe_build_table(F);
#if I8_P7
        Gemm g{WSP(bf16, WS_ACT), WSP(bf16, WS_W13), 512, WSP(int, WS_LIST), 0}; MoeOrder S{(const LAS int*)(F.lds + TAB_OFF), 2, F.G, F.vcu};
        EpiScaled<EpiUp, false> E{EpiUp{WSP(bf16, WS_H1), WSP(int, WS_LIST), WSP(float, WS_RS2)}, nullptr, WSP(float, WS_SB13)};
        gemm_fast<EpiScaled<EpiUp, false>, MoeOrder, true, GF_ALIGN, GF_SP2, true>(F.lds, g, S, E);
#else
        Gemm g{DOP(bf16, DO_X2B), WSP(bf16, WS_W13), 1024, WSP(int, WS_LIST), SKEW_K1024}; MoeOrder S{(const LAS int*)(F.lds + TAB_OFF), 2, F.G, F.vcu}; EpiUp E{WSP(bf16, WS_H1), WSP(int, WS_LIST), WSP(float, WS_RS2)};
        GEMM_PHASE_GATHER(EpiUp, MoeOrder, g, S, E);
#endif
    }
    if constexpr (PH == 8) {
#if N_LAUNCHES != 1
        moe_build_table(F);
#endif
        Gemm g{WSP(bf16, WS_H1), WSP(bf16, WS_W2T), 256, nullptr, SKEW_K256}; MoeOrder S{(const LAS int*)(F.lds + TAB_OFF), 4, F.G, F.vcu}; EpiDown E{WSP(bf16, WS_Y0), WSP(bf16, WS_Y1), WSP(int, WS_LIST), WSP(float, WS_EW)};
        GEMM_PHASE(EpiDown, MoeOrder, g, S, E);
    }
    if constexpr (PH == 9) {
#if !FUSE_PROJ
        Gemm g{WSP(bf16, WS_PB), WSP(bf16, WS_WPP), 256, nullptr, SKEW_K256}; StaticOrder S; S.init(T, D, F.G, (int)blockIdx.x); EpiProj E{WSP(bf16, WS_PROJ)};
        GEMM_PHASE(EpiProj, StaticOrder, g, S, E);
#endif
        x3_pass(F);
    }
    if constexpr (PH == 10) {
#if FUSE_PROJ && GATE_FIRST
        Gemm g{WSP(bf16, WS_ACT), WSP(bf16, WS_WPG), 512, nullptr, 0, WSP(bf16, WS_PB), WSP(bf16, WS_WPP), 128}; ProjGateOrder S; S.init(F.G, (int)blockIdx.x);
        EpiGateProj E{F.out, WSP(bf16, WS_X3B), F.ws + WS_PROJ + (size_t)blockIdx.x * 65536, WSP(float, WS_SA3), WSP(float, WS_SBPG), WSP(float, WS_SAP), WSP(float, WS_SBPP)};
        gemm_fast<EpiGateProj, ProjGateOrder, false, GF_ALIGN, GF_SP2, true, true>(F.lds, g, S, E);
#elif FUSE_PROJ
        Gemm g{WSP(bf16, WS_PB), WSP(bf16, WS_WPP), 128, nullptr, 0, WSP(bf16, WS_ACT), WSP(bf16, WS_WPG), 512}; ProjGateOrder S; S.init(F.G, (int)blockIdx.x);
        EpiProjGate E{F.out, WSP(bf16, WS_X3B), F.ws + WS_PROJ + (size_t)blockIdx.x * 131072, WSP(float, WS_SA3), WSP(float, WS_SBPG), WSP(float, WS_SAP), WSP(float, WS_SBPP)};
        gemm_fast<EpiProjGate, ProjGateOrder, false, GF_ALIGN, GF_SP2, true, true>(F.lds, g, S, E);
#elif I8_P10
        Gemm g{WSP(bf16, WS_ACT), WSP(bf16, WS_WPG), 512, nullptr, 0}; StaticOrder S; S.init(T, D, F.G, (int)blockIdx.x); EpiFinal8 E{F.out, WSP(bf16, WS_X3B), WSP(bf16, WS_PROJ), WSP(float, WS_SA3), WSP(float, WS_SBPG)};
        gemm_fast<EpiFinal8, StaticOrder, false, GF_ALIGN, GF_SP2, true>(F.lds, g, S, E);
#else
        Gemm g{WSP(bf16, WS_ACT), WSP(bf16, WS_WPG), 1024, nullptr, SKEW_K1024}; StaticOrder S; S.init(T, D, F.G, (int)blockIdx.x); EpiFinal E{F.out, WSP(bf16, WS_PROJ)};
        GEMM_PHASE(EpiFinal, StaticOrder, g, S, E);
#endif
    }
}

template <int PH> __global__ void __launch_bounds__(NTHR, 2) phase_kernel(Args args) {
    extern __shared__ __attribute__((aligned(16))) unsigned char lds[];
    Frame F; frame_init(F, args, lds);
    run_phase<PH>(F);
}
#if N_LAUNCHES == 1
__global__ void __launch_bounds__(NTHR, 2) mega(Args args) {
    extern __shared__ __attribute__((aligned(16))) unsigned char lds[];
    Frame F; frame_init(F, args, lds);
    XcdBarrier bar = xcd_barrier_post((unsigned*)(F.ctl + CW_BAR), F.MISC + 8);
#define PHASE(k) do { Frame Fk = F; int t_ = threadIdx.x; asm volatile("" : "+v"(t_)); Fk.tid = t_; Fk.lane = t_ & 63; Fk.wave = __builtin_amdgcn_readfirstlane(t_ >> 6); run_phase<k>(Fk); } while (0)
#define XBAR() xcd_barrier(bar)
    PHASE(0); XBAR();
    PHASE(1); XBAR();
    PHASE(2); XBAR();
    PHASE(3); XBAR();
    PHASE(4); XBAR();
    PHASE(5); XBAR();
    PHASE(6); XBAR();
    PHASE(7); XBAR();
    PHASE(8); XBAR();
    PHASE(9); XBAR();
    PHASE(10);
#undef PHASE
#undef XBAR
}
#endif
extern "C" void kernel_launch(void* const* d_in, const int* in_sizes, int n_in, void* d_out, int out_size, void* d_ws, size_t ws_size, hipStream_t stream) {
    static int grid = 0;
    if (grid == 0) {
        if (n_in != 27 || in_sizes[0] != T * D || out_size != T * D || ws_size < WS_END) { fprintf(stderr, "kernel_launch: unexpected shapes (n_in %d, in0 %d, out %d, ws %zu)\n", n_in, n_in > 0 ? in_sizes[0] : -1, out_size, ws_size); grid = -1; return; }
        int dev = 0, cus = 0;
        if (hipGetDevice(&dev) != hipSuccess || hipDeviceGetAttribute(&cus, hipDeviceAttributeMultiprocessorCount, dev) != hipSuccess) { grid = -1; return; }
#if N_LAUNCHES == 1
        if (hipFuncSetAttribute((const void*)mega, hipFuncAttributeMaxDynamicSharedMemorySize, LDS_BYTES) != hipSuccess) { fprintf(stderr, "kernel_launch: hipFuncSetAttribute failed\n"); grid = -1; return; }
#else
#define SETATTR(k) if (hipFuncSetAttribute((const void*)phase_kernel<k>, hipFuncAttributeMaxDynamicSharedMemorySize, LDS_BYTES) != hipSuccess) { fprintf(stderr, "kernel_launch: hipFuncSetAttribute failed\n"); grid = -1; return; }
        SETATTR(0) SETATTR(1) SETATTR(2) SETATTR(3) SETATTR(4) SETATTR(5) SETATTR(6) SETATTR(7) SETATTR(8) SETATTR(9) SETATTR(10)
#endif
        grid = cus;
    }
    if (grid < 0) return;
    (void)hipMemsetAsync((char*)d_ws + WS_CTL, 0, CTL_ZERO_BYTES, stream);
    Args a{};
    for (int i = 0; i < 27; ++i) a.in[i] = (const float*)d_in[i];
    a.out = (float*)d_out; a.ws = (unsigned char*)d_ws;
#if N_LAUNCHES == 1
    a.ph_lo = 0; a.ph_hi = NPHASE; a.use_bar = 1;
    hipLaunchKernelGGL(mega, dim3(grid), dim3(NTHR), LDS_BYTES, stream, a);
#else
#define LAUNCH_PH(k) hipLaunchKernelGGL(phase_kernel<k>, dim3(grid), dim3(NTHR), LDS_BYTES, stream, a)
#ifndef LAST_PHASE
#define LAST_PHASE 10
#endif
    LAUNCH_PH(0); LAUNCH_PH(1); LAUNCH_PH(2); LAUNCH_PH(3); LAUNCH_PH(4); LAUNCH_PH(5);
    if (LAST_PHASE >= 6) { LAUNCH_PH(6); } if (LAST_PHASE >= 7) { LAUNCH_PH(7); } if (LAST_PHASE >= 8) { LAUNCH_PH(8); } if (LAST_PHASE >= 9) { LAUNCH_PH(9); } if (LAST_PHASE >= 10) { LAUNCH_PH(10); }
#endif
    const hipError_t le = hipPeekAtLastError();
    if (le != hipSuccess) fprintf(stderr, "kernel_launch: launch failed: %s\n", hipGetErrorName(le));
}
```
